# Optimizing an MI355X kernel written in HIP

```python
import math
import jax, jax.numpy as jnp
from jax import lax
import numpy as np

D_MODEL = 1024
BATCH = 16
SEQ = 4096
DEPTH = 2

HEAD_DIM = 64
LRU_WIDTH = D_MODEL // 2
LRU_BLOCKS = LRU_WIDTH // HEAD_DIM
SB_HEADS = D_MODEL // 256
FOX_HEADS = D_MODEL // 256
SB_WIDTH = SB_HEADS * HEAD_DIM
FOX_WIDTH = FOX_HEADS * HEAD_DIM
D_MIX = LRU_WIDTH + SB_WIDTH + FOX_WIDTH
CONV_WIDTH = 4
LRU_C = 8.0
D_FF = 2816
Q_BLOCK = 128
N_SUB = 3
EPS = 1e-6

SPLIT_SIZES = (LRU_WIDTH, LRU_WIDTH,
               SB_WIDTH, SB_WIDTH, SB_WIDTH,
               FOX_WIDTH, FOX_WIDTH, FOX_WIDTH,
               FOX_HEADS)
N_IN = sum(SPLIT_SIZES)
SPLIT_POINTS = tuple(int(v) for v in np.cumsum(SPLIT_SIZES)[:-1])

kernel_name = "hybrid_macaron_rglru_stickbreak_fox"


def _rms(x):
    xf = x.astype(jnp.float32)
    y = xf * lax.rsqrt(jnp.mean(xf * xf, axis=-1, keepdims=True) + EPS)
    return y.astype(x.dtype)


def _swiglu(h, w_up, w_down):
    gu = h @ w_up
    g, u = jnp.split(gu, 2, axis=-1)
    return (jax.nn.silu(g) * u) @ w_down


def _causal_depthwise_conv(x, w, b):
    y = lax.conv_general_dilated(
        x, w[:, None, :], window_strides=(1,), padding=[(CONV_WIDTH - 1, 0)],
        dimension_numbers=("NWC", "WIO", "NWC"), feature_group_count=x.shape[-1])
    return y + b


def _lru_combine(left, right):
    a1, b1 = left
    a2, b2 = right
    return a1 * a2, a2 * b1 + b2


def _rg_lru(u, w_r, b_r, w_i, b_i, lam):
    B, S, _ = u.shape
    ub = u.reshape(B, S, LRU_BLOCKS, HEAD_DIM)
    r = jax.nn.sigmoid(jnp.einsum("bshi,hij->bshj", ub, w_r).reshape(B, S, LRU_WIDTH) + b_r)
    i = jax.nn.sigmoid(jnp.einsum("bshi,hij->bshj", ub, w_i).reshape(B, S, LRU_WIDTH) + b_i)
    r = r.astype(jnp.float32)
    log_a = -LRU_C * r * jax.nn.softplus(-lam.astype(jnp.float32))
    a = jnp.exp(log_a)
    mult = jnp.sqrt(-jnp.expm1(2.0 * log_a))
    bt = mult * (i.astype(jnp.float32) * u.astype(jnp.float32))
    _, h = lax.associative_scan(_lru_combine, (a, bt), axis=1)
    return h.astype(u.dtype)


def _to_heads(t, n_heads):
    B, S, _ = t.shape
    return t.reshape(B, S, n_heads, HEAD_DIM).transpose(0, 2, 1, 3)


def _from_blocks(out):
    nb, B, H, Q, Dh = out.shape
    return out.transpose(1, 0, 3, 2, 4).reshape(B, nb * Q, H * Dh)


def _stick_breaking_attention(q, k, v):
    S = q.shape[2]
    scale = HEAD_DIM ** -0.5
    key_pos = jnp.arange(S)

    def block(bi):
        start = bi * Q_BLOCK
        qb = lax.dynamic_slice_in_dim(q, start, Q_BLOCK, axis=2)
        z = jnp.einsum("bhqd,bhkd->bhqk", qb, k).astype(jnp.float32) * scale
        q_pos = start + jnp.arange(Q_BLOCK)
        past = key_pos[None, :] < q_pos[:, None]
        log_beta = jax.nn.log_sigmoid(z)
        log_1mb = jnp.where(past, jax.nn.log_sigmoid(-z), 0.0)
        after = lax.cumsum(log_1mb, axis=3, reverse=True) - log_1mb
        w = jnp.where(past, jnp.exp(log_beta + after), 0.0)
        return jnp.einsum("bhqk,bhkd->bhqd", w.astype(v.dtype), v)

    return _from_blocks(lax.map(block, jnp.arange(S // Q_BLOCK)))


def _forgetting_attention(q, k, v, log_f):
    S = q.shape[2]
    scale = HEAD_DIM ** -0.5
    key_pos = jnp.arange(S)
    F = jnp.cumsum(log_f, axis=-1)

    def block(bi):
        start = bi * Q_BLOCK
        qb = lax.dynamic_slice_in_dim(q, start, Q_BLOCK, axis=2)
        Fq = lax.dynamic_slice_in_dim(F, start, Q_BLOCK, axis=2)
        logits = jnp.einsum("bhqd,bhkd->bhqk", qb, k).astype(jnp.float32) * scale
        logits = logits + Fq[..., :, None] - F[..., None, :]
        q_pos = start + jnp.arange(Q_BLOCK)
        causal = key_pos[None, :] <= q_pos[:, None]
        logits = jnp.where(causal, logits, -jnp.inf)
        p = jax.nn.softmax(logits, axis=-1)
        return jnp.einsum("bhqk,bhkd->bhqd", p.astype(v.dtype), v)

    return _from_blocks(lax.map(block, jnp.arange(S // Q_BLOCK)))


def _mixer(h, w_in, b_fgate, conv_w, conv_b, w_rgate, b_rgate, w_igate, b_igate,
           lru_lambda, g_qk, g_mix_out, w_out):
    proj = h @ w_in
    (lru_x, lru_g, sb_q, sb_k, sb_v, fx_q, fx_k, fx_v, fx_f) = jnp.split(proj, SPLIT_POINTS, axis=-1)

    u = _causal_depthwise_conv(lru_x, conv_w, conv_b)
    y_lru = _rg_lru(u, w_rgate, b_rgate, w_igate, b_igate, lru_lambda) * jax.nn.gelu(lru_g)

    y_sb = _stick_breaking_attention(_to_heads(sb_q, SB_HEADS), _to_heads(sb_k, SB_HEADS),
                                     _to_heads(sb_v, SB_HEADS))

    fq = _rms(_to_heads(fx_q, FOX_HEADS)) * g_qk[0]
    fk = _rms(_to_heads(fx_k, FOX_HEADS)) * g_qk[1]
    log_f = jax.nn.log_sigmoid(fx_f.astype(jnp.float32) + b_fgate.astype(jnp.float32))
    y_fox = _forgetting_attention(fq, fk, _to_heads(fx_v, FOX_HEADS), log_f.transpose(0, 2, 1))

    y = jnp.concatenate([_rms(y_lru), _rms(y_sb), _rms(y_fox)], axis=-1) * g_mix_out
    return y @ w_out


def setup_inputs(seed: int = 0) -> dict:
    key = jax.random.key(seed)
    ks = jax.random.split(key, 20)
    f32 = jnp.float32
    nrm = lambda k, shape, s: jax.random.normal(k, shape, f32) * s
    x = jax.random.normal(ks[0], (BATCH, SEQ, D_MODEL), f32)
    c = jax.random.normal(ks[1], (BATCH, D_MODEL), f32)
    w_ada = nrm(ks[2], (DEPTH, D_MODEL, N_SUB * 3 * D_MODEL), 0.1 * D_MODEL ** -0.5)
    b_ada = nrm(ks[3], (DEPTH, N_SUB * 3 * D_MODEL), 0.01)
    g_norm = 1.0 + nrm(ks[4], (DEPTH, N_SUB, D_MODEL), 0.05)
    w_ffn_up = nrm(ks[5], (DEPTH, 2, D_MODEL, 2 * D_FF), D_MODEL ** -0.5)
    w_ffn_down = nrm(ks[6], (DEPTH, 2, D_FF, D_MODEL), D_FF ** -0.5)
    w_in = nrm(ks[7], (DEPTH, D_MODEL, N_IN), D_MODEL ** -0.5)
    b_fgate = 3.0 + nrm(ks[8], (DEPTH, FOX_HEADS), 0.1)
    conv_w = nrm(ks[9], (DEPTH, CONV_WIDTH, LRU_WIDTH), CONV_WIDTH ** -0.5)
    conv_b = nrm(ks[10], (DEPTH, LRU_WIDTH), 0.01)
    w_rgate = nrm(ks[11], (DEPTH, LRU_BLOCKS, HEAD_DIM, HEAD_DIM), HEAD_DIM ** -0.5)
    b_rgate = nrm(ks[12], (DEPTH, LRU_WIDTH), 0.01)
    w_igate = nrm(ks[13], (DEPTH, LRU_BLOCKS, HEAD_DIM, HEAD_DIM), HEAD_DIM ** -0.5)
    b_igate = nrm(ks[14], (DEPTH, LRU_WIDTH), 0.01)
    a_c = jax.random.uniform(ks[15], (DEPTH, LRU_WIDTH), f32, 0.9, 0.999)
    s = a_c ** (1.0 / LRU_C)
    lru_lambda = jnp.log(s) - jnp.log1p(-s)
    g_qk = 1.0 + nrm(ks[16], (DEPTH, 2, HEAD_DIM), 0.05)
    g_mix_out = 1.0 + nrm(ks[17], (DEPTH, D_MIX), 0.05)
    w_out = nrm(ks[18], (DEPTH, D_MIX, D_MODEL), D_MIX ** -0.5)
    return {"x": x, "c": c, "w_ada": w_ada, "b_ada": b_ada, "g_norm": g_norm,
            "w_ffn_up": w_ffn_up, "w_ffn_down": w_ffn_down, "w_in": w_in,
            "b_fgate": b_fgate, "conv_w": conv_w, "conv_b": conv_b,
            "w_rgate": w_rgate, "b_rgate": b_rgate, "w_igate": w_igate,
            "b_igate": b_igate, "lru_lambda": lru_lambda, "g_qk": g_qk,
            "g_mix_out": g_mix_out, "w_out": w_out}


def reference(x, c, w_ada, b_ada, g_norm, w_ffn_up, w_ffn_down, w_in, b_fgate, conv_w,
              conv_b, w_rgate, b_rgate, w_igate, b_igate, lru_lambda, g_qk, g_mix_out, w_out):
    B = x.shape[0]
    c_act = jax.nn.silu(c)
    for l in range(DEPTH):
        mod = (c_act @ w_ada[l] + b_ada[l]).reshape(B, N_SUB, 3, D_MODEL)

        def norm_mod(h, j):
            shift = mod[:, j, 0][:, None, :]
            scale = mod[:, j, 1][:, None, :]
            return _rms(h) * g_norm[l, j] * (1.0 + scale) + shift

        def gate(j):
            return (1.0 + mod[:, j, 2])[:, None, :]

        x = x + 0.5 * gate(0) * _swiglu(norm_mod(x, 0), w_ffn_up[l, 0], w_ffn_down[l, 0])
        x = x + gate(1) * _mixer(norm_mod(x, 1), w_in[l], b_fgate[l], conv_w[l], conv_b[l],
                                 w_rgate[l], b_rgate[l], w_igate[l], b_igate[l],
                                 lru_lambda[l], g_qk[l], g_mix_out[l], w_out[l])
        x = x + 0.5 * gate(2) * _swiglu(norm_mod(x, 2), w_ffn_up[l, 1], w_ffn_down[l, 1])
    return x
```

```cpp
#include <hip/hip_runtime.h>
#include <hip/hip_cooperative_groups.h>
#include <cstdio>
#include <cstdint>
namespace cg = cooperative_groups;
namespace pg8 {
#define PG8_LAS __attribute__((address_space(3)))
typedef unsigned short bf16_t;
typedef short bf16x8 __attribute__((ext_vector_type(8)));
typedef float f32x4 __attribute__((ext_vector_type(4)));
typedef unsigned u32x4 __attribute__((ext_vector_type(4)));
constexpr int BM = 256, BK = 64, HALF = 128, HTB = HALF * BK * 2  , STAGE_BYTES = 8 * HTB, NXCD = 8, WGM = 8;

__host__ __device__ __forceinline__ int lds_byte(int r, int c) { const int st = (r >> 4) * 2 + (c >> 5), rr = r & 15, cc = c & 31, ob = rr * 64 + cc * 2; return st * 1024 + (ob ^ (((ob >> 9) & 1) << 5)); }
__host__ __device__ __forceinline__ void stage_rc(int b, int& R, int& C) { const int st = b / 1024, sb = b % 1024, swz = sb ^ (((sb >> 9) & 1) << 5); R = (st >> 1) * 16 + swz / 64; C = (st & 1) * 32 + (swz % 64) / 2; }
__host__ __device__ __forceinline__ int perm32(int rho) { const int n = rho >> 4, i = rho & 15; return 8 * (i >> 2) + 4 * n + (i & 3); }

struct Unit { int pm, pn; };
struct Gemm { const bf16_t* A; const bf16_t* Bt; int M, N, K; };

struct StaticOrder {
    int nM, nN, nwg, G, c;
    __host__ __device__ void init(int M, int N, int G_, int c_) { nM = M / BM; nN = N / BM; nwg = nM * nN; G = G_; c = c_; }
    __host__ __device__ bool next(int i, Unit& u) const {
        const long L = (long)i * G + c; if (L >= nwg) return false;
        int wgid = (int)L; { const int q = nwg / NXCD, r = nwg % NXCD, xcd = wgid % NXCD, off = wgid / NXCD; wgid = (xcd < r ? xcd * (q + 1) : r * (q + 1) + (xcd - r) * q) + off; }
        const int nig = WGM * nN, gid = wgid / nig, fm = gid * WGM, gsz = (nM - fm) < WGM ? (nM - fm) : WGM;
        u.pm = fm + ((wgid % nig) % gsz); u.pn = (wgid % nig) / gsz; return true;
    }
    __device__ __forceinline__ void a_ready(const Unit&) const {}
    __device__ __forceinline__ void done(const Unit&) const {}
};

typedef float f32x2c_t __attribute__((ext_vector_type(2))); typedef __bf16 bf16x2c_t __attribute__((ext_vector_type(2)));
__device__ __forceinline__ unsigned cvt_pk_bf16(float lo, float hi) { f32x2c_t v = {lo, hi}; bf16x2c_t b = __builtin_convertvector(v, bf16x2c_t); return __builtin_bit_cast(unsigned, b); }
typedef float f32x2 __attribute__((ext_vector_type(2)));
constexpr float RMS_EPS = 1e-6f;
__device__ __forceinline__ float row_rstd(const float* rowss, int row) {
    const f32x4* p = (const f32x4*)(rowss + (size_t)row * 16); const f32x4 a = p[0], b = p[1], c = p[2], d = p[3];
    const float s = ((a[0] + a[1]) + (a[2] + a[3])) + ((b[0] + b[1]) + (b[2] + b[3])) + ((c[0] + c[1]) + (c[2] + c[3])) + ((d[0] + d[1]) + (d[2] + d[3]));
    return __builtin_amdgcn_rsqf(s * (1.0f / 1024.0f) + RMS_EPS);
}
struct EpiUp {
    static constexpr bool PERM = true, AFTER_DRAIN = false;
    bf16_t* H; const float* rowss; const float* sb;
    __device__ __forceinline__ void operator()(const f32x4 (&acc)[2][2][4][2], const Unit& u, int wr, int wc, int fr, int fq) const {
        const int row0 = u.pm * BM + wr * 64 + fr, b = u.pm >> 4, cl = wc * 32 + 8 * fq;
        const float* sbp = sb + (size_t)b * 5632 + u.pn * 256 + cl;
#pragma unroll
        for (int ai = 0; ai < 2; ++ai)
#pragma unroll
            for (int m = 0; m < 4; ++m) {
                const int row = row0 + ai * HALF + m * 16;
                const float rs = row_rstd(rowss, row);
                float hv[8];
#pragma unroll
                for (int n = 0; n < 2; ++n) { const f32x4 sgn = *(const f32x4*)(sbp + 4 * n), sun = *(const f32x4*)(sbp + 128 + 4 * n);
#pragma unroll
                    for (int i = 0; i < 4; ++i) {
                        const float g = rs * acc[ai][0][m][n][i] + sgn[i], uu = rs * acc[ai][1][m][n][i] + sun[i];
                        hv[n * 4 + i] = g * __builtin_amdgcn_rcpf(1.0f + __builtin_amdgcn_exp2f(-1.4426950408889634f * g)) * uu;
                    } }
                asm volatile("" ::: "memory");
                u32x4 w; w.x = cvt_pk_bf16(hv[0], hv[1]); w.y = cvt_pk_bf16(hv[2], hv[3]); w.z = cvt_pk_bf16(hv[4], hv[5]); w.w = cvt_pk_bf16(hv[6], hv[7]);
                *(u32x4*)(H + (size_t)row * 2816 + u.pn * 128 + cl) = w;
            }
    }
};
struct EpiIn {
    static constexpr bool PERM = true, AFTER_DRAIN = false;
    bf16_t* P; float* FG; const float* rowss; const float* sb;
    __device__ __forceinline__ void operator()(const f32x4 (&acc)[2][2][4][2], const Unit& u, int wr, int wc, int fr, int fq) const {
        const int row0 = u.pm * BM + wr * 64 + fr, b = u.pm >> 4, cl = wc * 32 + 8 * fq;
        const float* sbp = sb + (size_t)b * 5632 + u.pn * 256 + cl;
#pragma unroll
        for (int ai = 0; ai < 2; ++ai)
#pragma unroll
            for (int m = 0; m < 4; ++m) {
                const int row = row0 + ai * HALF + m * 16;
                const float rs = row_rstd(rowss, row);
                if (u.pn < 10) {
#pragma unroll
                    for (int bj = 0; bj < 2; ++bj) {
                        const f32x4 v0 = acc[ai][bj][m][0] * rs + *(const f32x4*)(sbp + bj * HALF), v1 = acc[ai][bj][m][1] * rs + *(const f32x4*)(sbp + bj * HALF + 4);
                        u32x4 w; w.x = cvt_pk_bf16(v0[0], v0[1]); w.y = cvt_pk_bf16(v0[2], v0[3]); w.z = cvt_pk_bf16(v1[0], v1[1]); w.w = cvt_pk_bf16(v1[2], v1[3]);
                        *(u32x4*)(P + (size_t)row * 2560 + u.pn * 256 + bj * HALF + cl) = w;
                    }
                } else if (wc == 0 && fq == 0) {
                    *(f32x4*)(FG + (size_t)row * 4) = acc[ai][0][m][0] * rs + *(const f32x4*)(sbp);
                }
            }
    }
};
struct EpiRes {
    static constexpr bool PERM = false, AFTER_DRAIN = false;
    const float* xin; float* xout; const float* gate; const float* gmn; bf16_t* XN; float* rowssn; int has_next;
    __device__ __forceinline__ void operator()(const f32x4 (&acc)[2][2][4][2], const Unit& u, int wr, int wc, int fr, int fq) const {
        typedef unsigned u32x2v __attribute__((ext_vector_type(2)));
        const int row0 = u.pm * BM + wr * 64 + fr, b = u.pm >> 4, col0 = u.pn * BM + wc * 32 + 4 * fq;
        const float* gp_ = gate + b * 1024 + col0; const float* gm_ = gmn + b * 1024 + col0;
#pragma unroll
        for (int ai = 0; ai < 2; ++ai)
#pragma unroll
            for (int m = 0; m < 4; ++m) {
                const int row = row0 + ai * HALF + m * 16; const size_t off = (size_t)row * 1024 + col0;
                float ss = 0.f;
#pragma unroll
                for (int bj = 0; bj < 2; ++bj)
#pragma unroll
                    for (int n = 0; n < 2; ++n) {
                        const f32x4 xi = *(const f32x4*)(xin + off + bj * HALF + n * 16);
                        const f32x4 xo = xi + *(const f32x4*)(gp_ + bj * HALF + n * 16) * acc[ai][bj][m][n];
                        *(f32x4*)(xout + off + bj * HALF + n * 16) = xo;
                        if (has_next) {
                            ss += (xo[0] * xo[0] + xo[1] * xo[1]) + (xo[2] * xo[2] + xo[3] * xo[3]);
                            const f32x4 a = xo * *(const f32x4*)(gm_ + bj * HALF + n * 16); u32x2v w; w.x = cvt_pk_bf16(a[0], a[1]); w.y = cvt_pk_bf16(a[2], a[3]);
                            *(u32x2v*)(XN + off + bj * HALF + n * 16) = w;
                        }
                    }
                if (has_next) { ss += __shfl_xor(ss, 16); ss += __shfl_xor(ss, 32); if (fq == 0) rowssn[(size_t)row * 16 + u.pn * 4 + wc] = ss; }
                asm volatile("" ::: "memory");
            }
    }
};

template <class Epi, class Sched, bool ALIGN_EPI = false, bool SP2 = false>
__device__ __forceinline__ void gemm_phase(PG8_LAS unsigned char* lds, const Gemm g, const Sched& S, const Epi& E) {
    int tid_o = threadIdx.x; asm volatile("" : "+v"(tid_o)); const int tid = tid_o, wid = __builtin_amdgcn_readfirstlane(tid >> 6), lane = tid & 63, wr = wid >> 2, wc = wid & 3, fr = lane & 15, fq = lane >> 4;
    const int K = g.K, nt = K / BK;
    unsigned voffA[2], voffB[2];
#pragma unroll
    for (int i = 0; i < 2; ++i) { int R, C; stage_rc(tid * 16 + i * 8192, R, C); const int Rb = Epi::PERM ? ((R & ~31) + perm32(R & 31)) : R;
        voffA[i] = (unsigned)(R * K + C) * 2u; voffB[i] = (unsigned)(Rb * K + C) * 2u; }
    const size_t kstep = (size_t)(BK * 2);
    const size_t hstep = (size_t)HALF * K * 2;
    const size_t tstep = 2 * hstep;
    const unsigned ldsw = (unsigned)wid * 1024u;
    const int aoff = lds_byte(wr * 64 + fr, fq * 8), boff = lds_byte(wc * 32 + fr, fq * 8);
#define PG8_SA(b, h) (((b) * 2 + (h)) * HTB)
#define PG8_SB(b, h) ((4 + (b) * 2 + (h)) * HTB)
#define PG8_STAGE(bufoff, gbase, voff) do { _Pragma("unroll") for (int _i = 0; _i < 2; ++_i) \
        __builtin_amdgcn_global_load_lds((const unsigned*)((const char*)(gbase) + (voff)[_i]), (PG8_LAS unsigned*)(lds + (bufoff) + ldsw + _i * 8192), 16, 0, 0); } while (0)
#define PG8_LDA(dst, b, h) do { _Pragma("unroll") for (int m = 0; m < 4; ++m) _Pragma("unroll") for (int k = 0; k < 2; ++k) dst[m][k] = *(const PG8_LAS bf16x8*)(lds + PG8_SA(b, h) + aoff + m * 2048 + k * 1024); } while (0)
#define PG8_LDB(dst, b, h) do { _Pragma("unroll") for (int n = 0; n < 2; ++n) _Pragma("unroll") for (int k = 0; k < 2; ++k) dst[n][k] = *(const PG8_LAS bf16x8*)(lds + PG8_SB(b, h) + boff + n * 2048 + k * 1024); } while (0)
#define PG8_MMA(ai, bj, At, Bt) do { __builtin_amdgcn_s_setprio(1); _Pragma("unroll") for (int m = 0; m < 4; ++m) _Pragma("unroll") for (int n = 0; n < 2; ++n) _Pragma("unroll") for (int k = 0; k < 2; ++k) \
        acc[ai][bj][m][n] = __builtin_amdgcn_mfma_f32_16x16x32_bf16(Bt[n][k], At[m][k], acc[ai][bj][m][n], 0, 0, 0); __builtin_amdgcn_s_setprio(0); } while (0)
#define PG8_WAIT_V(n) asm volatile("s_waitcnt vmcnt(" #n ")" ::: "memory")
#define PG8_WAIT_L(n) asm volatile("s_waitcnt lgkmcnt(" #n ")" ::: "memory")
#define PG8_BAR __builtin_amdgcn_s_barrier()
#define PG8_SCHED __builtin_amdgcn_sched_barrier(0)
    Unit cur, nxt; int ui = 0;
    if (!S.next(0, cur)) return;
    f32x4 acc[2][2][4][2];
#pragma unroll
    for (int a = 0; a < 2; ++a)
#pragma unroll
        for (int b = 0; b < 2; ++b)
#pragma unroll
            for (int m = 0; m < 4; ++m)
#pragma unroll
                for (int n = 0; n < 2; ++n) acc[a][b][m][n] = (f32x4){0.f, 0.f, 0.f, 0.f};
    bf16x8 At[4][2], B0[2][2], B1[2][2];
    const char* cA = (const char*)g.A + (size_t)cur.pm * tstep; const char* cB = (const char*)g.Bt + (size_t)cur.pn * tstep;
    S.a_ready(cur);
    if constexpr (SP2) {
        PG8_STAGE(PG8_SB(0, 0), cB, voffB); PG8_STAGE(PG8_SB(0, 1), cB + hstep, voffB); PG8_STAGE(PG8_SA(0, 0), cA, voffA); PG8_STAGE(PG8_SA(0, 1), cA + hstep, voffA);
        if (wr == 1) PG8_BAR;
        PG8_WAIT_V(2); PG8_BAR;
        PG8_STAGE(PG8_SB(1, 0), cB + kstep, voffB); PG8_STAGE(PG8_SA(1, 0), cA + kstep, voffA); PG8_STAGE(PG8_SB(1, 1), cB + hstep + kstep, voffB);
        PG8_WAIT_V(6); PG8_BAR;
    } else {
        PG8_STAGE(PG8_SB(0, 0), cB, voffB); PG8_STAGE(PG8_SA(0, 0), cA, voffA); PG8_STAGE(PG8_SB(0, 1), cB + hstep, voffB); PG8_STAGE(PG8_SA(0, 1), cA + hstep, voffA);
        if (wr == 1) PG8_BAR;
        PG8_WAIT_V(4); PG8_BAR;
        PG8_STAGE(PG8_SB(1, 0), cB + kstep, voffB); PG8_STAGE(PG8_SA(1, 0), cA + kstep, voffA); PG8_STAGE(PG8_SB(1, 1), cB + hstep + kstep, voffB);
        PG8_WAIT_V(6); PG8_BAR;
    }
    for (;;) {
        const bool has_next = S.next(ui + 1, nxt);
        const char* nA = has_next ? (const char*)g.A + (size_t)nxt.pm * tstep : cA; const char* nB = has_next ? (const char*)g.Bt + (size_t)nxt.pn * tstep : cB;
        for (int t = 0; t < nt; t += 2) {
            const bool last = (t == nt - 2);
            const char* a1 = cA + (size_t)(t + 1) * kstep;
            const char* a2 = last ? nA : cA + (size_t)(t + 2) * kstep; const char* b2 = last ? nB : cB + (size_t)(t + 2) * kstep;
            const char* a3 = a2 + kstep; const char* b3 = b2 + kstep;
            if (last && has_next) S.a_ready(nxt);
            if constexpr (SP2) {
            PG8_LDB(B0, 0, 0); PG8_LDB(B1, 0, 1); PG8_SCHED; PG8_LDA(At, 0, 0); PG8_STAGE(PG8_SA(1, 1), a1 + hstep, voffA);
            PG8_WAIT_V(8); PG8_WAIT_L(0); PG8_BAR; PG8_MMA(0, 0, At, B0); PG8_MMA(0, 1, At, B1); PG8_BAR; PG8_SCHED;
            PG8_LDA(At, 0, 1); PG8_STAGE(PG8_SB(0, 0), b2, voffB); PG8_STAGE(PG8_SB(0, 1), b2 + hstep, voffB); PG8_STAGE(PG8_SA(0, 0), a2, voffA);
            PG8_WAIT_V(8); PG8_WAIT_L(0); PG8_BAR; PG8_MMA(1, 0, At, B0); PG8_MMA(1, 1, At, B1); PG8_BAR; PG8_SCHED;
            PG8_LDB(B0, 1, 0); PG8_LDB(B1, 1, 1); PG8_SCHED; PG8_LDA(At, 1, 0); PG8_STAGE(PG8_SA(0, 1), a2 + hstep, voffA);
            PG8_WAIT_V(8); PG8_WAIT_L(0); PG8_BAR; PG8_MMA(0, 0, At, B0); PG8_MMA(0, 1, At, B1); PG8_BAR; PG8_SCHED;
            PG8_LDA(At, 1, 1); PG8_STAGE(PG8_SB(1, 0), b3, voffB); PG8_STAGE(PG8_SB(1, 1), b3 + hstep, voffB); PG8_STAGE(PG8_SA(1, 0), a3, voffA);
            PG8_WAIT_V(8); PG8_WAIT_L(0); PG8_BAR; PG8_MMA(1, 0, At, B0); PG8_MMA(1, 1, At, B1); PG8_BAR; PG8_SCHED;
            } else {
            PG8_LDB(B0, 0, 0); PG8_SCHED; PG8_LDA(At, 0, 0); PG8_STAGE(PG8_SA(1, 1), a1 + hstep, voffA);
            PG8_WAIT_L(8); PG8_BAR; PG8_WAIT_L(0); PG8_MMA(0, 0, At, B0); PG8_BAR; PG8_SCHED;
            PG8_LDB(B1, 0, 1); PG8_STAGE(PG8_SB(0, 0), b2, voffB);
            PG8_BAR; PG8_WAIT_L(0); PG8_MMA(0, 1, At, B1); PG8_BAR;
            PG8_LDA(At, 0, 1); PG8_STAGE(PG8_SA(0, 0), a2, voffA);
            PG8_BAR; PG8_WAIT_L(0); PG8_MMA(1, 0, At, B0); PG8_BAR; PG8_SCHED;
            PG8_STAGE(PG8_SB(0, 1), b2 + hstep, voffB);
            PG8_WAIT_V(6); PG8_BAR; PG8_MMA(1, 1, At, B1); PG8_BAR;
            PG8_LDB(B0, 1, 0); PG8_SCHED; PG8_LDA(At, 1, 0); PG8_STAGE(PG8_SA(0, 1), a2 + hstep, voffA);
            PG8_WAIT_L(8); PG8_BAR; PG8_WAIT_L(0); PG8_MMA(0, 0, At, B0); PG8_BAR; PG8_SCHED;
            PG8_LDB(B1, 1, 1); PG8_STAGE(PG8_SB(1, 0), b3, voffB);
            PG8_BAR; PG8_WAIT_L(0); PG8_MMA(0, 1, At, B1); PG8_BAR;
            PG8_LDA(At, 1, 1); PG8_STAGE(PG8_SA(1, 0), a3, voffA);
            PG8_BAR; PG8_WAIT_L(0); PG8_MMA(1, 0, At, B0); PG8_BAR; PG8_SCHED;
            PG8_STAGE(PG8_SB(1, 1), b3 + hstep, voffB);
            PG8_WAIT_V(6); PG8_BAR; PG8_MMA(1, 1, At, B1); PG8_BAR;
            }
        }
        if constexpr (ALIGN_EPI) { if (wr == 0) PG8_BAR; }
        if constexpr (!Epi::AFTER_DRAIN) { E(acc, cur, wr, wc, fr, fq); S.done(cur); }
        if (!has_next) break;
#pragma unroll
        for (int a = 0; a < 2; ++a)
#pragma unroll
            for (int b = 0; b < 2; ++b)
#pragma unroll
                for (int m = 0; m < 4; ++m)
#pragma unroll
                    for (int n = 0; n < 2; ++n) acc[a][b][m][n] = (f32x4){0.f, 0.f, 0.f, 0.f};
        cur = nxt; cA = nA; cB = nB; ++ui;
        if constexpr (ALIGN_EPI) { if (wr == 1) PG8_BAR; }
    }
    PG8_WAIT_V(0);
    if constexpr (!ALIGN_EPI) { if (wr == 0) PG8_BAR; }
    PG8_BAR;
    if constexpr (Epi::AFTER_DRAIN) { E.fused(acc, cur, wr, wc, fr, fq, lds, wid, lane); S.done(cur); }
#undef PG8_SA
#undef PG8_SB
#undef PG8_STAGE
#undef PG8_LDA
#undef PG8_LDB
#undef PG8_MMA
#undef PG8_WAIT_V
#undef PG8_WAIT_L
#undef PG8_BAR
#undef PG8_SCHED
}
}

#define LAS __attribute__((address_space(3)))
typedef unsigned short bf16_t;
typedef short bf16x8 __attribute__((ext_vector_type(8)));
typedef short s16x4 __attribute__((ext_vector_type(4)));
typedef float f32x4 __attribute__((ext_vector_type(4)));
typedef float f32x2 __attribute__((ext_vector_type(2)));
typedef float f32x16 __attribute__((ext_vector_type(16)));
typedef unsigned u32x4 __attribute__((ext_vector_type(4)));
typedef unsigned u32x2 __attribute__((ext_vector_type(2)));

constexpr int MTOK = 65536, DM = 1024, DFF = 2816, NUP = 5632, NINP = 2816, PPITCH = 2560, SEQL = 4096;
constexpr float EPSF = 1e-6f, LOG2E = 1.4426950408889634f;
constexpr size_t MiB = 1u << 20;
constexpr size_t WS_MOD = 1 * MiB, WS_GMOD = 3 * MiB, WS_GATE = 4 * MiB, WS_SB = 5 * MiB, WS_ROWSS = 976 * MiB, WS_KS = 10 * MiB, WS_F2 = 11 * MiB, WS_FG = 12 * MiB,
                 WS_ASEG = 13 * MiB, WS_BSEG = 17 * MiB, WS_WUP = 24 * MiB, WS_WDN = 68 * MiB, WS_WIN = 90 * MiB, WS_WOUT = 101 * MiB, WS_XN = 112 * MiB,
                 WS_H = 240 * MiB, WS_PROJ = 240 * MiB, WS_YU = 592 * MiB, WS_HLOC = 656 * MiB, WS_PCUM = 784 * MiB, WS_YN = 848 * MiB, WS_END = 1000 * MiB;
constexpr int LDS_BYTES = 147456;

__device__ __forceinline__ float bf2f(unsigned short v) { return __uint_as_float((unsigned)v << 16); }
__device__ __forceinline__ unsigned f2bf(float f) { unsigned u = __float_as_uint(f); return (u + 0x7fffu + ((u >> 16) & 1u)) >> 16; }
__device__ __forceinline__ unsigned pk2(float lo, float hi) { return pg8::cvt_pk_bf16(lo, hi); }
__device__ __forceinline__ float wave_sum(float v) {
#pragma unroll
    for (int o = 1; o < 64; o <<= 1) v += __shfl_xor(v, o);
    return v;
}
__device__ __forceinline__ float sigmoidf_(float x) { return __builtin_amdgcn_rcpf(1.0f + __builtin_amdgcn_exp2f(-LOG2E * x)); }
#define WAITV(n) asm volatile("s_waitcnt vmcnt(" #n ")" ::: "memory")
#define LBAR() asm volatile("s_waitcnt lgkmcnt(0)\n\ts_barrier" ::: "memory")
#define CFENCE() asm volatile("" ::: "memory")

struct Args { const float* in[19]; float* out; unsigned char* ws; int ph_lo, ph_hi; };

__device__ __forceinline__ void transpose_item(const float* __restrict__ W, int ldw, int clim, int K, bf16_t* __restrict__ WT, int n0, int c0, int k0, LAS float* scr, int lane) {
    const int col = c0 + (lane & 31);
#pragma unroll 8
    for (int i = 0; i < 32; ++i) { const int kk = 2 * i + (lane >> 5); scr[kk * 33 + (lane & 31)] = (col < clim) ? W[(size_t)(k0 + kk) * ldw + col] : 0.f; }
    asm volatile("s_waitcnt lgkmcnt(0)" ::: "memory");
    const int c = lane & 7;
#pragma unroll
    for (int j = 0; j < 4; ++j) { const int n = (lane >> 3) + 8 * j; const LAS float* s = scr + (8 * c) * 33 + n;
        u32x4 o; o.x = pk2(s[0 * 33], s[1 * 33]); o.y = pk2(s[2 * 33], s[3 * 33]); o.z = pk2(s[4 * 33], s[5 * 33]); o.w = pk2(s[6 * 33], s[7 * 33]);
        *(u32x4*)(WT + (size_t)(n0 + n) * K + k0 + 8 * c) = o; }
    asm volatile("s_waitcnt lgkmcnt(0)" ::: "memory");
}

__device__ __forceinline__ int crow(int r, int hi) { return (r & 3) + 8 * (r >> 2) + 4 * hi; }
__device__ __forceinline__ s16x4 vtr(const LAS unsigned char* p) {
    typedef short v4i16_t __attribute__((ext_vector_type(4)));
    return __builtin_bit_cast(s16x4, __builtin_amdgcn_ds_read_tr16_b64_v4i16((LAS v4i16_t*)p));
}
constexpr int AT_SLOT = 16384, AT_AUX = 3 * AT_SLOT, AT_WSF = AT_AUX + 3 * 512, AT_VOTE = AT_WSF + 8 * 256;
constexpr float C2 = 0.125f * LOG2E;

__device__ __forceinline__ void sb_block(f32x16& X, float& carry, bool band, int kv0  , int qrel, int hi) {
    float lm[16];
#pragma unroll
    for (int r = 0; r < 16; ++r) {
        float z2 = X[r] * C2; z2 = __builtin_fminf(__builtin_fmaxf(z2, -120.f), 120.f);
        const float e = __builtin_amdgcn_exp2f(-z2), sp = __builtin_amdgcn_logf(1.0f + e);
        float l1 = -(sp + z2), lb = -sp;
        if (band) { const int kv = kv0 + (r & 3) + 8 * (r >> 2); const bool valid = kv < qrel; l1 = valid ? l1 : 0.f; lb = valid ? lb : -INFINITY; }
        lm[r] = l1; X[r] = lb;
    }
    float G[4], Gp[4], T[4];
#pragma unroll
    for (int g = 0; g < 4; ++g) { G[g] = (lm[4 * g] + lm[4 * g + 1]) + (lm[4 * g + 2] + lm[4 * g + 3]); Gp[g] = __shfl_xor(G[g], 32); T[g] = G[g] + Gp[g]; }
    float S = carry;
#pragma unroll
    for (int g = 3; g >= 0; --g) {
        const float a3 = S + (hi == 0 ? Gp[g] : 0.f), a2 = a3 + lm[4 * g + 3], a1 = a2 + lm[4 * g + 2], a0 = a1 + lm[4 * g + 1];
        X[4 * g + 3] = __builtin_amdgcn_exp2f(X[4 * g + 3] + a3); X[4 * g + 2] = __builtin_amdgcn_exp2f(X[4 * g + 2] + a2);
        X[4 * g + 1] = __builtin_amdgcn_exp2f(X[4 * g + 1] + a1); X[4 * g] = __builtin_amdgcn_exp2f(X[4 * g] + a0);
        S += T[g];
    }
    carry = S;
}

template <int KIND>
__device__ __forceinline__ void attn_unit(LAS unsigned char* lds, const bf16_t* __restrict__ PROJ, bf16_t* __restrict__ YU, const float* __restrict__ KS,
                                          const float* __restrict__ F2, const float* __restrict__ gqk, int b, int h, int qb) {
    int tid_o = threadIdx.x; asm volatile("" : "+v"(tid_o));
    const int tid = tid_o, lane = tid & 63, r32 = lane & 31, hi = lane >> 5;
    const int wid = __builtin_amdgcn_readfirstlane(tid >> 6);
    const int qcol = (KIND == 0 ? 1024 : 1792) + h * 64, kcol = qcol + 256, vcol = qcol + 512;
    const size_t rowbase = (size_t)b * SEQL; const int q0 = qb * 256, bh = b * 4 + h;
    const int NT = (q0 + 256) / 64;
    const bf16_t* ksrc = PROJ + (rowbase + lane) * PPITCH + kcol + wid * 8;
    const bf16_t* vsrc = PROJ + (rowbase + 16 * (wid & 3) + (lane >> 2)) * PPITCH + vcol + (wid >> 2) * 32 + (lane & 3) * 8;
    const float* axsrc = (wid == 0 ? KS : F2) + (size_t)bh * SEQL + lane;
    u32x4 kreg, vreg; float areg = 0.f;
#define AT_LOAD(it_) do { const int kt_ = NT - 1 - (it_); kreg = *(const u32x4*)(ksrc + (size_t)kt_ * 64 * PPITCH); vreg = *(const u32x4*)(vsrc + (size_t)kt_ * 64 * PPITCH); \
        if (KIND == 1 && wid < 2) areg = axsrc[kt_ * 64]; } while (0)
#define AT_STORE(slot_) do { *(LAS u32x4*)(lds + (slot_) * AT_SLOT + wid * 1024 + lane * 16) = kreg; *(LAS u32x4*)(lds + (slot_) * AT_SLOT + 8192 + wid * 1024 + lane * 16) = vreg; \
        if (KIND == 1 && wid < 2) *(LAS float*)(lds + AT_AUX + (slot_) * 512 + wid * 256 + lane * 4) = areg; } while (0)
    const bf16_t* Qw = PROJ + (rowbase + q0 + wid * 32 + r32) * PPITCH + qcol + hi * 8;
    bf16x8 qr[4];
#pragma unroll
    for (int d0 = 0; d0 < 4; ++d0) qr[d0] = *(const bf16x8*)(Qw + d0 * 16);
    float Ft = 0.f;
    if (KIND == 1) Ft = F2[(size_t)bh * SEQL + q0 + wid * 32 + r32];
    AT_LOAD(0);
    if (KIND == 1) {
        float qf[4][8]; float ss = 0.f;
#pragma unroll
        for (int d0 = 0; d0 < 4; ++d0)
#pragma unroll
            for (int i = 0; i < 8; ++i) { qf[d0][i] = bf2f((unsigned short)qr[d0][i]); ss += qf[d0][i] * qf[d0][i]; }
        ss += __shfl_xor(ss, 32);
        const float rs = __builtin_amdgcn_rsqf(ss * (1.0f / 64.0f) + EPSF) * C2;
#pragma unroll
        for (int d0 = 0; d0 < 4; ++d0) {
            const float* gp = gqk + d0 * 16 + hi * 8; float v[8];
#pragma unroll
            for (int i = 0; i < 8; ++i) v[i] = qf[d0][i] * rs * gp[i] * gp[64 + i];
            u32x4 w; w.x = pk2(v[0], v[1]); w.y = pk2(v[2], v[3]); w.z = pk2(v[4], v[5]); w.w = pk2(v[6], v[7]);
            qr[d0] = __builtin_bit_cast(bf16x8, w);
        }
    }
    f32x16 o0, o1;
#pragma unroll
    for (int r = 0; r < 16; ++r) { o0[r] = 0.f; o1[r] = 0.f; }
    float mhat = -1e30f, lsum = 0.f, carry = 0.f;
    LAS float* wsf = (LAS float*)(lds + AT_WSF) + wid * 64;
    LAS unsigned* votes = (LAS unsigned*)(lds + AT_VOTE);
    const int qrel = wid * 32 + r32;
    AT_STORE(0); LBAR();
    for (int it = 0; it < NT; ++it) {
        const int slot = it & 1;
        if (KIND == 0 && it > 0) {
            const LAS unsigned* vp = votes + ((it - 1) & 1) * 8;
            const unsigned all = vp[0] & vp[1] & vp[2] & vp[3] & vp[4] & vp[5] & vp[6] & vp[7];
            if (all) break;
        }
        if (it + 1 < NT) AT_LOAD(it + 1);
        const int kt = NT - 1 - it, jb = kt - (NT - 4);
        const bool band = jb >= 0;
        const bool active = !(band && 64 * jb > 32 * wid + 31);
        if (active) {
            f32x16 p0, p1;
            { const LAS unsigned char* kb = lds + slot * AT_SLOT + hi * 1024 + r32 * 16;
#pragma unroll
              for (int d0 = 0; d0 < 4; ++d0) {
                  const bf16x8 b0 = *(const LAS bf16x8*)(kb + d0 * 2048), b1 = *(const LAS bf16x8*)(kb + d0 * 2048 + 512);
                  if (d0 == 0) { f32x16 z;
#pragma unroll
                      for (int r = 0; r < 16; ++r) z[r] = 0.f;
                      p0 = __builtin_amdgcn_mfma_f32_32x32x16_bf16(b0, qr[0], z, 0, 0, 0); p1 = __builtin_amdgcn_mfma_f32_32x32x16_bf16(b1, qr[0], z, 0, 0, 0); }
                  else { p0 = __builtin_amdgcn_mfma_f32_32x32x16_bf16(b0, qr[d0], p0, 0, 0, 0); p1 = __builtin_amdgcn_mfma_f32_32x32x16_bf16(b1, qr[d0], p1, 0, 0, 0); }
              } }
            if (KIND == 0) {
                sb_block(p1, carry, band, 64 * jb + 32 + 4 * hi, qrel, hi);
                sb_block(p0, carry, band, 64 * jb + 4 * hi, qrel, hi);
            } else {
                const LAS float* ax = (const LAS float*)(lds + AT_AUX + slot * 512);
#pragma unroll
                for (int g = 0; g < 4; ++g) {
                    const f32x4 k0 = *(const LAS f32x4*)(ax + 8 * g + 4 * hi), k1 = *(const LAS f32x4*)(ax + 32 + 8 * g + 4 * hi);
                    const f32x4 f0 = *(const LAS f32x4*)(ax + 64 + 8 * g + 4 * hi), f1 = *(const LAS f32x4*)(ax + 96 + 8 * g + 4 * hi);
#pragma unroll
                    for (int i = 0; i < 4; ++i) { p0[4 * g + i] = p0[4 * g + i] * k0[i] + (Ft - f0[i]); p1[4 * g + i] = p1[4 * g + i] * k1[i] + (Ft - f1[i]); }
                }
                if (band) {
#pragma unroll
                    for (int r = 0; r < 16; ++r) { const int kv = 64 * jb + crow(r, hi); if (kv > qrel) p0[r] = -INFINITY; if (kv + 32 > qrel) p1[r] = -INFINITY; }
                }
                float rm = p0[0];
#pragma unroll
                for (int r = 1; r < 16; ++r) rm = __builtin_fmaxf(rm, p0[r]);
#pragma unroll
                for (int r = 0; r < 16; ++r) rm = __builtin_fmaxf(rm, p1[r]);
                rm = __builtin_fmaxf(rm, __shfl_xor(rm, 32));
                if (__any(rm > mhat + 8.0f)) {
                    const float mnew = __builtin_fmaxf(mhat, rm), f = __builtin_amdgcn_exp2f(mhat - mnew);
                    lsum *= f; mhat = mnew;
                    CFENCE(); if (hi == 0) wsf[r32] = f; CFENCE();
                    asm volatile("s_waitcnt lgkmcnt(0)" ::: "memory");
#pragma unroll
                    for (int r = 0; r < 16; ++r) { const float fr_ = wsf[crow(r, hi)]; o0[r] *= fr_; o1[r] *= fr_; }
                    CFENCE();
                }
                float sacc = 0.f;
#pragma unroll
                for (int r = 0; r < 16; ++r) { p0[r] = __builtin_amdgcn_exp2f(p0[r] - mhat); p1[r] = __builtin_amdgcn_exp2f(p1[r] - mhat); sacc += p0[r] + p1[r]; }
                lsum += sacc;
            }
            u32x4 pw0, pw1, pw2, pw3;
            pw0.x = pk2(p0[0], p0[1]); pw0.y = pk2(p0[2], p0[3]); pw0.z = pk2(p0[4], p0[5]); pw0.w = pk2(p0[6], p0[7]);
            pw1.x = pk2(p0[8], p0[9]); pw1.y = pk2(p0[10], p0[11]); pw1.z = pk2(p0[12], p0[13]); pw1.w = pk2(p0[14], p0[15]);
            pw2.x = pk2(p1[0], p1[1]); pw2.y = pk2(p1[2], p1[3]); pw2.z = pk2(p1[4], p1[5]); pw2.w = pk2(p1[6], p1[7]);
            pw3.x = pk2(p1[8], p1[9]); pw3.y = pk2(p1[10], p1[11]); pw3.z = pk2(p1[12], p1[13]); pw3.w = pk2(p1[14], p1[15]);
            const LAS unsigned char* vb = lds + slot * AT_SLOT + 8192 + ((lane >> 4) & 1) * 32 + (lane & 3) * 8 + (4 * hi + ((lane & 15) >> 2)) * 64;
            s16x4 vlo[8], vhi[8];
#pragma unroll
            for (int i = 0; i < 8; ++i) { vlo[i] = vtr(vb + (i >> 2) * 4096 + (i & 3) * 1024); vhi[i] = vtr(vb + (i >> 2) * 4096 + (i & 3) * 1024 + 512); }
#define VFR(i) (bf16x8){vlo[i][0], vlo[i][1], vlo[i][2], vlo[i][3], vhi[i][0], vhi[i][1], vhi[i][2], vhi[i][3]}
#define PAF(x) __builtin_bit_cast(bf16x8, x)
            o0 = __builtin_amdgcn_mfma_f32_32x32x16_bf16(PAF(pw0), VFR(0), o0, 0, 0, 0); o1 = __builtin_amdgcn_mfma_f32_32x32x16_bf16(PAF(pw0), VFR(4), o1, 0, 0, 0);
            o0 = __builtin_amdgcn_mfma_f32_32x32x16_bf16(PAF(pw1), VFR(1), o0, 0, 0, 0); o1 = __builtin_amdgcn_mfma_f32_32x32x16_bf16(PAF(pw1), VFR(5), o1, 0, 0, 0);
            o0 = __builtin_amdgcn_mfma_f32_32x32x16_bf16(PAF(pw2), VFR(2), o0, 0, 0, 0); o1 = __builtin_amdgcn_mfma_f32_32x32x16_bf16(PAF(pw2), VFR(6), o1, 0, 0, 0);
            o0 = __builtin_amdgcn_mfma_f32_32x32x16_bf16(PAF(pw3), VFR(3), o0, 0, 0, 0); o1 = __builtin_amdgcn_mfma_f32_32x32x16_bf16(PAF(pw3), VFR(7), o1, 0, 0, 0);
#undef VFR
#undef PAF
        }
        if (KIND == 0) { const unsigned done = (active && __all(carry < -150.0f)) ? 1u : 0u; if (lane == 0) votes[(it & 1) * 8 + wid] = done; }
        if (it + 1 < NT) AT_STORE(slot ^ 1);
        LBAR();
    }
    if (KIND == 1) { lsum += __shfl_xor(lsum, 32); CFENCE(); if (hi == 0) wsf[r32] = lsum; CFENCE(); asm volatile("s_waitcnt lgkmcnt(0)" ::: "memory"); }
    bf16_t* Yw = YU + (rowbase + q0 + wid * 32) * 512 + KIND * 256 + h * 64 + r32;
#pragma unroll
    for (int r = 0; r < 16; ++r) {
        const int orow = crow(r, hi); float sc = 1.0f;
        if (KIND == 1) sc = __builtin_amdgcn_rcpf(wsf[orow]);
        Yw[(size_t)orow * 512] = (bf16_t)f2bf(o0[r] * sc); Yw[(size_t)orow * 512 + 32] = (bf16_t)f2bf(o1[r] * sc);
    }
    LBAR();
#undef AT_LOAD
#undef AT_STORE
}

#define DEFPTRS \
    const __attribute__((address_space(4))) Args* ka_ = (const __attribute__((address_space(4))) Args*)__builtin_amdgcn_kernarg_segment_ptr(); \
    asm volatile("" : "+s"(ka_)); \
    int tid_o_ = threadIdx.x; asm volatile("" : "+v"(tid_o_)); const int tid = tid_o_, lane = tid & 63; (void)lane; \
    unsigned char* ws = ka_->ws; \
    const float* x_in = ka_->in[0]; const float* c_in = ka_->in[1]; const float* w_ada = ka_->in[2]; const float* b_ada = ka_->in[3]; const float* g_norm = ka_->in[4]; \
    const float* w_up = ka_->in[5]; const float* w_dn = ka_->in[6]; const float* w_in = ka_->in[7]; const float* b_fg = ka_->in[8]; const float* conv_w = ka_->in[9]; \
    const float* conv_b = ka_->in[10]; const float* w_rg = ka_->in[11]; const float* b_rg = ka_->in[12]; const float* w_ig = ka_->in[13]; const float* b_ig = ka_->in[14]; \
    const float* lam = ka_->in[15]; const float* g_qk = ka_->in[16]; const float* g_mix = ka_->in[17]; const float* w_out = ka_->in[18]; \
    float* xout = ka_->out; \
    float* MOD = (float*)(ws + WS_MOD); float* GMOD = (float*)(ws + WS_GMOD); float* GATE = (float*)(ws + WS_GATE); float* SBV = (float*)(ws + WS_SB); \
    float* ROWSS = (float*)(ws + WS_ROWSS); float* KS = (float*)(ws + WS_KS); float* F2 = (float*)(ws + WS_F2); float* FG = (float*)(ws + WS_FG); \
    float* ASEG = (float*)(ws + WS_ASEG); float* BSEG = (float*)(ws + WS_BSEG); \
    bf16_t* WUP = (bf16_t*)(ws + WS_WUP); bf16_t* WDN = (bf16_t*)(ws + WS_WDN); bf16_t* WIN = (bf16_t*)(ws + WS_WIN); bf16_t* WOUT = (bf16_t*)(ws + WS_WOUT); \
    bf16_t* XN = (bf16_t*)(ws + WS_XN); bf16_t* HB = (bf16_t*)(ws + WS_H); bf16_t* PROJ = (bf16_t*)(ws + WS_PROJ); bf16_t* YU = (bf16_t*)(ws + WS_YU); \
    float* HLOC = (float*)(ws + WS_HLOC); bf16_t* PCUM = (bf16_t*)(ws + WS_PCUM); bf16_t* YN = (bf16_t*)(ws + WS_YN);
__global__ void __launch_bounds__(512) mk_fwd(Args args) {
    extern __shared__ __attribute__((aligned(16))) unsigned char lds_raw[];
    LAS unsigned char* lds = (LAS unsigned char*)lds_raw;
    cg::grid_group grid = cg::this_grid();
    const int wave = __builtin_amdgcn_readfirstlane(threadIdx.x >> 6);
    const int G = gridDim.x; const int bx = blockIdx.x;
    const int vcu = (G % 8 == 0) ? (bx % 8) * (G / 8) + bx / 8 : bx;
    const int gw = vcu * 8 + wave, NGW = G * 8;
    const int lo = args.ph_lo, hi_ph = args.ph_hi;
    int ph = 0;
#define PH_ON (ph >= lo && ph < hi_ph)
#define PH_NEXT do { ++ph; if (ph > lo && ph < hi_ph) { asm volatile("s_waitcnt vmcnt(0) lgkmcnt(0)" ::: "memory"); __builtin_amdgcn_fence(__ATOMIC_RELEASE, "agent"); grid.sync(); __builtin_amdgcn_fence(__ATOMIC_ACQUIRE, "agent"); } } while (0)

    if (PH_ON) { DEFPTRS
        LAS float* cact = (LAS float*)lds;
        LAS float* red = (LAS float*)(lds + 65536);
        for (int i = tid; i < 16 * 1024; i += 512) { const int b = i >> 10, k = i & 1023; const float v = c_in[i]; cact[k * 16 + b] = v * sigmoidf_(v); }
        __syncthreads();
        for (int task = bx; task < 288; task += G) {
            const int l = task / 144, n0 = (task % 144) * 64;
            float acc[16];
#pragma unroll
            for (int b = 0; b < 16; ++b) acc[b] = 0.f;
            const float* wp = w_ada + (size_t)l * 1024 * 9216 + n0 + lane;
#pragma unroll 4
            for (int k = wave * 128; k < wave * 128 + 128; ++k) {
                const float w = wp[(size_t)k * 9216];
                const f32x4 c0 = *(const LAS f32x4*)(cact + k * 16), c1 = *(const LAS f32x4*)(cact + k * 16 + 4), c2 = *(const LAS f32x4*)(cact + k * 16 + 8), c3 = *(const LAS f32x4*)(cact + k * 16 + 12);
#pragma unroll
                for (int i = 0; i < 4; ++i) { acc[i] += c0[i] * w; acc[4 + i] += c1[i] * w; acc[8 + i] += c2[i] * w; acc[12 + i] += c3[i] * w; }
            }
#pragma unroll
            for (int b = 0; b < 16; ++b) red[(wave * 16 + b) * 64 + lane] = acc[b];
            __syncthreads();
            for (int o = tid; o < 1024; o += 512) { const int b = o >> 6, ln = o & 63; float s = 0.f;
#pragma unroll
                for (int w = 0; w < 8; ++w) s += red[(w * 16 + b) * 64 + ln];
                MOD[((size_t)l * 16 + b) * 9216 + n0 + ln] = s + b_ada[l * 9216 + n0 + ln]; }
            __syncthreads();
        }
    }
    PH_NEXT;
    if (PH_ON) { DEFPTRS
        for (int i = bx * 512 + tid; i < 2 * 3 * 16 * 1024; i += G * 512) {
            const int k = i & 1023, b = (i >> 10) & 15, lj = i >> 14, l = lj / 3, j = lj % 3;
            const float* mp = MOD + ((size_t)l * 16 + b) * 9216 + j * 3072;
            GMOD[i] = g_norm[(l * 3 + j) * 1024 + k] * (1.0f + mp[1024 + k]);
            GATE[i] = (j == 1 ? 1.0f : 0.5f) * (1.0f + mp[2048 + k]);
        }
        LAS float* scr = (LAS float*)(lds + wave * 8448);
        constexpr int I_UP = 16 * 176, I_DN = 44 * 32, I_IN = 16 * 88, I_OUT = 16 * 32;
        constexpr int NIT = 4 * I_UP + 4 * I_DN + 2 * I_IN + 2 * I_OUT;
        for (int it = gw; it < NIT; it += NGW) {
            int r = it;
            if (r < 4 * I_UP) { const int mat = r / I_UP; r -= mat * I_UP; const int kb = r / 176, nb = r % 176, n0 = nb * 32;
                const int c0 = ((n0 >> 7) & 1) * DFF + (n0 >> 8) * 128 + (n0 & 127);
                transpose_item(w_up + (size_t)mat * DM * NUP, NUP, NUP, DM, WUP + (size_t)mat * NUP * DM, n0, c0, kb * 64, scr, lane); continue; }
            r -= 4 * I_UP;
            if (r < 4 * I_DN) { const int mat = r / I_DN; r -= mat * I_DN; const int kb = r / 32, nb = r % 32;
                transpose_item(w_dn + (size_t)mat * DFF * DM, DM, DM, DFF, WDN + (size_t)mat * DM * DFF, nb * 32, nb * 32, kb * 64, scr, lane); continue; }
            r -= 4 * I_DN;
            if (r < 2 * I_IN) { const int mat = r / I_IN; r -= mat * I_IN; const int kb = r / 88, nb = r % 88;
                transpose_item(w_in + (size_t)mat * DM * 2564, 2564, 2564, DM, WIN + (size_t)mat * NINP * DM, nb * 32, nb * 32, kb * 64, scr, lane); continue; }
            r -= 2 * I_IN;
            { const int mat = r / I_OUT; r -= mat * I_OUT; const int kb = r / 32, nb = r % 32;
                transpose_item(w_out + (size_t)mat * DM * DM, DM, DM, DM, WOUT + (size_t)mat * DM * DM, nb * 32, nb * 32, kb * 64, scr, lane); }
        }
        for (int m = gw; m < MTOK; m += NGW) {
            const int b = m >> 12;
            const f32x4* xr = (const f32x4*)(x_in + (size_t)m * DM) + lane;
            const f32x4* gp = (const f32x4*)(g_norm) + lane;
            const f32x4* sp = (const f32x4*)(MOD + (size_t)b * 9216 + 1024) + lane;
            float s = 0.f; u32x2* o8 = (u32x2*)(XN + (size_t)m * DM) + lane;
#pragma unroll
            for (int j = 0; j < 4; ++j) { const f32x4 v = xr[64 * j]; s += (v[0] * v[0] + v[1] * v[1]) + (v[2] * v[2] + v[3] * v[3]);
                const f32x4 a = v * gp[64 * j] * (sp[64 * j] + 1.0f); u32x2 w; w.x = pk2(a[0], a[1]); w.y = pk2(a[2], a[3]); o8[64 * j] = w; }
            s = wave_sum(s);
            if (lane < 16) ROWSS[(size_t)m * 16 + lane] = (lane == 0) ? s : 0.f;
        }
    }
    PH_NEXT;
    if (PH_ON) { DEFPTRS
        LAS float* sh = (LAS float*)lds;
        for (int combo = 0; combo < 6; ++combo) {
            const int l = combo / 3, j = combo % 3;
            __syncthreads();
            for (int i = tid; i < 16 * 1024; i += 512) { const int b = i >> 10, k = i & 1023; sh[i] = MOD[((size_t)l * 16 + b) * 9216 + j * 3072 + k]; }
            __syncthreads();
            const bf16_t* Wt = (j == 1) ? WIN + (size_t)l * NINP * DM : WUP + (size_t)(l * 2 + (j == 2 ? 1 : 0)) * NUP * DM;
            const int N = (j == 1) ? NINP : NUP;
            float* dst = SBV + (size_t)combo * 16 * 5632;
            for (int n = gw; n < N; n += NGW) {
                float w[16];
#pragma unroll
                for (int c = 0; c < 4; ++c) { const u32x2 q = *(const u32x2*)(Wt + (size_t)n * DM + c * 256 + lane * 4);
                    w[4 * c] = __uint_as_float(q.x << 16); w[4 * c + 1] = __uint_as_float(q.x & 0xffff0000u); w[4 * c + 2] = __uint_as_float(q.y << 16); w[4 * c + 3] = __uint_as_float(q.y & 0xffff0000u); }
                float keep = 0.f;
#pragma unroll 1
                for (int b = 0; b < 16; ++b) { float s = 0.f;
#pragma unroll
                    for (int c = 0; c < 4; ++c) { const f32x4 v = *(const LAS f32x4*)(sh + b * 1024 + c * 256 + lane * 4); s += (w[4 * c] * v[0] + w[4 * c + 1] * v[1]) + (w[4 * c + 2] * v[2] + w[4 * c + 3] * v[3]); }
                    s = wave_sum(s); if (lane == b) keep = s; }
                if (lane < 16) dst[(size_t)lane * 5632 + n] = keep;
            }
        }
        __syncthreads();
    }
    PH_NEXT;

#pragma unroll 1
    for (int f = 0; f < 4; ++f) {
        const int l = f >> 1, s = f & 1;
        if (s == 1) {
            if (PH_ON) { DEFPTRS
                pg8::Gemm g{XN, WIN + (size_t)l * NINP * DM, MTOK, NINP, DM}; pg8::StaticOrder S; S.init(MTOK, NINP, G, bx);
                pg8::EpiIn E{PROJ, FG, ROWSS + (size_t)(l * 3 + 1) * MTOK * 16, SBV + (size_t)(l * 3 + 1) * 16 * 5632};
#ifndef NO_G_IN
                pg8::gemm_phase<pg8::EpiIn, pg8::StaticOrder, true, true>(lds, g, S, E);
#endif
            }
            PH_NEXT;
            if (PH_ON) { DEFPTRS
#ifndef NO_PREP
                const int blk = gw & 7, ch = blk * 64 + lane;
                LAS float* ul = (LAS float*)(lds + wave * 8448);
                LAS float* xs = ul + 64;
                f32x2 w2[64];
#pragma unroll
                for (int i = 0; i < 64; ++i) { const size_t o = ((size_t)(l * 8 + blk) * 64 + i) * 64 + lane; w2[i] = (f32x2){w_rg[o], w_ig[o]}; }
                const float br = b_rg[l * 512 + ch], bi = b_ig[l * 512 + ch], cb = conv_b[l * 512 + ch];
                const float cw0 = conv_w[(l * 4 + 0) * 512 + ch], cw1 = conv_w[(l * 4 + 1) * 512 + ch], cw2 = conv_w[(l * 4 + 2) * 512 + ch], cw3 = conv_w[(l * 4 + 3) * 512 + ch];
                const float lmv = lam[l * 512 + ch];
                const float spl = __builtin_fmaxf(-lmv, 0.f) + log1pf(expf(-fabsf(lmv)));
                const float c8 = -8.0f * spl * LOG2E;
                for (int seg = gw >> 3; seg < MTOK / 32; seg += NGW >> 3) {
                    const int row0 = seg * 32; const bf16_t* xp = PROJ + (size_t)row0 * PPITCH + ch;
                    float xm3 = 0.f, xm2 = 0.f, xm1 = 0.f;
                    if ((row0 & (SEQL - 1)) != 0) { xm3 = bf2f(xp[-3 * PPITCH]); xm2 = bf2f(xp[-2 * PPITCH]); xm1 = bf2f(xp[-1 * PPITCH]); }
#pragma unroll
                    for (int t = 0; t < 32; ++t) xs[t * 64 + lane] = bf2f(xp[(size_t)t * PPITCH]);
                    float hs = 0.f, P = 1.f;
                    float* hl = HLOC + (size_t)row0 * 512 + ch; bf16_t* pc = PCUM + (size_t)row0 * 512 + ch;
#pragma unroll 1
                    for (int t = 0; t < 32; ++t) {
                        const float x0 = xs[t * 64 + lane];
                        const float u = cb + cw0 * xm3 + cw1 * xm2 + cw2 * xm1 + cw3 * x0; xm3 = xm2; xm2 = xm1; xm1 = x0;
                        CFENCE(); ul[lane] = u; CFENCE();
                        f32x2 acc = (f32x2){br, bi};
#pragma unroll
                        for (int i4 = 0; i4 < 16; ++i4) { const f32x4 uu = *(const LAS f32x4*)(ul + 4 * i4);
                            acc += w2[4 * i4] * uu[0]; acc += w2[4 * i4 + 1] * uu[1]; acc += w2[4 * i4 + 2] * uu[2]; acc += w2[4 * i4 + 3] * uu[3]; }
                        CFENCE();
                        const float r = sigmoidf_(acc[0]), ig = sigmoidf_(acc[1]);
                        const float la2 = c8 * r, a = __builtin_amdgcn_exp2f(la2);
                        const float xx = 2.0f * 0.6931471805599453f * la2;
                        const float om = (xx > -0.25f) ? -xx * (1.0f + xx * 0.5f * (1.0f + xx * (1.0f / 3.0f) * (1.0f + xx * 0.25f * (1.0f + xx * 0.2f)))) : 1.0f - a * a;
                        const float bt = __builtin_sqrtf(om) * ig * u;
                        hs = a * hs + bt; P *= a;
                        hl[(size_t)t * 512] = hs; pc[(size_t)t * 512] = (bf16_t)f2bf(P);
                    }
                    ASEG[(size_t)seg * 512 + ch] = P; BSEG[(size_t)seg * 512 + ch] = hs;
                }
                for (int row = gw; row < MTOK; row += NGW) {
                    const u32x2 q = *(const u32x2*)(PROJ + (size_t)row * PPITCH + 2048 + lane * 4);
                    const float a0 = __uint_as_float(q.x << 16), a1 = __uint_as_float(q.x & 0xffff0000u), a2 = __uint_as_float(q.y << 16), a3 = __uint_as_float(q.y & 0xffff0000u);
                    float ss = (a0 * a0 + a1 * a1) + (a2 * a2 + a3 * a3);
                    ss += __shfl_xor(ss, 1); ss += __shfl_xor(ss, 2); ss += __shfl_xor(ss, 4); ss += __shfl_xor(ss, 8);
                    if ((lane & 15) == 0) KS[(size_t)((row >> 12) * 4 + (lane >> 4)) * SEQL + (row & (SEQL - 1))] = __builtin_amdgcn_rsqf(ss * (1.0f / 64.0f) + EPSF);
                }
                if (wave == 0) for (int chn = vcu; chn < 64; chn += G) {
                    const int b = chn >> 2, h = chn & 3; const float bf = b_fg[l * 4 + h];
                    const float* fp = FG + ((size_t)b * SEQL + lane * 64) * 4 + h;
                    float tot = 0.f;
#pragma unroll 8
                    for (int i = 0; i < 64; ++i) { const float v = fp[i * 4] + bf; tot += __builtin_fminf(v, 0.f) - log1pf(expf(-fabsf(v))); }
                    float inc = tot;
#pragma unroll
                    for (int o = 1; o < 64; o <<= 1) { const float t_ = __shfl_up(inc, o); if (lane >= o) inc += t_; }
                    float run = inc - tot;
                    float* op = F2 + (size_t)chn * SEQL + lane * 64;
#pragma unroll 8
                    for (int i = 0; i < 64; ++i) { const float v = fp[i * 4] + bf; run += __builtin_fminf(v, 0.f) - log1pf(expf(-fabsf(v))); op[i] = run * LOG2E; }
                }
#endif
                __syncthreads();
            }
            PH_NEXT;
            if (PH_ON) { DEFPTRS
#ifndef NO_ATTN
                for (int vw = vcu; vw < 256; vw += G) {
                    const int bh = vw >> 2, s4 = vw & 3, b = bh >> 2, h = bh & 3;
#pragma unroll 1
                    for (int i = 0; i < 4; ++i) { const int qb = (i == 0) ? s4 : (i == 1) ? 7 - s4 : (i == 2) ? 8 + s4 : 15 - s4;
#ifndef NO_FOX
                        attn_unit<1>(lds, PROJ, YU, KS, F2, g_qk + l * 128, b, h, qb);
#endif
 }
#pragma unroll 1
                    for (int i = 0; i < 4; ++i) { const int qb = (i == 0) ? s4 : (i == 1) ? 7 - s4 : (i == 2) ? 8 + s4 : 15 - s4;
#ifndef NO_SB
                        attn_unit<0>(lds, PROJ, YU, KS, F2, g_qk + l * 128, b, h, qb);
#endif
 }
                }
#endif
            }
            PH_NEXT;
            if (PH_ON) { DEFPTRS
                LAS float* hin = (LAS float*)lds;
                const f32x4 gm0 = *(const f32x4*)(g_mix + l * 1024 + lane * 8), gm1 = *(const f32x4*)(g_mix + l * 1024 + lane * 8 + 4);
                const f32x4 gx0 = *(const f32x4*)(g_mix + l * 1024 + 512 + lane * 8), gx1 = *(const f32x4*)(g_mix + l * 1024 + 512 + lane * 8 + 4);
                for (int tt = vcu; tt < 256; tt += G) {
                    __syncthreads();
                    { const int ch = tid, seg0 = (tt >> 4) * 128, nb = (tt & 15) * 8; float Hc = 0.f;
#pragma unroll 8
                      for (int sg = 0; sg < nb; ++sg) Hc = ASEG[(size_t)(seg0 + sg) * 512 + ch] * Hc + BSEG[(size_t)(seg0 + sg) * 512 + ch];
#pragma unroll
                      for (int s8 = 0; s8 < 8; ++s8) { hin[s8 * 512 + ch] = Hc; Hc = ASEG[(size_t)(seg0 + nb + s8) * 512 + ch] * Hc + BSEG[(size_t)(seg0 + nb + s8) * 512 + ch]; } }
                    __syncthreads();
                    const f32x4 hi0 = *(const LAS f32x4*)(hin + wave * 512 + lane * 8), hi1 = *(const LAS f32x4*)(hin + wave * 512 + lane * 8 + 4);
#pragma unroll 2
                    for (int t = 0; t < 32; ++t) {
                        const size_t row = (size_t)tt * 256 + wave * 32 + t;
                        const f32x4 h0 = *(const f32x4*)(HLOC + row * 512 + lane * 8), h1 = *(const f32x4*)(HLOC + row * 512 + lane * 8 + 4);
                        const u32x4 pq = *(const u32x4*)(PCUM + row * 512 + lane * 8);
                        const u32x4 gq = *(const u32x4*)(PROJ + row * PPITCH + 512 + lane * 8);
                        const u32x4 yq = *(const u32x4*)(YU + row * 512 + lane * 8);
                        float y[8], yu[8]; float ss = 0.f, s2 = 0.f;
#pragma unroll
                        for (int i = 0; i < 8; ++i) {
                            const unsigned pw = pq[i >> 1], gw_ = gq[i >> 1], yw = yq[i >> 1];
                            const float p = (i & 1) ? __uint_as_float(pw & 0xffff0000u) : __uint_as_float(pw << 16);
                            const float gg = (i & 1) ? __uint_as_float(gw_ & 0xffff0000u) : __uint_as_float(gw_ << 16);
                            yu[i] = (i & 1) ? __uint_as_float(yw & 0xffff0000u) : __uint_as_float(yw << 16);
                            const float hh = (i < 4 ? h0[i & 3] : h1[i & 3]) + p * (i < 4 ? hi0[i & 3] : hi1[i & 3]);
                            const float inner = 0.7978845608028654f * (gg + 0.044715f * gg * gg * gg);
                            const float ge = gg * __builtin_amdgcn_rcpf(1.0f + __builtin_amdgcn_exp2f(-2.0f * LOG2E * inner));
                            y[i] = hh * ge; ss += y[i] * y[i]; s2 += yu[i] * yu[i];
                        }
                        ss = wave_sum(ss);
                        s2 += __shfl_xor(s2, 1); s2 += __shfl_xor(s2, 2); s2 += __shfl_xor(s2, 4); s2 += __shfl_xor(s2, 8); s2 += __shfl_xor(s2, 16);
                        const float rl = __builtin_amdgcn_rsqf(ss * (1.0f / 512.0f) + EPSF), rx = __builtin_amdgcn_rsqf(s2 * (1.0f / 256.0f) + EPSF);
                        u32x4 o1, o2;
                        o1.x = pk2(y[0] * rl * gm0[0], y[1] * rl * gm0[1]); o1.y = pk2(y[2] * rl * gm0[2], y[3] * rl * gm0[3]);
                        o1.z = pk2(y[4] * rl * gm1[0], y[5] * rl * gm1[1]); o1.w = pk2(y[6] * rl * gm1[2], y[7] * rl * gm1[3]);
                        o2.x = pk2(yu[0] * rx * gx0[0], yu[1] * rx * gx0[1]); o2.y = pk2(yu[2] * rx * gx0[2], yu[3] * rx * gx0[3]);
                        o2.z = pk2(yu[4] * rx * gx1[0], yu[5] * rx * gx1[1]); o2.w = pk2(yu[6] * rx * gx1[2], yu[7] * rx * gx1[3]);
                        *(u32x4*)(YN + row * 1024 + lane * 8) = o1; *(u32x4*)(YN + row * 1024 + 512 + lane * 8) = o2;
                    }
                }
                __syncthreads();
            }
            PH_NEXT;
            if (PH_ON) { DEFPTRS
                pg8::Gemm g{YN, WOUT + (size_t)l * DM * DM, MTOK, DM, DM}; pg8::StaticOrder S; S.init(MTOK, DM, G, bx);
                pg8::EpiRes E{xout, xout, GATE + (size_t)(l * 3 + 1) * 16 * 1024, GMOD + (size_t)(l * 3 + 2) * 16 * 1024, XN, ROWSS + (size_t)(l * 3 + 2) * MTOK * 16, 1};
#ifndef NO_G_OUT
                pg8::gemm_phase<pg8::EpiRes, pg8::StaticOrder, true, true>(lds, g, S, E);
#endif
            }
            PH_NEXT;
        }
        const int j = s ? 2 : 0;
        if (PH_ON) { DEFPTRS
            pg8::Gemm g{XN, WUP + (size_t)(l * 2 + s) * NUP * DM, MTOK, NUP, DM}; pg8::StaticOrder S; S.init(MTOK, NUP, G, bx);
            pg8::EpiUp E{HB, ROWSS + (size_t)(l * 3 + j) * MTOK * 16, SBV + (size_t)(l * 3 + j) * 16 * 5632};
#ifndef NO_G_UP
            pg8::gemm_phase<pg8::EpiUp, pg8::StaticOrder, true, true>(lds, g, S, E);
#endif
        }
        PH_NEXT;
        if (PH_ON) { DEFPTRS
            const int nl = s ? l + 1 : l, nj = s ? 0 : 1; const int has_next = (nl < 2) ? 1 : 0; const int nidx = has_next ? nl * 3 + nj : 0;
            pg8::Gemm g{HB, WDN + (size_t)(l * 2 + s) * DM * DFF, MTOK, DM, DFF}; pg8::StaticOrder S; S.init(MTOK, DM, G, bx);
            pg8::EpiRes E{f == 0 ? x_in : xout, xout, GATE + (size_t)(l * 3 + j) * 16 * 1024, GMOD + (size_t)nidx * 16 * 1024, XN, ROWSS + (size_t)nidx * MTOK * 16, has_next};
#ifndef NO_G_DN
            pg8::gemm_phase<pg8::EpiRes, pg8::StaticOrder, true, true>(lds, g, S, E);
#endif
        }
        PH_NEXT;
    }
#undef PH_ON
#undef PH_NEXT
}


#ifdef DBG_STOP
__global__ void dbg_dump(const unsigned char* ws, float* out, int mode) {
    const size_t n = (size_t)MTOK * DM; const size_t i0 = (size_t)blockIdx.x * blockDim.x + threadIdx.x, st = (size_t)gridDim.x * blockDim.x;
    const bf16_t* XN = (const bf16_t*)(ws + WS_XN); const bf16_t* HB = (const bf16_t*)(ws + WS_H); const bf16_t* PR = (const bf16_t*)(ws + WS_PROJ);
    const bf16_t* YU = (const bf16_t*)(ws + WS_YU); const float* HL = (const float*)(ws + WS_HLOC); const bf16_t* YN = (const bf16_t*)(ws + WS_YN); const bf16_t* PC = (const bf16_t*)(ws + WS_PCUM);
    for (size_t i = i0; i < n; i += st) {
        float v = 0.f;
        if (mode == 0) v = bf2f(XN[i]);
        else if (mode == 1) v = bf2f(HB[i]) + bf2f(HB[i + n]) + bf2f(HB[i + (size_t)117440512]);
        else if (mode == 2) v = bf2f(PR[i]) + bf2f(PR[i + n]) + bf2f(PR[i + (size_t)100663296]);
        else if (mode == 3) v = (i < n / 2) ? bf2f(YU[i]) : HL[i - n / 2];
        else if (mode == 4) v = bf2f(YN[i]);
        else if (mode == 6) v = (i < n / 2) ? bf2f(PC[i]) : ((const float*)(ws + WS_KS))[(i - n / 2) % (3 * 262144)];
        else if (mode == 7) v = HL[i % (n / 2)] + bf2f(PC[i % (n / 2)]) + ((const float*)(ws + WS_KS))[i % (3 * 262144)] + ((const float*)(ws + WS_ASEG))[i % (2 * 1048576)];
        if (mode == 3) { const bool nan_ = !(v == v), big = (v > 3e38f) || (v < -3e38f); float code = 0.f;
            if (i < n / 2) { const int col = (int)(i & 511); if (col < 256) code = nan_ ? 2000.f : (big ? 1000.f : 0.f); else code = (nan_ || big) ? 4000.f : 0.f; }
            else code = (nan_ || big) ? 8000.f : 0.f;
            v = code; }
        if (!(v == v)) v = 77777.f; if (v > 3e38f) v = 88888.f; if (v < -3e38f) v = 99999.f;
        if (mode != 5) out[i] = v;
    }
}
#endif
#ifndef MK_N_LAUNCHES
#define MK_N_LAUNCHES 1
#endif
constexpr int N_PHASES = 3 + 2 * 9;
extern "C" void kernel_launch(void* const* d_in, const int* in_sizes, int n_in, void* d_out, int out_size, void* d_ws, size_t ws_size, hipStream_t stream) {
    static int grid = 0;
    if (grid == 0) {
        if (n_in != 19 || out_size != MTOK * DM || ws_size < WS_END) { fprintf(stderr, "kernel_launch: unexpected shapes (n_in %d, out %d, ws %zu)\n", n_in, out_size, ws_size); grid = -1; return; }
        int dev = 0, cus = 0, per_cu = 0;
        hipGetDevice(&dev); hipDeviceGetAttribute(&cus, hipDeviceAttributeMultiprocessorCount, dev);
        if (hipFuncSetAttribute((const void*)mk_fwd, hipFuncAttributeMaxDynamicSharedMemorySize, LDS_BYTES) != hipSuccess) { fprintf(stderr, "kernel_launch: hipFuncSetAttribute failed\n"); grid = -1; return; }
        if (hipOccupancyMaxActiveBlocksPerMultiprocessor(&per_cu, (const void*)mk_fwd, 512, LDS_BYTES) != hipSuccess || per_cu < 1) { fprintf(stderr, "kernel_launch: occupancy query says %d\n", per_cu); per_cu = 1; }
        (void)hipGetLastError();
        grid = cus * 1;
    }
    if (grid < 0) return;
    Args a{};
    for (int i = 0; i < 19; ++i) a.in[i] = (const float*)d_in[i];
    a.out = (float*)d_out; a.ws = (unsigned char*)d_ws;
#if MK_N_LAUNCHES == 1
    a.ph_lo = 0; a.ph_hi = N_PHASES;
    void* kargs[] = {&a};
    hipError_t e = hipLaunchCooperativeKernel((const void*)mk_fwd, dim3(grid), dim3(512), kargs, LDS_BYTES, stream);
    if (e != hipSuccess) fprintf(stderr, "kernel_launch: cooperative launch failed: %s (grid %d)\n", hipGetErrorString(e), grid);
#else
#ifdef DBG_STOP
    for (int p = 0; p < DBG_STOP; ++p) { a.ph_lo = p; a.ph_hi = p + 1; hipLaunchKernelGGL(mk_fwd, dim3(grid), dim3(512), LDS_BYTES, stream, a); }
    hipLaunchKernelGGL(dbg_dump, dim3(2048), dim3(256), 0, stream, (const unsigned char*)d_ws, (float*)d_out, DBG_MODE);
#else
    for (int p = 0; p < N_PHASES; ++p) { a.ph_lo = p; a.ph_hi = p + 1; hipLaunchKernelGGL(mk_fwd, dim3(grid), dim3(512), LDS_BYTES, stream, a); }
#endif
#endif
}
```

```cpp
#include <hip/hip_runtime.h>
#include <hip/hip_cooperative_groups.h>
#include <cstdio>
#include <cstdint>
namespace cg = cooperative_groups;
namespace pg8 {
#define PG8_LAS __attribute__((address_space(3)))
typedef unsigned short bf16_t;
typedef short bf16x8 __attribute__((ext_vector_type(8)));
typedef float f32x4 __attribute__((ext_vector_type(4)));
typedef unsigned u32x4 __attribute__((ext_vector_type(4)));
constexpr int BM = 256, BK = 64, HALF = 128, HTB = HALF * BK * 2  , STAGE_BYTES = 8 * HTB, NXCD = 8, WGM = 8;

__host__ __device__ __forceinline__ int lds_byte(int r, int c) { const int st = (r >> 4) * 2 + (c >> 5), rr = r & 15, cc = c & 31, ob = rr * 64 + cc * 2; return st * 1024 + (ob ^ (((ob >> 9) & 1) << 5)); }
__host__ __device__ __forceinline__ void stage_rc(int b, int& R, int& C) { const int st = b / 1024, sb = b % 1024, swz = sb ^ (((sb >> 9) & 1) << 5); R = (st >> 1) * 16 + swz / 64; C = (st & 1) * 32 + (swz % 64) / 2; }
__host__ __device__ __forceinline__ int perm32(int rho) { const int n = rho >> 4, i = rho & 15; return 8 * (i >> 2) + 4 * n + (i & 3); }

struct Unit { int pm, pn; };
struct Gemm { const bf16_t* A; const bf16_t* Bt; int M, N, K; };

struct StaticOrder {
    int nM, nN, nwg, G, c;
    __host__ __device__ void init(int M, int N, int G_, int c_) { nM = M / BM; nN = N / BM; nwg = nM * nN; G = G_; c = c_; }
    __host__ __device__ bool next(int i, Unit& u) const {
        const long L = (long)i * G + c; if (L >= nwg) return false;
        int wgid = (int)L; { const int q = nwg / NXCD, r = nwg % NXCD, xcd = wgid % NXCD, off = wgid / NXCD; wgid = (xcd < r ? xcd * (q + 1) : r * (q + 1) + (xcd - r) * q) + off; }
        const int nig = WGM * nN, gid = wgid / nig, fm = gid * WGM, gsz = (nM - fm) < WGM ? (nM - fm) : WGM;
        u.pm = fm + ((wgid % nig) % gsz); u.pn = (wgid % nig) / gsz; return true;
    }
    __device__ __forceinline__ void a_ready(const Unit&) const {}
    __device__ __forceinline__ void done(const Unit&) const {}
};

typedef float f32x2c_t __attribute__((ext_vector_type(2))); typedef __bf16 bf16x2c_t __attribute__((ext_vector_type(2)));
__device__ __forceinline__ unsigned cvt_pk_bf16(float lo, float hi) { f32x2c_t v = {lo, hi}; bf16x2c_t b = __builtin_convertvector(v, bf16x2c_t); return __builtin_bit_cast(unsigned, b); }
typedef float f32x2 __attribute__((ext_vector_type(2)));
constexpr float RMS_EPS = 1e-6f;
__device__ __forceinline__ float row_rstd(const float* rowss, int row) {
    const f32x4* p = (const f32x4*)(rowss + (size_t)row * 16); const f32x4 a = p[0], b = p[1], c = p[2], d = p[3];
    const float s = ((a[0] + a[1]) + (a[2] + a[3])) + ((b[0] + b[1]) + (b[2] + b[3])) + ((c[0] + c[1]) + (c[2] + c[3])) + ((d[0] + d[1]) + (d[2] + d[3]));
    return __builtin_amdgcn_rsqf(s * (1.0f / 1024.0f) + RMS_EPS);
}
struct EpiUp {
    static constexpr bool PERM = true, AFTER_DRAIN = false;
    bf16_t* H; const float* rowss; const float* sb;
    __device__ __forceinline__ void operator()(const f32x4 (&acc)[2][2][4][2], const Unit& u, int wr, int wc, int fr, int fq) const {
        const int row0 = u.pm * BM + wr * 64 + fr, b = u.pm >> 4, cl = wc * 32 + 8 * fq;
        const float* sbp = sb + (size_t)b * 5632 + u.pn * 256 + cl;
#pragma unroll
        for (int ai = 0; ai < 2; ++ai)
#pragma unroll
            for (int m = 0; m < 4; ++m) {
                const int row = row0 + ai * HALF + m * 16;
                const float rs = row_rstd(rowss, row);
                float hv[8];
#pragma unroll
                for (int n = 0; n < 2; ++n) { const f32x4 sgn = *(const f32x4*)(sbp + 4 * n), sun = *(const f32x4*)(sbp + 128 + 4 * n);
#pragma unroll
                    for (int i = 0; i < 4; ++i) {
                        const float g = rs * acc[ai][0][m][n][i] + sgn[i], uu = rs * acc[ai][1][m][n][i] + sun[i];
                        hv[n * 4 + i] = g * __builtin_amdgcn_rcpf(1.0f + __builtin_amdgcn_exp2f(-1.4426950408889634f * g)) * uu;
                    } }
                asm volatile("" ::: "memory");
                u32x4 w; w.x = cvt_pk_bf16(hv[0], hv[1]); w.y = cvt_pk_bf16(hv[2], hv[3]); w.z = cvt_pk_bf16(hv[4], hv[5]); w.w = cvt_pk_bf16(hv[6], hv[7]);
                *(u32x4*)(H + (size_t)row * 2816 + u.pn * 128 + cl) = w;
            }
    }
};
struct EpiIn {
    static constexpr bool PERM = true, AFTER_DRAIN = false;
    bf16_t* P; float* FG; const float* rowss; const float* sb;
    __device__ __forceinline__ void operator()(const f32x4 (&acc)[2][2][4][2], const Unit& u, int wr, int wc, int fr, int fq) const {
        const int row0 = u.pm * BM + wr * 64 + fr, b = u.pm >> 4, cl = wc * 32 + 8 * fq;
        const float* sbp = sb + (size_t)b * 5632 + u.pn * 256 + cl;
#pragma unroll
        for (int ai = 0; ai < 2; ++ai)
#pragma unroll
            for (int m = 0; m < 4; ++m) {
                const int row = row0 + ai * HALF + m * 16;
                const float rs = row_rstd(rowss, row);
                if (u.pn < 10) {
#pragma unroll
                    for (int bj = 0; bj < 2; ++bj) {
                        const f32x4 v0 = acc[ai][bj][m][0] * rs + *(const f32x4*)(sbp + bj * HALF), v1 = acc[ai][bj][m][1] * rs + *(const f32x4*)(sbp + bj * HALF + 4);
                        u32x4 w; w.x = cvt_pk_bf16(v0[0], v0[1]); w.y = cvt_pk_bf16(v0[2], v0[3]); w.z = cvt_pk_bf16(v1[0], v1[1]); w.w = cvt_pk_bf16(v1[2], v1[3]);
                        *(u32x4*)(P + (size_t)row * 2560 + u.pn * 256 + bj * HALF + cl) = w;
                    }
                } else if (wc == 0 && fq == 0) {
                    *(f32x4*)(FG + (size_t)row * 4) = acc[ai][0][m][0] * rs + *(const f32x4*)(sbp);
                }
            }
    }
};
struct EpiRes {
    static constexpr bool PERM = false, AFTER_DRAIN = false;
    const float* xin; float* xout; const float* gate; const float* gmn; bf16_t* XN; float* rowssn; int has_next;
    __device__ __forceinline__ void operator()(const f32x4 (&acc)[2][2][4][2], const Unit& u, int wr, int wc, int fr, int fq) const {
        typedef unsigned u32x2v __attribute__((ext_vector_type(2)));
        const int row0 = u.pm * BM + wr * 64 + fr, b = u.pm >> 4, col0 = u.pn * BM + wc * 32 + 4 * fq;
        const float* gp_ = gate + b * 1024 + col0; const float* gm_ = gmn + b * 1024 + col0;
#pragma unroll
        for (int ai = 0; ai < 2; ++ai)
#pragma unroll
            for (int m = 0; m < 4; ++m) {
                const int row = row0 + ai * HALF + m * 16; const size_t off = (size_t)row * 1024 + col0;
                float ss = 0.f;
#pragma unroll
                for (int bj = 0; bj < 2; ++bj)
#pragma unroll
                    for (int n = 0; n < 2; ++n) {
                        const f32x4 xi = *(const f32x4*)(xin + off + bj * HALF + n * 16);
                        const f32x4 xo = xi + *(const f32x4*)(gp_ + bj * HALF + n * 16) * acc[ai][bj][m][n];
                        *(f32x4*)(xout + off + bj * HALF + n * 16) = xo;
                        if (has_next) {
                            ss += (xo[0] * xo[0] + xo[1] * xo[1]) + (xo[2] * xo[2] + xo[3] * xo[3]);
                            const f32x4 a = xo * *(const f32x4*)(gm_ + bj * HALF + n * 16); u32x2v w; w.x = cvt_pk_bf16(a[0], a[1]); w.y = cvt_pk_bf16(a[2], a[3]);
                            *(u32x2v*)(XN + off + bj * HALF + n * 16) = w;
                        }
                    }
                if (has_next) { ss += __shfl_xor(ss, 16); ss += __shfl_xor(ss, 32); if (fq == 0) rowssn[(size_t)row * 16 + u.pn * 4 + wc] = ss; }
                asm volatile("" ::: "memory");
            }
    }
};

template <class Epi, class Sched, bool ALIGN_EPI = false, bool SP2 = false>
__device__ __forceinline__ void gemm_phase(PG8_LAS unsigned char* lds, const Gemm g, const Sched& S, const Epi& E) {
    int tid_o = threadIdx.x; asm volatile("" : "+v"(tid_o)); const int tid = tid_o, wid = __builtin_amdgcn_readfirstlane(tid >> 6), lane = tid & 63, wr = wid >> 2, wc = wid & 3, fr = lane & 15, fq = lane >> 4;
    const int K = g.K, nt = K / BK;
    unsigned voffA[2], voffB[2];
#pragma unroll
    for (int i = 0; i < 2; ++i) { int R, C; stage_rc(tid * 16 + i * 8192, R, C); const int Rb = Epi::PERM ? ((R & ~31) + perm32(R & 31)) : R;
        voffA[i] = (unsigned)(R * K + C) * 2u; voffB[i] = (unsigned)(Rb * K + C) * 2u; }
    const size_t kstep = (size_t)(BK * 2);
    const size_t hstep = (size_t)HALF * K * 2;
    const size_t tstep = 2 * hstep;
    const unsigned ldsw = (unsigned)wid * 1024u;
    const int aoff = lds_byte(wr * 64 + fr, fq * 8), boff = lds_byte(wc * 32 + fr, fq * 8);
#define PG8_SA(b, h) (((b) * 2 + (h)) * HTB)
#define PG8_SB(b, h) ((4 + (b) * 2 + (h)) * HTB)
#define PG8_STAGE(bufoff, gbase, voff) do { _Pragma("unroll") for (int _i = 0; _i < 2; ++_i) \
        __builtin_amdgcn_global_load_lds((const unsigned*)((const char*)(gbase) + (voff)[_i]), (PG8_LAS unsigned*)(lds + (bufoff) + ldsw + _i * 8192), 16, 0, 0); } while (0)
#define PG8_LDA(dst, b, h) do { _Pragma("unroll") for (int m = 0; m < 4; ++m) _Pragma("unroll") for (int k = 0; k < 2; ++k) dst[m][k] = *(const PG8_LAS bf16x8*)(lds + PG8_SA(b, h) + aoff + m * 2048 + k * 1024); } while (0)
#define PG8_LDB(dst, b, h) do { _Pragma("unroll") for (int n = 0; n < 2; ++n) _Pragma("unroll") for (int k = 0; k < 2; ++k) dst[n][k] = *(const PG8_LAS bf16x8*)(lds + PG8_SB(b, h) + boff + n * 2048 + k * 1024); } while (0)
#define PG8_MMA(ai, bj, At, Bt) do { __builtin_amdgcn_s_setprio(1); _Pragma("unroll") for (int m = 0; m < 4; ++m) _Pragma("unroll") for (int n = 0; n < 2; ++n) _Pragma("unroll") for (int k = 0; k < 2; ++k) \
        acc[ai][bj][m][n] = __builtin_amdgcn_mfma_f32_16x16x32_bf16(Bt[n][k], At[m][k], acc[ai][bj][m][n], 0, 0, 0); __builtin_amdgcn_s_setprio(0); } while (0)
#define PG8_WAIT_V(n) asm volatile("s_waitcnt vmcnt(" #n ")" ::: "memory")
#define PG8_WAIT_L(n) asm volatile("s_waitcnt lgkmcnt(" #n ")" ::: "memory")
#define PG8_BAR __builtin_amdgcn_s_barrier()
#define PG8_SCHED __builtin_amdgcn_sched_barrier(0)
    Unit cur, nxt; int ui = 0;
    if (!S.next(0, cur)) return;
    f32x4 acc[2][2][4][2];
#pragma unroll
    for (int a = 0; a < 2; ++a)
#pragma unroll
        for (int b = 0; b < 2; ++b)
#pragma unroll
            for (int m = 0; m < 4; ++m)
#pragma unroll
                for (int n = 0; n < 2; ++n) acc[a][b][m][n] = (f32x4){0.f, 0.f, 0.f, 0.f};
    bf16x8 At[4][2], B0[2][2], B1[2][2];
    const char* cA = (const char*)g.A + (size_t)cur.pm * tstep; const char* cB = (const char*)g.Bt + (size_t)cur.pn * tstep;
    S.a_ready(cur);
    if constexpr (SP2) {
        PG8_STAGE(PG8_SB(0, 0), cB, voffB); PG8_STAGE(PG8_SB(0, 1), cB + hstep, voffB); PG8_STAGE(PG8_SA(0, 0), cA, voffA); PG8_STAGE(PG8_SA(0, 1), cA + hstep, voffA);
        if (wr == 1) PG8_BAR;
        PG8_WAIT_V(2); PG8_BAR;
        PG8_STAGE(PG8_SB(1, 0), cB + kstep, voffB); PG8_STAGE(PG8_SA(1, 0), cA + kstep, voffA); PG8_STAGE(PG8_SB(1, 1), cB + hstep + kstep, voffB);
        PG8_WAIT_V(6); PG8_BAR;
    } else {
        PG8_STAGE(PG8_SB(0, 0), cB, voffB); PG8_STAGE(PG8_SA(0, 0), cA, voffA); PG8_STAGE(PG8_SB(0, 1), cB + hstep, voffB); PG8_STAGE(PG8_SA(0, 1), cA + hstep, voffA);
        if (wr == 1) PG8_BAR;
        PG8_WAIT_V(4); PG8_BAR;
        PG8_STAGE(PG8_SB(1, 0), cB + kstep, voffB); PG8_STAGE(PG8_SA(1, 0), cA + kstep, voffA); PG8_STAGE(PG8_SB(1, 1), cB + hstep + kstep, voffB);
        PG8_WAIT_V(6); PG8_BAR;
    }
    for (;;) {
        const bool has_next = S.next(ui + 1, nxt);
        const char* nA = has_next ? (const char*)g.A + (size_t)nxt.pm * tstep : cA; const char* nB = has_next ? (const char*)g.Bt + (size_t)nxt.pn * tstep : cB;
        for (int t = 0; t < nt; t += 2) {
            const bool last = (t == nt - 2);
            const char* a1 = cA + (size_t)(t + 1) * kstep;
            const char* a2 = last ? nA : cA + (size_t)(t + 2) * kstep; const char* b2 = last ? nB : cB + (size_t)(t + 2) * kstep;
            const char* a3 = a2 + kstep; const char* b3 = b2 + kstep;
            if (last && has_next) S.a_ready(nxt);
            if constexpr (SP2) {
            PG8_LDB(B0, 0, 0); PG8_LDB(B1, 0, 1); PG8_SCHED; PG8_LDA(At, 0, 0); PG8_STAGE(PG8_SA(1, 1), a1 + hstep, voffA);
            PG8_WAIT_V(8); PG8_WAIT_L(0); PG8_BAR; PG8_MMA(0, 0, At, B0); PG8_MMA(0, 1, At, B1); PG8_BAR; PG8_SCHED;
            PG8_LDA(At, 0, 1); PG8_STAGE(PG8_SB(0, 0), b2, voffB); PG8_STAGE(PG8_SB(0, 1), b2 + hstep, voffB); PG8_STAGE(PG8_SA(0, 0), a2, voffA);
            PG8_WAIT_V(8); PG8_WAIT_L(0); PG8_BAR; PG8_MMA(1, 0, At, B0); PG8_MMA(1, 1, At, B1); PG8_BAR; PG8_SCHED;
            PG8_LDB(B0, 1, 0); PG8_LDB(B1, 1, 1); PG8_SCHED; PG8_LDA(At, 1, 0); PG8_STAGE(PG8_SA(0, 1), a2 + hstep, voffA);
            PG8_WAIT_V(8); PG8_WAIT_L(0); PG8_BAR; PG8_MMA(0, 0, At, B0); PG8_MMA(0, 1, At, B1); PG8_BAR; PG8_SCHED;
            PG8_LDA(At, 1, 1); PG8_STAGE(PG8_SB(1, 0), b3, voffB); PG8_STAGE(PG8_SB(1, 1), b3 + hstep, voffB); PG8_STAGE(PG8_SA(1, 0), a3, voffA);
            PG8_WAIT_V(8); PG8_WAIT_L(0); PG8_BAR; PG8_MMA(1, 0, At, B0); PG8_MMA(1, 1, At, B1); PG8_BAR; PG8_SCHED;
            } else {
            PG8_LDB(B0, 0, 0); PG8_SCHED; PG8_LDA(At, 0, 0); PG8_STAGE(PG8_SA(1, 1), a1 + hstep, voffA);
            PG8_WAIT_L(8); PG8_BAR; PG8_WAIT_L(0); PG8_MMA(0, 0, At, B0); PG8_BAR; PG8_SCHED;
            PG8_LDB(B1, 0, 1); PG8_STAGE(PG8_SB(0, 0), b2, voffB);
            PG8_BAR; PG8_WAIT_L(0); PG8_MMA(0, 1, At, B1); PG8_BAR;
            PG8_LDA(At, 0, 1); PG8_STAGE(PG8_SA(0, 0), a2, voffA);
            PG8_BAR; PG8_WAIT_L(0); PG8_MMA(1, 0, At, B0); PG8_BAR; PG8_SCHED;
            PG8_STAGE(PG8_SB(0, 1), b2 + hstep, voffB);
            PG8_WAIT_V(6); PG8_BAR; PG8_MMA(1, 1, At, B1); PG8_BAR;
            PG8_LDB(B0, 1, 0); PG8_SCHED; PG8_LDA(At, 1, 0); PG8_STAGE(PG8_SA(0, 1), a2 + hstep, voffA);
            PG8_WAIT_L(8); PG8_BAR; PG8_WAIT_L(0); PG8_MMA(0, 0, At, B0); PG8_BAR; PG8_SCHED;
            PG8_LDB(B1, 1, 1); PG8_STAGE(PG8_SB(1, 0), b3, voffB);
            PG8_BAR; PG8_WAIT_L(0); PG8_MMA(0, 1, At, B1); PG8_BAR;
            PG8_LDA(At, 1, 1); PG8_STAGE(PG8_SA(1, 0), a3, voffA);
            PG8_BAR; PG8_WAIT_L(0); PG8_MMA(1, 0, At, B0); PG8_BAR; PG8_SCHED;
            PG8_STAGE(PG8_SB(1, 1), b3 + hstep, voffB);
            PG8_WAIT_V(6); PG8_BAR; PG8_MMA(1, 1, At, B1); PG8_BAR;
            }
        }
        if constexpr (ALIGN_EPI) { if (wr == 0) PG8_BAR; }
        if constexpr (!Epi::AFTER_DRAIN) { E(acc, cur, wr, wc, fr, fq); S.done(cur); }
        if (!has_next) break;
#pragma unroll
        for (int a = 0; a < 2; ++a)
#pragma unroll
            for (int b = 0; b < 2; ++b)
#pragma unroll
                for (int m = 0; m < 4; ++m)
#pragma unroll
                    for (int n = 0; n < 2; ++n) acc[a][b][m][n] = (f32x4){0.f, 0.f, 0.f, 0.f};
        cur = nxt; cA = nA; cB = nB; ++ui;
        if constexpr (ALIGN_EPI) { if (wr == 1) PG8_BAR; }
    }
    PG8_WAIT_V(0);
    if constexpr (!ALIGN_EPI) { if (wr == 0) PG8_BAR; }
    PG8_BAR;
    if constexpr (Epi::AFTER_DRAIN) { E.fused(acc, cur, wr, wc, fr, fq, lds, wid, lane); S.done(cur); }
#undef PG8_SA
#undef PG8_SB
#undef PG8_STAGE
#undef PG8_LDA
#undef PG8_LDB
#undef PG8_MMA
#undef PG8_WAIT_V
#undef PG8_WAIT_L
#undef PG8_BAR
#undef PG8_SCHED
}
}

#define LAS __attribute__((address_space(3)))
typedef unsigned short bf16_t;
typedef short bf16x8 __attribute__((ext_vector_type(8)));
typedef short s16x4 __attribute__((ext_vector_type(4)));
typedef float f32x4 __attribute__((ext_vector_type(4)));
typedef float f32x2 __attribute__((ext_vector_type(2)));
typedef float f32x16 __attribute__((ext_vector_type(16)));
typedef unsigned u32x4 __attribute__((ext_vector_type(4)));
typedef unsigned u32x2 __attribute__((ext_vector_type(2)));

constexpr int MTOK = 65536, DM = 1024, DFF = 2816, NUP = 5632, NINP = 2816, PPITCH = 2560, SEQL = 4096;
constexpr float EPSF = 1e-6f, LOG2E = 1.4426950408889634f;
constexpr size_t MiB = 1u << 20;
constexpr size_t WS_MOD = 1 * MiB, WS_GMOD = 3 * MiB, WS_GATE = 4 * MiB, WS_SB = 5 * MiB, WS_ROWSS = 976 * MiB, WS_KS = 10 * MiB, WS_F2 = 11 * MiB, WS_FG = 12 * MiB,
                 WS_ASEG = 13 * MiB, WS_BSEG = 17 * MiB, WS_WUP = 24 * MiB, WS_WDN = 68 * MiB, WS_WIN = 90 * MiB, WS_WOUT = 101 * MiB, WS_XN = 112 * MiB,
                 WS_H = 240 * MiB, WS_PROJ = 240 * MiB, WS_YU = 592 * MiB, WS_HLOC = 656 * MiB, WS_PCUM = 784 * MiB, WS_YN = 848 * MiB, WS_END = 1000 * MiB;
constexpr int LDS_BYTES = 147456;

__device__ __forceinline__ float bf2f(unsigned short v) { return __uint_as_float((unsigned)v << 16); }
__device__ __forceinline__ unsigned f2bf(float f) { unsigned u = __float_as_uint(f); return (u + 0x7fffu + ((u >> 16) & 1u)) >> 16; }
__device__ __forceinline__ unsigned pk2(float lo, float hi) { return pg8::cvt_pk_bf16(lo, hi); }
__device__ __forceinline__ float wave_sum(float v) {
#pragma unroll
    for (int o = 1; o < 64; o <<= 1) v += __shfl_xor(v, o);
    return v;
}
__device__ __forceinline__ float sigmoidf_(float x) { return __builtin_amdgcn_rcpf(1.0f + __builtin_amdgcn_exp2f(-LOG2E * x)); }
#define WAITV(n) asm volatile("s_waitcnt vmcnt(" #n ")" ::: "memory")
#define LBAR() asm volatile("s_waitcnt lgkmcnt(0)\n\ts_barrier" ::: "memory")
#define CFENCE() asm volatile("" ::: "memory")

#ifndef REP_PREP
#define REP_PREP 1
#endif
#ifndef REP_ATTN
#define REP_ATTN 1
#endif
#ifndef REP_UP
#define REP_UP 1
#endif
struct Args { const float* in[19]; float* out; unsigned char* ws; int ph_lo, ph_hi; };

__device__ __forceinline__ void transpose_item(const float* __restrict__ W, int ldw, int clim, int K, bf16_t* __restrict__ WT, int n0, int c0, int k0, LAS float* scr, int lane) {
    const int col = c0 + (lane & 31);
#pragma unroll 8
    for (int i = 0; i < 32; ++i) { const int kk = 2 * i + (lane >> 5); scr[kk * 33 + (lane & 31)] = (col < clim) ? W[(size_t)(k0 + kk) * ldw + col] : 0.f; }
    asm volatile("s_waitcnt lgkmcnt(0)" ::: "memory");
    const int c = lane & 7;
#pragma unroll
    for (int j = 0; j < 4; ++j) { const int n = (lane >> 3) + 8 * j; const LAS float* s = scr + (8 * c) * 33 + n;
        u32x4 o; o.x = pk2(s[0 * 33], s[1 * 33]); o.y = pk2(s[2 * 33], s[3 * 33]); o.z = pk2(s[4 * 33], s[5 * 33]); o.w = pk2(s[6 * 33], s[7 * 33]);
        *(u32x4*)(WT + (size_t)(n0 + n) * K + k0 + 8 * c) = o; }
    asm volatile("s_waitcnt lgkmcnt(0)" ::: "memory");
}

__device__ __forceinline__ int crow(int r, int hi) { return (r & 3) + 8 * (r >> 2) + 4 * hi; }
__device__ __forceinline__ s16x4 vtr(const LAS unsigned char* p) {
    typedef short v4i16_t __attribute__((ext_vector_type(4)));
    return __builtin_bit_cast(s16x4, __builtin_amdgcn_ds_read_tr16_b64_v4i16((LAS v4i16_t*)p));
}
constexpr int AT_SLOT = 16384, AT_AUX = 3 * AT_SLOT, AT_WSF = AT_AUX + 3 * 512, AT_VOTE = AT_WSF + 8 * 256;
constexpr float C2 = 0.125f * LOG2E;

__device__ __forceinline__ void sb_block(f32x16& X, float& carry, bool band, int kv0  , int qrel, int hi) {
    float lm[16];
#pragma unroll
    for (int r = 0; r < 16; ++r) {
        float z2 = X[r] * C2; z2 = __builtin_fminf(__builtin_fmaxf(z2, -120.f), 120.f);
        const float e = __builtin_amdgcn_exp2f(-z2), sp = __builtin_amdgcn_logf(1.0f + e);
        float l1 = -(sp + z2), lb = -sp;
        if (band) { const int kv = kv0 + (r & 3) + 8 * (r >> 2); const bool valid = kv < qrel; l1 = valid ? l1 : 0.f; lb = valid ? lb : -INFINITY; }
        lm[r] = l1; X[r] = lb;
    }
    float G[4], Gp[4], T[4];
#pragma unroll
    for (int g = 0; g < 4; ++g) { G[g] = (lm[4 * g] + lm[4 * g + 1]) + (lm[4 * g + 2] + lm[4 * g + 3]); Gp[g] = __shfl_xor(G[g], 32); T[g] = G[g] + Gp[g]; }
    float S = carry;
#pragma unroll
    for (int g = 3; g >= 0; --g) {
        const float a3 = S + (hi == 0 ? Gp[g] : 0.f), a2 = a3 + lm[4 * g + 3], a1 = a2 + lm[4 * g + 2], a0 = a1 + lm[4 * g + 1];
        X[4 * g + 3] = __builtin_amdgcn_exp2f(X[4 * g + 3] + a3); X[4 * g + 2] = __builtin_amdgcn_exp2f(X[4 * g + 2] + a2);
        X[4 * g + 1] = __builtin_amdgcn_exp2f(X[4 * g + 1] + a1); X[4 * g] = __builtin_amdgcn_exp2f(X[4 * g] + a0);
        S += T[g];
    }
    carry = S;
}

template <int KIND>
__device__ __forceinline__ void attn_unit(LAS unsigned char* lds, const bf16_t* __restrict__ PROJ, bf16_t* __restrict__ YU, const float* __restrict__ KS,
                                          const float* __restrict__ F2, const float* __restrict__ gqk, int b, int h, int qb) {
    int tid_o = threadIdx.x; asm volatile("" : "+v"(tid_o));
    const int tid = tid_o, lane = tid & 63, r32 = lane & 31, hi = lane >> 5;
    const int wid = __builtin_amdgcn_readfirstlane(tid >> 6);
    const int qcol = (KIND == 0 ? 1024 : 1792) + h * 64, kcol = qcol + 256, vcol = qcol + 512;
    const size_t rowbase = (size_t)b * SEQL; const int q0 = qb * 256, bh = b * 4 + h;
    const int NT = (q0 + 256) / 64;
    const bf16_t* ksrc = PROJ + (rowbase + lane) * PPITCH + kcol + wid * 8;
    const bf16_t* vsrc = PROJ + (rowbase + 16 * (wid & 3) + (lane >> 2)) * PPITCH + vcol + (wid >> 2) * 32 + (lane & 3) * 8;
    const float* axsrc = (wid == 0 ? KS : F2) + (size_t)bh * SEQL + lane;
    u32x4 kreg, vreg; float areg = 0.f;
#define AT_LOAD(it_) do { const int kt_ = NT - 1 - (it_); kreg = *(const u32x4*)(ksrc + (size_t)kt_ * 64 * PPITCH); vreg = *(const u32x4*)(vsrc + (size_t)kt_ * 64 * PPITCH); \
        if (KIND == 1 && wid < 2) areg = axsrc[kt_ * 64]; } while (0)
#define AT_STORE(slot_) do { *(LAS u32x4*)(lds + (slot_) * AT_SLOT + wid * 1024 + lane * 16) = kreg; *(LAS u32x4*)(lds + (slot_) * AT_SLOT + 8192 + wid * 1024 + lane * 16) = vreg; \
        if (KIND == 1 && wid < 2) *(LAS float*)(lds + AT_AUX + (slot_) * 512 + wid * 256 + lane * 4) = areg; } while (0)
    const bf16_t* Qw = PROJ + (rowbase + q0 + wid * 32 + r32) * PPITCH + qcol + hi * 8;
    bf16x8 qr[4];
#pragma unroll
    for (int d0 = 0; d0 < 4; ++d0) qr[d0] = *(const bf16x8*)(Qw + d0 * 16);
    float Ft = 0.f;
    if (KIND == 1) Ft = F2[(size_t)bh * SEQL + q0 + wid * 32 + r32];
    AT_LOAD(0);
    if (KIND == 1) {
        float qf[4][8]; float ss = 0.f;
#pragma unroll
        for (int d0 = 0; d0 < 4; ++d0)
#pragma unroll
            for (int i = 0; i < 8; ++i) { qf[d0][i] = bf2f((unsigned short)qr[d0][i]); ss += qf[d0][i] * qf[d0][i]; }
        ss += __shfl_xor(ss, 32);
        const float rs = __builtin_amdgcn_rsqf(ss * (1.0f / 64.0f) + EPSF) * C2;
#pragma unroll
        for (int d0 = 0; d0 < 4; ++d0) {
            const float* gp = gqk + d0 * 16 + hi * 8; float v[8];
#pragma unroll
            for (int i = 0; i < 8; ++i) v[i] = qf[d0][i] * rs * gp[i] * gp[64 + i];
            u32x4 w; w.x = pk2(v[0], v[1]); w.y = pk2(v[2], v[3]); w.z = pk2(v[4], v[5]); w.w = pk2(v[6], v[7]);
            qr[d0] = __builtin_bit_cast(bf16x8, w);
        }
    }
    f32x16 o0, o1;
#pragma unroll
    for (int r = 0; r < 16; ++r) { o0[r] = 0.f; o1[r] = 0.f; }
    float mhat = -1e30f, lsum = 0.f, carry = 0.f;
    LAS float* wsf = (LAS float*)(lds + AT_WSF) + wid * 64;
    LAS unsigned* votes = (LAS unsigned*)(lds + AT_VOTE);
    const int qrel = wid * 32 + r32;
    AT_STORE(0); LBAR();
    for (int it = 0; it < NT; ++it) {
        const int slot = it & 1;
        if (KIND == 0 && it > 0) {
            const LAS unsigned* vp = votes + ((it - 1) & 1) * 8;
            const unsigned all = vp[0] & vp[1] & vp[2] & vp[3] & vp[4] & vp[5] & vp[6] & vp[7];
            if (all) break;
        }
        if (it + 1 < NT) AT_LOAD(it + 1);
        const int kt = NT - 1 - it, jb = kt - (NT - 4);
        const bool band = jb >= 0;
        const bool active = !(band && 64 * jb > 32 * wid + 31);
        if (active) {
            f32x16 p0, p1;
            { const LAS unsigned char* kb = lds + slot * AT_SLOT + hi * 1024 + r32 * 16;
#pragma unroll
              for (int d0 = 0; d0 < 4; ++d0) {
                  const bf16x8 b0 = *(const LAS bf16x8*)(kb + d0 * 2048), b1 = *(const LAS bf16x8*)(kb + d0 * 2048 + 512);
                  if (d0 == 0) { f32x16 z;
#pragma unroll
                      for (int r = 0; r < 16; ++r) z[r] = 0.f;
                      p0 = __builtin_amdgcn_mfma_f32_32x32x16_bf16(b0, qr[0], z, 0, 0, 0); p1 = __builtin_amdgcn_mfma_f32_32x32x16_bf16(b1, qr[0], z, 0, 0, 0); }
                  else { p0 = __builtin_amdgcn_mfma_f32_32x32x16_bf16(b0, qr[d0], p0, 0, 0, 0); p1 = __builtin_amdgcn_mfma_f32_32x32x16_bf16(b1, qr[d0], p1, 0, 0, 0); }
              } }
            if (KIND == 0) {
                sb_block(p1, carry, band, 64 * jb + 32 + 4 * hi, qrel, hi);
                sb_block(p0, carry, band, 64 * jb + 4 * hi, qrel, hi);
            } else {
                const LAS float* ax = (const LAS float*)(lds + AT_AUX + slot * 512);
#pragma unroll
                for (int g = 0; g < 4; ++g) {
                    const f32x4 k0 = *(const LAS f32x4*)(ax + 8 * g + 4 * hi), k1 = *(const LAS f32x4*)(ax + 32 + 8 * g + 4 * hi);
                    const f32x4 f0 = *(const LAS f32x4*)(ax + 64 + 8 * g + 4 * hi), f1 = *(const LAS f32x4*)(ax + 96 + 8 * g + 4 * hi);
#pragma unroll
                    for (int i = 0; i < 4; ++i) { p0[4 * g + i] = p0[4 * g + i] * k0[i] + (Ft - f0[i]); p1[4 * g + i] = p1[4 * g + i] * k1[i] + (Ft - f1[i]); }
                }
                if (band) {
#pragma unroll
                    for (int r = 0; r < 16; ++r) { const int kv = 64 * jb + crow(r, hi); if (kv > qrel) p0[r] = -INFINITY; if (kv + 32 > qrel) p1[r] = -INFINITY; }
                }
                float rm = p0[0];
#pragma unroll
                for (int r = 1; r < 16; ++r) rm = __builtin_fmaxf(rm, p0[r]);
#pragma unroll
                for (int r = 0; r < 16; ++r) rm = __builtin_fmaxf(rm, p1[r]);
                rm = __builtin_fmaxf(rm, __shfl_xor(rm, 32));
                if (__any(rm > mhat + 8.0f)) {
                    const float mnew = __builtin_fmaxf(mhat, rm), f = __builtin_amdgcn_exp2f(mhat - mnew);
                    lsum *= f; mhat = mnew;
                    CFENCE(); if (hi == 0) wsf[r32] = f; CFENCE();
                    asm volatile("s_waitcnt lgkmcnt(0)" ::: "memory");
#pragma unroll
                    for (int r = 0; r < 16; ++r) { const float fr_ = wsf[crow(r, hi)]; o0[r] *= fr_; o1[r] *= fr_; }
                    CFENCE();
                }
                float sacc = 0.f;
#pragma unroll
                for (int r = 0; r < 16; ++r) { p0[r] = __builtin_amdgcn_exp2f(p0[r] - mhat); p1[r] = __builtin_amdgcn_exp2f(p1[r] - mhat); sacc += p0[r] + p1[r]; }
                lsum += sacc;
            }
            u32x4 pw0, pw1, pw2, pw3;
            pw0.x = pk2(p0[0], p0[1]); pw0.y = pk2(p0[2], p0[3]); pw0.z = pk2(p0[4], p0[5]); pw0.w = pk2(p0[6], p0[7]);
            pw1.x = pk2(p0[8], p0[9]); pw1.y = pk2(p0[10], p0[11]); pw1.z = pk2(p0[12], p0[13]); pw1.w = pk2(p0[14], p0[15]);
            pw2.x = pk2(p1[0], p1[1]); pw2.y = pk2(p1[2], p1[3]); pw2.z = pk2(p1[4], p1[5]); pw2.w = pk2(p1[6], p1[7]);
            pw3.x = pk2(p1[8], p1[9]); pw3.y = pk2(p1[10], p1[11]); pw3.z = pk2(p1[12], p1[13]); pw3.w = pk2(p1[14], p1[15]);
            const LAS unsigned char* vb = lds + slot * AT_SLOT + 8192 + ((lane >> 4) & 1) * 32 + (lane & 3) * 8 + (4 * hi + ((lane & 15) >> 2)) * 64;
            s16x4 vlo[8], vhi[8];
#pragma unroll
            for (int i = 0; i < 8; ++i) { vlo[i] = vtr(vb + (i >> 2) * 4096 + (i & 3) * 1024); vhi[i] = vtr(vb + (i >> 2) * 4096 + (i & 3) * 1024 + 512); }
#define VFR(i) (bf16x8){vlo[i][0], vlo[i][1], vlo[i][2], vlo[i][3], vhi[i][0], vhi[i][1], vhi[i][2], vhi[i][3]}
#define PAF(x) __builtin_bit_cast(bf16x8, x)
            o0 = __builtin_amdgcn_mfma_f32_32x32x16_bf16(PAF(pw0), VFR(0), o0, 0, 0, 0); o1 = __builtin_amdgcn_mfma_f32_32x32x16_bf16(PAF(pw0), VFR(4), o1, 0, 0, 0);
            o0 = __builtin_amdgcn_mfma_f32_32x32x16_bf16(PAF(pw1), VFR(1), o0, 0, 0, 0); o1 = __builtin_amdgcn_mfma_f32_32x32x16_bf16(PAF(pw1), VFR(5), o1, 0, 0, 0);
            o0 = __builtin_amdgcn_mfma_f32_32x32x16_bf16(PAF(pw2), VFR(2), o0, 0, 0, 0); o1 = __builtin_amdgcn_mfma_f32_32x32x16_bf16(PAF(pw2), VFR(6), o1, 0, 0, 0);
            o0 = __builtin_amdgcn_mfma_f32_32x32x16_bf16(PAF(pw3), VFR(3), o0, 0, 0, 0); o1 = __builtin_amdgcn_mfma_f32_32x32x16_bf16(PAF(pw3), VFR(7), o1, 0, 0, 0);
#undef VFR
#undef PAF
        }
        if (KIND == 0) { const unsigned done = (active && __all(carry < -150.0f)) ? 1u : 0u; if (lane == 0) votes[(it & 1) * 8 + wid] = done; }
        if (it + 1 < NT) AT_STORE(slot ^ 1);
        LBAR();
    }
    if (KIND == 1) { lsum += __shfl_xor(lsum, 32); CFENCE(); if (hi == 0) wsf[r32] = lsum; CFENCE(); asm volatile("s_waitcnt lgkmcnt(0)" ::: "memory"); }
    bf16_t* Yw = YU + (rowbase + q0 + wid * 32) * 512 + KIND * 256 + h * 64 + r32;
#pragma unroll
    for (int r = 0; r < 16; ++r) {
        const int orow = crow(r, hi); float sc = 1.0f;
        if (KIND == 1) sc = __builtin_amdgcn_rcpf(wsf[orow]);
        Yw[(size_t)orow * 512] = (bf16_t)f2bf(o0[r] * sc); Yw[(size_t)orow * 512 + 32] = (bf16_t)f2bf(o1[r] * sc);
    }
    LBAR();
#undef AT_LOAD
#undef AT_STORE
}

#define DEFPTRS \
    const __attribute__((address_space(4))) Args* ka_ = (const __attribute__((address_space(4))) Args*)__builtin_amdgcn_kernarg_segment_ptr(); \
    asm volatile("" : "+s"(ka_)); \
    int tid_o_ = threadIdx.x; asm volatile("" : "+v"(tid_o_)); const int tid = tid_o_, lane = tid & 63; (void)lane; \
    unsigned char* ws = ka_->ws; \
    const float* x_in = ka_->in[0]; const float* c_in = ka_->in[1]; const float* w_ada = ka_->in[2]; const float* b_ada = ka_->in[3]; const float* g_norm = ka_->in[4]; \
    const float* w_up = ka_->in[5]; const float* w_dn = ka_->in[6]; const float* w_in = ka_->in[7]; const float* b_fg = ka_->in[8]; const float* conv_w = ka_->in[9]; \
    const float* conv_b = ka_->in[10]; const float* w_rg = ka_->in[11]; const float* b_rg = ka_->in[12]; const float* w_ig = ka_->in[13]; const float* b_ig = ka_->in[14]; \
    const float* lam = ka_->in[15]; const float* g_qk = ka_->in[16]; const float* g_mix = ka_->in[17]; const float* w_out = ka_->in[18]; \
    float* xout = ka_->out; \
    float* MOD = (float*)(ws + WS_MOD); float* GMOD = (float*)(ws + WS_GMOD); float* GATE = (float*)(ws + WS_GATE); float* SBV = (float*)(ws + WS_SB); \
    float* ROWSS = (float*)(ws + WS_ROWSS); float* KS = (float*)(ws + WS_KS); float* F2 = (float*)(ws + WS_F2); float* FG = (float*)(ws + WS_FG); \
    float* ASEG = (float*)(ws + WS_ASEG); float* BSEG = (float*)(ws + WS_BSEG); \
    bf16_t* WUP = (bf16_t*)(ws + WS_WUP); bf16_t* WDN = (bf16_t*)(ws + WS_WDN); bf16_t* WIN = (bf16_t*)(ws + WS_WIN); bf16_t* WOUT = (bf16_t*)(ws + WS_WOUT); \
    bf16_t* XN = (bf16_t*)(ws + WS_XN); bf16_t* HB = (bf16_t*)(ws + WS_H); bf16_t* PROJ = (bf16_t*)(ws + WS_PROJ); bf16_t* YU = (bf16_t*)(ws + WS_YU); \
    float* HLOC = (float*)(ws + WS_HLOC); bf16_t* PCUM = (bf16_t*)(ws + WS_PCUM); bf16_t* YN = (bf16_t*)(ws + WS_YN);
__global__ void __launch_bounds__(512) mk_fwd(Args args) {
    extern __shared__ __attribute__((aligned(16))) unsigned char lds_raw[];
    LAS unsigned char* lds = (LAS unsigned char*)lds_raw;
    cg::grid_group grid = cg::this_grid();
    const int wave = __builtin_amdgcn_readfirstlane(threadIdx.x >> 6);
    const int G = gridDim.x; const int bx = blockIdx.x;
    const int vcu = (G % 8 == 0) ? (bx % 8) * (G / 8) + bx / 8 : bx;
    const int gw = vcu * 8 + wave, NGW = G * 8;
    const int lo = args.ph_lo, hi_ph = args.ph_hi;
    int ph = 0;
#define PH_ON (ph >= lo && ph < hi_ph)
#define PH_NEXT do { ++ph; if (ph > lo && ph < hi_ph) { asm volatile("s_waitcnt vmcnt(0) lgkmcnt(0)" ::: "memory"); grid.sync(); asm volatile("" ::: "memory"); } } while (0)

    if (PH_ON) { DEFPTRS
        LAS float* cact = (LAS float*)lds;
        LAS float* red = (LAS float*)(lds + 65536);
        for (int i = tid; i < 16 * 1024; i += 512) { const int b = i >> 10, k = i & 1023; const float v = c_in[i]; cact[k * 16 + b] = v * sigmoidf_(v); }
        __syncthreads();
        for (int task = bx; task < 288; task += G) {
            const int l = task / 144, n0 = (task % 144) * 64;
            float acc[16];
#pragma unroll
            for (int b = 0; b < 16; ++b) acc[b] = 0.f;
            const float* wp = w_ada + (size_t)l * 1024 * 9216 + n0 + lane;
#pragma unroll 4
            for (int k = wave * 128; k < wave * 128 + 128; ++k) {
                const float w = wp[(size_t)k * 9216];
                const f32x4 c0 = *(const LAS f32x4*)(cact + k * 16), c1 = *(const LAS f32x4*)(cact + k * 16 + 4), c2 = *(const LAS f32x4*)(cact + k * 16 + 8), c3 = *(const LAS f32x4*)(cact + k * 16 + 12);
#pragma unroll
                for (int i = 0; i < 4; ++i) { acc[i] += c0[i] * w; acc[4 + i] += c1[i] * w; acc[8 + i] += c2[i] * w; acc[12 + i] += c3[i] * w; }
            }
#pragma unroll
            for (int b = 0; b < 16; ++b) red[(wave * 16 + b) * 64 + lane] = acc[b];
            __syncthreads();
            for (int o = tid; o < 1024; o += 512) { const int b = o >> 6, ln = o & 63; float s = 0.f;
#pragma unroll
                for (int w = 0; w < 8; ++w) s += red[(w * 16 + b) * 64 + ln];
                MOD[((size_t)l * 16 + b) * 9216 + n0 + ln] = s + b_ada[l * 9216 + n0 + ln]; }
            __syncthreads();
        }
    }
    PH_NEXT;
    if (PH_ON) { DEFPTRS
        for (int i = bx * 512 + tid; i < 2 * 3 * 16 * 1024; i += G * 512) {
            const int k = i & 1023, b = (i >> 10) & 15, lj = i >> 14, l = lj / 3, j = lj % 3;
            const float* mp = MOD + ((size_t)l * 16 + b) * 9216 + j * 3072;
            GMOD[i] = g_norm[(l * 3 + j) * 1024 + k] * (1.0f + mp[1024 + k]);
            GATE[i] = (j == 1 ? 1.0f : 0.5f) * (1.0f + mp[2048 + k]);
        }
        LAS float* scr = (LAS float*)(lds + wave * 8448);
        constexpr int I_UP = 16 * 176, I_DN = 44 * 32, I_IN = 16 * 88, I_OUT = 16 * 32;
        constexpr int NIT = 4 * I_UP + 4 * I_DN + 2 * I_IN + 2 * I_OUT;
        for (int it = gw; it < NIT; it += NGW) {
            int r = it;
            if (r < 4 * I_UP) { const int mat = r / I_UP; r -= mat * I_UP; const int kb = r / 176, nb = r % 176, n0 = nb * 32;
                const int c0 = ((n0 >> 7) & 1) * DFF + (n0 >> 8) * 128 + (n0 & 127);
                transpose_item(w_up + (size_t)mat * DM * NUP, NUP, NUP, DM, WUP + (size_t)mat * NUP * DM, n0, c0, kb * 64, scr, lane); continue; }
            r -= 4 * I_UP;
            if (r < 4 * I_DN) { const int mat = r / I_DN; r -= mat * I_DN; const int kb = r / 32, nb = r % 32;
                transpose_item(w_dn + (size_t)mat * DFF * DM, DM, DM, DFF, WDN + (size_t)mat * DM * DFF, nb * 32, nb * 32, kb * 64, scr, lane); continue; }
            r -= 4 * I_DN;
            if (r < 2 * I_IN) { const int mat = r / I_IN; r -= mat * I_IN; const int kb = r / 88, nb = r % 88;
                transpose_item(w_in + (size_t)mat * DM * 2564, 2564, 2564, DM, WIN + (size_t)mat * NINP * DM, nb * 32, nb * 32, kb * 64, scr, lane); continue; }
            r -= 2 * I_IN;
            { const int mat = r / I_OUT; r -= mat * I_OUT; const int kb = r / 32, nb = r % 32;
                transpose_item(w_out + (size_t)mat * DM * DM, DM, DM, DM, WOUT + (size_t)mat * DM * DM, nb * 32, nb * 32, kb * 64, scr, lane); }
        }
        for (int m = gw; m < MTOK; m += NGW) {
            const int b = m >> 12;
            const f32x4* xr = (const f32x4*)(x_in + (size_t)m * DM) + lane;
            const f32x4* gp = (const f32x4*)(g_norm) + lane;
            const f32x4* sp = (const f32x4*)(MOD + (size_t)b * 9216 + 1024) + lane;
            float s = 0.f; u32x2* o8 = (u32x2*)(XN + (size_t)m * DM) + lane;
#pragma unroll
            for (int j = 0; j < 4; ++j) { const f32x4 v = xr[64 * j]; s += (v[0] * v[0] + v[1] * v[1]) + (v[2] * v[2] + v[3] * v[3]);
                const f32x4 a = v * gp[64 * j] * (sp[64 * j] + 1.0f); u32x2 w; w.x = pk2(a[0], a[1]); w.y = pk2(a[2], a[3]); o8[64 * j] = w; }
            s = wave_sum(s);
            if (lane < 16) ROWSS[(size_t)m * 16 + lane] = (lane == 0) ? s : 0.f;
        }
    }
    PH_NEXT;
    if (PH_ON) { DEFPTRS
        LAS float* sh = (LAS float*)lds;
        for (int combo = 0; combo < 6; ++combo) {
            const int l = combo / 3, j = combo % 3;
            __syncthreads();
            for (int i = tid; i < 16 * 1024; i += 512) { const int b = i >> 10, k = i & 1023; sh[i] = MOD[((size_t)l * 16 + b) * 9216 + j * 3072 + k]; }
            __syncthreads();
            const bf16_t* Wt = (j == 1) ? WIN + (size_t)l * NINP * DM : WUP + (size_t)(l * 2 + (j == 2 ? 1 : 0)) * NUP * DM;
            const int N = (j == 1) ? NINP : NUP;
            float* dst = SBV + (size_t)combo * 16 * 5632;
            for (int n = gw; n < N; n += NGW) {
                float w[16];
#pragma unroll
                for (int c = 0; c < 4; ++c) { const u32x2 q = *(const u32x2*)(Wt + (size_t)n * DM + c * 256 + lane * 4);
                    w[4 * c] = __uint_as_float(q.x << 16); w[4 * c + 1] = __uint_as_float(q.x & 0xffff0000u); w[4 * c + 2] = __uint_as_float(q.y << 16); w[4 * c + 3] = __uint_as_float(q.y & 0xffff0000u); }
                float keep = 0.f;
#pragma unroll 1
                for (int b = 0; b < 16; ++b) { float s = 0.f;
#pragma unroll
                    for (int c = 0; c < 4; ++c) { const f32x4 v = *(const LAS f32x4*)(sh + b * 1024 + c * 256 + lane * 4); s += (w[4 * c] * v[0] + w[4 * c + 1] * v[1]) + (w[4 * c + 2] * v[2] + w[4 * c + 3] * v[3]); }
                    s = wave_sum(s); if (lane == b) keep = s; }
                if (lane < 16) dst[(size_t)lane * 5632 + n] = keep;
            }
        }
        __syncthreads();
    }
    PH_NEXT;

#pragma unroll 1
    for (int f = 0; f < 4; ++f) {
        const int l = f >> 1, s = f & 1;
        if (s == 1) {
            if (PH_ON) { DEFPTRS
                pg8::Gemm g{XN, WIN + (size_t)l * NINP * DM, MTOK, NINP, DM}; pg8::StaticOrder S; S.init(MTOK, NINP, G, bx);
                pg8::EpiIn E{PROJ, FG, ROWSS + (size_t)(l * 3 + 1) * MTOK * 16, SBV + (size_t)(l * 3 + 1) * 16 * 5632};
#ifndef NO_G_IN
                pg8::gemm_phase<pg8::EpiIn, pg8::StaticOrder, true, true>(lds, g, S, E);
#endif
            }
            PH_NEXT;
            if (PH_ON) { DEFPTRS
#ifndef NO_PREP
                const int blk = gw & 7, ch = blk * 64 + lane;
                LAS float* ul = (LAS float*)(lds + wave * 8448);
                LAS float* xs = ul + 64;
                f32x2 w2[64];
#pragma unroll
                for (int i = 0; i < 64; ++i) { const size_t o = ((size_t)(l * 8 + blk) * 64 + i) * 64 + lane; w2[i] = (f32x2){w_rg[o], w_ig[o]}; }
                const float br = b_rg[l * 512 + ch], bi = b_ig[l * 512 + ch], cb = conv_b[l * 512 + ch];
                const float cw0 = conv_w[(l * 4 + 0) * 512 + ch], cw1 = conv_w[(l * 4 + 1) * 512 + ch], cw2 = conv_w[(l * 4 + 2) * 512 + ch], cw3 = conv_w[(l * 4 + 3) * 512 + ch];
                const float lmv = lam[l * 512 + ch];
                const float spl = __builtin_fmaxf(-lmv, 0.f) + log1pf(expf(-fabsf(lmv)));
                const float c8 = -8.0f * spl * LOG2E;
                for (int segi = gw >> 3; segi < REP_PREP * (MTOK / 32); segi += NGW >> 3) { const int seg = segi & (MTOK / 32 - 1);
                    const int row0 = seg * 32; const bf16_t* xp = PROJ + (size_t)row0 * PPITCH + ch;
                    float xm3 = 0.f, xm2 = 0.f, xm1 = 0.f;
                    if ((row0 & (SEQL - 1)) != 0) { xm3 = bf2f(xp[-3 * PPITCH]); xm2 = bf2f(xp[-2 * PPITCH]); xm1 = bf2f(xp[-1 * PPITCH]); }
#pragma unroll
                    for (int t = 0; t < 32; ++t) xs[t * 64 + lane] = bf2f(xp[(size_t)t * PPITCH]);
                    float hs = 0.f, P = 1.f;
                    float* hl = HLOC + (size_t)row0 * 512 + ch; bf16_t* pc = PCUM + (size_t)row0 * 512 + ch;
#pragma unroll 1
                    for (int t = 0; t < 32; ++t) {
                        const float x0 = xs[t * 64 + lane];
                        const float u = cb + cw0 * xm3 + cw1 * xm2 + cw2 * xm1 + cw3 * x0; xm3 = xm2; xm2 = xm1; xm1 = x0;
                        CFENCE(); ul[lane] = u; CFENCE();
                        f32x2 acc = (f32x2){br, bi};
#pragma unroll
                        for (int i4 = 0; i4 < 16; ++i4) { const f32x4 uu = *(const LAS f32x4*)(ul + 4 * i4);
                            acc += w2[4 * i4] * uu[0]; acc += w2[4 * i4 + 1] * uu[1]; acc += w2[4 * i4 + 2] * uu[2]; acc += w2[4 * i4 + 3] * uu[3]; }
                        CFENCE();
                        const float r = sigmoidf_(acc[0]), ig = sigmoidf_(acc[1]);
                        const float la2 = c8 * r, a = __builtin_amdgcn_exp2f(la2);
                        const float xx = 2.0f * 0.6931471805599453f * la2;
                        const float om = (xx > -0.25f) ? -xx * (1.0f + xx * 0.5f * (1.0f + xx * (1.0f / 3.0f) * (1.0f + xx * 0.25f * (1.0f + xx * 0.2f)))) : 1.0f - a * a;
                        const float bt = __builtin_sqrtf(om) * ig * u;
                        hs = a * hs + bt; P *= a;
                        hl[(size_t)t * 512] = hs; pc[(size_t)t * 512] = (bf16_t)f2bf(P);
                    }
                    ASEG[(size_t)seg * 512 + ch] = P; BSEG[(size_t)seg * 512 + ch] = hs;
                }
                for (int row = gw; row < MTOK; row += NGW) {
                    const u32x2 q = *(const u32x2*)(PROJ + (size_t)row * PPITCH + 2048 + lane * 4);
                    const float a0 = __uint_as_float(q.x << 16), a1 = __uint_as_float(q.x & 0xffff0000u), a2 = __uint_as_float(q.y << 16), a3 = __uint_as_float(q.y & 0xffff0000u);
                    float ss = (a0 * a0 + a1 * a1) + (a2 * a2 + a3 * a3);
                    ss += __shfl_xor(ss, 1); ss += __shfl_xor(ss, 2); ss += __shfl_xor(ss, 4); ss += __shfl_xor(ss, 8);
                    if ((lane & 15) == 0) KS[(size_t)((row >> 12) * 4 + (lane >> 4)) * SEQL + (row & (SEQL - 1))] = __builtin_amdgcn_rsqf(ss * (1.0f / 64.0f) + EPSF);
                }
                if (wave == 0) for (int chn = vcu; chn < 64; chn += G) {
                    const int b = chn >> 2, h = chn & 3; const float bf = b_fg[l * 4 + h];
                    const float* fp = FG + ((size_t)b * SEQL + lane * 64) * 4 + h;
                    float tot = 0.f;
#pragma unroll 8
                    for (int i = 0; i < 64; ++i) { const float v = fp[i * 4] + bf; tot += __builtin_fminf(v, 0.f) - log1pf(expf(-fabsf(v))); }
                    float inc = tot;
#pragma unroll
                    for (int o = 1; o < 64; o <<= 1) { const float t_ = __shfl_up(inc, o); if (lane >= o) inc += t_; }
                    float run = inc - tot;
                    float* op = F2 + (size_t)chn * SEQL + lane * 64;
#pragma unroll 8
                    for (int i = 0; i < 64; ++i) { const float v = fp[i * 4] + bf; run += __builtin_fminf(v, 0.f) - log1pf(expf(-fabsf(v))); op[i] = run * LOG2E; }
                }
#endif
                __syncthreads();
            }
            PH_NEXT;
            if (PH_ON) { DEFPTRS
#ifndef NO_ATTN
                for (int rep_ = 0; rep_ < REP_ATTN; ++rep_)
                for (int vw = vcu; vw < 256; vw += G) {
                    const int bh = vw >> 2, s4 = vw & 3, b = bh >> 2, h = bh & 3;
#pragma unroll 1
                    for (int i = 0; i < 4; ++i) { const int qb = (i == 0) ? s4 : (i == 1) ? 7 - s4 : (i == 2) ? 8 + s4 : 15 - s4;
#ifndef NO_FOX
                        attn_unit<1>(lds, PROJ, YU, KS, F2, g_qk + l * 128, b, h, qb);
#endif
 }
#pragma unroll 1
                    for (int i = 0; i < 4; ++i) { const int qb = (i == 0) ? s4 : (i == 1) ? 7 - s4 : (i == 2) ? 8 + s4 : 15 - s4;
#ifndef NO_SB
                        attn_unit<0>(lds, PROJ, YU, KS, F2, g_qk + l * 128, b, h, qb);
#endif
 }
                }
#endif
            }
            PH_NEXT;
            if (PH_ON) { DEFPTRS
                LAS float* hin = (LAS float*)lds;
                const f32x4 gm0 = *(const f32x4*)(g_mix + l * 1024 + lane * 8), gm1 = *(const f32x4*)(g_mix + l * 1024 + lane * 8 + 4);
                const f32x4 gx0 = *(const f32x4*)(g_mix + l * 1024 + 512 + lane * 8), gx1 = *(const f32x4*)(g_mix + l * 1024 + 512 + lane * 8 + 4);
                for (int tt = vcu; tt < 256; tt += G) {
                    __syncthreads();
                    { const int ch = tid, seg0 = (tt >> 4) * 128, nb = (tt & 15) * 8; float Hc = 0.f;
#pragma unroll 8
                      for (int sg = 0; sg < nb; ++sg) Hc = ASEG[(size_t)(seg0 + sg) * 512 + ch] * Hc + BSEG[(size_t)(seg0 + sg) * 512 + ch];
#pragma unroll
                      for (int s8 = 0; s8 < 8; ++s8) { hin[s8 * 512 + ch] = Hc; Hc = ASEG[(size_t)(seg0 + nb + s8) * 512 + ch] * Hc + BSEG[(size_t)(seg0 + nb + s8) * 512 + ch]; } }
                    __syncthreads();
                    const f32x4 hi0 = *(const LAS f32x4*)(hin + wave * 512 + lane * 8), hi1 = *(const LAS f32x4*)(hin + wave * 512 + lane * 8 + 4);
#pragma unroll 2
                    for (int t = 0; t < 32; ++t) {
                        const size_t row = (size_t)tt * 256 + wave * 32 + t;
                        const f32x4 h0 = *(const f32x4*)(HLOC + row * 512 + lane * 8), h1 = *(const f32x4*)(HLOC + row * 512 + lane * 8 + 4);
                        const u32x4 pq = *(const u32x4*)(PCUM + row * 512 + lane * 8);
                        const u32x4 gq = *(const u32x4*)(PROJ + row * PPITCH + 512 + lane * 8);
                        const u32x4 yq = *(const u32x4*)(YU + row * 512 + lane * 8);
                        float y[8], yu[8]; float ss = 0.f, s2 = 0.f;
#pragma unroll
                        for (int i = 0; i < 8; ++i) {
                            const unsigned pw = pq[i >> 1], gw_ = gq[i >> 1], yw = yq[i >> 1];
                            const float p = (i & 1) ? __uint_as_float(pw & 0xffff0000u) : __uint_as_float(pw << 16);
                            const float gg = (i & 1) ? __uint_as_float(gw_ & 0xffff0000u) : __uint_as_float(gw_ << 16);
                            yu[i] = (i & 1) ? __uint_as_float(yw & 0xffff0000u) : __uint_as_float(yw << 16);
                            const float hh = (i < 4 ? h0[i & 3] : h1[i & 3]) + p * (i < 4 ? hi0[i & 3] : hi1[i & 3]);
                            const float inner = 0.7978845608028654f * (gg + 0.044715f * gg * gg * gg);
                            const float ge = gg * __builtin_amdgcn_rcpf(1.0f + __builtin_amdgcn_exp2f(-2.0f * LOG2E * inner));
                            y[i] = hh * ge; ss += y[i] * y[i]; s2 += yu[i] * yu[i];
                        }
                        ss = wave_sum(ss);
                        s2 += __shfl_xor(s2, 1); s2 += __shfl_xor(s2, 2); s2 += __shfl_xor(s2, 4); s2 += __shfl_xor(s2, 8); s2 += __shfl_xor(s2, 16);
                        const float rl = __builtin_amdgcn_rsqf(ss * (1.0f / 512.0f) + EPSF), rx = __builtin_amdgcn_rsqf(s2 * (1.0f / 256.0f) + EPSF);
                        u32x4 o1, o2;
                        o1.x = pk2(y[0] * rl * gm0[0], y[1] * rl * gm0[1]); o1.y = pk2(y[2] * rl * gm0[2], y[3] * rl * gm0[3]);
                        o1.z = pk2(y[4] * rl * gm1[0], y[5] * rl * gm1[1]); o1.w = pk2(y[6] * rl * gm1[2], y[7] * rl * gm1[3]);
                        o2.x = pk2(yu[0] * rx * gx0[0], yu[1] * rx * gx0[1]); o2.y = pk2(yu[2] * rx * gx0[2], yu[3] * rx * gx0[3]);
                        o2.z = pk2(yu[4] * rx * gx1[0], yu[5] * rx * gx1[1]); o2.w = pk2(yu[6] * rx * gx1[2], yu[7] * rx * gx1[3]);
                        *(u32x4*)(YN + row * 1024 + lane * 8) = o1; *(u32x4*)(YN + row * 1024 + 512 + lane * 8) = o2;
                    }
                }
                __syncthreads();
            }
            PH_NEXT;
            if (PH_ON) { DEFPTRS
                pg8::Gemm g{YN, WOUT + (size_t)l * DM * DM, MTOK, DM, DM}; pg8::StaticOrder S; S.init(MTOK, DM, G, bx);
                pg8::EpiRes E{xout, xout, GATE + (size_t)(l * 3 + 1) * 16 * 1024, GMOD + (size_t)(l * 3 + 2) * 16 * 1024, XN, ROWSS + (size_t)(l * 3 + 2) * MTOK * 16, 1};
#ifndef NO_G_OUT
                pg8::gemm_phase<pg8::EpiRes, pg8::StaticOrder, true, true>(lds, g, S, E);
#endif
            }
            PH_NEXT;
        }
        const int j = s ? 2 : 0;
        if (PH_ON) { DEFPTRS
            pg8::Gemm g{XN, WUP + (size_t)(l * 2 + s) * NUP * DM, MTOK, NUP, DM}; pg8::StaticOrder S; S.init(MTOK, NUP, G, bx);
            pg8::EpiUp E{HB, ROWSS + (size_t)(l * 3 + j) * MTOK * 16, SBV + (size_t)(l * 3 + j) * 16 * 5632};
#ifndef NO_G_UP
            for (int rep_ = 0; rep_ < REP_UP; ++rep_) {
            pg8::gemm_phase<pg8::EpiUp, pg8::StaticOrder, true, true>(lds, g, S, E);
            }
#endif
        }
        PH_NEXT;
        if (PH_ON) { DEFPTRS
            const int nl = s ? l + 1 : l, nj = s ? 0 : 1; const int has_next = (nl < 2) ? 1 : 0; const int nidx = has_next ? nl * 3 + nj : 0;
            pg8::Gemm g{HB, WDN + (size_t)(l * 2 + s) * DM * DFF, MTOK, DM, DFF}; pg8::StaticOrder S; S.init(MTOK, DM, G, bx);
            pg8::EpiRes E{f == 0 ? x_in : xout, xout, GATE + (size_t)(l * 3 + j) * 16 * 1024, GMOD + (size_t)nidx * 16 * 1024, XN, ROWSS + (size_t)nidx * MTOK * 16, has_next};
#ifndef NO_G_DN
            pg8::gemm_phase<pg8::EpiRes, pg8::StaticOrder, true, true>(lds, g, S, E);
#endif
        }
        PH_NEXT;
    }
#undef PH_ON
#undef PH_NEXT
}


#ifdef DBG_STOP
__global__ void dbg_dump(const unsigned char* ws, float* out, int mode) {
    const size_t n = (size_t)MTOK * DM; const size_t i0 = (size_t)blockIdx.x * blockDim.x + threadIdx.x, st = (size_t)gridDim.x * blockDim.x;
    const bf16_t* XN = (const bf16_t*)(ws + WS_XN); const bf16_t* HB = (const bf16_t*)(ws + WS_H); const bf16_t* PR = (const bf16_t*)(ws + WS_PROJ);
    const bf16_t* YU = (const bf16_t*)(ws + WS_YU); const float* HL = (const float*)(ws + WS_HLOC); const bf16_t* YN = (const bf16_t*)(ws + WS_YN); const bf16_t* PC = (const bf16_t*)(ws + WS_PCUM);
    for (size_t i = i0; i < n; i += st) {
        float v = 0.f;
        if (mode == 0) v = bf2f(XN[i]);
        else if (mode == 1) v = bf2f(HB[i]) + bf2f(HB[i + n]) + bf2f(HB[i + (size_t)117440512]);
        else if (mode == 2) v = bf2f(PR[i]) + bf2f(PR[i + n]) + bf2f(PR[i + (size_t)100663296]);
        else if (mode == 3) v = (i < n / 2) ? bf2f(YU[i]) : HL[i - n / 2];
        else if (mode == 4) v = bf2f(YN[i]);
        else if (mode == 6) v = (i < n / 2) ? bf2f(PC[i]) : ((const float*)(ws + WS_KS))[(i - n / 2) % (3 * 262144)];
        else if (mode == 7) v = HL[i % (n / 2)] + bf2f(PC[i % (n / 2)]) + ((const float*)(ws + WS_KS))[i % (3 * 262144)] + ((const float*)(ws + WS_ASEG))[i % (2 * 1048576)];
        if (mode == 3) { const bool nan_ = !(v == v), big = (v > 3e38f) || (v < -3e38f); float code = 0.f;
            if (i < n / 2) { const int col = (int)(i & 511); if (col < 256) code = nan_ ? 2000.f : (big ? 1000.f : 0.f); else code = (nan_ || big) ? 4000.f : 0.f; }
            else code = (nan_ || big) ? 8000.f : 0.f;
            v = code; }
        if (!(v == v)) v = 77777.f; if (v > 3e38f) v = 88888.f; if (v < -3e38f) v = 99999.f;
        if (mode != 5) out[i] = v;
    }
}
#endif
#ifndef MK_N_LAUNCHES
#define MK_N_LAUNCHES 1
#endif
constexpr int N_PHASES = 3 + 2 * 9;
extern "C" void kernel_launch(void* const* d_in, const int* in_sizes, int n_in, void* d_out, int out_size, void* d_ws, size_t ws_size, hipStream_t stream) {
    static int grid = 0;
    if (grid == 0) {
        if (n_in != 19 || out_size != MTOK * DM || ws_size < WS_END) { fprintf(stderr, "kernel_launch: unexpected shapes (n_in %d, out %d, ws %zu)\n", n_in, out_size, ws_size); grid = -1; return; }
        int dev = 0, cus = 0, per_cu = 0;
        hipGetDevice(&dev); hipDeviceGetAttribute(&cus, hipDeviceAttributeMultiprocessorCount, dev);
        if (hipFuncSetAttribute((const void*)mk_fwd, hipFuncAttributeMaxDynamicSharedMemorySize, LDS_BYTES) != hipSuccess) { fprintf(stderr, "kernel_launch: hipFuncSetAttribute failed\n"); grid = -1; return; }
        if (hipOccupancyMaxActiveBlocksPerMultiprocessor(&per_cu, (const void*)mk_fwd, 512, LDS_BYTES) != hipSuccess || per_cu < 1) { fprintf(stderr, "kernel_launch: occupancy query says %d\n", per_cu); per_cu = 1; }
        (void)hipGetLastError();
        grid = cus * 1;
    }
    if (grid < 0) return;
    Args a{};
    for (int i = 0; i < 19; ++i) a.in[i] = (const float*)d_in[i];
    a.out = (float*)d_out; a.ws = (unsigned char*)d_ws;
#if MK_N_LAUNCHES == 1
    a.ph_lo = 0; a.ph_hi = N_PHASES;
    void* kargs[] = {&a};
    hipError_t e = hipLaunchCooperativeKernel((const void*)mk_fwd, dim3(grid), dim3(512), kargs, LDS_BYTES, stream);
    if (e != hipSuccess) fprintf(stderr, "kernel_launch: cooperative launch failed: %s (grid %d)\n", hipGetErrorString(e), grid);
#else
#ifdef DBG_STOP
    for (int p = 0; p < DBG_STOP; ++p) { a.ph_lo = p; a.ph_hi = p + 1; hipLaunchKernelGGL(mk_fwd, dim3(grid), dim3(512), LDS_BYTES, stream, a); }
    hipLaunchKernelGGL(dbg_dump, dim3(2048), dim3(256), 0, stream, (const unsigned char*)d_ws, (float*)d_out, DBG_MODE);
#else
    for (int p = 0; p < N_PHASES; ++p) { a.ph_lo = p; a.ph_hi = p + 1; hipLaunchKernelGGL(mk_fwd, dim3(grid), dim3(512), LDS_BYTES, stream, a); }
#endif
#endif
}
```

```cpp
#include <hip/hip_runtime.h>
#include <hip/hip_cooperative_groups.h>
#include <cstdio>
#include <cstdint>
namespace cg = cooperative_groups;
namespace pg8 {
#define PG8_LAS __attribute__((address_space(3)))
typedef unsigned short bf16_t;
typedef short bf16x8 __attribute__((ext_vector_type(8)));
typedef float f32x4 __attribute__((ext_vector_type(4)));
typedef unsigned u32x4 __attribute__((ext_vector_type(4)));
constexpr int BM = 256, BK = 64, HALF = 128, HTB = HALF * BK * 2  , STAGE_BYTES = 8 * HTB, NXCD = 8, WGM = 8;

__host__ __device__ __forceinline__ int lds_byte(int r, int c) { const int st = (r >> 4) * 2 + (c >> 5), rr = r & 15, cc = c & 31, ob = rr * 64 + cc * 2; return st * 1024 + (ob ^ (((ob >> 9) & 1) << 5)); }
__host__ __device__ __forceinline__ void stage_rc(int b, int& R, int& C) { const int st = b / 1024, sb = b % 1024, swz = sb ^ (((sb >> 9) & 1) << 5); R = (st >> 1) * 16 + swz / 64; C = (st & 1) * 32 + (swz % 64) / 2; }
__host__ __device__ __forceinline__ int perm32(int rho) { const int n = rho >> 4, i = rho & 15; return 8 * (i >> 2) + 4 * n + (i & 3); }

struct Unit { int pm, pn; };
struct Gemm { const bf16_t* A; const bf16_t* Bt; int M, N, K; };

struct StaticOrder {
    int nM, nN, nwg, G, c;
    __host__ __device__ void init(int M, int N, int G_, int c_) { nM = M / BM; nN = N / BM; nwg = nM * nN; G = G_; c = c_; }
    __host__ __device__ bool next(int i, Unit& u) const {
        const long L = (long)i * G + c; if (L >= nwg) return false;
        int wgid = (int)L; { const int q = nwg / NXCD, r = nwg % NXCD, xcd = wgid % NXCD, off = wgid / NXCD; wgid = (xcd < r ? xcd * (q + 1) : r * (q + 1) + (xcd - r) * q) + off; }
        const int nig = WGM * nN, gid = wgid / nig, fm = gid * WGM, gsz = (nM - fm) < WGM ? (nM - fm) : WGM;
        u.pm = fm + ((wgid % nig) % gsz); u.pn = (wgid % nig) / gsz; return true;
    }
    __device__ __forceinline__ void a_ready(const Unit&) const {}
    __device__ __forceinline__ void done(const Unit&) const {}
};

typedef float f32x2c_t __attribute__((ext_vector_type(2))); typedef __bf16 bf16x2c_t __attribute__((ext_vector_type(2)));
__device__ __forceinline__ unsigned cvt_pk_bf16(float lo, float hi) { f32x2c_t v = {lo, hi}; bf16x2c_t b = __builtin_convertvector(v, bf16x2c_t); return __builtin_bit_cast(unsigned, b); }
typedef float f32x2 __attribute__((ext_vector_type(2)));
constexpr float RMS_EPS = 1e-6f;
struct EpiUp {
    static constexpr bool PERM = true, AFTER_DRAIN = false;
    bf16_t* H; const float* rowss; const float* sb;
    __device__ __forceinline__ void operator()(const f32x4 (&acc)[2][2][4][2], const Unit& u, int wr, int wc, int fr, int fq) const {
        const int row0 = u.pm * BM + wr * 64 + fr, b = u.pm >> 4, cl = wc * 32 + 8 * fq;
        const float* sbp = sb + (size_t)b * 5632 + u.pn * 256 + cl;
        float rsv[2][4];
#pragma unroll
        for (int ai = 0; ai < 2; ++ai)
#pragma unroll
            for (int m = 0; m < 4; ++m) rsv[ai][m] = rowss[row0 + ai * HALF + m * 16];
        f32x4 sg[2], su[2];
#pragma unroll
        for (int n = 0; n < 2; ++n) { sg[n] = *(const f32x4*)(sbp + 4 * n); su[n] = *(const f32x4*)(sbp + 128 + 4 * n); }
#pragma unroll
        for (int ai = 0; ai < 2; ++ai)
#pragma unroll
            for (int m = 0; m < 4; ++m) {
                const int row = row0 + ai * HALF + m * 16;
                const float rs = __builtin_amdgcn_rsqf(rsv[ai][m] * (1.0f / 1024.0f) + RMS_EPS);
                float hv[8];
#pragma unroll
                for (int n = 0; n < 2; ++n)
#pragma unroll
                    for (int i = 0; i < 4; ++i) {
                        const float g = rs * acc[ai][0][m][n][i] + sg[n][i], uu = rs * acc[ai][1][m][n][i] + su[n][i];
                        hv[n * 4 + i] = g * __builtin_amdgcn_rcpf(1.0f + __builtin_amdgcn_exp2f(-1.4426950408889634f * g)) * uu;
                    }
                u32x4 w; w.x = cvt_pk_bf16(hv[0], hv[1]); w.y = cvt_pk_bf16(hv[2], hv[3]); w.z = cvt_pk_bf16(hv[4], hv[5]); w.w = cvt_pk_bf16(hv[6], hv[7]);
                *(u32x4*)(H + (size_t)row * 2816 + u.pn * 128 + cl) = w;
            }
    }
};
struct EpiIn {
    static constexpr bool PERM = true, AFTER_DRAIN = false;
    bf16_t* P; float* FG; const float* rowss; const float* sb;
    __device__ __forceinline__ void operator()(const f32x4 (&acc)[2][2][4][2], const Unit& u, int wr, int wc, int fr, int fq) const {
        const int row0 = u.pm * BM + wr * 64 + fr, b = u.pm >> 4, cl = wc * 32 + 8 * fq;
        const float* sbp = sb + (size_t)b * 5632 + u.pn * 256 + cl;
        float rsv[2][4];
#pragma unroll
        for (int ai = 0; ai < 2; ++ai)
#pragma unroll
            for (int m = 0; m < 4; ++m) rsv[ai][m] = rowss[row0 + ai * HALF + m * 16];
        f32x4 sv[2][2];
#pragma unroll
        for (int bj = 0; bj < 2; ++bj)
#pragma unroll
            for (int n = 0; n < 2; ++n) sv[bj][n] = *(const f32x4*)(sbp + bj * HALF + 4 * n);
#pragma unroll
        for (int ai = 0; ai < 2; ++ai)
#pragma unroll
            for (int m = 0; m < 4; ++m) {
                const int row = row0 + ai * HALF + m * 16;
                const float rs = __builtin_amdgcn_rsqf(rsv[ai][m] * (1.0f / 1024.0f) + RMS_EPS);
                if (u.pn < 10) {
#pragma unroll
                    for (int bj = 0; bj < 2; ++bj) {
                        const f32x4 v0 = acc[ai][bj][m][0] * rs + sv[bj][0], v1 = acc[ai][bj][m][1] * rs + sv[bj][1];
                        u32x4 w; w.x = cvt_pk_bf16(v0[0], v0[1]); w.y = cvt_pk_bf16(v0[2], v0[3]); w.z = cvt_pk_bf16(v1[0], v1[1]); w.w = cvt_pk_bf16(v1[2], v1[3]);
                        *(u32x4*)(P + (size_t)row * 2560 + u.pn * 256 + bj * HALF + cl) = w;
                    }
                } else if (wc == 0 && fq == 0) {
                    *(f32x4*)(FG + (size_t)row * 4) = acc[ai][0][m][0] * rs + sv[0][0];
                }
            }
    }
};
struct EpiRes {
    static constexpr bool PERM = false, AFTER_DRAIN = false;
    const float* xin; float* xout; const float* gate; const float* gmn; bf16_t* XN; float* rowssn; int has_next;
    __device__ __forceinline__ void operator()(const f32x4 (&acc)[2][2][4][2], const Unit& u, int wr, int wc, int fr, int fq) const {
        typedef unsigned u32x2v __attribute__((ext_vector_type(2)));
        const int row0 = u.pm * BM + wr * 64 + fr, b = u.pm >> 4, col0 = u.pn * BM + wc * 32 + 4 * fq;
        const float* gp_ = gate + b * 1024 + col0; const float* gm_ = gmn + b * 1024 + col0;
#pragma unroll
        for (int ai = 0; ai < 2; ++ai) {
            f32x4 xi[4][2][2];
#pragma unroll
            for (int m = 0; m < 4; ++m)
#pragma unroll
                for (int bj = 0; bj < 2; ++bj)
#pragma unroll
                    for (int n = 0; n < 2; ++n) xi[m][bj][n] = *(const f32x4*)(xin + (size_t)(row0 + ai * HALF + m * 16) * 1024 + col0 + bj * HALF + n * 16);
            asm volatile("" ::: "memory");
#pragma unroll
            for (int m = 0; m < 4; ++m) {
                const int row = row0 + ai * HALF + m * 16; const size_t off = (size_t)row * 1024 + col0;
                float ss = 0.f;
#pragma unroll
                for (int bj = 0; bj < 2; ++bj)
#pragma unroll
                    for (int n = 0; n < 2; ++n) {
                        const f32x4 xo = xi[m][bj][n] + *(const f32x4*)(gp_ + bj * HALF + n * 16) * acc[ai][bj][m][n];
                        *(f32x4*)(xout + off + bj * HALF + n * 16) = xo;
                        if (has_next) {
                            ss += (xo[0] * xo[0] + xo[1] * xo[1]) + (xo[2] * xo[2] + xo[3] * xo[3]);
                            const f32x4 a = xo * *(const f32x4*)(gm_ + bj * HALF + n * 16); u32x2v w; w.x = cvt_pk_bf16(a[0], a[1]); w.y = cvt_pk_bf16(a[2], a[3]);
                            *(u32x2v*)(XN + off + bj * HALF + n * 16) = w;
                        }
                    }
                if (has_next) { ss += __shfl_xor(ss, 16); ss += __shfl_xor(ss, 32); if (fq == 0) unsafeAtomicAdd(rowssn + row, ss); }
            }
            asm volatile("" ::: "memory");
        }
    }
};

template <class Epi, class Sched, bool ALIGN_EPI = false, bool SP2 = false>
__device__ __forceinline__ void gemm_phase(PG8_LAS unsigned char* lds, const Gemm g, const Sched& S, const Epi& E) {
    int tid_o = threadIdx.x; asm volatile("" : "+v"(tid_o)); const int tid = tid_o, wid = __builtin_amdgcn_readfirstlane(tid >> 6), lane = tid & 63, wr = wid >> 2, wc = wid & 3, fr = lane & 15, fq = lane >> 4;
    const int K = g.K, nt = K / BK;
    unsigned voffA[2], voffB[2];
#pragma unroll
    for (int i = 0; i < 2; ++i) { int R, C; stage_rc(tid * 16 + i * 8192, R, C); const int Rb = Epi::PERM ? ((R & ~31) + perm32(R & 31)) : R;
        voffA[i] = (unsigned)(R * K + C) * 2u; voffB[i] = (unsigned)(Rb * K + C) * 2u; }
    const size_t kstep = (size_t)(BK * 2);
    const size_t hstep = (size_t)HALF * K * 2;
    const size_t tstep = 2 * hstep;
    const unsigned ldsw = (unsigned)wid * 1024u;
    const int aoff = lds_byte(wr * 64 + fr, fq * 8), boff = lds_byte(wc * 32 + fr, fq * 8);
#define PG8_SA(b, h) (((b) * 2 + (h)) * HTB)
#define PG8_SB(b, h) ((4 + (b) * 2 + (h)) * HTB)
#define PG8_STAGE(bufoff, gbase, voff) do { _Pragma("unroll") for (int _i = 0; _i < 2; ++_i) \
        __builtin_amdgcn_global_load_lds((const unsigned*)((const char*)(gbase) + (voff)[_i]), (PG8_LAS unsigned*)(lds + (bufoff) + ldsw + _i * 8192), 16, 0, 0); } while (0)
#define PG8_LDA(dst, b, h) do { _Pragma("unroll") for (int m = 0; m < 4; ++m) _Pragma("unroll") for (int k = 0; k < 2; ++k) dst[m][k] = *(const PG8_LAS bf16x8*)(lds + PG8_SA(b, h) + aoff + m * 2048 + k * 1024); } while (0)
#define PG8_LDB(dst, b, h) do { _Pragma("unroll") for (int n = 0; n < 2; ++n) _Pragma("unroll") for (int k = 0; k < 2; ++k) dst[n][k] = *(const PG8_LAS bf16x8*)(lds + PG8_SB(b, h) + boff + n * 2048 + k * 1024); } while (0)
#define PG8_MMA(ai, bj, At, Bt) do { __builtin_amdgcn_s_setprio(1); _Pragma("unroll") for (int m = 0; m < 4; ++m) _Pragma("unroll") for (int n = 0; n < 2; ++n) _Pragma("unroll") for (int k = 0; k < 2; ++k) \
        acc[ai][bj][m][n] = __builtin_amdgcn_mfma_f32_16x16x32_bf16(Bt[n][k], At[m][k], acc[ai][bj][m][n], 0, 0, 0); __builtin_amdgcn_s_setprio(0); } while (0)
#define PG8_WAIT_V(n) asm volatile("s_waitcnt vmcnt(" #n ")" ::: "memory")
#define PG8_WAIT_L(n) asm volatile("s_waitcnt lgkmcnt(" #n ")" ::: "memory")
#define PG8_BAR __builtin_amdgcn_s_barrier()
#define PG8_SCHED __builtin_amdgcn_sched_barrier(0)
    Unit cur, nxt; int ui = 0;
    if (!S.next(0, cur)) return;
    f32x4 acc[2][2][4][2];
#pragma unroll
    for (int a = 0; a < 2; ++a)
#pragma unroll
        for (int b = 0; b < 2; ++b)
#pragma unroll
            for (int m = 0; m < 4; ++m)
#pragma unroll
                for (int n = 0; n < 2; ++n) acc[a][b][m][n] = (f32x4){0.f, 0.f, 0.f, 0.f};
    bf16x8 At[4][2], B0[2][2], B1[2][2];
    const char* cA = (const char*)g.A + (size_t)cur.pm * tstep; const char* cB = (const char*)g.Bt + (size_t)cur.pn * tstep;
    S.a_ready(cur);
    if constexpr (SP2) {
        PG8_STAGE(PG8_SB(0, 0), cB, voffB); PG8_STAGE(PG8_SB(0, 1), cB + hstep, voffB); PG8_STAGE(PG8_SA(0, 0), cA, voffA); PG8_STAGE(PG8_SA(0, 1), cA + hstep, voffA);
        if (wr == 1) PG8_BAR;
        PG8_WAIT_V(2); PG8_BAR;
        PG8_STAGE(PG8_SB(1, 0), cB + kstep, voffB); PG8_STAGE(PG8_SA(1, 0), cA + kstep, voffA); PG8_STAGE(PG8_SB(1, 1), cB + hstep + kstep, voffB);
        PG8_WAIT_V(6); PG8_BAR;
    } else {
        PG8_STAGE(PG8_SB(0, 0), cB, voffB); PG8_STAGE(PG8_SA(0, 0), cA, voffA); PG8_STAGE(PG8_SB(0, 1), cB + hstep, voffB); PG8_STAGE(PG8_SA(0, 1), cA + hstep, voffA);
        if (wr == 1) PG8_BAR;
        PG8_WAIT_V(4); PG8_BAR;
        PG8_STAGE(PG8_SB(1, 0), cB + kstep, voffB); PG8_STAGE(PG8_SA(1, 0), cA + kstep, voffA); PG8_STAGE(PG8_SB(1, 1), cB + hstep + kstep, voffB);
        PG8_WAIT_V(6); PG8_BAR;
    }
    for (;;) {
        const bool has_next = S.next(ui + 1, nxt);
        const char* nA = has_next ? (const char*)g.A + (size_t)nxt.pm * tstep : cA; const char* nB = has_next ? (const char*)g.Bt + (size_t)nxt.pn * tstep : cB;
        for (int t = 0; t < nt; t += 2) {
            const bool last = (t == nt - 2);
            const char* a1 = cA + (size_t)(t + 1) * kstep;
            const char* a2 = last ? nA : cA + (size_t)(t + 2) * kstep; const char* b2 = last ? nB : cB + (size_t)(t + 2) * kstep;
            const char* a3 = a2 + kstep; const char* b3 = b2 + kstep;
            if (last && has_next) S.a_ready(nxt);
            if constexpr (SP2) {
            PG8_LDB(B0, 0, 0); PG8_LDB(B1, 0, 1); PG8_SCHED; PG8_LDA(At, 0, 0); PG8_STAGE(PG8_SA(1, 1), a1 + hstep, voffA);
            PG8_WAIT_V(8); PG8_WAIT_L(0); PG8_BAR; PG8_MMA(0, 0, At, B0); PG8_MMA(0, 1, At, B1); PG8_BAR; PG8_SCHED;
            PG8_LDA(At, 0, 1); PG8_STAGE(PG8_SB(0, 0), b2, voffB); PG8_STAGE(PG8_SB(0, 1), b2 + hstep, voffB); PG8_STAGE(PG8_SA(0, 0), a2, voffA);
            PG8_WAIT_V(8); PG8_WAIT_L(0); PG8_BAR; PG8_MMA(1, 0, At, B0); PG8_MMA(1, 1, At, B1); PG8_BAR; PG8_SCHED;
            PG8_LDB(B0, 1, 0); PG8_LDB(B1, 1, 1); PG8_SCHED; PG8_LDA(At, 1, 0); PG8_STAGE(PG8_SA(0, 1), a2 + hstep, voffA);
            PG8_WAIT_V(8); PG8_WAIT_L(0); PG8_BAR; PG8_MMA(0, 0, At, B0); PG8_MMA(0, 1, At, B1); PG8_BAR; PG8_SCHED;
            PG8_LDA(At, 1, 1); PG8_STAGE(PG8_SB(1, 0), b3, voffB); PG8_STAGE(PG8_SB(1, 1), b3 + hstep, voffB); PG8_STAGE(PG8_SA(1, 0), a3, voffA);
            PG8_WAIT_V(8); PG8_WAIT_L(0); PG8_BAR; PG8_MMA(1, 0, At, B0); PG8_MMA(1, 1, At, B1); PG8_BAR; PG8_SCHED;
            } else {
            PG8_LDB(B0, 0, 0); PG8_SCHED; PG8_LDA(At, 0, 0); PG8_STAGE(PG8_SA(1, 1), a1 + hstep, voffA);
            PG8_WAIT_L(8); PG8_BAR; PG8_WAIT_L(0); PG8_MMA(0, 0, At, B0); PG8_BAR; PG8_SCHED;
            PG8_LDB(B1, 0, 1); PG8_STAGE(PG8_SB(0, 0), b2, voffB);
            PG8_BAR; PG8_WAIT_L(0); PG8_MMA(0, 1, At, B1); PG8_BAR;
            PG8_LDA(At, 0, 1); PG8_STAGE(PG8_SA(0, 0), a2, voffA);
            PG8_BAR; PG8_WAIT_L(0); PG8_MMA(1, 0, At, B0); PG8_BAR; PG8_SCHED;
            PG8_STAGE(PG8_SB(0, 1), b2 + hstep, voffB);
            PG8_WAIT_V(6); PG8_BAR; PG8_MMA(1, 1, At, B1); PG8_BAR;
            PG8_LDB(B0, 1, 0); PG8_SCHED; PG8_LDA(At, 1, 0); PG8_STAGE(PG8_SA(0, 1), a2 + hstep, voffA);
            PG8_WAIT_L(8); PG8_BAR; PG8_WAIT_L(0); PG8_MMA(0, 0, At, B0); PG8_BAR; PG8_SCHED;
            PG8_LDB(B1, 1, 1); PG8_STAGE(PG8_SB(1, 0), b3, voffB);
            PG8_BAR; PG8_WAIT_L(0); PG8_MMA(0, 1, At, B1); PG8_BAR;
            PG8_LDA(At, 1, 1); PG8_STAGE(PG8_SA(1, 0), a3, voffA);
            PG8_BAR; PG8_WAIT_L(0); PG8_MMA(1, 0, At, B0); PG8_BAR; PG8_SCHED;
            PG8_STAGE(PG8_SB(1, 1), b3 + hstep, voffB);
            PG8_WAIT_V(6); PG8_BAR; PG8_MMA(1, 1, At, B1); PG8_BAR;
            }
        }
        if constexpr (ALIGN_EPI) { if (wr == 0) PG8_BAR; }
        if constexpr (!Epi::AFTER_DRAIN) { E(acc, cur, wr, wc, fr, fq); S.done(cur); }
        if (!has_next) break;
#pragma unroll
        for (int a = 0; a < 2; ++a)
#pragma unroll
            for (int b = 0; b < 2; ++b)
#pragma unroll
                for (int m = 0; m < 4; ++m)
#pragma unroll
                    for (int n = 0; n < 2; ++n) acc[a][b][m][n] = (f32x4){0.f, 0.f, 0.f, 0.f};
        cur = nxt; cA = nA; cB = nB; ++ui;
        if constexpr (ALIGN_EPI) { if (wr == 1) PG8_BAR; }
    }
    PG8_WAIT_V(0);
    if constexpr (!ALIGN_EPI) { if (wr == 0) PG8_BAR; }
    PG8_BAR;
    if constexpr (Epi::AFTER_DRAIN) { E.fused(acc, cur, wr, wc, fr, fq, lds, wid, lane); S.done(cur); }
#undef PG8_SA
#undef PG8_SB
#undef PG8_STAGE
#undef PG8_LDA
#undef PG8_LDB
#undef PG8_MMA
#undef PG8_WAIT_V
#undef PG8_WAIT_L
#undef PG8_BAR
#undef PG8_SCHED
}
}

#define LAS __attribute__((address_space(3)))
typedef unsigned short bf16_t;
typedef short bf16x8 __attribute__((ext_vector_type(8)));
typedef short s16x4 __attribute__((ext_vector_type(4)));
typedef float f32x4 __attribute__((ext_vector_type(4)));
typedef float f32x2 __attribute__((ext_vector_type(2)));
typedef float f32x16 __attribute__((ext_vector_type(16)));
typedef unsigned u32x4 __attribute__((ext_vector_type(4)));
typedef unsigned u32x2 __attribute__((ext_vector_type(2)));

constexpr int MTOK = 65536, DM = 1024, DFF = 2816, NUP = 5632, NINP = 2816, PPITCH = 2560, SEQL = 4096;
constexpr float EPSF = 1e-6f, LOG2E = 1.4426950408889634f;
constexpr size_t MiB = 1u << 20;
constexpr size_t WS_MOD = 1 * MiB, WS_GMOD = 3 * MiB, WS_GATE = 4 * MiB, WS_SB = 5 * MiB, WS_ROWSS = 8 * MiB, WS_KS = 10 * MiB, WS_F2 = 11 * MiB, WS_FG = 12 * MiB,
                 WS_ASEG = 13 * MiB, WS_BSEG = 17 * MiB, WS_WUP = 24 * MiB, WS_WDN = 68 * MiB, WS_WIN = 90 * MiB, WS_WOUT = 101 * MiB, WS_XN = 112 * MiB,
                 WS_H = 240 * MiB, WS_PROJ = 240 * MiB, WS_YU = 592 * MiB, WS_HLOC = 656 * MiB, WS_PCUM = 784 * MiB, WS_YN = 848 * MiB, WS_END = 976 * MiB;
constexpr int LDS_BYTES = 147456;

__device__ __forceinline__ float bf2f(unsigned short v) { return __uint_as_float((unsigned)v << 16); }
__device__ __forceinline__ unsigned f2bf(float f) { unsigned u = __float_as_uint(f); return (u + 0x7fffu + ((u >> 16) & 1u)) >> 16; }
__device__ __forceinline__ unsigned pk2(float lo, float hi) { return pg8::cvt_pk_bf16(lo, hi); }
__device__ __forceinline__ float wave_sum(float v) {
#pragma unroll
    for (int o = 1; o < 64; o <<= 1) v += __shfl_xor(v, o);
    return v;
}
__device__ __forceinline__ float sigmoidf_(float x) { return __builtin_amdgcn_rcpf(1.0f + __builtin_amdgcn_exp2f(-LOG2E * x)); }
#define WAITV(n) asm volatile("s_waitcnt vmcnt(" #n ")" ::: "memory")
#define LBAR() asm volatile("s_waitcnt lgkmcnt(0)\n\ts_barrier" ::: "memory")
#define CFENCE() asm volatile("" ::: "memory")

#ifndef REP_FIN
#define REP_FIN 1
#endif
#ifndef REP_PREP
#define REP_PREP 1
#endif
#ifndef REP_ATTN
#define REP_ATTN 1
#endif
#ifndef REP_UP
#define REP_UP 1
#endif
struct Args { const float* in[19]; float* out; unsigned char* ws; int ph_lo, ph_hi; };

__device__ __forceinline__ void transpose_item(const float* __restrict__ W, int ldw, int clim, int K, bf16_t* __restrict__ WT, int n0, int c0, int k0, LAS float* scr, int lane) {
    const int col = c0 + (lane & 31);
#pragma unroll 8
    for (int i = 0; i < 32; ++i) { const int kk = 2 * i + (lane >> 5); scr[kk * 33 + (lane & 31)] = (col < clim) ? W[(size_t)(k0 + kk) * ldw + col] : 0.f; }
    asm volatile("s_waitcnt lgkmcnt(0)" ::: "memory");
    const int c = lane & 7;
#pragma unroll
    for (int j = 0; j < 4; ++j) { const int n = (lane >> 3) + 8 * j; const LAS float* s = scr + (8 * c) * 33 + n;
        u32x4 o; o.x = pk2(s[0 * 33], s[1 * 33]); o.y = pk2(s[2 * 33], s[3 * 33]); o.z = pk2(s[4 * 33], s[5 * 33]); o.w = pk2(s[6 * 33], s[7 * 33]);
        *(u32x4*)(WT + (size_t)(n0 + n) * K + k0 + 8 * c) = o; }
    asm volatile("s_waitcnt lgkmcnt(0)" ::: "memory");
}

__device__ __forceinline__ int crow(int r, int hi) { return (r & 3) + 8 * (r >> 2) + 4 * hi; }
__device__ __forceinline__ s16x4 vtr(const LAS unsigned char* p) {
    typedef short v4i16_t __attribute__((ext_vector_type(4)));
    return __builtin_bit_cast(s16x4, __builtin_amdgcn_ds_read_tr16_b64_v4i16((LAS v4i16_t*)p));
}
constexpr int AT_SLOT = 16384, AT_AUX = 3 * AT_SLOT, AT_WSF = AT_AUX + 3 * 512, AT_VOTE = AT_WSF + 8 * 256;
constexpr float C2 = 0.125f * LOG2E;

__device__ __forceinline__ void sb_block(f32x16& X, float& carry, bool band, int kv0  , int qrel, int hi) {
    float lm[16];
#pragma unroll
    for (int r = 0; r < 16; ++r) {
        float z2 = X[r] * C2; z2 = __builtin_fminf(__builtin_fmaxf(z2, -120.f), 120.f);
        const float e = __builtin_amdgcn_exp2f(-z2), sp = __builtin_amdgcn_logf(1.0f + e);
        float l1 = -(sp + z2), lb = -sp;
        if (band) { const int kv = kv0 + (r & 3) + 8 * (r >> 2); const bool valid = kv < qrel; l1 = valid ? l1 : 0.f; lb = valid ? lb : -INFINITY; }
        lm[r] = l1; X[r] = lb;
    }
    float G[4], Gp[4], T[4];
#pragma unroll
    for (int g = 0; g < 4; ++g) { G[g] = (lm[4 * g] + lm[4 * g + 1]) + (lm[4 * g + 2] + lm[4 * g + 3]); Gp[g] = __shfl_xor(G[g], 32); T[g] = G[g] + Gp[g]; }
    float S = carry;
#pragma unroll
    for (int g = 3; g >= 0; --g) {
        const float a3 = S + (hi == 0 ? Gp[g] : 0.f), a2 = a3 + lm[4 * g + 3], a1 = a2 + lm[4 * g + 2], a0 = a1 + lm[4 * g + 1];
        X[4 * g + 3] = __builtin_amdgcn_exp2f(X[4 * g + 3] + a3); X[4 * g + 2] = __builtin_amdgcn_exp2f(X[4 * g + 2] + a2);
        X[4 * g + 1] = __builtin_amdgcn_exp2f(X[4 * g + 1] + a1); X[4 * g] = __builtin_amdgcn_exp2f(X[4 * g] + a0);
        S += T[g];
    }
    carry = S;
}

template <int KIND>
__device__ __forceinline__ void attn_unit(LAS unsigned char* lds, const bf16_t* __restrict__ PROJ, bf16_t* __restrict__ YU, const float* __restrict__ KS,
                                          const float* __restrict__ F2, const float* __restrict__ gqk, int b, int h, int qb) {
    int tid_o = threadIdx.x; asm volatile("" : "+v"(tid_o));
    const int tid = tid_o, lane = tid & 63, r32 = lane & 31, hi = lane >> 5;
    const int wid = __builtin_amdgcn_readfirstlane(tid >> 6);
    const int qcol = (KIND == 0 ? 1024 : 1792) + h * 64, kcol = qcol + 256, vcol = qcol + 512;
    const size_t rowbase = (size_t)b * SEQL; const int q0 = qb * 256, bh = b * 4 + h;
    const int NT = (q0 + 256) / 64;
    const bf16_t* ksrc = PROJ + (rowbase + lane) * PPITCH + kcol + wid * 8;
    const bf16_t* vsrc = PROJ + (rowbase + 16 * (wid & 3) + (lane >> 2)) * PPITCH + vcol + (wid >> 2) * 32 + (lane & 3) * 8;
    const float* axsrc = (wid == 0 ? KS : F2) + (size_t)bh * SEQL + lane;
    u32x4 kreg, vreg; float areg = 0.f;
#define AT_LOAD(it_) do { const int kt_ = NT - 1 - (it_); kreg = *(const u32x4*)(ksrc + (size_t)kt_ * 64 * PPITCH); vreg = *(const u32x4*)(vsrc + (size_t)kt_ * 64 * PPITCH); \
        if (KIND == 1 && wid < 2) areg = axsrc[kt_ * 64]; } while (0)
#define AT_STORE(slot_) do { *(LAS u32x4*)(lds + (slot_) * AT_SLOT + wid * 1024 + lane * 16) = kreg; *(LAS u32x4*)(lds + (slot_) * AT_SLOT + 8192 + wid * 1024 + lane * 16) = vreg; \
        if (KIND == 1 && wid < 2) *(LAS float*)(lds + AT_AUX + (slot_) * 512 + wid * 256 + lane * 4) = areg; } while (0)
    const bf16_t* Qw = PROJ + (rowbase + q0 + wid * 32 + r32) * PPITCH + qcol + hi * 8;
    bf16x8 qr[4];
#pragma unroll
    for (int d0 = 0; d0 < 4; ++d0) qr[d0] = *(const bf16x8*)(Qw + d0 * 16);
    float Ft = 0.f;
    if (KIND == 1) Ft = F2[(size_t)bh * SEQL + q0 + wid * 32 + r32];
    AT_LOAD(0);
    if (KIND == 1) {
        float qf[4][8]; float ss = 0.f;
#pragma unroll
        for (int d0 = 0; d0 < 4; ++d0)
#pragma unroll
            for (int i = 0; i < 8; ++i) { qf[d0][i] = bf2f((unsigned short)qr[d0][i]); ss += qf[d0][i] * qf[d0][i]; }
        ss += __shfl_xor(ss, 32);
        const float rs = __builtin_amdgcn_rsqf(ss * (1.0f / 64.0f) + EPSF) * C2;
#pragma unroll
        for (int d0 = 0; d0 < 4; ++d0) {
            const float* gp = gqk + d0 * 16 + hi * 8; float v[8];
#pragma unroll
            for (int i = 0; i < 8; ++i) v[i] = qf[d0][i] * rs * gp[i] * gp[64 + i];
            u32x4 w; w.x = pk2(v[0], v[1]); w.y = pk2(v[2], v[3]); w.z = pk2(v[4], v[5]); w.w = pk2(v[6], v[7]);
            qr[d0] = __builtin_bit_cast(bf16x8, w);
        }
    }
    f32x16 o0, o1;
#pragma unroll
    for (int r = 0; r < 16; ++r) { o0[r] = 0.f; o1[r] = 0.f; }
    float mhat = -1e30f, lsum = 0.f, carry = 0.f;
    LAS float* wsf = (LAS float*)(lds + AT_WSF) + wid * 64;
    LAS unsigned* votes = (LAS unsigned*)(lds + AT_VOTE);
    const int qrel = wid * 32 + r32;
    AT_STORE(0); LBAR();
    for (int it = 0; it < NT; ++it) {
        const int slot = it & 1;
        if (KIND == 0 && it > 0) {
            const LAS unsigned* vp = votes + ((it - 1) & 1) * 8;
            const unsigned all = vp[0] & vp[1] & vp[2] & vp[3] & vp[4] & vp[5] & vp[6] & vp[7];
            if (all) break;
        }
        if (it + 1 < NT) AT_LOAD(it + 1);
        const int kt = NT - 1 - it, jb = kt - (NT - 4);
        const bool band = jb >= 0;
        const bool active = !(band && 64 * jb > 32 * wid + 31);
        if (active) {
            f32x16 p0, p1;
            { const LAS unsigned char* kb = lds + slot * AT_SLOT + hi * 1024 + r32 * 16;
#pragma unroll
              for (int d0 = 0; d0 < 4; ++d0) {
                  const bf16x8 b0 = *(const LAS bf16x8*)(kb + d0 * 2048), b1 = *(const LAS bf16x8*)(kb + d0 * 2048 + 512);
                  if (d0 == 0) { f32x16 z;
#pragma unroll
                      for (int r = 0; r < 16; ++r) z[r] = 0.f;
                      p0 = __builtin_amdgcn_mfma_f32_32x32x16_bf16(b0, qr[0], z, 0, 0, 0); p1 = __builtin_amdgcn_mfma_f32_32x32x16_bf16(b1, qr[0], z, 0, 0, 0); }
                  else { p0 = __builtin_amdgcn_mfma_f32_32x32x16_bf16(b0, qr[d0], p0, 0, 0, 0); p1 = __builtin_amdgcn_mfma_f32_32x32x16_bf16(b1, qr[d0], p1, 0, 0, 0); }
              } }
            if (KIND == 0) {
                sb_block(p1, carry, band, 64 * jb + 32 + 4 * hi, qrel, hi);
                sb_block(p0, carry, band, 64 * jb + 4 * hi, qrel, hi);
            } else {
                const LAS float* ax = (const LAS float*)(lds + AT_AUX + slot * 512);
#pragma unroll
                for (int g = 0; g < 4; ++g) {
                    const f32x4 k0 = *(const LAS f32x4*)(ax + 8 * g + 4 * hi), k1 = *(const LAS f32x4*)(ax + 32 + 8 * g + 4 * hi);
                    const f32x4 f0 = *(const LAS f32x4*)(ax + 64 + 8 * g + 4 * hi), f1 = *(const LAS f32x4*)(ax + 96 + 8 * g + 4 * hi);
#pragma unroll
                    for (int i = 0; i < 4; ++i) { p0[4 * g + i] = p0[4 * g + i] * k0[i] + (Ft - f0[i]); p1[4 * g + i] = p1[4 * g + i] * k1[i] + (Ft - f1[i]); }
                }
                if (band) {
#pragma unroll
                    for (int r = 0; r < 16; ++r) { const int kv = 64 * jb + crow(r, hi); if (kv > qrel) p0[r] = -INFINITY; if (kv + 32 > qrel) p1[r] = -INFINITY; }
                }
                float rm = p0[0];
#pragma unroll
                for (int r = 1; r < 16; ++r) rm = __builtin_fmaxf(rm, p0[r]);
#pragma unroll
                for (int r = 0; r < 16; ++r) rm = __builtin_fmaxf(rm, p1[r]);
                rm = __builtin_fmaxf(rm, __shfl_xor(rm, 32));
                if (__any(rm > mhat + 8.0f)) {
                    const float mnew = __builtin_fmaxf(mhat, rm), f = __builtin_amdgcn_exp2f(mhat - mnew);
                    lsum *= f; mhat = mnew;
                    CFENCE(); if (hi == 0) wsf[r32] = f; CFENCE();
                    asm volatile("s_waitcnt lgkmcnt(0)" ::: "memory");
#pragma unroll
                    for (int r = 0; r < 16; ++r) { const float fr_ = wsf[crow(r, hi)]; o0[r] *= fr_; o1[r] *= fr_; }
                    CFENCE();
                }
                float sacc = 0.f;
#pragma unroll
                for (int r = 0; r < 16; ++r) { p0[r] = __builtin_amdgcn_exp2f(p0[r] - mhat); p1[r] = __builtin_amdgcn_exp2f(p1[r] - mhat); sacc += p0[r] + p1[r]; }
                lsum += sacc;
            }
            u32x4 pw0, pw1, pw2, pw3;
            pw0.x = pk2(p0[0], p0[1]); pw0.y = pk2(p0[2], p0[3]); pw0.z = pk2(p0[4], p0[5]); pw0.w = pk2(p0[6], p0[7]);
            pw1.x = pk2(p0[8], p0[9]); pw1.y = pk2(p0[10], p0[11]); pw1.z = pk2(p0[12], p0[13]); pw1.w = pk2(p0[14], p0[15]);
            pw2.x = pk2(p1[0], p1[1]); pw2.y = pk2(p1[2], p1[3]); pw2.z = pk2(p1[4], p1[5]); pw2.w = pk2(p1[6], p1[7]);
            pw3.x = pk2(p1[8], p1[9]); pw3.y = pk2(p1[10], p1[11]); pw3.z = pk2(p1[12], p1[13]); pw3.w = pk2(p1[14], p1[15]);
            const LAS unsigned char* vb = lds + slot * AT_SLOT + 8192 + ((lane >> 4) & 1) * 32 + (lane & 3) * 8 + (4 * hi + ((lane & 15) >> 2)) * 64;
            s16x4 vlo[8], vhi[8];
#pragma unroll
            for (int i = 0; i < 8; ++i) { vlo[i] = vtr(vb + (i >> 2) * 4096 + (i & 3) * 1024); vhi[i] = vtr(vb + (i >> 2) * 4096 + (i & 3) * 1024 + 512); }
#define VFR(i) (bf16x8){vlo[i][0], vlo[i][1], vlo[i][2], vlo[i][3], vhi[i][0], vhi[i][1], vhi[i][2], vhi[i][3]}
#define PAF(x) __builtin_bit_cast(bf16x8, x)
            o0 = __builtin_amdgcn_mfma_f32_32x32x16_bf16(PAF(pw0), VFR(0), o0, 0, 0, 0); o1 = __builtin_amdgcn_mfma_f32_32x32x16_bf16(PAF(pw0), VFR(4), o1, 0, 0, 0);
            o0 = __builtin_amdgcn_mfma_f32_32x32x16_bf16(PAF(pw1), VFR(1), o0, 0, 0, 0); o1 = __builtin_amdgcn_mfma_f32_32x32x16_bf16(PAF(pw1), VFR(5), o1, 0, 0, 0);
            o0 = __builtin_amdgcn_mfma_f32_32x32x16_bf16(PAF(pw2), VFR(2), o0, 0, 0, 0); o1 = __builtin_amdgcn_mfma_f32_32x32x16_bf16(PAF(pw2), VFR(6), o1, 0, 0, 0);
            o0 = __builtin_amdgcn_mfma_f32_32x32x16_bf16(PAF(pw3), VFR(3), o0, 0, 0, 0); o1 = __builtin_amdgcn_mfma_f32_32x32x16_bf16(PAF(pw3), VFR(7), o1, 0, 0, 0);
#undef VFR
#undef PAF
        }
        if (KIND == 0) { const unsigned done = (active && __all(carry < -150.0f)) ? 1u : 0u; if (lane == 0) votes[(it & 1) * 8 + wid] = done; }
        if (it + 1 < NT) AT_STORE(slot ^ 1);
        LBAR();
    }
    if (KIND == 1) { lsum += __shfl_xor(lsum, 32); CFENCE(); if (hi == 0) wsf[r32] = lsum; CFENCE(); asm volatile("s_waitcnt lgkmcnt(0)" ::: "memory"); }
    bf16_t* Yw = YU + (rowbase + q0 + wid * 32) * 512 + KIND * 256 + h * 64 + r32;
#pragma unroll
    for (int r = 0; r < 16; ++r) {
        const int orow = crow(r, hi); float sc = 1.0f;
        if (KIND == 1) sc = __builtin_amdgcn_rcpf(wsf[orow]);
        Yw[(size_t)orow * 512] = (bf16_t)f2bf(o0[r] * sc); Yw[(size_t)orow * 512 + 32] = (bf16_t)f2bf(o1[r] * sc);
    }
    LBAR();
#undef AT_LOAD
#undef AT_STORE
}

#define DEFPTRS \
    const __attribute__((address_space(4))) Args* ka_ = (const __attribute__((address_space(4))) Args*)__builtin_amdgcn_kernarg_segment_ptr(); \
    asm volatile("" : "+s"(ka_)); \
    int tid_o_ = threadIdx.x; asm volatile("" : "+v"(tid_o_)); const int tid = tid_o_, lane = tid & 63; (void)lane; \
    unsigned char* ws = ka_->ws; \
    const float* x_in = ka_->in[0]; const float* c_in = ka_->in[1]; const float* w_ada = ka_->in[2]; const float* b_ada = ka_->in[3]; const float* g_norm = ka_->in[4]; \
    const float* w_up = ka_->in[5]; const float* w_dn = ka_->in[6]; const float* w_in = ka_->in[7]; const float* b_fg = ka_->in[8]; const float* conv_w = ka_->in[9]; \
    const float* conv_b = ka_->in[10]; const float* w_rg = ka_->in[11]; const float* b_rg = ka_->in[12]; const float* w_ig = ka_->in[13]; const float* b_ig = ka_->in[14]; \
    const float* lam = ka_->in[15]; const float* g_qk = ka_->in[16]; const float* g_mix = ka_->in[17]; const float* w_out = ka_->in[18]; \
    float* xout = ka_->out; \
    float* MOD = (float*)(ws + WS_MOD); float* GMOD = (float*)(ws + WS_GMOD); float* GATE = (float*)(ws + WS_GATE); float* SBV = (float*)(ws + WS_SB); \
    float* ROWSS = (float*)(ws + WS_ROWSS); float* KS = (float*)(ws + WS_KS); float* F2 = (float*)(ws + WS_F2); float* FG = (float*)(ws + WS_FG); \
    float* ASEG = (float*)(ws + WS_ASEG); float* BSEG = (float*)(ws + WS_BSEG); \
    bf16_t* WUP = (bf16_t*)(ws + WS_WUP); bf16_t* WDN = (bf16_t*)(ws + WS_WDN); bf16_t* WIN = (bf16_t*)(ws + WS_WIN); bf16_t* WOUT = (bf16_t*)(ws + WS_WOUT); \
    bf16_t* XN = (bf16_t*)(ws + WS_XN); bf16_t* HB = (bf16_t*)(ws + WS_H); bf16_t* PROJ = (bf16_t*)(ws + WS_PROJ); bf16_t* YU = (bf16_t*)(ws + WS_YU); \
    float* HLOC = (float*)(ws + WS_HLOC); bf16_t* PCUM = (bf16_t*)(ws + WS_PCUM); bf16_t* YN = (bf16_t*)(ws + WS_YN);
__global__ void __launch_bounds__(512) mk_fwd(Args args) {
    extern __shared__ __attribute__((aligned(16))) unsigned char lds_raw[];
    LAS unsigned char* lds = (LAS unsigned char*)lds_raw;
    cg::grid_group grid = cg::this_grid();
    const int wave = __builtin_amdgcn_readfirstlane(threadIdx.x >> 6);
    const int G = gridDim.x; const int bx = blockIdx.x;
    const int vcu = (G % 8 == 0) ? (bx % 8) * (G / 8) + bx / 8 : bx;
    const int gw = vcu * 8 + wave, NGW = G * 8;
    const int lo = args.ph_lo, hi_ph = args.ph_hi;
    int ph = 0;
#define PH_ON (ph >= lo && ph < hi_ph)
#ifdef REP_SYNC
#define SYNC_EXTRA grid.sync(); asm volatile("" ::: "memory");
#else
#define SYNC_EXTRA
#endif
#define PH_NEXT do { ++ph; if (ph > lo && ph < hi_ph) { asm volatile("s_waitcnt vmcnt(0) lgkmcnt(0)" ::: "memory"); grid.sync(); asm volatile("" ::: "memory"); SYNC_EXTRA } } while (0)

#ifdef REP_PRO
    int rp_ = 0; pro_again:
#endif
    if (PH_ON) { DEFPTRS
        for (int i = bx * 512 + tid; i < 5 * MTOK; i += G * 512) ROWSS[MTOK + i] = 0.f;
        LAS float* cact = (LAS float*)lds;
        LAS float* red = (LAS float*)(lds + 65536);
        for (int i = tid; i < 16 * 1024; i += 512) { const int b = i >> 10, k = i & 1023; const float v = c_in[i]; cact[k * 16 + b] = v * sigmoidf_(v); }
        __syncthreads();
        for (int task = bx; task < 288; task += G) {
            const int l = task / 144, n0 = (task % 144) * 64;
            float acc[16];
#pragma unroll
            for (int b = 0; b < 16; ++b) acc[b] = 0.f;
            const float* wp = w_ada + (size_t)l * 1024 * 9216 + n0 + lane;
#pragma unroll 4
            for (int k = wave * 128; k < wave * 128 + 128; ++k) {
                const float w = wp[(size_t)k * 9216];
                const f32x4 c0 = *(const LAS f32x4*)(cact + k * 16), c1 = *(const LAS f32x4*)(cact + k * 16 + 4), c2 = *(const LAS f32x4*)(cact + k * 16 + 8), c3 = *(const LAS f32x4*)(cact + k * 16 + 12);
#pragma unroll
                for (int i = 0; i < 4; ++i) { acc[i] += c0[i] * w; acc[4 + i] += c1[i] * w; acc[8 + i] += c2[i] * w; acc[12 + i] += c3[i] * w; }
            }
#pragma unroll
            for (int b = 0; b < 16; ++b) red[(wave * 16 + b) * 64 + lane] = acc[b];
            __syncthreads();
            for (int o = tid; o < 1024; o += 512) { const int b = o >> 6, ln = o & 63; float s = 0.f;
#pragma unroll
                for (int w = 0; w < 8; ++w) s += red[(w * 16 + b) * 64 + ln];
                MOD[((size_t)l * 16 + b) * 9216 + n0 + ln] = s + b_ada[l * 9216 + n0 + ln]; }
            __syncthreads();
        }
    }
    PH_NEXT;
    if (PH_ON) { DEFPTRS
        for (int i = bx * 512 + tid; i < 2 * 3 * 16 * 1024; i += G * 512) {
            const int k = i & 1023, b = (i >> 10) & 15, lj = i >> 14, l = lj / 3, j = lj % 3;
            const float* mp = MOD + ((size_t)l * 16 + b) * 9216 + j * 3072;
            GMOD[i] = g_norm[(l * 3 + j) * 1024 + k] * (1.0f + mp[1024 + k]);
            GATE[i] = (j == 1 ? 1.0f : 0.5f) * (1.0f + mp[2048 + k]);
        }
        LAS float* scr = (LAS float*)(lds + wave * 8448);
        constexpr int I_UP = 16 * 176, I_DN = 44 * 32, I_IN = 16 * 88, I_OUT = 16 * 32;
        constexpr int NIT = 4 * I_UP + 4 * I_DN + 2 * I_IN + 2 * I_OUT;
        for (int it = gw; it < NIT; it += NGW) {
            int r = it;
            if (r < 4 * I_UP) { const int mat = r / I_UP; r -= mat * I_UP; const int kb = r / 176, nb = r % 176, n0 = nb * 32;
                const int c0 = ((n0 >> 7) & 1) * DFF + (n0 >> 8) * 128 + (n0 & 127);
                transpose_item(w_up + (size_t)mat * DM * NUP, NUP, NUP, DM, WUP + (size_t)mat * NUP * DM, n0, c0, kb * 64, scr, lane); continue; }
            r -= 4 * I_UP;
            if (r < 4 * I_DN) { const int mat = r / I_DN; r -= mat * I_DN; const int kb = r / 32, nb = r % 32;
                transpose_item(w_dn + (size_t)mat * DFF * DM, DM, DM, DFF, WDN + (size_t)mat * DM * DFF, nb * 32, nb * 32, kb * 64, scr, lane); continue; }
            r -= 4 * I_DN;
            if (r < 2 * I_IN) { const int mat = r / I_IN; r -= mat * I_IN; const int kb = r / 88, nb = r % 88;
                transpose_item(w_in + (size_t)mat * DM * 2564, 2564, 2564, DM, WIN + (size_t)mat * NINP * DM, nb * 32, nb * 32, kb * 64, scr, lane); continue; }
            r -= 2 * I_IN;
            { const int mat = r / I_OUT; r -= mat * I_OUT; const int kb = r / 32, nb = r % 32;
                transpose_item(w_out + (size_t)mat * DM * DM, DM, DM, DM, WOUT + (size_t)mat * DM * DM, nb * 32, nb * 32, kb * 64, scr, lane); }
        }
        for (int m = gw; m < MTOK; m += NGW) {
            const int b = m >> 12;
            const f32x4* xr = (const f32x4*)(x_in + (size_t)m * DM) + lane;
            const f32x4* gp = (const f32x4*)(g_norm) + lane;
            const f32x4* sp = (const f32x4*)(MOD + (size_t)b * 9216 + 1024) + lane;
            float s = 0.f; u32x2* o8 = (u32x2*)(XN + (size_t)m * DM) + lane;
#pragma unroll
            for (int j = 0; j < 4; ++j) { const f32x4 v = xr[64 * j]; s += (v[0] * v[0] + v[1] * v[1]) + (v[2] * v[2] + v[3] * v[3]);
                const f32x4 a = v * gp[64 * j] * (sp[64 * j] + 1.0f); u32x2 w; w.x = pk2(a[0], a[1]); w.y = pk2(a[2], a[3]); o8[64 * j] = w; }
            s = wave_sum(s);
            if (lane == 0) ROWSS[m] = s;
        }
    }
    PH_NEXT;
    if (PH_ON) { DEFPTRS
        LAS float* sh = (LAS float*)lds;
        for (int combo = 0; combo < 6; ++combo) {
            const int l = combo / 3, j = combo % 3;
            __syncthreads();
            for (int i = tid; i < 16 * 1024; i += 512) { const int b = i >> 10, k = i & 1023; sh[i] = MOD[((size_t)l * 16 + b) * 9216 + j * 3072 + k]; }
            __syncthreads();
            const bf16_t* Wt = (j == 1) ? WIN + (size_t)l * NINP * DM : WUP + (size_t)(l * 2 + (j == 2 ? 1 : 0)) * NUP * DM;
            const int N = (j == 1) ? NINP : NUP;
            float* dst = SBV + (size_t)combo * 16 * 5632;
            for (int n = gw; n < N; n += NGW) {
                float w[16];
#pragma unroll
                for (int c = 0; c < 4; ++c) { const u32x2 q = *(const u32x2*)(Wt + (size_t)n * DM + c * 256 + lane * 4);
                    w[4 * c] = __uint_as_float(q.x << 16); w[4 * c + 1] = __uint_as_float(q.x & 0xffff0000u); w[4 * c + 2] = __uint_as_float(q.y << 16); w[4 * c + 3] = __uint_as_float(q.y & 0xffff0000u); }
                float keep = 0.f;
#pragma unroll 1
                for (int b = 0; b < 16; ++b) { float s = 0.f;
#pragma unroll
                    for (int c = 0; c < 4; ++c) { const f32x4 v = *(const LAS f32x4*)(sh + b * 1024 + c * 256 + lane * 4); s += (w[4 * c] * v[0] + w[4 * c + 1] * v[1]) + (w[4 * c + 2] * v[2] + w[4 * c + 3] * v[3]); }
                    s = wave_sum(s); if (lane == b) keep = s; }
                if (lane < 16) dst[(size_t)lane * 5632 + n] = keep;
            }
        }
        __syncthreads();
    }
    PH_NEXT;

#ifdef REP_PRO
    if (rp_ == 0) { rp_ = 1; ph = 0; goto pro_again; }
#endif
#pragma unroll 1
    for (int f = 0; f < 4; ++f) {
        const int l = f >> 1, s = f & 1;
        if (s == 1) {
            if (PH_ON) { DEFPTRS
                pg8::Gemm g{XN, WIN + (size_t)l * NINP * DM, MTOK, NINP, DM}; pg8::StaticOrder S; S.init(MTOK, NINP, G, bx);
                pg8::EpiIn E{PROJ, FG, ROWSS + (size_t)(l * 3 + 1) * MTOK, SBV + (size_t)(l * 3 + 1) * 16 * 5632};
#ifndef NO_G_IN
                pg8::gemm_phase<pg8::EpiIn, pg8::StaticOrder, true, true>(lds, g, S, E);
#endif
            }
            PH_NEXT;
            if (PH_ON) { DEFPTRS
#ifndef NO_PREP
                const int blk = gw & 7, ch = blk * 64 + lane;
                LAS float* ul = (LAS float*)(lds + wave * 8448);
                LAS float* xs = ul + 64;
                f32x2 w2[64];
#pragma unroll
                for (int i = 0; i < 64; ++i) { const size_t o = ((size_t)(l * 8 + blk) * 64 + i) * 64 + lane; w2[i] = (f32x2){w_rg[o], w_ig[o]}; }
                const float br = b_rg[l * 512 + ch], bi = b_ig[l * 512 + ch], cb = conv_b[l * 512 + ch];
                const float cw0 = conv_w[(l * 4 + 0) * 512 + ch], cw1 = conv_w[(l * 4 + 1) * 512 + ch], cw2 = conv_w[(l * 4 + 2) * 512 + ch], cw3 = conv_w[(l * 4 + 3) * 512 + ch];
                const float lmv = lam[l * 512 + ch];
                const float spl = __builtin_fmaxf(-lmv, 0.f) + log1pf(expf(-fabsf(lmv)));
                const float c8 = -8.0f * spl * LOG2E;
                for (int segi = gw >> 3; segi < REP_PREP * (MTOK / 32); segi += NGW >> 3) { const int seg = segi & (MTOK / 32 - 1);
                    const int row0 = seg * 32; const bf16_t* xp = PROJ + (size_t)row0 * PPITCH + ch;
                    float xm3 = 0.f, xm2 = 0.f, xm1 = 0.f;
                    if ((row0 & (SEQL - 1)) != 0) { xm3 = bf2f(xp[-3 * PPITCH]); xm2 = bf2f(xp[-2 * PPITCH]); xm1 = bf2f(xp[-1 * PPITCH]); }
#pragma unroll
                    for (int t = 0; t < 32; ++t) xs[t * 64 + lane] = bf2f(xp[(size_t)t * PPITCH]);
                    float hs = 0.f, P = 1.f;
                    float* hl = HLOC + (size_t)row0 * 512 + ch; bf16_t* pc = PCUM + (size_t)row0 * 512 + ch;
#pragma unroll 1
                    for (int t = 0; t < 32; ++t) {
                        const float x0 = xs[t * 64 + lane];
                        const float u = cb + cw0 * xm3 + cw1 * xm2 + cw2 * xm1 + cw3 * x0; xm3 = xm2; xm2 = xm1; xm1 = x0;
                        CFENCE(); ul[lane] = u; CFENCE();
                        f32x2 acc = (f32x2){br, bi};
#pragma unroll
                        for (int i4 = 0; i4 < 16; ++i4) { const f32x4 uu = *(const LAS f32x4*)(ul + 4 * i4);
                            acc += w2[4 * i4] * uu[0]; acc += w2[4 * i4 + 1] * uu[1]; acc += w2[4 * i4 + 2] * uu[2]; acc += w2[4 * i4 + 3] * uu[3]; }
                        CFENCE();
                        const float r = sigmoidf_(acc[0]), ig = sigmoidf_(acc[1]);
                        const float la2 = c8 * r, a = __builtin_amdgcn_exp2f(la2);
                        const float xx = 2.0f * 0.6931471805599453f * la2;
                        const float om = (xx > -0.25f) ? -xx * (1.0f + xx * 0.5f * (1.0f + xx * (1.0f / 3.0f) * (1.0f + xx * 0.25f * (1.0f + xx * 0.2f)))) : 1.0f - a * a;
                        const float bt = __builtin_sqrtf(om) * ig * u;
                        hs = a * hs + bt; P *= a;
                        hl[(size_t)t * 512] = hs; pc[(size_t)t * 512] = (bf16_t)f2bf(P);
                    }
                    ASEG[(size_t)seg * 512 + ch] = P; BSEG[(size_t)seg * 512 + ch] = hs;
                }
                for (int row = gw; row < MTOK; row += NGW) {
                    const u32x2 q = *(const u32x2*)(PROJ + (size_t)row * PPITCH + 2048 + lane * 4);
                    const float a0 = __uint_as_float(q.x << 16), a1 = __uint_as_float(q.x & 0xffff0000u), a2 = __uint_as_float(q.y << 16), a3 = __uint_as_float(q.y & 0xffff0000u);
                    float ss = (a0 * a0 + a1 * a1) + (a2 * a2 + a3 * a3);
                    ss += __shfl_xor(ss, 1); ss += __shfl_xor(ss, 2); ss += __shfl_xor(ss, 4); ss += __shfl_xor(ss, 8);
                    if ((lane & 15) == 0) KS[(size_t)((row >> 12) * 4 + (lane >> 4)) * SEQL + (row & (SEQL - 1))] = __builtin_amdgcn_rsqf(ss * (1.0f / 64.0f) + EPSF);
                }
                if (wave == 0) for (int chn = vcu; chn < 64; chn += G) {
                    const int b = chn >> 2, h = chn & 3; const float bf = b_fg[l * 4 + h];
                    const float* fp = FG + ((size_t)b * SEQL + lane * 64) * 4 + h;
                    float tot = 0.f;
#pragma unroll 8
                    for (int i = 0; i < 64; ++i) { const float v = fp[i * 4] + bf; tot += __builtin_fminf(v, 0.f) - log1pf(expf(-fabsf(v))); }
                    float inc = tot;
#pragma unroll
                    for (int o = 1; o < 64; o <<= 1) { const float t_ = __shfl_up(inc, o); if (lane >= o) inc += t_; }
                    float run = inc - tot;
                    float* op = F2 + (size_t)chn * SEQL + lane * 64;
#pragma unroll 8
                    for (int i = 0; i < 64; ++i) { const float v = fp[i * 4] + bf; run += __builtin_fminf(v, 0.f) - log1pf(expf(-fabsf(v))); op[i] = run * LOG2E; }
                }
#endif
                __syncthreads();
            }
            PH_NEXT;
            if (PH_ON) { DEFPTRS
#ifndef NO_ATTN
                for (int rep_ = 0; rep_ < REP_ATTN; ++rep_)
                for (int vw = vcu; vw < 256; vw += G) {
                    const int bh = vw >> 2, s4 = vw & 3, b = bh >> 2, h = bh & 3;
#pragma unroll 1
                    for (int i = 0; i < 4; ++i) { const int qb = (i == 0) ? s4 : (i == 1) ? 7 - s4 : (i == 2) ? 8 + s4 : 15 - s4;
#ifndef NO_FOX
                        attn_unit<1>(lds, PROJ, YU, KS, F2, g_qk + l * 128, b, h, qb);
#endif
 }
#pragma unroll 1
                    for (int i = 0; i < 4; ++i) { const int qb = (i == 0) ? s4 : (i == 1) ? 7 - s4 : (i == 2) ? 8 + s4 : 15 - s4;
#ifndef NO_SB
                        attn_unit<0>(lds, PROJ, YU, KS, F2, g_qk + l * 128, b, h, qb);
#endif
 }
                }
#endif
            }
            PH_NEXT;
            if (PH_ON) { DEFPTRS
                LAS float* hin = (LAS float*)lds;
                const f32x4 gm0 = *(const f32x4*)(g_mix + l * 1024 + lane * 8), gm1 = *(const f32x4*)(g_mix + l * 1024 + lane * 8 + 4);
                const f32x4 gx0 = *(const f32x4*)(g_mix + l * 1024 + 512 + lane * 8), gx1 = *(const f32x4*)(g_mix + l * 1024 + 512 + lane * 8 + 4);
                for (int tti = vcu; tti < REP_FIN * 256; tti += G) { const int tt = tti & 255;
                    __syncthreads();
                    { const int ch = tid, seg0 = (tt >> 4) * 128, nb = (tt & 15) * 8; float Hc = 0.f;
#pragma unroll 8
                      for (int sg = 0; sg < nb; ++sg) Hc = ASEG[(size_t)(seg0 + sg) * 512 + ch] * Hc + BSEG[(size_t)(seg0 + sg) * 512 + ch];
#pragma unroll
                      for (int s8 = 0; s8 < 8; ++s8) { hin[s8 * 512 + ch] = Hc; Hc = ASEG[(size_t)(seg0 + nb + s8) * 512 + ch] * Hc + BSEG[(size_t)(seg0 + nb + s8) * 512 + ch]; } }
                    __syncthreads();
                    const f32x4 hi0 = *(const LAS f32x4*)(hin + wave * 512 + lane * 8), hi1 = *(const LAS f32x4*)(hin + wave * 512 + lane * 8 + 4);
#pragma unroll 2
                    for (int t = 0; t < 32; ++t) {
                        const size_t row = (size_t)tt * 256 + wave * 32 + t;
                        const f32x4 h0 = *(const f32x4*)(HLOC + row * 512 + lane * 8), h1 = *(const f32x4*)(HLOC + row * 512 + lane * 8 + 4);
                        const u32x4 pq = *(const u32x4*)(PCUM + row * 512 + lane * 8);
                        const u32x4 gq = *(const u32x4*)(PROJ + row * PPITCH + 512 + lane * 8);
                        const u32x4 yq = *(const u32x4*)(YU + row * 512 + lane * 8);
                        float y[8], yu[8]; float ss = 0.f, s2 = 0.f;
#pragma unroll
                        for (int i = 0; i < 8; ++i) {
                            const unsigned pw = pq[i >> 1], gw_ = gq[i >> 1], yw = yq[i >> 1];
                            const float p = (i & 1) ? __uint_as_float(pw & 0xffff0000u) : __uint_as_float(pw << 16);
                            const float gg = (i & 1) ? __uint_as_float(gw_ & 0xffff0000u) : __uint_as_float(gw_ << 16);
                            yu[i] = (i & 1) ? __uint_as_float(yw & 0xffff0000u) : __uint_as_float(yw << 16);
                            const float hh = (i < 4 ? h0[i & 3] : h1[i & 3]) + p * (i < 4 ? hi0[i & 3] : hi1[i & 3]);
                            const float inner = 0.7978845608028654f * (gg + 0.044715f * gg * gg * gg);
                            const float ge = gg * __builtin_amdgcn_rcpf(1.0f + __builtin_amdgcn_exp2f(-2.0f * LOG2E * inner));
                            y[i] = hh * ge; ss += y[i] * y[i]; s2 += yu[i] * yu[i];
                        }
                        ss = wave_sum(ss);
                        s2 += __shfl_xor(s2, 1); s2 += __shfl_xor(s2, 2); s2 += __shfl_xor(s2, 4); s2 += __shfl_xor(s2, 8); s2 += __shfl_xor(s2, 16);
                        const float rl = __builtin_amdgcn_rsqf(ss * (1.0f / 512.0f) + EPSF), rx = __builtin_amdgcn_rsqf(s2 * (1.0f / 256.0f) + EPSF);
                        u32x4 o1, o2;
                        o1.x = pk2(y[0] * rl * gm0[0], y[1] * rl * gm0[1]); o1.y = pk2(y[2] * rl * gm0[2], y[3] * rl * gm0[3]);
                        o1.z = pk2(y[4] * rl * gm1[0], y[5] * rl * gm1[1]); o1.w = pk2(y[6] * rl * gm1[2], y[7] * rl * gm1[3]);
                        o2.x = pk2(yu[0] * rx * gx0[0], yu[1] * rx * gx0[1]); o2.y = pk2(yu[2] * rx * gx0[2], yu[3] * rx * gx0[3]);
                        o2.z = pk2(yu[4] * rx * gx1[0], yu[5] * rx * gx1[1]); o2.w = pk2(yu[6] * rx * gx1[2], yu[7] * rx * gx1[3]);
                        *(u32x4*)(YN + row * 1024 + lane * 8) = o1; *(u32x4*)(YN + row * 1024 + 512 + lane * 8) = o2;
                    }
                }
                __syncthreads();
            }
            PH_NEXT;
            if (PH_ON) { DEFPTRS
                pg8::Gemm g{YN, WOUT + (size_t)l * DM * DM, MTOK, DM, DM}; pg8::StaticOrder S; S.init(MTOK, DM, G, bx);
                pg8::EpiRes E{xout, xout, GATE + (size_t)(l * 3 + 1) * 16 * 1024, GMOD + (size_t)(l * 3 + 2) * 16 * 1024, XN, ROWSS + (size_t)(l * 3 + 2) * MTOK, 1};
#ifndef NO_G_OUT
                pg8::gemm_phase<pg8::EpiRes, pg8::StaticOrder, true, true>(lds, g, S, E);
#endif
            }
            PH_NEXT;
        }
        const int j = s ? 2 : 0;
        if (PH_ON) { DEFPTRS
            pg8::Gemm g{XN, WUP + (size_t)(l * 2 + s) * NUP * DM, MTOK, NUP, DM}; pg8::StaticOrder S; S.init(MTOK, NUP, G, bx);
            pg8::EpiUp E{HB, ROWSS + (size_t)(l * 3 + j) * MTOK, SBV + (size_t)(l * 3 + j) * 16 * 5632};
#ifndef NO_G_UP
            for (int rep_ = 0; rep_ < REP_UP; ++rep_) {
            pg8::gemm_phase<pg8::EpiUp, pg8::StaticOrder, true, true>(lds, g, S, E);
            }
#endif
        }
        PH_NEXT;
        if (PH_ON) { DEFPTRS
            const int nl = s ? l + 1 : l, nj = s ? 0 : 1; const int has_next = (nl < 2) ? 1 : 0; const int nidx = has_next ? nl * 3 + nj : 0;
            pg8::Gemm g{HB, WDN + (size_t)(l * 2 + s) * DM * DFF, MTOK, DM, DFF}; pg8::StaticOrder S; S.init(MTOK, DM, G, bx);
            pg8::EpiRes E{f == 0 ? x_in : xout, xout, GATE + (size_t)(l * 3 + j) * 16 * 1024, GMOD + (size_t)nidx * 16 * 1024, XN, ROWSS + (size_t)nidx * MTOK, has_next};
#ifndef NO_G_DN
#ifdef REP_DN
            for (int rep_ = 0; rep_ < 2; ++rep_) { E.xout = (rep_ == 0) ? HLOC : xout;
            pg8::gemm_phase<pg8::EpiRes, pg8::StaticOrder, true, true>(lds, g, S, E); }
#else
            pg8::gemm_phase<pg8::EpiRes, pg8::StaticOrder, true, true>(lds, g, S, E);
#endif
#endif
        }
        PH_NEXT;
    }
#undef PH_ON
#undef PH_NEXT
}


#ifdef DBG_STOP
__global__ void dbg_dump(const unsigned char* ws, float* out, int mode) {
    const size_t n = (size_t)MTOK * DM; const size_t i0 = (size_t)blockIdx.x * blockDim.x + threadIdx.x, st = (size_t)gridDim.x * blockDim.x;
    const bf16_t* XN = (const bf16_t*)(ws + WS_XN); const bf16_t* HB = (const bf16_t*)(ws + WS_H); const bf16_t* PR = (const bf16_t*)(ws + WS_PROJ);
    const bf16_t* YU = (const bf16_t*)(ws + WS_YU); const float* HL = (const float*)(ws + WS_HLOC); const bf16_t* YN = (const bf16_t*)(ws + WS_YN); const bf16_t* PC = (const bf16_t*)(ws + WS_PCUM);
    for (size_t i = i0; i < n; i += st) {
        float v = 0.f;
        if (mode == 0) v = bf2f(XN[i]);
        else if (mode == 1) v = bf2f(HB[i]) + bf2f(HB[i + n]) + bf2f(HB[i + (size_t)117440512]);
        else if (mode == 2) v = bf2f(PR[i]) + bf2f(PR[i + n]) + bf2f(PR[i + (size_t)100663296]);
        else if (mode == 3) v = (i < n / 2) ? bf2f(YU[i]) : HL[i - n / 2];
        else if (mode == 4) v = bf2f(YN[i]);
        else if (mode == 6) v = (i < n / 2) ? bf2f(PC[i]) : ((const float*)(ws + WS_KS))[(i - n / 2) % (3 * 262144)];
        else if (mode == 7) v = HL[i % (n / 2)] + bf2f(PC[i % (n / 2)]) + ((const float*)(ws + WS_KS))[i % (3 * 262144)] + ((const float*)(ws + WS_ASEG))[i % (2 * 1048576)];
        if (mode == 3) { const bool nan_ = !(v == v), big = (v > 3e38f) || (v < -3e38f); float code = 0.f;
            if (i < n / 2) { const int col = (int)(i & 511); if (col < 256) code = nan_ ? 2000.f : (big ? 1000.f : 0.f); else code = (nan_ || big) ? 4000.f : 0.f; }
            else code = (nan_ || big) ? 8000.f : 0.f;
            v = code; }
        if (!(v == v)) v = 77777.f; if (v > 3e38f) v = 88888.f; if (v < -3e38f) v = 99999.f;
        if (mode != 5) out[i] = v;
    }
}
#endif
#ifndef MK_N_LAUNCHES
#define MK_N_LAUNCHES 1
#endif
constexpr int N_PHASES = 3 + 2 * 9;
extern "C" void kernel_launch(void* const* d_in, const int* in_sizes, int n_in, void* d_out, int out_size, void* d_ws, size_t ws_size, hipStream_t stream) {
    static int grid = 0;
    if (grid == 0) {
        if (n_in != 19 || out_size != MTOK * DM || ws_size < WS_END) { fprintf(stderr, "kernel_launch: unexpected shapes (n_in %d, out %d, ws %zu)\n", n_in, out_size, ws_size); grid = -1; return; }
        int dev = 0, cus = 0, per_cu = 0;
        hipGetDevice(&dev); hipDeviceGetAttribute(&cus, hipDeviceAttributeMultiprocessorCount, dev);
        if (hipFuncSetAttribute((const void*)mk_fwd, hipFuncAttributeMaxDynamicSharedMemorySize, LDS_BYTES) != hipSuccess) { fprintf(stderr, "kernel_launch: hipFuncSetAttribute failed\n"); grid = -1; return; }
        if (hipOccupancyMaxActiveBlocksPerMultiprocessor(&per_cu, (const void*)mk_fwd, 512, LDS_BYTES) != hipSuccess || per_cu < 1) { fprintf(stderr, "kernel_launch: occupancy query says %d\n", per_cu); per_cu = 1; }
        (void)hipGetLastError();
        grid = cus * 1;
    }
    if (grid < 0) return;
    Args a{};
    for (int i = 0; i < 19; ++i) a.in[i] = (const float*)d_in[i];
    a.out = (float*)d_out; a.ws = (unsigned char*)d_ws;
#if MK_N_LAUNCHES == 1
    a.ph_lo = 0; a.ph_hi = N_PHASES;
    void* kargs[] = {&a};
    hipError_t e = hipLaunchCooperativeKernel((const void*)mk_fwd, dim3(grid), dim3(512), kargs, LDS_BYTES, stream);
    if (e != hipSuccess) fprintf(stderr, "kernel_launch: cooperative launch failed: %s (grid %d)\n", hipGetErrorString(e), grid);
#else
#ifdef DBG_STOP
    for (int p = 0; p < DBG_STOP; ++p) { a.ph_lo = p; a.ph_hi = p + 1; hipLaunchKernelGGL(mk_fwd, dim3(grid), dim3(512), LDS_BYTES, stream, a); }
    hipLaunchKernelGGL(dbg_dump, dim3(2048), dim3(256), 0, stream, (const unsigned char*)d_ws, (float*)d_out, DBG_MODE);
#else
    for (int p = 0; p < N_PHASES; ++p) { a.ph_lo = p; a.ph_hi = p + 1; hipLaunchKernelGGL(mk_fwd, dim3(grid), dim3(512), LDS_BYTES, stream, a); }
#endif
#endif
}
```

```cpp
#include <hip/hip_runtime.h>
#include <hip/hip_cooperative_groups.h>
#include <cstdio>
#include <cstdint>
namespace cg = cooperative_groups;
namespace pg8 {
#define PG8_LAS __attribute__((address_space(3)))
typedef unsigned short bf16_t;
typedef short bf16x8 __attribute__((ext_vector_type(8)));
typedef float f32x4 __attribute__((ext_vector_type(4)));
typedef unsigned u32x4 __attribute__((ext_vector_type(4)));
constexpr int BM = 256, BK = 64, HALF = 128, HTB = HALF * BK * 2  , STAGE_BYTES = 8 * HTB, NXCD = 8, WGM = 8;

__host__ __device__ __forceinline__ int lds_byte(int r, int c) { const int st = (r >> 4) * 2 + (c >> 5), rr = r & 15, cc = c & 31, ob = rr * 64 + cc * 2; return st * 1024 + (ob ^ (((ob >> 9) & 1) << 5)); }
__host__ __device__ __forceinline__ void stage_rc(int b, int& R, int& C) { const int st = b / 1024, sb = b % 1024, swz = sb ^ (((sb >> 9) & 1) << 5); R = (st >> 1) * 16 + swz / 64; C = (st & 1) * 32 + (swz % 64) / 2; }
__host__ __device__ __forceinline__ int perm32(int rho) { const int n = rho >> 4, i = rho & 15; return 8 * (i >> 2) + 4 * n + (i & 3); }

struct Unit { int pm, pn; };
struct Gemm { const bf16_t* A; const bf16_t* Bt; int M, N, K; };

struct StaticOrder {
    int nM, nN, nwg, G, c;
    __host__ __device__ void init(int M, int N, int G_, int c_) { nM = M / BM; nN = N / BM; nwg = nM * nN; G = G_; c = c_; }
    __host__ __device__ bool next(int i, Unit& u) const {
        const long L = (long)i * G + c; if (L >= nwg) return false;
        int wgid = (int)L; { const int q = nwg / NXCD, r = nwg % NXCD, xcd = wgid % NXCD, off = wgid / NXCD; wgid = (xcd < r ? xcd * (q + 1) : r * (q + 1) + (xcd - r) * q) + off; }
        const int nig = WGM * nN, gid = wgid / nig, fm = gid * WGM, gsz = (nM - fm) < WGM ? (nM - fm) : WGM;
        u.pm = fm + ((wgid % nig) % gsz); u.pn = (wgid % nig) / gsz; return true;
    }
    __device__ __forceinline__ void a_ready(const Unit&) const {}
    __device__ __forceinline__ void done(const Unit&) const {}
};

typedef float f32x2c_t __attribute__((ext_vector_type(2))); typedef __bf16 bf16x2c_t __attribute__((ext_vector_type(2)));
__device__ __forceinline__ unsigned cvt_pk_bf16(float lo, float hi) { f32x2c_t v = {lo, hi}; bf16x2c_t b = __builtin_convertvector(v, bf16x2c_t); return __builtin_bit_cast(unsigned, b); }
typedef float f32x2 __attribute__((ext_vector_type(2)));
constexpr float RMS_EPS = 1e-6f;
struct EpiUp {
    static constexpr bool PERM = true, AFTER_DRAIN = false;
    bf16_t* H; const float* rowss; const float* sb;
    __device__ __forceinline__ void operator()(const f32x4 (&acc)[2][2][4][2], const Unit& u, int wr, int wc, int fr, int fq) const {
        const int row0 = u.pm * BM + wr * 64 + fr, b = u.pm >> 4, cl = wc * 32 + 8 * fq;
        const float* sbp = sb + (size_t)b * 5632 + u.pn * 256 + cl;
        float rsv[2][4];
#pragma unroll
        for (int ai = 0; ai < 2; ++ai)
#pragma unroll
            for (int m = 0; m < 4; ++m) rsv[ai][m] = rowss[row0 + ai * HALF + m * 16];
        f32x4 sg[2], su[2];
#pragma unroll
        for (int n = 0; n < 2; ++n) { sg[n] = *(const f32x4*)(sbp + 4 * n); su[n] = *(const f32x4*)(sbp + 128 + 4 * n); }
#pragma unroll
        for (int ai = 0; ai < 2; ++ai)
#pragma unroll
            for (int m = 0; m < 4; ++m) {
                const int row = row0 + ai * HALF + m * 16;
                const float rs = __builtin_amdgcn_rsqf(rsv[ai][m] * (1.0f / 1024.0f) + RMS_EPS);
                float hv[8];
#pragma unroll
                for (int n = 0; n < 2; ++n)
#pragma unroll
                    for (int i = 0; i < 4; ++i) {
                        const float g = rs * acc[ai][0][m][n][i] + sg[n][i], uu = rs * acc[ai][1][m][n][i] + su[n][i];
                        hv[n * 4 + i] = g * __builtin_amdgcn_rcpf(1.0f + __builtin_amdgcn_exp2f(-1.4426950408889634f * g)) * uu;
                    }
                u32x4 w; w.x = cvt_pk_bf16(hv[0], hv[1]); w.y = cvt_pk_bf16(hv[2], hv[3]); w.z = cvt_pk_bf16(hv[4], hv[5]); w.w = cvt_pk_bf16(hv[6], hv[7]);
                *(u32x4*)(H + (size_t)row * 2816 + u.pn * 128 + cl) = w;
            }
    }
};
struct EpiIn {
    static constexpr bool PERM = true, AFTER_DRAIN = false;
    bf16_t* P; float* FG; const float* rowss; const float* sb;
    __device__ __forceinline__ void operator()(const f32x4 (&acc)[2][2][4][2], const Unit& u, int wr, int wc, int fr, int fq) const {
        const int row0 = u.pm * BM + wr * 64 + fr, b = u.pm >> 4, cl = wc * 32 + 8 * fq;
        const float* sbp = sb + (size_t)b * 5632 + u.pn * 256 + cl;
        float rsv[2][4];
#pragma unroll
        for (int ai = 0; ai < 2; ++ai)
#pragma unroll
            for (int m = 0; m < 4; ++m) rsv[ai][m] = rowss[row0 + ai * HALF + m * 16];
        f32x4 sv[2][2];
#pragma unroll
        for (int bj = 0; bj < 2; ++bj)
#pragma unroll
            for (int n = 0; n < 2; ++n) sv[bj][n] = *(const f32x4*)(sbp + bj * HALF + 4 * n);
#pragma unroll
        for (int ai = 0; ai < 2; ++ai)
#pragma unroll
            for (int m = 0; m < 4; ++m) {
                const int row = row0 + ai * HALF + m * 16;
                const float rs = __builtin_amdgcn_rsqf(rsv[ai][m] * (1.0f / 1024.0f) + RMS_EPS);
                if (u.pn < 10) {
#pragma unroll
                    for (int bj = 0; bj < 2; ++bj) {
                        const f32x4 v0 = acc[ai][bj][m][0] * rs + sv[bj][0], v1 = acc[ai][bj][m][1] * rs + sv[bj][1];
                        u32x4 w; w.x = cvt_pk_bf16(v0[0], v0[1]); w.y = cvt_pk_bf16(v0[2], v0[3]); w.z = cvt_pk_bf16(v1[0], v1[1]); w.w = cvt_pk_bf16(v1[2], v1[3]);
                        *(u32x4*)(P + (size_t)row * 2560 + u.pn * 256 + bj * HALF + cl) = w;
                    }
                } else if (wc == 0 && fq == 0) {
                    *(f32x4*)(FG + (size_t)row * 4) = acc[ai][0][m][0] * rs + sv[0][0];
                }
            }
    }
};
struct EpiRes {
    static constexpr bool PERM = false, AFTER_DRAIN = false;
    const float* xin; float* xout; const float* gate; const float* gmn; bf16_t* XN; float* rowssn; int has_next;
    __device__ __forceinline__ void operator()(const f32x4 (&acc)[2][2][4][2], const Unit& u, int wr, int wc, int fr, int fq) const {
        typedef unsigned u32x2v __attribute__((ext_vector_type(2)));
        const int row0 = u.pm * BM + wr * 64 + fr, b = u.pm >> 4, col0 = u.pn * BM + wc * 32 + 4 * fq;
        const float* gp_ = gate + b * 1024 + col0; const float* gm_ = gmn + b * 1024 + col0;
#pragma unroll
        for (int ai = 0; ai < 2; ++ai) {
            f32x4 xi[4][2][2];
#pragma unroll
            for (int m = 0; m < 4; ++m)
#pragma unroll
                for (int bj = 0; bj < 2; ++bj)
#pragma unroll
                    for (int n = 0; n < 2; ++n) xi[m][bj][n] = *(const f32x4*)(xin + (size_t)(row0 + ai * HALF + m * 16) * 1024 + col0 + bj * HALF + n * 16);
            asm volatile("" ::: "memory");
#pragma unroll
            for (int m = 0; m < 4; ++m) {
                const int row = row0 + ai * HALF + m * 16; const size_t off = (size_t)row * 1024 + col0;
                float ss = 0.f;
#pragma unroll
                for (int bj = 0; bj < 2; ++bj)
#pragma unroll
                    for (int n = 0; n < 2; ++n) {
                        const f32x4 xo = xi[m][bj][n] + *(const f32x4*)(gp_ + bj * HALF + n * 16) * acc[ai][bj][m][n];
                        *(f32x4*)(xout + off + bj * HALF + n * 16) = xo;
                        if (has_next) {
                            ss += (xo[0] * xo[0] + xo[1] * xo[1]) + (xo[2] * xo[2] + xo[3] * xo[3]);
                            const f32x4 a = xo * *(const f32x4*)(gm_ + bj * HALF + n * 16); u32x2v w; w.x = cvt_pk_bf16(a[0], a[1]); w.y = cvt_pk_bf16(a[2], a[3]);
                            *(u32x2v*)(XN + off + bj * HALF + n * 16) = w;
                        }
                    }
                if (has_next) { ss += __shfl_xor(ss, 16); ss += __shfl_xor(ss, 32); if (fq == 0) unsafeAtomicAdd(rowssn + row, ss); }
            }
            asm volatile("" ::: "memory");
        }
    }
};

template <class Epi, class Sched, bool ALIGN_EPI = false, bool SP2 = false>
__device__ __forceinline__ void gemm_phase(PG8_LAS unsigned char* lds, const Gemm g, const Sched& S, const Epi& E) {
    int tid_o = threadIdx.x; asm volatile("" : "+v"(tid_o)); const int tid = tid_o, wid = __builtin_amdgcn_readfirstlane(tid >> 6), lane = tid & 63, wr = wid >> 2, wc = wid & 3, fr = lane & 15, fq = lane >> 4;
    const int K = g.K, nt = K / BK;
    unsigned voffA[2], voffB[2];
#pragma unroll
    for (int i = 0; i < 2; ++i) { int R, C; stage_rc(tid * 16 + i * 8192, R, C); const int Rb = Epi::PERM ? ((R & ~31) + perm32(R & 31)) : R;
        voffA[i] = (unsigned)(R * K + C) * 2u; voffB[i] = (unsigned)(Rb * K + C) * 2u; }
    const size_t kstep = (size_t)(BK * 2);
    const size_t hstep = (size_t)HALF * K * 2;
    const size_t tstep = 2 * hstep;
    const unsigned ldsw = (unsigned)wid * 1024u;
    const int aoff = lds_byte(wr * 64 + fr, fq * 8), boff = lds_byte(wc * 32 + fr, fq * 8);
#define PG8_SA(b, h) (((b) * 2 + (h)) * HTB)
#define PG8_SB(b, h) ((4 + (b) * 2 + (h)) * HTB)
#define PG8_STAGE(bufoff, gbase, voff) do { _Pragma("unroll") for (int _i = 0; _i < 2; ++_i) \
        __builtin_amdgcn_global_load_lds((const unsigned*)((const char*)(gbase) + (voff)[_i]), (PG8_LAS unsigned*)(lds + (bufoff) + ldsw + _i * 8192), 16, 0, 0); } while (0)
#define PG8_LDA(dst, b, h) do { _Pragma("unroll") for (int m = 0; m < 4; ++m) _Pragma("unroll") for (int k = 0; k < 2; ++k) dst[m][k] = *(const PG8_LAS bf16x8*)(lds + PG8_SA(b, h) + aoff + m * 2048 + k * 1024); } while (0)
#define PG8_LDB(dst, b, h) do { _Pragma("unroll") for (int n = 0; n < 2; ++n) _Pragma("unroll") for (int k = 0; k < 2; ++k) dst[n][k] = *(const PG8_LAS bf16x8*)(lds + PG8_SB(b, h) + boff + n * 2048 + k * 1024); } while (0)
#define PG8_MMA(ai, bj, At, Bt) do { __builtin_amdgcn_s_setprio(1); _Pragma("unroll") for (int m = 0; m < 4; ++m) _Pragma("unroll") for (int n = 0; n < 2; ++n) _Pragma("unroll") for (int k = 0; k < 2; ++k) \
        acc[ai][bj][m][n] = __builtin_amdgcn_mfma_f32_16x16x32_bf16(Bt[n][k], At[m][k], acc[ai][bj][m][n], 0, 0, 0); __builtin_amdgcn_s_setprio(0); } while (0)
#define PG8_WAIT_V(n) asm volatile("s_waitcnt vmcnt(" #n ")" ::: "memory")
#define PG8_WAIT_L(n) asm volatile("s_waitcnt lgkmcnt(" #n ")" ::: "memory")
#define PG8_BAR __builtin_amdgcn_s_barrier()
#define PG8_SCHED __builtin_amdgcn_sched_barrier(0)
    Unit cur, nxt; int ui = 0;
    if (!S.next(0, cur)) return;
    f32x4 acc[2][2][4][2];
#pragma unroll
    for (int a = 0; a < 2; ++a)
#pragma unroll
        for (int b = 0; b < 2; ++b)
#pragma unroll
            for (int m = 0; m < 4; ++m)
#pragma unroll
                for (int n = 0; n < 2; ++n) acc[a][b][m][n] = (f32x4){0.f, 0.f, 0.f, 0.f};
    bf16x8 At[4][2], B0[2][2], B1[2][2];
    const char* cA = (const char*)g.A + (size_t)cur.pm * tstep; const char* cB = (const char*)g.Bt + (size_t)cur.pn * tstep;
    S.a_ready(cur);
    if constexpr (SP2) {
        PG8_STAGE(PG8_SB(0, 0), cB, voffB); PG8_STAGE(PG8_SB(0, 1), cB + hstep, voffB); PG8_STAGE(PG8_SA(0, 0), cA, voffA); PG8_STAGE(PG8_SA(0, 1), cA + hstep, voffA);
        if (wr == 1) PG8_BAR;
        PG8_WAIT_V(2); PG8_BAR;
        PG8_STAGE(PG8_SB(1, 0), cB + kstep, voffB); PG8_STAGE(PG8_SA(1, 0), cA + kstep, voffA); PG8_STAGE(PG8_SB(1, 1), cB + hstep + kstep, voffB);
        PG8_WAIT_V(6); PG8_BAR;
    } else {
        PG8_STAGE(PG8_SB(0, 0), cB, voffB); PG8_STAGE(PG8_SA(0, 0), cA, voffA); PG8_STAGE(PG8_SB(0, 1), cB + hstep, voffB); PG8_STAGE(PG8_SA(0, 1), cA + hstep, voffA);
        if (wr == 1) PG8_BAR;
        PG8_WAIT_V(4); PG8_BAR;
        PG8_STAGE(PG8_SB(1, 0), cB + kstep, voffB); PG8_STAGE(PG8_SA(1, 0), cA + kstep, voffA); PG8_STAGE(PG8_SB(1, 1), cB + hstep + kstep, voffB);
        PG8_WAIT_V(6); PG8_BAR;
    }
    for (;;) {
        const bool has_next = S.next(ui + 1, nxt);
        const char* nA = has_next ? (const char*)g.A + (size_t)nxt.pm * tstep : cA; const char* nB = has_next ? (const char*)g.Bt + (size_t)nxt.pn * tstep : cB;
        for (int t = 0; t < nt; t += 2) {
            const bool last = (t == nt - 2);
            const char* a1 = cA + (size_t)(t + 1) * kstep;
            const char* a2 = last ? nA : cA + (size_t)(t + 2) * kstep; const char* b2 = last ? nB : cB + (size_t)(t + 2) * kstep;
            const char* a3 = a2 + kstep; const char* b3 = b2 + kstep;
            if (last && has_next) S.a_ready(nxt);
            if constexpr (SP2) {
            PG8_LDB(B0, 0, 0); PG8_LDB(B1, 0, 1); PG8_SCHED; PG8_LDA(At, 0, 0); PG8_STAGE(PG8_SA(1, 1), a1 + hstep, voffA);
            PG8_WAIT_V(8); PG8_WAIT_L(0); PG8_BAR; PG8_MMA(0, 0, At, B0); PG8_MMA(0, 1, At, B1); PG8_BAR; PG8_SCHED;
            PG8_LDA(At, 0, 1); PG8_STAGE(PG8_SB(0, 0), b2, voffB); PG8_STAGE(PG8_SB(0, 1), b2 + hstep, voffB); PG8_STAGE(PG8_SA(0, 0), a2, voffA);
            PG8_WAIT_V(8); PG8_WAIT_L(0); PG8_BAR; PG8_MMA(1, 0, At, B0); PG8_MMA(1, 1, At, B1); PG8_BAR; PG8_SCHED;
            PG8_LDB(B0, 1, 0); PG8_LDB(B1, 1, 1); PG8_SCHED; PG8_LDA(At, 1, 0); PG8_STAGE(PG8_SA(0, 1), a2 + hstep, voffA);
            PG8_WAIT_V(8); PG8_WAIT_L(0); PG8_BAR; PG8_MMA(0, 0, At, B0); PG8_MMA(0, 1, At, B1); PG8_BAR; PG8_SCHED;
            PG8_LDA(At, 1, 1); PG8_STAGE(PG8_SB(1, 0), b3, voffB); PG8_STAGE(PG8_SB(1, 1), b3 + hstep, voffB); PG8_STAGE(PG8_SA(1, 0), a3, voffA);
            PG8_WAIT_V(8); PG8_WAIT_L(0); PG8_BAR; PG8_MMA(1, 0, At, B0); PG8_MMA(1, 1, At, B1); PG8_BAR; PG8_SCHED;
            } else {
            PG8_LDB(B0, 0, 0); PG8_SCHED; PG8_LDA(At, 0, 0); PG8_STAGE(PG8_SA(1, 1), a1 + hstep, voffA);
            PG8_WAIT_L(8); PG8_BAR; PG8_WAIT_L(0); PG8_MMA(0, 0, At, B0); PG8_BAR; PG8_SCHED;
            PG8_LDB(B1, 0, 1); PG8_STAGE(PG8_SB(0, 0), b2, voffB);
            PG8_BAR; PG8_WAIT_L(0); PG8_MMA(0, 1, At, B1); PG8_BAR;
            PG8_LDA(At, 0, 1); PG8_STAGE(PG8_SA(0, 0), a2, voffA);
            PG8_BAR; PG8_WAIT_L(0); PG8_MMA(1, 0, At, B0); PG8_BAR; PG8_SCHED;
            PG8_STAGE(PG8_SB(0, 1), b2 + hstep, voffB);
            PG8_WAIT_V(6); PG8_BAR; PG8_MMA(1, 1, At, B1); PG8_BAR;
            PG8_LDB(B0, 1, 0); PG8_SCHED; PG8_LDA(At, 1, 0); PG8_STAGE(PG8_SA(0, 1), a2 + hstep, voffA);
            PG8_WAIT_L(8); PG8_BAR; PG8_WAIT_L(0); PG8_MMA(0, 0, At, B0); PG8_BAR; PG8_SCHED;
            PG8_LDB(B1, 1, 1); PG8_STAGE(PG8_SB(1, 0), b3, voffB);
            PG8_BAR; PG8_WAIT_L(0); PG8_MMA(0, 1, At, B1); PG8_BAR;
            PG8_LDA(At, 1, 1); PG8_STAGE(PG8_SA(1, 0), a3, voffA);
            PG8_BAR; PG8_WAIT_L(0); PG8_MMA(1, 0, At, B0); PG8_BAR; PG8_SCHED;
            PG8_STAGE(PG8_SB(1, 1), b3 + hstep, voffB);
            PG8_WAIT_V(6); PG8_BAR; PG8_MMA(1, 1, At, B1); PG8_BAR;
            }
        }
        if constexpr (ALIGN_EPI) { if (wr == 0) PG8_BAR; }
        if constexpr (!Epi::AFTER_DRAIN) { E(acc, cur, wr, wc, fr, fq); S.done(cur); }
        if (!has_next) break;
#pragma unroll
        for (int a = 0; a < 2; ++a)
#pragma unroll
            for (int b = 0; b < 2; ++b)
#pragma unroll
                for (int m = 0; m < 4; ++m)
#pragma unroll
                    for (int n = 0; n < 2; ++n) acc[a][b][m][n] = (f32x4){0.f, 0.f, 0.f, 0.f};
        cur = nxt; cA = nA; cB = nB; ++ui;
        if constexpr (ALIGN_EPI) { if (wr == 1) PG8_BAR; }
    }
    PG8_WAIT_V(0);
    if constexpr (!ALIGN_EPI) { if (wr == 0) PG8_BAR; }
    PG8_BAR;
    if constexpr (Epi::AFTER_DRAIN) { E.fused(acc, cur, wr, wc, fr, fq, lds, wid, lane); S.done(cur); }
#undef PG8_SA
#undef PG8_SB
#undef PG8_STAGE
#undef PG8_LDA
#undef PG8_LDB
#undef PG8_MMA
#undef PG8_WAIT_V
#undef PG8_WAIT_L
#undef PG8_BAR
#undef PG8_SCHED
}
}

#define LAS __attribute__((address_space(3)))
typedef unsigned short bf16_t;
typedef short bf16x8 __attribute__((ext_vector_type(8)));
typedef short s16x4 __attribute__((ext_vector_type(4)));
typedef float f32x4 __attribute__((ext_vector_type(4)));
typedef float f32x2 __attribute__((ext_vector_type(2)));
typedef float f32x16 __attribute__((ext_vector_type(16)));
typedef unsigned u32x4 __attribute__((ext_vector_type(4)));
typedef unsigned u32x2 __attribute__((ext_vector_type(2)));

constexpr int MTOK = 65536, DM = 1024, DFF = 2816, NUP = 5632, NINP = 2816, PPITCH = 2560, SEQL = 4096;
constexpr float EPSF = 1e-6f, LOG2E = 1.4426950408889634f;
constexpr size_t MiB = 1u << 20;
constexpr size_t WS_MOD = 1 * MiB, WS_GMOD = 3 * MiB, WS_GATE = 4 * MiB, WS_SB = 5 * MiB, WS_ROWSS = 8 * MiB, WS_KS = 10 * MiB, WS_F2 = 11 * MiB, WS_FG = 12 * MiB,
                 WS_ASEG = 13 * MiB, WS_BSEG = 17 * MiB, WS_WUP = 24 * MiB, WS_WDN = 68 * MiB, WS_WIN = 90 * MiB, WS_WOUT = 101 * MiB, WS_XN = 112 * MiB,
                 WS_H = 240 * MiB, WS_PROJ = 240 * MiB, WS_YU = 592 * MiB, WS_HLOC = 656 * MiB, WS_PCUM = 784 * MiB, WS_YN = 848 * MiB, WS_END = 976 * MiB;
constexpr int LDS_BYTES = 147456;

__device__ __forceinline__ float bf2f(unsigned short v) { return __uint_as_float((unsigned)v << 16); }
__device__ __forceinline__ unsigned f2bf(float f) { unsigned u = __float_as_uint(f); return (u + 0x7fffu + ((u >> 16) & 1u)) >> 16; }
__device__ __forceinline__ unsigned pk2(float lo, float hi) { return pg8::cvt_pk_bf16(lo, hi); }
__device__ __forceinline__ float wave_sum(float v) {
#pragma unroll
    for (int o = 1; o < 64; o <<= 1) v += __shfl_xor(v, o);
    return v;
}
__device__ __forceinline__ float sigmoidf_(float x) { return __builtin_amdgcn_rcpf(1.0f + __builtin_amdgcn_exp2f(-LOG2E * x)); }
#define WAITV(n) asm volatile("s_waitcnt vmcnt(" #n ")" ::: "memory")
#define LBAR() asm volatile("s_waitcnt lgkmcnt(0)\n\ts_barrier" ::: "memory")
#define CFENCE() asm volatile("" ::: "memory")

#ifndef REP_FIN
#define REP_FIN 1
#endif
#ifndef REP_PREP
#define REP_PREP 1
#endif
#ifndef REP_ATTN
#define REP_ATTN 1
#endif
#ifndef REP_UP
#define REP_UP 1
#endif
struct Args { const float* in[19]; float* out; unsigned char* ws; int ph_lo, ph_hi; };

__device__ __forceinline__ void transpose_item(const float* __restrict__ W, int ldw, int clim, int K, bf16_t* __restrict__ WT, int n0, int c0, int k0, LAS float* scr, int lane) {
    const int col = c0 + (lane & 31);
#pragma unroll 8
    for (int i = 0; i < 32; ++i) { const int kk = 2 * i + (lane >> 5); scr[kk * 33 + (lane & 31)] = (col < clim) ? W[(size_t)(k0 + kk) * ldw + col] : 0.f; }
    asm volatile("s_waitcnt lgkmcnt(0)" ::: "memory");
    const int c = lane & 7;
#pragma unroll
    for (int j = 0; j < 4; ++j) { const int n = (lane >> 3) + 8 * j; const LAS float* s = scr + (8 * c) * 33 + n;
        u32x4 o; o.x = pk2(s[0 * 33], s[1 * 33]); o.y = pk2(s[2 * 33], s[3 * 33]); o.z = pk2(s[4 * 33], s[5 * 33]); o.w = pk2(s[6 * 33], s[7 * 33]);
        *(u32x4*)(WT + (size_t)(n0 + n) * K + k0 + 8 * c) = o; }
    asm volatile("s_waitcnt lgkmcnt(0)" ::: "memory");
}

__device__ __forceinline__ int crow(int r, int hi) { return (r & 3) + 8 * (r >> 2) + 4 * hi; }
__device__ __forceinline__ s16x4 vtr(const LAS unsigned char* p) {
    typedef short v4i16_t __attribute__((ext_vector_type(4)));
    return __builtin_bit_cast(s16x4, __builtin_amdgcn_ds_read_tr16_b64_v4i16((LAS v4i16_t*)p));
}
constexpr int AT_SLOT = 16384, AT_AUX = 3 * AT_SLOT, AT_WSF = AT_AUX + 3 * 512, AT_VOTE = AT_WSF + 8 * 256;
constexpr float C2 = 0.125f * LOG2E;

__device__ __forceinline__ void sb_block(f32x16& X, float& carry, bool band, int kv0  , int qrel, int hi) {
    float lm[16];
#pragma unroll
    for (int r = 0; r < 16; ++r) {
        float z2 = X[r] * C2; z2 = __builtin_fminf(__builtin_fmaxf(z2, -120.f), 120.f);
        const float e = __builtin_amdgcn_exp2f(-z2), sp = __builtin_amdgcn_logf(1.0f + e);
        float l1 = -(sp + z2), lb = -sp;
        if (band) { const int kv = kv0 + (r & 3) + 8 * (r >> 2); const bool valid = kv < qrel; l1 = valid ? l1 : 0.f; lb = valid ? lb : -INFINITY; }
        lm[r] = l1; X[r] = lb;
    }
    float G[4], Gp[4], T[4];
#pragma unroll
    for (int g = 0; g < 4; ++g) { G[g] = (lm[4 * g] + lm[4 * g + 1]) + (lm[4 * g + 2] + lm[4 * g + 3]); Gp[g] = __shfl_xor(G[g], 32); T[g] = G[g] + Gp[g]; }
    float S = carry;
#pragma unroll
    for (int g = 3; g >= 0; --g) {
        const float a3 = S + (hi == 0 ? Gp[g] : 0.f), a2 = a3 + lm[4 * g + 3], a1 = a2 + lm[4 * g + 2], a0 = a1 + lm[4 * g + 1];
        X[4 * g + 3] = __builtin_amdgcn_exp2f(X[4 * g + 3] + a3); X[4 * g + 2] = __builtin_amdgcn_exp2f(X[4 * g + 2] + a2);
        X[4 * g + 1] = __builtin_amdgcn_exp2f(X[4 * g + 1] + a1); X[4 * g] = __builtin_amdgcn_exp2f(X[4 * g] + a0);
        S += T[g];
    }
    carry = S;
}

template <int KIND>
__device__ __forceinline__ void attn_unit(LAS unsigned char* lds, const bf16_t* __restrict__ PROJ, bf16_t* __restrict__ YU, const float* __restrict__ KS,
                                          const float* __restrict__ F2, const float* __restrict__ gqk, int b, int h, int qb) {
    int tid_o = threadIdx.x; asm volatile("" : "+v"(tid_o));
    const int tid = tid_o, lane = tid & 63, r32 = lane & 31, hi = lane >> 5;
    const int wid = __builtin_amdgcn_readfirstlane(tid >> 6);
    const int qcol = (KIND == 0 ? 1024 : 1792) + h * 64, kcol = qcol + 256, vcol = qcol + 512;
    const size_t rowbase = (size_t)b * SEQL; const int q0 = qb * 256, bh = b * 4 + h;
    const int NT = (q0 + 256) / 64;
    const bf16_t* ksrc = PROJ + (rowbase + lane) * PPITCH + kcol + wid * 8;
    const bf16_t* vsrc = PROJ + (rowbase + 16 * (wid & 3) + (lane >> 2)) * PPITCH + vcol + (wid >> 2) * 32 + (lane & 3) * 8;
    const float* axsrc = (wid == 0 ? KS : F2) + (size_t)bh * SEQL + lane;
    u32x4 kreg, vreg; float areg = 0.f;
#define AT_LOAD(it_) do { const int kt_ = NT - 1 - (it_); kreg = *(const u32x4*)(ksrc + (size_t)kt_ * 64 * PPITCH); vreg = *(const u32x4*)(vsrc + (size_t)kt_ * 64 * PPITCH); \
        if (KIND == 1 && wid < 2) areg = axsrc[kt_ * 64]; } while (0)
#define AT_STORE(slot_) do { *(LAS u32x4*)(lds + (slot_) * AT_SLOT + wid * 1024 + lane * 16) = kreg; *(LAS u32x4*)(lds + (slot_) * AT_SLOT + 8192 + wid * 1024 + lane * 16) = vreg; \
        if (KIND == 1 && wid < 2) *(LAS float*)(lds + AT_AUX + (slot_) * 512 + wid * 256 + lane * 4) = areg; } while (0)
    const bf16_t* Qw = PROJ + (rowbase + q0 + wid * 32 + r32) * PPITCH + qcol + hi * 8;
    bf16x8 qr[4];
#pragma unroll
    for (int d0 = 0; d0 < 4; ++d0) qr[d0] = *(const bf16x8*)(Qw + d0 * 16);
    float Ft = 0.f;
    if (KIND == 1) Ft = F2[(size_t)bh * SEQL + q0 + wid * 32 + r32];
    AT_LOAD(0);
    if (KIND == 1) {
        float qf[4][8]; float ss = 0.f;
#pragma unroll
        for (int d0 = 0; d0 < 4; ++d0)
#pragma unroll
            for (int i = 0; i < 8; ++i) { qf[d0][i] = bf2f((unsigned short)qr[d0][i]); ss += qf[d0][i] * qf[d0][i]; }
        ss += __shfl_xor(ss, 32);
        const float rs = __builtin_amdgcn_rsqf(ss * (1.0f / 64.0f) + EPSF) * C2;
#pragma unroll
        for (int d0 = 0; d0 < 4; ++d0) {
            const float* gp = gqk + d0 * 16 + hi * 8; float v[8];
#pragma unroll
            for (int i = 0; i < 8; ++i) v[i] = qf[d0][i] * rs * gp[i] * gp[64 + i];
            u32x4 w; w.x = pk2(v[0], v[1]); w.y = pk2(v[2], v[3]); w.z = pk2(v[4], v[5]); w.w = pk2(v[6], v[7]);
            qr[d0] = __builtin_bit_cast(bf16x8, w);
        }
    }
    f32x16 o0, o1;
#pragma unroll
    for (int r = 0; r < 16; ++r) { o0[r] = 0.f; o1[r] = 0.f; }
    float mhat = -1e30f, lsum = 0.f, carry = 0.f;
    LAS float* wsf = (LAS float*)(lds + AT_WSF) + wid * 64;
    LAS unsigned* votes = (LAS unsigned*)(lds + AT_VOTE);
    const int qrel = wid * 32 + r32;
    AT_STORE(0); LBAR();
    for (int it = 0; it < NT; ++it) {
        const int slot = it & 1;
        if (KIND == 0 && it > 0) {
            const LAS unsigned* vp = votes + ((it - 1) & 1) * 8;
            const unsigned all = vp[0] & vp[1] & vp[2] & vp[3] & vp[4] & vp[5] & vp[6] & vp[7];
            if (all) break;
        }
        if (it + 1 < NT) AT_LOAD(it + 1);
        const int kt = NT - 1 - it, jb = kt - (NT - 4);
        const bool band = jb >= 0;
        const bool active = !(band && 64 * jb > 32 * wid + 31);
        if (active) {
            f32x16 p0, p1;
            { const LAS unsigned char* kb = lds + slot * AT_SLOT + hi * 1024 + r32 * 16;
#pragma unroll
              for (int d0 = 0; d0 < 4; ++d0) {
                  const bf16x8 b0 = *(const LAS bf16x8*)(kb + d0 * 2048), b1 = *(const LAS bf16x8*)(kb + d0 * 2048 + 512);
                  if (d0 == 0) { f32x16 z;
#pragma unroll
                      for (int r = 0; r < 16; ++r) z[r] = 0.f;
                      p0 = __builtin_amdgcn_mfma_f32_32x32x16_bf16(b0, qr[0], z, 0, 0, 0); p1 = __builtin_amdgcn_mfma_f32_32x32x16_bf16(b1, qr[0], z, 0, 0, 0); }
                  else { p0 = __builtin_amdgcn_mfma_f32_32x32x16_bf16(b0, qr[d0], p0, 0, 0, 0); p1 = __builtin_amdgcn_mfma_f32_32x32x16_bf16(b1, qr[d0], p1, 0, 0, 0); }
              } }
            if (KIND == 0) {
                sb_block(p1, carry, band, 64 * jb + 32 + 4 * hi, qrel, hi);
                sb_block(p0, carry, band, 64 * jb + 4 * hi, qrel, hi);
            } else {
                const LAS float* ax = (const LAS float*)(lds + AT_AUX + slot * 512);
#pragma unroll
                for (int g = 0; g < 4; ++g) {
                    const f32x4 k0 = *(const LAS f32x4*)(ax + 8 * g + 4 * hi), k1 = *(const LAS f32x4*)(ax + 32 + 8 * g + 4 * hi);
                    const f32x4 f0 = *(const LAS f32x4*)(ax + 64 + 8 * g + 4 * hi), f1 = *(const LAS f32x4*)(ax + 96 + 8 * g + 4 * hi);
#pragma unroll
                    for (int i = 0; i < 4; ++i) { p0[4 * g + i] = p0[4 * g + i] * k0[i] + (Ft - f0[i]); p1[4 * g + i] = p1[4 * g + i] * k1[i] + (Ft - f1[i]); }
                }
                if (band) {
#pragma unroll
                    for (int r = 0; r < 16; ++r) { const int kv = 64 * jb + crow(r, hi); if (kv > qrel) p0[r] = -INFINITY; if (kv + 32 > qrel) p1[r] = -INFINITY; }
                }
                float rm = p0[0];
#pragma unroll
                for (int r = 1; r < 16; ++r) rm = __builtin_fmaxf(rm, p0[r]);
#pragma unroll
                for (int r = 0; r < 16; ++r) rm = __builtin_fmaxf(rm, p1[r]);
                rm = __builtin_fmaxf(rm, __shfl_xor(rm, 32));
                if (__any(rm > mhat + 8.0f)) {
                    const float mnew = __builtin_fmaxf(mhat, rm), f = __builtin_amdgcn_exp2f(mhat - mnew);
                    lsum *= f; mhat = mnew;
                    CFENCE(); if (hi == 0) wsf[r32] = f; CFENCE();
                    asm volatile("s_waitcnt lgkmcnt(0)" ::: "memory");
#pragma unroll
                    for (int r = 0; r < 16; ++r) { const float fr_ = wsf[crow(r, hi)]; o0[r] *= fr_; o1[r] *= fr_; }
                    CFENCE();
                }
                float sacc = 0.f;
#pragma unroll
                for (int r = 0; r < 16; ++r) { p0[r] = __builtin_amdgcn_exp2f(p0[r] - mhat); p1[r] = __builtin_amdgcn_exp2f(p1[r] - mhat); sacc += p0[r] + p1[r]; }
                lsum += sacc;
            }
            u32x4 pw0, pw1, pw2, pw3;
            pw0.x = pk2(p0[0], p0[1]); pw0.y = pk2(p0[2], p0[3]); pw0.z = pk2(p0[4], p0[5]); pw0.w = pk2(p0[6], p0[7]);
            pw1.x = pk2(p0[8], p0[9]); pw1.y = pk2(p0[10], p0[11]); pw1.z = pk2(p0[12], p0[13]); pw1.w = pk2(p0[14], p0[15]);
            pw2.x = pk2(p1[0], p1[1]); pw2.y = pk2(p1[2], p1[3]); pw2.z = pk2(p1[4], p1[5]); pw2.w = pk2(p1[6], p1[7]);
            pw3.x = pk2(p1[8], p1[9]); pw3.y = pk2(p1[10], p1[11]); pw3.z = pk2(p1[12], p1[13]); pw3.w = pk2(p1[14], p1[15]);
            const LAS unsigned char* vb = lds + slot * AT_SLOT + 8192 + ((lane >> 4) & 1) * 32 + (lane & 3) * 8 + (4 * hi + ((lane & 15) >> 2)) * 64;
            s16x4 vlo[8], vhi[8];
#pragma unroll
            for (int i = 0; i < 8; ++i) { vlo[i] = vtr(vb + (i >> 2) * 4096 + (i & 3) * 1024); vhi[i] = vtr(vb + (i >> 2) * 4096 + (i & 3) * 1024 + 512); }
#define VFR(i) (bf16x8){vlo[i][0], vlo[i][1], vlo[i][2], vlo[i][3], vhi[i][0], vhi[i][1], vhi[i][2], vhi[i][3]}
#define PAF(x) __builtin_bit_cast(bf16x8, x)
            o0 = __builtin_amdgcn_mfma_f32_32x32x16_bf16(PAF(pw0), VFR(0), o0, 0, 0, 0); o1 = __builtin_amdgcn_mfma_f32_32x32x16_bf16(PAF(pw0), VFR(4), o1, 0, 0, 0);
            o0 = __builtin_amdgcn_mfma_f32_32x32x16_bf16(PAF(pw1), VFR(1), o0, 0, 0, 0); o1 = __builtin_amdgcn_mfma_f32_32x32x16_bf16(PAF(pw1), VFR(5), o1, 0, 0, 0);
            o0 = __builtin_amdgcn_mfma_f32_32x32x16_bf16(PAF(pw2), VFR(2), o0, 0, 0, 0); o1 = __builtin_amdgcn_mfma_f32_32x32x16_bf16(PAF(pw2), VFR(6), o1, 0, 0, 0);
            o0 = __builtin_amdgcn_mfma_f32_32x32x16_bf16(PAF(pw3), VFR(3), o0, 0, 0, 0); o1 = __builtin_amdgcn_mfma_f32_32x32x16_bf16(PAF(pw3), VFR(7), o1, 0, 0, 0);
#undef VFR
#undef PAF
        }
        if (KIND == 0) { const unsigned done = (active && __all(carry < -150.0f)) ? 1u : 0u; if (lane == 0) votes[(it & 1) * 8 + wid] = done; }
        if (it + 1 < NT) AT_STORE(slot ^ 1);
        LBAR();
    }
    if (KIND == 1) { lsum += __shfl_xor(lsum, 32); CFENCE(); if (hi == 0) wsf[r32] = lsum; CFENCE(); asm volatile("s_waitcnt lgkmcnt(0)" ::: "memory"); }
    bf16_t* Yw = YU + (rowbase + q0 + wid * 32) * 512 + KIND * 256 + h * 64 + r32;
#pragma unroll
    for (int r = 0; r < 16; ++r) {
        const int orow = crow(r, hi); float sc = 1.0f;
        if (KIND == 1) sc = __builtin_amdgcn_rcpf(wsf[orow]);
        Yw[(size_t)orow * 512] = (bf16_t)f2bf(o0[r] * sc); Yw[(size_t)orow * 512 + 32] = (bf16_t)f2bf(o1[r] * sc);
    }
    LBAR();
#undef AT_LOAD
#undef AT_STORE
}

#define DEFPTRS \
    const __attribute__((address_space(4))) Args* ka_ = (const __attribute__((address_space(4))) Args*)__builtin_amdgcn_kernarg_segment_ptr(); \
    asm volatile("" : "+s"(ka_)); \
    int tid_o_ = threadIdx.x; asm volatile("" : "+v"(tid_o_)); const int tid = tid_o_, lane = tid & 63; (void)lane; \
    unsigned char* ws = ka_->ws; \
    const float* x_in = ka_->in[0]; const float* c_in = ka_->in[1]; const float* w_ada = ka_->in[2]; const float* b_ada = ka_->in[3]; const float* g_norm = ka_->in[4]; \
    const float* w_up = ka_->in[5]; const float* w_dn = ka_->in[6]; const float* w_in = ka_->in[7]; const float* b_fg = ka_->in[8]; const float* conv_w = ka_->in[9]; \
    const float* conv_b = ka_->in[10]; const float* w_rg = ka_->in[11]; const float* b_rg = ka_->in[12]; const float* w_ig = ka_->in[13]; const float* b_ig = ka_->in[14]; \
    const float* lam = ka_->in[15]; const float* g_qk = ka_->in[16]; const float* g_mix = ka_->in[17]; const float* w_out = ka_->in[18]; \
    float* xout = ka_->out; \
    float* MOD = (float*)(ws + WS_MOD); float* GMOD = (float*)(ws + WS_GMOD); float* GATE = (float*)(ws + WS_GATE); float* SBV = (float*)(ws + WS_SB); \
    float* ROWSS = (float*)(ws + WS_ROWSS); float* KS = (float*)(ws + WS_KS); float* F2 = (float*)(ws + WS_F2); float* FG = (float*)(ws + WS_FG); \
    float* ASEG = (float*)(ws + WS_ASEG); float* BSEG = (float*)(ws + WS_BSEG); \
    bf16_t* WUP = (bf16_t*)(ws + WS_WUP); bf16_t* WDN = (bf16_t*)(ws + WS_WDN); bf16_t* WIN = (bf16_t*)(ws + WS_WIN); bf16_t* WOUT = (bf16_t*)(ws + WS_WOUT); \
    bf16_t* XN = (bf16_t*)(ws + WS_XN); bf16_t* HB = (bf16_t*)(ws + WS_H); bf16_t* PROJ = (bf16_t*)(ws + WS_PROJ); bf16_t* YU = (bf16_t*)(ws + WS_YU); \
    float* HLOC = (float*)(ws + WS_HLOC); bf16_t* PCUM = (bf16_t*)(ws + WS_PCUM); bf16_t* YN = (bf16_t*)(ws + WS_YN);
#define XB_TMO      128
#define XB_XCNT(j)  (256  + 64 * (j))
#define XB_XSUB(j)  (1280 + 64 * (j))
#define XB_XGEN(j)  (2304 + 64 * (j))
#define XB_TOP      3328
#define XB_TOPGEN   3392
#define XCD_BAR_WORDS 3456
#define XB_SPIN_CAP (1u << 18)

__device__ __forceinline__ unsigned xb_ld(unsigned* p)              { return __hip_atomic_load(p, __ATOMIC_RELAXED, __HIP_MEMORY_SCOPE_AGENT); }
__device__ __forceinline__ unsigned xb_add(unsigned* p, unsigned v) { return __hip_atomic_fetch_add(p, v, __ATOMIC_RELAXED, __HIP_MEMORY_SCOPE_AGENT); }
__device__ __forceinline__ unsigned xb_xcc_id() { return (unsigned)__builtin_amdgcn_s_getreg((3 << 11) | 20) & 0xFu; }
#define XB_SPIN(cond, bar) do { unsigned _sp = 0; while (cond) { __builtin_amdgcn_s_sleep(1); \
    if ((++_sp & 255u) == 0u) { if (xb_ld(&(bar)[XB_TMO])) break; if (_sp > XB_SPIN_CAP) { atomicAdd(&(bar)[XB_TMO], 1u); break; } } } } while (0)

struct XcdBarrier {
    unsigned* bar; unsigned x;
    volatile LAS unsigned* st;
};

__device__ __forceinline__ XcdBarrier xcd_barrier_post(unsigned* bar, volatile LAS unsigned* st) {
    XcdBarrier b; b.bar = bar; b.x = xb_xcc_id(); b.st = st;
    if (threadIdx.x == 0) (void)xb_add(&bar[XB_XCNT(b.x)], 1u);
    return b;
}
__device__ __forceinline__ void xcd_barrier_complete(unsigned* bar, unsigned x, unsigned& nloc, unsigned& nx) {
    const unsigned G = gridDim.x * gridDim.y * gridDim.z;
    unsigned sum, cnt, mine, sp = 0u;
    for (;;) {
        sum = 0u; cnt = 0u; mine = 0u;
#pragma unroll
        for (unsigned j = 0; j < 16; ++j) { const unsigned c = xb_ld(&bar[XB_XCNT(j)]); sum += c; cnt += (c > 0u) ? 1u : 0u; mine = (j == x) ? c : mine; }
        if (sum == G) break;
        __builtin_amdgcn_s_sleep(1);
        if ((++sp & 255u) == 0u) { if (xb_ld(&bar[XB_TMO])) break; if (sp > XB_SPIN_CAP) { atomicAdd(&bar[XB_TMO], 1u); break; } }
    }
    nloc = mine > 0u ? mine : 1u; nx = cnt > 0u ? cnt : 1u;
}

__device__ __forceinline__ void xcd_barrier(const XcdBarrier& b) {
    asm volatile("s_waitcnt vmcnt(0)" ::: "memory");
    __syncthreads();
    if (threadIdx.x == 0) {
        unsigned* bar = b.bar;
        __builtin_amdgcn_s_waitcnt(0);
        unsigned nloc = b.st[0], nx = b.st[1];
        if (nloc == 0u) { xcd_barrier_complete(bar, b.x, nloc, nx); b.st[0] = nloc; b.st[1] = nx; }
        const unsigned old = xb_add(&bar[XB_XSUB(b.x)], 1u);
        const unsigned gen = old / nloc;
        if (old + 1u == (gen + 1u) * nloc) {
            __builtin_amdgcn_fence(__ATOMIC_RELEASE, "agent");
            asm volatile("s_waitcnt vmcnt(0)" ::: "memory");
            const unsigned og = xb_add(&bar[XB_TOP], 1u);
            const unsigned tg = og / nx;
            if (og + 1u == (tg + 1u) * nx) xb_add(&bar[XB_TOPGEN], 1u);
            else XB_SPIN(xb_ld(&bar[XB_TOPGEN]) == tg, bar);
            __builtin_amdgcn_fence(__ATOMIC_ACQUIRE, "agent");
            xb_add(&bar[XB_XGEN(b.x)], 1u);
            asm volatile("s_waitcnt vmcnt(0)" ::: "memory");
        } else {
            XB_SPIN(xb_ld(&bar[XB_XGEN(b.x)]) == gen, bar);
            __builtin_amdgcn_fence(__ATOMIC_ACQUIRE, "agent");
            asm volatile("s_waitcnt vmcnt(0)" ::: "memory");
        }
    }
    __syncthreads();
}

__global__ void __launch_bounds__(512) mk_fwd(Args args) {
    extern __shared__ __attribute__((aligned(16))) unsigned char lds_raw[];
    LAS unsigned char* lds = (LAS unsigned char*)lds_raw;
    cg::grid_group grid = cg::this_grid();
    const int wave = __builtin_amdgcn_readfirstlane(threadIdx.x >> 6);
    const int G = gridDim.x; const int bx = blockIdx.x;
    const int vcu = (G % 8 == 0) ? (bx % 8) * (G / 8) + bx / 8 : bx;
    const int gw = vcu * 8 + wave, NGW = G * 8;
    const int lo = args.ph_lo, hi_ph = args.ph_hi;
    volatile LAS unsigned* MISC = (volatile LAS unsigned*)(lds + 131072 + 320);
    if (threadIdx.x < 16) MISC[threadIdx.x] = 0u;
    __syncthreads();
    XcdBarrier xbar = xcd_barrier_post((unsigned*)args.ws, MISC + 8);
    int ph = 0;
#define PH_ON (ph >= lo && ph < hi_ph)
#ifdef REP_SYNC
#define SYNC_EXTRA grid.sync(); asm volatile("" ::: "memory");
#else
#define SYNC_EXTRA
#endif
#define PH_NEXT do { ++ph; if (ph > lo && ph < hi_ph) { asm volatile("s_waitcnt vmcnt(0) lgkmcnt(0)" ::: "memory"); if (ph == 1) grid.sync(); else xcd_barrier(xbar); asm volatile("" ::: "memory"); SYNC_EXTRA } } while (0)

#ifdef REP_PRO
    int rp_ = 0; pro_again:
#endif
    if (PH_ON) { DEFPTRS
        for (int i = bx * 512 + tid; i < 5 * MTOK; i += G * 512) ROWSS[MTOK + i] = 0.f;
        LAS float* cact = (LAS float*)lds;
        LAS float* red = (LAS float*)(lds + 65536);
        for (int i = tid; i < 16 * 1024; i += 512) { const int b = i >> 10, k = i & 1023; const float v = c_in[i]; cact[k * 16 + b] = v * sigmoidf_(v); }
        __syncthreads();
        for (int task = bx; task < 288; task += G) {
            const int l = task / 144, n0 = (task % 144) * 64;
            float acc[16];
#pragma unroll
            for (int b = 0; b < 16; ++b) acc[b] = 0.f;
            const float* wp = w_ada + (size_t)l * 1024 * 9216 + n0 + lane;
#pragma unroll 4
            for (int k = wave * 128; k < wave * 128 + 128; ++k) {
                const float w = wp[(size_t)k * 9216];
                const f32x4 c0 = *(const LAS f32x4*)(cact + k * 16), c1 = *(const LAS f32x4*)(cact + k * 16 + 4), c2 = *(const LAS f32x4*)(cact + k * 16 + 8), c3 = *(const LAS f32x4*)(cact + k * 16 + 12);
#pragma unroll
                for (int i = 0; i < 4; ++i) { acc[i] += c0[i] * w; acc[4 + i] += c1[i] * w; acc[8 + i] += c2[i] * w; acc[12 + i] += c3[i] * w; }
            }
#pragma unroll
            for (int b = 0; b < 16; ++b) red[(wave * 16 + b) * 64 + lane] = acc[b];
            __syncthreads();
            for (int o = tid; o < 1024; o += 512) { const int b = o >> 6, ln = o & 63; float s = 0.f;
#pragma unroll
                for (int w = 0; w < 8; ++w) s += red[(w * 16 + b) * 64 + ln];
                MOD[((size_t)l * 16 + b) * 9216 + n0 + ln] = s + b_ada[l * 9216 + n0 + ln]; }
            __syncthreads();
        }
    }
    PH_NEXT;
    if (PH_ON) { DEFPTRS
        for (int i = bx * 512 + tid; i < 2 * 3 * 16 * 1024; i += G * 512) {
            const int k = i & 1023, b = (i >> 10) & 15, lj = i >> 14, l = lj / 3, j = lj % 3;
            const float* mp = MOD + ((size_t)l * 16 + b) * 9216 + j * 3072;
            GMOD[i] = g_norm[(l * 3 + j) * 1024 + k] * (1.0f + mp[1024 + k]);
            GATE[i] = (j == 1 ? 1.0f : 0.5f) * (1.0f + mp[2048 + k]);
        }
        LAS float* scr = (LAS float*)(lds + wave * 8448);
        constexpr int I_UP = 16 * 176, I_DN = 44 * 32, I_IN = 16 * 88, I_OUT = 16 * 32;
        constexpr int NIT = 4 * I_UP + 4 * I_DN + 2 * I_IN + 2 * I_OUT;
        for (int it = gw; it < NIT; it += NGW) {
            int r = it;
            if (r < 4 * I_UP) { const int mat = r / I_UP; r -= mat * I_UP; const int kb = r / 176, nb = r % 176, n0 = nb * 32;
                const int c0 = ((n0 >> 7) & 1) * DFF + (n0 >> 8) * 128 + (n0 & 127);
                transpose_item(w_up + (size_t)mat * DM * NUP, NUP, NUP, DM, WUP + (size_t)mat * NUP * DM, n0, c0, kb * 64, scr, lane); continue; }
            r -= 4 * I_UP;
            if (r < 4 * I_DN) { const int mat = r / I_DN; r -= mat * I_DN; const int kb = r / 32, nb = r % 32;
                transpose_item(w_dn + (size_t)mat * DFF * DM, DM, DM, DFF, WDN + (size_t)mat * DM * DFF, nb * 32, nb * 32, kb * 64, scr, lane); continue; }
            r -= 4 * I_DN;
            if (r < 2 * I_IN) { const int mat = r / I_IN; r -= mat * I_IN; const int kb = r / 88, nb = r % 88;
                transpose_item(w_in + (size_t)mat * DM * 2564, 2564, 2564, DM, WIN + (size_t)mat * NINP * DM, nb * 32, nb * 32, kb * 64, scr, lane); continue; }
            r -= 2 * I_IN;
            { const int mat = r / I_OUT; r -= mat * I_OUT; const int kb = r / 32, nb = r % 32;
                transpose_item(w_out + (size_t)mat * DM * DM, DM, DM, DM, WOUT + (size_t)mat * DM * DM, nb * 32, nb * 32, kb * 64, scr, lane); }
        }
        for (int m = gw; m < MTOK; m += NGW) {
            const int b = m >> 12;
            const f32x4* xr = (const f32x4*)(x_in + (size_t)m * DM) + lane;
            const f32x4* gp = (const f32x4*)(g_norm) + lane;
            const f32x4* sp = (const f32x4*)(MOD + (size_t)b * 9216 + 1024) + lane;
            float s = 0.f; u32x2* o8 = (u32x2*)(XN + (size_t)m * DM) + lane;
#pragma unroll
            for (int j = 0; j < 4; ++j) { const f32x4 v = xr[64 * j]; s += (v[0] * v[0] + v[1] * v[1]) + (v[2] * v[2] + v[3] * v[3]);
                const f32x4 a = v * gp[64 * j] * (sp[64 * j] + 1.0f); u32x2 w; w.x = pk2(a[0], a[1]); w.y = pk2(a[2], a[3]); o8[64 * j] = w; }
            s = wave_sum(s);
            if (lane == 0) ROWSS[m] = s;
        }
    }
    PH_NEXT;
    if (PH_ON) { DEFPTRS
        LAS float* sh = (LAS float*)lds;
        for (int combo = 0; combo < 6; ++combo) {
            const int l = combo / 3, j = combo % 3;
            __syncthreads();
            for (int i = tid; i < 16 * 1024; i += 512) { const int b = i >> 10, k = i & 1023; sh[i] = MOD[((size_t)l * 16 + b) * 9216 + j * 3072 + k]; }
            __syncthreads();
            const bf16_t* Wt = (j == 1) ? WIN + (size_t)l * NINP * DM : WUP + (size_t)(l * 2 + (j == 2 ? 1 : 0)) * NUP * DM;
            const int N = (j == 1) ? NINP : NUP;
            float* dst = SBV + (size_t)combo * 16 * 5632;
            for (int n = gw; n < N; n += NGW) {
                float w[16];
#pragma unroll
                for (int c = 0; c < 4; ++c) { const u32x2 q = *(const u32x2*)(Wt + (size_t)n * DM + c * 256 + lane * 4);
                    w[4 * c] = __uint_as_float(q.x << 16); w[4 * c + 1] = __uint_as_float(q.x & 0xffff0000u); w[4 * c + 2] = __uint_as_float(q.y << 16); w[4 * c + 3] = __uint_as_float(q.y & 0xffff0000u); }
                float keep = 0.f;
#pragma unroll 1
                for (int b = 0; b < 16; ++b) { float s = 0.f;
#pragma unroll
                    for (int c = 0; c < 4; ++c) { const f32x4 v = *(const LAS f32x4*)(sh + b * 1024 + c * 256 + lane * 4); s += (w[4 * c] * v[0] + w[4 * c + 1] * v[1]) + (w[4 * c + 2] * v[2] + w[4 * c + 3] * v[3]); }
                    s = wave_sum(s); if (lane == b) keep = s; }
                if (lane < 16) dst[(size_t)lane * 5632 + n] = keep;
            }
        }
        __syncthreads();
    }
    PH_NEXT;

#ifdef REP_PRO
    if (rp_ == 0) { rp_ = 1; ph = 0; goto pro_again; }
#endif
#pragma unroll 1
    for (int f = 0; f < 4; ++f) {
        const int l = f >> 1, s = f & 1;
        if (s == 1) {
            if (PH_ON) { DEFPTRS
                pg8::Gemm g{XN, WIN + (size_t)l * NINP * DM, MTOK, NINP, DM}; pg8::StaticOrder S; S.init(MTOK, NINP, G, bx);
                pg8::EpiIn E{PROJ, FG, ROWSS + (size_t)(l * 3 + 1) * MTOK, SBV + (size_t)(l * 3 + 1) * 16 * 5632};
#ifndef NO_G_IN
                pg8::gemm_phase<pg8::EpiIn, pg8::StaticOrder, true, true>(lds, g, S, E);
#endif
            }
            PH_NEXT;
            if (PH_ON) { DEFPTRS
#ifndef NO_PREP
                const int blk = gw & 7, ch = blk * 64 + lane;
                LAS float* ul = (LAS float*)(lds + wave * 8448);
                LAS float* xs = ul + 64;
                f32x2 w2[64];
#pragma unroll
                for (int i = 0; i < 64; ++i) { const size_t o = ((size_t)(l * 8 + blk) * 64 + i) * 64 + lane; w2[i] = (f32x2){w_rg[o], w_ig[o]}; }
                const float br = b_rg[l * 512 + ch], bi = b_ig[l * 512 + ch], cb = conv_b[l * 512 + ch];
                const float cw0 = conv_w[(l * 4 + 0) * 512 + ch], cw1 = conv_w[(l * 4 + 1) * 512 + ch], cw2 = conv_w[(l * 4 + 2) * 512 + ch], cw3 = conv_w[(l * 4 + 3) * 512 + ch];
                const float lmv = lam[l * 512 + ch];
                const float spl = __builtin_fmaxf(-lmv, 0.f) + log1pf(expf(-fabsf(lmv)));
                const float c8 = -8.0f * spl * LOG2E;
                for (int segi = gw >> 3; segi < REP_PREP * (MTOK / 32); segi += NGW >> 3) { const int seg = segi & (MTOK / 32 - 1);
                    const int row0 = seg * 32; const bf16_t* xp = PROJ + (size_t)row0 * PPITCH + ch;
                    float xm3 = 0.f, xm2 = 0.f, xm1 = 0.f;
                    if ((row0 & (SEQL - 1)) != 0) { xm3 = bf2f(xp[-3 * PPITCH]); xm2 = bf2f(xp[-2 * PPITCH]); xm1 = bf2f(xp[-1 * PPITCH]); }
#pragma unroll
                    for (int t = 0; t < 32; ++t) xs[t * 64 + lane] = bf2f(xp[(size_t)t * PPITCH]);
                    float hs = 0.f, P = 1.f;
                    float* hl = HLOC + (size_t)row0 * 512 + ch; bf16_t* pc = PCUM + (size_t)row0 * 512 + ch;
#pragma unroll 1
                    for (int t = 0; t < 32; ++t) {
                        const float x0 = xs[t * 64 + lane];
                        const float u = cb + cw0 * xm3 + cw1 * xm2 + cw2 * xm1 + cw3 * x0; xm3 = xm2; xm2 = xm1; xm1 = x0;
                        CFENCE(); ul[lane] = u; CFENCE();
                        f32x2 acc = (f32x2){br, bi};
#pragma unroll
                        for (int i4 = 0; i4 < 16; ++i4) { const f32x4 uu = *(const LAS f32x4*)(ul + 4 * i4);
                            acc += w2[4 * i4] * uu[0]; acc += w2[4 * i4 + 1] * uu[1]; acc += w2[4 * i4 + 2] * uu[2]; acc += w2[4 * i4 + 3] * uu[3]; }
                        CFENCE();
                        const float r = sigmoidf_(acc[0]), ig = sigmoidf_(acc[1]);
                        const float la2 = c8 * r, a = __builtin_amdgcn_exp2f(la2);
                        const float xx = 2.0f * 0.6931471805599453f * la2;
                        const float om = (xx > -0.25f) ? -xx * (1.0f + xx * 0.5f * (1.0f + xx * (1.0f / 3.0f) * (1.0f + xx * 0.25f * (1.0f + xx * 0.2f)))) : 1.0f - a * a;
                        const float bt = __builtin_sqrtf(om) * ig * u;
                        hs = a * hs + bt; P *= a;
                        hl[(size_t)t * 512] = hs; pc[(size_t)t * 512] = (bf16_t)f2bf(P);
                    }
                    ASEG[(size_t)seg * 512 + ch] = P; BSEG[(size_t)seg * 512 + ch] = hs;
                }
                for (int row = gw; row < MTOK; row += NGW) {
                    const u32x2 q = *(const u32x2*)(PROJ + (size_t)row * PPITCH + 2048 + lane * 4);
                    const float a0 = __uint_as_float(q.x << 16), a1 = __uint_as_float(q.x & 0xffff0000u), a2 = __uint_as_float(q.y << 16), a3 = __uint_as_float(q.y & 0xffff0000u);
                    float ss = (a0 * a0 + a1 * a1) + (a2 * a2 + a3 * a3);
                    ss += __shfl_xor(ss, 1); ss += __shfl_xor(ss, 2); ss += __shfl_xor(ss, 4); ss += __shfl_xor(ss, 8);
                    if ((lane & 15) == 0) KS[(size_t)((row >> 12) * 4 + (lane >> 4)) * SEQL + (row & (SEQL - 1))] = __builtin_amdgcn_rsqf(ss * (1.0f / 64.0f) + EPSF);
                }
                if (wave == 0) for (int chn = vcu; chn < 64; chn += G) {
                    const int b = chn >> 2, h = chn & 3; const float bf = b_fg[l * 4 + h];
                    const float* fp = FG + ((size_t)b * SEQL + lane * 64) * 4 + h;
                    float tot = 0.f;
#pragma unroll 8
                    for (int i = 0; i < 64; ++i) { const float v = fp[i * 4] + bf; tot += __builtin_fminf(v, 0.f) - log1pf(expf(-fabsf(v))); }
                    float inc = tot;
#pragma unroll
                    for (int o = 1; o < 64; o <<= 1) { const float t_ = __shfl_up(inc, o); if (lane >= o) inc += t_; }
                    float run = inc - tot;
                    float* op = F2 + (size_t)chn * SEQL + lane * 64;
#pragma unroll 8
                    for (int i = 0; i < 64; ++i) { const float v = fp[i * 4] + bf; run += __builtin_fminf(v, 0.f) - log1pf(expf(-fabsf(v))); op[i] = run * LOG2E; }
                }
#endif
                __syncthreads();
            }
            PH_NEXT;
            if (PH_ON) { DEFPTRS
#ifndef NO_ATTN
                for (int rep_ = 0; rep_ < REP_ATTN; ++rep_)
                for (int vw = vcu; vw < 256; vw += G) {
                    const int bh = vw >> 2, s4 = vw & 3, b = bh >> 2, h = bh & 3;
#pragma unroll 1
                    for (int i = 0; i < 4; ++i) { const int qb = (i == 0) ? s4 : (i == 1) ? 7 - s4 : (i == 2) ? 8 + s4 : 15 - s4;
#ifndef NO_FOX
                        attn_unit<1>(lds, PROJ, YU, KS, F2, g_qk + l * 128, b, h, qb);
#endif
 }
#pragma unroll 1
                    for (int i = 0; i < 4; ++i) { const int qb = (i == 0) ? s4 : (i == 1) ? 7 - s4 : (i == 2) ? 8 + s4 : 15 - s4;
#ifndef NO_SB
                        attn_unit<0>(lds, PROJ, YU, KS, F2, g_qk + l * 128, b, h, qb);
#endif
 }
                }
#endif
            }
            PH_NEXT;
            if (PH_ON) { DEFPTRS
                LAS float* hin = (LAS float*)lds;
                const f32x4 gm0 = *(const f32x4*)(g_mix + l * 1024 + lane * 8), gm1 = *(const f32x4*)(g_mix + l * 1024 + lane * 8 + 4);
                const f32x4 gx0 = *(const f32x4*)(g_mix + l * 1024 + 512 + lane * 8), gx1 = *(const f32x4*)(g_mix + l * 1024 + 512 + lane * 8 + 4);
                for (int tti = vcu; tti < REP_FIN * 256; tti += G) { const int tt = tti & 255;
                    __syncthreads();
                    { const int ch = tid, seg0 = (tt >> 4) * 128, nb = (tt & 15) * 8; float Hc = 0.f;
#pragma unroll 8
                      for (int sg = 0; sg < nb; ++sg) Hc = ASEG[(size_t)(seg0 + sg) * 512 + ch] * Hc + BSEG[(size_t)(seg0 + sg) * 512 + ch];
#pragma unroll
                      for (int s8 = 0; s8 < 8; ++s8) { hin[s8 * 512 + ch] = Hc; Hc = ASEG[(size_t)(seg0 + nb + s8) * 512 + ch] * Hc + BSEG[(size_t)(seg0 + nb + s8) * 512 + ch]; } }
                    __syncthreads();
                    const f32x4 hi0 = *(const LAS f32x4*)(hin + wave * 512 + lane * 8), hi1 = *(const LAS f32x4*)(hin + wave * 512 + lane * 8 + 4);
#pragma unroll 2
                    for (int t = 0; t < 32; ++t) {
                        const size_t row = (size_t)tt * 256 + wave * 32 + t;
                        const f32x4 h0 = *(const f32x4*)(HLOC + row * 512 + lane * 8), h1 = *(const f32x4*)(HLOC + row * 512 + lane * 8 + 4);
                        const u32x4 pq = *(const u32x4*)(PCUM + row * 512 + lane * 8);
                        const u32x4 gq = *(const u32x4*)(PROJ + row * PPITCH + 512 + lane * 8);
                        const u32x4 yq = *(const u32x4*)(YU + row * 512 + lane * 8);
                        float y[8], yu[8]; float ss = 0.f, s2 = 0.f;
#pragma unroll
                        for (int i = 0; i < 8; ++i) {
                            const unsigned pw = pq[i >> 1], gw_ = gq[i >> 1], yw = yq[i >> 1];
                            const float p = (i & 1) ? __uint_as_float(pw & 0xffff0000u) : __uint_as_float(pw << 16);
                            const float gg = (i & 1) ? __uint_as_float(gw_ & 0xffff0000u) : __uint_as_float(gw_ << 16);
                            yu[i] = (i & 1) ? __uint_as_float(yw & 0xffff0000u) : __uint_as_float(yw << 16);
                            const float hh = (i < 4 ? h0[i & 3] : h1[i & 3]) + p * (i < 4 ? hi0[i & 3] : hi1[i & 3]);
                            const float inner = 0.7978845608028654f * (gg + 0.044715f * gg * gg * gg);
                            const float ge = gg * __builtin_amdgcn_rcpf(1.0f + __builtin_amdgcn_exp2f(-2.0f * LOG2E * inner));
                            y[i] = hh * ge; ss += y[i] * y[i]; s2 += yu[i] * yu[i];
                        }
                        ss = wave_sum(ss);
                        s2 += __shfl_xor(s2, 1); s2 += __shfl_xor(s2, 2); s2 += __shfl_xor(s2, 4); s2 += __shfl_xor(s2, 8); s2 += __shfl_xor(s2, 16);
                        const float rl = __builtin_amdgcn_rsqf(ss * (1.0f / 512.0f) + EPSF), rx = __builtin_amdgcn_rsqf(s2 * (1.0f / 256.0f) + EPSF);
                        u32x4 o1, o2;
                        o1.x = pk2(y[0] * rl * gm0[0], y[1] * rl * gm0[1]); o1.y = pk2(y[2] * rl * gm0[2], y[3] * rl * gm0[3]);
                        o1.z = pk2(y[4] * rl * gm1[0], y[5] * rl * gm1[1]); o1.w = pk2(y[6] * rl * gm1[2], y[7] * rl * gm1[3]);
                        o2.x = pk2(yu[0] * rx * gx0[0], yu[1] * rx * gx0[1]); o2.y = pk2(yu[2] * rx * gx0[2], yu[3] * rx * gx0[3]);
                        o2.z = pk2(yu[4] * rx * gx1[0], yu[5] * rx * gx1[1]); o2.w = pk2(yu[6] * rx * gx1[2], yu[7] * rx * gx1[3]);
                        *(u32x4*)(YN + row * 1024 + lane * 8) = o1; *(u32x4*)(YN + row * 1024 + 512 + lane * 8) = o2;
                    }
                }
                __syncthreads();
            }
            PH_NEXT;
            if (PH_ON) { DEFPTRS
                pg8::Gemm g{YN, WOUT + (size_t)l * DM * DM, MTOK, DM, DM}; pg8::StaticOrder S; S.init(MTOK, DM, G, bx);
                pg8::EpiRes E{xout, xout, GATE + (size_t)(l * 3 + 1) * 16 * 1024, GMOD + (size_t)(l * 3 + 2) * 16 * 1024, XN, ROWSS + (size_t)(l * 3 + 2) * MTOK, 1};
#ifndef NO_G_OUT
                pg8::gemm_phase<pg8::EpiRes, pg8::StaticOrder, true, true>(lds, g, S, E);
#endif
            }
            PH_NEXT;
        }
        const int j = s ? 2 : 0;
        if (PH_ON) { DEFPTRS
            pg8::Gemm g{XN, WUP + (size_t)(l * 2 + s) * NUP * DM, MTOK, NUP, DM}; pg8::StaticOrder S; S.init(MTOK, NUP, G, bx);
            pg8::EpiUp E{HB, ROWSS + (size_t)(l * 3 + j) * MTOK, SBV + (size_t)(l * 3 + j) * 16 * 5632};
#ifndef NO_G_UP
            for (int rep_ = 0; rep_ < REP_UP; ++rep_) {
            pg8::gemm_phase<pg8::EpiUp, pg8::StaticOrder, true, true>(lds, g, S, E);
            }
#endif
        }
        PH_NEXT;
        if (PH_ON) { DEFPTRS
            const int nl = s ? l + 1 : l, nj = s ? 0 : 1; const int has_next = (nl < 2) ? 1 : 0; const int nidx = has_next ? nl * 3 + nj : 0;
            pg8::Gemm g{HB, WDN + (size_t)(l * 2 + s) * DM * DFF, MTOK, DM, DFF}; pg8::StaticOrder S; S.init(MTOK, DM, G, bx);
            pg8::EpiRes E{f == 0 ? x_in : xout, xout, GATE + (size_t)(l * 3 + j) * 16 * 1024, GMOD + (size_t)nidx * 16 * 1024, XN, ROWSS + (size_t)nidx * MTOK, has_next};
#ifndef NO_G_DN
#ifdef REP_DN
            for (int rep_ = 0; rep_ < 2; ++rep_) { E.xout = (rep_ == 0) ? HLOC : xout;
            pg8::gemm_phase<pg8::EpiRes, pg8::StaticOrder, true, true>(lds, g, S, E); }
#else
            pg8::gemm_phase<pg8::EpiRes, pg8::StaticOrder, true, true>(lds, g, S, E);
#endif
#endif
        }
        PH_NEXT;
    }
#undef PH_ON
#undef PH_NEXT
}


#ifdef DBG_STOP
__global__ void dbg_dump(const unsigned char* ws, float* out, int mode) {
    const size_t n = (size_t)MTOK * DM; const size_t i0 = (size_t)blockIdx.x * blockDim.x + threadIdx.x, st = (size_t)gridDim.x * blockDim.x;
    const bf16_t* XN = (const bf16_t*)(ws + WS_XN); const bf16_t* HB = (const bf16_t*)(ws + WS_H); const bf16_t* PR = (const bf16_t*)(ws + WS_PROJ);
    const bf16_t* YU = (const bf16_t*)(ws + WS_YU); const float* HL = (const float*)(ws + WS_HLOC); const bf16_t* YN = (const bf16_t*)(ws + WS_YN); const bf16_t* PC = (const bf16_t*)(ws + WS_PCUM);
    for (size_t i = i0; i < n; i += st) {
        float v = 0.f;
        if (mode == 0) v = bf2f(XN[i]);
        else if (mode == 1) v = bf2f(HB[i]) + bf2f(HB[i + n]) + bf2f(HB[i + (size_t)117440512]);
        else if (mode == 2) v = bf2f(PR[i]) + bf2f(PR[i + n]) + bf2f(PR[i + (size_t)100663296]);
        else if (mode == 3) v = (i < n / 2) ? bf2f(YU[i]) : HL[i - n / 2];
        else if (mode == 4) v = bf2f(YN[i]);
        else if (mode == 6) v = (i < n / 2) ? bf2f(PC[i]) : ((const float*)(ws + WS_KS))[(i - n / 2) % (3 * 262144)];
        else if (mode == 7) v = HL[i % (n / 2)] + bf2f(PC[i % (n / 2)]) + ((const float*)(ws + WS_KS))[i % (3 * 262144)] + ((const float*)(ws + WS_ASEG))[i % (2 * 1048576)];
        if (mode == 3) { const bool nan_ = !(v == v), big = (v > 3e38f) || (v < -3e38f); float code = 0.f;
            if (i < n / 2) { const int col = (int)(i & 511); if (col < 256) code = nan_ ? 2000.f : (big ? 1000.f : 0.f); else code = (nan_ || big) ? 4000.f : 0.f; }
            else code = (nan_ || big) ? 8000.f : 0.f;
            v = code; }
        if (!(v == v)) v = 77777.f; if (v > 3e38f) v = 88888.f; if (v < -3e38f) v = 99999.f;
        if (mode != 5) out[i] = v;
    }
}
#endif
#ifndef MK_N_LAUNCHES
#define MK_N_LAUNCHES 1
#endif
constexpr int N_PHASES = 3 + 2 * 9;
extern "C" void kernel_launch(void* const* d_in, const int* in_sizes, int n_in, void* d_out, int out_size, void* d_ws, size_t ws_size, hipStream_t stream) {
    static int grid = 0;
    if (grid == 0) {
        if (n_in != 19 || out_size != MTOK * DM || ws_size < WS_END) { fprintf(stderr, "kernel_launch: unexpected shapes (n_in %d, out %d, ws %zu)\n", n_in, out_size, ws_size); grid = -1; return; }
        int dev = 0, cus = 0, per_cu = 0;
        hipGetDevice(&dev); hipDeviceGetAttribute(&cus, hipDeviceAttributeMultiprocessorCount, dev);
        if (hipFuncSetAttribute((const void*)mk_fwd, hipFuncAttributeMaxDynamicSharedMemorySize, LDS_BYTES) != hipSuccess) { fprintf(stderr, "kernel_launch: hipFuncSetAttribute failed\n"); grid = -1; return; }
        if (hipOccupancyMaxActiveBlocksPerMultiprocessor(&per_cu, (const void*)mk_fwd, 512, LDS_BYTES) != hipSuccess || per_cu < 1) { fprintf(stderr, "kernel_launch: occupancy query says %d\n", per_cu); per_cu = 1; }
        (void)hipGetLastError();
        grid = cus * 1;
    }
    if (grid < 0) return;
    if (hipMemsetAsync(d_ws, 0, 16384, stream) != hipSuccess) { fprintf(stderr, "kernel_launch: memset failed\n"); return; }
    Args a{};
    for (int i = 0; i < 19; ++i) a.in[i] = (const float*)d_in[i];
    a.out = (float*)d_out; a.ws = (unsigned char*)d_ws;
#if MK_N_LAUNCHES == 1
    a.ph_lo = 0; a.ph_hi = N_PHASES;
    void* kargs[] = {&a};
    hipError_t e = hipLaunchCooperativeKernel((const void*)mk_fwd, dim3(grid), dim3(512), kargs, LDS_BYTES, stream);
    if (e != hipSuccess) fprintf(stderr, "kernel_launch: cooperative launch failed: %s (grid %d)\n", hipGetErrorString(e), grid);
#else
#ifdef DBG_STOP
    for (int p = 0; p < DBG_STOP; ++p) { a.ph_lo = p; a.ph_hi = p + 1; hipLaunchKernelGGL(mk_fwd, dim3(grid), dim3(512), LDS_BYTES, stream, a); }
    hipLaunchKernelGGL(dbg_dump, dim3(2048), dim3(256), 0, stream, (const unsigned char*)d_ws, (float*)d_out, DBG_MODE);
#else
    for (int p = 0; p < N_PHASES; ++p) { a.ph_lo = p; a.ph_hi = p + 1; hipLaunchKernelGGL(mk_fwd, dim3(grid), dim3(512), LDS_BYTES, stream, a); }
#endif
#endif
}
```

```cpp
#include <hip/hip_runtime.h>
#include <hip/hip_cooperative_groups.h>
#include <cstdio>
#include <cstdint>
namespace cg = cooperative_groups;
namespace pg8 {
#define PG8_LAS __attribute__((address_space(3)))
typedef unsigned short bf16_t;
typedef short bf16x8 __attribute__((ext_vector_type(8)));
typedef float f32x4 __attribute__((ext_vector_type(4)));
typedef unsigned u32x4 __attribute__((ext_vector_type(4)));
constexpr int BM = 256, BK = 64, HALF = 128, HTB = HALF * BK * 2  , STAGE_BYTES = 8 * HTB, NXCD = 8, WGM = 8;

__host__ __device__ __forceinline__ int lds_byte(int r, int c) { const int st = (r >> 4) * 2 + (c >> 5), rr = r & 15, cc = c & 31, ob = rr * 64 + cc * 2; return st * 1024 + (ob ^ (((ob >> 9) & 1) << 5)); }
__host__ __device__ __forceinline__ void stage_rc(int b, int& R, int& C) { const int st = b / 1024, sb = b % 1024, swz = sb ^ (((sb >> 9) & 1) << 5); R = (st >> 1) * 16 + swz / 64; C = (st & 1) * 32 + (swz % 64) / 2; }
__host__ __device__ __forceinline__ int perm32(int rho) { const int n = rho >> 4, i = rho & 15; return 8 * (i >> 2) + 4 * n + (i & 3); }

struct Unit { int pm, pn; };
struct Gemm { const bf16_t* A; const bf16_t* Bt; int M, N, K; };

struct StaticOrder {
    int nM, nN, nwg, G, c;
    __host__ __device__ void init(int M, int N, int G_, int c_) { nM = M / BM; nN = N / BM; nwg = nM * nN; G = G_; c = c_; }
    __host__ __device__ bool next(int i, Unit& u) const {
        const long L = (long)i * G + c; if (L >= nwg) return false;
        int wgid = (int)L; { const int q = nwg / NXCD, r = nwg % NXCD, xcd = wgid % NXCD, off = wgid / NXCD; wgid = (xcd < r ? xcd * (q + 1) : r * (q + 1) + (xcd - r) * q) + off; }
        const int nig = WGM * nN, gid = wgid / nig, fm = gid * WGM, gsz = (nM - fm) < WGM ? (nM - fm) : WGM;
        u.pm = fm + ((wgid % nig) % gsz); u.pn = (wgid % nig) / gsz; return true;
    }
    __device__ __forceinline__ void a_ready(const Unit&) const {}
    __device__ __forceinline__ void done(const Unit&) const {}
};

typedef float f32x2c_t __attribute__((ext_vector_type(2))); typedef __bf16 bf16x2c_t __attribute__((ext_vector_type(2)));
__device__ __forceinline__ unsigned cvt_pk_bf16(float lo, float hi) { f32x2c_t v = {lo, hi}; bf16x2c_t b = __builtin_convertvector(v, bf16x2c_t); return __builtin_bit_cast(unsigned, b); }
typedef float f32x2 __attribute__((ext_vector_type(2)));
constexpr float RMS_EPS = 1e-6f;
struct EpiUp {
    static constexpr bool PERM = true, AFTER_DRAIN = false;
    bf16_t* H; const float* rowss; const float* sb;
    __device__ __forceinline__ void operator()(const f32x4 (&acc)[2][2][4][2], const Unit& u, int wr, int wc, int fr, int fq) const {
        const int row0 = u.pm * BM + wr * 64 + fr, b = u.pm >> 4, cl = wc * 32 + 8 * fq;
        const float* sbp = sb + (size_t)b * 5632 + u.pn * 256 + cl;
        float rsv[2][4];
#pragma unroll
        for (int ai = 0; ai < 2; ++ai)
#pragma unroll
            for (int m = 0; m < 4; ++m) rsv[ai][m] = rowss[row0 + ai * HALF + m * 16];
        f32x4 sg[2], su[2];
#pragma unroll
        for (int n = 0; n < 2; ++n) { sg[n] = *(const f32x4*)(sbp + 4 * n); su[n] = *(const f32x4*)(sbp + 128 + 4 * n); }
#pragma unroll
        for (int ai = 0; ai < 2; ++ai)
#pragma unroll
            for (int m = 0; m < 4; ++m) {
                const int row = row0 + ai * HALF + m * 16;
                const float rs = __builtin_amdgcn_rsqf(rsv[ai][m] * (1.0f / 1024.0f) + RMS_EPS);
                float hv[8];
#pragma unroll
                for (int n = 0; n < 2; ++n)
#pragma unroll
                    for (int i = 0; i < 4; ++i) {
                        const float g = rs * acc[ai][0][m][n][i] + sg[n][i], uu = rs * acc[ai][1][m][n][i] + su[n][i];
                        hv[n * 4 + i] = g * __builtin_amdgcn_rcpf(1.0f + __builtin_amdgcn_exp2f(-1.4426950408889634f * g)) * uu;
                    }
                u32x4 w; w.x = cvt_pk_bf16(hv[0], hv[1]); w.y = cvt_pk_bf16(hv[2], hv[3]); w.z = cvt_pk_bf16(hv[4], hv[5]); w.w = cvt_pk_bf16(hv[6], hv[7]);
                *(u32x4*)(H + (size_t)row * 2816 + u.pn * 128 + cl) = w;
            }
    }
};
struct EpiIn {
    static constexpr bool PERM = true, AFTER_DRAIN = false;
    bf16_t* P; float* FG; const float* rowss; const float* sb;
    __device__ __forceinline__ void operator()(const f32x4 (&acc)[2][2][4][2], const Unit& u, int wr, int wc, int fr, int fq) const {
        const int row0 = u.pm * BM + wr * 64 + fr, b = u.pm >> 4, cl = wc * 32 + 8 * fq;
        const float* sbp = sb + (size_t)b * 5632 + u.pn * 256 + cl;
        float rsv[2][4];
#pragma unroll
        for (int ai = 0; ai < 2; ++ai)
#pragma unroll
            for (int m = 0; m < 4; ++m) rsv[ai][m] = rowss[row0 + ai * HALF + m * 16];
        f32x4 sv[2][2];
#pragma unroll
        for (int bj = 0; bj < 2; ++bj)
#pragma unroll
            for (int n = 0; n < 2; ++n) sv[bj][n] = *(const f32x4*)(sbp + bj * HALF + 4 * n);
#pragma unroll
        for (int ai = 0; ai < 2; ++ai)
#pragma unroll
            for (int m = 0; m < 4; ++m) {
                const int row = row0 + ai * HALF + m * 16;
                const float rs = __builtin_amdgcn_rsqf(rsv[ai][m] * (1.0f / 1024.0f) + RMS_EPS);
                if (u.pn < 10) {
#pragma unroll
                    for (int bj = 0; bj < 2; ++bj) {
                        const f32x4 v0 = acc[ai][bj][m][0] * rs + sv[bj][0], v1 = acc[ai][bj][m][1] * rs + sv[bj][1];
                        u32x4 w; w.x = cvt_pk_bf16(v0[0], v0[1]); w.y = cvt_pk_bf16(v0[2], v0[3]); w.z = cvt_pk_bf16(v1[0], v1[1]); w.w = cvt_pk_bf16(v1[2], v1[3]);
                        *(u32x4*)(P + (size_t)row * 2560 + u.pn * 256 + bj * HALF + cl) = w;
                    }
                } else if (wc == 0 && fq == 0) {
                    *(f32x4*)(FG + (size_t)row * 4) = acc[ai][0][m][0] * rs + sv[0][0];
                }
            }
    }
};
struct EpiRes {
    static constexpr bool PERM = false, AFTER_DRAIN = false;
    const float* xin; float* xout; const float* gate; const float* gmn; bf16_t* XN; float* rowssn; int has_next;
    __device__ __forceinline__ void operator()(const f32x4 (&acc)[2][2][4][2], const Unit& u, int wr, int wc, int fr, int fq) const {
        typedef unsigned u32x2v __attribute__((ext_vector_type(2)));
        const int row0 = u.pm * BM + wr * 64 + fr, b = u.pm >> 4, col0 = u.pn * BM + wc * 32 + 4 * fq;
        const float* gp_ = gate + b * 1024 + col0; const float* gm_ = gmn + b * 1024 + col0;
#pragma unroll
        for (int ai = 0; ai < 2; ++ai) {
            f32x4 xi[4][2][2];
#pragma unroll
            for (int m = 0; m < 4; ++m)
#pragma unroll
                for (int bj = 0; bj < 2; ++bj)
#pragma unroll
                    for (int n = 0; n < 2; ++n) xi[m][bj][n] = *(const f32x4*)(xin + (size_t)(row0 + ai * HALF + m * 16) * 1024 + col0 + bj * HALF + n * 16);
            asm volatile("" ::: "memory");
#pragma unroll
            for (int m = 0; m < 4; ++m) {
                const int row = row0 + ai * HALF + m * 16; const size_t off = (size_t)row * 1024 + col0;
                float ss = 0.f;
#pragma unroll
                for (int bj = 0; bj < 2; ++bj)
#pragma unroll
                    for (int n = 0; n < 2; ++n) {
                        const f32x4 xo = xi[m][bj][n] + *(const f32x4*)(gp_ + bj * HALF + n * 16) * acc[ai][bj][m][n];
                        *(f32x4*)(xout + off + bj * HALF + n * 16) = xo;
                        if (has_next) {
                            ss += (xo[0] * xo[0] + xo[1] * xo[1]) + (xo[2] * xo[2] + xo[3] * xo[3]);
                            const f32x4 a = xo * *(const f32x4*)(gm_ + bj * HALF + n * 16); u32x2v w; w.x = cvt_pk_bf16(a[0], a[1]); w.y = cvt_pk_bf16(a[2], a[3]);
                            *(u32x2v*)(XN + off + bj * HALF + n * 16) = w;
                        }
                    }
                if (has_next) { ss += __shfl_xor(ss, 16); ss += __shfl_xor(ss, 32); if (fq == 0) unsafeAtomicAdd(rowssn + row, ss); }
            }
            asm volatile("" ::: "memory");
        }
    }
};

template <class Epi, class Sched, bool ALIGN_EPI = false, bool SP2 = false>
__device__ __forceinline__ void gemm_phase(PG8_LAS unsigned char* lds, const Gemm g, const Sched& S, const Epi& E) {
    int tid_o = threadIdx.x; asm volatile("" : "+v"(tid_o)); const int tid = tid_o, wid = __builtin_amdgcn_readfirstlane(tid >> 6), lane = tid & 63, wr = wid >> 2, wc = wid & 3, fr = lane & 15, fq = lane >> 4;
    const int K = g.K, nt = K / BK;
    unsigned voffA[2], voffB[2];
#pragma unroll
    for (int i = 0; i < 2; ++i) { int R, C; stage_rc(tid * 16 + i * 8192, R, C); const int Rb = Epi::PERM ? ((R & ~31) + perm32(R & 31)) : R;
        voffA[i] = (unsigned)(R * K + C) * 2u; voffB[i] = (unsigned)(Rb * K + C) * 2u; }
    const size_t kstep = (size_t)(BK * 2);
    const size_t hstep = (size_t)HALF * K * 2;
    const size_t tstep = 2 * hstep;
    const unsigned ldsw = (unsigned)wid * 1024u;
    const int aoff = lds_byte(wr * 64 + fr, fq * 8), boff = lds_byte(wc * 32 + fr, fq * 8);
#define PG8_SA(b, h) (((b) * 2 + (h)) * HTB)
#define PG8_SB(b, h) ((4 + (b) * 2 + (h)) * HTB)
#define PG8_STAGE(bufoff, gbase, voff) do { _Pragma("unroll") for (int _i = 0; _i < 2; ++_i) \
        __builtin_amdgcn_global_load_lds((const unsigned*)((const char*)(gbase) + (voff)[_i]), (PG8_LAS unsigned*)(lds + (bufoff) + ldsw + _i * 8192), 16, 0, 0); } while (0)
#define PG8_LDA(dst, b, h) do { _Pragma("unroll") for (int m = 0; m < 4; ++m) _Pragma("unroll") for (int k = 0; k < 2; ++k) dst[m][k] = *(const PG8_LAS bf16x8*)(lds + PG8_SA(b, h) + aoff + m * 2048 + k * 1024); } while (0)
#define PG8_LDB(dst, b, h) do { _Pragma("unroll") for (int n = 0; n < 2; ++n) _Pragma("unroll") for (int k = 0; k < 2; ++k) dst[n][k] = *(const PG8_LAS bf16x8*)(lds + PG8_SB(b, h) + boff + n * 2048 + k * 1024); } while (0)
#define PG8_MMA(ai, bj, At, Bt) do { __builtin_amdgcn_s_setprio(1); _Pragma("unroll") for (int m = 0; m < 4; ++m) _Pragma("unroll") for (int n = 0; n < 2; ++n) _Pragma("unroll") for (int k = 0; k < 2; ++k) \
        acc[ai][bj][m][n] = __builtin_amdgcn_mfma_f32_16x16x32_bf16(Bt[n][k], At[m][k], acc[ai][bj][m][n], 0, 0, 0); __builtin_amdgcn_s_setprio(0); } while (0)
#define PG8_WAIT_V(n) asm volatile("s_waitcnt vmcnt(" #n ")" ::: "memory")
#define PG8_WAIT_L(n) asm volatile("s_waitcnt lgkmcnt(" #n ")" ::: "memory")
#define PG8_BAR __builtin_amdgcn_s_barrier()
#define PG8_SCHED __builtin_amdgcn_sched_barrier(0)
    Unit cur, nxt; int ui = 0;
    if (!S.next(0, cur)) return;
    f32x4 acc[2][2][4][2];
#pragma unroll
    for (int a = 0; a < 2; ++a)
#pragma unroll
        for (int b = 0; b < 2; ++b)
#pragma unroll
            for (int m = 0; m < 4; ++m)
#pragma unroll
                for (int n = 0; n < 2; ++n) acc[a][b][m][n] = (f32x4){0.f, 0.f, 0.f, 0.f};
    bf16x8 At[4][2], B0[2][2], B1[2][2];
    const char* cA = (const char*)g.A + (size_t)cur.pm * tstep; const char* cB = (const char*)g.Bt + (size_t)cur.pn * tstep;
    S.a_ready(cur);
    if constexpr (SP2) {
        PG8_STAGE(PG8_SB(0, 0), cB, voffB); PG8_STAGE(PG8_SB(0, 1), cB + hstep, voffB); PG8_STAGE(PG8_SA(0, 0), cA, voffA); PG8_STAGE(PG8_SA(0, 1), cA + hstep, voffA);
        if (wr == 1) PG8_BAR;
        PG8_WAIT_V(2); PG8_BAR;
        PG8_STAGE(PG8_SB(1, 0), cB + kstep, voffB); PG8_STAGE(PG8_SA(1, 0), cA + kstep, voffA); PG8_STAGE(PG8_SB(1, 1), cB + hstep + kstep, voffB);
        PG8_WAIT_V(6); PG8_BAR;
    } else {
        PG8_STAGE(PG8_SB(0, 0), cB, voffB); PG8_STAGE(PG8_SA(0, 0), cA, voffA); PG8_STAGE(PG8_SB(0, 1), cB + hstep, voffB); PG8_STAGE(PG8_SA(0, 1), cA + hstep, voffA);
        if (wr == 1) PG8_BAR;
        PG8_WAIT_V(4); PG8_BAR;
        PG8_STAGE(PG8_SB(1, 0), cB + kstep, voffB); PG8_STAGE(PG8_SA(1, 0), cA + kstep, voffA); PG8_STAGE(PG8_SB(1, 1), cB + hstep + kstep, voffB);
        PG8_WAIT_V(6); PG8_BAR;
    }
    for (;;) {
        const bool has_next = S.next(ui + 1, nxt);
        const char* nA = has_next ? (const char*)g.A + (size_t)nxt.pm * tstep : cA; const char* nB = has_next ? (const char*)g.Bt + (size_t)nxt.pn * tstep : cB;
        for (int t = 0; t < nt; t += 2) {
            const bool last = (t == nt - 2);
            const char* a1 = cA + (size_t)(t + 1) * kstep;
            const char* a2 = last ? nA : cA + (size_t)(t + 2) * kstep; const char* b2 = last ? nB : cB + (size_t)(t + 2) * kstep;
            const char* a3 = a2 + kstep; const char* b3 = b2 + kstep;
            if (last && has_next) S.a_ready(nxt);
            if constexpr (SP2) {
            PG8_LDB(B0, 0, 0); PG8_LDB(B1, 0, 1); PG8_SCHED; PG8_LDA(At, 0, 0); PG8_STAGE(PG8_SA(1, 1), a1 + hstep, voffA);
            PG8_WAIT_V(8); PG8_WAIT_L(0); PG8_BAR; PG8_MMA(0, 0, At, B0); PG8_MMA(0, 1, At, B1); PG8_BAR; PG8_SCHED;
            PG8_LDA(At, 0, 1); PG8_STAGE(PG8_SB(0, 0), b2, voffB); PG8_STAGE(PG8_SB(0, 1), b2 + hstep, voffB); PG8_STAGE(PG8_SA(0, 0), a2, voffA);
            PG8_WAIT_V(8); PG8_WAIT_L(0); PG8_BAR; PG8_MMA(1, 0, At, B0); PG8_MMA(1, 1, At, B1); PG8_BAR; PG8_SCHED;
            PG8_LDB(B0, 1, 0); PG8_LDB(B1, 1, 1); PG8_SCHED; PG8_LDA(At, 1, 0); PG8_STAGE(PG8_SA(0, 1), a2 + hstep, voffA);
            PG8_WAIT_V(8); PG8_WAIT_L(0); PG8_BAR; PG8_MMA(0, 0, At, B0); PG8_MMA(0, 1, At, B1); PG8_BAR; PG8_SCHED;
            PG8_LDA(At, 1, 1); PG8_STAGE(PG8_SB(1, 0), b3, voffB); PG8_STAGE(PG8_SB(1, 1), b3 + hstep, voffB); PG8_STAGE(PG8_SA(1, 0), a3, voffA);
            PG8_WAIT_V(8); PG8_WAIT_L(0); PG8_BAR; PG8_MMA(1, 0, At, B0); PG8_MMA(1, 1, At, B1); PG8_BAR; PG8_SCHED;
            } else {
            PG8_LDB(B0, 0, 0); PG8_SCHED; PG8_LDA(At, 0, 0); PG8_STAGE(PG8_SA(1, 1), a1 + hstep, voffA);
            PG8_WAIT_L(8); PG8_BAR; PG8_WAIT_L(0); PG8_MMA(0, 0, At, B0); PG8_BAR; PG8_SCHED;
            PG8_LDB(B1, 0, 1); PG8_STAGE(PG8_SB(0, 0), b2, voffB);
            PG8_BAR; PG8_WAIT_L(0); PG8_MMA(0, 1, At, B1); PG8_BAR;
            PG8_LDA(At, 0, 1); PG8_STAGE(PG8_SA(0, 0), a2, voffA);
            PG8_BAR; PG8_WAIT_L(0); PG8_MMA(1, 0, At, B0); PG8_BAR; PG8_SCHED;
            PG8_STAGE(PG8_SB(0, 1), b2 + hstep, voffB);
            PG8_WAIT_V(6); PG8_BAR; PG8_MMA(1, 1, At, B1); PG8_BAR;
            PG8_LDB(B0, 1, 0); PG8_SCHED; PG8_LDA(At, 1, 0); PG8_STAGE(PG8_SA(0, 1), a2 + hstep, voffA);
            PG8_WAIT_L(8); PG8_BAR; PG8_WAIT_L(0); PG8_MMA(0, 0, At, B0); PG8_BAR; PG8_SCHED;
            PG8_LDB(B1, 1, 1); PG8_STAGE(PG8_SB(1, 0), b3, voffB);
            PG8_BAR; PG8_WAIT_L(0); PG8_MMA(0, 1, At, B1); PG8_BAR;
            PG8_LDA(At, 1, 1); PG8_STAGE(PG8_SA(1, 0), a3, voffA);
            PG8_BAR; PG8_WAIT_L(0); PG8_MMA(1, 0, At, B0); PG8_BAR; PG8_SCHED;
            PG8_STAGE(PG8_SB(1, 1), b3 + hstep, voffB);
            PG8_WAIT_V(6); PG8_BAR; PG8_MMA(1, 1, At, B1); PG8_BAR;
            }
        }
        if constexpr (ALIGN_EPI) { if (wr == 0) PG8_BAR; }
        if constexpr (!Epi::AFTER_DRAIN) { E(acc, cur, wr, wc, fr, fq); S.done(cur); }
        if (!has_next) break;
#pragma unroll
        for (int a = 0; a < 2; ++a)
#pragma unroll
            for (int b = 0; b < 2; ++b)
#pragma unroll
                for (int m = 0; m < 4; ++m)
#pragma unroll
                    for (int n = 0; n < 2; ++n) acc[a][b][m][n] = (f32x4){0.f, 0.f, 0.f, 0.f};
        cur = nxt; cA = nA; cB = nB; ++ui;
        if constexpr (ALIGN_EPI) { if (wr == 1) PG8_BAR; }
    }
    PG8_WAIT_V(0);
    if constexpr (!ALIGN_EPI) { if (wr == 0) PG8_BAR; }
    PG8_BAR;
    if constexpr (Epi::AFTER_DRAIN) { E.fused(acc, cur, wr, wc, fr, fq, lds, wid, lane); S.done(cur); }
#undef PG8_SA
#undef PG8_SB
#undef PG8_STAGE
#undef PG8_LDA
#undef PG8_LDB
#undef PG8_MMA
#undef PG8_WAIT_V
#undef PG8_WAIT_L
#undef PG8_BAR
#undef PG8_SCHED
}
}

#define LAS __attribute__((address_space(3)))
typedef unsigned short bf16_t;
typedef short bf16x8 __attribute__((ext_vector_type(8)));
typedef short s16x4 __attribute__((ext_vector_type(4)));
typedef float f32x4 __attribute__((ext_vector_type(4)));
typedef float f32x2 __attribute__((ext_vector_type(2)));
typedef float f32x16 __attribute__((ext_vector_type(16)));
typedef unsigned u32x4 __attribute__((ext_vector_type(4)));
typedef unsigned u32x2 __attribute__((ext_vector_type(2)));

constexpr int MTOK = 65536, DM = 1024, DFF = 2816, NUP = 5632, NINP = 2816, PPITCH = 2560, SEQL = 4096;
constexpr float EPSF = 1e-6f, LOG2E = 1.4426950408889634f;
constexpr size_t MiB = 1u << 20;
constexpr size_t WS_MOD = 1 * MiB, WS_GMOD = 3 * MiB, WS_GATE = 4 * MiB, WS_SB = 5 * MiB, WS_ROWSS = 8 * MiB, WS_KS = 10 * MiB, WS_F2 = 11 * MiB, WS_FG = 12 * MiB,
                 WS_ASEG = 13 * MiB, WS_BSEG = 17 * MiB, WS_WUP = 24 * MiB, WS_WDN = 68 * MiB, WS_WIN = 90 * MiB, WS_WOUT = 101 * MiB, WS_XN = 112 * MiB,
                 WS_H = 240 * MiB, WS_PROJ = 240 * MiB, WS_YU = 592 * MiB, WS_HLOC = 656 * MiB, WS_PCUM = 784 * MiB, WS_YN = 848 * MiB, WS_END = 976 * MiB;
constexpr int LDS_BYTES = 147456;

__device__ __forceinline__ float bf2f(unsigned short v) { return __uint_as_float((unsigned)v << 16); }
__device__ __forceinline__ unsigned f2bf(float f) { unsigned u = __float_as_uint(f); return (u + 0x7fffu + ((u >> 16) & 1u)) >> 16; }
__device__ __forceinline__ unsigned pk2(float lo, float hi) { return pg8::cvt_pk_bf16(lo, hi); }
__device__ __forceinline__ float wave_sum(float v) {
#pragma unroll
    for (int o = 1; o < 64; o <<= 1) v += __shfl_xor(v, o);
    return v;
}
__device__ __forceinline__ float sigmoidf_(float x) { return __builtin_amdgcn_rcpf(1.0f + __builtin_amdgcn_exp2f(-LOG2E * x)); }
#define WAITV(n) asm volatile("s_waitcnt vmcnt(" #n ")" ::: "memory")
#define LBAR() asm volatile("s_waitcnt lgkmcnt(0)\n\ts_barrier" ::: "memory")
#define CFENCE() asm volatile("" ::: "memory")

#ifndef REP_FIN
#define REP_FIN 1
#endif
#ifndef REP_PREP
#define REP_PREP 1
#endif
#ifndef REP_ATTN
#define REP_ATTN 1
#endif
#ifndef REP_UP
#define REP_UP 1
#endif
struct Args { const float* in[19]; float* out; unsigned char* ws; int ph_lo, ph_hi; };

__device__ __forceinline__ void transpose_item(const float* __restrict__ W, int ldw, int clim, int K, bf16_t* __restrict__ WT, int n0, int c0, int k0, LAS float* scr, int lane) {
    const int col = c0 + (lane & 31);
#pragma unroll 8
    for (int i = 0; i < 32; ++i) { const int kk = 2 * i + (lane >> 5); scr[kk * 33 + (lane & 31)] = (col < clim) ? W[(size_t)(k0 + kk) * ldw + col] : 0.f; }
    asm volatile("s_waitcnt lgkmcnt(0)" ::: "memory");
    const int c = lane & 7;
#pragma unroll
    for (int j = 0; j < 4; ++j) { const int n = (lane >> 3) + 8 * j; const LAS float* s = scr + (8 * c) * 33 + n;
        u32x4 o; o.x = pk2(s[0 * 33], s[1 * 33]); o.y = pk2(s[2 * 33], s[3 * 33]); o.z = pk2(s[4 * 33], s[5 * 33]); o.w = pk2(s[6 * 33], s[7 * 33]);
        *(u32x4*)(WT + (size_t)(n0 + n) * K + k0 + 8 * c) = o; }
    asm volatile("s_waitcnt lgkmcnt(0)" ::: "memory");
}

__device__ __forceinline__ int crow(int r, int hi) { return (r & 3) + 8 * (r >> 2) + 4 * hi; }
__device__ __forceinline__ s16x4 vtr(const LAS unsigned char* p) {
    typedef short v4i16_t __attribute__((ext_vector_type(4)));
    return __builtin_bit_cast(s16x4, __builtin_amdgcn_ds_read_tr16_b64_v4i16((LAS v4i16_t*)p));
}
constexpr int AT_SLOT = 16384, AT_AUX = 3 * AT_SLOT, AT_WSF = AT_AUX + 3 * 512, AT_VOTE = AT_WSF + 8 * 256;
constexpr float C2 = 0.125f * LOG2E;

__device__ __forceinline__ void sb_block(f32x16& X, float& carry, bool band, int kv0  , int qrel, int hi) {
    float lm[16];
#pragma unroll
    for (int r = 0; r < 16; ++r) {
        float z2 = X[r] * C2; z2 = __builtin_fminf(__builtin_fmaxf(z2, -120.f), 120.f);
        const float e = __builtin_amdgcn_exp2f(-z2), sp = __builtin_amdgcn_logf(1.0f + e);
        float l1 = -(sp + z2), lb = -sp;
        if (band) { const int kv = kv0 + (r & 3) + 8 * (r >> 2); const bool valid = kv < qrel; l1 = valid ? l1 : 0.f; lb = valid ? lb : -INFINITY; }
        lm[r] = l1; X[r] = lb;
    }
    float G[4], Gp[4], T[4];
#pragma unroll
    for (int g = 0; g < 4; ++g) { G[g] = (lm[4 * g] + lm[4 * g + 1]) + (lm[4 * g + 2] + lm[4 * g + 3]); Gp[g] = __shfl_xor(G[g], 32); T[g] = G[g] + Gp[g]; }
    float S = carry;
#pragma unroll
    for (int g = 3; g >= 0; --g) {
        const float a3 = S + (hi == 0 ? Gp[g] : 0.f), a2 = a3 + lm[4 * g + 3], a1 = a2 + lm[4 * g + 2], a0 = a1 + lm[4 * g + 1];
        X[4 * g + 3] = __builtin_amdgcn_exp2f(X[4 * g + 3] + a3); X[4 * g + 2] = __builtin_amdgcn_exp2f(X[4 * g + 2] + a2);
        X[4 * g + 1] = __builtin_amdgcn_exp2f(X[4 * g + 1] + a1); X[4 * g] = __builtin_amdgcn_exp2f(X[4 * g] + a0);
        S += T[g];
    }
    carry = S;
}

template <int KIND>
__device__ __forceinline__ void attn_unit(LAS unsigned char* lds, const bf16_t* __restrict__ PROJ, bf16_t* __restrict__ YU, const float* __restrict__ KS,
                                          const float* __restrict__ F2, const float* __restrict__ gqk, int b, int h, int qb) {
    int tid_o = threadIdx.x; asm volatile("" : "+v"(tid_o));
    const int tid = tid_o, lane = tid & 63, r32 = lane & 31, hi = lane >> 5;
    const int wid = __builtin_amdgcn_readfirstlane(tid >> 6);
    const int qcol = (KIND == 0 ? 1024 : 1792) + h * 64, kcol = qcol + 256, vcol = qcol + 512;
    const size_t rowbase = (size_t)b * SEQL; const int q0 = qb * 256, bh = b * 4 + h;
    const int NT = (q0 + 256) / 64;
    const bf16_t* ksrc = PROJ + (rowbase + lane) * PPITCH + kcol + wid * 8;
    const bf16_t* vsrc = PROJ + (rowbase + 16 * (wid & 3) + (lane >> 2)) * PPITCH + vcol + (wid >> 2) * 32 + (lane & 3) * 8;
    const float* axsrc = (wid == 0 ? KS : F2) + (size_t)bh * SEQL + lane;
    u32x4 kreg, vreg; float areg = 0.f;
#define AT_LOAD(it_) do { const int kt_ = NT - 1 - (it_); kreg = *(const u32x4*)(ksrc + (size_t)kt_ * 64 * PPITCH); vreg = *(const u32x4*)(vsrc + (size_t)kt_ * 64 * PPITCH); \
        if (KIND == 1 && wid < 2) areg = axsrc[kt_ * 64]; } while (0)
#define AT_STORE(slot_) do { *(LAS u32x4*)(lds + (slot_) * AT_SLOT + wid * 1024 + lane * 16) = kreg; *(LAS u32x4*)(lds + (slot_) * AT_SLOT + 8192 + wid * 1024 + lane * 16) = vreg; \
        if (KIND == 1 && wid < 2) *(LAS float*)(lds + AT_AUX + (slot_) * 512 + wid * 256 + lane * 4) = areg; } while (0)
    const bf16_t* Qw = PROJ + (rowbase + q0 + wid * 32 + r32) * PPITCH + qcol + hi * 8;
    bf16x8 qr[4];
#pragma unroll
    for (int d0 = 0; d0 < 4; ++d0) qr[d0] = *(const bf16x8*)(Qw + d0 * 16);
    AT_LOAD(0);
    if (KIND == 1) {
        float qf[4][8]; float ss = 0.f;
#pragma unroll
        for (int d0 = 0; d0 < 4; ++d0)
#pragma unroll
            for (int i = 0; i < 8; ++i) { qf[d0][i] = bf2f((unsigned short)qr[d0][i]); ss += qf[d0][i] * qf[d0][i]; }
        ss += __shfl_xor(ss, 32);
        const float rs = __builtin_amdgcn_rsqf(ss * (1.0f / 64.0f) + EPSF) * C2;
#pragma unroll
        for (int d0 = 0; d0 < 4; ++d0) {
            const float* gp = gqk + d0 * 16 + hi * 8; float v[8];
#pragma unroll
            for (int i = 0; i < 8; ++i) v[i] = qf[d0][i] * rs * gp[i] * gp[64 + i];
            u32x4 w; w.x = pk2(v[0], v[1]); w.y = pk2(v[2], v[3]); w.z = pk2(v[4], v[5]); w.w = pk2(v[6], v[7]);
            qr[d0] = __builtin_bit_cast(bf16x8, w);
        }
    }
    f32x16 o0, o1;
#pragma unroll
    for (int r = 0; r < 16; ++r) { o0[r] = 0.f; o1[r] = 0.f; }
    float mhat = -1e30f, lsum = 0.f, carry = 0.f;
    LAS float* wsf = (LAS float*)(lds + AT_WSF) + wid * 64;
    LAS unsigned* votes = (LAS unsigned*)(lds + AT_VOTE);
    const int qrel = wid * 32 + r32;
    bool wdone = false;
    AT_STORE(0); LBAR();
    for (int it = 0; it < NT; ++it) {
        const int slot = it & 1;
        if (KIND == 0 && it > 0) {
            const LAS unsigned* vp = votes + ((it - 1) & 1) * 8;
            const unsigned all = vp[0] & vp[1] & vp[2] & vp[3] & vp[4] & vp[5] & vp[6] & vp[7];
            if (all) break;
        }
        if (it + 1 < NT) AT_LOAD(it + 1);
        const int kt = NT - 1 - it, jb = kt - (NT - 4);
        const bool band = jb >= 0;
        const bool active = !(band && 64 * jb > 32 * wid + 31) && !wdone;
        if (active) {
            f32x16 p0, p1;
            { const LAS unsigned char* kb = lds + slot * AT_SLOT + hi * 1024 + r32 * 16;
#pragma unroll
              for (int d0 = 0; d0 < 4; ++d0) {
                  const bf16x8 b0 = *(const LAS bf16x8*)(kb + d0 * 2048), b1 = *(const LAS bf16x8*)(kb + d0 * 2048 + 512);
                  if (d0 == 0) { f32x16 z;
#pragma unroll
                      for (int r = 0; r < 16; ++r) z[r] = 0.f;
                      p0 = __builtin_amdgcn_mfma_f32_32x32x16_bf16(b0, qr[0], z, 0, 0, 0); p1 = __builtin_amdgcn_mfma_f32_32x32x16_bf16(b1, qr[0], z, 0, 0, 0); }
                  else { p0 = __builtin_amdgcn_mfma_f32_32x32x16_bf16(b0, qr[d0], p0, 0, 0, 0); p1 = __builtin_amdgcn_mfma_f32_32x32x16_bf16(b1, qr[d0], p1, 0, 0, 0); }
              } }
            if (KIND == 0) {
                sb_block(p1, carry, band, 64 * jb + 32 + 4 * hi, qrel, hi);
                sb_block(p0, carry, band, 64 * jb + 4 * hi, qrel, hi);
            } else {
                const LAS float* ax = (const LAS float*)(lds + AT_AUX + slot * 512);
#pragma unroll
                for (int g = 0; g < 4; ++g) {
                    const f32x4 k0 = *(const LAS f32x4*)(ax + 8 * g + 4 * hi), k1 = *(const LAS f32x4*)(ax + 32 + 8 * g + 4 * hi);
                    const f32x4 f0 = *(const LAS f32x4*)(ax + 64 + 8 * g + 4 * hi), f1 = *(const LAS f32x4*)(ax + 96 + 8 * g + 4 * hi);
#pragma unroll
                    for (int i = 0; i < 4; ++i) { p0[4 * g + i] = p0[4 * g + i] * k0[i] + f0[i]; p1[4 * g + i] = p1[4 * g + i] * k1[i] + f1[i]; }
                }
                if (band) {
#pragma unroll
                    for (int r = 0; r < 16; ++r) { const int kv = 64 * jb + crow(r, hi); if (kv > qrel) p0[r] = -INFINITY; if (kv + 32 > qrel) p1[r] = -INFINITY; }
                }
                float rm = __builtin_fmaxf(p0[0], p1[0]), rm2 = __builtin_fmaxf(p0[1], p1[1]);
#pragma unroll
                for (int r = 2; r < 16; r += 2) { rm = __builtin_fmaxf(__builtin_fmaxf(rm, p0[r]), p1[r]); rm2 = __builtin_fmaxf(__builtin_fmaxf(rm2, p0[r + 1]), p1[r + 1]); }
                rm = __builtin_fmaxf(rm, rm2);
                rm = __builtin_fmaxf(rm, __shfl_xor(rm, 32));
                if (__any(rm > mhat + 8.0f)) {
                    const float mnew = __builtin_fmaxf(mhat, rm), f = __builtin_amdgcn_exp2f(mhat - mnew);
                    lsum *= f; mhat = mnew;
                    CFENCE(); if (hi == 0) wsf[r32] = f; CFENCE();
                    asm volatile("s_waitcnt lgkmcnt(0)" ::: "memory");
#pragma unroll
                    for (int r = 0; r < 16; ++r) { const float fr_ = wsf[crow(r, hi)]; o0[r] *= fr_; o1[r] *= fr_; }
                    CFENCE();
                }
                f32x2 sacc2 = (f32x2){0.f, 0.f};
#pragma unroll
                for (int r = 0; r < 16; r += 2) {
                    const f32x2 a0 = (f32x2){p0[r], p0[r + 1]} - mhat, a1 = (f32x2){p1[r], p1[r + 1]} - mhat;
                    p0[r] = __builtin_amdgcn_exp2f(a0[0]); p0[r + 1] = __builtin_amdgcn_exp2f(a0[1]); p1[r] = __builtin_amdgcn_exp2f(a1[0]); p1[r + 1] = __builtin_amdgcn_exp2f(a1[1]);
                    sacc2 += (f32x2){p0[r], p0[r + 1]}; sacc2 += (f32x2){p1[r], p1[r + 1]};
                }
                lsum += sacc2[0] + sacc2[1];
            }
            u32x4 pw0, pw1, pw2, pw3;
            pw0.x = pk2(p0[0], p0[1]); pw0.y = pk2(p0[2], p0[3]); pw0.z = pk2(p0[4], p0[5]); pw0.w = pk2(p0[6], p0[7]);
            pw1.x = pk2(p0[8], p0[9]); pw1.y = pk2(p0[10], p0[11]); pw1.z = pk2(p0[12], p0[13]); pw1.w = pk2(p0[14], p0[15]);
            pw2.x = pk2(p1[0], p1[1]); pw2.y = pk2(p1[2], p1[3]); pw2.z = pk2(p1[4], p1[5]); pw2.w = pk2(p1[6], p1[7]);
            pw3.x = pk2(p1[8], p1[9]); pw3.y = pk2(p1[10], p1[11]); pw3.z = pk2(p1[12], p1[13]); pw3.w = pk2(p1[14], p1[15]);
            const LAS unsigned char* vb = lds + slot * AT_SLOT + 8192 + ((lane >> 4) & 1) * 32 + (lane & 3) * 8 + (4 * hi + ((lane & 15) >> 2)) * 64;
            s16x4 vlo[8], vhi[8];
#pragma unroll
            for (int i = 0; i < 8; ++i) { vlo[i] = vtr(vb + (i >> 2) * 4096 + (i & 3) * 1024); vhi[i] = vtr(vb + (i >> 2) * 4096 + (i & 3) * 1024 + 512); }
#define VFR(i) (bf16x8){vlo[i][0], vlo[i][1], vlo[i][2], vlo[i][3], vhi[i][0], vhi[i][1], vhi[i][2], vhi[i][3]}
#define PAF(x) __builtin_bit_cast(bf16x8, x)
            o0 = __builtin_amdgcn_mfma_f32_32x32x16_bf16(PAF(pw0), VFR(0), o0, 0, 0, 0); o1 = __builtin_amdgcn_mfma_f32_32x32x16_bf16(PAF(pw0), VFR(4), o1, 0, 0, 0);
            o0 = __builtin_amdgcn_mfma_f32_32x32x16_bf16(PAF(pw1), VFR(1), o0, 0, 0, 0); o1 = __builtin_amdgcn_mfma_f32_32x32x16_bf16(PAF(pw1), VFR(5), o1, 0, 0, 0);
            o0 = __builtin_amdgcn_mfma_f32_32x32x16_bf16(PAF(pw2), VFR(2), o0, 0, 0, 0); o1 = __builtin_amdgcn_mfma_f32_32x32x16_bf16(PAF(pw2), VFR(6), o1, 0, 0, 0);
            o0 = __builtin_amdgcn_mfma_f32_32x32x16_bf16(PAF(pw3), VFR(3), o0, 0, 0, 0); o1 = __builtin_amdgcn_mfma_f32_32x32x16_bf16(PAF(pw3), VFR(7), o1, 0, 0, 0);
#undef VFR
#undef PAF
        }
        if (KIND == 0) { if (active) wdone = __all(carry < -150.0f); if (lane == 0) votes[(it & 1) * 8 + wid] = wdone ? 1u : 0u; }
        if (it + 1 < NT) AT_STORE(slot ^ 1);
        LBAR();
    }
    if (KIND == 1) { lsum += __shfl_xor(lsum, 32); CFENCE(); if (hi == 0) wsf[r32] = lsum; CFENCE(); asm volatile("s_waitcnt lgkmcnt(0)" ::: "memory"); }
    bf16_t* Yw = YU + (rowbase + q0 + wid * 32) * 512 + KIND * 256 + h * 64 + r32;
#pragma unroll
    for (int r = 0; r < 16; ++r) {
        const int orow = crow(r, hi); float sc = 1.0f;
        if (KIND == 1) sc = __builtin_amdgcn_rcpf(wsf[orow]);
        Yw[(size_t)orow * 512] = (bf16_t)f2bf(o0[r] * sc); Yw[(size_t)orow * 512 + 32] = (bf16_t)f2bf(o1[r] * sc);
    }
    LBAR();
#undef AT_LOAD
#undef AT_STORE
}

#define DEFPTRS \
    const __attribute__((address_space(4))) Args* ka_ = (const __attribute__((address_space(4))) Args*)__builtin_amdgcn_kernarg_segment_ptr(); \
    asm volatile("" : "+s"(ka_)); \
    int tid_o_ = threadIdx.x; asm volatile("" : "+v"(tid_o_)); const int tid = tid_o_, lane = tid & 63; (void)lane; \
    unsigned char* ws = ka_->ws; \
    const float* x_in = ka_->in[0]; const float* c_in = ka_->in[1]; const float* w_ada = ka_->in[2]; const float* b_ada = ka_->in[3]; const float* g_norm = ka_->in[4]; \
    const float* w_up = ka_->in[5]; const float* w_dn = ka_->in[6]; const float* w_in = ka_->in[7]; const float* b_fg = ka_->in[8]; const float* conv_w = ka_->in[9]; \
    const float* conv_b = ka_->in[10]; const float* w_rg = ka_->in[11]; const float* b_rg = ka_->in[12]; const float* w_ig = ka_->in[13]; const float* b_ig = ka_->in[14]; \
    const float* lam = ka_->in[15]; const float* g_qk = ka_->in[16]; const float* g_mix = ka_->in[17]; const float* w_out = ka_->in[18]; \
    float* xout = ka_->out; \
    float* MOD = (float*)(ws + WS_MOD); float* GMOD = (float*)(ws + WS_GMOD); float* GATE = (float*)(ws + WS_GATE); float* SBV = (float*)(ws + WS_SB); \
    float* ROWSS = (float*)(ws + WS_ROWSS); float* KS = (float*)(ws + WS_KS); float* F2 = (float*)(ws + WS_F2); float* FG = (float*)(ws + WS_FG); \
    float* ASEG = (float*)(ws + WS_ASEG); float* BSEG = (float*)(ws + WS_BSEG); \
    bf16_t* WUP = (bf16_t*)(ws + WS_WUP); bf16_t* WDN = (bf16_t*)(ws + WS_WDN); bf16_t* WIN = (bf16_t*)(ws + WS_WIN); bf16_t* WOUT = (bf16_t*)(ws + WS_WOUT); \
    bf16_t* XN = (bf16_t*)(ws + WS_XN); bf16_t* HB = (bf16_t*)(ws + WS_H); bf16_t* PROJ = (bf16_t*)(ws + WS_PROJ); bf16_t* YU = (bf16_t*)(ws + WS_YU); \
    float* HLOC = (float*)(ws + WS_HLOC); bf16_t* PCUM = (bf16_t*)(ws + WS_PCUM); bf16_t* YN = (bf16_t*)(ws + WS_YN);
#define XB_TMO      128
#define XB_XCNT(j)  (256  + 64 * (j))
#define XB_XSUB(j)  (1280 + 64 * (j))
#define XB_XGEN(j)  (2304 + 64 * (j))
#define XB_TOP      3328
#define XB_TOPGEN   3392
#define XCD_BAR_WORDS 3456
#define XB_SPIN_CAP (1u << 18)

__device__ __forceinline__ unsigned xb_ld(unsigned* p)              { return __hip_atomic_load(p, __ATOMIC_RELAXED, __HIP_MEMORY_SCOPE_AGENT); }
__device__ __forceinline__ unsigned xb_add(unsigned* p, unsigned v) { return __hip_atomic_fetch_add(p, v, __ATOMIC_RELAXED, __HIP_MEMORY_SCOPE_AGENT); }
__device__ __forceinline__ unsigned xb_xcc_id() { return (unsigned)__builtin_amdgcn_s_getreg((3 << 11) | 20) & 0xFu; }
#define XB_SPIN(cond, bar) do { unsigned _sp = 0; while (cond) { __builtin_amdgcn_s_sleep(1); \
    if ((++_sp & 255u) == 0u) { if (xb_ld(&(bar)[XB_TMO])) break; if (_sp > XB_SPIN_CAP) { atomicAdd(&(bar)[XB_TMO], 1u); break; } } } } while (0)

struct XcdBarrier {
    unsigned* bar; unsigned x;
    volatile LAS unsigned* st;
};

__device__ __forceinline__ XcdBarrier xcd_barrier_post(unsigned* bar, volatile LAS unsigned* st) {
    XcdBarrier b; b.bar = bar; b.x = xb_xcc_id(); b.st = st;
    if (threadIdx.x == 0) (void)xb_add(&bar[XB_XCNT(b.x)], 1u);
    return b;
}
__device__ __forceinline__ void xcd_barrier_complete(unsigned* bar, unsigned x, unsigned& nloc, unsigned& nx) {
    const unsigned G = gridDim.x * gridDim.y * gridDim.z;
    unsigned sum, cnt, mine, sp = 0u;
    for (;;) {
        sum = 0u; cnt = 0u; mine = 0u;
#pragma unroll
        for (unsigned j = 0; j < 16; ++j) { const unsigned c = xb_ld(&bar[XB_XCNT(j)]); sum += c; cnt += (c > 0u) ? 1u : 0u; mine = (j == x) ? c : mine; }
        if (sum == G) break;
        __builtin_amdgcn_s_sleep(1);
        if ((++sp & 255u) == 0u) { if (xb_ld(&bar[XB_TMO])) break; if (sp > XB_SPIN_CAP) { atomicAdd(&bar[XB_TMO], 1u); break; } }
    }
    nloc = mine > 0u ? mine : 1u; nx = cnt > 0u ? cnt : 1u;
}

__device__ __forceinline__ void xcd_barrier(const XcdBarrier& b) {
    asm volatile("s_waitcnt vmcnt(0)" ::: "memory");
    __syncthreads();
    if (threadIdx.x == 0) {
        unsigned* bar = b.bar;
        __builtin_amdgcn_s_waitcnt(0);
        unsigned nloc = b.st[0], nx = b.st[1];
        if (nloc == 0u) { xcd_barrier_complete(bar, b.x, nloc, nx); b.st[0] = nloc; b.st[1] = nx; }
        const unsigned old = xb_add(&bar[XB_XSUB(b.x)], 1u);
        const unsigned gen = old / nloc;
        if (old + 1u == (gen + 1u) * nloc) {
            __builtin_amdgcn_fence(__ATOMIC_RELEASE, "agent");
            asm volatile("s_waitcnt vmcnt(0)" ::: "memory");
            const unsigned og = xb_add(&bar[XB_TOP], 1u);
            const unsigned tg = og / nx;
            if (og + 1u == (tg + 1u) * nx) xb_add(&bar[XB_TOPGEN], 1u);
            else XB_SPIN(xb_ld(&bar[XB_TOPGEN]) == tg, bar);
            __builtin_amdgcn_fence(__ATOMIC_ACQUIRE, "agent");
            xb_add(&bar[XB_XGEN(b.x)], 1u);
            asm volatile("s_waitcnt vmcnt(0)" ::: "memory");
        } else {
            XB_SPIN(xb_ld(&bar[XB_XGEN(b.x)]) == gen, bar);
            __builtin_amdgcn_fence(__ATOMIC_ACQUIRE, "agent");
            asm volatile("s_waitcnt vmcnt(0)" ::: "memory");
        }
    }
    __syncthreads();
}

__global__ void __launch_bounds__(512) mk_fwd(Args args) {
    extern __shared__ __attribute__((aligned(16))) unsigned char lds_raw[];
    LAS unsigned char* lds = (LAS unsigned char*)lds_raw;
    cg::grid_group grid = cg::this_grid();
    const int wave = __builtin_amdgcn_readfirstlane(threadIdx.x >> 6);
    const int G = gridDim.x; const int bx = blockIdx.x;
    const int vcu = (G % 8 == 0) ? (bx % 8) * (G / 8) + bx / 8 : bx;
    const int gw = vcu * 8 + wave, NGW = G * 8;
    const int lo = args.ph_lo, hi_ph = args.ph_hi;
    volatile LAS unsigned* MISC = (volatile LAS unsigned*)(lds + 131072 + 320);
    if (threadIdx.x < 16) MISC[threadIdx.x] = 0u;
    __syncthreads();
    XcdBarrier xbar = xcd_barrier_post((unsigned*)args.ws, MISC + 8);
    int ph = 0;
#define PH_ON (ph >= lo && ph < hi_ph)
#ifdef REP_SYNC
#define SYNC_EXTRA grid.sync(); asm volatile("" ::: "memory");
#else
#define SYNC_EXTRA
#endif
#define PH_NEXT do { ++ph; if (ph > lo && ph < hi_ph) { asm volatile("s_waitcnt vmcnt(0) lgkmcnt(0)" ::: "memory"); if (ph == 1) grid.sync(); else xcd_barrier(xbar); asm volatile("" ::: "memory"); SYNC_EXTRA } } while (0)

#ifdef REP_PRO
    int rp_ = 0; pro_again:
#endif
    if (PH_ON) { DEFPTRS
        for (int i = bx * 512 + tid; i < 5 * MTOK; i += G * 512) ROWSS[MTOK + i] = 0.f;
        LAS float* cact = (LAS float*)lds;
        LAS float* red = (LAS float*)(lds + 65536);
        for (int i = tid; i < 16 * 1024; i += 512) { const int b = i >> 10, k = i & 1023; const float v = c_in[i]; cact[k * 16 + b] = v * sigmoidf_(v); }
        __syncthreads();
        for (int task = bx; task < 288; task += G) {
            const int l = task / 144, n0 = (task % 144) * 64;
            float acc[16];
#pragma unroll
            for (int b = 0; b < 16; ++b) acc[b] = 0.f;
            const float* wp = w_ada + (size_t)l * 1024 * 9216 + n0 + lane;
#pragma unroll 4
            for (int k = wave * 128; k < wave * 128 + 128; ++k) {
                const float w = wp[(size_t)k * 9216];
                const f32x4 c0 = *(const LAS f32x4*)(cact + k * 16), c1 = *(const LAS f32x4*)(cact + k * 16 + 4), c2 = *(const LAS f32x4*)(cact + k * 16 + 8), c3 = *(const LAS f32x4*)(cact + k * 16 + 12);
#pragma unroll
                for (int i = 0; i < 4; ++i) { acc[i] += c0[i] * w; acc[4 + i] += c1[i] * w; acc[8 + i] += c2[i] * w; acc[12 + i] += c3[i] * w; }
            }
#pragma unroll
            for (int b = 0; b < 16; ++b) red[(wave * 16 + b) * 64 + lane] = acc[b];
            __syncthreads();
            for (int o = tid; o < 1024; o += 512) { const int b = o >> 6, ln = o & 63; float s = 0.f;
#pragma unroll
                for (int w = 0; w < 8; ++w) s += red[(w * 16 + b) * 64 + ln];
                MOD[((size_t)l * 16 + b) * 9216 + n0 + ln] = s + b_ada[l * 9216 + n0 + ln]; }
            __syncthreads();
        }
    }
    PH_NEXT;
    if (PH_ON) { DEFPTRS
        for (int i = bx * 512 + tid; i < 2 * 3 * 16 * 1024; i += G * 512) {
            const int k = i & 1023, b = (i >> 10) & 15, lj = i >> 14, l = lj / 3, j = lj % 3;
            const float* mp = MOD + ((size_t)l * 16 + b) * 9216 + j * 3072;
            GMOD[i] = g_norm[(l * 3 + j) * 1024 + k] * (1.0f + mp[1024 + k]);
            GATE[i] = (j == 1 ? 1.0f : 0.5f) * (1.0f + mp[2048 + k]);
        }
        LAS float* scr = (LAS float*)(lds + wave * 8448);
        constexpr int I_UP = 16 * 176, I_DN = 44 * 32, I_IN = 16 * 88, I_OUT = 16 * 32;
        constexpr int NIT = 4 * I_UP + 4 * I_DN + 2 * I_IN + 2 * I_OUT;
        for (int it = gw; it < NIT; it += NGW) {
            int r = it;
            if (r < 4 * I_UP) { const int mat = r / I_UP; r -= mat * I_UP; const int kb = r / 176, nb = r % 176, n0 = nb * 32;
                const int c0 = ((n0 >> 7) & 1) * DFF + (n0 >> 8) * 128 + (n0 & 127);
                transpose_item(w_up + (size_t)mat * DM * NUP, NUP, NUP, DM, WUP + (size_t)mat * NUP * DM, n0, c0, kb * 64, scr, lane); continue; }
            r -= 4 * I_UP;
            if (r < 4 * I_DN) { const int mat = r / I_DN; r -= mat * I_DN; const int kb = r / 32, nb = r % 32;
                transpose_item(w_dn + (size_t)mat * DFF * DM, DM, DM, DFF, WDN + (size_t)mat * DM * DFF, nb * 32, nb * 32, kb * 64, scr, lane); continue; }
            r -= 4 * I_DN;
            if (r < 2 * I_IN) { const int mat = r / I_IN; r -= mat * I_IN; const int kb = r / 88, nb = r % 88;
                transpose_item(w_in + (size_t)mat * DM * 2564, 2564, 2564, DM, WIN + (size_t)mat * NINP * DM, nb * 32, nb * 32, kb * 64, scr, lane); continue; }
            r -= 2 * I_IN;
            { const int mat = r / I_OUT; r -= mat * I_OUT; const int kb = r / 32, nb = r % 32;
                transpose_item(w_out + (size_t)mat * DM * DM, DM, DM, DM, WOUT + (size_t)mat * DM * DM, nb * 32, nb * 32, kb * 64, scr, lane); }
        }
        for (int m = gw; m < MTOK; m += NGW) {
            const int b = m >> 12;
            const f32x4* xr = (const f32x4*)(x_in + (size_t)m * DM) + lane;
            const f32x4* gp = (const f32x4*)(g_norm) + lane;
            const f32x4* sp = (const f32x4*)(MOD + (size_t)b * 9216 + 1024) + lane;
            float s = 0.f; u32x2* o8 = (u32x2*)(XN + (size_t)m * DM) + lane;
#pragma unroll
            for (int j = 0; j < 4; ++j) { const f32x4 v = xr[64 * j]; s += (v[0] * v[0] + v[1] * v[1]) + (v[2] * v[2] + v[3] * v[3]);
                const f32x4 a = v * gp[64 * j] * (sp[64 * j] + 1.0f); u32x2 w; w.x = pk2(a[0], a[1]); w.y = pk2(a[2], a[3]); o8[64 * j] = w; }
            s = wave_sum(s);
            if (lane == 0) ROWSS[m] = s;
        }
    }
    PH_NEXT;
    if (PH_ON) { DEFPTRS
        LAS float* sh = (LAS float*)lds;
        for (int combo = 0; combo < 6; ++combo) {
            const int l = combo / 3, j = combo % 3;
            __syncthreads();
            for (int i = tid; i < 16 * 1024; i += 512) { const int b = i >> 10, k = i & 1023; sh[i] = MOD[((size_t)l * 16 + b) * 9216 + j * 3072 + k]; }
            __syncthreads();
            const bf16_t* Wt = (j == 1) ? WIN + (size_t)l * NINP * DM : WUP + (size_t)(l * 2 + (j == 2 ? 1 : 0)) * NUP * DM;
            const int N = (j == 1) ? NINP : NUP;
            float* dst = SBV + (size_t)combo * 16 * 5632;
            for (int n = gw; n < N; n += NGW) {
                float w[16];
#pragma unroll
                for (int c = 0; c < 4; ++c) { const u32x2 q = *(const u32x2*)(Wt + (size_t)n * DM + c * 256 + lane * 4);
                    w[4 * c] = __uint_as_float(q.x << 16); w[4 * c + 1] = __uint_as_float(q.x & 0xffff0000u); w[4 * c + 2] = __uint_as_float(q.y << 16); w[4 * c + 3] = __uint_as_float(q.y & 0xffff0000u); }
                float keep = 0.f;
#pragma unroll 1
                for (int b = 0; b < 16; ++b) { float s = 0.f;
#pragma unroll
                    for (int c = 0; c < 4; ++c) { const f32x4 v = *(const LAS f32x4*)(sh + b * 1024 + c * 256 + lane * 4); s += (w[4 * c] * v[0] + w[4 * c + 1] * v[1]) + (w[4 * c + 2] * v[2] + w[4 * c + 3] * v[3]); }
                    s = wave_sum(s); if (lane == b) keep = s; }
                if (lane < 16) dst[(size_t)lane * 5632 + n] = keep;
            }
        }
        __syncthreads();
    }
    PH_NEXT;

#ifdef REP_PRO
    if (rp_ == 0) { rp_ = 1; ph = 0; goto pro_again; }
#endif
#pragma unroll 1
    for (int f = 0; f < 4; ++f) {
        const int l = f >> 1, s = f & 1;
        if (s == 1) {
            if (PH_ON) { DEFPTRS
                pg8::Gemm g{XN, WIN + (size_t)l * NINP * DM, MTOK, NINP, DM}; pg8::StaticOrder S; S.init(MTOK, NINP, G, bx);
                pg8::EpiIn E{PROJ, FG, ROWSS + (size_t)(l * 3 + 1) * MTOK, SBV + (size_t)(l * 3 + 1) * 16 * 5632};
#ifndef NO_G_IN
                pg8::gemm_phase<pg8::EpiIn, pg8::StaticOrder, true, true>(lds, g, S, E);
#endif
            }
            PH_NEXT;
            if (PH_ON) { DEFPTRS
#ifndef NO_PREP
                {
                    const int blk = vcu & 7, n = lane & 31, hi = lane >> 5;
                    LAS unsigned char* wfl = lds;
                    LAS float* xs = (LAS float*)(lds + 16384 + wave * 13568);
                    LAS unsigned char* ub = lds + 16384 + wave * 13568 + 8960;
#pragma unroll
                    for (int q = 0; q < 2; ++q) { const int f = wave * 2 + q, gt = f >> 3, nb = (f >> 2) & 1, d0 = f & 3;
                        const float* wsrc = (gt ? w_ig : w_rg) + ((size_t)(l * 8 + blk) * 64 + 16 * d0 + 8 * hi) * 64 + nb * 32 + n;
                        u32x4 w; w.x = pk2(wsrc[0], wsrc[64]); w.y = pk2(wsrc[128], wsrc[192]); w.z = pk2(wsrc[256], wsrc[320]); w.w = pk2(wsrc[384], wsrc[448]);
                        *(LAS u32x4*)(wfl + f * 1024 + lane * 16) = w; }
                    __syncthreads();
                    float br[2], bi[2], cb[2], cw[2][4], c8[2];
#pragma unroll
                    for (int nb = 0; nb < 2; ++nb) { const int ch = blk * 64 + nb * 32 + n;
                        br[nb] = b_rg[l * 512 + ch]; bi[nb] = b_ig[l * 512 + ch]; cb[nb] = conv_b[l * 512 + ch];
#pragma unroll
                        for (int k = 0; k < 4; ++k) cw[nb][k] = conv_w[(l * 4 + k) * 512 + ch];
                        const float lmv = lam[l * 512 + ch];
                        c8[nb] = -8.0f * LOG2E * (__builtin_fmaxf(-lmv, 0.f) + log1pf(expf(-fabsf(lmv)))); }
                    for (int segi = (vcu >> 3) * 8 + wave; segi < REP_PREP * (MTOK / 32); segi += (G >> 3) * 8) { const int seg = segi & (MTOK / 32 - 1);
                        const int row0 = seg * 32; const bool first = (row0 & (SEQL - 1)) == 0;
                        const bf16_t* xp = PROJ + (size_t)row0 * PPITCH + blk * 64;
                        CFENCE();
#pragma unroll
                        for (int t = 0; t < 35; ++t) { float v = 0.f; if (t >= 3 || !first) v = bf2f((xp + ((long)t - 3) * PPITCH)[lane]); xs[t * 64 + lane] = v; }
                        CFENCE();
#pragma unroll
                        for (int nb = 0; nb < 2; ++nb)
#pragma unroll
                            for (int g = 0; g < 4; ++g) { const LAS float* xb = xs + (8 * g + 4 * hi) * 64 + nb * 32 + n; float xv[7];
#pragma unroll
                                for (int j = 0; j < 7; ++j) xv[j] = xb[j * 64];
#pragma unroll
                                for (int i = 0; i < 4; ++i) { const float uu = cb[nb] + cw[nb][0] * xv[i] + cw[nb][1] * xv[i + 1] + cw[nb][2] * xv[i + 2] + cw[nb][3] * xv[i + 3];
                                    *(LAS unsigned short*)(ub + (8 * g + 4 * hi + i) * 144 + (nb * 32 + n) * 2) = (unsigned short)f2bf(uu); }
                                __builtin_amdgcn_sched_barrier(0); }
                        CFENCE();
                        bf16x8 af[4];
#pragma unroll
                        for (int d0 = 0; d0 < 4; ++d0) af[d0] = *(const LAS bf16x8*)(ub + n * 144 + (16 * d0 + 8 * hi) * 2);
#pragma unroll
                        for (int nb = 0; nb < 2; ++nb) {
                            f32x16 arx, aix;
#pragma unroll
                            for (int r = 0; r < 16; ++r) { arx[r] = br[nb]; aix[r] = bi[nb]; }
#pragma unroll
                            for (int d0 = 0; d0 < 4; ++d0) { const bf16x8 w0 = *(const LAS bf16x8*)(wfl + ((0 * 2 + nb) * 4 + d0) * 1024 + lane * 16), w1 = *(const LAS bf16x8*)(wfl + ((1 * 2 + nb) * 4 + d0) * 1024 + lane * 16);
                                                             arx = __builtin_amdgcn_mfma_f32_32x32x16_bf16(af[d0], w0, arx, 0, 0, 0);
                                                             aix = __builtin_amdgcn_mfma_f32_32x32x16_bf16(af[d0], w1, aix, 0, 0, 0); }
                            CFENCE(); __builtin_amdgcn_sched_barrier(0);
#pragma unroll
                            for (int r = 0; r < 16; ++r) {
                                float uu; { const LAS float* xb = xs + (8 * (r >> 2) + 4 * hi + (r & 3)) * 64 + nb * 32 + n;
                                    uu = cb[nb] + cw[nb][0] * xb[0] + cw[nb][1] * xb[64] + cw[nb][2] * xb[128] + cw[nb][3] * xb[192]; }
                                const float rg = sigmoidf_(arx[r]), ig = sigmoidf_(aix[r]);
                                const float la2 = c8[nb] * rg, a = __builtin_amdgcn_exp2f(la2);
                                const float xx = 2.0f * 0.6931471805599453f * la2;
                                const float om = (xx > -0.25f) ? -xx * (1.0f + xx * 0.5f * (1.0f + xx * (1.0f / 3.0f) * (1.0f + xx * 0.25f * (1.0f + xx * 0.2f)))) : 1.0f - a * a;
                                arx[r] = a; aix[r] = __builtin_sqrtf(om) * ig * uu;
                            }
                            float H = 0.f, P = 1.f;
                            const int ch = blk * 64 + nb * 32 + n;
                            float* hl = HLOC + (size_t)(row0 + 4 * hi) * 512 + ch; bf16_t* pc = PCUM + (size_t)(row0 + 4 * hi) * 512 + ch;
#pragma unroll
                            for (int g = 0; g < 4; ++g) {
                                const float a0 = arx[4 * g], a1 = arx[4 * g + 1], a2 = arx[4 * g + 2], a3 = arx[4 * g + 3];
                                const float b0 = aix[4 * g], b1 = aix[4 * g + 1], b2 = aix[4 * g + 2], b3 = aix[4 * g + 3];
                                const float Ao = (a0 * a1) * (a2 * a3), Bo = ((b0 * a1 + b1) * a2 + b2) * a3 + b3;
                                const float Ap = __shfl_xor(Ao, 32), Bp = __shfl_xor(Bo, 32);
                                const float A1 = hi ? Ap : Ao, B1 = hi ? Bp : Bo, A2 = hi ? Ao : Ap, B2 = hi ? Bo : Bp;
                                const float Hm = A1 * H + B1, Pm = A1 * P;
                                float h = hi ? Hm : H, p = hi ? Pm : P;
                                H = A2 * Hm + B2; P = A2 * Pm;
                                float* hg = hl + (size_t)g * 8 * 512; bf16_t* pg = pc + (size_t)g * 8 * 512; asm volatile("" : "+v"(hg), "+v"(pg));
                                h = a0 * h + b0; p *= a0; hg[0 * 512] = h; pg[0 * 512] = (bf16_t)f2bf(p);
                                h = a1 * h + b1; p *= a1; hg[1 * 512] = h; pg[1 * 512] = (bf16_t)f2bf(p);
                                h = a2 * h + b2; p *= a2; hg[2 * 512] = h; pg[2 * 512] = (bf16_t)f2bf(p);
                                h = a3 * h + b3; p *= a3; hg[3 * 512] = h; pg[3 * 512] = (bf16_t)f2bf(p);
                            }
                            if (hi == 0) { ASEG[(size_t)seg * 512 + ch] = P; BSEG[(size_t)seg * 512 + ch] = H; }
                            CFENCE(); __builtin_amdgcn_sched_barrier(0);
                        }
                    }
                }
                for (int row = gw; row < MTOK; row += NGW) {
                    const u32x2 q = *(const u32x2*)(PROJ + (size_t)row * PPITCH + 2048 + lane * 4);
                    const float a0 = __uint_as_float(q.x << 16), a1 = __uint_as_float(q.x & 0xffff0000u), a2 = __uint_as_float(q.y << 16), a3 = __uint_as_float(q.y & 0xffff0000u);
                    float ss = (a0 * a0 + a1 * a1) + (a2 * a2 + a3 * a3);
                    ss += __shfl_xor(ss, 1); ss += __shfl_xor(ss, 2); ss += __shfl_xor(ss, 4); ss += __shfl_xor(ss, 8);
                    if ((lane & 15) == 0) KS[(size_t)((row >> 12) * 4 + (lane >> 4)) * SEQL + (row & (SEQL - 1))] = __builtin_amdgcn_rsqf(ss * (1.0f / 64.0f) + EPSF);
                }
                if (wave == 0) for (int chn = vcu; chn < 64; chn += G) {
                    const int b = chn >> 2, h = chn & 3; const float bf = b_fg[l * 4 + h];
                    const float* fp = FG + ((size_t)b * SEQL + lane * 64) * 4 + h;
                    float tot = 0.f;
#pragma unroll 8
                    for (int i = 0; i < 64; ++i) { const float v = fp[i * 4] + bf; tot += __builtin_fminf(v, 0.f) - log1pf(expf(-fabsf(v))); }
                    float inc = tot;
#pragma unroll
                    for (int o = 1; o < 64; o <<= 1) { const float t_ = __shfl_up(inc, o); if (lane >= o) inc += t_; }
                    float run = inc - tot;
                    float* op = F2 + (size_t)chn * SEQL + lane * 64;
#pragma unroll 8
                    for (int i = 0; i < 64; ++i) { const float v = fp[i * 4] + bf; run += __builtin_fminf(v, 0.f) - log1pf(expf(-fabsf(v))); op[i] = -run * LOG2E; }
                }
#endif
                __syncthreads();
            }
            PH_NEXT;
            if (PH_ON) { DEFPTRS
#ifndef NO_ATTN
                for (int rep_ = 0; rep_ < REP_ATTN; ++rep_)
                for (int vw = vcu; vw < 256; vw += G) {
                    const int bh = vw >> 2, s4 = vw & 3, b = bh >> 2, h = bh & 3;
#pragma unroll 1
                    for (int i = 0; i < 4; ++i) { const int qb = (i == 0) ? s4 : (i == 1) ? 7 - s4 : (i == 2) ? 8 + s4 : 15 - s4;
#ifndef NO_FOX
                        attn_unit<1>(lds, PROJ, YU, KS, F2, g_qk + l * 128, b, h, qb);
#endif
 }
#pragma unroll 1
                    for (int i = 0; i < 4; ++i) { const int qb = (i == 0) ? s4 : (i == 1) ? 7 - s4 : (i == 2) ? 8 + s4 : 15 - s4;
#ifndef NO_SB
                        attn_unit<0>(lds, PROJ, YU, KS, F2, g_qk + l * 128, b, h, qb);
#endif
 }
                }
#endif
            }
            PH_NEXT;
            if (PH_ON) { DEFPTRS
                LAS float* hin = (LAS float*)lds;
                const f32x4 gm0 = *(const f32x4*)(g_mix + l * 1024 + lane * 8), gm1 = *(const f32x4*)(g_mix + l * 1024 + lane * 8 + 4);
                const f32x4 gx0 = *(const f32x4*)(g_mix + l * 1024 + 512 + lane * 8), gx1 = *(const f32x4*)(g_mix + l * 1024 + 512 + lane * 8 + 4);
                for (int tti = vcu; tti < REP_FIN * 256; tti += G) { const int tt = tti & 255;
                    __syncthreads();
                    { const int ch = tid, seg0 = (tt >> 4) * 128, nb = (tt & 15) * 8; float Hc = 0.f;
#pragma unroll 8
                      for (int sg = 0; sg < nb; ++sg) Hc = ASEG[(size_t)(seg0 + sg) * 512 + ch] * Hc + BSEG[(size_t)(seg0 + sg) * 512 + ch];
#pragma unroll
                      for (int s8 = 0; s8 < 8; ++s8) { hin[s8 * 512 + ch] = Hc; Hc = ASEG[(size_t)(seg0 + nb + s8) * 512 + ch] * Hc + BSEG[(size_t)(seg0 + nb + s8) * 512 + ch]; } }
                    __syncthreads();
                    const f32x4 hi0 = *(const LAS f32x4*)(hin + wave * 512 + lane * 8), hi1 = *(const LAS f32x4*)(hin + wave * 512 + lane * 8 + 4);
#pragma unroll 2
                    for (int t = 0; t < 32; ++t) {
                        const size_t row = (size_t)tt * 256 + wave * 32 + t;
                        const f32x4 h0 = *(const f32x4*)(HLOC + row * 512 + lane * 8), h1 = *(const f32x4*)(HLOC + row * 512 + lane * 8 + 4);
                        const u32x4 pq = *(const u32x4*)(PCUM + row * 512 + lane * 8);
                        const u32x4 gq = *(const u32x4*)(PROJ + row * PPITCH + 512 + lane * 8);
                        const u32x4 yq = *(const u32x4*)(YU + row * 512 + lane * 8);
                        float y[8], yu[8]; float ss = 0.f, s2 = 0.f;
#pragma unroll
                        for (int i = 0; i < 8; ++i) {
                            const unsigned pw = pq[i >> 1], gw_ = gq[i >> 1], yw = yq[i >> 1];
                            const float p = (i & 1) ? __uint_as_float(pw & 0xffff0000u) : __uint_as_float(pw << 16);
                            const float gg = (i & 1) ? __uint_as_float(gw_ & 0xffff0000u) : __uint_as_float(gw_ << 16);
                            yu[i] = (i & 1) ? __uint_as_float(yw & 0xffff0000u) : __uint_as_float(yw << 16);
                            const float hh = (i < 4 ? h0[i & 3] : h1[i & 3]) + p * (i < 4 ? hi0[i & 3] : hi1[i & 3]);
                            const float inner = 0.7978845608028654f * (gg + 0.044715f * gg * gg * gg);
                            const float ge = gg * __builtin_amdgcn_rcpf(1.0f + __builtin_amdgcn_exp2f(-2.0f * LOG2E * inner));
                            y[i] = hh * ge; ss += y[i] * y[i]; s2 += yu[i] * yu[i];
                        }
                        ss = wave_sum(ss);
                        s2 += __shfl_xor(s2, 1); s2 += __shfl_xor(s2, 2); s2 += __shfl_xor(s2, 4); s2 += __shfl_xor(s2, 8); s2 += __shfl_xor(s2, 16);
                        const float rl = __builtin_amdgcn_rsqf(ss * (1.0f / 512.0f) + EPSF), rx = __builtin_amdgcn_rsqf(s2 * (1.0f / 256.0f) + EPSF);
                        u32x4 o1, o2;
                        o1.x = pk2(y[0] * rl * gm0[0], y[1] * rl * gm0[1]); o1.y = pk2(y[2] * rl * gm0[2], y[3] * rl * gm0[3]);
                        o1.z = pk2(y[4] * rl * gm1[0], y[5] * rl * gm1[1]); o1.w = pk2(y[6] * rl * gm1[2], y[7] * rl * gm1[3]);
                        o2.x = pk2(yu[0] * rx * gx0[0], yu[1] * rx * gx0[1]); o2.y = pk2(yu[2] * rx * gx0[2], yu[3] * rx * gx0[3]);
                        o2.z = pk2(yu[4] * rx * gx1[0], yu[5] * rx * gx1[1]); o2.w = pk2(yu[6] * rx * gx1[2], yu[7] * rx * gx1[3]);
                        *(u32x4*)(YN + row * 1024 + lane * 8) = o1; *(u32x4*)(YN + row * 1024 + 512 + lane * 8) = o2;
                    }
                }
                __syncthreads();
            }
            PH_NEXT;
            if (PH_ON) { DEFPTRS
                pg8::Gemm g{YN, WOUT + (size_t)l * DM * DM, MTOK, DM, DM}; pg8::StaticOrder S; S.init(MTOK, DM, G, bx);
                pg8::EpiRes E{xout, xout, GATE + (size_t)(l * 3 + 1) * 16 * 1024, GMOD + (size_t)(l * 3 + 2) * 16 * 1024, XN, ROWSS + (size_t)(l * 3 + 2) * MTOK, 1};
#ifndef NO_G_OUT
                pg8::gemm_phase<pg8::EpiRes, pg8::StaticOrder, true, true>(lds, g, S, E);
#endif
            }
            PH_NEXT;
        }
        const int j = s ? 2 : 0;
        if (PH_ON) { DEFPTRS
            pg8::Gemm g{XN, WUP + (size_t)(l * 2 + s) * NUP * DM, MTOK, NUP, DM}; pg8::StaticOrder S; S.init(MTOK, NUP, G, bx);
            pg8::EpiUp E{HB, ROWSS + (size_t)(l * 3 + j) * MTOK, SBV + (size_t)(l * 3 + j) * 16 * 5632};
#ifndef NO_G_UP
            for (int rep_ = 0; rep_ < REP_UP; ++rep_) {
            pg8::gemm_phase<pg8::EpiUp, pg8::StaticOrder, true, true>(lds, g, S, E);
            }
#endif
        }
        PH_NEXT;
        if (PH_ON) { DEFPTRS
            const int nl = s ? l + 1 : l, nj = s ? 0 : 1; const int has_next = (nl < 2) ? 1 : 0; const int nidx = has_next ? nl * 3 + nj : 0;
            pg8::Gemm g{HB, WDN + (size_t)(l * 2 + s) * DM * DFF, MTOK, DM, DFF}; pg8::StaticOrder S; S.init(MTOK, DM, G, bx);
            pg8::EpiRes E{f == 0 ? x_in : xout, xout, GATE + (size_t)(l * 3 + j) * 16 * 1024, GMOD + (size_t)nidx * 16 * 1024, XN, ROWSS + (size_t)nidx * MTOK, has_next};
#ifndef NO_G_DN
#ifdef REP_DN
            for (int rep_ = 0; rep_ < 2; ++rep_) { E.xout = (rep_ == 0) ? HLOC : xout;
            pg8::gemm_phase<pg8::EpiRes, pg8::StaticOrder, true, true>(lds, g, S, E); }
#else
            pg8::gemm_phase<pg8::EpiRes, pg8::StaticOrder, true, true>(lds, g, S, E);
#endif
#endif
        }
        PH_NEXT;
    }
#undef PH_ON
#undef PH_NEXT
}


#ifdef DBG_STOP
__global__ void dbg_dump(const unsigned char* ws, float* out, int mode) {
    const size_t n = (size_t)MTOK * DM; const size_t i0 = (size_t)blockIdx.x * blockDim.x + threadIdx.x, st = (size_t)gridDim.x * blockDim.x;
    const bf16_t* XN = (const bf16_t*)(ws + WS_XN); const bf16_t* HB = (const bf16_t*)(ws + WS_H); const bf16_t* PR = (const bf16_t*)(ws + WS_PROJ);
    const bf16_t* YU = (const bf16_t*)(ws + WS_YU); const float* HL = (const float*)(ws + WS_HLOC); const bf16_t* YN = (const bf16_t*)(ws + WS_YN); const bf16_t* PC = (const bf16_t*)(ws + WS_PCUM);
    for (size_t i = i0; i < n; i += st) {
        float v = 0.f;
        if (mode == 0) v = bf2f(XN[i]);
        else if (mode == 1) v = bf2f(HB[i]) + bf2f(HB[i + n]) + bf2f(HB[i + (size_t)117440512]);
        else if (mode == 2) v = bf2f(PR[i]) + bf2f(PR[i + n]) + bf2f(PR[i + (size_t)100663296]);
        else if (mode == 3) v = (i < n / 2) ? bf2f(YU[i]) : HL[i - n / 2];
        else if (mode == 4) v = bf2f(YN[i]);
        else if (mode == 6) v = (i < n / 2) ? bf2f(PC[i]) : ((const float*)(ws + WS_KS))[(i - n / 2) % (3 * 262144)];
        else if (mode == 7) v = HL[i % (n / 2)] + bf2f(PC[i % (n / 2)]) + ((const float*)(ws + WS_KS))[i % (3 * 262144)] + ((const float*)(ws + WS_ASEG))[i % (2 * 1048576)];
        if (mode == 3) { const bool nan_ = !(v == v), big = (v > 3e38f) || (v < -3e38f); float code = 0.f;
            if (i < n / 2) { const int col = (int)(i & 511); if (col < 256) code = nan_ ? 2000.f : (big ? 1000.f : 0.f); else code = (nan_ || big) ? 4000.f : 0.f; }
            else code = (nan_ || big) ? 8000.f : 0.f;
            v = code; }
        if (!(v == v)) v = 77777.f; if (v > 3e38f) v = 88888.f; if (v < -3e38f) v = 99999.f;
        if (mode != 5) out[i] = v;
    }
}
#endif
#ifndef MK_N_LAUNCHES
#define MK_N_LAUNCHES 1
#endif
constexpr int N_PHASES = 3 + 2 * 9;
extern "C" void kernel_launch(void* const* d_in, const int* in_sizes, int n_in, void* d_out, int out_size, void* d_ws, size_t ws_size, hipStream_t stream) {
    static int grid = 0;
    if (grid == 0) {
        if (n_in != 19 || out_size != MTOK * DM || ws_size < WS_END) { fprintf(stderr, "kernel_launch: unexpected shapes (n_in %d, out %d, ws %zu)\n", n_in, out_size, ws_size); grid = -1; return; }
        int dev = 0, cus = 0, per_cu = 0;
        hipGetDevice(&dev); hipDeviceGetAttribute(&cus, hipDeviceAttributeMultiprocessorCount, dev);
        if (hipFuncSetAttribute((const void*)mk_fwd, hipFuncAttributeMaxDynamicSharedMemorySize, LDS_BYTES) != hipSuccess) { fprintf(stderr, "kernel_launch: hipFuncSetAttribute failed\n"); grid = -1; return; }
        if (hipOccupancyMaxActiveBlocksPerMultiprocessor(&per_cu, (const void*)mk_fwd, 512, LDS_BYTES) != hipSuccess || per_cu < 1) { fprintf(stderr, "kernel_launch: occupancy query says %d\n", per_cu); per_cu = 1; }
        (void)hipGetLastError();
        grid = cus * 1;
    }
    if (grid < 0) return;
    if (hipMemsetAsync(d_ws, 0, 16384, stream) != hipSuccess) { fprintf(stderr, "kernel_launch: memset failed\n"); return; }
    Args a{};
    for (int i = 0; i < 19; ++i) a.in[i] = (const float*)d_in[i];
    a.out = (float*)d_out; a.ws = (unsigned char*)d_ws;
#if MK_N_LAUNCHES == 1
    a.ph_lo = 0; a.ph_hi = N_PHASES;
    void* kargs[] = {&a};
    hipError_t e = hipLaunchCooperativeKernel((const void*)mk_fwd, dim3(grid), dim3(512), kargs, LDS_BYTES, stream);
    if (e != hipSuccess) fprintf(stderr, "kernel_launch: cooperative launch failed: %s (grid %d)\n", hipGetErrorString(e), grid);
#else
#ifdef DBG_STOP
    for (int p = 0; p < DBG_STOP; ++p) { a.ph_lo = p; a.ph_hi = p + 1; hipLaunchKernelGGL(mk_fwd, dim3(grid), dim3(512), LDS_BYTES, stream, a); }
    hipLaunchKernelGGL(dbg_dump, dim3(2048), dim3(256), 0, stream, (const unsigned char*)d_ws, (float*)d_out, DBG_MODE);
#else
    for (int p = 0; p < N_PHASES; ++p) { a.ph_lo = p; a.ph_hi = p + 1; hipLaunchKernelGGL(mk_fwd, dim3(grid), dim3(512), LDS_BYTES, stream, a); }
#endif
#endif
}
```

```cpp
#include <hip/hip_runtime.h>
#include <hip/hip_cooperative_groups.h>
#include <cstdio>
#include <cstdint>
namespace cg = cooperative_groups;
namespace pg8 {
#define PG8_LAS __attribute__((address_space(3)))
typedef unsigned short bf16_t;
typedef short bf16x8 __attribute__((ext_vector_type(8)));
typedef float f32x4 __attribute__((ext_vector_type(4)));
typedef unsigned u32x4 __attribute__((ext_vector_type(4)));
constexpr int BM = 256, BK = 64, HALF = 128, HTB = HALF * BK * 2  , STAGE_BYTES = 8 * HTB, NXCD = 8, WGM = 8;

__host__ __device__ __forceinline__ int lds_byte(int r, int c) { const int st = (r >> 4) * 2 + (c >> 5), rr = r & 15, cc = c & 31, ob = rr * 64 + cc * 2; return st * 1024 + (ob ^ (((ob >> 9) & 1) << 5)); }
__host__ __device__ __forceinline__ void stage_rc(int b, int& R, int& C) { const int st = b / 1024, sb = b % 1024, swz = sb ^ (((sb >> 9) & 1) << 5); R = (st >> 1) * 16 + swz / 64; C = (st & 1) * 32 + (swz % 64) / 2; }
__host__ __device__ __forceinline__ int perm32(int rho) { const int n = rho >> 4, i = rho & 15; return 8 * (i >> 2) + 4 * n + (i & 3); }

struct Unit { int pm, pn; };
struct Gemm { const bf16_t* A; const bf16_t* Bt; int M, N, K; };

struct StaticOrder {
    int nM, nN, nwg, G, c;
    __host__ __device__ void init(int M, int N, int G_, int c_) { nM = M / BM; nN = N / BM; nwg = nM * nN; G = G_; c = c_; }
    __host__ __device__ bool next(int i, Unit& u) const {
        const long L = (long)i * G + c; if (L >= nwg) return false;
        int wgid = (int)L; { const int q = nwg / NXCD, r = nwg % NXCD, xcd = wgid % NXCD, off = wgid / NXCD; wgid = (xcd < r ? xcd * (q + 1) : r * (q + 1) + (xcd - r) * q) + off; }
        const int nig = WGM * nN, gid = wgid / nig, fm = gid * WGM, gsz = (nM - fm) < WGM ? (nM - fm) : WGM;
        u.pm = fm + ((wgid % nig) % gsz); u.pn = (wgid % nig) / gsz; return true;
    }
    __device__ __forceinline__ void a_ready(const Unit&) const {}
    __device__ __forceinline__ void done(const Unit&) const {}
};

typedef float f32x2c_t __attribute__((ext_vector_type(2))); typedef __bf16 bf16x2c_t __attribute__((ext_vector_type(2)));
__device__ __forceinline__ unsigned cvt_pk_bf16(float lo, float hi) { f32x2c_t v = {lo, hi}; bf16x2c_t b = __builtin_convertvector(v, bf16x2c_t); return __builtin_bit_cast(unsigned, b); }
typedef float f32x2 __attribute__((ext_vector_type(2)));
constexpr float RMS_EPS = 1e-6f;
struct EpiUp {
    static constexpr bool PERM = true, AFTER_DRAIN = false;
    bf16_t* H; const float* rowss; const float* sb;
    __device__ __forceinline__ void operator()(const f32x4 (&acc)[2][2][4][2], const Unit& u, int wr, int wc, int fr, int fq) const {
        const int row0 = u.pm * BM + wr * 64 + fr, b = u.pm >> 4, cl = wc * 32 + 8 * fq;
        const float* sbp = sb + (size_t)b * 5632 + u.pn * 256 + cl;
        float rsv[2][4];
#pragma unroll
        for (int ai = 0; ai < 2; ++ai)
#pragma unroll
            for (int m = 0; m < 4; ++m) rsv[ai][m] = rowss[row0 + ai * HALF + m * 16];
        f32x4 sg[2], su[2];
#pragma unroll
        for (int n = 0; n < 2; ++n) { sg[n] = *(const f32x4*)(sbp + 4 * n); su[n] = *(const f32x4*)(sbp + 128 + 4 * n); }
#pragma unroll
        for (int ai = 0; ai < 2; ++ai)
#pragma unroll
            for (int m = 0; m < 4; ++m) {
                const int row = row0 + ai * HALF + m * 16;
                const float rs = __builtin_amdgcn_rsqf(rsv[ai][m] * (1.0f / 1024.0f) + RMS_EPS);
                unsigned wq[4];
#pragma unroll
                for (int n = 0; n < 2; ++n)
#pragma unroll
                    for (int ip = 0; ip < 2; ++ip) {
                        const f32x2 ag = (f32x2){acc[ai][0][m][n][2 * ip], acc[ai][0][m][n][2 * ip + 1]}, au = (f32x2){acc[ai][1][m][n][2 * ip], acc[ai][1][m][n][2 * ip + 1]};
                        const f32x2 g = ag * rs + (f32x2){sg[n][2 * ip], sg[n][2 * ip + 1]}, uu = au * rs + (f32x2){su[n][2 * ip], su[n][2 * ip + 1]};
                        const f32x2 t = g * (-1.4426950408889634f);
                        f32x2 d; d.x = __builtin_amdgcn_exp2f(t.x); d.y = __builtin_amdgcn_exp2f(t.y); d = d + 1.0f;
                        f32x2 r; r.x = __builtin_amdgcn_rcpf(d.x); r.y = __builtin_amdgcn_rcpf(d.y);
                        const f32x2 hv = (g * uu) * r;
                        wq[n * 2 + ip] = cvt_pk_bf16(hv.x, hv.y);
                    }
                u32x4 w; w.x = wq[0]; w.y = wq[1]; w.z = wq[2]; w.w = wq[3];
                *(u32x4*)(H + (size_t)row * 2816 + u.pn * 128 + cl) = w;
            }
    }
};
struct EpiIn {
    static constexpr bool PERM = true, AFTER_DRAIN = false;
    bf16_t* P; float* FG; const float* rowss; const float* sb;
    __device__ __forceinline__ void operator()(const f32x4 (&acc)[2][2][4][2], const Unit& u, int wr, int wc, int fr, int fq) const {
        const int row0 = u.pm * BM + wr * 64 + fr, b = u.pm >> 4, cl = wc * 32 + 8 * fq;
        const float* sbp = sb + (size_t)b * 5632 + u.pn * 256 + cl;
        float rsv[2][4];
#pragma unroll
        for (int ai = 0; ai < 2; ++ai)
#pragma unroll
            for (int m = 0; m < 4; ++m) rsv[ai][m] = rowss[row0 + ai * HALF + m * 16];
        f32x4 sv[2][2];
#pragma unroll
        for (int bj = 0; bj < 2; ++bj)
#pragma unroll
            for (int n = 0; n < 2; ++n) sv[bj][n] = *(const f32x4*)(sbp + bj * HALF + 4 * n);
#pragma unroll
        for (int ai = 0; ai < 2; ++ai)
#pragma unroll
            for (int m = 0; m < 4; ++m) {
                const int row = row0 + ai * HALF + m * 16;
                const float rs = __builtin_amdgcn_rsqf(rsv[ai][m] * (1.0f / 1024.0f) + RMS_EPS);
                if (u.pn < 10) {
#pragma unroll
                    for (int bj = 0; bj < 2; ++bj) {
                        const f32x4 v0 = acc[ai][bj][m][0] * rs + sv[bj][0], v1 = acc[ai][bj][m][1] * rs + sv[bj][1];
                        u32x4 w; w.x = cvt_pk_bf16(v0[0], v0[1]); w.y = cvt_pk_bf16(v0[2], v0[3]); w.z = cvt_pk_bf16(v1[0], v1[1]); w.w = cvt_pk_bf16(v1[2], v1[3]);
                        *(u32x4*)(P + (size_t)row * 2560 + u.pn * 256 + bj * HALF + cl) = w;
                    }
                } else if (wc == 0 && fq == 0) {
                    *(f32x4*)(FG + (size_t)row * 4) = acc[ai][0][m][0] * rs + sv[0][0];
                }
            }
    }
};
struct EpiRes {
    static constexpr bool PERM = false, AFTER_DRAIN = false;
    const float* xin; float* xout; const float* gate; const float* gmn; bf16_t* XN; float* rowssn; int has_next;
    __device__ __forceinline__ void operator()(const f32x4 (&acc)[2][2][4][2], const Unit& u, int wr, int wc, int fr, int fq) const {
        typedef unsigned u32x2v __attribute__((ext_vector_type(2)));
        const int row0 = u.pm * BM + wr * 64 + fr, b = u.pm >> 4, col0 = u.pn * BM + wc * 32 + 4 * fq;
        const float* gp_ = gate + b * 1024 + col0; const float* gm_ = gmn + b * 1024 + col0;
#pragma unroll
        for (int ai = 0; ai < 2; ++ai) {
            f32x4 xi[4][2][2];
#pragma unroll
            for (int m = 0; m < 4; ++m)
#pragma unroll
                for (int bj = 0; bj < 2; ++bj)
#pragma unroll
                    for (int n = 0; n < 2; ++n) xi[m][bj][n] = *(const f32x4*)(xin + (size_t)(row0 + ai * HALF + m * 16) * 1024 + col0 + bj * HALF + n * 16);
            asm volatile("" ::: "memory");
#pragma unroll
            for (int m = 0; m < 4; ++m) {
                const int row = row0 + ai * HALF + m * 16; const size_t off = (size_t)row * 1024 + col0;
                float ss = 0.f;
#pragma unroll
                for (int bj = 0; bj < 2; ++bj)
#pragma unroll
                    for (int n = 0; n < 2; ++n) {
                        const f32x4 xo = xi[m][bj][n] + *(const f32x4*)(gp_ + bj * HALF + n * 16) * acc[ai][bj][m][n];
                        *(f32x4*)(xout + off + bj * HALF + n * 16) = xo;
                        if (has_next) {
                            ss += (xo[0] * xo[0] + xo[1] * xo[1]) + (xo[2] * xo[2] + xo[3] * xo[3]);
                            const f32x4 a = xo * *(const f32x4*)(gm_ + bj * HALF + n * 16); u32x2v w; w.x = cvt_pk_bf16(a[0], a[1]); w.y = cvt_pk_bf16(a[2], a[3]);
                            *(u32x2v*)(XN + off + bj * HALF + n * 16) = w;
                        }
                    }
                if (has_next) { ss += __shfl_xor(ss, 16); ss += __shfl_xor(ss, 32); if (fq == 0) unsafeAtomicAdd(rowssn + row, ss); }
            }
            asm volatile("" ::: "memory");
        }
    }
};

template <class Epi, class Sched, bool ALIGN_EPI = false, bool SP2 = false>
__device__ __forceinline__ void gemm_phase(PG8_LAS unsigned char* lds, const Gemm g, const Sched& S, const Epi& E) {
    int tid_o = threadIdx.x; asm volatile("" : "+v"(tid_o)); const int tid = tid_o, wid = __builtin_amdgcn_readfirstlane(tid >> 6), lane = tid & 63, wr = wid >> 2, wc = wid & 3, fr = lane & 15, fq = lane >> 4;
    const int K = g.K, nt = K / BK;
    unsigned voffA[2], voffB[2];
#pragma unroll
    for (int i = 0; i < 2; ++i) { int R, C; stage_rc(tid * 16 + i * 8192, R, C); const int Rb = Epi::PERM ? ((R & ~31) + perm32(R & 31)) : R;
        voffA[i] = (unsigned)(R * K + C) * 2u; voffB[i] = (unsigned)(Rb * K + C) * 2u; }
    const size_t kstep = (size_t)(BK * 2);
    const size_t hstep = (size_t)HALF * K * 2;
    const size_t tstep = 2 * hstep;
    const unsigned ldsw = (unsigned)wid * 1024u;
    const int aoff = lds_byte(wr * 64 + fr, fq * 8), boff = lds_byte(wc * 32 + fr, fq * 8);
#define PG8_SA(b, h) (((b) * 2 + (h)) * HTB)
#define PG8_SB(b, h) ((4 + (b) * 2 + (h)) * HTB)
#define PG8_STAGE(bufoff, gbase, voff) do { _Pragma("unroll") for (int _i = 0; _i < 2; ++_i) \
        __builtin_amdgcn_global_load_lds((const unsigned*)((const char*)(gbase) + (voff)[_i]), (PG8_LAS unsigned*)(lds + (bufoff) + ldsw + _i * 8192), 16, 0, 0); } while (0)
#define PG8_LDA(dst, b, h) do { _Pragma("unroll") for (int m = 0; m < 4; ++m) _Pragma("unroll") for (int k = 0; k < 2; ++k) dst[m][k] = *(const PG8_LAS bf16x8*)(lds + PG8_SA(b, h) + aoff + m * 2048 + k * 1024); } while (0)
#define PG8_LDB(dst, b, h) do { _Pragma("unroll") for (int n = 0; n < 2; ++n) _Pragma("unroll") for (int k = 0; k < 2; ++k) dst[n][k] = *(const PG8_LAS bf16x8*)(lds + PG8_SB(b, h) + boff + n * 2048 + k * 1024); } while (0)
#define PG8_MMA(ai, bj, At, Bt) do { __builtin_amdgcn_s_setprio(1); _Pragma("unroll") for (int m = 0; m < 4; ++m) _Pragma("unroll") for (int n = 0; n < 2; ++n) _Pragma("unroll") for (int k = 0; k < 2; ++k) \
        acc[ai][bj][m][n] = __builtin_amdgcn_mfma_f32_16x16x32_bf16(Bt[n][k], At[m][k], acc[ai][bj][m][n], 0, 0, 0); __builtin_amdgcn_s_setprio(0); } while (0)
#define PG8_WAIT_V(n) asm volatile("s_waitcnt vmcnt(" #n ")" ::: "memory")
#define PG8_WAIT_L(n) asm volatile("s_waitcnt lgkmcnt(" #n ")" ::: "memory")
#define PG8_BAR __builtin_amdgcn_s_barrier()
#define PG8_SCHED __builtin_amdgcn_sched_barrier(0)
    Unit cur, nxt; int ui = 0;
    if (!S.next(0, cur)) return;
    f32x4 acc[2][2][4][2];
#pragma unroll
    for (int a = 0; a < 2; ++a)
#pragma unroll
        for (int b = 0; b < 2; ++b)
#pragma unroll
            for (int m = 0; m < 4; ++m)
#pragma unroll
                for (int n = 0; n < 2; ++n) acc[a][b][m][n] = (f32x4){0.f, 0.f, 0.f, 0.f};
    bf16x8 At[4][2], B0[2][2], B1[2][2];
    const char* cA = (const char*)g.A + (size_t)cur.pm * tstep; const char* cB = (const char*)g.Bt + (size_t)cur.pn * tstep;
    S.a_ready(cur);
    if constexpr (SP2) {
        PG8_STAGE(PG8_SB(0, 0), cB, voffB); PG8_STAGE(PG8_SB(0, 1), cB + hstep, voffB); PG8_STAGE(PG8_SA(0, 0), cA, voffA); PG8_STAGE(PG8_SA(0, 1), cA + hstep, voffA);
        if (wr == 1) PG8_BAR;
        PG8_WAIT_V(2); PG8_BAR;
        PG8_STAGE(PG8_SB(1, 0), cB + kstep, voffB); PG8_STAGE(PG8_SA(1, 0), cA + kstep, voffA); PG8_STAGE(PG8_SB(1, 1), cB + hstep + kstep, voffB);
        PG8_WAIT_V(6); PG8_BAR;
    } else {
        PG8_STAGE(PG8_SB(0, 0), cB, voffB); PG8_STAGE(PG8_SA(0, 0), cA, voffA); PG8_STAGE(PG8_SB(0, 1), cB + hstep, voffB); PG8_STAGE(PG8_SA(0, 1), cA + hstep, voffA);
        if (wr == 1) PG8_BAR;
        PG8_WAIT_V(4); PG8_BAR;
        PG8_STAGE(PG8_SB(1, 0), cB + kstep, voffB); PG8_STAGE(PG8_SA(1, 0), cA + kstep, voffA); PG8_STAGE(PG8_SB(1, 1), cB + hstep + kstep, voffB);
        PG8_WAIT_V(6); PG8_BAR;
    }
    for (;;) {
        const bool has_next = S.next(ui + 1, nxt);
        const char* nA = has_next ? (const char*)g.A + (size_t)nxt.pm * tstep : cA; const char* nB = has_next ? (const char*)g.Bt + (size_t)nxt.pn * tstep : cB;
        for (int t = 0; t < nt; t += 2) {
            const bool last = (t == nt - 2);
            const char* a1 = cA + (size_t)(t + 1) * kstep;
            const char* a2 = last ? nA : cA + (size_t)(t + 2) * kstep; const char* b2 = last ? nB : cB + (size_t)(t + 2) * kstep;
            const char* a3 = a2 + kstep; const char* b3 = b2 + kstep;
            if (last && has_next) S.a_ready(nxt);
            if constexpr (SP2) {
            PG8_LDB(B0, 0, 0); PG8_LDB(B1, 0, 1); PG8_SCHED; PG8_LDA(At, 0, 0); PG8_STAGE(PG8_SA(1, 1), a1 + hstep, voffA);
            PG8_WAIT_V(8); PG8_WAIT_L(0); PG8_BAR; PG8_MMA(0, 0, At, B0); PG8_MMA(0, 1, At, B1); PG8_BAR; PG8_SCHED;
            PG8_LDA(At, 0, 1); PG8_STAGE(PG8_SB(0, 0), b2, voffB); PG8_STAGE(PG8_SB(0, 1), b2 + hstep, voffB); PG8_STAGE(PG8_SA(0, 0), a2, voffA);
            PG8_WAIT_V(8); PG8_WAIT_L(0); PG8_BAR; PG8_MMA(1, 0, At, B0); PG8_MMA(1, 1, At, B1); PG8_BAR; PG8_SCHED;
            PG8_LDB(B0, 1, 0); PG8_LDB(B1, 1, 1); PG8_SCHED; PG8_LDA(At, 1, 0); PG8_STAGE(PG8_SA(0, 1), a2 + hstep, voffA);
            PG8_WAIT_V(8); PG8_WAIT_L(0); PG8_BAR; PG8_MMA(0, 0, At, B0); PG8_MMA(0, 1, At, B1); PG8_BAR; PG8_SCHED;
            PG8_LDA(At, 1, 1); PG8_STAGE(PG8_SB(1, 0), b3, voffB); PG8_STAGE(PG8_SB(1, 1), b3 + hstep, voffB); PG8_STAGE(PG8_SA(1, 0), a3, voffA);
            PG8_WAIT_V(8); PG8_WAIT_L(0); PG8_BAR; PG8_MMA(1, 0, At, B0); PG8_MMA(1, 1, At, B1); PG8_BAR; PG8_SCHED;
            } else {
            PG8_LDB(B0, 0, 0); PG8_SCHED; PG8_LDA(At, 0, 0); PG8_STAGE(PG8_SA(1, 1), a1 + hstep, voffA);
            PG8_WAIT_L(8); PG8_BAR; PG8_WAIT_L(0); PG8_MMA(0, 0, At, B0); PG8_BAR; PG8_SCHED;
            PG8_LDB(B1, 0, 1); PG8_STAGE(PG8_SB(0, 0), b2, voffB);
            PG8_BAR; PG8_WAIT_L(0); PG8_MMA(0, 1, At, B1); PG8_BAR;
            PG8_LDA(At, 0, 1); PG8_STAGE(PG8_SA(0, 0), a2, voffA);
            PG8_BAR; PG8_WAIT_L(0); PG8_MMA(1, 0, At, B0); PG8_BAR; PG8_SCHED;
            PG8_STAGE(PG8_SB(0, 1), b2 + hstep, voffB);
            PG8_WAIT_V(6); PG8_BAR; PG8_MMA(1, 1, At, B1); PG8_BAR;
            PG8_LDB(B0, 1, 0); PG8_SCHED; PG8_LDA(At, 1, 0); PG8_STAGE(PG8_SA(0, 1), a2 + hstep, voffA);
            PG8_WAIT_L(8); PG8_BAR; PG8_WAIT_L(0); PG8_MMA(0, 0, At, B0); PG8_BAR; PG8_SCHED;
            PG8_LDB(B1, 1, 1); PG8_STAGE(PG8_SB(1, 0), b3, voffB);
            PG8_BAR; PG8_WAIT_L(0); PG8_MMA(0, 1, At, B1); PG8_BAR;
            PG8_LDA(At, 1, 1); PG8_STAGE(PG8_SA(1, 0), a3, voffA);
            PG8_BAR; PG8_WAIT_L(0); PG8_MMA(1, 0, At, B0); PG8_BAR; PG8_SCHED;
            PG8_STAGE(PG8_SB(1, 1), b3 + hstep, voffB);
            PG8_WAIT_V(6); PG8_BAR; PG8_MMA(1, 1, At, B1); PG8_BAR;
            }
        }
        if constexpr (ALIGN_EPI) { if (wr == 0) PG8_BAR; }
        if constexpr (!Epi::AFTER_DRAIN) { E(acc, cur, wr, wc, fr, fq); S.done(cur); }
        if (!has_next) break;
#pragma unroll
        for (int a = 0; a < 2; ++a)
#pragma unroll
            for (int b = 0; b < 2; ++b)
#pragma unroll
                for (int m = 0; m < 4; ++m)
#pragma unroll
                    for (int n = 0; n < 2; ++n) acc[a][b][m][n] = (f32x4){0.f, 0.f, 0.f, 0.f};
        cur = nxt; cA = nA; cB = nB; ++ui;
        if constexpr (ALIGN_EPI) { if (wr == 1) PG8_BAR; }
    }
    PG8_WAIT_V(0);
    if constexpr (!ALIGN_EPI) { if (wr == 0) PG8_BAR; }
    PG8_BAR;
    if constexpr (Epi::AFTER_DRAIN) { E.fused(acc, cur, wr, wc, fr, fq, lds, wid, lane); S.done(cur); }
#undef PG8_SA
#undef PG8_SB
#undef PG8_STAGE
#undef PG8_LDA
#undef PG8_LDB
#undef PG8_MMA
#undef PG8_WAIT_V
#undef PG8_WAIT_L
#undef PG8_BAR
#undef PG8_SCHED
}
}

#define LAS __attribute__((address_space(3)))
typedef unsigned short bf16_t;
typedef short bf16x8 __attribute__((ext_vector_type(8)));
typedef short s16x4 __attribute__((ext_vector_type(4)));
typedef float f32x4 __attribute__((ext_vector_type(4)));
typedef float f32x2 __attribute__((ext_vector_type(2)));
typedef float f32x16 __attribute__((ext_vector_type(16)));
typedef unsigned u32x4 __attribute__((ext_vector_type(4)));
typedef unsigned u32x2 __attribute__((ext_vector_type(2)));

constexpr int MTOK = 65536, DM = 1024, DFF = 2816, NUP = 5632, NINP = 2816, PPITCH = 2560, SEQL = 4096;
constexpr float EPSF = 1e-6f, LOG2E = 1.4426950408889634f;
constexpr size_t MiB = 1u << 20;
constexpr size_t WS_MOD = 1 * MiB, WS_GMOD = 3 * MiB, WS_GATE = 4 * MiB, WS_SB = 5 * MiB, WS_ROWSS = 8 * MiB, WS_KS = 10 * MiB, WS_F2 = 11 * MiB, WS_FG = 12 * MiB,
                 WS_ASEG = 13 * MiB, WS_BSEG = 17 * MiB, WS_WUP = 24 * MiB, WS_WDN = 68 * MiB, WS_WIN = 90 * MiB, WS_WOUT = 101 * MiB, WS_XN = 112 * MiB,
                 WS_H = 240 * MiB, WS_PROJ = 240 * MiB, WS_YU = 592 * MiB, WS_HLOC = 656 * MiB, WS_PCUM = 784 * MiB, WS_YN = 848 * MiB, WS_END = 976 * MiB;
constexpr int LDS_BYTES = 147456;

__device__ __forceinline__ float bf2f(unsigned short v) { return __uint_as_float((unsigned)v << 16); }
__device__ __forceinline__ unsigned f2bf(float f) { unsigned u = __float_as_uint(f); return (u + 0x7fffu + ((u >> 16) & 1u)) >> 16; }
__device__ __forceinline__ unsigned pk2(float lo, float hi) { return pg8::cvt_pk_bf16(lo, hi); }
__device__ __forceinline__ float wave_sum(float v) {
#pragma unroll
    for (int o = 1; o < 64; o <<= 1) v += __shfl_xor(v, o);
    return v;
}
__device__ __forceinline__ float sigmoidf_(float x) { return __builtin_amdgcn_rcpf(1.0f + __builtin_amdgcn_exp2f(-LOG2E * x)); }
#define WAITV(n) asm volatile("s_waitcnt vmcnt(" #n ")" ::: "memory")
#define LBAR() asm volatile("s_waitcnt lgkmcnt(0)\n\ts_barrier" ::: "memory")
#define CFENCE() asm volatile("" ::: "memory")

#ifndef REP_FIN
#define REP_FIN 1
#endif
#ifndef REP_IN
#define REP_IN 1
#endif
#ifndef REP_PREP
#define REP_PREP 1
#endif
#ifndef REP_ATTN
#define REP_ATTN 1
#endif
#ifndef REP_UP
#define REP_UP 1
#endif
struct Args { const float* in[19]; float* out; unsigned char* ws; int ph_lo, ph_hi; };

__device__ __forceinline__ void transpose_item(const float* __restrict__ W, int ldw, int clim, int K, bf16_t* __restrict__ WT, int n0, int c0, int k0, LAS float* scr, int lane) {
    const int col = c0 + (lane & 31);
#pragma unroll 16
    for (int i = 0; i < 32; ++i) { const int kk = 2 * i + (lane >> 5); scr[kk * 33 + (lane & 31)] = (col < clim) ? W[(size_t)(k0 + kk) * ldw + col] : 0.f; }
    asm volatile("s_waitcnt lgkmcnt(0)" ::: "memory");
    const int c = lane & 7;
#pragma unroll
    for (int j = 0; j < 4; ++j) { const int n = (lane >> 3) + 8 * j; const LAS float* s = scr + (8 * c) * 33 + n;
        u32x4 o; o.x = pk2(s[0 * 33], s[1 * 33]); o.y = pk2(s[2 * 33], s[3 * 33]); o.z = pk2(s[4 * 33], s[5 * 33]); o.w = pk2(s[6 * 33], s[7 * 33]);
        *(u32x4*)(WT + (size_t)(n0 + n) * K + k0 + 8 * c) = o; }
    asm volatile("s_waitcnt lgkmcnt(0)" ::: "memory");
}

__device__ __forceinline__ int crow(int r, int hi) { return (r & 3) + 8 * (r >> 2) + 4 * hi; }
__device__ __forceinline__ s16x4 vtr(const LAS unsigned char* p) {
    typedef short v4i16_t __attribute__((ext_vector_type(4)));
    return __builtin_bit_cast(s16x4, __builtin_amdgcn_ds_read_tr16_b64_v4i16((LAS v4i16_t*)p));
}
constexpr int AT_SLOT = 16384, AT_AUX = 3 * AT_SLOT, AT_WSF = AT_AUX + 3 * 512, AT_VOTE = AT_WSF + 8 * 256;
constexpr float C2 = 0.125f * LOG2E;

__device__ __forceinline__ void sb_block(f32x16& X, float& carry, bool band, int kv0  , int qrel, int hi) {
    float lm[16];
#pragma unroll
    for (int r = 0; r < 16; ++r) {
        float z2 = X[r] * C2; z2 = __builtin_fminf(__builtin_fmaxf(z2, -120.f), 120.f);
        const float e = __builtin_amdgcn_exp2f(-z2), sp = __builtin_amdgcn_logf(1.0f + e);
        float l1 = -(sp + z2), lb = -sp;
        if (band) { const int kv = kv0 + (r & 3) + 8 * (r >> 2); const bool valid = kv < qrel; l1 = valid ? l1 : 0.f; lb = valid ? lb : -INFINITY; }
        lm[r] = l1; X[r] = lb;
    }
    float G[4], Gp[4], T[4];
#pragma unroll
    for (int g = 0; g < 4; ++g) { G[g] = (lm[4 * g] + lm[4 * g + 1]) + (lm[4 * g + 2] + lm[4 * g + 3]); Gp[g] = __shfl_xor(G[g], 32); T[g] = G[g] + Gp[g]; }
    float S = carry;
#pragma unroll
    for (int g = 3; g >= 0; --g) {
        const float a3 = S + (hi == 0 ? Gp[g] : 0.f), a2 = a3 + lm[4 * g + 3], a1 = a2 + lm[4 * g + 2], a0 = a1 + lm[4 * g + 1];
        X[4 * g + 3] = __builtin_amdgcn_exp2f(X[4 * g + 3] + a3); X[4 * g + 2] = __builtin_amdgcn_exp2f(X[4 * g + 2] + a2);
        X[4 * g + 1] = __builtin_amdgcn_exp2f(X[4 * g + 1] + a1); X[4 * g] = __builtin_amdgcn_exp2f(X[4 * g] + a0);
        S += T[g];
    }
    carry = S;
}

template <int KIND>
__device__ __forceinline__ void attn_unit(LAS unsigned char* lds, const bf16_t* __restrict__ PROJ, bf16_t* __restrict__ YU, const float* __restrict__ KS,
                                          const float* __restrict__ F2, const float* __restrict__ gqk, int b, int h, int qb) {
    int tid_o = threadIdx.x; asm volatile("" : "+v"(tid_o));
    const int tid = tid_o, lane = tid & 63, r32 = lane & 31, hi = lane >> 5;
    const int wid = __builtin_amdgcn_readfirstlane(tid >> 6);
    const int qcol = (KIND == 0 ? 1024 : 1792) + h * 64, kcol = qcol + 256, vcol = qcol + 512;
    const size_t rowbase = (size_t)b * SEQL; const int q0 = qb * 256, bh = b * 4 + h;
    const int NT = (q0 + 256) / 64;
    const bf16_t* ksrc = PROJ + (rowbase + lane) * PPITCH + kcol + wid * 8;
    const bf16_t* vsrc = PROJ + (rowbase + 16 * (wid & 3) + (lane >> 2)) * PPITCH + vcol + (wid >> 2) * 32 + (lane & 3) * 8;
    const float* axsrc = (wid == 0 ? KS : F2) + (size_t)bh * SEQL + lane;
    u32x4 kreg, vreg; float areg = 0.f;
#define AT_LOAD(it_) do { const int kt_ = NT - 1 - (it_); kreg = *(const u32x4*)(ksrc + (size_t)kt_ * 64 * PPITCH); vreg = *(const u32x4*)(vsrc + (size_t)kt_ * 64 * PPITCH); \
        if (KIND == 1 && wid < 2) areg = axsrc[kt_ * 64]; } while (0)
#define AT_STORE(slot_) do { *(LAS u32x4*)(lds + (slot_) * AT_SLOT + wid * 1024 + lane * 16) = kreg; *(LAS u32x4*)(lds + (slot_) * AT_SLOT + 8192 + wid * 1024 + lane * 16) = vreg; \
        if (KIND == 1 && wid < 2) *(LAS float*)(lds + AT_AUX + (slot_) * 512 + wid * 256 + lane * 4) = areg; } while (0)
    const bf16_t* Qw = PROJ + (rowbase + q0 + wid * 32 + r32) * PPITCH + qcol + hi * 8;
    bf16x8 qr[4];
#pragma unroll
    for (int d0 = 0; d0 < 4; ++d0) qr[d0] = *(const bf16x8*)(Qw + d0 * 16);
    AT_LOAD(0);
    if (KIND == 1) {
        float qf[4][8]; float ss = 0.f;
#pragma unroll
        for (int d0 = 0; d0 < 4; ++d0)
#pragma unroll
            for (int i = 0; i < 8; ++i) { qf[d0][i] = bf2f((unsigned short)qr[d0][i]); ss += qf[d0][i] * qf[d0][i]; }
        ss += __shfl_xor(ss, 32);
        const float rs = __builtin_amdgcn_rsqf(ss * (1.0f / 64.0f) + EPSF) * C2;
#pragma unroll
        for (int d0 = 0; d0 < 4; ++d0) {
            const float* gp = gqk + d0 * 16 + hi * 8; float v[8];
#pragma unroll
            for (int i = 0; i < 8; ++i) v[i] = qf[d0][i] * rs * gp[i] * gp[64 + i];
            u32x4 w; w.x = pk2(v[0], v[1]); w.y = pk2(v[2], v[3]); w.z = pk2(v[4], v[5]); w.w = pk2(v[6], v[7]);
            qr[d0] = __builtin_bit_cast(bf16x8, w);
        }
    }
    f32x16 o0, o1;
#pragma unroll
    for (int r = 0; r < 16; ++r) { o0[r] = 0.f; o1[r] = 0.f; }
    float mhat = -1e30f, lsum = 0.f, carry = 0.f;
    LAS float* wsf = (LAS float*)(lds + AT_WSF) + wid * 64;
    LAS unsigned* votes = (LAS unsigned*)(lds + AT_VOTE);
    const int qrel = wid * 32 + r32;
    bool wdone = false;
    AT_STORE(0); LBAR();
    for (int it = 0; it < NT; ++it) {
        const int slot = it & 1;
        if (KIND == 0 && it > 0) {
            const LAS unsigned* vp = votes + ((it - 1) & 1) * 8;
            const unsigned all = vp[0] & vp[1] & vp[2] & vp[3] & vp[4] & vp[5] & vp[6] & vp[7];
            if (all) break;
        }
        if (it + 1 < NT) AT_LOAD(it + 1);
        const int kt = NT - 1 - it, jb = kt - (NT - 4);
        const bool band = jb >= 0;
        const bool active = !(band && 64 * jb > 32 * wid + 31) && !wdone;
        if (active) {
            f32x16 p0, p1;
            { const LAS unsigned char* kb = lds + slot * AT_SLOT + hi * 1024 + r32 * 16;
#pragma unroll
              for (int d0 = 0; d0 < 4; ++d0) {
                  const bf16x8 b0 = *(const LAS bf16x8*)(kb + d0 * 2048), b1 = *(const LAS bf16x8*)(kb + d0 * 2048 + 512);
                  if (d0 == 0) { f32x16 z;
#pragma unroll
                      for (int r = 0; r < 16; ++r) z[r] = 0.f;
                      p0 = __builtin_amdgcn_mfma_f32_32x32x16_bf16(b0, qr[0], z, 0, 0, 0); p1 = __builtin_amdgcn_mfma_f32_32x32x16_bf16(b1, qr[0], z, 0, 0, 0); }
                  else { p0 = __builtin_amdgcn_mfma_f32_32x32x16_bf16(b0, qr[d0], p0, 0, 0, 0); p1 = __builtin_amdgcn_mfma_f32_32x32x16_bf16(b1, qr[d0], p1, 0, 0, 0); }
              } }
            if (KIND == 0) {
                sb_block(p1, carry, band, 64 * jb + 32 + 4 * hi, qrel, hi);
                sb_block(p0, carry, band, 64 * jb + 4 * hi, qrel, hi);
            } else {
                const LAS float* ax = (const LAS float*)(lds + AT_AUX + slot * 512);
#pragma unroll
                for (int g = 0; g < 4; ++g) {
                    const f32x4 k0 = *(const LAS f32x4*)(ax + 8 * g + 4 * hi), k1 = *(const LAS f32x4*)(ax + 32 + 8 * g + 4 * hi);
                    const f32x4 f0 = *(const LAS f32x4*)(ax + 64 + 8 * g + 4 * hi), f1 = *(const LAS f32x4*)(ax + 96 + 8 * g + 4 * hi);
#pragma unroll
                    for (int i = 0; i < 4; ++i) { p0[4 * g + i] = p0[4 * g + i] * k0[i] + f0[i]; p1[4 * g + i] = p1[4 * g + i] * k1[i] + f1[i]; }
                }
                if (band) {
#pragma unroll
                    for (int r = 0; r < 16; ++r) { const int kv = 64 * jb + crow(r, hi); if (kv > qrel) p0[r] = -INFINITY; if (kv + 32 > qrel) p1[r] = -INFINITY; }
                }
                float rm = __builtin_fmaxf(p0[0], p1[0]), rm2 = __builtin_fmaxf(p0[1], p1[1]);
#pragma unroll
                for (int r = 2; r < 16; r += 2) { rm = __builtin_fmaxf(__builtin_fmaxf(rm, p0[r]), p1[r]); rm2 = __builtin_fmaxf(__builtin_fmaxf(rm2, p0[r + 1]), p1[r + 1]); }
                rm = __builtin_fmaxf(rm, rm2);
                rm = __builtin_fmaxf(rm, __shfl_xor(rm, 32));
                if (__any(rm > mhat + 8.0f)) {
                    const float mnew = __builtin_fmaxf(mhat, rm), f = __builtin_amdgcn_exp2f(mhat - mnew);
                    lsum *= f; mhat = mnew;
                    CFENCE(); if (hi == 0) wsf[r32] = f; CFENCE();
                    asm volatile("s_waitcnt lgkmcnt(0)" ::: "memory");
#pragma unroll
                    for (int r = 0; r < 16; ++r) { const float fr_ = wsf[crow(r, hi)]; o0[r] *= fr_; o1[r] *= fr_; }
                    CFENCE();
                }
                f32x2 sacc2 = (f32x2){0.f, 0.f};
#pragma unroll
                for (int r = 0; r < 16; r += 2) {
                    const f32x2 a0 = (f32x2){p0[r], p0[r + 1]} - mhat, a1 = (f32x2){p1[r], p1[r + 1]} - mhat;
                    p0[r] = __builtin_amdgcn_exp2f(a0[0]); p0[r + 1] = __builtin_amdgcn_exp2f(a0[1]); p1[r] = __builtin_amdgcn_exp2f(a1[0]); p1[r + 1] = __builtin_amdgcn_exp2f(a1[1]);
                    sacc2 += (f32x2){p0[r], p0[r + 1]}; sacc2 += (f32x2){p1[r], p1[r + 1]};
                }
                lsum += sacc2[0] + sacc2[1];
            }
            u32x4 pw0, pw1, pw2, pw3;
            pw0.x = pk2(p0[0], p0[1]); pw0.y = pk2(p0[2], p0[3]); pw0.z = pk2(p0[4], p0[5]); pw0.w = pk2(p0[6], p0[7]);
            pw1.x = pk2(p0[8], p0[9]); pw1.y = pk2(p0[10], p0[11]); pw1.z = pk2(p0[12], p0[13]); pw1.w = pk2(p0[14], p0[15]);
            pw2.x = pk2(p1[0], p1[1]); pw2.y = pk2(p1[2], p1[3]); pw2.z = pk2(p1[4], p1[5]); pw2.w = pk2(p1[6], p1[7]);
            pw3.x = pk2(p1[8], p1[9]); pw3.y = pk2(p1[10], p1[11]); pw3.z = pk2(p1[12], p1[13]); pw3.w = pk2(p1[14], p1[15]);
            const LAS unsigned char* vb = lds + slot * AT_SLOT + 8192 + ((lane >> 4) & 1) * 32 + (lane & 3) * 8 + (4 * hi + ((lane & 15) >> 2)) * 64;
            s16x4 vlo[8], vhi[8];
#pragma unroll
            for (int i = 0; i < 8; ++i) { vlo[i] = vtr(vb + (i >> 2) * 4096 + (i & 3) * 1024); vhi[i] = vtr(vb + (i >> 2) * 4096 + (i & 3) * 1024 + 512); }
#define VFR(i) (bf16x8){vlo[i][0], vlo[i][1], vlo[i][2], vlo[i][3], vhi[i][0], vhi[i][1], vhi[i][2], vhi[i][3]}
#define PAF(x) __builtin_bit_cast(bf16x8, x)
            o0 = __builtin_amdgcn_mfma_f32_32x32x16_bf16(PAF(pw0), VFR(0), o0, 0, 0, 0); o1 = __builtin_amdgcn_mfma_f32_32x32x16_bf16(PAF(pw0), VFR(4), o1, 0, 0, 0);
            o0 = __builtin_amdgcn_mfma_f32_32x32x16_bf16(PAF(pw1), VFR(1), o0, 0, 0, 0); o1 = __builtin_amdgcn_mfma_f32_32x32x16_bf16(PAF(pw1), VFR(5), o1, 0, 0, 0);
            o0 = __builtin_amdgcn_mfma_f32_32x32x16_bf16(PAF(pw2), VFR(2), o0, 0, 0, 0); o1 = __builtin_amdgcn_mfma_f32_32x32x16_bf16(PAF(pw2), VFR(6), o1, 0, 0, 0);
            o0 = __builtin_amdgcn_mfma_f32_32x32x16_bf16(PAF(pw3), VFR(3), o0, 0, 0, 0); o1 = __builtin_amdgcn_mfma_f32_32x32x16_bf16(PAF(pw3), VFR(7), o1, 0, 0, 0);
#undef VFR
#undef PAF
        }
        if (KIND == 0) { if (active) wdone = __all(carry < -150.0f); if (lane == 0) votes[(it & 1) * 8 + wid] = wdone ? 1u : 0u; }
        if (it + 1 < NT) AT_STORE(slot ^ 1);
        LBAR();
    }
    if (KIND == 1) { lsum += __shfl_xor(lsum, 32); CFENCE(); if (hi == 0) wsf[r32] = lsum; CFENCE(); asm volatile("s_waitcnt lgkmcnt(0)" ::: "memory"); }
    bf16_t* Yw = YU + (rowbase + q0 + wid * 32) * 512 + KIND * 256 + h * 64 + r32;
#pragma unroll
    for (int r = 0; r < 16; ++r) {
        const int orow = crow(r, hi); float sc = 1.0f;
        if (KIND == 1) sc = __builtin_amdgcn_rcpf(wsf[orow]);
        Yw[(size_t)orow * 512] = (bf16_t)f2bf(o0[r] * sc); Yw[(size_t)orow * 512 + 32] = (bf16_t)f2bf(o1[r] * sc);
    }
    LBAR();
#undef AT_LOAD
#undef AT_STORE
}

#define DEFPTRS \
    const __attribute__((address_space(4))) Args* ka_ = (const __attribute__((address_space(4))) Args*)__builtin_amdgcn_kernarg_segment_ptr(); \
    asm volatile("" : "+s"(ka_)); \
    int tid_o_ = threadIdx.x; asm volatile("" : "+v"(tid_o_)); const int tid = tid_o_, lane = tid & 63; (void)lane; \
    unsigned char* ws = ka_->ws; \
    const float* x_in = ka_->in[0]; const float* c_in = ka_->in[1]; const float* w_ada = ka_->in[2]; const float* b_ada = ka_->in[3]; const float* g_norm = ka_->in[4]; \
    const float* w_up = ka_->in[5]; const float* w_dn = ka_->in[6]; const float* w_in = ka_->in[7]; const float* b_fg = ka_->in[8]; const float* conv_w = ka_->in[9]; \
    const float* conv_b = ka_->in[10]; const float* w_rg = ka_->in[11]; const float* b_rg = ka_->in[12]; const float* w_ig = ka_->in[13]; const float* b_ig = ka_->in[14]; \
    const float* lam = ka_->in[15]; const float* g_qk = ka_->in[16]; const float* g_mix = ka_->in[17]; const float* w_out = ka_->in[18]; \
    float* xout = ka_->out; \
    float* MOD = (float*)(ws + WS_MOD); float* GMOD = (float*)(ws + WS_GMOD); float* GATE = (float*)(ws + WS_GATE); float* SBV = (float*)(ws + WS_SB); \
    float* ROWSS = (float*)(ws + WS_ROWSS); float* KS = (float*)(ws + WS_KS); float* F2 = (float*)(ws + WS_F2); float* FG = (float*)(ws + WS_FG); \
    float* ASEG = (float*)(ws + WS_ASEG); float* BSEG = (float*)(ws + WS_BSEG); \
    bf16_t* WUP = (bf16_t*)(ws + WS_WUP); bf16_t* WDN = (bf16_t*)(ws + WS_WDN); bf16_t* WIN = (bf16_t*)(ws + WS_WIN); bf16_t* WOUT = (bf16_t*)(ws + WS_WOUT); \
    bf16_t* XN = (bf16_t*)(ws + WS_XN); bf16_t* HB = (bf16_t*)(ws + WS_H); bf16_t* PROJ = (bf16_t*)(ws + WS_PROJ); bf16_t* YU = (bf16_t*)(ws + WS_YU); \
    float* HLOC = (float*)(ws + WS_HLOC); bf16_t* PCUM = (bf16_t*)(ws + WS_PCUM); bf16_t* YN = (bf16_t*)(ws + WS_YN);
#define XB_TMO      128
#define XB_XCNT(j)  (256  + 64 * (j))
#define XB_XSUB(j)  (1280 + 64 * (j))
#define XB_XGEN(j)  (2304 + 64 * (j))
#define XB_TOP      3328
#define XB_TOPGEN   3392
#define XCD_BAR_WORDS 3456
#define XB_SPIN_CAP (1u << 18)

__device__ __forceinline__ unsigned xb_ld(unsigned* p)              { return __hip_atomic_load(p, __ATOMIC_RELAXED, __HIP_MEMORY_SCOPE_AGENT); }
__device__ __forceinline__ unsigned xb_add(unsigned* p, unsigned v) { return __hip_atomic_fetch_add(p, v, __ATOMIC_RELAXED, __HIP_MEMORY_SCOPE_AGENT); }
__device__ __forceinline__ unsigned xb_xcc_id() { return (unsigned)__builtin_amdgcn_s_getreg((3 << 11) | 20) & 0xFu; }
#define XB_SPIN(cond, bar) do { unsigned _sp = 0; while (cond) { __builtin_amdgcn_s_sleep(1); \
    if ((++_sp & 255u) == 0u) { if (xb_ld(&(bar)[XB_TMO])) break; if (_sp > XB_SPIN_CAP) { atomicAdd(&(bar)[XB_TMO], 1u); break; } } } } while (0)

struct XcdBarrier {
    unsigned* bar; unsigned x;
    volatile LAS unsigned* st;
};

__device__ __forceinline__ XcdBarrier xcd_barrier_post(unsigned* bar, volatile LAS unsigned* st) {
    XcdBarrier b; b.bar = bar; b.x = xb_xcc_id(); b.st = st;
    if (threadIdx.x == 0) (void)xb_add(&bar[XB_XCNT(b.x)], 1u);
    return b;
}
__device__ __forceinline__ void xcd_barrier_complete(unsigned* bar, unsigned x, unsigned& nloc, unsigned& nx) {
    const unsigned G = gridDim.x * gridDim.y * gridDim.z;
    unsigned sum, cnt, mine, sp = 0u;
    for (;;) {
        sum = 0u; cnt = 0u; mine = 0u;
#pragma unroll
        for (unsigned j = 0; j < 16; ++j) { const unsigned c = xb_ld(&bar[XB_XCNT(j)]); sum += c; cnt += (c > 0u) ? 1u : 0u; mine = (j == x) ? c : mine; }
        if (sum == G) break;
        __builtin_amdgcn_s_sleep(1);
        if ((++sp & 255u) == 0u) { if (xb_ld(&bar[XB_TMO])) break; if (sp > XB_SPIN_CAP) { atomicAdd(&bar[XB_TMO], 1u); break; } }
    }
    nloc = mine > 0u ? mine : 1u; nx = cnt > 0u ? cnt : 1u;
}

__device__ __forceinline__ void xcd_barrier(const XcdBarrier& b) {
    asm volatile("s_waitcnt vmcnt(0)" ::: "memory");
    __syncthreads();
    if (threadIdx.x == 0) {
        unsigned* bar = b.bar;
        __builtin_amdgcn_s_waitcnt(0);
        unsigned nloc = b.st[0], nx = b.st[1];
        if (nloc == 0u) { xcd_barrier_complete(bar, b.x, nloc, nx); b.st[0] = nloc; b.st[1] = nx; }
        const unsigned old = xb_add(&bar[XB_XSUB(b.x)], 1u);
        const unsigned gen = old / nloc;
        if (old + 1u == (gen + 1u) * nloc) {
            __builtin_amdgcn_fence(__ATOMIC_RELEASE, "agent");
            asm volatile("s_waitcnt vmcnt(0)" ::: "memory");
            const unsigned og = xb_add(&bar[XB_TOP], 1u);
            const unsigned tg = og / nx;
            if (og + 1u == (tg + 1u) * nx) xb_add(&bar[XB_TOPGEN], 1u);
            else XB_SPIN(xb_ld(&bar[XB_TOPGEN]) == tg, bar);
            __builtin_amdgcn_fence(__ATOMIC_ACQUIRE, "agent");
            xb_add(&bar[XB_XGEN(b.x)], 1u);
            asm volatile("s_waitcnt vmcnt(0)" ::: "memory");
        } else {
            XB_SPIN(xb_ld(&bar[XB_XGEN(b.x)]) == gen, bar);
            __builtin_amdgcn_fence(__ATOMIC_ACQUIRE, "agent");
            asm volatile("s_waitcnt vmcnt(0)" ::: "memory");
        }
    }
    __syncthreads();
}

__global__ void __launch_bounds__(512) mk_fwd(Args args) {
    extern __shared__ __attribute__((aligned(16))) unsigned char lds_raw[];
    LAS unsigned char* lds = (LAS unsigned char*)lds_raw;
    cg::grid_group grid = cg::this_grid();
    const int wave = __builtin_amdgcn_readfirstlane(threadIdx.x >> 6);
    const int G = gridDim.x; const int bx = blockIdx.x;
    const int vcu = (G % 8 == 0) ? (bx % 8) * (G / 8) + bx / 8 : bx;
    const int gw = vcu * 8 + wave, NGW = G * 8;
    const int lo = args.ph_lo, hi_ph = args.ph_hi;
    volatile LAS unsigned* MISC = (volatile LAS unsigned*)(lds + 131072 + 320);
    if (threadIdx.x < 16) MISC[threadIdx.x] = 0u;
    __syncthreads();
    XcdBarrier xbar = xcd_barrier_post((unsigned*)args.ws, MISC + 8);
    int ph = 0;
#define PH_ON (ph >= lo && ph < hi_ph)
#ifdef REP_SYNC
#define SYNC_EXTRA grid.sync(); asm volatile("" ::: "memory");
#else
#define SYNC_EXTRA
#endif
#define PH_NEXT do { ++ph; if (ph > lo && ph < hi_ph) { asm volatile("s_waitcnt vmcnt(0) lgkmcnt(0)" ::: "memory"); if (ph == 1) grid.sync(); else xcd_barrier(xbar); asm volatile("" ::: "memory"); SYNC_EXTRA } } while (0)

#ifdef REP_PRO
    int rp_ = 0; pro_again:
#endif
    if (PH_ON) { DEFPTRS
        for (int i = bx * 512 + tid; i < 5 * MTOK; i += G * 512) ROWSS[MTOK + i] = 0.f;
        LAS float* cact = (LAS float*)lds;
        LAS float* red = (LAS float*)(lds + 65536);
        for (int i = tid; i < 16 * 1024; i += 512) { const int b = i >> 10, k = i & 1023; const float v = c_in[i]; cact[k * 16 + b] = v * sigmoidf_(v); }
        __syncthreads();
        for (int task = bx; task < 288; task += G) {
            const int l = task / 144, n0 = (task % 144) * 64;
            float acc[16];
#pragma unroll
            for (int b = 0; b < 16; ++b) acc[b] = 0.f;
            const float* wp = w_ada + (size_t)l * 1024 * 9216 + n0 + lane;
#pragma unroll 1
            for (int k0 = wave * 128; k0 < wave * 128 + 128; k0 += 16) {
                float wv[16];
#pragma unroll
                for (int j = 0; j < 16; ++j) wv[j] = wp[(size_t)(k0 + j) * 9216];
                CFENCE();
#pragma unroll
                for (int j = 0; j < 16; ++j) { const int k = k0 + j; const float w = wv[j];
                    const f32x4 c0 = *(const LAS f32x4*)(cact + k * 16), c1 = *(const LAS f32x4*)(cact + k * 16 + 4), c2 = *(const LAS f32x4*)(cact + k * 16 + 8), c3 = *(const LAS f32x4*)(cact + k * 16 + 12);
#pragma unroll
                    for (int i = 0; i < 4; ++i) { acc[i] += c0[i] * w; acc[4 + i] += c1[i] * w; acc[8 + i] += c2[i] * w; acc[12 + i] += c3[i] * w; }
                    if ((j & 3) == 3) CFENCE(); }
            }
#pragma unroll
            for (int b = 0; b < 16; ++b) red[(wave * 16 + b) * 64 + lane] = acc[b];
            __syncthreads();
            for (int o = tid; o < 1024; o += 512) { const int b = o >> 6, ln = o & 63; float s = 0.f;
#pragma unroll
                for (int w = 0; w < 8; ++w) s += red[(w * 16 + b) * 64 + ln];
                MOD[((size_t)l * 16 + b) * 9216 + n0 + ln] = s + b_ada[l * 9216 + n0 + ln]; }
            __syncthreads();
        }
    }
    PH_NEXT;
    if (PH_ON) { DEFPTRS
        for (int i = bx * 512 + tid; i < 2 * 3 * 16 * 1024; i += G * 512) {
            const int k = i & 1023, b = (i >> 10) & 15, lj = i >> 14, l = lj / 3, j = lj % 3;
            const float* mp = MOD + ((size_t)l * 16 + b) * 9216 + j * 3072;
            GMOD[i] = g_norm[(l * 3 + j) * 1024 + k] * (1.0f + mp[1024 + k]);
            GATE[i] = (j == 1 ? 1.0f : 0.5f) * (1.0f + mp[2048 + k]);
        }
        LAS float* scr = (LAS float*)(lds + wave * 8448);
        constexpr int I_UP = 16 * 176, I_DN = 44 * 32, I_IN = 16 * 88, I_OUT = 16 * 32;
        constexpr int NIT = 4 * I_UP + 4 * I_DN + 2 * I_IN + 2 * I_OUT;
        for (int it = gw; it < NIT; it += NGW) {
            int r = it;
            if (r < 4 * I_UP) { const int mat = r / I_UP; r -= mat * I_UP; const int kb = r / 176, nb = r % 176, n0 = nb * 32;
                const int c0 = ((n0 >> 7) & 1) * DFF + (n0 >> 8) * 128 + (n0 & 127);
                transpose_item(w_up + (size_t)mat * DM * NUP, NUP, NUP, DM, WUP + (size_t)mat * NUP * DM, n0, c0, kb * 64, scr, lane); continue; }
            r -= 4 * I_UP;
            if (r < 4 * I_DN) { const int mat = r / I_DN; r -= mat * I_DN; const int kb = r / 32, nb = r % 32;
                transpose_item(w_dn + (size_t)mat * DFF * DM, DM, DM, DFF, WDN + (size_t)mat * DM * DFF, nb * 32, nb * 32, kb * 64, scr, lane); continue; }
            r -= 4 * I_DN;
            if (r < 2 * I_IN) { const int mat = r / I_IN; r -= mat * I_IN; const int kb = r / 88, nb = r % 88;
                transpose_item(w_in + (size_t)mat * DM * 2564, 2564, 2564, DM, WIN + (size_t)mat * NINP * DM, nb * 32, nb * 32, kb * 64, scr, lane); continue; }
            r -= 2 * I_IN;
            { const int mat = r / I_OUT; r -= mat * I_OUT; const int kb = r / 32, nb = r % 32;
                transpose_item(w_out + (size_t)mat * DM * DM, DM, DM, DM, WOUT + (size_t)mat * DM * DM, nb * 32, nb * 32, kb * 64, scr, lane); }
        }
        for (int m0 = gw; m0 < MTOK; m0 += 2 * NGW) {
            const int m1 = m0 + NGW;
            const f32x4* gp = (const f32x4*)(g_norm) + lane;
            const f32x4* xr0 = (const f32x4*)(x_in + (size_t)m0 * DM) + lane; const f32x4* xr1 = (const f32x4*)(x_in + (size_t)m1 * DM) + lane;
            f32x4 v0[4], v1[4];
#pragma unroll
            for (int j = 0; j < 4; ++j) { v0[j] = xr0[64 * j]; v1[j] = xr1[64 * j]; }
            const f32x4* sp0 = (const f32x4*)(MOD + (size_t)(m0 >> 12) * 9216 + 1024) + lane; const f32x4* sp1 = (const f32x4*)(MOD + (size_t)(m1 >> 12) * 9216 + 1024) + lane;
            float s0 = 0.f, s1 = 0.f; u32x2* o0 = (u32x2*)(XN + (size_t)m0 * DM) + lane; u32x2* o1 = (u32x2*)(XN + (size_t)m1 * DM) + lane;
#pragma unroll
            for (int j = 0; j < 4; ++j) { const f32x4 g = gp[64 * j];
                { const f32x4 v = v0[j]; s0 += (v[0] * v[0] + v[1] * v[1]) + (v[2] * v[2] + v[3] * v[3]); const f32x4 a = v * g * (sp0[64 * j] + 1.0f); u32x2 w; w.x = pk2(a[0], a[1]); w.y = pk2(a[2], a[3]); o0[64 * j] = w; }
                { const f32x4 v = v1[j]; s1 += (v[0] * v[0] + v[1] * v[1]) + (v[2] * v[2] + v[3] * v[3]); const f32x4 a = v * g * (sp1[64 * j] + 1.0f); u32x2 w; w.x = pk2(a[0], a[1]); w.y = pk2(a[2], a[3]); o1[64 * j] = w; } }
            s0 = wave_sum(s0); s1 = wave_sum(s1);
            if (lane == 0) { ROWSS[m0] = s0; ROWSS[m1] = s1; }
        }
    }
    PH_NEXT;
    if (PH_ON) { DEFPTRS
        LAS float* sh = (LAS float*)lds;
        for (int combo = 0; combo < 6; ++combo) {
            const int l = combo / 3, j = combo % 3;
            __syncthreads();
            for (int i = tid; i < 16 * 1024; i += 512) { const int b = i >> 10, k = i & 1023; sh[i] = MOD[((size_t)l * 16 + b) * 9216 + j * 3072 + k]; }
            __syncthreads();
            const bf16_t* Wt = (j == 1) ? WIN + (size_t)l * NINP * DM : WUP + (size_t)(l * 2 + (j == 2 ? 1 : 0)) * NUP * DM;
            const int N = (j == 1) ? NINP : NUP;
            float* dst = SBV + (size_t)combo * 16 * 5632;
            for (int n = gw; n < N; n += NGW) {
                float w[16];
#pragma unroll
                for (int c = 0; c < 4; ++c) { const u32x2 q = *(const u32x2*)(Wt + (size_t)n * DM + c * 256 + lane * 4);
                    w[4 * c] = __uint_as_float(q.x << 16); w[4 * c + 1] = __uint_as_float(q.x & 0xffff0000u); w[4 * c + 2] = __uint_as_float(q.y << 16); w[4 * c + 3] = __uint_as_float(q.y & 0xffff0000u); }
                float sv[16];
#pragma unroll
                for (int b = 0; b < 16; ++b) { float s = 0.f;
#pragma unroll
                    for (int c = 0; c < 4; ++c) { const f32x4 v = *(const LAS f32x4*)(sh + b * 1024 + c * 256 + lane * 4); s += (w[4 * c] * v[0] + w[4 * c + 1] * v[1]) + (w[4 * c + 2] * v[2] + w[4 * c + 3] * v[3]); }
                    sv[b] = s; if ((b & 3) == 3) CFENCE(); }
                float t8[8], t4[4], t2[2];
#pragma unroll
                for (int i = 0; i < 8; ++i) { const float snd = (lane & 32) ? sv[i] : sv[i + 8], kp = (lane & 32) ? sv[i + 8] : sv[i]; t8[i] = kp + __shfl_xor(snd, 32); }
#pragma unroll
                for (int i = 0; i < 4; ++i) { const float snd = (lane & 16) ? t8[i] : t8[i + 4], kp = (lane & 16) ? t8[i + 4] : t8[i]; t4[i] = kp + __shfl_xor(snd, 16); }
#pragma unroll
                for (int i = 0; i < 2; ++i) { const float snd = (lane & 8) ? t4[i] : t4[i + 2], kp = (lane & 8) ? t4[i + 2] : t4[i]; t2[i] = kp + __shfl_xor(snd, 8); }
                float t1; { const float snd = (lane & 4) ? t2[0] : t2[1], kp = (lane & 4) ? t2[1] : t2[0]; t1 = kp + __shfl_xor(snd, 4); }
                t1 += __shfl_xor(t1, 2); t1 += __shfl_xor(t1, 1);
                const int bsel = ((lane >> 5) & 1) * 8 + ((lane >> 4) & 1) * 4 + ((lane >> 3) & 1) * 2 + ((lane >> 2) & 1);
                if ((lane & 3) == 0) dst[(size_t)bsel * 5632 + n] = t1;
            }
        }
        __syncthreads();
    }
    PH_NEXT;

#ifdef REP_PRO
    if (rp_ == 0) { rp_ = 1; ph = 0; goto pro_again; }
#endif
#pragma unroll 1
    for (int f = 0; f < 4; ++f) {
        const int l = f >> 1, s = f & 1;
        if (s == 1) {
            if (PH_ON) { DEFPTRS
                pg8::Gemm g{XN, WIN + (size_t)l * NINP * DM, MTOK, NINP, DM}; pg8::StaticOrder S; S.init(MTOK, NINP, G, bx);
                pg8::EpiIn E{PROJ, FG, ROWSS + (size_t)(l * 3 + 1) * MTOK, SBV + (size_t)(l * 3 + 1) * 16 * 5632};
#ifndef NO_G_IN
                for (int rep_ = 0; rep_ < REP_IN; ++rep_) {
                pg8::gemm_phase<pg8::EpiIn, pg8::StaticOrder, true, true>(lds, g, S, E); }
#endif
            }
            PH_NEXT;
            if (PH_ON) { DEFPTRS
#ifndef NO_PREP
                {
                    const int blk = vcu & 7, n = lane & 31, hi = lane >> 5;
                    LAS unsigned char* wfl = lds;
                    LAS float* xs = (LAS float*)(lds + 16384 + wave * 13568);
                    LAS unsigned char* ub = lds + 16384 + wave * 13568 + 8960;
#pragma unroll
                    for (int q = 0; q < 2; ++q) { const int f = wave * 2 + q, gt = f >> 3, nb = (f >> 2) & 1, d0 = f & 3;
                        const float* wsrc = (gt ? w_ig : w_rg) + ((size_t)(l * 8 + blk) * 64 + 16 * d0 + 8 * hi) * 64 + nb * 32 + n;
                        u32x4 w; w.x = pk2(wsrc[0], wsrc[64]); w.y = pk2(wsrc[128], wsrc[192]); w.z = pk2(wsrc[256], wsrc[320]); w.w = pk2(wsrc[384], wsrc[448]);
                        *(LAS u32x4*)(wfl + f * 1024 + lane * 16) = w; }
                    __syncthreads();
                    float br[2], bi[2], cb[2], cw[2][4], c8[2];
#pragma unroll
                    for (int nb = 0; nb < 2; ++nb) { const int ch = blk * 64 + nb * 32 + n;
                        br[nb] = b_rg[l * 512 + ch]; bi[nb] = b_ig[l * 512 + ch]; cb[nb] = conv_b[l * 512 + ch];
#pragma unroll
                        for (int k = 0; k < 4; ++k) cw[nb][k] = conv_w[(l * 4 + k) * 512 + ch];
                        const float lmv = lam[l * 512 + ch];
                        c8[nb] = -8.0f * LOG2E * (__builtin_fmaxf(-lmv, 0.f) + log1pf(expf(-fabsf(lmv)))); }
                    for (int segi = (vcu >> 3) * 8 + wave; segi < REP_PREP * (MTOK / 32); segi += (G >> 3) * 8) { const int seg = segi & (MTOK / 32 - 1);
                        const int row0 = seg * 32; const bool first = (row0 & (SEQL - 1)) == 0;
                        const bf16_t* xp = PROJ + (size_t)row0 * PPITCH + blk * 64;
                        CFENCE();
#pragma unroll
                        for (int t = 0; t < 35; ++t) { float v = 0.f; if (t >= 3 || !first) v = bf2f((xp + ((long)t - 3) * PPITCH)[lane]); xs[t * 64 + lane] = v; }
                        CFENCE();
#pragma unroll
                        for (int nb = 0; nb < 2; ++nb)
#pragma unroll
                            for (int g = 0; g < 4; ++g) { const LAS float* xb = xs + (8 * g + 4 * hi) * 64 + nb * 32 + n; float xv[7];
#pragma unroll
                                for (int j = 0; j < 7; ++j) xv[j] = xb[j * 64];
#pragma unroll
                                for (int i = 0; i < 4; ++i) { const float uu = cb[nb] + cw[nb][0] * xv[i] + cw[nb][1] * xv[i + 1] + cw[nb][2] * xv[i + 2] + cw[nb][3] * xv[i + 3];
                                    *(LAS unsigned short*)(ub + (8 * g + 4 * hi + i) * 144 + (nb * 32 + n) * 2) = (unsigned short)f2bf(uu); }
                                __builtin_amdgcn_sched_barrier(0); }
                        CFENCE();
                        bf16x8 af[4];
#pragma unroll
                        for (int d0 = 0; d0 < 4; ++d0) af[d0] = *(const LAS bf16x8*)(ub + n * 144 + (16 * d0 + 8 * hi) * 2);
#pragma unroll
                        for (int nb = 0; nb < 2; ++nb) {
                            f32x16 arx, aix;
#pragma unroll
                            for (int r = 0; r < 16; ++r) { arx[r] = br[nb]; aix[r] = bi[nb]; }
#pragma unroll
                            for (int d0 = 0; d0 < 4; ++d0) { const bf16x8 w0 = *(const LAS bf16x8*)(wfl + ((0 * 2 + nb) * 4 + d0) * 1024 + lane * 16), w1 = *(const LAS bf16x8*)(wfl + ((1 * 2 + nb) * 4 + d0) * 1024 + lane * 16);
                                                             arx = __builtin_amdgcn_mfma_f32_32x32x16_bf16(af[d0], w0, arx, 0, 0, 0);
                                                             aix = __builtin_amdgcn_mfma_f32_32x32x16_bf16(af[d0], w1, aix, 0, 0, 0); }
                            CFENCE(); __builtin_amdgcn_sched_barrier(0);
#pragma unroll
                            for (int r = 0; r < 16; ++r) {
                                float uu; { const LAS float* xb = xs + (8 * (r >> 2) + 4 * hi + (r & 3)) * 64 + nb * 32 + n;
                                    uu = cb[nb] + cw[nb][0] * xb[0] + cw[nb][1] * xb[64] + cw[nb][2] * xb[128] + cw[nb][3] * xb[192]; }
                                const float rg = sigmoidf_(arx[r]), ig = sigmoidf_(aix[r]);
                                const float la2 = c8[nb] * rg, a = __builtin_amdgcn_exp2f(la2);
                                const float xx = 2.0f * 0.6931471805599453f * la2;
                                const float om = (xx > -0.25f) ? -xx * (1.0f + xx * 0.5f * (1.0f + xx * (1.0f / 3.0f) * (1.0f + xx * 0.25f * (1.0f + xx * 0.2f)))) : 1.0f - a * a;
                                arx[r] = a; aix[r] = __builtin_sqrtf(om) * ig * uu;
                            }
                            float H = 0.f, P = 1.f;
                            const int ch = blk * 64 + nb * 32 + n;
                            float* hl = HLOC + (size_t)(row0 + 4 * hi) * 512 + ch; bf16_t* pc = PCUM + (size_t)(row0 + 4 * hi) * 512 + ch;
#pragma unroll
                            for (int g = 0; g < 4; ++g) {
                                const float a0 = arx[4 * g], a1 = arx[4 * g + 1], a2 = arx[4 * g + 2], a3 = arx[4 * g + 3];
                                const float b0 = aix[4 * g], b1 = aix[4 * g + 1], b2 = aix[4 * g + 2], b3 = aix[4 * g + 3];
                                const float Ao = (a0 * a1) * (a2 * a3), Bo = ((b0 * a1 + b1) * a2 + b2) * a3 + b3;
                                const float Ap = __shfl_xor(Ao, 32), Bp = __shfl_xor(Bo, 32);
                                const float A1 = hi ? Ap : Ao, B1 = hi ? Bp : Bo, A2 = hi ? Ao : Ap, B2 = hi ? Bo : Bp;
                                const float Hm = A1 * H + B1, Pm = A1 * P;
                                float h = hi ? Hm : H, p = hi ? Pm : P;
                                H = A2 * Hm + B2; P = A2 * Pm;
                                float* hg = hl + (size_t)g * 8 * 512; bf16_t* pg = pc + (size_t)g * 8 * 512; asm volatile("" : "+v"(hg), "+v"(pg));
                                h = a0 * h + b0; p *= a0; hg[0 * 512] = h; pg[0 * 512] = (bf16_t)f2bf(p);
                                h = a1 * h + b1; p *= a1; hg[1 * 512] = h; pg[1 * 512] = (bf16_t)f2bf(p);
                                h = a2 * h + b2; p *= a2; hg[2 * 512] = h; pg[2 * 512] = (bf16_t)f2bf(p);
                                h = a3 * h + b3; p *= a3; hg[3 * 512] = h; pg[3 * 512] = (bf16_t)f2bf(p);
                            }
                            if (hi == 0) { ASEG[(size_t)seg * 512 + ch] = P; BSEG[(size_t)seg * 512 + ch] = H; }
                            CFENCE(); __builtin_amdgcn_sched_barrier(0);
                        }
                    }
                }
                for (int row = gw; row < MTOK; row += NGW) {
                    const u32x2 q = *(const u32x2*)(PROJ + (size_t)row * PPITCH + 2048 + lane * 4);
                    const float a0 = __uint_as_float(q.x << 16), a1 = __uint_as_float(q.x & 0xffff0000u), a2 = __uint_as_float(q.y << 16), a3 = __uint_as_float(q.y & 0xffff0000u);
                    float ss = (a0 * a0 + a1 * a1) + (a2 * a2 + a3 * a3);
                    ss += __shfl_xor(ss, 1); ss += __shfl_xor(ss, 2); ss += __shfl_xor(ss, 4); ss += __shfl_xor(ss, 8);
                    if ((lane & 15) == 0) KS[(size_t)((row >> 12) * 4 + (lane >> 4)) * SEQL + (row & (SEQL - 1))] = __builtin_amdgcn_rsqf(ss * (1.0f / 64.0f) + EPSF);
                }
                if (wave == 0) for (int chn = vcu; chn < 64; chn += G) {
                    const int b = chn >> 2, h = chn & 3; const float bf = b_fg[l * 4 + h];
                    const float* fp = FG + ((size_t)b * SEQL + lane * 64) * 4 + h;
                    float tot = 0.f;
#pragma unroll 8
                    for (int i = 0; i < 64; ++i) { const float v = fp[i * 4] + bf; tot += __builtin_fminf(v, 0.f) - log1pf(expf(-fabsf(v))); }
                    float inc = tot;
#pragma unroll
                    for (int o = 1; o < 64; o <<= 1) { const float t_ = __shfl_up(inc, o); if (lane >= o) inc += t_; }
                    float run = inc - tot;
                    float* op = F2 + (size_t)chn * SEQL + lane * 64;
#pragma unroll 8
                    for (int i = 0; i < 64; ++i) { const float v = fp[i * 4] + bf; run += __builtin_fminf(v, 0.f) - log1pf(expf(-fabsf(v))); op[i] = -run * LOG2E; }
                }
#endif
                __syncthreads();
            }
            PH_NEXT;
            if (PH_ON) { DEFPTRS
#ifndef NO_ATTN
                for (int rep_ = 0; rep_ < REP_ATTN; ++rep_)
                for (int vw = vcu; vw < 256; vw += G) {
                    const int bh = vw >> 2, s4 = vw & 3, b = bh >> 2, h = bh & 3;
#pragma unroll 1
                    for (int i = 0; i < 4; ++i) { const int qb = (i == 0) ? s4 : (i == 1) ? 7 - s4 : (i == 2) ? 8 + s4 : 15 - s4;
#ifndef NO_FOX
                        attn_unit<1>(lds, PROJ, YU, KS, F2, g_qk + l * 128, b, h, qb);
#endif
 }
#pragma unroll 1
                    for (int i = 0; i < 4; ++i) { const int qb = (i == 0) ? s4 : (i == 1) ? 7 - s4 : (i == 2) ? 8 + s4 : 15 - s4;
#ifndef NO_SB
                        attn_unit<0>(lds, PROJ, YU, KS, F2, g_qk + l * 128, b, h, qb);
#endif
 }
                }
#endif
            }
            PH_NEXT;
            if (PH_ON) { DEFPTRS
                LAS float* hin = (LAS float*)lds;
                const f32x4 gm0 = *(const f32x4*)(g_mix + l * 1024 + lane * 8), gm1 = *(const f32x4*)(g_mix + l * 1024 + lane * 8 + 4);
                const f32x4 gx0 = *(const f32x4*)(g_mix + l * 1024 + 512 + lane * 8), gx1 = *(const f32x4*)(g_mix + l * 1024 + 512 + lane * 8 + 4);
                for (int tti = vcu; tti < REP_FIN * 256; tti += G) { const int tt = tti & 255;
                    __syncthreads();
                    { const int ch = tid, seg0 = (tt >> 4) * 128, nb = (tt & 15) * 8; float Hc = 0.f;
#pragma unroll 8
                      for (int sg = 0; sg < nb; ++sg) Hc = ASEG[(size_t)(seg0 + sg) * 512 + ch] * Hc + BSEG[(size_t)(seg0 + sg) * 512 + ch];
#pragma unroll
                      for (int s8 = 0; s8 < 8; ++s8) { hin[s8 * 512 + ch] = Hc; Hc = ASEG[(size_t)(seg0 + nb + s8) * 512 + ch] * Hc + BSEG[(size_t)(seg0 + nb + s8) * 512 + ch]; } }
                    __syncthreads();
                    const f32x4 hi0 = *(const LAS f32x4*)(hin + wave * 512 + lane * 8), hi1 = *(const LAS f32x4*)(hin + wave * 512 + lane * 8 + 4);
#pragma unroll 2
                    for (int t = 0; t < 32; ++t) {
                        const size_t row = (size_t)tt * 256 + wave * 32 + t;
                        const f32x4 h0 = *(const f32x4*)(HLOC + row * 512 + lane * 8), h1 = *(const f32x4*)(HLOC + row * 512 + lane * 8 + 4);
                        const u32x4 pq = *(const u32x4*)(PCUM + row * 512 + lane * 8);
                        const u32x4 gq = *(const u32x4*)(PROJ + row * PPITCH + 512 + lane * 8);
                        const u32x4 yq = *(const u32x4*)(YU + row * 512 + lane * 8);
                        float y[8], yu[8]; float ss = 0.f, s2 = 0.f;
#pragma unroll
                        for (int i = 0; i < 8; ++i) {
                            const unsigned pw = pq[i >> 1], gw_ = gq[i >> 1], yw = yq[i >> 1];
                            const float p = (i & 1) ? __uint_as_float(pw & 0xffff0000u) : __uint_as_float(pw << 16);
                            const float gg = (i & 1) ? __uint_as_float(gw_ & 0xffff0000u) : __uint_as_float(gw_ << 16);
                            yu[i] = (i & 1) ? __uint_as_float(yw & 0xffff0000u) : __uint_as_float(yw << 16);
                            const float hh = (i < 4 ? h0[i & 3] : h1[i & 3]) + p * (i < 4 ? hi0[i & 3] : hi1[i & 3]);
                            const float inner = 0.7978845608028654f * (gg + 0.044715f * gg * gg * gg);
                            const float ge = gg * __builtin_amdgcn_rcpf(1.0f + __builtin_amdgcn_exp2f(-2.0f * LOG2E * inner));
                            y[i] = hh * ge; ss += y[i] * y[i]; s2 += yu[i] * yu[i];
                        }
                        ss = wave_sum(ss);
                        s2 += __shfl_xor(s2, 1); s2 += __shfl_xor(s2, 2); s2 += __shfl_xor(s2, 4); s2 += __shfl_xor(s2, 8); s2 += __shfl_xor(s2, 16);
                        const float rl = __builtin_amdgcn_rsqf(ss * (1.0f / 512.0f) + EPSF), rx = __builtin_amdgcn_rsqf(s2 * (1.0f / 256.0f) + EPSF);
                        u32x4 o1, o2;
                        o1.x = pk2(y[0] * rl * gm0[0], y[1] * rl * gm0[1]); o1.y = pk2(y[2] * rl * gm0[2], y[3] * rl * gm0[3]);
                        o1.z = pk2(y[4] * rl * gm1[0], y[5] * rl * gm1[1]); o1.w = pk2(y[6] * rl * gm1[2], y[7] * rl * gm1[3]);
                        o2.x = pk2(yu[0] * rx * gx0[0], yu[1] * rx * gx0[1]); o2.y = pk2(yu[2] * rx * gx0[2], yu[3] * rx * gx0[3]);
                        o2.z = pk2(yu[4] * rx * gx1[0], yu[5] * rx * gx1[1]); o2.w = pk2(yu[6] * rx * gx1[2], yu[7] * rx * gx1[3]);
                        *(u32x4*)(YN + row * 1024 + lane * 8) = o1; *(u32x4*)(YN + row * 1024 + 512 + lane * 8) = o2;
                    }
                }
                __syncthreads();
            }
            PH_NEXT;
            if (PH_ON) { DEFPTRS
                pg8::Gemm g{YN, WOUT + (size_t)l * DM * DM, MTOK, DM, DM}; pg8::StaticOrder S; S.init(MTOK, DM, G, bx);
                pg8::EpiRes E{xout, xout, GATE + (size_t)(l * 3 + 1) * 16 * 1024, GMOD + (size_t)(l * 3 + 2) * 16 * 1024, XN, ROWSS + (size_t)(l * 3 + 2) * MTOK, 1};
#ifndef NO_G_OUT
#ifdef REP_OUT
                { E.xout = (float*)HB; E.has_next = 0; pg8::gemm_phase<pg8::EpiRes, pg8::StaticOrder, true, true>(lds, g, S, E); E.xout = xout; E.has_next = 1; }
#endif
                pg8::gemm_phase<pg8::EpiRes, pg8::StaticOrder, true, true>(lds, g, S, E);
#endif
            }
            PH_NEXT;
        }
        const int j = s ? 2 : 0;
        if (PH_ON) { DEFPTRS
            pg8::Gemm g{XN, WUP + (size_t)(l * 2 + s) * NUP * DM, MTOK, NUP, DM}; pg8::StaticOrder S; S.init(MTOK, NUP, G, bx);
            pg8::EpiUp E{HB, ROWSS + (size_t)(l * 3 + j) * MTOK, SBV + (size_t)(l * 3 + j) * 16 * 5632};
#ifndef NO_G_UP
            for (int rep_ = 0; rep_ < REP_UP; ++rep_) {
            pg8::gemm_phase<pg8::EpiUp, pg8::StaticOrder, true, true>(lds, g, S, E);
            }
#endif
        }
        PH_NEXT;
        if (PH_ON) { DEFPTRS
            const int nl = s ? l + 1 : l, nj = s ? 0 : 1; const int has_next = (nl < 2) ? 1 : 0; const int nidx = has_next ? nl * 3 + nj : 0;
            pg8::Gemm g{HB, WDN + (size_t)(l * 2 + s) * DM * DFF, MTOK, DM, DFF}; pg8::StaticOrder S; S.init(MTOK, DM, G, bx);
            pg8::EpiRes E{f == 0 ? x_in : xout, xout, GATE + (size_t)(l * 3 + j) * 16 * 1024, GMOD + (size_t)nidx * 16 * 1024, XN, ROWSS + (size_t)nidx * MTOK, has_next};
#ifndef NO_G_DN
#ifdef REP_DN
            for (int rep_ = 0; rep_ < 2; ++rep_) { E.xout = (rep_ == 0) ? HLOC : xout; E.has_next = (rep_ == 0) ? 0 : has_next;
            pg8::gemm_phase<pg8::EpiRes, pg8::StaticOrder, true, true>(lds, g, S, E); }
#else
            pg8::gemm_phase<pg8::EpiRes, pg8::StaticOrder, true, true>(lds, g, S, E);
#endif
#endif
        }
        PH_NEXT;
    }
#undef PH_ON
#undef PH_NEXT
}


#ifdef DBG_STOP
__global__ void dbg_dump(const unsigned char* ws, float* out, int mode) {
    const size_t n = (size_t)MTOK * DM; const size_t i0 = (size_t)blockIdx.x * blockDim.x + threadIdx.x, st = (size_t)gridDim.x * blockDim.x;
    const bf16_t* XN = (const bf16_t*)(ws + WS_XN); const bf16_t* HB = (const bf16_t*)(ws + WS_H); const bf16_t* PR = (const bf16_t*)(ws + WS_PROJ);
    const bf16_t* YU = (const bf16_t*)(ws + WS_YU); const float* HL = (const float*)(ws + WS_HLOC); const bf16_t* YN = (const bf16_t*)(ws + WS_YN); const bf16_t* PC = (const bf16_t*)(ws + WS_PCUM);
    for (size_t i = i0; i < n; i += st) {
        float v = 0.f;
        if (mode == 0) v = bf2f(XN[i]);
        else if (mode == 1) v = bf2f(HB[i]) + bf2f(HB[i + n]) + bf2f(HB[i + (size_t)117440512]);
        else if (mode == 2) v = bf2f(PR[i]) + bf2f(PR[i + n]) + bf2f(PR[i + (size_t)100663296]);
        else if (mode == 3) v = (i < n / 2) ? bf2f(YU[i]) : HL[i - n / 2];
        else if (mode == 4) v = bf2f(YN[i]);
        else if (mode == 6) v = (i < n / 2) ? bf2f(PC[i]) : ((const float*)(ws + WS_KS))[(i - n / 2) % (3 * 262144)];
        else if (mode == 7) v = HL[i % (n / 2)] + bf2f(PC[i % (n / 2)]) + ((const float*)(ws + WS_KS))[i % (3 * 262144)] + ((const float*)(ws + WS_ASEG))[i % (2 * 1048576)];
        if (mode == 3) { const bool nan_ = !(v == v), big = (v > 3e38f) || (v < -3e38f); float code = 0.f;
            if (i < n / 2) { const int col = (int)(i & 511); if (col < 256) code = nan_ ? 2000.f : (big ? 1000.f : 0.f); else code = (nan_ || big) ? 4000.f : 0.f; }
            else code = (nan_ || big) ? 8000.f : 0.f;
            v = code; }
        if (!(v == v)) v = 77777.f; if (v > 3e38f) v = 88888.f; if (v < -3e38f) v = 99999.f;
        if (mode != 5) out[i] = v;
    }
}
#endif
#ifndef MK_N_LAUNCHES
#define MK_N_LAUNCHES 1
#endif
constexpr int N_PHASES = 3 + 2 * 9;
extern "C" void kernel_launch(void* const* d_in, const int* in_sizes, int n_in, void* d_out, int out_size, void* d_ws, size_t ws_size, hipStream_t stream) {
    static int grid = 0;
    if (grid == 0) {
        if (n_in != 19 || out_size != MTOK * DM || ws_size < WS_END) { fprintf(stderr, "kernel_launch: unexpected shapes (n_in %d, out %d, ws %zu)\n", n_in, out_size, ws_size); grid = -1; return; }
        int dev = 0, cus = 0, per_cu = 0;
        hipGetDevice(&dev); hipDeviceGetAttribute(&cus, hipDeviceAttributeMultiprocessorCount, dev);
        if (hipFuncSetAttribute((const void*)mk_fwd, hipFuncAttributeMaxDynamicSharedMemorySize, LDS_BYTES) != hipSuccess) { fprintf(stderr, "kernel_launch: hipFuncSetAttribute failed\n"); grid = -1; return; }
        if (hipOccupancyMaxActiveBlocksPerMultiprocessor(&per_cu, (const void*)mk_fwd, 512, LDS_BYTES) != hipSuccess || per_cu < 1) { fprintf(stderr, "kernel_launch: occupancy query says %d\n", per_cu); per_cu = 1; }
        (void)hipGetLastError();
        grid = cus * 1;
    }
    if (grid < 0) return;
    if (hipMemsetAsync(d_ws, 0, 16384, stream) != hipSuccess) { fprintf(stderr, "kernel_launch: memset failed\n"); return; }
    Args a{};
    for (int i = 0; i < 19; ++i) a.in[i] = (const float*)d_in[i];
    a.out = (float*)d_out; a.ws = (unsigned char*)d_ws;
#if MK_N_LAUNCHES == 1
    a.ph_lo = 0; a.ph_hi = N_PHASES;
    void* kargs[] = {&a};
    hipError_t e = hipLaunchCooperativeKernel((const void*)mk_fwd, dim3(grid), dim3(512), kargs, LDS_BYTES, stream);
    if (e != hipSuccess) fprintf(stderr, "kernel_launch: cooperative launch failed: %s (grid %d)\n", hipGetErrorString(e), grid);
#else
#ifdef DBG_STOP
    for (int p = 0; p < DBG_STOP; ++p) { a.ph_lo = p; a.ph_hi = p + 1; hipLaunchKernelGGL(mk_fwd, dim3(grid), dim3(512), LDS_BYTES, stream, a); }
    hipLaunchKernelGGL(dbg_dump, dim3(2048), dim3(256), 0, stream, (const unsigned char*)d_ws, (float*)d_out, DBG_MODE);
#else
    for (int p = 0; p < N_PHASES; ++p) { a.ph_lo = p; a.ph_hi = p + 1; hipLaunchKernelGGL(mk_fwd, dim3(grid), dim3(512), LDS_BYTES, stream, a); }
#endif
#endif
}
```

```cpp
#include <hip/hip_runtime.h>
#include <hip/hip_cooperative_groups.h>
#include <cstdio>
#include <cstdint>
namespace cg = cooperative_groups;
namespace pg8 {
#define PG8_LAS __attribute__((address_space(3)))
typedef unsigned short bf16_t;
typedef short bf16x8 __attribute__((ext_vector_type(8)));
typedef float f32x4 __attribute__((ext_vector_type(4)));
typedef unsigned u32x4 __attribute__((ext_vector_type(4)));
constexpr int BM = 256, BK = 64, HALF = 128, HTB = HALF * BK * 2  , STAGE_BYTES = 8 * HTB, NXCD = 8, WGM = 8;

__host__ __device__ __forceinline__ int lds_byte(int r, int c) { const int st = (r >> 4) * 2 + (c >> 5), rr = r & 15, cc = c & 31, ob = rr * 64 + cc * 2; return st * 1024 + (ob ^ (((ob >> 9) & 1) << 5)); }
__host__ __device__ __forceinline__ void stage_rc(int b, int& R, int& C) { const int st = b / 1024, sb = b % 1024, swz = sb ^ (((sb >> 9) & 1) << 5); R = (st >> 1) * 16 + swz / 64; C = (st & 1) * 32 + (swz % 64) / 2; }
__host__ __device__ __forceinline__ int perm32(int rho) { const int n = rho >> 4, i = rho & 15; return 8 * (i >> 2) + 4 * n + (i & 3); }

struct Unit { int pm, pn; };
struct Gemm { const bf16_t* A; const bf16_t* Bt; int M, N, K; };

struct StaticOrder {
    int nM, nN, nwg, G, c;
    __host__ __device__ void init(int M, int N, int G_, int c_) { nM = M / BM; nN = N / BM; nwg = nM * nN; G = G_; c = c_; }
    __host__ __device__ bool next(int i, Unit& u) const {
        const long L = (long)i * G + c; if (L >= nwg) return false;
        int wgid = (int)L; { const int q = nwg / NXCD, r = nwg % NXCD, xcd = wgid % NXCD, off = wgid / NXCD; wgid = (xcd < r ? xcd * (q + 1) : r * (q + 1) + (xcd - r) * q) + off; }
        const int nig = WGM * nN, gid = wgid / nig, fm = gid * WGM, gsz = (nM - fm) < WGM ? (nM - fm) : WGM;
        u.pm = fm + ((wgid % nig) % gsz); u.pn = (wgid % nig) / gsz; return true;
    }
    __device__ __forceinline__ void a_ready(const Unit&) const {}
    __device__ __forceinline__ void done(const Unit&) const {}
};

typedef float f32x2c_t __attribute__((ext_vector_type(2))); typedef __bf16 bf16x2c_t __attribute__((ext_vector_type(2)));
__device__ __forceinline__ unsigned cvt_pk_bf16(float lo, float hi) { f32x2c_t v = {lo, hi}; bf16x2c_t b = __builtin_convertvector(v, bf16x2c_t); return __builtin_bit_cast(unsigned, b); }
typedef float f32x2 __attribute__((ext_vector_type(2)));
constexpr float RMS_EPS = 1e-6f;
struct EpiUp {
    static constexpr bool PERM = true, AFTER_DRAIN = false;
    bf16_t* H; const float* rowss; const float* sb;
    __device__ __forceinline__ void operator()(const f32x4 (&acc)[2][2][4][2], const Unit& u, int wr, int wc, int fr, int fq) const {
        const int row0 = u.pm * BM + wr * 64 + fr, b = u.pm >> 4, cl = wc * 32 + 8 * fq;
        const float* sbp = sb + (size_t)b * 5632 + u.pn * 256 + cl;
        float rsv[2][4];
#pragma unroll
        for (int ai = 0; ai < 2; ++ai)
#pragma unroll
            for (int m = 0; m < 4; ++m) rsv[ai][m] = rowss[row0 + ai * HALF + m * 16];
        f32x4 sg[2], su[2];
#pragma unroll
        for (int n = 0; n < 2; ++n) { sg[n] = *(const f32x4*)(sbp + 4 * n); su[n] = *(const f32x4*)(sbp + 128 + 4 * n); }
#pragma unroll
        for (int ai = 0; ai < 2; ++ai)
#pragma unroll
            for (int m = 0; m < 4; ++m) {
                const int row = row0 + ai * HALF + m * 16;
                const float rs = __builtin_amdgcn_rsqf(rsv[ai][m] * (1.0f / 1024.0f) + RMS_EPS);
                unsigned wq[4];
#pragma unroll
                for (int n = 0; n < 2; ++n)
#pragma unroll
                    for (int ip = 0; ip < 2; ++ip) {
                        const f32x2 ag = (f32x2){acc[ai][0][m][n][2 * ip], acc[ai][0][m][n][2 * ip + 1]}, au = (f32x2){acc[ai][1][m][n][2 * ip], acc[ai][1][m][n][2 * ip + 1]};
                        const f32x2 g = ag * rs + (f32x2){sg[n][2 * ip], sg[n][2 * ip + 1]}, uu = au * rs + (f32x2){su[n][2 * ip], su[n][2 * ip + 1]};
                        const f32x2 t = g * (-1.4426950408889634f);
                        f32x2 d; d.x = __builtin_amdgcn_exp2f(t.x); d.y = __builtin_amdgcn_exp2f(t.y); d = d + 1.0f;
                        f32x2 r; r.x = __builtin_amdgcn_rcpf(d.x); r.y = __builtin_amdgcn_rcpf(d.y);
                        const f32x2 hv = (g * uu) * r;
                        wq[n * 2 + ip] = cvt_pk_bf16(hv.x, hv.y);
                    }
                u32x4 w; w.x = wq[0]; w.y = wq[1]; w.z = wq[2]; w.w = wq[3];
                *(u32x4*)(H + (size_t)row * 2816 + u.pn * 128 + cl) = w;
            }
    }
};
struct EpiIn {
    static constexpr bool PERM = true, AFTER_DRAIN = false;
    bf16_t* P; float* FG; const float* rowss; const float* sb;
    __device__ __forceinline__ void operator()(const f32x4 (&acc)[2][2][4][2], const Unit& u, int wr, int wc, int fr, int fq) const {
        const int row0 = u.pm * BM + wr * 64 + fr, b = u.pm >> 4, cl = wc * 32 + 8 * fq;
        const float* sbp = sb + (size_t)b * 5632 + u.pn * 256 + cl;
        float rsv[2][4];
#pragma unroll
        for (int ai = 0; ai < 2; ++ai)
#pragma unroll
            for (int m = 0; m < 4; ++m) rsv[ai][m] = rowss[row0 + ai * HALF + m * 16];
        f32x4 sv[2][2];
#pragma unroll
        for (int bj = 0; bj < 2; ++bj)
#pragma unroll
            for (int n = 0; n < 2; ++n) sv[bj][n] = *(const f32x4*)(sbp + bj * HALF + 4 * n);
#pragma unroll
        for (int ai = 0; ai < 2; ++ai)
#pragma unroll
            for (int m = 0; m < 4; ++m) {
                const int row = row0 + ai * HALF + m * 16;
                const float rs = __builtin_amdgcn_rsqf(rsv[ai][m] * (1.0f / 1024.0f) + RMS_EPS);
                if (u.pn < 10) {
#pragma unroll
                    for (int bj = 0; bj < 2; ++bj) {
                        const f32x4 v0 = acc[ai][bj][m][0] * rs + sv[bj][0], v1 = acc[ai][bj][m][1] * rs + sv[bj][1];
                        u32x4 w; w.x = cvt_pk_bf16(v0[0], v0[1]); w.y = cvt_pk_bf16(v0[2], v0[3]); w.z = cvt_pk_bf16(v1[0], v1[1]); w.w = cvt_pk_bf16(v1[2], v1[3]);
                        *(u32x4*)(P + (size_t)row * 2560 + u.pn * 256 + bj * HALF + cl) = w;
                    }
                } else if (wc == 0 && fq == 0) {
                    *(f32x4*)(FG + (size_t)row * 4) = acc[ai][0][m][0] * rs + sv[0][0];
                }
            }
    }
};
struct EpiRes {
    static constexpr bool PERM = false, AFTER_DRAIN = false;
    const float* xin; float* xout; const float* gate; const float* gmn; bf16_t* XN; float* rowssn; int has_next;
    __device__ __forceinline__ void operator()(const f32x4 (&acc)[2][2][4][2], const Unit& u, int wr, int wc, int fr, int fq) const {
        typedef unsigned u32x2v __attribute__((ext_vector_type(2)));
        const int row0 = u.pm * BM + wr * 64 + fr, b = u.pm >> 4, col0 = u.pn * BM + wc * 32 + 4 * fq;
        const float* gp_ = gate + b * 1024 + col0; const float* gm_ = gmn + b * 1024 + col0;
#pragma unroll
        for (int ai = 0; ai < 2; ++ai) {
            f32x4 xi[4][2][2];
#pragma unroll
            for (int m = 0; m < 4; ++m)
#pragma unroll
                for (int bj = 0; bj < 2; ++bj)
#pragma unroll
                    for (int n = 0; n < 2; ++n) xi[m][bj][n] = *(const f32x4*)(xin + (size_t)(row0 + ai * HALF + m * 16) * 1024 + col0 + bj * HALF + n * 16);
            asm volatile("" ::: "memory");
#pragma unroll
            for (int m = 0; m < 4; ++m) {
                const int row = row0 + ai * HALF + m * 16; const size_t off = (size_t)row * 1024 + col0;
                float ss = 0.f;
#pragma unroll
                for (int bj = 0; bj < 2; ++bj)
#pragma unroll
                    for (int n = 0; n < 2; ++n) {
                        const f32x4 xo = xi[m][bj][n] + *(const f32x4*)(gp_ + bj * HALF + n * 16) * acc[ai][bj][m][n];
                        *(f32x4*)(xout + off + bj * HALF + n * 16) = xo;
                        if (has_next) {
                            ss += (xo[0] * xo[0] + xo[1] * xo[1]) + (xo[2] * xo[2] + xo[3] * xo[3]);
                            const f32x4 a = xo * *(const f32x4*)(gm_ + bj * HALF + n * 16); u32x2v w; w.x = cvt_pk_bf16(a[0], a[1]); w.y = cvt_pk_bf16(a[2], a[3]);
                            *(u32x2v*)(XN + off + bj * HALF + n * 16) = w;
                        }
                    }
                if (has_next) { ss += __shfl_xor(ss, 16); ss += __shfl_xor(ss, 32); if (fq == 0) unsafeAtomicAdd(rowssn + row, ss); }
            }
            asm volatile("" ::: "memory");
        }
    }
};

template <class Epi, class Sched, bool ALIGN_EPI = false, bool SP2 = false>
__device__ __forceinline__ void gemm_phase(PG8_LAS unsigned char* lds, const Gemm g, const Sched& S, const Epi& E) {
    int tid_o = threadIdx.x; asm volatile("" : "+v"(tid_o)); const int tid = tid_o, wid = __builtin_amdgcn_readfirstlane(tid >> 6), lane = tid & 63, wr = wid >> 2, wc = wid & 3, fr = lane & 15, fq = lane >> 4;
    const int K = g.K, nt = K / BK;
    unsigned voffA[2], voffB[2];
#pragma unroll
    for (int i = 0; i < 2; ++i) { int R, C; stage_rc(tid * 16 + i * 8192, R, C); const int Rb = Epi::PERM ? ((R & ~31) + perm32(R & 31)) : R;
        voffA[i] = (unsigned)(R * K + C) * 2u; voffB[i] = (unsigned)(Rb * K + C) * 2u; }
    const size_t kstep = (size_t)(BK * 2);
    const size_t hstep = (size_t)HALF * K * 2;
    const size_t tstep = 2 * hstep;
    const unsigned ldsw = (unsigned)wid * 1024u;
    const int aoff = lds_byte(wr * 64 + fr, fq * 8), boff = lds_byte(wc * 32 + fr, fq * 8);
#define PG8_SA(b, h) (((b) * 2 + (h)) * HTB)
#define PG8_SB(b, h) ((4 + (b) * 2 + (h)) * HTB)
#define PG8_STAGE(bufoff, gbase, voff) do { _Pragma("unroll") for (int _i = 0; _i < 2; ++_i) \
        __builtin_amdgcn_global_load_lds((const unsigned*)((const char*)(gbase) + (voff)[_i]), (PG8_LAS unsigned*)(lds + (bufoff) + ldsw + _i * 8192), 16, 0, 0); } while (0)
#define PG8_LDA(dst, b, h) do { _Pragma("unroll") for (int m = 0; m < 4; ++m) _Pragma("unroll") for (int k = 0; k < 2; ++k) dst[m][k] = *(const PG8_LAS bf16x8*)(lds + PG8_SA(b, h) + aoff + m * 2048 + k * 1024); } while (0)
#define PG8_LDB(dst, b, h) do { _Pragma("unroll") for (int n = 0; n < 2; ++n) _Pragma("unroll") for (int k = 0; k < 2; ++k) dst[n][k] = *(const PG8_LAS bf16x8*)(lds + PG8_SB(b, h) + boff + n * 2048 + k * 1024); } while (0)
#define PG8_MMA(ai, bj, At, Bt) do { __builtin_amdgcn_s_setprio(1); _Pragma("unroll") for (int m = 0; m < 4; ++m) _Pragma("unroll") for (int n = 0; n < 2; ++n) _Pragma("unroll") for (int k = 0; k < 2; ++k) \
        acc[ai][bj][m][n] = __builtin_amdgcn_mfma_f32_16x16x32_bf16(Bt[n][k], At[m][k], acc[ai][bj][m][n], 0, 0, 0); __builtin_amdgcn_s_setprio(0); } while (0)
#define PG8_WAIT_V(n) asm volatile("s_waitcnt vmcnt(" #n ")" ::: "memory")
#define PG8_WAIT_L(n) asm volatile("s_waitcnt lgkmcnt(" #n ")" ::: "memory")
#define PG8_BAR __builtin_amdgcn_s_barrier()
#define PG8_SCHED __builtin_amdgcn_sched_barrier(0)
    Unit cur, nxt; int ui = 0;
    if (!S.next(0, cur)) return;
    f32x4 acc[2][2][4][2];
#pragma unroll
    for (int a = 0; a < 2; ++a)
#pragma unroll
        for (int b = 0; b < 2; ++b)
#pragma unroll
            for (int m = 0; m < 4; ++m)
#pragma unroll
                for (int n = 0; n < 2; ++n) acc[a][b][m][n] = (f32x4){0.f, 0.f, 0.f, 0.f};
    bf16x8 At[4][2], B0[2][2], B1[2][2];
    const char* cA = (const char*)g.A + (size_t)cur.pm * tstep; const char* cB = (const char*)g.Bt + (size_t)cur.pn * tstep;
    S.a_ready(cur);
    if constexpr (SP2) {
        PG8_STAGE(PG8_SB(0, 0), cB, voffB); PG8_STAGE(PG8_SB(0, 1), cB + hstep, voffB); PG8_STAGE(PG8_SA(0, 0), cA, voffA); PG8_STAGE(PG8_SA(0, 1), cA + hstep, voffA);
        if (wr == 1) PG8_BAR;
        PG8_WAIT_V(2); PG8_BAR;
        PG8_STAGE(PG8_SB(1, 0), cB + kstep, voffB); PG8_STAGE(PG8_SA(1, 0), cA + kstep, voffA); PG8_STAGE(PG8_SB(1, 1), cB + hstep + kstep, voffB);
        PG8_WAIT_V(6); PG8_BAR;
    } else {
        PG8_STAGE(PG8_SB(0, 0), cB, voffB); PG8_STAGE(PG8_SA(0, 0), cA, voffA); PG8_STAGE(PG8_SB(0, 1), cB + hstep, voffB); PG8_STAGE(PG8_SA(0, 1), cA + hstep, voffA);
        if (wr == 1) PG8_BAR;
        PG8_WAIT_V(4); PG8_BAR;
        PG8_STAGE(PG8_SB(1, 0), cB + kstep, voffB); PG8_STAGE(PG8_SA(1, 0), cA + kstep, voffA); PG8_STAGE(PG8_SB(1, 1), cB + hstep + kstep, voffB);
        PG8_WAIT_V(6); PG8_BAR;
    }
    for (;;) {
        const bool has_next = S.next(ui + 1, nxt);
        const char* nA = has_next ? (const char*)g.A + (size_t)nxt.pm * tstep : cA; const char* nB = has_next ? (const char*)g.Bt + (size_t)nxt.pn * tstep : cB;
        for (int t = 0; t < nt; t += 2) {
            const bool last = (t == nt - 2);
            const char* a1 = cA + (size_t)(t + 1) * kstep;
            const char* a2 = last ? nA : cA + (size_t)(t + 2) * kstep; const char* b2 = last ? nB : cB + (size_t)(t + 2) * kstep;
            const char* a3 = a2 + kstep; const char* b3 = b2 + kstep;
            if (last && has_next) S.a_ready(nxt);
            if constexpr (SP2) {
            PG8_LDB(B0, 0, 0); PG8_LDB(B1, 0, 1); PG8_SCHED; PG8_LDA(At, 0, 0); PG8_STAGE(PG8_SA(1, 1), a1 + hstep, voffA);
            PG8_WAIT_V(8); PG8_WAIT_L(0); PG8_BAR; PG8_MMA(0, 0, At, B0); PG8_MMA(0, 1, At, B1); PG8_BAR; PG8_SCHED;
            PG8_LDA(At, 0, 1); PG8_STAGE(PG8_SB(0, 0), b2, voffB); PG8_STAGE(PG8_SB(0, 1), b2 + hstep, voffB); PG8_STAGE(PG8_SA(0, 0), a2, voffA);
            PG8_WAIT_V(8); PG8_WAIT_L(0); PG8_BAR; PG8_MMA(1, 0, At, B0); PG8_MMA(1, 1, At, B1); PG8_BAR; PG8_SCHED;
            PG8_LDB(B0, 1, 0); PG8_LDB(B1, 1, 1); PG8_SCHED; PG8_LDA(At, 1, 0); PG8_STAGE(PG8_SA(0, 1), a2 + hstep, voffA);
            PG8_WAIT_V(8); PG8_WAIT_L(0); PG8_BAR; PG8_MMA(0, 0, At, B0); PG8_MMA(0, 1, At, B1); PG8_BAR; PG8_SCHED;
            PG8_LDA(At, 1, 1); PG8_STAGE(PG8_SB(1, 0), b3, voffB); PG8_STAGE(PG8_SB(1, 1), b3 + hstep, voffB); PG8_STAGE(PG8_SA(1, 0), a3, voffA);
            PG8_WAIT_V(8); PG8_WAIT_L(0); PG8_BAR; PG8_MMA(1, 0, At, B0); PG8_MMA(1, 1, At, B1); PG8_BAR; PG8_SCHED;
            } else {
            PG8_LDB(B0, 0, 0); PG8_SCHED; PG8_LDA(At, 0, 0); PG8_STAGE(PG8_SA(1, 1), a1 + hstep, voffA);
            PG8_WAIT_L(8); PG8_BAR; PG8_WAIT_L(0); PG8_MMA(0, 0, At, B0); PG8_BAR; PG8_SCHED;
            PG8_LDB(B1, 0, 1); PG8_STAGE(PG8_SB(0, 0), b2, voffB);
            PG8_BAR; PG8_WAIT_L(0); PG8_MMA(0, 1, At, B1); PG8_BAR;
            PG8_LDA(At, 0, 1); PG8_STAGE(PG8_SA(0, 0), a2, voffA);
            PG8_BAR; PG8_WAIT_L(0); PG8_MMA(1, 0, At, B0); PG8_BAR; PG8_SCHED;
            PG8_STAGE(PG8_SB(0, 1), b2 + hstep, voffB);
            PG8_WAIT_V(6); PG8_BAR; PG8_MMA(1, 1, At, B1); PG8_BAR;
            PG8_LDB(B0, 1, 0); PG8_SCHED; PG8_LDA(At, 1, 0); PG8_STAGE(PG8_SA(0, 1), a2 + hstep, voffA);
            PG8_WAIT_L(8); PG8_BAR; PG8_WAIT_L(0); PG8_MMA(0, 0, At, B0); PG8_BAR; PG8_SCHED;
            PG8_LDB(B1, 1, 1); PG8_STAGE(PG8_SB(1, 0), b3, voffB);
            PG8_BAR; PG8_WAIT_L(0); PG8_MMA(0, 1, At, B1); PG8_BAR;
            PG8_LDA(At, 1, 1); PG8_STAGE(PG8_SA(1, 0), a3, voffA);
            PG8_BAR; PG8_WAIT_L(0); PG8_MMA(1, 0, At, B0); PG8_BAR; PG8_SCHED;
            PG8_STAGE(PG8_SB(1, 1), b3 + hstep, voffB);
            PG8_WAIT_V(6); PG8_BAR; PG8_MMA(1, 1, At, B1); PG8_BAR;
            }
        }
        if constexpr (ALIGN_EPI) { if (wr == 0) PG8_BAR; }
        if constexpr (!Epi::AFTER_DRAIN) { E(acc, cur, wr, wc, fr, fq); S.done(cur); }
        if (!has_next) break;
#pragma unroll
        for (int a = 0; a < 2; ++a)
#pragma unroll
            for (int b = 0; b < 2; ++b)
#pragma unroll
                for (int m = 0; m < 4; ++m)
#pragma unroll
                    for (int n = 0; n < 2; ++n) acc[a][b][m][n] = (f32x4){0.f, 0.f, 0.f, 0.f};
        cur = nxt; cA = nA; cB = nB; ++ui;
        if constexpr (ALIGN_EPI) { if (wr == 1) PG8_BAR; }
    }
    PG8_WAIT_V(0);
    if constexpr (!ALIGN_EPI) { if (wr == 0) PG8_BAR; }
    PG8_BAR;
    if constexpr (Epi::AFTER_DRAIN) { E.fused(acc, cur, wr, wc, fr, fq, lds, wid, lane); S.done(cur); }
#undef PG8_SA
#undef PG8_SB
#undef PG8_STAGE
#undef PG8_LDA
#undef PG8_LDB
#undef PG8_MMA
#undef PG8_WAIT_V
#undef PG8_WAIT_L
#undef PG8_BAR
#undef PG8_SCHED
}
}

#define LAS __attribute__((address_space(3)))
typedef unsigned short bf16_t;
typedef short bf16x8 __attribute__((ext_vector_type(8)));
typedef short s16x4 __attribute__((ext_vector_type(4)));
typedef float f32x4 __attribute__((ext_vector_type(4)));
typedef float f32x2 __attribute__((ext_vector_type(2)));
typedef float f32x16 __attribute__((ext_vector_type(16)));
typedef unsigned u32x4 __attribute__((ext_vector_type(4)));
typedef unsigned u32x2 __attribute__((ext_vector_type(2)));

constexpr int MTOK = 65536, DM = 1024, DFF = 2816, NUP = 5632, NINP = 2816, PPITCH = 2560, SEQL = 4096;
constexpr float EPSF = 1e-6f, LOG2E = 1.4426950408889634f;
constexpr size_t MiB = 1u << 20;
constexpr size_t WS_MOD = 1 * MiB, WS_GMOD = 3 * MiB, WS_GATE = 4 * MiB, WS_SB = 5 * MiB, WS_ROWSS = 8 * MiB, WS_KS = 10 * MiB, WS_F2 = 11 * MiB, WS_FG = 12 * MiB,
                 WS_ASEG = 13 * MiB, WS_BSEG = 17 * MiB, WS_WUP = 24 * MiB, WS_WDN = 68 * MiB, WS_WIN = 90 * MiB, WS_WOUT = 101 * MiB, WS_XN = 112 * MiB,
                 WS_H = 240 * MiB, WS_PROJ = 240 * MiB, WS_YU = 592 * MiB, WS_HLOC = 656 * MiB, WS_PCUM = 784 * MiB, WS_YN = 848 * MiB, WS_END = 976 * MiB;
constexpr int LDS_BYTES = 147456;

__device__ __forceinline__ float bf2f(unsigned short v) { return __uint_as_float((unsigned)v << 16); }
__device__ __forceinline__ unsigned f2bf(float f) { unsigned u = __float_as_uint(f); return (u + 0x7fffu + ((u >> 16) & 1u)) >> 16; }
__device__ __forceinline__ unsigned pk2(float lo, float hi) { return pg8::cvt_pk_bf16(lo, hi); }
__device__ __forceinline__ float wave_sum(float v) {
#pragma unroll
    for (int o = 1; o < 64; o <<= 1) v += __shfl_xor(v, o);
    return v;
}
__device__ __forceinline__ float sigmoidf_(float x) { return __builtin_amdgcn_rcpf(1.0f + __builtin_amdgcn_exp2f(-LOG2E * x)); }
#define WAITV(n) asm volatile("s_waitcnt vmcnt(" #n ")" ::: "memory")
#define LBAR() asm volatile("s_waitcnt lgkmcnt(0)\n\ts_barrier" ::: "memory")
#define CFENCE() asm volatile("" ::: "memory")

#ifndef REP_FIN
#define REP_FIN 1
#endif
#ifndef REP_IN
#define REP_IN 1
#endif
#ifndef REP_PREP
#define REP_PREP 1
#endif
#ifndef REP_ATTN
#define REP_ATTN 1
#endif
#ifndef REP_UP
#define REP_UP 1
#endif
struct Args { const float* in[19]; float* out; unsigned char* ws; int ph_lo, ph_hi; };

__device__ __forceinline__ void transpose_item(const float* __restrict__ W, int ldw, int clim, int K, bf16_t* __restrict__ WT, int n0, int c0, int k0, LAS float* scr, int lane) {
    const int col = c0 + (lane & 31);
#pragma unroll 16
    for (int i = 0; i < 32; ++i) { const int kk = 2 * i + (lane >> 5); scr[kk * 33 + (lane & 31)] = (col < clim) ? W[(size_t)(k0 + kk) * ldw + col] : 0.f; }
    asm volatile("s_waitcnt lgkmcnt(0)" ::: "memory");
    const int c = lane & 7;
#pragma unroll
    for (int j = 0; j < 4; ++j) { const int n = (lane >> 3) + 8 * j; const LAS float* s = scr + (8 * c) * 33 + n;
        u32x4 o; o.x = pk2(s[0 * 33], s[1 * 33]); o.y = pk2(s[2 * 33], s[3 * 33]); o.z = pk2(s[4 * 33], s[5 * 33]); o.w = pk2(s[6 * 33], s[7 * 33]);
        *(u32x4*)(WT + (size_t)(n0 + n) * K + k0 + 8 * c) = o; }
    asm volatile("s_waitcnt lgkmcnt(0)" ::: "memory");
}

__device__ __forceinline__ int crow(int r, int hi) { return (r & 3) + 8 * (r >> 2) + 4 * hi; }
__device__ __forceinline__ s16x4 vtr(const LAS unsigned char* p) {
    typedef short v4i16_t __attribute__((ext_vector_type(4)));
    return __builtin_bit_cast(s16x4, __builtin_amdgcn_ds_read_tr16_b64_v4i16((LAS v4i16_t*)p));
}
constexpr int AT_SLOT = 16384, AT_AUX = 3 * AT_SLOT, AT_WSF = AT_AUX + 3 * 512, AT_VOTE = AT_WSF + 8 * 256;
constexpr float C2 = 0.125f * LOG2E;

__device__ __forceinline__ void sb_block(f32x16& X, float& carry, bool band, int kv0  , int qrel, int hi) {
    float lm[16];
#pragma unroll
    for (int r = 0; r < 16; ++r) {
        float z2 = X[r] * C2; z2 = __builtin_fminf(__builtin_fmaxf(z2, -120.f), 120.f);
        const float e = __builtin_amdgcn_exp2f(-z2), sp = __builtin_amdgcn_logf(1.0f + e);
        float l1 = -(sp + z2), lb = -sp;
        if (band) { const int kv = kv0 + (r & 3) + 8 * (r >> 2); const bool valid = kv < qrel; l1 = valid ? l1 : 0.f; lb = valid ? lb : -INFINITY; }
        lm[r] = l1; X[r] = lb;
    }
    float G[4], Gp[4], T[4];
#pragma unroll
    for (int g = 0; g < 4; ++g) { G[g] = (lm[4 * g] + lm[4 * g + 1]) + (lm[4 * g + 2] + lm[4 * g + 3]); Gp[g] = __shfl_xor(G[g], 32); T[g] = G[g] + Gp[g]; }
    float S = carry;
#pragma unroll
    for (int g = 3; g >= 0; --g) {
        const float a3 = S + (hi == 0 ? Gp[g] : 0.f), a2 = a3 + lm[4 * g + 3], a1 = a2 + lm[4 * g + 2], a0 = a1 + lm[4 * g + 1];
        X[4 * g + 3] = __builtin_amdgcn_exp2f(X[4 * g + 3] + a3); X[4 * g + 2] = __builtin_amdgcn_exp2f(X[4 * g + 2] + a2);
        X[4 * g + 1] = __builtin_amdgcn_exp2f(X[4 * g + 1] + a1); X[4 * g] = __builtin_amdgcn_exp2f(X[4 * g] + a0);
        S += T[g];
    }
    carry = S;
}

template <int KIND>
__device__ __forceinline__ void attn_unit(LAS unsigned char* lds, const bf16_t* __restrict__ PROJ, bf16_t* __restrict__ YU, const float* __restrict__ KS,
                                          const float* __restrict__ F2, const float* __restrict__ gqk, int b, int h, int qb) {
    int tid_o = threadIdx.x; asm volatile("" : "+v"(tid_o));
    const int tid = tid_o, lane = tid & 63, r32 = lane & 31, hi = lane >> 5;
    const int wid = __builtin_amdgcn_readfirstlane(tid >> 6);
    const int qcol = (KIND == 0 ? 1024 : 1792) + h * 64, kcol = qcol + 256, vcol = qcol + 512;
    const size_t rowbase = (size_t)b * SEQL; const int q0 = qb * 256, bh = b * 4 + h;
    const int NT = (q0 + 256) / 64;
    const bf16_t* ksrc = PROJ + (rowbase + lane) * PPITCH + kcol + wid * 8;
    const bf16_t* vsrc = PROJ + (rowbase + 16 * (wid & 3) + (lane >> 2)) * PPITCH + vcol + (wid >> 2) * 32 + (lane & 3) * 8;
    const float* axsrc = (wid == 0 ? KS : F2) + (size_t)bh * SEQL + lane;
    u32x4 kreg, vreg; float areg = 0.f;
#define AT_LOAD(it_) do { const int kt_ = NT - 1 - (it_); kreg = *(const u32x4*)(ksrc + (size_t)kt_ * 64 * PPITCH); vreg = *(const u32x4*)(vsrc + (size_t)kt_ * 64 * PPITCH); \
        if (KIND == 1 && wid < 2) areg = axsrc[kt_ * 64]; } while (0)
#define AT_STORE(slot_) do { *(LAS u32x4*)(lds + (slot_) * AT_SLOT + wid * 1024 + lane * 16) = kreg; *(LAS u32x4*)(lds + (slot_) * AT_SLOT + 8192 + wid * 1024 + lane * 16) = vreg; \
        if (KIND == 1 && wid < 2) *(LAS float*)(lds + AT_AUX + (slot_) * 512 + wid * 256 + lane * 4) = areg; } while (0)
    const bf16_t* Qw = PROJ + (rowbase + q0 + wid * 32 + r32) * PPITCH + qcol + hi * 8;
    bf16x8 qr[4];
#pragma unroll
    for (int d0 = 0; d0 < 4; ++d0) qr[d0] = *(const bf16x8*)(Qw + d0 * 16);
    AT_LOAD(0);
    if (KIND == 1) {
        float qf[4][8]; float ss = 0.f;
#pragma unroll
        for (int d0 = 0; d0 < 4; ++d0)
#pragma unroll
            for (int i = 0; i < 8; ++i) { qf[d0][i] = bf2f((unsigned short)qr[d0][i]); ss += qf[d0][i] * qf[d0][i]; }
        ss += __shfl_xor(ss, 32);
        const float rs = __builtin_amdgcn_rsqf(ss * (1.0f / 64.0f) + EPSF) * C2;
#pragma unroll
        for (int d0 = 0; d0 < 4; ++d0) {
            const float* gp = gqk + d0 * 16 + hi * 8; float v[8];
#pragma unroll
            for (int i = 0; i < 8; ++i) v[i] = qf[d0][i] * rs * gp[i] * gp[64 + i];
            u32x4 w; w.x = pk2(v[0], v[1]); w.y = pk2(v[2], v[3]); w.z = pk2(v[4], v[5]); w.w = pk2(v[6], v[7]);
            qr[d0] = __builtin_bit_cast(bf16x8, w);
        }
    }
    f32x16 o0, o1;
#pragma unroll
    for (int r = 0; r < 16; ++r) { o0[r] = 0.f; o1[r] = 0.f; }
    float mhat = -1e30f, lsum = 0.f, carry = 0.f;
    LAS float* wsf = (LAS float*)(lds + AT_WSF) + wid * 64;
    LAS unsigned* votes = (LAS unsigned*)(lds + AT_VOTE);
    const int qrel = wid * 32 + r32;
    bool wdone = false;
    AT_STORE(0); LBAR();
    for (int it = 0; it < NT; ++it) {
        const int slot = it & 1;
        if (KIND == 0 && it > 0) {
            const LAS unsigned* vp = votes + ((it - 1) & 1) * 8;
            const unsigned all = vp[0] & vp[1] & vp[2] & vp[3] & vp[4] & vp[5] & vp[6] & vp[7];
            if (all) break;
        }
        if (it + 1 < NT) AT_LOAD(it + 1);
        const int kt = NT - 1 - it, jb = kt - (NT - 4);
        const bool band = jb >= 0;
        const bool active = !(band && 64 * jb > 32 * wid + 31) && !wdone;
        if (active) {
            f32x16 p0, p1;
            { const LAS unsigned char* kb = lds + slot * AT_SLOT + hi * 1024 + r32 * 16;
#pragma unroll
              for (int d0 = 0; d0 < 4; ++d0) {
                  const bf16x8 b0 = *(const LAS bf16x8*)(kb + d0 * 2048), b1 = *(const LAS bf16x8*)(kb + d0 * 2048 + 512);
                  if (d0 == 0) { f32x16 z;
#pragma unroll
                      for (int r = 0; r < 16; ++r) z[r] = 0.f;
                      p0 = __builtin_amdgcn_mfma_f32_32x32x16_bf16(b0, qr[0], z, 0, 0, 0); p1 = __builtin_amdgcn_mfma_f32_32x32x16_bf16(b1, qr[0], z, 0, 0, 0); }
                  else { p0 = __builtin_amdgcn_mfma_f32_32x32x16_bf16(b0, qr[d0], p0, 0, 0, 0); p1 = __builtin_amdgcn_mfma_f32_32x32x16_bf16(b1, qr[d0], p1, 0, 0, 0); }
              } }
            if (KIND == 0) {
                sb_block(p1, carry, band, 64 * jb + 32 + 4 * hi, qrel, hi);
                sb_block(p0, carry, band, 64 * jb + 4 * hi, qrel, hi);
            } else {
                const LAS float* ax = (const LAS float*)(lds + AT_AUX + slot * 512);
#pragma unroll
                for (int g = 0; g < 4; ++g) {
                    const f32x4 k0 = *(const LAS f32x4*)(ax + 8 * g + 4 * hi), k1 = *(const LAS f32x4*)(ax + 32 + 8 * g + 4 * hi);
                    const f32x4 f0 = *(const LAS f32x4*)(ax + 64 + 8 * g + 4 * hi), f1 = *(const LAS f32x4*)(ax + 96 + 8 * g + 4 * hi);
#pragma unroll
                    for (int i = 0; i < 4; ++i) { p0[4 * g + i] = p0[4 * g + i] * k0[i] + f0[i]; p1[4 * g + i] = p1[4 * g + i] * k1[i] + f1[i]; }
                }
                if (band) {
#pragma unroll
                    for (int r = 0; r < 16; ++r) { const int kv = 64 * jb + crow(r, hi); if (kv > qrel) p0[r] = -INFINITY; if (kv + 32 > qrel) p1[r] = -INFINITY; }
                }
                float rm = __builtin_fmaxf(p0[0], p1[0]), rm2 = __builtin_fmaxf(p0[1], p1[1]);
#pragma unroll
                for (int r = 2; r < 16; r += 2) { rm = __builtin_fmaxf(__builtin_fmaxf(rm, p0[r]), p1[r]); rm2 = __builtin_fmaxf(__builtin_fmaxf(rm2, p0[r + 1]), p1[r + 1]); }
                rm = __builtin_fmaxf(rm, rm2);
                rm = __builtin_fmaxf(rm, __shfl_xor(rm, 32));
                if (__any(rm > mhat + 8.0f)) {
                    const float mnew = __builtin_fmaxf(mhat, rm), f = __builtin_amdgcn_exp2f(mhat - mnew);
                    lsum *= f; mhat = mnew;
                    CFENCE(); if (hi == 0) wsf[r32] = f; CFENCE();
                    asm volatile("s_waitcnt lgkmcnt(0)" ::: "memory");
#pragma unroll
                    for (int r = 0; r < 16; ++r) { const float fr_ = wsf[crow(r, hi)]; o0[r] *= fr_; o1[r] *= fr_; }
                    CFENCE();
                }
                f32x2 sacc2 = (f32x2){0.f, 0.f};
#pragma unroll
                for (int r = 0; r < 16; r += 2) {
                    const f32x2 a0 = (f32x2){p0[r], p0[r + 1]} - mhat, a1 = (f32x2){p1[r], p1[r + 1]} - mhat;
                    p0[r] = __builtin_amdgcn_exp2f(a0[0]); p0[r + 1] = __builtin_amdgcn_exp2f(a0[1]); p1[r] = __builtin_amdgcn_exp2f(a1[0]); p1[r + 1] = __builtin_amdgcn_exp2f(a1[1]);
                    sacc2 += (f32x2){p0[r], p0[r + 1]}; sacc2 += (f32x2){p1[r], p1[r + 1]};
                }
                lsum += sacc2[0] + sacc2[1];
            }
            u32x4 pw0, pw1, pw2, pw3;
            pw0.x = pk2(p0[0], p0[1]); pw0.y = pk2(p0[2], p0[3]); pw0.z = pk2(p0[4], p0[5]); pw0.w = pk2(p0[6], p0[7]);
            pw1.x = pk2(p0[8], p0[9]); pw1.y = pk2(p0[10], p0[11]); pw1.z = pk2(p0[12], p0[13]); pw1.w = pk2(p0[14], p0[15]);
            pw2.x = pk2(p1[0], p1[1]); pw2.y = pk2(p1[2], p1[3]); pw2.z = pk2(p1[4], p1[5]); pw2.w = pk2(p1[6], p1[7]);
            pw3.x = pk2(p1[8], p1[9]); pw3.y = pk2(p1[10], p1[11]); pw3.z = pk2(p1[12], p1[13]); pw3.w = pk2(p1[14], p1[15]);
            const LAS unsigned char* vb = lds + slot * AT_SLOT + 8192 + ((lane >> 4) & 1) * 32 + (lane & 3) * 8 + (4 * hi + ((lane & 15) >> 2)) * 64;
            s16x4 vlo[8], vhi[8];
#pragma unroll
            for (int i = 0; i < 8; ++i) { vlo[i] = vtr(vb + (i >> 2) * 4096 + (i & 3) * 1024); vhi[i] = vtr(vb + (i >> 2) * 4096 + (i & 3) * 1024 + 512); }
#define VFR(i) (bf16x8){vlo[i][0], vlo[i][1], vlo[i][2], vlo[i][3], vhi[i][0], vhi[i][1], vhi[i][2], vhi[i][3]}
#define PAF(x) __builtin_bit_cast(bf16x8, x)
            o0 = __builtin_amdgcn_mfma_f32_32x32x16_bf16(PAF(pw0), VFR(0), o0, 0, 0, 0); o1 = __builtin_amdgcn_mfma_f32_32x32x16_bf16(PAF(pw0), VFR(4), o1, 0, 0, 0);
            o0 = __builtin_amdgcn_mfma_f32_32x32x16_bf16(PAF(pw1), VFR(1), o0, 0, 0, 0); o1 = __builtin_amdgcn_mfma_f32_32x32x16_bf16(PAF(pw1), VFR(5), o1, 0, 0, 0);
            o0 = __builtin_amdgcn_mfma_f32_32x32x16_bf16(PAF(pw2), VFR(2), o0, 0, 0, 0); o1 = __builtin_amdgcn_mfma_f32_32x32x16_bf16(PAF(pw2), VFR(6), o1, 0, 0, 0);
            o0 = __builtin_amdgcn_mfma_f32_32x32x16_bf16(PAF(pw3), VFR(3), o0, 0, 0, 0); o1 = __builtin_amdgcn_mfma_f32_32x32x16_bf16(PAF(pw3), VFR(7), o1, 0, 0, 0);
#undef VFR
#undef PAF
        }
        if (KIND == 0) { if (active) wdone = __all(carry < -150.0f); if (lane == 0) votes[(it & 1) * 8 + wid] = wdone ? 1u : 0u; }
        if (it + 1 < NT) AT_STORE(slot ^ 1);
        LBAR();
    }
    if (KIND == 1) { lsum += __shfl_xor(lsum, 32); CFENCE(); if (hi == 0) wsf[r32] = lsum; CFENCE(); asm volatile("s_waitcnt lgkmcnt(0)" ::: "memory"); }
    bf16_t* Yw = YU + (rowbase + q0 + wid * 32) * 512 + KIND * 256 + h * 64 + r32;
#pragma unroll
    for (int r = 0; r < 16; ++r) {
        const int orow = crow(r, hi); float sc = 1.0f;
        if (KIND == 1) sc = __builtin_amdgcn_rcpf(wsf[orow]);
        Yw[(size_t)orow * 512] = (bf16_t)f2bf(o0[r] * sc); Yw[(size_t)orow * 512 + 32] = (bf16_t)f2bf(o1[r] * sc);
    }
    LBAR();
#undef AT_LOAD
#undef AT_STORE
}

#define DEFPTRS \
    const __attribute__((address_space(4))) Args* ka_ = (const __attribute__((address_space(4))) Args*)__builtin_amdgcn_kernarg_segment_ptr(); \
    asm volatile("" : "+s"(ka_)); \
    int tid_o_ = threadIdx.x; asm volatile("" : "+v"(tid_o_)); const int tid = tid_o_, lane = tid & 63; (void)lane; \
    unsigned char* ws = ka_->ws; \
    const float* x_in = ka_->in[0]; const float* c_in = ka_->in[1]; const float* w_ada = ka_->in[2]; const float* b_ada = ka_->in[3]; const float* g_norm = ka_->in[4]; \
    const float* w_up = ka_->in[5]; const float* w_dn = ka_->in[6]; const float* w_in = ka_->in[7]; const float* b_fg = ka_->in[8]; const float* conv_w = ka_->in[9]; \
    const float* conv_b = ka_->in[10]; const float* w_rg = ka_->in[11]; const float* b_rg = ka_->in[12]; const float* w_ig = ka_->in[13]; const float* b_ig = ka_->in[14]; \
    const float* lam = ka_->in[15]; const float* g_qk = ka_->in[16]; const float* g_mix = ka_->in[17]; const float* w_out = ka_->in[18]; \
    float* xout = ka_->out; \
    float* MOD = (float*)(ws + WS_MOD); float* GMOD = (float*)(ws + WS_GMOD); float* GATE = (float*)(ws + WS_GATE); float* SBV = (float*)(ws + WS_SB); \
    float* ROWSS = (float*)(ws + WS_ROWSS); float* KS = (float*)(ws + WS_KS); float* F2 = (float*)(ws + WS_F2); float* FG = (float*)(ws + WS_FG); \
    float* ASEG = (float*)(ws + WS_ASEG); float* BSEG = (float*)(ws + WS_BSEG); \
    bf16_t* WUP = (bf16_t*)(ws + WS_WUP); bf16_t* WDN = (bf16_t*)(ws + WS_WDN); bf16_t* WIN = (bf16_t*)(ws + WS_WIN); bf16_t* WOUT = (bf16_t*)(ws + WS_WOUT); \
    bf16_t* XN = (bf16_t*)(ws + WS_XN); bf16_t* HB = (bf16_t*)(ws + WS_H); bf16_t* PROJ = (bf16_t*)(ws + WS_PROJ); bf16_t* YU = (bf16_t*)(ws + WS_YU); \
    bf16_t* HLOC = (bf16_t*)(ws + WS_HLOC); bf16_t* PCUM = (bf16_t*)(ws + WS_PCUM); bf16_t* YN = (bf16_t*)(ws + WS_YN);
#define XB_TMO      128
#define XB_XCNT(j)  (256  + 64 * (j))
#define XB_XSUB(j)  (1280 + 64 * (j))
#define XB_XGEN(j)  (2304 + 64 * (j))
#define XB_TOP      3328
#define XB_TOPGEN   3392
#define XCD_BAR_WORDS 3456
#define XB_SPIN_CAP (1u << 18)

__device__ __forceinline__ unsigned xb_ld(unsigned* p)              { return __hip_atomic_load(p, __ATOMIC_RELAXED, __HIP_MEMORY_SCOPE_AGENT); }
__device__ __forceinline__ unsigned xb_add(unsigned* p, unsigned v) { return __hip_atomic_fetch_add(p, v, __ATOMIC_RELAXED, __HIP_MEMORY_SCOPE_AGENT); }
__device__ __forceinline__ unsigned xb_xcc_id() { return (unsigned)__builtin_amdgcn_s_getreg((3 << 11) | 20) & 0xFu; }
#define XB_SPIN(cond, bar) do { unsigned _sp = 0; while (cond) { __builtin_amdgcn_s_sleep(1); \
    if ((++_sp & 255u) == 0u) { if (xb_ld(&(bar)[XB_TMO])) break; if (_sp > XB_SPIN_CAP) { atomicAdd(&(bar)[XB_TMO], 1u); break; } } } } while (0)

struct XcdBarrier {
    unsigned* bar; unsigned x;
    volatile LAS unsigned* st;
};

__device__ __forceinline__ XcdBarrier xcd_barrier_post(unsigned* bar, volatile LAS unsigned* st) {
    XcdBarrier b; b.bar = bar; b.x = xb_xcc_id(); b.st = st;
    if (threadIdx.x == 0) (void)xb_add(&bar[XB_XCNT(b.x)], 1u);
    return b;
}
__device__ __forceinline__ void xcd_barrier_complete(unsigned* bar, unsigned x, unsigned& nloc, unsigned& nx) {
    const unsigned G = gridDim.x * gridDim.y * gridDim.z;
    unsigned sum, cnt, mine, sp = 0u;
    for (;;) {
        sum = 0u; cnt = 0u; mine = 0u;
#pragma unroll
        for (unsigned j = 0; j < 16; ++j) { const unsigned c = xb_ld(&bar[XB_XCNT(j)]); sum += c; cnt += (c > 0u) ? 1u : 0u; mine = (j == x) ? c : mine; }
        if (sum == G) break;
        __builtin_amdgcn_s_sleep(1);
        if ((++sp & 255u) == 0u) { if (xb_ld(&bar[XB_TMO])) break; if (sp > XB_SPIN_CAP) { atomicAdd(&bar[XB_TMO], 1u); break; } }
    }
    nloc = mine > 0u ? mine : 1u; nx = cnt > 0u ? cnt : 1u;
}

__device__ __forceinline__ void xcd_barrier(const XcdBarrier& b) {
    asm volatile("s_waitcnt vmcnt(0)" ::: "memory");
    __syncthreads();
    if (threadIdx.x == 0) {
        unsigned* bar = b.bar;
        __builtin_amdgcn_s_waitcnt(0);
        unsigned nloc = b.st[0], nx = b.st[1];
        if (nloc == 0u) { xcd_barrier_complete(bar, b.x, nloc, nx); b.st[0] = nloc; b.st[1] = nx; }
        const unsigned old = xb_add(&bar[XB_XSUB(b.x)], 1u);
        const unsigned gen = old / nloc;
        if (old + 1u == (gen + 1u) * nloc) {
            __builtin_amdgcn_fence(__ATOMIC_RELEASE, "agent");
            asm volatile("s_waitcnt vmcnt(0)" ::: "memory");
            const unsigned og = xb_add(&bar[XB_TOP], 1u);
            const unsigned tg = og / nx;
            if (og + 1u == (tg + 1u) * nx) xb_add(&bar[XB_TOPGEN], 1u);
            else XB_SPIN(xb_ld(&bar[XB_TOPGEN]) == tg, bar);
            __builtin_amdgcn_fence(__ATOMIC_ACQUIRE, "agent");
            xb_add(&bar[XB_XGEN(b.x)], 1u);
            asm volatile("s_waitcnt vmcnt(0)" ::: "memory");
        } else {
            XB_SPIN(xb_ld(&bar[XB_XGEN(b.x)]) == gen, bar);
            __builtin_amdgcn_fence(__ATOMIC_ACQUIRE, "agent");
            asm volatile("s_waitcnt vmcnt(0)" ::: "memory");
        }
    }
    __syncthreads();
}

__global__ void __launch_bounds__(512) mk_fwd(Args args) {
    extern __shared__ __attribute__((aligned(16))) unsigned char lds_raw[];
    LAS unsigned char* lds = (LAS unsigned char*)lds_raw;
    cg::grid_group grid = cg::this_grid();
    const int wave = __builtin_amdgcn_readfirstlane(threadIdx.x >> 6);
    const int G = gridDim.x; const int bx = blockIdx.x;
    const int vcu = (G % 8 == 0) ? (bx % 8) * (G / 8) + bx / 8 : bx;
    const int gw = vcu * 8 + wave, NGW = G * 8;
    const int lo = args.ph_lo, hi_ph = args.ph_hi;
    volatile LAS unsigned* MISC = (volatile LAS unsigned*)(lds + 131072 + 320);
    if (threadIdx.x < 16) MISC[threadIdx.x] = 0u;
    __syncthreads();
    XcdBarrier xbar = xcd_barrier_post((unsigned*)args.ws, MISC + 8);
    int ph = 0;
#define PH_ON (ph >= lo && ph < hi_ph)
#ifdef REP_SYNC
#define SYNC_EXTRA grid.sync(); asm volatile("" ::: "memory");
#else
#define SYNC_EXTRA
#endif
#define PH_NEXT do { ++ph; if (ph > lo && ph < hi_ph) { asm volatile("s_waitcnt vmcnt(0) lgkmcnt(0)" ::: "memory"); if (ph == 1) grid.sync(); else xcd_barrier(xbar); asm volatile("" ::: "memory"); SYNC_EXTRA } } while (0)

#ifdef REP_PRO
    int rp_ = 0; pro_again:
#endif
    if (PH_ON) { DEFPTRS
        for (int i = bx * 512 + tid; i < 5 * MTOK; i += G * 512) ROWSS[MTOK + i] = 0.f;
        LAS float* cact = (LAS float*)lds;
        LAS float* red = (LAS float*)(lds + 65536);
        for (int i = tid; i < 16 * 1024; i += 512) { const int b = i >> 10, k = i & 1023; const float v = c_in[i]; cact[k * 16 + b] = v * sigmoidf_(v); }
        __syncthreads();
        for (int task = bx; task < 288; task += G) {
            const int l = task / 144, n0 = (task % 144) * 64;
            float acc[16];
#pragma unroll
            for (int b = 0; b < 16; ++b) acc[b] = 0.f;
            const float* wp = w_ada + (size_t)l * 1024 * 9216 + n0 + lane;
#pragma unroll 1
            for (int k0 = wave * 128; k0 < wave * 128 + 128; k0 += 16) {
                float wv[16];
#pragma unroll
                for (int j = 0; j < 16; ++j) wv[j] = wp[(size_t)(k0 + j) * 9216];
                CFENCE();
#pragma unroll
                for (int j = 0; j < 16; ++j) { const int k = k0 + j; const float w = wv[j];
                    const f32x4 c0 = *(const LAS f32x4*)(cact + k * 16), c1 = *(const LAS f32x4*)(cact + k * 16 + 4), c2 = *(const LAS f32x4*)(cact + k * 16 + 8), c3 = *(const LAS f32x4*)(cact + k * 16 + 12);
#pragma unroll
                    for (int i = 0; i < 4; ++i) { acc[i] += c0[i] * w; acc[4 + i] += c1[i] * w; acc[8 + i] += c2[i] * w; acc[12 + i] += c3[i] * w; }
                    if ((j & 3) == 3) CFENCE(); }
            }
#pragma unroll
            for (int b = 0; b < 16; ++b) red[(wave * 16 + b) * 64 + lane] = acc[b];
            __syncthreads();
            for (int o = tid; o < 1024; o += 512) { const int b = o >> 6, ln = o & 63; float s = 0.f;
#pragma unroll
                for (int w = 0; w < 8; ++w) s += red[(w * 16 + b) * 64 + ln];
                MOD[((size_t)l * 16 + b) * 9216 + n0 + ln] = s + b_ada[l * 9216 + n0 + ln]; }
            __syncthreads();
        }
    }
    PH_NEXT;
    if (PH_ON) { DEFPTRS
        for (int i = bx * 512 + tid; i < 2 * 3 * 16 * 1024; i += G * 512) {
            const int k = i & 1023, b = (i >> 10) & 15, lj = i >> 14, l = lj / 3, j = lj % 3;
            const float* mp = MOD + ((size_t)l * 16 + b) * 9216 + j * 3072;
            GMOD[i] = g_norm[(l * 3 + j) * 1024 + k] * (1.0f + mp[1024 + k]);
            GATE[i] = (j == 1 ? 1.0f : 0.5f) * (1.0f + mp[2048 + k]);
        }
        LAS float* scr = (LAS float*)(lds + wave * 8448);
        constexpr int I_UP = 16 * 176, I_DN = 44 * 32, I_IN = 16 * 88, I_OUT = 16 * 32;
        constexpr int NIT = 4 * I_UP + 4 * I_DN + 2 * I_IN + 2 * I_OUT;
        for (int it = gw; it < NIT; it += NGW) {
            int r = it;
            if (r < 4 * I_UP) { const int mat = r / I_UP; r -= mat * I_UP; const int kb = r / 176, nb = r % 176, n0 = nb * 32;
                const int c0 = ((n0 >> 7) & 1) * DFF + (n0 >> 8) * 128 + (n0 & 127);
                transpose_item(w_up + (size_t)mat * DM * NUP, NUP, NUP, DM, WUP + (size_t)mat * NUP * DM, n0, c0, kb * 64, scr, lane); continue; }
            r -= 4 * I_UP;
            if (r < 4 * I_DN) { const int mat = r / I_DN; r -= mat * I_DN; const int kb = r / 32, nb = r % 32;
                transpose_item(w_dn + (size_t)mat * DFF * DM, DM, DM, DFF, WDN + (size_t)mat * DM * DFF, nb * 32, nb * 32, kb * 64, scr, lane); continue; }
            r -= 4 * I_DN;
            if (r < 2 * I_IN) { const int mat = r / I_IN; r -= mat * I_IN; const int kb = r / 88, nb = r % 88;
                transpose_item(w_in + (size_t)mat * DM * 2564, 2564, 2564, DM, WIN + (size_t)mat * NINP * DM, nb * 32, nb * 32, kb * 64, scr, lane); continue; }
            r -= 2 * I_IN;
            { const int mat = r / I_OUT; r -= mat * I_OUT; const int kb = r / 32, nb = r % 32;
                transpose_item(w_out + (size_t)mat * DM * DM, DM, DM, DM, WOUT + (size_t)mat * DM * DM, nb * 32, nb * 32, kb * 64, scr, lane); }
        }
        for (int m0 = gw; m0 < MTOK; m0 += 2 * NGW) {
            const int m1 = m0 + NGW;
            const f32x4* gp = (const f32x4*)(g_norm) + lane;
            const f32x4* xr0 = (const f32x4*)(x_in + (size_t)m0 * DM) + lane; const f32x4* xr1 = (const f32x4*)(x_in + (size_t)m1 * DM) + lane;
            f32x4 v0[4], v1[4];
#pragma unroll
            for (int j = 0; j < 4; ++j) { v0[j] = xr0[64 * j]; v1[j] = xr1[64 * j]; }
            const f32x4* sp0 = (const f32x4*)(MOD + (size_t)(m0 >> 12) * 9216 + 1024) + lane; const f32x4* sp1 = (const f32x4*)(MOD + (size_t)(m1 >> 12) * 9216 + 1024) + lane;
            float s0 = 0.f, s1 = 0.f; u32x2* o0 = (u32x2*)(XN + (size_t)m0 * DM) + lane; u32x2* o1 = (u32x2*)(XN + (size_t)m1 * DM) + lane;
#pragma unroll
            for (int j = 0; j < 4; ++j) { const f32x4 g = gp[64 * j];
                { const f32x4 v = v0[j]; s0 += (v[0] * v[0] + v[1] * v[1]) + (v[2] * v[2] + v[3] * v[3]); const f32x4 a = v * g * (sp0[64 * j] + 1.0f); u32x2 w; w.x = pk2(a[0], a[1]); w.y = pk2(a[2], a[3]); o0[64 * j] = w; }
                { const f32x4 v = v1[j]; s1 += (v[0] * v[0] + v[1] * v[1]) + (v[2] * v[2] + v[3] * v[3]); const f32x4 a = v * g * (sp1[64 * j] + 1.0f); u32x2 w; w.x = pk2(a[0], a[1]); w.y = pk2(a[2], a[3]); o1[64 * j] = w; } }
            s0 = wave_sum(s0); s1 = wave_sum(s1);
            if (lane == 0) { ROWSS[m0] = s0; ROWSS[m1] = s1; }
        }
    }
    PH_NEXT;
    if (PH_ON) { DEFPTRS
        LAS float* sh = (LAS float*)lds;
        for (int combo = 0; combo < 6; ++combo) {
            const int l = combo / 3, j = combo % 3;
            __syncthreads();
            for (int i = tid; i < 16 * 1024; i += 512) { const int b = i >> 10, k = i & 1023; sh[i] = MOD[((size_t)l * 16 + b) * 9216 + j * 3072 + k]; }
            __syncthreads();
            const bf16_t* Wt = (j == 1) ? WIN + (size_t)l * NINP * DM : WUP + (size_t)(l * 2 + (j == 2 ? 1 : 0)) * NUP * DM;
            const int N = (j == 1) ? NINP : NUP;
            float* dst = SBV + (size_t)combo * 16 * 5632;
            for (int n = gw; n < N; n += NGW) {
                float w[16];
#pragma unroll
                for (int c = 0; c < 4; ++c) { const u32x2 q = *(const u32x2*)(Wt + (size_t)n * DM + c * 256 + lane * 4);
                    w[4 * c] = __uint_as_float(q.x << 16); w[4 * c + 1] = __uint_as_float(q.x & 0xffff0000u); w[4 * c + 2] = __uint_as_float(q.y << 16); w[4 * c + 3] = __uint_as_float(q.y & 0xffff0000u); }
                float sv[16];
#pragma unroll
                for (int b = 0; b < 16; ++b) { float s = 0.f;
#pragma unroll
                    for (int c = 0; c < 4; ++c) { const f32x4 v = *(const LAS f32x4*)(sh + b * 1024 + c * 256 + lane * 4); s += (w[4 * c] * v[0] + w[4 * c + 1] * v[1]) + (w[4 * c + 2] * v[2] + w[4 * c + 3] * v[3]); }
                    sv[b] = s; if ((b & 3) == 3) CFENCE(); }
                float t8[8], t4[4], t2[2];
#pragma unroll
                for (int i = 0; i < 8; ++i) { const float snd = (lane & 32) ? sv[i] : sv[i + 8], kp = (lane & 32) ? sv[i + 8] : sv[i]; t8[i] = kp + __shfl_xor(snd, 32); }
#pragma unroll
                for (int i = 0; i < 4; ++i) { const float snd = (lane & 16) ? t8[i] : t8[i + 4], kp = (lane & 16) ? t8[i + 4] : t8[i]; t4[i] = kp + __shfl_xor(snd, 16); }
#pragma unroll
                for (int i = 0; i < 2; ++i) { const float snd = (lane & 8) ? t4[i] : t4[i + 2], kp = (lane & 8) ? t4[i + 2] : t4[i]; t2[i] = kp + __shfl_xor(snd, 8); }
                float t1; { const float snd = (lane & 4) ? t2[0] : t2[1], kp = (lane & 4) ? t2[1] : t2[0]; t1 = kp + __shfl_xor(snd, 4); }
                t1 += __shfl_xor(t1, 2); t1 += __shfl_xor(t1, 1);
                const int bsel = ((lane >> 5) & 1) * 8 + ((lane >> 4) & 1) * 4 + ((lane >> 3) & 1) * 2 + ((lane >> 2) & 1);
                if ((lane & 3) == 0) dst[(size_t)bsel * 5632 + n] = t1;
            }
        }
        __syncthreads();
    }
    PH_NEXT;

#ifdef REP_PRO
    if (rp_ == 0) { rp_ = 1; ph = 0; goto pro_again; }
#endif
#pragma unroll 1
    for (int f = 0; f < 4; ++f) {
        const int l = f >> 1, s = f & 1;
        if (s == 1) {
            if (PH_ON) { DEFPTRS
                pg8::Gemm g{XN, WIN + (size_t)l * NINP * DM, MTOK, NINP, DM}; pg8::StaticOrder S; S.init(MTOK, NINP, G, bx);
                pg8::EpiIn E{PROJ, FG, ROWSS + (size_t)(l * 3 + 1) * MTOK, SBV + (size_t)(l * 3 + 1) * 16 * 5632};
#ifndef NO_G_IN
                for (int rep_ = 0; rep_ < REP_IN; ++rep_) {
                pg8::gemm_phase<pg8::EpiIn, pg8::StaticOrder, true, true>(lds, g, S, E); }
#endif
            }
            PH_NEXT;
            if (PH_ON) { DEFPTRS
#ifndef NO_PREP
                {
                    const int blk = vcu & 7, n = lane & 31, hi = lane >> 5;
                    LAS unsigned char* wfl = lds;
                    LAS float* xs = (LAS float*)(lds + 16384 + wave * 13568);
                    LAS unsigned char* ub = lds + 16384 + wave * 13568 + 8960;
#pragma unroll
                    for (int q = 0; q < 2; ++q) { const int f = wave * 2 + q, gt = f >> 3, nb = (f >> 2) & 1, d0 = f & 3;
                        const float* wsrc = (gt ? w_ig : w_rg) + ((size_t)(l * 8 + blk) * 64 + 16 * d0 + 8 * hi) * 64 + nb * 32 + n;
                        u32x4 w; w.x = pk2(wsrc[0], wsrc[64]); w.y = pk2(wsrc[128], wsrc[192]); w.z = pk2(wsrc[256], wsrc[320]); w.w = pk2(wsrc[384], wsrc[448]);
                        *(LAS u32x4*)(wfl + f * 1024 + lane * 16) = w; }
                    __syncthreads();
                    float br[2], bi[2], cb[2], cw[2][4], c8[2];
#pragma unroll
                    for (int nb = 0; nb < 2; ++nb) { const int ch = blk * 64 + nb * 32 + n;
                        br[nb] = b_rg[l * 512 + ch]; bi[nb] = b_ig[l * 512 + ch]; cb[nb] = conv_b[l * 512 + ch];
#pragma unroll
                        for (int k = 0; k < 4; ++k) cw[nb][k] = conv_w[(l * 4 + k) * 512 + ch];
                        const float lmv = lam[l * 512 + ch];
                        c8[nb] = -8.0f * LOG2E * (__builtin_fmaxf(-lmv, 0.f) + log1pf(expf(-fabsf(lmv)))); }
                    for (int segi = (vcu >> 3) * 8 + wave; segi < REP_PREP * (MTOK / 32); segi += (G >> 3) * 8) { const int seg = segi & (MTOK / 32 - 1);
                        const int row0 = seg * 32; const bool first = (row0 & (SEQL - 1)) == 0;
                        const bf16_t* xp = PROJ + (size_t)row0 * PPITCH + blk * 64;
                        CFENCE();
#pragma unroll
                        for (int t = 0; t < 35; ++t) { float v = 0.f; if (t >= 3 || !first) v = bf2f((xp + ((long)t - 3) * PPITCH)[lane]); xs[t * 64 + lane] = v; }
                        CFENCE();
#pragma unroll
                        for (int nb = 0; nb < 2; ++nb)
#pragma unroll
                            for (int g = 0; g < 4; ++g) { const LAS float* xb = xs + (8 * g + 4 * hi) * 64 + nb * 32 + n; float xv[7];
#pragma unroll
                                for (int j = 0; j < 7; ++j) xv[j] = xb[j * 64];
#pragma unroll
                                for (int i = 0; i < 4; ++i) { const float uu = cb[nb] + cw[nb][0] * xv[i] + cw[nb][1] * xv[i + 1] + cw[nb][2] * xv[i + 2] + cw[nb][3] * xv[i + 3];
                                    *(LAS unsigned short*)(ub + (8 * g + 4 * hi + i) * 144 + (nb * 32 + n) * 2) = (unsigned short)f2bf(uu); }
                                __builtin_amdgcn_sched_barrier(0); }
                        CFENCE();
                        bf16x8 af[4];
#pragma unroll
                        for (int d0 = 0; d0 < 4; ++d0) af[d0] = *(const LAS bf16x8*)(ub + n * 144 + (16 * d0 + 8 * hi) * 2);
#pragma unroll
                        for (int nb = 0; nb < 2; ++nb) {
                            f32x16 arx, aix;
#pragma unroll
                            for (int r = 0; r < 16; ++r) { arx[r] = br[nb]; aix[r] = bi[nb]; }
#pragma unroll
                            for (int d0 = 0; d0 < 4; ++d0) { const bf16x8 w0 = *(const LAS bf16x8*)(wfl + ((0 * 2 + nb) * 4 + d0) * 1024 + lane * 16), w1 = *(const LAS bf16x8*)(wfl + ((1 * 2 + nb) * 4 + d0) * 1024 + lane * 16);
                                                             arx = __builtin_amdgcn_mfma_f32_32x32x16_bf16(af[d0], w0, arx, 0, 0, 0);
                                                             aix = __builtin_amdgcn_mfma_f32_32x32x16_bf16(af[d0], w1, aix, 0, 0, 0); }
                            CFENCE(); __builtin_amdgcn_sched_barrier(0);
#pragma unroll
                            for (int r = 0; r < 16; ++r) {
                                float uu; { const LAS float* xb = xs + (8 * (r >> 2) + 4 * hi + (r & 3)) * 64 + nb * 32 + n;
                                    uu = cb[nb] + cw[nb][0] * xb[0] + cw[nb][1] * xb[64] + cw[nb][2] * xb[128] + cw[nb][3] * xb[192]; }
                                const float rg = sigmoidf_(arx[r]), ig = sigmoidf_(aix[r]);
                                const float la2 = c8[nb] * rg, a = __builtin_amdgcn_exp2f(la2);
                                const float xx = 2.0f * 0.6931471805599453f * la2;
                                const float om = (xx > -0.25f) ? -xx * (1.0f + xx * 0.5f * (1.0f + xx * (1.0f / 3.0f) * (1.0f + xx * 0.25f * (1.0f + xx * 0.2f)))) : 1.0f - a * a;
                                arx[r] = a; aix[r] = __builtin_sqrtf(om) * ig * uu;
                            }
                            float H = 0.f, P = 1.f;
                            const int ch = blk * 64 + nb * 32 + n;
                            bf16_t* hl = HLOC + (size_t)(row0 + 4 * hi) * 512 + ch; bf16_t* pc = PCUM + (size_t)(row0 + 4 * hi) * 512 + ch;
#pragma unroll
                            for (int g = 0; g < 4; ++g) {
                                const float a0 = arx[4 * g], a1 = arx[4 * g + 1], a2 = arx[4 * g + 2], a3 = arx[4 * g + 3];
                                const float b0 = aix[4 * g], b1 = aix[4 * g + 1], b2 = aix[4 * g + 2], b3 = aix[4 * g + 3];
                                const float Ao = (a0 * a1) * (a2 * a3), Bo = ((b0 * a1 + b1) * a2 + b2) * a3 + b3;
                                const float Ap = __shfl_xor(Ao, 32), Bp = __shfl_xor(Bo, 32);
                                const float A1 = hi ? Ap : Ao, B1 = hi ? Bp : Bo, A2 = hi ? Ao : Ap, B2 = hi ? Bo : Bp;
                                const float Hm = A1 * H + B1, Pm = A1 * P;
                                float h = hi ? Hm : H, p = hi ? Pm : P;
                                H = A2 * Hm + B2; P = A2 * Pm;
                                bf16_t* hg = hl + (size_t)g * 8 * 512; bf16_t* pg = pc + (size_t)g * 8 * 512; asm volatile("" : "+v"(hg), "+v"(pg));
                                h = a0 * h + b0; p *= a0; hg[0 * 512] = (bf16_t)f2bf(h); pg[0 * 512] = (bf16_t)f2bf(p);
                                h = a1 * h + b1; p *= a1; hg[1 * 512] = (bf16_t)f2bf(h); pg[1 * 512] = (bf16_t)f2bf(p);
                                h = a2 * h + b2; p *= a2; hg[2 * 512] = (bf16_t)f2bf(h); pg[2 * 512] = (bf16_t)f2bf(p);
                                h = a3 * h + b3; p *= a3; hg[3 * 512] = (bf16_t)f2bf(h); pg[3 * 512] = (bf16_t)f2bf(p);
                            }
                            if (hi == 0) { ASEG[(size_t)seg * 512 + ch] = P; BSEG[(size_t)seg * 512 + ch] = H; }
                            CFENCE(); __builtin_amdgcn_sched_barrier(0);
                        }
                    }
                }
                for (int row = gw; row < MTOK; row += NGW) {
                    const u32x2 q = *(const u32x2*)(PROJ + (size_t)row * PPITCH + 2048 + lane * 4);
                    const float a0 = __uint_as_float(q.x << 16), a1 = __uint_as_float(q.x & 0xffff0000u), a2 = __uint_as_float(q.y << 16), a3 = __uint_as_float(q.y & 0xffff0000u);
                    float ss = (a0 * a0 + a1 * a1) + (a2 * a2 + a3 * a3);
                    ss += __shfl_xor(ss, 1); ss += __shfl_xor(ss, 2); ss += __shfl_xor(ss, 4); ss += __shfl_xor(ss, 8);
                    if ((lane & 15) == 0) KS[(size_t)((row >> 12) * 4 + (lane >> 4)) * SEQL + (row & (SEQL - 1))] = __builtin_amdgcn_rsqf(ss * (1.0f / 64.0f) + EPSF);
                }
                if (wave == 0) for (int chn = vcu; chn < 64; chn += G) {
                    const int b = chn >> 2, h = chn & 3; const float bf = b_fg[l * 4 + h];
                    const float* fp = FG + ((size_t)b * SEQL + lane * 64) * 4 + h;
                    float tot = 0.f;
#pragma unroll 8
                    for (int i = 0; i < 64; ++i) { const float v = fp[i * 4] + bf; tot += __builtin_fminf(v, 0.f) - log1pf(expf(-fabsf(v))); }
                    float inc = tot;
#pragma unroll
                    for (int o = 1; o < 64; o <<= 1) { const float t_ = __shfl_up(inc, o); if (lane >= o) inc += t_; }
                    float run = inc - tot;
                    float* op = F2 + (size_t)chn * SEQL + lane * 64;
#pragma unroll 8
                    for (int i = 0; i < 64; ++i) { const float v = fp[i * 4] + bf; run += __builtin_fminf(v, 0.f) - log1pf(expf(-fabsf(v))); op[i] = -run * LOG2E; }
                }
#endif
                __syncthreads();
            }
            PH_NEXT;
            if (PH_ON) { DEFPTRS
#ifndef NO_ATTN
                for (int rep_ = 0; rep_ < REP_ATTN; ++rep_)
                for (int vw = vcu; vw < 256; vw += G) {
                    const int bh = vw >> 2, s4 = vw & 3, b = bh >> 2, h = bh & 3;
#pragma unroll 1
                    for (int i = 0; i < 4; ++i) { const int qb = (i == 0) ? s4 : (i == 1) ? 7 - s4 : (i == 2) ? 8 + s4 : 15 - s4;
#ifndef NO_FOX
                        attn_unit<1>(lds, PROJ, YU, KS, F2, g_qk + l * 128, b, h, qb);
#endif
 }
#pragma unroll 1
                    for (int i = 0; i < 4; ++i) { const int qb = (i == 0) ? s4 : (i == 1) ? 7 - s4 : (i == 2) ? 8 + s4 : 15 - s4;
#ifndef NO_SB
                        attn_unit<0>(lds, PROJ, YU, KS, F2, g_qk + l * 128, b, h, qb);
#endif
 }
                }
#endif
            }
            PH_NEXT;
            if (PH_ON) { DEFPTRS
                LAS float* hin = (LAS float*)lds;
                const f32x4 gm0 = *(const f32x4*)(g_mix + l * 1024 + lane * 8), gm1 = *(const f32x4*)(g_mix + l * 1024 + lane * 8 + 4);
                const f32x4 gx0 = *(const f32x4*)(g_mix + l * 1024 + 512 + lane * 8), gx1 = *(const f32x4*)(g_mix + l * 1024 + 512 + lane * 8 + 4);
                for (int tti = vcu; tti < REP_FIN * 256; tti += G) { const int tt = tti & 255;
                    __syncthreads();
                    { const int ch = tid, seg0 = (tt >> 4) * 128, nb = (tt & 15) * 8; float Hc = 0.f;
#pragma unroll 8
                      for (int sg = 0; sg < nb; ++sg) Hc = ASEG[(size_t)(seg0 + sg) * 512 + ch] * Hc + BSEG[(size_t)(seg0 + sg) * 512 + ch];
#pragma unroll
                      for (int s8 = 0; s8 < 8; ++s8) { hin[s8 * 512 + ch] = Hc; Hc = ASEG[(size_t)(seg0 + nb + s8) * 512 + ch] * Hc + BSEG[(size_t)(seg0 + nb + s8) * 512 + ch]; } }
                    __syncthreads();
                    const f32x4 hi0 = *(const LAS f32x4*)(hin + wave * 512 + lane * 8), hi1 = *(const LAS f32x4*)(hin + wave * 512 + lane * 8 + 4);
#pragma unroll 2
                    for (int t = 0; t < 32; ++t) {
                        const size_t row = (size_t)tt * 256 + wave * 32 + t;
                        const u32x4 hq = *(const u32x4*)(HLOC + row * 512 + lane * 8);
                        const u32x4 pq = *(const u32x4*)(PCUM + row * 512 + lane * 8);
                        const u32x4 gq = *(const u32x4*)(PROJ + row * PPITCH + 512 + lane * 8);
                        const u32x4 yq = *(const u32x4*)(YU + row * 512 + lane * 8);
                        float y[8], yu[8]; float ss = 0.f, s2 = 0.f;
#pragma unroll
                        for (int i = 0; i < 8; ++i) {
                            const unsigned pw = pq[i >> 1], gw_ = gq[i >> 1], yw = yq[i >> 1];
                            const float p = (i & 1) ? __uint_as_float(pw & 0xffff0000u) : __uint_as_float(pw << 16);
                            const float gg = (i & 1) ? __uint_as_float(gw_ & 0xffff0000u) : __uint_as_float(gw_ << 16);
                            yu[i] = (i & 1) ? __uint_as_float(yw & 0xffff0000u) : __uint_as_float(yw << 16);
                            const unsigned hw = hq[i >> 1]; const float hlv = (i & 1) ? __uint_as_float(hw & 0xffff0000u) : __uint_as_float(hw << 16);
                            const float hh = hlv + p * (i < 4 ? hi0[i & 3] : hi1[i & 3]);
                            const float inner = 0.7978845608028654f * (gg + 0.044715f * gg * gg * gg);
                            const float ge = gg * __builtin_amdgcn_rcpf(1.0f + __builtin_amdgcn_exp2f(-2.0f * LOG2E * inner));
                            y[i] = hh * ge; ss += y[i] * y[i]; s2 += yu[i] * yu[i];
                        }
                        ss = wave_sum(ss);
                        s2 += __shfl_xor(s2, 1); s2 += __shfl_xor(s2, 2); s2 += __shfl_xor(s2, 4); s2 += __shfl_xor(s2, 8); s2 += __shfl_xor(s2, 16);
                        const float rl = __builtin_amdgcn_rsqf(ss * (1.0f / 512.0f) + EPSF), rx = __builtin_amdgcn_rsqf(s2 * (1.0f / 256.0f) + EPSF);
                        u32x4 o1, o2;
                        o1.x = pk2(y[0] * rl * gm0[0], y[1] * rl * gm0[1]); o1.y = pk2(y[2] * rl * gm0[2], y[3] * rl * gm0[3]);
                        o1.z = pk2(y[4] * rl * gm1[0], y[5] * rl * gm1[1]); o1.w = pk2(y[6] * rl * gm1[2], y[7] * rl * gm1[3]);
                        o2.x = pk2(yu[0] * rx * gx0[0], yu[1] * rx * gx0[1]); o2.y = pk2(yu[2] * rx * gx0[2], yu[3] * rx * gx0[3]);
                        o2.z = pk2(yu[4] * rx * gx1[0], yu[5] * rx * gx1[1]); o2.w = pk2(yu[6] * rx * gx1[2], yu[7] * rx * gx1[3]);
                        *(u32x4*)(YN + row * 1024 + lane * 8) = o1; *(u32x4*)(YN + row * 1024 + 512 + lane * 8) = o2;
                    }
                }
                __syncthreads();
            }
            PH_NEXT;
            if (PH_ON) { DEFPTRS
                pg8::Gemm g{YN, WOUT + (size_t)l * DM * DM, MTOK, DM, DM}; pg8::StaticOrder S; S.init(MTOK, DM, G, bx);
                pg8::EpiRes E{xout, xout, GATE + (size_t)(l * 3 + 1) * 16 * 1024, GMOD + (size_t)(l * 3 + 2) * 16 * 1024, XN, ROWSS + (size_t)(l * 3 + 2) * MTOK, 1};
#ifndef NO_G_OUT
#ifdef REP_OUT
                { E.xout = (float*)HB; E.has_next = 0; pg8::gemm_phase<pg8::EpiRes, pg8::StaticOrder, true, true>(lds, g, S, E); E.xout = xout; E.has_next = 1; }
#endif
                pg8::gemm_phase<pg8::EpiRes, pg8::StaticOrder, true, true>(lds, g, S, E);
#endif
            }
            PH_NEXT;
        }
        const int j = s ? 2 : 0;
        if (PH_ON) { DEFPTRS
            pg8::Gemm g{XN, WUP + (size_t)(l * 2 + s) * NUP * DM, MTOK, NUP, DM}; pg8::StaticOrder S; S.init(MTOK, NUP, G, bx);
            pg8::EpiUp E{HB, ROWSS + (size_t)(l * 3 + j) * MTOK, SBV + (size_t)(l * 3 + j) * 16 * 5632};
#ifndef NO_G_UP
            for (int rep_ = 0; rep_ < REP_UP; ++rep_) {
            pg8::gemm_phase<pg8::EpiUp, pg8::StaticOrder, true, true>(lds, g, S, E);
            }
#endif
        }
        PH_NEXT;
        if (PH_ON) { DEFPTRS
            const int nl = s ? l + 1 : l, nj = s ? 0 : 1; const int has_next = (nl < 2) ? 1 : 0; const int nidx = has_next ? nl * 3 + nj : 0;
            pg8::Gemm g{HB, WDN + (size_t)(l * 2 + s) * DM * DFF, MTOK, DM, DFF}; pg8::StaticOrder S; S.init(MTOK, DM, G, bx);
            pg8::EpiRes E{f == 0 ? x_in : xout, xout, GATE + (size_t)(l * 3 + j) * 16 * 1024, GMOD + (size_t)nidx * 16 * 1024, XN, ROWSS + (size_t)nidx * MTOK, has_next};
#ifndef NO_G_DN
#ifdef REP_DN
            for (int rep_ = 0; rep_ < 2; ++rep_) { E.xout = (rep_ == 0) ? (float*)HLOC : xout; E.has_next = (rep_ == 0) ? 0 : has_next;
            pg8::gemm_phase<pg8::EpiRes, pg8::StaticOrder, true, true>(lds, g, S, E); }
#else
            pg8::gemm_phase<pg8::EpiRes, pg8::StaticOrder, true, true>(lds, g, S, E);
#endif
#endif
        }
        PH_NEXT;
    }
#undef PH_ON
#undef PH_NEXT
}


#ifdef DBG_STOP
__global__ void dbg_dump(const unsigned char* ws, float* out, int mode) {
    const size_t n = (size_t)MTOK * DM; const size_t i0 = (size_t)blockIdx.x * blockDim.x + threadIdx.x, st = (size_t)gridDim.x * blockDim.x;
    const bf16_t* XN = (const bf16_t*)(ws + WS_XN); const bf16_t* HB = (const bf16_t*)(ws + WS_H); const bf16_t* PR = (const bf16_t*)(ws + WS_PROJ);
    const bf16_t* YU = (const bf16_t*)(ws + WS_YU); const float* HL = (const float*)(ws + WS_HLOC); const bf16_t* YN = (const bf16_t*)(ws + WS_YN); const bf16_t* PC = (const bf16_t*)(ws + WS_PCUM);
    for (size_t i = i0; i < n; i += st) {
        float v = 0.f;
        if (mode == 0) v = bf2f(XN[i]);
        else if (mode == 1) v = bf2f(HB[i]) + bf2f(HB[i + n]) + bf2f(HB[i + (size_t)117440512]);
        else if (mode == 2) v = bf2f(PR[i]) + bf2f(PR[i + n]) + bf2f(PR[i + (size_t)100663296]);
        else if (mode == 3) v = (i < n / 2) ? bf2f(YU[i]) : HL[i - n / 2];
        else if (mode == 4) v = bf2f(YN[i]);
        else if (mode == 6) v = (i < n / 2) ? bf2f(PC[i]) : ((const float*)(ws + WS_KS))[(i - n / 2) % (3 * 262144)];
        else if (mode == 7) v = HL[i % (n / 2)] + bf2f(PC[i % (n / 2)]) + ((const float*)(ws + WS_KS))[i % (3 * 262144)] + ((const float*)(ws + WS_ASEG))[i % (2 * 1048576)];
        if (mode == 3) { const bool nan_ = !(v == v), big = (v > 3e38f) || (v < -3e38f); float code = 0.f;
            if (i < n / 2) { const int col = (int)(i & 511); if (col < 256) code = nan_ ? 2000.f : (big ? 1000.f : 0.f); else code = (nan_ || big) ? 4000.f : 0.f; }
            else code = (nan_ || big) ? 8000.f : 0.f;
            v = code; }
        if (!(v == v)) v = 77777.f; if (v > 3e38f) v = 88888.f; if (v < -3e38f) v = 99999.f;
        if (mode != 5) out[i] = v;
    }
}
#endif
#ifndef MK_N_LAUNCHES
#define MK_N_LAUNCHES 1
#endif
constexpr int N_PHASES = 3 + 2 * 9;
extern "C" void kernel_launch(void* const* d_in, const int* in_sizes, int n_in, void* d_out, int out_size, void* d_ws, size_t ws_size, hipStream_t stream) {
    static int grid = 0;
    if (grid == 0) {
        if (n_in != 19 || out_size != MTOK * DM || ws_size < WS_END) { fprintf(stderr, "kernel_launch: unexpected shapes (n_in %d, out %d, ws %zu)\n", n_in, out_size, ws_size); grid = -1; return; }
        int dev = 0, cus = 0, per_cu = 0;
        hipGetDevice(&dev); hipDeviceGetAttribute(&cus, hipDeviceAttributeMultiprocessorCount, dev);
        if (hipFuncSetAttribute((const void*)mk_fwd, hipFuncAttributeMaxDynamicSharedMemorySize, LDS_BYTES) != hipSuccess) { fprintf(stderr, "kernel_launch: hipFuncSetAttribute failed\n"); grid = -1; return; }
        if (hipOccupancyMaxActiveBlocksPerMultiprocessor(&per_cu, (const void*)mk_fwd, 512, LDS_BYTES) != hipSuccess || per_cu < 1) { fprintf(stderr, "kernel_launch: occupancy query says %d\n", per_cu); per_cu = 1; }
        (void)hipGetLastError();
        grid = cus * 1;
    }
    if (grid < 0) return;
    if (hipMemsetAsync(d_ws, 0, 16384, stream) != hipSuccess) { fprintf(stderr, "kernel_launch: memset failed\n"); return; }
    Args a{};
    for (int i = 0; i < 19; ++i) a.in[i] = (const float*)d_in[i];
    a.out = (float*)d_out; a.ws = (unsigned char*)d_ws;
#if MK_N_LAUNCHES == 1
    a.ph_lo = 0; a.ph_hi = N_PHASES;
    void* kargs[] = {&a};
    hipError_t e = hipLaunchCooperativeKernel((const void*)mk_fwd, dim3(grid), dim3(512), kargs, LDS_BYTES, stream);
    if (e != hipSuccess) fprintf(stderr, "kernel_launch: cooperative launch failed: %s (grid %d)\n", hipGetErrorString(e), grid);
#else
#ifdef DBG_STOP
    for (int p = 0; p < DBG_STOP; ++p) { a.ph_lo = p; a.ph_hi = p + 1; hipLaunchKernelGGL(mk_fwd, dim3(grid), dim3(512), LDS_BYTES, stream, a); }
    hipLaunchKernelGGL(dbg_dump, dim3(2048), dim3(256), 0, stream, (const unsigned char*)d_ws, (float*)d_out, DBG_MODE);
#else
    for (int p = 0; p < N_PHASES; ++p) { a.ph_lo = p; a.ph_hi = p + 1; hipLaunchKernelGGL(mk_fwd, dim3(grid), dim3(512), LDS_BYTES, stream, a); }
#endif
#endif
}
```

```cpp
#include <hip/hip_runtime.h>
#include <hip/hip_cooperative_groups.h>
#include <cstdio>
#include <cstdint>
namespace cg = cooperative_groups;
namespace pg8 {
#define PG8_LAS __attribute__((address_space(3)))
typedef unsigned short bf16_t;
typedef short bf16x8 __attribute__((ext_vector_type(8)));
typedef float f32x4 __attribute__((ext_vector_type(4)));
typedef unsigned u32x4 __attribute__((ext_vector_type(4)));
constexpr int BM = 256, BK = 64, HALF = 128, HTB = HALF * BK * 2  , STAGE_BYTES = 8 * HTB, NXCD = 8, WGM = 8;

__host__ __device__ __forceinline__ int lds_byte(int r, int c) { const int st = (r >> 4) * 2 + (c >> 5), rr = r & 15, cc = c & 31, ob = rr * 64 + cc * 2; return st * 1024 + (ob ^ (((ob >> 9) & 1) << 5)); }
__host__ __device__ __forceinline__ void stage_rc(int b, int& R, int& C) { const int st = b / 1024, sb = b % 1024, swz = sb ^ (((sb >> 9) & 1) << 5); R = (st >> 1) * 16 + swz / 64; C = (st & 1) * 32 + (swz % 64) / 2; }
__host__ __device__ __forceinline__ int perm32(int rho) { const int n = rho >> 4, i = rho & 15; return 8 * (i >> 2) + 4 * n + (i & 3); }

struct Unit { int pm, pn; };
struct Gemm { const bf16_t* A; const bf16_t* Bt; int M, N, K; };

struct StaticOrder {
    int nM, nN, nwg, G, c, rev;
    __host__ __device__ void init(int M, int N, int G_, int c_, int rev_ = 0) { nM = M / BM; nN = N / BM; nwg = nM * nN; G = G_; c = c_; rev = rev_; }
    __host__ __device__ bool next(int i, Unit& u) const {
        const long L = (long)i * G + c; if (L >= nwg) return false;
        int wgid = (int)L; { const int q = nwg / NXCD, r = nwg % NXCD, xcd = wgid % NXCD, off = wgid / NXCD; wgid = (xcd < r ? xcd * (q + 1) : r * (q + 1) + (xcd - r) * q) + off; }
        const int nig = WGM * nN, gid = wgid / nig, fm = gid * WGM, gsz = (nM - fm) < WGM ? (nM - fm) : WGM;
        u.pm = (fm + ((wgid % nig) % gsz)) ^ rev; u.pn = (wgid % nig) / gsz; return true;
    }
    __device__ __forceinline__ void a_ready(const Unit&) const {}
    __device__ __forceinline__ void done(const Unit&) const {}
};

typedef float f32x2c_t __attribute__((ext_vector_type(2))); typedef __bf16 bf16x2c_t __attribute__((ext_vector_type(2)));
__device__ __forceinline__ unsigned cvt_pk_bf16(float lo, float hi) { f32x2c_t v = {lo, hi}; bf16x2c_t b = __builtin_convertvector(v, bf16x2c_t); return __builtin_bit_cast(unsigned, b); }
typedef float f32x2 __attribute__((ext_vector_type(2)));
constexpr float RMS_EPS = 1e-6f;
struct EpiUp {
    static constexpr bool PERM = true, AFTER_DRAIN = false;
    bf16_t* H; const float* rowss; const float* sb;
    __device__ __forceinline__ void operator()(const f32x4 (&acc)[2][2][4][2], const Unit& u, int wr, int wc, int fr, int fq) const {
        const int row0 = u.pm * BM + wr * 64 + fr, b = u.pm >> 4, cl = wc * 32 + 8 * fq;
        const float* sbp = sb + (size_t)b * 5632 + u.pn * 256 + cl;
        float rsv[2][4];
#pragma unroll
        for (int ai = 0; ai < 2; ++ai)
#pragma unroll
            for (int m = 0; m < 4; ++m) rsv[ai][m] = rowss[row0 + ai * HALF + m * 16];
        f32x4 sg[2], su[2];
#pragma unroll
        for (int n = 0; n < 2; ++n) { sg[n] = *(const f32x4*)(sbp + 4 * n); su[n] = *(const f32x4*)(sbp + 128 + 4 * n); }
#pragma unroll
        for (int ai = 0; ai < 2; ++ai)
#pragma unroll
            for (int m = 0; m < 4; ++m) {
                const int row = row0 + ai * HALF + m * 16;
                const float rs = __builtin_amdgcn_rsqf(rsv[ai][m] * (1.0f / 1024.0f) + RMS_EPS);
                unsigned wq[4];
#pragma unroll
                for (int n = 0; n < 2; ++n)
#pragma unroll
                    for (int ip = 0; ip < 2; ++ip) {
                        const f32x2 ag = (f32x2){acc[ai][0][m][n][2 * ip], acc[ai][0][m][n][2 * ip + 1]}, au = (f32x2){acc[ai][1][m][n][2 * ip], acc[ai][1][m][n][2 * ip + 1]};
                        const f32x2 g = ag * rs + (f32x2){sg[n][2 * ip], sg[n][2 * ip + 1]}, uu = au * rs + (f32x2){su[n][2 * ip], su[n][2 * ip + 1]};
                        const f32x2 t = g * (-1.4426950408889634f);
                        f32x2 d; d.x = __builtin_amdgcn_exp2f(t.x); d.y = __builtin_amdgcn_exp2f(t.y); d = d + 1.0f;
                        f32x2 r; r.x = __builtin_amdgcn_rcpf(d.x); r.y = __builtin_amdgcn_rcpf(d.y);
                        const f32x2 hv = (g * uu) * r;
                        wq[n * 2 + ip] = cvt_pk_bf16(hv.x, hv.y);
                    }
                u32x4 w; w.x = wq[0]; w.y = wq[1]; w.z = wq[2]; w.w = wq[3];
                *(u32x4*)(H + (size_t)row * 2816 + u.pn * 128 + cl) = w;
            }
    }
};
struct EpiIn {
    static constexpr bool PERM = true, AFTER_DRAIN = false;
    bf16_t* P; float* FG; const float* rowss; const float* sb;
    __device__ __forceinline__ void operator()(const f32x4 (&acc)[2][2][4][2], const Unit& u, int wr, int wc, int fr, int fq) const {
        const int row0 = u.pm * BM + wr * 64 + fr, b = u.pm >> 4, cl = wc * 32 + 8 * fq;
        const float* sbp = sb + (size_t)b * 5632 + u.pn * 256 + cl;
        float rsv[2][4];
#pragma unroll
        for (int ai = 0; ai < 2; ++ai)
#pragma unroll
            for (int m = 0; m < 4; ++m) rsv[ai][m] = rowss[row0 + ai * HALF + m * 16];
        f32x4 sv[2][2];
#pragma unroll
        for (int bj = 0; bj < 2; ++bj)
#pragma unroll
            for (int n = 0; n < 2; ++n) sv[bj][n] = *(const f32x4*)(sbp + bj * HALF + 4 * n);
#pragma unroll
        for (int ai = 0; ai < 2; ++ai)
#pragma unroll
            for (int m = 0; m < 4; ++m) {
                const int row = row0 + ai * HALF + m * 16;
                const float rs = __builtin_amdgcn_rsqf(rsv[ai][m] * (1.0f / 1024.0f) + RMS_EPS);
                if (u.pn < 10) {
#pragma unroll
                    for (int bj = 0; bj < 2; ++bj) {
                        const f32x4 v0 = acc[ai][bj][m][0] * rs + sv[bj][0], v1 = acc[ai][bj][m][1] * rs + sv[bj][1];
                        u32x4 w; w.x = cvt_pk_bf16(v0[0], v0[1]); w.y = cvt_pk_bf16(v0[2], v0[3]); w.z = cvt_pk_bf16(v1[0], v1[1]); w.w = cvt_pk_bf16(v1[2], v1[3]);
                        *(u32x4*)(P + (size_t)row * 2560 + u.pn * 256 + bj * HALF + cl) = w;
                    }
                } else if (wc == 0 && fq == 0) {
                    *(f32x4*)(FG + (size_t)row * 4) = acc[ai][0][m][0] * rs + sv[0][0];
                }
            }
    }
};
struct EpiRes {
    static constexpr bool PERM = false, AFTER_DRAIN = false;
    const float* xin; float* xout; const float* gate; const float* gmn; bf16_t* XN; float* rowssn; int has_next;
    __device__ __forceinline__ void operator()(const f32x4 (&acc)[2][2][4][2], const Unit& u, int wr, int wc, int fr, int fq) const {
        typedef unsigned u32x2v __attribute__((ext_vector_type(2)));
        const int row0 = u.pm * BM + wr * 64 + fr, b = u.pm >> 4, col0 = u.pn * BM + wc * 32 + 4 * fq;
        const float* gp_ = gate + b * 1024 + col0; const float* gm_ = gmn + b * 1024 + col0;
#pragma unroll
        for (int ai = 0; ai < 2; ++ai) {
            f32x4 xi[4][2][2];
#pragma unroll
            for (int m = 0; m < 4; ++m)
#pragma unroll
                for (int bj = 0; bj < 2; ++bj)
#pragma unroll
                    for (int n = 0; n < 2; ++n) xi[m][bj][n] = *(const f32x4*)(xin + (size_t)(row0 + ai * HALF + m * 16) * 1024 + col0 + bj * HALF + n * 16);
            asm volatile("" ::: "memory");
#pragma unroll
            for (int m = 0; m < 4; ++m) {
                const int row = row0 + ai * HALF + m * 16; const size_t off = (size_t)row * 1024 + col0;
                float ss = 0.f;
#pragma unroll
                for (int bj = 0; bj < 2; ++bj)
#pragma unroll
                    for (int n = 0; n < 2; ++n) {
                        const f32x4 xo = xi[m][bj][n] + *(const f32x4*)(gp_ + bj * HALF + n * 16) * acc[ai][bj][m][n];
                        *(f32x4*)(xout + off + bj * HALF + n * 16) = xo;
                        if (has_next) {
                            ss += (xo[0] * xo[0] + xo[1] * xo[1]) + (xo[2] * xo[2] + xo[3] * xo[3]);
                            const f32x4 a = xo * *(const f32x4*)(gm_ + bj * HALF + n * 16); u32x2v w; w.x = cvt_pk_bf16(a[0], a[1]); w.y = cvt_pk_bf16(a[2], a[3]);
                            *(u32x2v*)(XN + off + bj * HALF + n * 16) = w;
                        }
                    }
                if (has_next) { ss += __shfl_xor(ss, 16); ss += __shfl_xor(ss, 32); if (fq == 0) unsafeAtomicAdd(rowssn + row, ss); }
            }
            asm volatile("" ::: "memory");
        }
    }
};

template <class Epi, class Sched, bool ALIGN_EPI = false, bool SP2 = false>
__device__ __forceinline__ void gemm_phase(PG8_LAS unsigned char* lds, const Gemm g, const Sched& S, const Epi& E) {
    int tid_o = threadIdx.x; asm volatile("" : "+v"(tid_o)); const int tid = tid_o, wid = __builtin_amdgcn_readfirstlane(tid >> 6), lane = tid & 63, wr = wid >> 2, wc = wid & 3, fr = lane & 15, fq = lane >> 4;
    const int K = g.K, nt = K / BK;
    unsigned voffA[2], voffB[2];
#pragma unroll
    for (int i = 0; i < 2; ++i) { int R, C; stage_rc(tid * 16 + i * 8192, R, C); const int Rb = Epi::PERM ? ((R & ~31) + perm32(R & 31)) : R;
        voffA[i] = (unsigned)(R * K + C) * 2u; voffB[i] = (unsigned)(Rb * K + C) * 2u; }
    const size_t kstep = (size_t)(BK * 2);
    const size_t hstep = (size_t)HALF * K * 2;
    const size_t tstep = 2 * hstep;
    const unsigned ldsw = (unsigned)wid * 1024u;
    const int aoff = lds_byte(wr * 64 + fr, fq * 8), boff = lds_byte(wc * 32 + fr, fq * 8);
#define PG8_SA(b, h) (((b) * 2 + (h)) * HTB)
#define PG8_SB(b, h) ((4 + (b) * 2 + (h)) * HTB)
#define PG8_STAGE(bufoff, gbase, voff) do { _Pragma("unroll") for (int _i = 0; _i < 2; ++_i) \
        __builtin_amdgcn_global_load_lds((const unsigned*)((const char*)(gbase) + (voff)[_i]), (PG8_LAS unsigned*)(lds + (bufoff) + ldsw + _i * 8192), 16, 0, 0); } while (0)
#define PG8_LDA(dst, b, h) do { _Pragma("unroll") for (int m = 0; m < 4; ++m) _Pragma("unroll") for (int k = 0; k < 2; ++k) dst[m][k] = *(const PG8_LAS bf16x8*)(lds + PG8_SA(b, h) + aoff + m * 2048 + k * 1024); } while (0)
#define PG8_LDB(dst, b, h) do { _Pragma("unroll") for (int n = 0; n < 2; ++n) _Pragma("unroll") for (int k = 0; k < 2; ++k) dst[n][k] = *(const PG8_LAS bf16x8*)(lds + PG8_SB(b, h) + boff + n * 2048 + k * 1024); } while (0)
#define PG8_MMA(ai, bj, At, Bt) do { __builtin_amdgcn_s_setprio(1); _Pragma("unroll") for (int m = 0; m < 4; ++m) _Pragma("unroll") for (int n = 0; n < 2; ++n) _Pragma("unroll") for (int k = 0; k < 2; ++k) \
        acc[ai][bj][m][n] = __builtin_amdgcn_mfma_f32_16x16x32_bf16(Bt[n][k], At[m][k], acc[ai][bj][m][n], 0, 0, 0); __builtin_amdgcn_s_setprio(0); } while (0)
#define PG8_WAIT_V(n) asm volatile("s_waitcnt vmcnt(" #n ")" ::: "memory")
#define PG8_WAIT_L(n) asm volatile("s_waitcnt lgkmcnt(" #n ")" ::: "memory")
#define PG8_BAR __builtin_amdgcn_s_barrier()
#define PG8_SCHED __builtin_amdgcn_sched_barrier(0)
    Unit cur, nxt; int ui = 0;
    if (!S.next(0, cur)) return;
    f32x4 acc[2][2][4][2];
#pragma unroll
    for (int a = 0; a < 2; ++a)
#pragma unroll
        for (int b = 0; b < 2; ++b)
#pragma unroll
            for (int m = 0; m < 4; ++m)
#pragma unroll
                for (int n = 0; n < 2; ++n) acc[a][b][m][n] = (f32x4){0.f, 0.f, 0.f, 0.f};
    bf16x8 At[4][2], B0[2][2], B1[2][2];
    const char* cA = (const char*)g.A + (size_t)cur.pm * tstep; const char* cB = (const char*)g.Bt + (size_t)cur.pn * tstep;
    S.a_ready(cur);
    if constexpr (SP2) {
        PG8_STAGE(PG8_SB(0, 0), cB, voffB); PG8_STAGE(PG8_SB(0, 1), cB + hstep, voffB); PG8_STAGE(PG8_SA(0, 0), cA, voffA); PG8_STAGE(PG8_SA(0, 1), cA + hstep, voffA);
        if (wr == 1) PG8_BAR;
        PG8_WAIT_V(2); PG8_BAR;
        PG8_STAGE(PG8_SB(1, 0), cB + kstep, voffB); PG8_STAGE(PG8_SA(1, 0), cA + kstep, voffA); PG8_STAGE(PG8_SB(1, 1), cB + hstep + kstep, voffB);
        PG8_WAIT_V(6); PG8_BAR;
    } else {
        PG8_STAGE(PG8_SB(0, 0), cB, voffB); PG8_STAGE(PG8_SA(0, 0), cA, voffA); PG8_STAGE(PG8_SB(0, 1), cB + hstep, voffB); PG8_STAGE(PG8_SA(0, 1), cA + hstep, voffA);
        if (wr == 1) PG8_BAR;
        PG8_WAIT_V(4); PG8_BAR;
        PG8_STAGE(PG8_SB(1, 0), cB + kstep, voffB); PG8_STAGE(PG8_SA(1, 0), cA + kstep, voffA); PG8_STAGE(PG8_SB(1, 1), cB + hstep + kstep, voffB);
        PG8_WAIT_V(6); PG8_BAR;
    }
    for (;;) {
        const bool has_next = S.next(ui + 1, nxt);
        const char* nA = has_next ? (const char*)g.A + (size_t)nxt.pm * tstep : cA; const char* nB = has_next ? (const char*)g.Bt + (size_t)nxt.pn * tstep : cB;
        for (int t = 0; t < nt; t += 2) {
            const bool last = (t == nt - 2);
            const char* a1 = cA + (size_t)(t + 1) * kstep;
            const char* a2 = last ? nA : cA + (size_t)(t + 2) * kstep; const char* b2 = last ? nB : cB + (size_t)(t + 2) * kstep;
            const char* a3 = a2 + kstep; const char* b3 = b2 + kstep;
            if (last && has_next) S.a_ready(nxt);
            if constexpr (SP2) {
            PG8_LDB(B0, 0, 0); PG8_LDB(B1, 0, 1); PG8_SCHED; PG8_LDA(At, 0, 0); PG8_STAGE(PG8_SA(1, 1), a1 + hstep, voffA);
            PG8_WAIT_V(8); PG8_WAIT_L(0); PG8_BAR; PG8_MMA(0, 0, At, B0); PG8_MMA(0, 1, At, B1); PG8_BAR; PG8_SCHED;
            PG8_LDA(At, 0, 1); PG8_STAGE(PG8_SB(0, 0), b2, voffB); PG8_STAGE(PG8_SB(0, 1), b2 + hstep, voffB); PG8_STAGE(PG8_SA(0, 0), a2, voffA);
            PG8_WAIT_V(8); PG8_WAIT_L(0); PG8_BAR; PG8_MMA(1, 0, At, B0); PG8_MMA(1, 1, At, B1); PG8_BAR; PG8_SCHED;
            PG8_LDB(B0, 1, 0); PG8_LDB(B1, 1, 1); PG8_SCHED; PG8_LDA(At, 1, 0); PG8_STAGE(PG8_SA(0, 1), a2 + hstep, voffA);
            PG8_WAIT_V(8); PG8_WAIT_L(0); PG8_BAR; PG8_MMA(0, 0, At, B0); PG8_MMA(0, 1, At, B1); PG8_BAR; PG8_SCHED;
            PG8_LDA(At, 1, 1); PG8_STAGE(PG8_SB(1, 0), b3, voffB); PG8_STAGE(PG8_SB(1, 1), b3 + hstep, voffB); PG8_STAGE(PG8_SA(1, 0), a3, voffA);
            PG8_WAIT_V(8); PG8_WAIT_L(0); PG8_BAR; PG8_MMA(1, 0, At, B0); PG8_MMA(1, 1, At, B1); PG8_BAR; PG8_SCHED;
            } else {
            PG8_LDB(B0, 0, 0); PG8_SCHED; PG8_LDA(At, 0, 0); PG8_STAGE(PG8_SA(1, 1), a1 + hstep, voffA);
            PG8_WAIT_L(8); PG8_BAR; PG8_WAIT_L(0); PG8_MMA(0, 0, At, B0); PG8_BAR; PG8_SCHED;
            PG8_LDB(B1, 0, 1); PG8_STAGE(PG8_SB(0, 0), b2, voffB);
            PG8_BAR; PG8_WAIT_L(0); PG8_MMA(0, 1, At, B1); PG8_BAR;
            PG8_LDA(At, 0, 1); PG8_STAGE(PG8_SA(0, 0), a2, voffA);
            PG8_BAR; PG8_WAIT_L(0); PG8_MMA(1, 0, At, B0); PG8_BAR; PG8_SCHED;
            PG8_STAGE(PG8_SB(0, 1), b2 + hstep, voffB);
            PG8_WAIT_V(6); PG8_BAR; PG8_MMA(1, 1, At, B1); PG8_BAR;
            PG8_LDB(B0, 1, 0); PG8_SCHED; PG8_LDA(At, 1, 0); PG8_STAGE(PG8_SA(0, 1), a2 + hstep, voffA);
            PG8_WAIT_L(8); PG8_BAR; PG8_WAIT_L(0); PG8_MMA(0, 0, At, B0); PG8_BAR; PG8_SCHED;
            PG8_LDB(B1, 1, 1); PG8_STAGE(PG8_SB(1, 0), b3, voffB);
            PG8_BAR; PG8_WAIT_L(0); PG8_MMA(0, 1, At, B1); PG8_BAR;
            PG8_LDA(At, 1, 1); PG8_STAGE(PG8_SA(1, 0), a3, voffA);
            PG8_BAR; PG8_WAIT_L(0); PG8_MMA(1, 0, At, B0); PG8_BAR; PG8_SCHED;
            PG8_STAGE(PG8_SB(1, 1), b3 + hstep, voffB);
            PG8_WAIT_V(6); PG8_BAR; PG8_MMA(1, 1, At, B1); PG8_BAR;
            }
        }
        if constexpr (ALIGN_EPI) { if (wr == 0) PG8_BAR; }
        if constexpr (!Epi::AFTER_DRAIN) { E(acc, cur, wr, wc, fr, fq); S.done(cur); }
        if (!has_next) break;
#pragma unroll
        for (int a = 0; a < 2; ++a)
#pragma unroll
            for (int b = 0; b < 2; ++b)
#pragma unroll
                for (int m = 0; m < 4; ++m)
#pragma unroll
                    for (int n = 0; n < 2; ++n) acc[a][b][m][n] = (f32x4){0.f, 0.f, 0.f, 0.f};
        cur = nxt; cA = nA; cB = nB; ++ui;
        if constexpr (ALIGN_EPI) { if (wr == 1) PG8_BAR; }
    }
    PG8_WAIT_V(0);
    if constexpr (!ALIGN_EPI) { if (wr == 0) PG8_BAR; }
    PG8_BAR;
    if constexpr (Epi::AFTER_DRAIN) { E.fused(acc, cur, wr, wc, fr, fq, lds, wid, lane); S.done(cur); }
#undef PG8_SA
#undef PG8_SB
#undef PG8_STAGE
#undef PG8_LDA
#undef PG8_LDB
#undef PG8_MMA
#undef PG8_WAIT_V
#undef PG8_WAIT_L
#undef PG8_BAR
#undef PG8_SCHED
}
}

#define LAS __attribute__((address_space(3)))
typedef unsigned short bf16_t;
typedef short bf16x8 __attribute__((ext_vector_type(8)));
typedef short s16x4 __attribute__((ext_vector_type(4)));
typedef float f32x4 __attribute__((ext_vector_type(4)));
typedef float f32x2 __attribute__((ext_vector_type(2)));
typedef float f32x16 __attribute__((ext_vector_type(16)));
typedef unsigned u32x4 __attribute__((ext_vector_type(4)));
typedef unsigned u32x2 __attribute__((ext_vector_type(2)));

constexpr int MTOK = 65536, DM = 1024, DFF = 2816, NUP = 5632, NINP = 2816, PPITCH = 2560, SEQL = 4096;
constexpr float EPSF = 1e-6f, LOG2E = 1.4426950408889634f;
constexpr size_t MiB = 1u << 20;
constexpr size_t WS_MOD = 1 * MiB, WS_GMOD = 3 * MiB, WS_GATE = 4 * MiB, WS_SB = 5 * MiB, WS_ROWSS = 8 * MiB, WS_KS = 10 * MiB, WS_F2 = 11 * MiB, WS_FG = 12 * MiB,
                 WS_ASEG = 13 * MiB, WS_BSEG = 17 * MiB, WS_WUP = 24 * MiB, WS_WDN = 68 * MiB, WS_WIN = 90 * MiB, WS_WOUT = 101 * MiB, WS_XN = 112 * MiB,
                 WS_H = 240 * MiB, WS_PROJ = 240 * MiB, WS_YU = 592 * MiB, WS_HLOC = 656 * MiB, WS_PCUM = 784 * MiB, WS_YN = 848 * MiB, WS_END = 976 * MiB;
constexpr int LDS_BYTES = 147456;

__device__ __forceinline__ float bf2f(unsigned short v) { return __uint_as_float((unsigned)v << 16); }
__device__ __forceinline__ unsigned f2bf(float f) { unsigned u = __float_as_uint(f); return (u + 0x7fffu + ((u >> 16) & 1u)) >> 16; }
__device__ __forceinline__ unsigned pk2(float lo, float hi) { return pg8::cvt_pk_bf16(lo, hi); }
__device__ __forceinline__ float wave_sum(float v) {
#pragma unroll
    for (int o = 1; o < 64; o <<= 1) v += __shfl_xor(v, o);
    return v;
}
__device__ __forceinline__ float sigmoidf_(float x) { return __builtin_amdgcn_rcpf(1.0f + __builtin_amdgcn_exp2f(-LOG2E * x)); }
#define WAITV(n) asm volatile("s_waitcnt vmcnt(" #n ")" ::: "memory")
#define LBAR() asm volatile("s_waitcnt lgkmcnt(0)\n\ts_barrier" ::: "memory")
#define CFENCE() asm volatile("" ::: "memory")

#ifndef REP_FIN
#define REP_FIN 1
#endif
#ifndef REP_IN
#define REP_IN 1
#endif
#ifndef REP_PREP
#define REP_PREP 1
#endif
#ifndef REP_ATTN
#define REP_ATTN 1
#endif
#ifndef REP_UP
#define REP_UP 1
#endif
struct Args { const float* in[19]; float* out; unsigned char* ws; int ph_lo, ph_hi; };

__device__ __forceinline__ void transpose_item(const float* __restrict__ W, int ldw, int clim, int K, bf16_t* __restrict__ WT, int n0, int c0, int k0, LAS float* scr, int lane) {
    const int col = c0 + (lane & 31);
#pragma unroll 16
    for (int i = 0; i < 32; ++i) { const int kk = 2 * i + (lane >> 5); scr[kk * 33 + (lane & 31)] = (col < clim) ? W[(size_t)(k0 + kk) * ldw + col] : 0.f; }
    asm volatile("s_waitcnt lgkmcnt(0)" ::: "memory");
    const int c = lane & 7;
#pragma unroll
    for (int j = 0; j < 4; ++j) { const int n = (lane >> 3) + 8 * j; const LAS float* s = scr + (8 * c) * 33 + n;
        u32x4 o; o.x = pk2(s[0 * 33], s[1 * 33]); o.y = pk2(s[2 * 33], s[3 * 33]); o.z = pk2(s[4 * 33], s[5 * 33]); o.w = pk2(s[6 * 33], s[7 * 33]);
        *(u32x4*)(WT + (size_t)(n0 + n) * K + k0 + 8 * c) = o; }
    asm volatile("s_waitcnt lgkmcnt(0)" ::: "memory");
}

__device__ __forceinline__ int crow(int r, int hi) { return (r & 3) + 8 * (r >> 2) + 4 * hi; }
__device__ __forceinline__ s16x4 vtr(const LAS unsigned char* p) {
    typedef short v4i16_t __attribute__((ext_vector_type(4)));
    return __builtin_bit_cast(s16x4, __builtin_amdgcn_ds_read_tr16_b64_v4i16((LAS v4i16_t*)p));
}
constexpr int AT_SLOT = 16384, AT_AUX = 3 * AT_SLOT, AT_WSF = AT_AUX + 3 * 512, AT_VOTE = AT_WSF + 8 * 256;
constexpr float C2 = 0.125f * LOG2E;

__device__ __forceinline__ void sb_block(f32x16& X, float& carry, bool band, int kv0  , int qrel, int hi) {
    float lm[16];
#pragma unroll
    for (int r = 0; r < 16; ++r) {
        float z2 = X[r] * C2; z2 = __builtin_fminf(__builtin_fmaxf(z2, -120.f), 120.f);
        const float e = __builtin_amdgcn_exp2f(-z2), sp = __builtin_amdgcn_logf(1.0f + e);
        float l1 = -(sp + z2), lb = -sp;
        if (band) { const int kv = kv0 + (r & 3) + 8 * (r >> 2); const bool valid = kv < qrel; l1 = valid ? l1 : 0.f; lb = valid ? lb : -INFINITY; }
        lm[r] = l1; X[r] = lb;
    }
    float G[4], Gp[4], T[4];
#pragma unroll
    for (int g = 0; g < 4; ++g) { G[g] = (lm[4 * g] + lm[4 * g + 1]) + (lm[4 * g + 2] + lm[4 * g + 3]); Gp[g] = __shfl_xor(G[g], 32); T[g] = G[g] + Gp[g]; }
    float S = carry;
#pragma unroll
    for (int g = 3; g >= 0; --g) {
        const float a3 = S + (hi == 0 ? Gp[g] : 0.f), a2 = a3 + lm[4 * g + 3], a1 = a2 + lm[4 * g + 2], a0 = a1 + lm[4 * g + 1];
        X[4 * g + 3] = __builtin_amdgcn_exp2f(X[4 * g + 3] + a3); X[4 * g + 2] = __builtin_amdgcn_exp2f(X[4 * g + 2] + a2);
        X[4 * g + 1] = __builtin_amdgcn_exp2f(X[4 * g + 1] + a1); X[4 * g] = __builtin_amdgcn_exp2f(X[4 * g] + a0);
        S += T[g];
    }
    carry = S;
}

template <int KIND>
__device__ __forceinline__ void attn_unit(LAS unsigned char* lds, const bf16_t* __restrict__ PROJ, bf16_t* __restrict__ YU, const float* __restrict__ KS,
                                          const float* __restrict__ F2, const float* __restrict__ gqk, int b, int h, int qb) {
    int tid_o = threadIdx.x; asm volatile("" : "+v"(tid_o));
    const int tid = tid_o, lane = tid & 63, r32 = lane & 31, hi = lane >> 5;
    const int wid = __builtin_amdgcn_readfirstlane(tid >> 6);
    const int qcol = (KIND == 0 ? 1024 : 1792) + h * 64, kcol = qcol + 256, vcol = qcol + 512;
    const size_t rowbase = (size_t)b * SEQL; const int q0 = qb * 256, bh = b * 4 + h;
    const int NT = (q0 + 256) / 64;
    const bf16_t* ksrc = PROJ + (rowbase + lane) * PPITCH + kcol + wid * 8;
    const bf16_t* vsrc = PROJ + (rowbase + 16 * (wid & 3) + (lane >> 2)) * PPITCH + vcol + (wid >> 2) * 32 + (lane & 3) * 8;
    const float* axsrc = (wid == 0 ? KS : F2) + (size_t)bh * SEQL + lane;
    u32x4 kreg, vreg; float areg = 0.f;
#define AT_LOAD(it_) do { const int kt_ = NT - 1 - (it_); kreg = *(const u32x4*)(ksrc + (size_t)kt_ * 64 * PPITCH); vreg = *(const u32x4*)(vsrc + (size_t)kt_ * 64 * PPITCH); \
        if (KIND == 1 && wid < 2) areg = axsrc[kt_ * 64]; } while (0)
#define AT_STORE(slot_) do { *(LAS u32x4*)(lds + (slot_) * AT_SLOT + wid * 1024 + lane * 16) = kreg; *(LAS u32x4*)(lds + (slot_) * AT_SLOT + 8192 + wid * 1024 + lane * 16) = vreg; \
        if (KIND == 1 && wid < 2) *(LAS float*)(lds + AT_AUX + (slot_) * 512 + wid * 256 + lane * 4) = areg; } while (0)
    const bf16_t* Qw = PROJ + (rowbase + q0 + wid * 32 + r32) * PPITCH + qcol + hi * 8;
    bf16x8 qr[4];
#pragma unroll
    for (int d0 = 0; d0 < 4; ++d0) qr[d0] = *(const bf16x8*)(Qw + d0 * 16);
    AT_LOAD(0);
    if (KIND == 1) {
        float qf[4][8]; float ss = 0.f;
#pragma unroll
        for (int d0 = 0; d0 < 4; ++d0)
#pragma unroll
            for (int i = 0; i < 8; ++i) { qf[d0][i] = bf2f((unsigned short)qr[d0][i]); ss += qf[d0][i] * qf[d0][i]; }
        ss += __shfl_xor(ss, 32);
        const float rs = __builtin_amdgcn_rsqf(ss * (1.0f / 64.0f) + EPSF) * C2;
#pragma unroll
        for (int d0 = 0; d0 < 4; ++d0) {
            const float* gp = gqk + d0 * 16 + hi * 8; float v[8];
#pragma unroll
            for (int i = 0; i < 8; ++i) v[i] = qf[d0][i] * rs * gp[i] * gp[64 + i];
            u32x4 w; w.x = pk2(v[0], v[1]); w.y = pk2(v[2], v[3]); w.z = pk2(v[4], v[5]); w.w = pk2(v[6], v[7]);
            qr[d0] = __builtin_bit_cast(bf16x8, w);
        }
    }
    f32x16 o0, o1;
#pragma unroll
    for (int r = 0; r < 16; ++r) { o0[r] = 0.f; o1[r] = 0.f; }
    float mhat = -1e30f, lsum = 0.f, carry = 0.f;
    LAS float* wsf = (LAS float*)(lds + AT_WSF) + wid * 64;
    LAS unsigned* votes = (LAS unsigned*)(lds + AT_VOTE);
    const int qrel = wid * 32 + r32;
    bool wdone = false;
    AT_STORE(0); LBAR();
    for (int it = 0; it < NT; ++it) {
        const int slot = it & 1;
        if (KIND == 0 && it > 0) {
            const LAS unsigned* vp = votes + ((it - 1) & 1) * 8;
            const unsigned all = vp[0] & vp[1] & vp[2] & vp[3] & vp[4] & vp[5] & vp[6] & vp[7];
            if (all) break;
        }
        if (it + 1 < NT) AT_LOAD(it + 1);
        const int kt = NT - 1 - it, jb = kt - (NT - 4);
        const bool band = jb >= 0;
        const bool active = !(band && 64 * jb > 32 * wid + 31) && !wdone;
        if (active) {
            f32x16 p0, p1;
            __builtin_amdgcn_s_setprio(1);
            { const LAS unsigned char* kb = lds + slot * AT_SLOT + hi * 1024 + r32 * 16;
#pragma unroll
              for (int d0 = 0; d0 < 4; ++d0) {
                  const bf16x8 b0 = *(const LAS bf16x8*)(kb + d0 * 2048), b1 = *(const LAS bf16x8*)(kb + d0 * 2048 + 512);
                  if (d0 == 0) { f32x16 z;
#pragma unroll
                      for (int r = 0; r < 16; ++r) z[r] = 0.f;
                      p0 = __builtin_amdgcn_mfma_f32_32x32x16_bf16(b0, qr[0], z, 0, 0, 0); p1 = __builtin_amdgcn_mfma_f32_32x32x16_bf16(b1, qr[0], z, 0, 0, 0); }
                  else { p0 = __builtin_amdgcn_mfma_f32_32x32x16_bf16(b0, qr[d0], p0, 0, 0, 0); p1 = __builtin_amdgcn_mfma_f32_32x32x16_bf16(b1, qr[d0], p1, 0, 0, 0); }
              } }
            __builtin_amdgcn_s_setprio(0);
            if (KIND == 0) {
                sb_block(p1, carry, band, 64 * jb + 32 + 4 * hi, qrel, hi);
                sb_block(p0, carry, band, 64 * jb + 4 * hi, qrel, hi);
            } else {
                const LAS float* ax = (const LAS float*)(lds + AT_AUX + slot * 512);
#pragma unroll
                for (int g = 0; g < 4; ++g) {
                    const f32x4 k0 = *(const LAS f32x4*)(ax + 8 * g + 4 * hi), k1 = *(const LAS f32x4*)(ax + 32 + 8 * g + 4 * hi);
                    const f32x4 f0 = *(const LAS f32x4*)(ax + 64 + 8 * g + 4 * hi), f1 = *(const LAS f32x4*)(ax + 96 + 8 * g + 4 * hi);
#pragma unroll
                    for (int i = 0; i < 4; ++i) { p0[4 * g + i] = p0[4 * g + i] * k0[i] + f0[i]; p1[4 * g + i] = p1[4 * g + i] * k1[i] + f1[i]; }
                }
                if (band) {
#pragma unroll
                    for (int r = 0; r < 16; ++r) { const int kv = 64 * jb + crow(r, hi); if (kv > qrel) p0[r] = -INFINITY; if (kv + 32 > qrel) p1[r] = -INFINITY; }
                }
                float rm = __builtin_fmaxf(p0[0], p1[0]), rm2 = __builtin_fmaxf(p0[1], p1[1]);
#pragma unroll
                for (int r = 2; r < 16; r += 2) { rm = __builtin_fmaxf(__builtin_fmaxf(rm, p0[r]), p1[r]); rm2 = __builtin_fmaxf(__builtin_fmaxf(rm2, p0[r + 1]), p1[r + 1]); }
                rm = __builtin_fmaxf(rm, rm2);
                rm = __builtin_fmaxf(rm, __shfl_xor(rm, 32));
                if (__any(rm > mhat + 8.0f)) {
                    const float mnew = __builtin_fmaxf(mhat, rm), f = __builtin_amdgcn_exp2f(mhat - mnew);
                    lsum *= f; mhat = mnew;
                    CFENCE(); if (hi == 0) wsf[r32] = f; CFENCE();
                    asm volatile("s_waitcnt lgkmcnt(0)" ::: "memory");
#pragma unroll
                    for (int r = 0; r < 16; ++r) { const float fr_ = wsf[crow(r, hi)]; o0[r] *= fr_; o1[r] *= fr_; }
                    CFENCE();
                }
                f32x2 sacc2 = (f32x2){0.f, 0.f};
#pragma unroll
                for (int r = 0; r < 16; r += 2) {
                    const f32x2 a0 = (f32x2){p0[r], p0[r + 1]} - mhat, a1 = (f32x2){p1[r], p1[r + 1]} - mhat;
                    p0[r] = __builtin_amdgcn_exp2f(a0[0]); p0[r + 1] = __builtin_amdgcn_exp2f(a0[1]); p1[r] = __builtin_amdgcn_exp2f(a1[0]); p1[r + 1] = __builtin_amdgcn_exp2f(a1[1]);
                    sacc2 += (f32x2){p0[r], p0[r + 1]}; sacc2 += (f32x2){p1[r], p1[r + 1]};
                }
                lsum += sacc2[0] + sacc2[1];
            }
            u32x4 pw0, pw1, pw2, pw3;
            pw0.x = pk2(p0[0], p0[1]); pw0.y = pk2(p0[2], p0[3]); pw0.z = pk2(p0[4], p0[5]); pw0.w = pk2(p0[6], p0[7]);
            pw1.x = pk2(p0[8], p0[9]); pw1.y = pk2(p0[10], p0[11]); pw1.z = pk2(p0[12], p0[13]); pw1.w = pk2(p0[14], p0[15]);
            pw2.x = pk2(p1[0], p1[1]); pw2.y = pk2(p1[2], p1[3]); pw2.z = pk2(p1[4], p1[5]); pw2.w = pk2(p1[6], p1[7]);
            pw3.x = pk2(p1[8], p1[9]); pw3.y = pk2(p1[10], p1[11]); pw3.z = pk2(p1[12], p1[13]); pw3.w = pk2(p1[14], p1[15]);
            const LAS unsigned char* vb = lds + slot * AT_SLOT + 8192 + ((lane >> 4) & 1) * 32 + (lane & 3) * 8 + (4 * hi + ((lane & 15) >> 2)) * 64;
            s16x4 vlo[8], vhi[8];
#pragma unroll
            for (int i = 0; i < 8; ++i) { vlo[i] = vtr(vb + (i >> 2) * 4096 + (i & 3) * 1024); vhi[i] = vtr(vb + (i >> 2) * 4096 + (i & 3) * 1024 + 512); }
#define VFR(i) (bf16x8){vlo[i][0], vlo[i][1], vlo[i][2], vlo[i][3], vhi[i][0], vhi[i][1], vhi[i][2], vhi[i][3]}
#define PAF(x) __builtin_bit_cast(bf16x8, x)
            __builtin_amdgcn_s_setprio(1);
            o0 = __builtin_amdgcn_mfma_f32_32x32x16_bf16(PAF(pw0), VFR(0), o0, 0, 0, 0); o1 = __builtin_amdgcn_mfma_f32_32x32x16_bf16(PAF(pw0), VFR(4), o1, 0, 0, 0);
            o0 = __builtin_amdgcn_mfma_f32_32x32x16_bf16(PAF(pw1), VFR(1), o0, 0, 0, 0); o1 = __builtin_amdgcn_mfma_f32_32x32x16_bf16(PAF(pw1), VFR(5), o1, 0, 0, 0);
            o0 = __builtin_amdgcn_mfma_f32_32x32x16_bf16(PAF(pw2), VFR(2), o0, 0, 0, 0); o1 = __builtin_amdgcn_mfma_f32_32x32x16_bf16(PAF(pw2), VFR(6), o1, 0, 0, 0);
            o0 = __builtin_amdgcn_mfma_f32_32x32x16_bf16(PAF(pw3), VFR(3), o0, 0, 0, 0); o1 = __builtin_amdgcn_mfma_f32_32x32x16_bf16(PAF(pw3), VFR(7), o1, 0, 0, 0);
            __builtin_amdgcn_s_setprio(0);
#undef VFR
#undef PAF
        }
        if (KIND == 0) { if (active) wdone = __all(carry < -150.0f); if (lane == 0) votes[(it & 1) * 8 + wid] = wdone ? 1u : 0u; }
        if (it + 1 < NT) AT_STORE(slot ^ 1);
        LBAR();
    }
    if (KIND == 1) { lsum += __shfl_xor(lsum, 32); CFENCE(); if (hi == 0) wsf[r32] = lsum; CFENCE(); asm volatile("s_waitcnt lgkmcnt(0)" ::: "memory"); }
    bf16_t* Yw = YU + (rowbase + q0 + wid * 32) * 512 + KIND * 256 + h * 64 + r32;
#pragma unroll
    for (int r = 0; r < 16; ++r) {
        const int orow = crow(r, hi); float sc = 1.0f;
        if (KIND == 1) sc = __builtin_amdgcn_rcpf(wsf[orow]);
        Yw[(size_t)orow * 512] = (bf16_t)f2bf(o0[r] * sc); Yw[(size_t)orow * 512 + 32] = (bf16_t)f2bf(o1[r] * sc);
    }
    LBAR();
#undef AT_LOAD
#undef AT_STORE
}

#define DEFPTRS \
    const __attribute__((address_space(4))) Args* ka_ = (const __attribute__((address_space(4))) Args*)__builtin_amdgcn_kernarg_segment_ptr(); \
    asm volatile("" : "+s"(ka_)); \
    int tid_o_ = threadIdx.x; asm volatile("" : "+v"(tid_o_)); const int tid = tid_o_, lane = tid & 63; (void)lane; \
    unsigned char* ws = ka_->ws; \
    const float* x_in = ka_->in[0]; const float* c_in = ka_->in[1]; const float* w_ada = ka_->in[2]; const float* b_ada = ka_->in[3]; const float* g_norm = ka_->in[4]; \
    const float* w_up = ka_->in[5]; const float* w_dn = ka_->in[6]; const float* w_in = ka_->in[7]; const float* b_fg = ka_->in[8]; const float* conv_w = ka_->in[9]; \
    const float* conv_b = ka_->in[10]; const float* w_rg = ka_->in[11]; const float* b_rg = ka_->in[12]; const float* w_ig = ka_->in[13]; const float* b_ig = ka_->in[14]; \
    const float* lam = ka_->in[15]; const float* g_qk = ka_->in[16]; const float* g_mix = ka_->in[17]; const float* w_out = ka_->in[18]; \
    float* xout = ka_->out; \
    float* MOD = (float*)(ws + WS_MOD); float* GMOD = (float*)(ws + WS_GMOD); float* GATE = (float*)(ws + WS_GATE); float* SBV = (float*)(ws + WS_SB); \
    float* ROWSS = (float*)(ws + WS_ROWSS); float* KS = (float*)(ws + WS_KS); float* F2 = (float*)(ws + WS_F2); float* FG = (float*)(ws + WS_FG); \
    float* ASEG = (float*)(ws + WS_ASEG); float* BSEG = (float*)(ws + WS_BSEG); \
    bf16_t* WUP = (bf16_t*)(ws + WS_WUP); bf16_t* WDN = (bf16_t*)(ws + WS_WDN); bf16_t* WIN = (bf16_t*)(ws + WS_WIN); bf16_t* WOUT = (bf16_t*)(ws + WS_WOUT); \
    bf16_t* XN = (bf16_t*)(ws + WS_XN); bf16_t* HB = (bf16_t*)(ws + WS_H); bf16_t* PROJ = (bf16_t*)(ws + WS_PROJ); bf16_t* YU = (bf16_t*)(ws + WS_YU); \
    bf16_t* HLOC = (bf16_t*)(ws + WS_HLOC); bf16_t* PCUM = (bf16_t*)(ws + WS_PCUM); bf16_t* YN = (bf16_t*)(ws + WS_YN);
#define XB_TMO      128
#define XB_XCNT(j)  (256  + 64 * (j))
#define XB_XSUB(j)  (1280 + 64 * (j))
#define XB_XGEN(j)  (2304 + 64 * (j))
#define XB_TOP      3328
#define XB_TOPGEN   3392
#define XCD_BAR_WORDS 3456
#define XB_SPIN_CAP (1u << 18)

__device__ __forceinline__ unsigned xb_ld(unsigned* p)              { return __hip_atomic_load(p, __ATOMIC_RELAXED, __HIP_MEMORY_SCOPE_AGENT); }
__device__ __forceinline__ unsigned xb_add(unsigned* p, unsigned v) { return __hip_atomic_fetch_add(p, v, __ATOMIC_RELAXED, __HIP_MEMORY_SCOPE_AGENT); }
__device__ __forceinline__ unsigned xb_xcc_id() { return (unsigned)__builtin_amdgcn_s_getreg((3 << 11) | 20) & 0xFu; }
#define XB_SPIN(cond, bar) do { unsigned _sp = 0; while (cond) { __builtin_amdgcn_s_sleep(1); \
    if ((++_sp & 255u) == 0u) { if (xb_ld(&(bar)[XB_TMO])) break; if (_sp > XB_SPIN_CAP) { atomicAdd(&(bar)[XB_TMO], 1u); break; } } } } while (0)

struct XcdBarrier {
    unsigned* bar; unsigned x;
    volatile LAS unsigned* st;
};

__device__ __forceinline__ XcdBarrier xcd_barrier_post(unsigned* bar, volatile LAS unsigned* st) {
    XcdBarrier b; b.bar = bar; b.x = xb_xcc_id(); b.st = st;
    if (threadIdx.x == 0) (void)xb_add(&bar[XB_XCNT(b.x)], 1u);
    return b;
}
__device__ __forceinline__ void xcd_barrier_complete(unsigned* bar, unsigned x, unsigned& nloc, unsigned& nx) {
    const unsigned G = gridDim.x * gridDim.y * gridDim.z;
    unsigned sum, cnt, mine, sp = 0u;
    for (;;) {
        sum = 0u; cnt = 0u; mine = 0u;
#pragma unroll
        for (unsigned j = 0; j < 16; ++j) { const unsigned c = xb_ld(&bar[XB_XCNT(j)]); sum += c; cnt += (c > 0u) ? 1u : 0u; mine = (j == x) ? c : mine; }
        if (sum == G) break;
        __builtin_amdgcn_s_sleep(1);
        if ((++sp & 255u) == 0u) { if (xb_ld(&bar[XB_TMO])) break; if (sp > XB_SPIN_CAP) { atomicAdd(&bar[XB_TMO], 1u); break; } }
    }
    nloc = mine > 0u ? mine : 1u; nx = cnt > 0u ? cnt : 1u;
}

__device__ __forceinline__ void xcd_barrier(const XcdBarrier& b) {
    asm volatile("s_waitcnt vmcnt(0)" ::: "memory");
    __syncthreads();
    if (threadIdx.x == 0) {
        unsigned* bar = b.bar;
        __builtin_amdgcn_s_waitcnt(0);
        unsigned nloc = b.st[0], nx = b.st[1];
        if (nloc == 0u) { xcd_barrier_complete(bar, b.x, nloc, nx); b.st[0] = nloc; b.st[1] = nx; }
        const unsigned old = xb_add(&bar[XB_XSUB(b.x)], 1u);
        const unsigned gen = old / nloc;
        if (old + 1u == (gen + 1u) * nloc) {
            __builtin_amdgcn_fence(__ATOMIC_RELEASE, "agent");
            asm volatile("s_waitcnt vmcnt(0)" ::: "memory");
            const unsigned og = xb_add(&bar[XB_TOP], 1u);
            const unsigned tg = og / nx;
            if (og + 1u == (tg + 1u) * nx) xb_add(&bar[XB_TOPGEN], 1u);
            else XB_SPIN(xb_ld(&bar[XB_TOPGEN]) == tg, bar);
            __builtin_amdgcn_fence(__ATOMIC_ACQUIRE, "agent");
            xb_add(&bar[XB_XGEN(b.x)], 1u);
            asm volatile("s_waitcnt vmcnt(0)" ::: "memory");
        } else {
            XB_SPIN(xb_ld(&bar[XB_XGEN(b.x)]) == gen, bar);
            __builtin_amdgcn_fence(__ATOMIC_ACQUIRE, "agent");
            asm volatile("s_waitcnt vmcnt(0)" ::: "memory");
        }
    }
    __syncthreads();
}

__global__ void __launch_bounds__(512) mk_fwd(Args args) {
    extern __shared__ __attribute__((aligned(16))) unsigned char lds_raw[];
    LAS unsigned char* lds = (LAS unsigned char*)lds_raw;
    cg::grid_group grid = cg::this_grid();
    const int wave = __builtin_amdgcn_readfirstlane(threadIdx.x >> 6);
    const int G = gridDim.x; const int bx = blockIdx.x;
    const int vcu = (G % 8 == 0) ? (bx % 8) * (G / 8) + bx / 8 : bx;
    const int gw = vcu * 8 + wave, NGW = G * 8;
    const int lo = args.ph_lo, hi_ph = args.ph_hi;
    volatile LAS unsigned* MISC = (volatile LAS unsigned*)(lds + 131072 + 320);
    if (threadIdx.x < 16) MISC[threadIdx.x] = 0u;
    __syncthreads();
    XcdBarrier xbar = xcd_barrier_post((unsigned*)args.ws, MISC + 8);
    int ph = 0;
#define PH_ON (ph >= lo && ph < hi_ph)
#ifdef REP_SYNC
#define SYNC_EXTRA grid.sync(); asm volatile("" ::: "memory");
#else
#define SYNC_EXTRA
#endif
#define PH_NEXT do { ++ph; if (ph > lo && ph < hi_ph) { asm volatile("s_waitcnt vmcnt(0) lgkmcnt(0)" ::: "memory"); if (ph == 1) grid.sync(); else xcd_barrier(xbar); asm volatile("" ::: "memory"); SYNC_EXTRA } } while (0)

#ifdef REP_PRO
    int rp_ = 0; pro_again:
#endif
    if (PH_ON) { DEFPTRS
        for (int i = bx * 512 + tid; i < 5 * MTOK; i += G * 512) ROWSS[MTOK + i] = 0.f;
        LAS float* cact = (LAS float*)lds;
        LAS float* red = (LAS float*)(lds + 65536);
        for (int i = tid; i < 16 * 1024; i += 512) { const int b = i >> 10, k = i & 1023; const float v = c_in[i]; cact[k * 16 + b] = v * sigmoidf_(v); }
        __syncthreads();
        for (int task = bx; task < 288; task += G) {
            const int l = task / 144, n0 = (task % 144) * 64;
            float acc[16];
#pragma unroll
            for (int b = 0; b < 16; ++b) acc[b] = 0.f;
            const float* wp = w_ada + (size_t)l * 1024 * 9216 + n0 + lane;
#pragma unroll 1
            for (int k0 = wave * 128; k0 < wave * 128 + 128; k0 += 16) {
                float wv[16];
#pragma unroll
                for (int j = 0; j < 16; ++j) wv[j] = wp[(size_t)(k0 + j) * 9216];
                CFENCE();
#pragma unroll
                for (int j = 0; j < 16; ++j) { const int k = k0 + j; const float w = wv[j];
                    const f32x4 c0 = *(const LAS f32x4*)(cact + k * 16), c1 = *(const LAS f32x4*)(cact + k * 16 + 4), c2 = *(const LAS f32x4*)(cact + k * 16 + 8), c3 = *(const LAS f32x4*)(cact + k * 16 + 12);
#pragma unroll
                    for (int i = 0; i < 4; ++i) { acc[i] += c0[i] * w; acc[4 + i] += c1[i] * w; acc[8 + i] += c2[i] * w; acc[12 + i] += c3[i] * w; }
                    if ((j & 3) == 3) CFENCE(); }
            }
#pragma unroll
            for (int b = 0; b < 16; ++b) red[(wave * 16 + b) * 64 + lane] = acc[b];
            __syncthreads();
            for (int o = tid; o < 1024; o += 512) { const int b = o >> 6, ln = o & 63; float s = 0.f;
#pragma unroll
                for (int w = 0; w < 8; ++w) s += red[(w * 16 + b) * 64 + ln];
                MOD[((size_t)l * 16 + b) * 9216 + n0 + ln] = s + b_ada[l * 9216 + n0 + ln]; }
            __syncthreads();
        }
    }
    PH_NEXT;
    if (PH_ON) { DEFPTRS
        for (int i = bx * 512 + tid; i < 2 * 3 * 16 * 1024; i += G * 512) {
            const int k = i & 1023, b = (i >> 10) & 15, lj = i >> 14, l = lj / 3, j = lj % 3;
            const float* mp = MOD + ((size_t)l * 16 + b) * 9216 + j * 3072;
            GMOD[i] = g_norm[(l * 3 + j) * 1024 + k] * (1.0f + mp[1024 + k]);
            GATE[i] = (j == 1 ? 1.0f : 0.5f) * (1.0f + mp[2048 + k]);
        }
        LAS float* scr = (LAS float*)(lds + wave * 8448);
        constexpr int I_UP = 16 * 176, I_DN = 44 * 32, I_IN = 16 * 88, I_OUT = 16 * 32;
        constexpr int NIT = 4 * I_UP + 4 * I_DN + 2 * I_IN + 2 * I_OUT;
        for (int it = gw; it < NIT; it += NGW) {
            int r = it;
            if (r < 4 * I_UP) { const int mat = r / I_UP; r -= mat * I_UP; const int kb = r / 176, nb = r % 176, n0 = nb * 32;
                const int c0 = ((n0 >> 7) & 1) * DFF + (n0 >> 8) * 128 + (n0 & 127);
                transpose_item(w_up + (size_t)mat * DM * NUP, NUP, NUP, DM, WUP + (size_t)mat * NUP * DM, n0, c0, kb * 64, scr, lane); continue; }
            r -= 4 * I_UP;
            if (r < 4 * I_DN) { const int mat = r / I_DN; r -= mat * I_DN; const int kb = r / 32, nb = r % 32;
                transpose_item(w_dn + (size_t)mat * DFF * DM, DM, DM, DFF, WDN + (size_t)mat * DM * DFF, nb * 32, nb * 32, kb * 64, scr, lane); continue; }
            r -= 4 * I_DN;
            if (r < 2 * I_IN) { const int mat = r / I_IN; r -= mat * I_IN; const int kb = r / 88, nb = r % 88;
                transpose_item(w_in + (size_t)mat * DM * 2564, 2564, 2564, DM, WIN + (size_t)mat * NINP * DM, nb * 32, nb * 32, kb * 64, scr, lane); continue; }
            r -= 2 * I_IN;
            { const int mat = r / I_OUT; r -= mat * I_OUT; const int kb = r / 32, nb = r % 32;
                transpose_item(w_out + (size_t)mat * DM * DM, DM, DM, DM, WOUT + (size_t)mat * DM * DM, nb * 32, nb * 32, kb * 64, scr, lane); }
        }
        for (int m0 = gw; m0 < MTOK; m0 += 2 * NGW) {
            const int m1 = m0 + NGW;
            const f32x4* gp = (const f32x4*)(g_norm) + lane;
            const f32x4* xr0 = (const f32x4*)(x_in + (size_t)m0 * DM) + lane; const f32x4* xr1 = (const f32x4*)(x_in + (size_t)m1 * DM) + lane;
            f32x4 v0[4], v1[4];
#pragma unroll
            for (int j = 0; j < 4; ++j) { v0[j] = xr0[64 * j]; v1[j] = xr1[64 * j]; }
            const f32x4* sp0 = (const f32x4*)(MOD + (size_t)(m0 >> 12) * 9216 + 1024) + lane; const f32x4* sp1 = (const f32x4*)(MOD + (size_t)(m1 >> 12) * 9216 + 1024) + lane;
            float s0 = 0.f, s1 = 0.f; u32x2* o0 = (u32x2*)(XN + (size_t)m0 * DM) + lane; u32x2* o1 = (u32x2*)(XN + (size_t)m1 * DM) + lane;
#pragma unroll
            for (int j = 0; j < 4; ++j) { const f32x4 g = gp[64 * j];
                { const f32x4 v = v0[j]; s0 += (v[0] * v[0] + v[1] * v[1]) + (v[2] * v[2] + v[3] * v[3]); const f32x4 a = v * g * (sp0[64 * j] + 1.0f); u32x2 w; w.x = pk2(a[0], a[1]); w.y = pk2(a[2], a[3]); o0[64 * j] = w; }
                { const f32x4 v = v1[j]; s1 += (v[0] * v[0] + v[1] * v[1]) + (v[2] * v[2] + v[3] * v[3]); const f32x4 a = v * g * (sp1[64 * j] + 1.0f); u32x2 w; w.x = pk2(a[0], a[1]); w.y = pk2(a[2], a[3]); o1[64 * j] = w; } }
            s0 = wave_sum(s0); s1 = wave_sum(s1);
            if (lane == 0) { ROWSS[m0] = s0; ROWSS[m1] = s1; }
        }
    }
    PH_NEXT;
    if (PH_ON) { DEFPTRS
        LAS float* sh = (LAS float*)lds;
        for (int combo = 0; combo < 6; ++combo) {
            const int l = combo / 3, j = combo % 3;
            __syncthreads();
            for (int i = tid; i < 16 * 1024; i += 512) { const int b = i >> 10, k = i & 1023; sh[i] = MOD[((size_t)l * 16 + b) * 9216 + j * 3072 + k]; }
            __syncthreads();
            const bf16_t* Wt = (j == 1) ? WIN + (size_t)l * NINP * DM : WUP + (size_t)(l * 2 + (j == 2 ? 1 : 0)) * NUP * DM;
            const int N = (j == 1) ? NINP : NUP;
            float* dst = SBV + (size_t)combo * 16 * 5632;
            for (int n = gw; n < N; n += NGW) {
                float w[16];
#pragma unroll
                for (int c = 0; c < 4; ++c) { const u32x2 q = *(const u32x2*)(Wt + (size_t)n * DM + c * 256 + lane * 4);
                    w[4 * c] = __uint_as_float(q.x << 16); w[4 * c + 1] = __uint_as_float(q.x & 0xffff0000u); w[4 * c + 2] = __uint_as_float(q.y << 16); w[4 * c + 3] = __uint_as_float(q.y & 0xffff0000u); }
                float sv[16];
#pragma unroll
                for (int b = 0; b < 16; ++b) { float s = 0.f;
#pragma unroll
                    for (int c = 0; c < 4; ++c) { const f32x4 v = *(const LAS f32x4*)(sh + b * 1024 + c * 256 + lane * 4); s += (w[4 * c] * v[0] + w[4 * c + 1] * v[1]) + (w[4 * c + 2] * v[2] + w[4 * c + 3] * v[3]); }
                    sv[b] = s; if ((b & 3) == 3) CFENCE(); }
                float t8[8], t4[4], t2[2];
#pragma unroll
                for (int i = 0; i < 8; ++i) { const float snd = (lane & 32) ? sv[i] : sv[i + 8], kp = (lane & 32) ? sv[i + 8] : sv[i]; t8[i] = kp + __shfl_xor(snd, 32); }
#pragma unroll
                for (int i = 0; i < 4; ++i) { const float snd = (lane & 16) ? t8[i] : t8[i + 4], kp = (lane & 16) ? t8[i + 4] : t8[i]; t4[i] = kp + __shfl_xor(snd, 16); }
#pragma unroll
                for (int i = 0; i < 2; ++i) { const float snd = (lane & 8) ? t4[i] : t4[i + 2], kp = (lane & 8) ? t4[i + 2] : t4[i]; t2[i] = kp + __shfl_xor(snd, 8); }
                float t1; { const float snd = (lane & 4) ? t2[0] : t2[1], kp = (lane & 4) ? t2[1] : t2[0]; t1 = kp + __shfl_xor(snd, 4); }
                t1 += __shfl_xor(t1, 2); t1 += __shfl_xor(t1, 1);
                const int bsel = ((lane >> 5) & 1) * 8 + ((lane >> 4) & 1) * 4 + ((lane >> 3) & 1) * 2 + ((lane >> 2) & 1);
                if ((lane & 3) == 0) dst[(size_t)bsel * 5632 + n] = t1;
            }
        }
        __syncthreads();
    }
    PH_NEXT;

#ifdef REP_PRO
    if (rp_ == 0) { rp_ = 1; ph = 0; goto pro_again; }
#endif
#pragma unroll 1
    for (int f = 0; f < 4; ++f) {
        const int l = f >> 1, s = f & 1;
        if (s == 1) {
            if (PH_ON) { DEFPTRS
                pg8::Gemm g{XN, WIN + (size_t)l * NINP * DM, MTOK, NINP, DM}; pg8::StaticOrder S; S.init(MTOK, NINP, G, bx);
                pg8::EpiIn E{PROJ, FG, ROWSS + (size_t)(l * 3 + 1) * MTOK, SBV + (size_t)(l * 3 + 1) * 16 * 5632};
#ifndef NO_G_IN
                for (int rep_ = 0; rep_ < REP_IN; ++rep_) {
                pg8::gemm_phase<pg8::EpiIn, pg8::StaticOrder, true, true>(lds, g, S, E); }
#endif
            }
            PH_NEXT;
            if (PH_ON) { DEFPTRS
#ifndef NO_PREP
                {
                    const int blk = vcu & 7, n = lane & 31, hi = lane >> 5;
                    LAS unsigned char* wfl = lds;
                    LAS float* xs = (LAS float*)(lds + 16384 + wave * 13568);
                    LAS unsigned char* ub = lds + 16384 + wave * 13568 + 8960;
#pragma unroll
                    for (int q = 0; q < 2; ++q) { const int f = wave * 2 + q, gt = f >> 3, nb = (f >> 2) & 1, d0 = f & 3;
                        const float* wsrc = (gt ? w_ig : w_rg) + ((size_t)(l * 8 + blk) * 64 + 16 * d0 + 8 * hi) * 64 + nb * 32 + n;
                        u32x4 w; w.x = pk2(wsrc[0], wsrc[64]); w.y = pk2(wsrc[128], wsrc[192]); w.z = pk2(wsrc[256], wsrc[320]); w.w = pk2(wsrc[384], wsrc[448]);
                        *(LAS u32x4*)(wfl + f * 1024 + lane * 16) = w; }
                    __syncthreads();
                    float br[2], bi[2], cb[2], cw[2][4], c8[2];
#pragma unroll
                    for (int nb = 0; nb < 2; ++nb) { const int ch = blk * 64 + nb * 32 + n;
                        br[nb] = b_rg[l * 512 + ch]; bi[nb] = b_ig[l * 512 + ch]; cb[nb] = conv_b[l * 512 + ch];
#pragma unroll
                        for (int k = 0; k < 4; ++k) cw[nb][k] = conv_w[(l * 4 + k) * 512 + ch];
                        const float lmv = lam[l * 512 + ch];
                        c8[nb] = -8.0f * LOG2E * (__builtin_fmaxf(-lmv, 0.f) + log1pf(expf(-fabsf(lmv)))); }
                    for (int segi = (vcu >> 3) * 8 + wave; segi < REP_PREP * (MTOK / 32); segi += (G >> 3) * 8) { const int seg = segi & (MTOK / 32 - 1);
                        const int row0 = seg * 32; const bool first = (row0 & (SEQL - 1)) == 0;
                        const bf16_t* xp = PROJ + (size_t)row0 * PPITCH + blk * 64;
                        CFENCE();
#pragma unroll
                        for (int t = 0; t < 35; ++t) { float v = 0.f; if (t >= 3 || !first) v = bf2f((xp + ((long)t - 3) * PPITCH)[lane]); xs[t * 64 + lane] = v; }
                        CFENCE();
#pragma unroll
                        for (int nb = 0; nb < 2; ++nb)
#pragma unroll
                            for (int g = 0; g < 4; ++g) { const LAS float* xb = xs + (8 * g + 4 * hi) * 64 + nb * 32 + n; float xv[7];
#pragma unroll
                                for (int j = 0; j < 7; ++j) xv[j] = xb[j * 64];
#pragma unroll
                                for (int i = 0; i < 4; ++i) { const float uu = cb[nb] + cw[nb][0] * xv[i] + cw[nb][1] * xv[i + 1] + cw[nb][2] * xv[i + 2] + cw[nb][3] * xv[i + 3];
                                    *(LAS unsigned short*)(ub + (8 * g + 4 * hi + i) * 144 + (nb * 32 + n) * 2) = (unsigned short)f2bf(uu); }
                                __builtin_amdgcn_sched_barrier(0); }
                        CFENCE();
                        bf16x8 af[4];
#pragma unroll
                        for (int d0 = 0; d0 < 4; ++d0) af[d0] = *(const LAS bf16x8*)(ub + n * 144 + (16 * d0 + 8 * hi) * 2);
#pragma unroll
                        for (int nb = 0; nb < 2; ++nb) {
                            f32x16 arx, aix;
#pragma unroll
                            for (int r = 0; r < 16; ++r) { arx[r] = br[nb]; aix[r] = bi[nb]; }
#pragma unroll
                            for (int d0 = 0; d0 < 4; ++d0) { const bf16x8 w0 = *(const LAS bf16x8*)(wfl + ((0 * 2 + nb) * 4 + d0) * 1024 + lane * 16), w1 = *(const LAS bf16x8*)(wfl + ((1 * 2 + nb) * 4 + d0) * 1024 + lane * 16);
                                                             arx = __builtin_amdgcn_mfma_f32_32x32x16_bf16(af[d0], w0, arx, 0, 0, 0);
                                                             aix = __builtin_amdgcn_mfma_f32_32x32x16_bf16(af[d0], w1, aix, 0, 0, 0); }
                            CFENCE(); __builtin_amdgcn_sched_barrier(0);
#pragma unroll
                            for (int r = 0; r < 16; ++r) {
                                float uu; { const LAS float* xb = xs + (8 * (r >> 2) + 4 * hi + (r & 3)) * 64 + nb * 32 + n;
                                    uu = cb[nb] + cw[nb][0] * xb[0] + cw[nb][1] * xb[64] + cw[nb][2] * xb[128] + cw[nb][3] * xb[192]; }
                                const float rg = sigmoidf_(arx[r]), ig = sigmoidf_(aix[r]);
                                const float la2 = c8[nb] * rg, a = __builtin_amdgcn_exp2f(la2);
                                const float xx = 2.0f * 0.6931471805599453f * la2;
                                const float om = (xx > -0.25f) ? -xx * (1.0f + xx * 0.5f * (1.0f + xx * (1.0f / 3.0f) * (1.0f + xx * 0.25f * (1.0f + xx * 0.2f)))) : 1.0f - a * a;
                                arx[r] = a; aix[r] = __builtin_sqrtf(om) * ig * uu;
                            }
                            float H = 0.f, P = 1.f;
                            const int ch = blk * 64 + nb * 32 + n;
                            bf16_t* hl = HLOC + (size_t)(row0 + 4 * hi) * 512 + ch; bf16_t* pc = PCUM + (size_t)(row0 + 4 * hi) * 512 + ch;
#pragma unroll
                            for (int g = 0; g < 4; ++g) {
                                const float a0 = arx[4 * g], a1 = arx[4 * g + 1], a2 = arx[4 * g + 2], a3 = arx[4 * g + 3];
                                const float b0 = aix[4 * g], b1 = aix[4 * g + 1], b2 = aix[4 * g + 2], b3 = aix[4 * g + 3];
                                const float Ao = (a0 * a1) * (a2 * a3), Bo = ((b0 * a1 + b1) * a2 + b2) * a3 + b3;
                                const float Ap = __shfl_xor(Ao, 32), Bp = __shfl_xor(Bo, 32);
                                const float A1 = hi ? Ap : Ao, B1 = hi ? Bp : Bo, A2 = hi ? Ao : Ap, B2 = hi ? Bo : Bp;
                                const float Hm = A1 * H + B1, Pm = A1 * P;
                                float h = hi ? Hm : H, p = hi ? Pm : P;
                                H = A2 * Hm + B2; P = A2 * Pm;
                                bf16_t* hg = hl + (size_t)g * 8 * 512; bf16_t* pg = pc + (size_t)g * 8 * 512; asm volatile("" : "+v"(hg), "+v"(pg));
                                h = a0 * h + b0; p *= a0; hg[0 * 512] = (bf16_t)f2bf(h); pg[0 * 512] = (bf16_t)f2bf(p);
                                h = a1 * h + b1; p *= a1; hg[1 * 512] = (bf16_t)f2bf(h); pg[1 * 512] = (bf16_t)f2bf(p);
                                h = a2 * h + b2; p *= a2; hg[2 * 512] = (bf16_t)f2bf(h); pg[2 * 512] = (bf16_t)f2bf(p);
                                h = a3 * h + b3; p *= a3; hg[3 * 512] = (bf16_t)f2bf(h); pg[3 * 512] = (bf16_t)f2bf(p);
                            }
                            if (hi == 0) { ASEG[(size_t)seg * 512 + ch] = P; BSEG[(size_t)seg * 512 + ch] = H; }
                            CFENCE(); __builtin_amdgcn_sched_barrier(0);
                        }
                    }
                }
                for (int row = gw; row < MTOK; row += NGW) {
                    const u32x2 q = *(const u32x2*)(PROJ + (size_t)row * PPITCH + 2048 + lane * 4);
                    const float a0 = __uint_as_float(q.x << 16), a1 = __uint_as_float(q.x & 0xffff0000u), a2 = __uint_as_float(q.y << 16), a3 = __uint_as_float(q.y & 0xffff0000u);
                    float ss = (a0 * a0 + a1 * a1) + (a2 * a2 + a3 * a3);
                    ss += __shfl_xor(ss, 1); ss += __shfl_xor(ss, 2); ss += __shfl_xor(ss, 4); ss += __shfl_xor(ss, 8);
                    if ((lane & 15) == 0) KS[(size_t)((row >> 12) * 4 + (lane >> 4)) * SEQL + (row & (SEQL - 1))] = __builtin_amdgcn_rsqf(ss * (1.0f / 64.0f) + EPSF);
                }
                if (wave == 0) for (int chn = vcu; chn < 64; chn += G) {
                    const int b = chn >> 2, h = chn & 3; const float bf = b_fg[l * 4 + h];
                    const float* fp = FG + ((size_t)b * SEQL + lane * 64) * 4 + h;
                    float tot = 0.f;
#pragma unroll 8
                    for (int i = 0; i < 64; ++i) { const float v = fp[i * 4] + bf; tot += __builtin_fminf(v, 0.f) - log1pf(expf(-fabsf(v))); }
                    float inc = tot;
#pragma unroll
                    for (int o = 1; o < 64; o <<= 1) { const float t_ = __shfl_up(inc, o); if (lane >= o) inc += t_; }
                    float run = inc - tot;
                    float* op = F2 + (size_t)chn * SEQL + lane * 64;
#pragma unroll 8
                    for (int i = 0; i < 64; ++i) { const float v = fp[i * 4] + bf; run += __builtin_fminf(v, 0.f) - log1pf(expf(-fabsf(v))); op[i] = -run * LOG2E; }
                }
#endif
                __syncthreads();
            }
            PH_NEXT;
            if (PH_ON) { DEFPTRS
#ifndef NO_ATTN
                for (int rep_ = 0; rep_ < REP_ATTN; ++rep_)
                for (int vw = vcu; vw < 256; vw += G) {
                    const int bh = vw >> 2, s4 = vw & 3, b = bh >> 2, h = bh & 3;
#pragma unroll 1
                    for (int i = 0; i < 4; ++i) { const int qb = (i == 0) ? s4 : (i == 1) ? 7 - s4 : (i == 2) ? 8 + s4 : 15 - s4;
#ifndef NO_FOX
                        attn_unit<1>(lds, PROJ, YU, KS, F2, g_qk + l * 128, b, h, qb);
#endif
 }
#pragma unroll 1
                    for (int i = 0; i < 4; ++i) { const int qb = (i == 0) ? s4 : (i == 1) ? 7 - s4 : (i == 2) ? 8 + s4 : 15 - s4;
#ifndef NO_SB
                        attn_unit<0>(lds, PROJ, YU, KS, F2, g_qk + l * 128, b, h, qb);
#endif
 }
                }
#endif
            }
            PH_NEXT;
            if (PH_ON) { DEFPTRS
                LAS float* hin = (LAS float*)lds;
                const f32x4 gm0 = *(const f32x4*)(g_mix + l * 1024 + lane * 8), gm1 = *(const f32x4*)(g_mix + l * 1024 + lane * 8 + 4);
                const f32x4 gx0 = *(const f32x4*)(g_mix + l * 1024 + 512 + lane * 8), gx1 = *(const f32x4*)(g_mix + l * 1024 + 512 + lane * 8 + 4);
                for (int tti = vcu; tti < REP_FIN * 256; tti += G) { const int tt = tti & 255;
                    __syncthreads();
                    { const int ch = tid, seg0 = (tt >> 4) * 128, nb = (tt & 15) * 8; float Hc = 0.f;
#pragma unroll 8
                      for (int sg = 0; sg < nb; ++sg) Hc = ASEG[(size_t)(seg0 + sg) * 512 + ch] * Hc + BSEG[(size_t)(seg0 + sg) * 512 + ch];
#pragma unroll
                      for (int s8 = 0; s8 < 8; ++s8) { hin[s8 * 512 + ch] = Hc; Hc = ASEG[(size_t)(seg0 + nb + s8) * 512 + ch] * Hc + BSEG[(size_t)(seg0 + nb + s8) * 512 + ch]; } }
                    __syncthreads();
                    const f32x4 hi0 = *(const LAS f32x4*)(hin + wave * 512 + lane * 8), hi1 = *(const LAS f32x4*)(hin + wave * 512 + lane * 8 + 4);
#pragma unroll 2
                    for (int t = 0; t < 32; ++t) {
                        const size_t row = (size_t)tt * 256 + wave * 32 + t;
                        const u32x4 hq = *(const u32x4*)(HLOC + row * 512 + lane * 8);
                        const u32x4 pq = *(const u32x4*)(PCUM + row * 512 + lane * 8);
                        const u32x4 gq = *(const u32x4*)(PROJ + row * PPITCH + 512 + lane * 8);
                        const u32x4 yq = *(const u32x4*)(YU + row * 512 + lane * 8);
                        float y[8], yu[8]; float ss = 0.f, s2 = 0.f;
#pragma unroll
                        for (int i = 0; i < 8; ++i) {
                            const unsigned pw = pq[i >> 1], gw_ = gq[i >> 1], yw = yq[i >> 1];
                            const float p = (i & 1) ? __uint_as_float(pw & 0xffff0000u) : __uint_as_float(pw << 16);
                            const float gg = (i & 1) ? __uint_as_float(gw_ & 0xffff0000u) : __uint_as_float(gw_ << 16);
                            yu[i] = (i & 1) ? __uint_as_float(yw & 0xffff0000u) : __uint_as_float(yw << 16);
                            const unsigned hw = hq[i >> 1]; const float hlv = (i & 1) ? __uint_as_float(hw & 0xffff0000u) : __uint_as_float(hw << 16);
                            const float hh = hlv + p * (i < 4 ? hi0[i & 3] : hi1[i & 3]);
                            const float inner = 0.7978845608028654f * (gg + 0.044715f * gg * gg * gg);
                            const float ge = gg * __builtin_amdgcn_rcpf(1.0f + __builtin_amdgcn_exp2f(-2.0f * LOG2E * inner));
                            y[i] = hh * ge; ss += y[i] * y[i]; s2 += yu[i] * yu[i];
                        }
                        ss = wave_sum(ss);
                        s2 += __shfl_xor(s2, 1); s2 += __shfl_xor(s2, 2); s2 += __shfl_xor(s2, 4); s2 += __shfl_xor(s2, 8); s2 += __shfl_xor(s2, 16);
                        const float rl = __builtin_amdgcn_rsqf(ss * (1.0f / 512.0f) + EPSF), rx = __builtin_amdgcn_rsqf(s2 * (1.0f / 256.0f) + EPSF);
                        u32x4 o1, o2;
                        o1.x = pk2(y[0] * rl * gm0[0], y[1] * rl * gm0[1]); o1.y = pk2(y[2] * rl * gm0[2], y[3] * rl * gm0[3]);
                        o1.z = pk2(y[4] * rl * gm1[0], y[5] * rl * gm1[1]); o1.w = pk2(y[6] * rl * gm1[2], y[7] * rl * gm1[3]);
                        o2.x = pk2(yu[0] * rx * gx0[0], yu[1] * rx * gx0[1]); o2.y = pk2(yu[2] * rx * gx0[2], yu[3] * rx * gx0[3]);
                        o2.z = pk2(yu[4] * rx * gx1[0], yu[5] * rx * gx1[1]); o2.w = pk2(yu[6] * rx * gx1[2], yu[7] * rx * gx1[3]);
                        *(u32x4*)(YN + row * 1024 + lane * 8) = o1; *(u32x4*)(YN + row * 1024 + 512 + lane * 8) = o2;
                    }
                }
                __syncthreads();
            }
            PH_NEXT;
            if (PH_ON) { DEFPTRS
                pg8::Gemm g{YN, WOUT + (size_t)l * DM * DM, MTOK, DM, DM}; pg8::StaticOrder S; S.init(MTOK, DM, G, bx, 24);
                pg8::EpiRes E{xout, xout, GATE + (size_t)(l * 3 + 1) * 16 * 1024, GMOD + (size_t)(l * 3 + 2) * 16 * 1024, XN, ROWSS + (size_t)(l * 3 + 2) * MTOK, 1};
#ifndef NO_G_OUT
#ifdef REP_OUT
                { E.xout = (float*)HB; E.has_next = 0; pg8::gemm_phase<pg8::EpiRes, pg8::StaticOrder, true, true>(lds, g, S, E); E.xout = xout; E.has_next = 1; }
#endif
                pg8::gemm_phase<pg8::EpiRes, pg8::StaticOrder, true, true>(lds, g, S, E);
#endif
            }
            PH_NEXT;
        }
        const int j = s ? 2 : 0;
        if (PH_ON) { DEFPTRS
            pg8::Gemm g{XN, WUP + (size_t)(l * 2 + s) * NUP * DM, MTOK, NUP, DM}; pg8::StaticOrder S; S.init(MTOK, NUP, G, bx);
            pg8::EpiUp E{HB, ROWSS + (size_t)(l * 3 + j) * MTOK, SBV + (size_t)(l * 3 + j) * 16 * 5632};
#ifndef NO_G_UP
            for (int rep_ = 0; rep_ < REP_UP; ++rep_) {
            pg8::gemm_phase<pg8::EpiUp, pg8::StaticOrder, true, true>(lds, g, S, E);
            }
#endif
        }
        PH_NEXT;
        if (PH_ON) { DEFPTRS
            const int nl = s ? l + 1 : l, nj = s ? 0 : 1; const int has_next = (nl < 2) ? 1 : 0; const int nidx = has_next ? nl * 3 + nj : 0;
            pg8::Gemm g{HB, WDN + (size_t)(l * 2 + s) * DM * DFF, MTOK, DM, DFF}; pg8::StaticOrder S; S.init(MTOK, DM, G, bx, 24);
            pg8::EpiRes E{f == 0 ? x_in : xout, xout, GATE + (size_t)(l * 3 + j) * 16 * 1024, GMOD + (size_t)nidx * 16 * 1024, XN, ROWSS + (size_t)nidx * MTOK, has_next};
#ifndef NO_G_DN
#ifdef REP_DN
            for (int rep_ = 0; rep_ < 2; ++rep_) { E.xout = (rep_ == 0) ? (float*)HLOC : xout; E.has_next = (rep_ == 0) ? 0 : has_next;
            pg8::gemm_phase<pg8::EpiRes, pg8::StaticOrder, true, true>(lds, g, S, E); }
#else
            pg8::gemm_phase<pg8::EpiRes, pg8::StaticOrder, true, true>(lds, g, S, E);
#endif
#endif
        }
        PH_NEXT;
    }
#undef PH_ON
#undef PH_NEXT
}


#ifdef DBG_STOP
__global__ void dbg_dump(const unsigned char* ws, float* out, int mode) {
    const size_t n = (size_t)MTOK * DM; const size_t i0 = (size_t)blockIdx.x * blockDim.x + threadIdx.x, st = (size_t)gridDim.x * blockDim.x;
    const bf16_t* XN = (const bf16_t*)(ws + WS_XN); const bf16_t* HB = (const bf16_t*)(ws + WS_H); const bf16_t* PR = (const bf16_t*)(ws + WS_PROJ);
    const bf16_t* YU = (const bf16_t*)(ws + WS_YU); const float* HL = (const float*)(ws + WS_HLOC); const bf16_t* YN = (const bf16_t*)(ws + WS_YN); const bf16_t* PC = (const bf16_t*)(ws + WS_PCUM);
    for (size_t i = i0; i < n; i += st) {
        float v = 0.f;
        if (mode == 0) v = bf2f(XN[i]);
        else if (mode == 1) v = bf2f(HB[i]) + bf2f(HB[i + n]) + bf2f(HB[i + (size_t)117440512]);
        else if (mode == 2) v = bf2f(PR[i]) + bf2f(PR[i + n]) + bf2f(PR[i + (size_t)100663296]);
        else if (mode == 3) v = (i < n / 2) ? bf2f(YU[i]) : HL[i - n / 2];
        else if (mode == 4) v = bf2f(YN[i]);
        else if (mode == 6) v = (i < n / 2) ? bf2f(PC[i]) : ((const float*)(ws + WS_KS))[(i - n / 2) % (3 * 262144)];
        else if (mode == 7) v = HL[i % (n / 2)] + bf2f(PC[i % (n / 2)]) + ((const float*)(ws + WS_KS))[i % (3 * 262144)] + ((const float*)(ws + WS_ASEG))[i % (2 * 1048576)];
        if (mode == 3) { const bool nan_ = !(v == v), big = (v > 3e38f) || (v < -3e38f); float code = 0.f;
            if (i < n / 2) { const int col = (int)(i & 511); if (col < 256) code = nan_ ? 2000.f : (big ? 1000.f : 0.f); else code = (nan_ || big) ? 4000.f : 0.f; }
            else code = (nan_ || big) ? 8000.f : 0.f;
            v = code; }
        if (!(v == v)) v = 77777.f; if (v > 3e38f) v = 88888.f; if (v < -3e38f) v = 99999.f;
        if (mode != 5) out[i] = v;
    }
}
#endif
#ifndef MK_N_LAUNCHES
#define MK_N_LAUNCHES 1
#endif
constexpr int N_PHASES = 3 + 2 * 9;
extern "C" void kernel_launch(void* const* d_in, const int* in_sizes, int n_in, void* d_out, int out_size, void* d_ws, size_t ws_size, hipStream_t stream) {
    static int grid = 0;
    if (grid == 0) {
        if (n_in != 19 || out_size != MTOK * DM || ws_size < WS_END) { fprintf(stderr, "kernel_launch: unexpected shapes (n_in %d, out %d, ws %zu)\n", n_in, out_size, ws_size); grid = -1; return; }
        int dev = 0, cus = 0, per_cu = 0;
        hipGetDevice(&dev); hipDeviceGetAttribute(&cus, hipDeviceAttributeMultiprocessorCount, dev);
        if (hipFuncSetAttribute((const void*)mk_fwd, hipFuncAttributeMaxDynamicSharedMemorySize, LDS_BYTES) != hipSuccess) { fprintf(stderr, "kernel_launch: hipFuncSetAttribute failed\n"); grid = -1; return; }
        if (hipOccupancyMaxActiveBlocksPerMultiprocessor(&per_cu, (const void*)mk_fwd, 512, LDS_BYTES) != hipSuccess || per_cu < 1) { fprintf(stderr, "kernel_launch: occupancy query says %d\n", per_cu); per_cu = 1; }
        (void)hipGetLastError();
        grid = cus * 1;
    }
    if (grid < 0) return;
    if (hipMemsetAsync(d_ws, 0, 16384, stream) != hipSuccess) { fprintf(stderr, "kernel_launch: memset failed\n"); return; }
    Args a{};
    for (int i = 0; i < 19; ++i) a.in[i] = (const float*)d_in[i];
    a.out = (float*)d_out; a.ws = (unsigned char*)d_ws;
#if MK_N_LAUNCHES == 1
    a.ph_lo = 0; a.ph_hi = N_PHASES;
    void* kargs[] = {&a};
    hipError_t e = hipLaunchCooperativeKernel((const void*)mk_fwd, dim3(grid), dim3(512), kargs, LDS_BYTES, stream);
    if (e != hipSuccess) fprintf(stderr, "kernel_launch: cooperative launch failed: %s (grid %d)\n", hipGetErrorString(e), grid);
#else
#ifdef DBG_STOP
    for (int p = 0; p < DBG_STOP; ++p) { a.ph_lo = p; a.ph_hi = p + 1; hipLaunchKernelGGL(mk_fwd, dim3(grid), dim3(512), LDS_BYTES, stream, a); }
    hipLaunchKernelGGL(dbg_dump, dim3(2048), dim3(256), 0, stream, (const unsigned char*)d_ws, (float*)d_out, DBG_MODE);
#else
    for (int p = 0; p < N_PHASES; ++p) { a.ph_lo = p; a.ph_hi = p + 1; hipLaunchKernelGGL(mk_fwd, dim3(grid), dim3(512), LDS_BYTES, stream, a); }
#endif
#endif
}
```

```cpp
#include <hip/hip_runtime.h>
#include <hip/hip_cooperative_groups.h>
#include <cstdio>
#include <cstdint>
namespace cg = cooperative_groups;
namespace pg8 {
#define PG8_LAS __attribute__((address_space(3)))
typedef unsigned short bf16_t;
typedef short bf16x8 __attribute__((ext_vector_type(8)));
typedef float f32x4 __attribute__((ext_vector_type(4)));
typedef unsigned u32x4 __attribute__((ext_vector_type(4)));
constexpr int BM = 256, BK = 64, HALF = 128, HTB = HALF * BK * 2  , STAGE_BYTES = 8 * HTB, NXCD = 8, WGM = 8;

__host__ __device__ __forceinline__ int lds_byte(int r, int c) { const int st = (r >> 4) * 2 + (c >> 5), rr = r & 15, cc = c & 31, ob = rr * 64 + cc * 2; return st * 1024 + (ob ^ (((ob >> 9) & 1) << 5)); }
__host__ __device__ __forceinline__ void stage_rc(int b, int& R, int& C) { const int st = b / 1024, sb = b % 1024, swz = sb ^ (((sb >> 9) & 1) << 5); R = (st >> 1) * 16 + swz / 64; C = (st & 1) * 32 + (swz % 64) / 2; }
__host__ __device__ __forceinline__ int perm32(int rho) { const int n = rho >> 4, i = rho & 15; return 8 * (i >> 2) + 4 * n + (i & 3); }

struct Unit { int pm, pn; };
struct Gemm { const bf16_t* A; const bf16_t* Bt; int M, N, K; };

struct StaticOrder {
    int nM, nN, nwg, G, c, rev;
    __host__ __device__ void init(int M, int N, int G_, int c_, int rev_ = 0) { nM = M / BM; nN = N / BM; nwg = nM * nN; G = G_; c = c_; rev = rev_; }
    __host__ __device__ bool next(int i, Unit& u) const {
        const long L = (long)i * G + c; if (L >= nwg) return false;
        int wgid = (int)L; { const int q = nwg / NXCD, r = nwg % NXCD, xcd = wgid % NXCD, off = wgid / NXCD; wgid = (xcd < r ? xcd * (q + 1) : r * (q + 1) + (xcd - r) * q) + off; }
        const int nig = WGM * nN, gid = wgid / nig, fm = gid * WGM, gsz = (nM - fm) < WGM ? (nM - fm) : WGM;
        u.pm = (fm + ((wgid % nig) % gsz)) ^ rev; u.pn = (wgid % nig) / gsz; return true;
    }
    __device__ __forceinline__ void a_ready(const Unit&) const {}
    __device__ __forceinline__ void done(const Unit&) const {}
};

typedef float f32x2c_t __attribute__((ext_vector_type(2))); typedef __bf16 bf16x2c_t __attribute__((ext_vector_type(2)));
__device__ __forceinline__ unsigned cvt_pk_bf16(float lo, float hi) { f32x2c_t v = {lo, hi}; bf16x2c_t b = __builtin_convertvector(v, bf16x2c_t); return __builtin_bit_cast(unsigned, b); }
typedef float f32x2 __attribute__((ext_vector_type(2)));
constexpr float RMS_EPS = 1e-6f;
struct EpiUp {
    static constexpr bool PERM = true, AFTER_DRAIN = false;
    bf16_t* H; const float* rowss; const float* sb;
    __device__ __forceinline__ void operator()(const f32x4 (&acc)[2][2][4][2], const Unit& u, int wr, int wc, int fr, int fq) const {
        const int row0 = u.pm * BM + wr * 64 + fr, b = u.pm >> 4, cl = wc * 32 + 8 * fq;
        const float* sbp = sb + (size_t)b * 5632 + u.pn * 256 + cl;
        float rsv[2][4];
#pragma unroll
        for (int ai = 0; ai < 2; ++ai)
#pragma unroll
            for (int m = 0; m < 4; ++m) rsv[ai][m] = rowss[row0 + ai * HALF + m * 16];
        f32x4 sg[2], su[2];
#pragma unroll
        for (int n = 0; n < 2; ++n) { sg[n] = *(const f32x4*)(sbp + 4 * n); su[n] = *(const f32x4*)(sbp + 128 + 4 * n); }
#pragma unroll
        for (int ai = 0; ai < 2; ++ai)
#pragma unroll
            for (int m = 0; m < 4; ++m) {
                const int row = row0 + ai * HALF + m * 16;
                const float rs = __builtin_amdgcn_rsqf(rsv[ai][m] * (1.0f / 1024.0f) + RMS_EPS);
                unsigned wq[4];
#pragma unroll
                for (int n = 0; n < 2; ++n)
#pragma unroll
                    for (int ip = 0; ip < 2; ++ip) {
                        const f32x2 ag = (f32x2){acc[ai][0][m][n][2 * ip], acc[ai][0][m][n][2 * ip + 1]}, au = (f32x2){acc[ai][1][m][n][2 * ip], acc[ai][1][m][n][2 * ip + 1]};
                        const f32x2 g = ag * rs + (f32x2){sg[n][2 * ip], sg[n][2 * ip + 1]}, uu = au * rs + (f32x2){su[n][2 * ip], su[n][2 * ip + 1]};
                        const f32x2 t = g * (-1.4426950408889634f);
                        f32x2 d; d.x = __builtin_amdgcn_exp2f(t.x); d.y = __builtin_amdgcn_exp2f(t.y); d = d + 1.0f;
                        f32x2 r; r.x = __builtin_amdgcn_rcpf(d.x); r.y = __builtin_amdgcn_rcpf(d.y);
                        const f32x2 hv = (g * uu) * r;
                        wq[n * 2 + ip] = cvt_pk_bf16(hv.x, hv.y);
                    }
                u32x4 w; w.x = wq[0]; w.y = wq[1]; w.z = wq[2]; w.w = wq[3];
                *(u32x4*)(H + (size_t)row * 2816 + u.pn * 128 + cl) = w;
            }
    }
};
struct EpiIn {
    static constexpr bool PERM = true, AFTER_DRAIN = false;
    bf16_t* P; float* FG; const float* rowss; const float* sb;
    __device__ __forceinline__ void operator()(const f32x4 (&acc)[2][2][4][2], const Unit& u, int wr, int wc, int fr, int fq) const {
        const int row0 = u.pm * BM + wr * 64 + fr, b = u.pm >> 4, cl = wc * 32 + 8 * fq;
        const float* sbp = sb + (size_t)b * 5632 + u.pn * 256 + cl;
        float rsv[2][4];
#pragma unroll
        for (int ai = 0; ai < 2; ++ai)
#pragma unroll
            for (int m = 0; m < 4; ++m) rsv[ai][m] = rowss[row0 + ai * HALF + m * 16];
        f32x4 sv[2][2];
#pragma unroll
        for (int bj = 0; bj < 2; ++bj)
#pragma unroll
            for (int n = 0; n < 2; ++n) sv[bj][n] = *(const f32x4*)(sbp + bj * HALF + 4 * n);
#pragma unroll
        for (int ai = 0; ai < 2; ++ai)
#pragma unroll
            for (int m = 0; m < 4; ++m) {
                const int row = row0 + ai * HALF + m * 16;
                const float rs = __builtin_amdgcn_rsqf(rsv[ai][m] * (1.0f / 1024.0f) + RMS_EPS);
                if (u.pn < 10) {
#pragma unroll
                    for (int bj = 0; bj < 2; ++bj) {
                        const f32x4 v0 = acc[ai][bj][m][0] * rs + sv[bj][0], v1 = acc[ai][bj][m][1] * rs + sv[bj][1];
                        u32x4 w; w.x = cvt_pk_bf16(v0[0], v0[1]); w.y = cvt_pk_bf16(v0[2], v0[3]); w.z = cvt_pk_bf16(v1[0], v1[1]); w.w = cvt_pk_bf16(v1[2], v1[3]);
                        *(u32x4*)(P + (size_t)row * 2560 + u.pn * 256 + bj * HALF + cl) = w;
                    }
                } else if (wc == 0 && fq == 0) {
                    *(f32x4*)(FG + (size_t)row * 4) = acc[ai][0][m][0] * rs + sv[0][0];
                }
            }
    }
};
struct EpiRes {
    static constexpr bool PERM = false, AFTER_DRAIN = false;
    const float* xin; float* xout; const float* gate; const float* gmn; bf16_t* XN; float* rowssn; int has_next;
    __device__ __forceinline__ void operator()(const f32x4 (&acc)[2][2][4][2], const Unit& u, int wr, int wc, int fr, int fq) const {
        typedef unsigned u32x2v __attribute__((ext_vector_type(2)));
        const int row0 = u.pm * BM + wr * 64 + fr, b = u.pm >> 4, col0 = u.pn * BM + wc * 32 + 4 * fq;
        const float* gp_ = gate + b * 1024 + col0; const float* gm_ = gmn + b * 1024 + col0;
#pragma unroll
        for (int ai = 0; ai < 2; ++ai) {
            f32x4 xi[4][2][2];
#pragma unroll
            for (int m = 0; m < 4; ++m)
#pragma unroll
                for (int bj = 0; bj < 2; ++bj)
#pragma unroll
                    for (int n = 0; n < 2; ++n) xi[m][bj][n] = *(const f32x4*)(xin + (size_t)(row0 + ai * HALF + m * 16) * 1024 + col0 + bj * HALF + n * 16);
            asm volatile("" ::: "memory");
#pragma unroll
            for (int m = 0; m < 4; ++m) {
                const int row = row0 + ai * HALF + m * 16; const size_t off = (size_t)row * 1024 + col0;
                float ss = 0.f;
#pragma unroll
                for (int bj = 0; bj < 2; ++bj)
#pragma unroll
                    for (int n = 0; n < 2; ++n) {
                        const f32x4 xo = xi[m][bj][n] + *(const f32x4*)(gp_ + bj * HALF + n * 16) * acc[ai][bj][m][n];
                        *(f32x4*)(xout + off + bj * HALF + n * 16) = xo;
                        if (has_next) {
                            ss += (xo[0] * xo[0] + xo[1] * xo[1]) + (xo[2] * xo[2] + xo[3] * xo[3]);
                            const f32x4 a = xo * *(const f32x4*)(gm_ + bj * HALF + n * 16); u32x2v w; w.x = cvt_pk_bf16(a[0], a[1]); w.y = cvt_pk_bf16(a[2], a[3]);
                            *(u32x2v*)(XN + off + bj * HALF + n * 16) = w;
                        }
                    }
                if (has_next) { ss += __shfl_xor(ss, 16); ss += __shfl_xor(ss, 32); if (fq == 0) unsafeAtomicAdd(rowssn + row, ss); }
            }
            asm volatile("" ::: "memory");
        }
    }
};

template <class Epi, class Sched, bool ALIGN_EPI = false, bool SP2 = false>
__device__ __forceinline__ void gemm_phase(PG8_LAS unsigned char* lds, const Gemm g, const Sched& S, const Epi& E) {
    int tid_o = threadIdx.x; asm volatile("" : "+v"(tid_o)); const int tid = tid_o, wid = __builtin_amdgcn_readfirstlane(tid >> 6), lane = tid & 63, wr = wid >> 2, wc = wid & 3, fr = lane & 15, fq = lane >> 4;
    const int K = g.K, nt = K / BK;
    unsigned voffA[2], voffB[2];
#pragma unroll
    for (int i = 0; i < 2; ++i) { int R, C; stage_rc(tid * 16 + i * 8192, R, C); const int Rb = Epi::PERM ? ((R & ~31) + perm32(R & 31)) : R;
        voffA[i] = (unsigned)(R * K + C) * 2u; voffB[i] = (unsigned)(Rb * K + C) * 2u; }
    const size_t kstep = (size_t)(BK * 2);
    const size_t hstep = (size_t)HALF * K * 2;
    const size_t tstep = 2 * hstep;
    const unsigned ldsw = (unsigned)wid * 1024u;
    const int aoff = lds_byte(wr * 64 + fr, fq * 8), boff = lds_byte(wc * 32 + fr, fq * 8);
#define PG8_SA(b, h) (((b) * 2 + (h)) * HTB)
#define PG8_SB(b, h) ((4 + (b) * 2 + (h)) * HTB)
#define PG8_STAGE(bufoff, gbase, voff) do { _Pragma("unroll") for (int _i = 0; _i < 2; ++_i) \
        __builtin_amdgcn_global_load_lds((const unsigned*)((const char*)(gbase) + (voff)[_i]), (PG8_LAS unsigned*)(lds + (bufoff) + ldsw + _i * 8192), 16, 0, 0); } while (0)
#define PG8_LDA(dst, b, h) do { _Pragma("unroll") for (int m = 0; m < 4; ++m) _Pragma("unroll") for (int k = 0; k < 2; ++k) dst[m][k] = *(const PG8_LAS bf16x8*)(lds + PG8_SA(b, h) + aoff + m * 2048 + k * 1024); } while (0)
#define PG8_LDB(dst, b, h) do { _Pragma("unroll") for (int n = 0; n < 2; ++n) _Pragma("unroll") for (int k = 0; k < 2; ++k) dst[n][k] = *(const PG8_LAS bf16x8*)(lds + PG8_SB(b, h) + boff + n * 2048 + k * 1024); } while (0)
#define PG8_MMA(ai, bj, At, Bt) do { __builtin_amdgcn_s_setprio(1); _Pragma("unroll") for (int m = 0; m < 4; ++m) _Pragma("unroll") for (int n = 0; n < 2; ++n) _Pragma("unroll") for (int k = 0; k < 2; ++k) \
        acc[ai][bj][m][n] = __builtin_amdgcn_mfma_f32_16x16x32_bf16(Bt[n][k], At[m][k], acc[ai][bj][m][n], 0, 0, 0); __builtin_amdgcn_s_setprio(0); } while (0)
#define PG8_WAIT_V(n) asm volatile("s_waitcnt vmcnt(" #n ")" ::: "memory")
#define PG8_WAIT_L(n) asm volatile("s_waitcnt lgkmcnt(" #n ")" ::: "memory")
#define PG8_BAR __builtin_amdgcn_s_barrier()
#define PG8_SCHED __builtin_amdgcn_sched_barrier(0)
    Unit cur, nxt; int ui = 0;
    if (!S.next(0, cur)) return;
    f32x4 acc[2][2][4][2];
#pragma unroll
    for (int a = 0; a < 2; ++a)
#pragma unroll
        for (int b = 0; b < 2; ++b)
#pragma unroll
            for (int m = 0; m < 4; ++m)
#pragma unroll
                for (int n = 0; n < 2; ++n) acc[a][b][m][n] = (f32x4){0.f, 0.f, 0.f, 0.f};
    bf16x8 At[4][2], B0[2][2], B1[2][2];
    const char* cA = (const char*)g.A + (size_t)cur.pm * tstep; const char* cB = (const char*)g.Bt + (size_t)cur.pn * tstep;
    S.a_ready(cur);
    if constexpr (SP2) {
        PG8_STAGE(PG8_SB(0, 0), cB, voffB); PG8_STAGE(PG8_SB(0, 1), cB + hstep, voffB); PG8_STAGE(PG8_SA(0, 0), cA, voffA); PG8_STAGE(PG8_SA(0, 1), cA + hstep, voffA);
        if (wr == 1) PG8_BAR;
        PG8_WAIT_V(2); PG8_BAR;
        PG8_STAGE(PG8_SB(1, 0), cB + kstep, voffB); PG8_STAGE(PG8_SA(1, 0), cA + kstep, voffA); PG8_STAGE(PG8_SB(1, 1), cB + hstep + kstep, voffB);
        PG8_WAIT_V(6); PG8_BAR;
    } else {
        PG8_STAGE(PG8_SB(0, 0), cB, voffB); PG8_STAGE(PG8_SA(0, 0), cA, voffA); PG8_STAGE(PG8_SB(0, 1), cB + hstep, voffB); PG8_STAGE(PG8_SA(0, 1), cA + hstep, voffA);
        if (wr == 1) PG8_BAR;
        PG8_WAIT_V(4); PG8_BAR;
        PG8_STAGE(PG8_SB(1, 0), cB + kstep, voffB); PG8_STAGE(PG8_SA(1, 0), cA + kstep, voffA); PG8_STAGE(PG8_SB(1, 1), cB + hstep + kstep, voffB);
        PG8_WAIT_V(6); PG8_BAR;
    }
    for (;;) {
        const bool has_next = S.next(ui + 1, nxt);
        const char* nA = has_next ? (const char*)g.A + (size_t)nxt.pm * tstep : cA; const char* nB = has_next ? (const char*)g.Bt + (size_t)nxt.pn * tstep : cB;
        for (int t = 0; t < nt; t += 2) {
            const bool last = (t == nt - 2);
            const char* a1 = cA + (size_t)(t + 1) * kstep;
            const char* a2 = last ? nA : cA + (size_t)(t + 2) * kstep; const char* b2 = last ? nB : cB + (size_t)(t + 2) * kstep;
            const char* a3 = a2 + kstep; const char* b3 = b2 + kstep;
            if (last && has_next) S.a_ready(nxt);
            if constexpr (SP2) {
            PG8_LDB(B0, 0, 0); PG8_LDB(B1, 0, 1); PG8_SCHED; PG8_LDA(At, 0, 0); PG8_STAGE(PG8_SA(1, 1), a1 + hstep, voffA);
            PG8_WAIT_V(8); PG8_WAIT_L(0); PG8_BAR; PG8_MMA(0, 0, At, B0); PG8_MMA(0, 1, At, B1); PG8_BAR; PG8_SCHED;
            PG8_LDA(At, 0, 1); PG8_STAGE(PG8_SB(0, 0), b2, voffB); PG8_STAGE(PG8_SB(0, 1), b2 + hstep, voffB); PG8_STAGE(PG8_SA(0, 0), a2, voffA);
            PG8_WAIT_V(8); PG8_WAIT_L(0); PG8_BAR; PG8_MMA(1, 0, At, B0); PG8_MMA(1, 1, At, B1); PG8_BAR; PG8_SCHED;
            PG8_LDB(B0, 1, 0); PG8_LDB(B1, 1, 1); PG8_SCHED; PG8_LDA(At, 1, 0); PG8_STAGE(PG8_SA(0, 1), a2 + hstep, voffA);
            PG8_WAIT_V(8); PG8_WAIT_L(0); PG8_BAR; PG8_MMA(0, 0, At, B0); PG8_MMA(0, 1, At, B1); PG8_BAR; PG8_SCHED;
            PG8_LDA(At, 1, 1); PG8_STAGE(PG8_SB(1, 0), b3, voffB); PG8_STAGE(PG8_SB(1, 1), b3 + hstep, voffB); PG8_STAGE(PG8_SA(1, 0), a3, voffA);
            PG8_WAIT_V(8); PG8_WAIT_L(0); PG8_BAR; PG8_MMA(1, 0, At, B0); PG8_MMA(1, 1, At, B1); PG8_BAR; PG8_SCHED;
            } else {
            PG8_LDB(B0, 0, 0); PG8_SCHED; PG8_LDA(At, 0, 0); PG8_STAGE(PG8_SA(1, 1), a1 + hstep, voffA);
            PG8_WAIT_L(8); PG8_BAR; PG8_WAIT_L(0); PG8_MMA(0, 0, At, B0); PG8_BAR; PG8_SCHED;
            PG8_LDB(B1, 0, 1); PG8_STAGE(PG8_SB(0, 0), b2, voffB);
            PG8_BAR; PG8_WAIT_L(0); PG8_MMA(0, 1, At, B1); PG8_BAR;
            PG8_LDA(At, 0, 1); PG8_STAGE(PG8_SA(0, 0), a2, voffA);
            PG8_BAR; PG8_WAIT_L(0); PG8_MMA(1, 0, At, B0); PG8_BAR; PG8_SCHED;
            PG8_STAGE(PG8_SB(0, 1), b2 + hstep, voffB);
            PG8_WAIT_V(6); PG8_BAR; PG8_MMA(1, 1, At, B1); PG8_BAR;
            PG8_LDB(B0, 1, 0); PG8_SCHED; PG8_LDA(At, 1, 0); PG8_STAGE(PG8_SA(0, 1), a2 + hstep, voffA);
            PG8_WAIT_L(8); PG8_BAR; PG8_WAIT_L(0); PG8_MMA(0, 0, At, B0); PG8_BAR; PG8_SCHED;
            PG8_LDB(B1, 1, 1); PG8_STAGE(PG8_SB(1, 0), b3, voffB);
            PG8_BAR; PG8_WAIT_L(0); PG8_MMA(0, 1, At, B1); PG8_BAR;
            PG8_LDA(At, 1, 1); PG8_STAGE(PG8_SA(1, 0), a3, voffA);
            PG8_BAR; PG8_WAIT_L(0); PG8_MMA(1, 0, At, B0); PG8_BAR; PG8_SCHED;
            PG8_STAGE(PG8_SB(1, 1), b3 + hstep, voffB);
            PG8_WAIT_V(6); PG8_BAR; PG8_MMA(1, 1, At, B1); PG8_BAR;
            }
        }
        if constexpr (ALIGN_EPI) { if (wr == 0) PG8_BAR; }
        if constexpr (!Epi::AFTER_DRAIN) { E(acc, cur, wr, wc, fr, fq); S.done(cur); }
        if (!has_next) break;
#pragma unroll
        for (int a = 0; a < 2; ++a)
#pragma unroll
            for (int b = 0; b < 2; ++b)
#pragma unroll
                for (int m = 0; m < 4; ++m)
#pragma unroll
                    for (int n = 0; n < 2; ++n) acc[a][b][m][n] = (f32x4){0.f, 0.f, 0.f, 0.f};
        cur = nxt; cA = nA; cB = nB; ++ui;
        if constexpr (ALIGN_EPI) { if (wr == 1) PG8_BAR; }
    }
    PG8_WAIT_V(0);
    if constexpr (!ALIGN_EPI) { if (wr == 0) PG8_BAR; }
    PG8_BAR;
    if constexpr (Epi::AFTER_DRAIN) { E.fused(acc, cur, wr, wc, fr, fq, lds, wid, lane); S.done(cur); }
#undef PG8_SA
#undef PG8_SB
#undef PG8_STAGE
#undef PG8_LDA
#undef PG8_LDB
#undef PG8_MMA
#undef PG8_WAIT_V
#undef PG8_WAIT_L
#undef PG8_BAR
#undef PG8_SCHED
}
}

#define LAS __attribute__((address_space(3)))
typedef unsigned short bf16_t;
typedef short bf16x8 __attribute__((ext_vector_type(8)));
typedef short s16x4 __attribute__((ext_vector_type(4)));
typedef float f32x4 __attribute__((ext_vector_type(4)));
typedef float f32x2 __attribute__((ext_vector_type(2)));
typedef float f32x16 __attribute__((ext_vector_type(16)));
typedef unsigned u32x4 __attribute__((ext_vector_type(4)));
typedef unsigned u32x2 __attribute__((ext_vector_type(2)));

constexpr int MTOK = 65536, DM = 1024, DFF = 2816, NUP = 5632, NINP = 2816, PPITCH = 2560, SEQL = 4096;
constexpr float EPSF = 1e-6f, LOG2E = 1.4426950408889634f;
constexpr size_t MiB = 1u << 20;
constexpr size_t WS_MOD = 1 * MiB, WS_GMOD = 3 * MiB, WS_GATE = 4 * MiB, WS_SB = 5 * MiB, WS_ROWSS = 8 * MiB, WS_KS = 10 * MiB, WS_F2 = 11 * MiB, WS_FG = 12 * MiB,
                 WS_ASEG = 13 * MiB, WS_BSEG = 17 * MiB, WS_WUP = 24 * MiB, WS_WDN = 68 * MiB, WS_WIN = 90 * MiB, WS_WOUT = 101 * MiB, WS_XN = 112 * MiB,
                 WS_H = 240 * MiB, WS_PROJ = 240 * MiB, WS_YU = 592 * MiB, WS_HLOC = 656 * MiB, WS_PCUM = 784 * MiB, WS_YN = 848 * MiB, WS_END = 976 * MiB;
constexpr int LDS_BYTES = 147456;

__device__ __forceinline__ float bf2f(unsigned short v) { return __uint_as_float((unsigned)v << 16); }
__device__ __forceinline__ unsigned f2bf(float f) { unsigned u = __float_as_uint(f); return (u + 0x7fffu + ((u >> 16) & 1u)) >> 16; }
__device__ __forceinline__ unsigned pk2(float lo, float hi) { return pg8::cvt_pk_bf16(lo, hi); }
__device__ __forceinline__ float wave_sum(float v) {
#pragma unroll
    for (int o = 1; o < 64; o <<= 1) v += __shfl_xor(v, o);
    return v;
}
__device__ __forceinline__ float sigmoidf_(float x) { return __builtin_amdgcn_rcpf(1.0f + __builtin_amdgcn_exp2f(-LOG2E * x)); }
#define WAITV(n) asm volatile("s_waitcnt vmcnt(" #n ")" ::: "memory")
#define LBAR() asm volatile("s_waitcnt lgkmcnt(0)\n\ts_barrier" ::: "memory")
#define CFENCE() asm volatile("" ::: "memory")

#ifndef REP_FIN
#define REP_FIN 1
#endif
#ifndef REP_IN
#define REP_IN 1
#endif
#ifndef REP_PREP
#define REP_PREP 1
#endif
#ifndef REP_ATTN
#define REP_ATTN 1
#endif
#ifndef REP_UP
#define REP_UP 1
#endif
struct Args { const float* in[19]; float* out; unsigned char* ws; int ph_lo, ph_hi; };

__device__ __forceinline__ void transpose_item(const float* __restrict__ W, int ldw, int clim, int K, bf16_t* __restrict__ WT, int n0, int c0, int k0, LAS float* scr, int lane) {
    const int col = c0 + (lane & 31);
#pragma unroll 16
    for (int i = 0; i < 32; ++i) { const int kk = 2 * i + (lane >> 5); scr[kk * 33 + (lane & 31)] = (col < clim) ? W[(size_t)(k0 + kk) * ldw + col] : 0.f; }
    asm volatile("s_waitcnt lgkmcnt(0)" ::: "memory");
    const int c = lane & 7;
#pragma unroll
    for (int j = 0; j < 4; ++j) { const int n = (lane >> 3) + 8 * j; const LAS float* s = scr + (8 * c) * 33 + n;
        u32x4 o; o.x = pk2(s[0 * 33], s[1 * 33]); o.y = pk2(s[2 * 33], s[3 * 33]); o.z = pk2(s[4 * 33], s[5 * 33]); o.w = pk2(s[6 * 33], s[7 * 33]);
        *(u32x4*)(WT + (size_t)(n0 + n) * K + k0 + 8 * c) = o; }
    asm volatile("s_waitcnt lgkmcnt(0)" ::: "memory");
}

__device__ __forceinline__ int crow(int r, int hi) { return (r & 3) + 8 * (r >> 2) + 4 * hi; }
__device__ __forceinline__ s16x4 vtr(const LAS unsigned char* p) {
    typedef short v4i16_t __attribute__((ext_vector_type(4)));
    return __builtin_bit_cast(s16x4, __builtin_amdgcn_ds_read_tr16_b64_v4i16((LAS v4i16_t*)p));
}
constexpr int AT_SLOT = 16384, AT_AUX = 3 * AT_SLOT, AT_WSF = AT_AUX + 3 * 512, AT_VOTE = AT_WSF + 8 * 256;
constexpr float C2 = 0.125f * LOG2E;

__device__ __forceinline__ void sb_block(f32x16& X, float& carry, bool band, int kv0  , int qrel, int hi) {
    float lm[16];
#pragma unroll
    for (int r = 0; r < 16; ++r) {
        float z2 = X[r] * C2; z2 = __builtin_fminf(__builtin_fmaxf(z2, -120.f), 120.f);
        const float e = __builtin_amdgcn_exp2f(-z2), sp = __builtin_amdgcn_logf(1.0f + e);
        float l1 = -(sp + z2), lb = -sp;
        if (band) { const int kv = kv0 + (r & 3) + 8 * (r >> 2); const bool valid = kv < qrel; l1 = valid ? l1 : 0.f; lb = valid ? lb : -INFINITY; }
        lm[r] = l1; X[r] = lb;
    }
    float G[4], Gp[4], T[4];
#pragma unroll
    for (int g = 0; g < 4; ++g) { G[g] = (lm[4 * g] + lm[4 * g + 1]) + (lm[4 * g + 2] + lm[4 * g + 3]); Gp[g] = __shfl_xor(G[g], 32); T[g] = G[g] + Gp[g]; }
    float S = carry;
#pragma unroll
    for (int g = 3; g >= 0; --g) {
        const float a3 = S + (hi == 0 ? Gp[g] : 0.f), a2 = a3 + lm[4 * g + 3], a1 = a2 + lm[4 * g + 2], a0 = a1 + lm[4 * g + 1];
        X[4 * g + 3] = __builtin_amdgcn_exp2f(X[4 * g + 3] + a3); X[4 * g + 2] = __builtin_amdgcn_exp2f(X[4 * g + 2] + a2);
        X[4 * g + 1] = __builtin_amdgcn_exp2f(X[4 * g + 1] + a1); X[4 * g] = __builtin_amdgcn_exp2f(X[4 * g] + a0);
        S += T[g];
    }
    carry = S;
}

template <int KIND>
__device__ __forceinline__ void attn_unit(LAS unsigned char* lds, const bf16_t* __restrict__ PROJ, bf16_t* __restrict__ YU, const float* __restrict__ KS,
                                          const float* __restrict__ F2, const float* __restrict__ gqk, int b, int h, int qb) {
    int tid_o = threadIdx.x; asm volatile("" : "+v"(tid_o));
    const int tid = tid_o, lane = tid & 63, r32 = lane & 31, hi = lane >> 5;
    const int wid = __builtin_amdgcn_readfirstlane(tid >> 6);
    const int qcol = (KIND == 0 ? 1024 : 1792) + h * 64, kcol = qcol + 256, vcol = qcol + 512;
    const size_t rowbase = (size_t)b * SEQL; const int q0 = qb * 256, bh = b * 4 + h;
    const int NT = (q0 + 256) / 64;
    const bf16_t* ksrc = PROJ + (rowbase + lane) * PPITCH + kcol + wid * 8;
    const bf16_t* vsrc = PROJ + (rowbase + 16 * (wid & 3) + (lane >> 2)) * PPITCH + vcol + (wid >> 2) * 32 + (lane & 3) * 8;
    const float* axsrc = F2 + (size_t)bh * SEQL + lane;
    u32x4 kreg, vreg; float areg = 0.f;
#define AT_LOAD(it_) do { const int kt_ = NT - 1 - (it_); kreg = *(const u32x4*)(ksrc + (size_t)kt_ * 64 * PPITCH); vreg = *(const u32x4*)(vsrc + (size_t)kt_ * 64 * PPITCH); \
        if (KIND == 1 && wid == 0) areg = axsrc[kt_ * 64]; } while (0)
#define AT_STORE(slot_) do { *(LAS u32x4*)(lds + (slot_) * AT_SLOT + wid * 1024 + lane * 16) = kreg; *(LAS u32x4*)(lds + (slot_) * AT_SLOT + 8192 + wid * 1024 + lane * 16) = vreg; \
        if (KIND == 1 && wid == 0) *(LAS float*)(lds + AT_AUX + (slot_) * 512 + lane * 4) = areg; } while (0)
    const bf16_t* Qw = PROJ + (rowbase + q0 + wid * 32 + r32) * PPITCH + qcol + hi * 8;
    bf16x8 qr[4];
#pragma unroll
    for (int d0 = 0; d0 < 4; ++d0) qr[d0] = *(const bf16x8*)(Qw + d0 * 16);
    AT_LOAD(0);
    float qn2 = 0.f, mref = 0.f;
    if (KIND == 1) {
        float qf[4][8]; float ss = 0.f;
#pragma unroll
        for (int d0 = 0; d0 < 4; ++d0)
#pragma unroll
            for (int i = 0; i < 8; ++i) { qf[d0][i] = bf2f((unsigned short)qr[d0][i]); ss += qf[d0][i] * qf[d0][i]; }
        ss += __shfl_xor(ss, 32);
        const float rs = __builtin_amdgcn_rsqf(ss * (1.0f / 64.0f) + EPSF) * C2;
#pragma unroll
        for (int d0 = 0; d0 < 4; ++d0) {
            const float* gp = gqk + d0 * 16 + hi * 8; float v[8];
#pragma unroll
            for (int i = 0; i < 8; ++i) { v[i] = qf[d0][i] * rs * gp[i] * gp[64 + i]; qn2 += v[i] * v[i]; }
            u32x4 w; w.x = pk2(v[0], v[1]); w.y = pk2(v[2], v[3]); w.z = pk2(v[4], v[5]); w.w = pk2(v[6], v[7]);
            qr[d0] = __builtin_bit_cast(bf16x8, w);
        }
        qn2 += __shfl_xor(qn2, 32);
        mref = F2[(size_t)bh * SEQL + q0 + wid * 32 + r32] + __builtin_fminf(8.08f * __builtin_sqrtf(qn2), 60.0f);
    }
    f32x16 o0, o1;
#pragma unroll
    for (int r = 0; r < 16; ++r) { o0[r] = 0.f; o1[r] = 0.f; }
    float mhat = -1e30f, lsum = 0.f, carry = 0.f;
    LAS float* wsf = (LAS float*)(lds + AT_WSF) + wid * 64;
    LAS unsigned* votes = (LAS unsigned*)(lds + AT_VOTE);
    const int qrel = wid * 32 + r32;
    bool wdone = false;
    AT_STORE(0); LBAR();
    for (int it = 0; it < NT; ++it) {
        const int slot = it & 1;
        if (KIND == 0 && it > 0) {
            const LAS unsigned* vp = votes + ((it - 1) & 1) * 8;
            const unsigned all = vp[0] & vp[1] & vp[2] & vp[3] & vp[4] & vp[5] & vp[6] & vp[7];
            if (all) break;
        }
        if (it + 1 < NT) AT_LOAD(it + 1);
        const int kt = NT - 1 - it, jb = kt - (NT - 4);
        const bool band = jb >= 0;
        const bool active = !(band && 64 * jb > 32 * wid + 31) && !wdone;
        if (active) {
            f32x16 p0, p1;
            __builtin_amdgcn_s_setprio(1);
            { const LAS unsigned char* kb = lds + slot * AT_SLOT + hi * 1024 + r32 * 16;
#pragma unroll
              for (int d0 = 0; d0 < 4; ++d0) {
                  const bf16x8 b0 = *(const LAS bf16x8*)(kb + d0 * 2048), b1 = *(const LAS bf16x8*)(kb + d0 * 2048 + 512);
                  if (d0 == 0) { f32x16 z;
#pragma unroll
                      for (int r = 0; r < 16; ++r) z[r] = (KIND == 1) ? -mref : 0.f;
                      p0 = __builtin_amdgcn_mfma_f32_32x32x16_bf16(b0, qr[0], z, 0, 0, 0); p1 = __builtin_amdgcn_mfma_f32_32x32x16_bf16(b1, qr[0], z, 0, 0, 0); }
                  else { p0 = __builtin_amdgcn_mfma_f32_32x32x16_bf16(b0, qr[d0], p0, 0, 0, 0); p1 = __builtin_amdgcn_mfma_f32_32x32x16_bf16(b1, qr[d0], p1, 0, 0, 0); }
              } }
            __builtin_amdgcn_s_setprio(0);
            if (KIND == 0) {
                sb_block(p1, carry, band, 64 * jb + 32 + 4 * hi, qrel, hi);
                sb_block(p0, carry, band, 64 * jb + 4 * hi, qrel, hi);
            } else {
                const LAS float* ax = (const LAS float*)(lds + AT_AUX + slot * 512);
                f32x2 sacc2 = (f32x2){0.f, 0.f};
#pragma unroll
                for (int g = 0; g < 4; ++g) {
                    const f32x4 f0 = *(const LAS f32x4*)(ax + 8 * g + 4 * hi), f1 = *(const LAS f32x4*)(ax + 32 + 8 * g + 4 * hi);
#pragma unroll
                    for (int i = 0; i < 4; ++i) { p0[4 * g + i] += f0[i]; p1[4 * g + i] += f1[i]; }
                }
                if (band) {
#pragma unroll
                    for (int r = 0; r < 16; ++r) { const int kv = 64 * jb + crow(r, hi); if (kv > qrel) p0[r] = -INFINITY; if (kv + 32 > qrel) p1[r] = -INFINITY; }
                }
#pragma unroll
                for (int r = 0; r < 16; r += 2) {
                    p0[r] = __builtin_amdgcn_exp2f(p0[r]); p0[r + 1] = __builtin_amdgcn_exp2f(p0[r + 1]); p1[r] = __builtin_amdgcn_exp2f(p1[r]); p1[r + 1] = __builtin_amdgcn_exp2f(p1[r + 1]);
                    sacc2 += (f32x2){p0[r], p0[r + 1]}; sacc2 += (f32x2){p1[r], p1[r + 1]};
                }
                lsum += sacc2[0] + sacc2[1];
            }
            u32x4 pw0, pw1, pw2, pw3;
            pw0.x = pk2(p0[0], p0[1]); pw0.y = pk2(p0[2], p0[3]); pw0.z = pk2(p0[4], p0[5]); pw0.w = pk2(p0[6], p0[7]);
            pw1.x = pk2(p0[8], p0[9]); pw1.y = pk2(p0[10], p0[11]); pw1.z = pk2(p0[12], p0[13]); pw1.w = pk2(p0[14], p0[15]);
            pw2.x = pk2(p1[0], p1[1]); pw2.y = pk2(p1[2], p1[3]); pw2.z = pk2(p1[4], p1[5]); pw2.w = pk2(p1[6], p1[7]);
            pw3.x = pk2(p1[8], p1[9]); pw3.y = pk2(p1[10], p1[11]); pw3.z = pk2(p1[12], p1[13]); pw3.w = pk2(p1[14], p1[15]);
            const LAS unsigned char* vb = lds + slot * AT_SLOT + 8192 + ((lane >> 4) & 1) * 32 + (lane & 3) * 8 + (4 * hi + ((lane & 15) >> 2)) * 64;
            s16x4 vlo[8], vhi[8];
#pragma unroll
            for (int i = 0; i < 8; ++i) { vlo[i] = vtr(vb + (i >> 2) * 4096 + (i & 3) * 1024); vhi[i] = vtr(vb + (i >> 2) * 4096 + (i & 3) * 1024 + 512); }
#define VFR(i) (bf16x8){vlo[i][0], vlo[i][1], vlo[i][2], vlo[i][3], vhi[i][0], vhi[i][1], vhi[i][2], vhi[i][3]}
#define PAF(x) __builtin_bit_cast(bf16x8, x)
            __builtin_amdgcn_s_setprio(1);
            o0 = __builtin_amdgcn_mfma_f32_32x32x16_bf16(PAF(pw0), VFR(0), o0, 0, 0, 0); o1 = __builtin_amdgcn_mfma_f32_32x32x16_bf16(PAF(pw0), VFR(4), o1, 0, 0, 0);
            o0 = __builtin_amdgcn_mfma_f32_32x32x16_bf16(PAF(pw1), VFR(1), o0, 0, 0, 0); o1 = __builtin_amdgcn_mfma_f32_32x32x16_bf16(PAF(pw1), VFR(5), o1, 0, 0, 0);
            o0 = __builtin_amdgcn_mfma_f32_32x32x16_bf16(PAF(pw2), VFR(2), o0, 0, 0, 0); o1 = __builtin_amdgcn_mfma_f32_32x32x16_bf16(PAF(pw2), VFR(6), o1, 0, 0, 0);
            o0 = __builtin_amdgcn_mfma_f32_32x32x16_bf16(PAF(pw3), VFR(3), o0, 0, 0, 0); o1 = __builtin_amdgcn_mfma_f32_32x32x16_bf16(PAF(pw3), VFR(7), o1, 0, 0, 0);
            __builtin_amdgcn_s_setprio(0);
#undef VFR
#undef PAF
        }
        if (KIND == 0) { if (active) wdone = __all(carry < -150.0f); if (lane == 0) votes[(it & 1) * 8 + wid] = wdone ? 1u : 0u; }
        if (it + 1 < NT) AT_STORE(slot ^ 1);
        LBAR();
    }
    if (KIND == 1) { lsum += __shfl_xor(lsum, 32); CFENCE(); if (hi == 0) wsf[r32] = lsum; CFENCE(); asm volatile("s_waitcnt lgkmcnt(0)" ::: "memory"); }
    bf16_t* Yw = YU + (rowbase + q0 + wid * 32) * 512 + KIND * 256 + h * 64 + r32;
#pragma unroll
    for (int r = 0; r < 16; ++r) {
        const int orow = crow(r, hi); float sc = 1.0f;
        if (KIND == 1) sc = __builtin_amdgcn_rcpf(wsf[orow]);
        Yw[(size_t)orow * 512] = (bf16_t)f2bf(o0[r] * sc); Yw[(size_t)orow * 512 + 32] = (bf16_t)f2bf(o1[r] * sc);
    }
    LBAR();
#undef AT_LOAD
#undef AT_STORE
}

#define DEFPTRS \
    const __attribute__((address_space(4))) Args* ka_ = (const __attribute__((address_space(4))) Args*)__builtin_amdgcn_kernarg_segment_ptr(); \
    asm volatile("" : "+s"(ka_)); \
    int tid_o_ = threadIdx.x; asm volatile("" : "+v"(tid_o_)); const int tid = tid_o_, lane = tid & 63; (void)lane; \
    unsigned char* ws = ka_->ws; \
    const float* x_in = ka_->in[0]; const float* c_in = ka_->in[1]; const float* w_ada = ka_->in[2]; const float* b_ada = ka_->in[3]; const float* g_norm = ka_->in[4]; \
    const float* w_up = ka_->in[5]; const float* w_dn = ka_->in[6]; const float* w_in = ka_->in[7]; const float* b_fg = ka_->in[8]; const float* conv_w = ka_->in[9]; \
    const float* conv_b = ka_->in[10]; const float* w_rg = ka_->in[11]; const float* b_rg = ka_->in[12]; const float* w_ig = ka_->in[13]; const float* b_ig = ka_->in[14]; \
    const float* lam = ka_->in[15]; const float* g_qk = ka_->in[16]; const float* g_mix = ka_->in[17]; const float* w_out = ka_->in[18]; \
    float* xout = ka_->out; \
    float* MOD = (float*)(ws + WS_MOD); float* GMOD = (float*)(ws + WS_GMOD); float* GATE = (float*)(ws + WS_GATE); float* SBV = (float*)(ws + WS_SB); \
    float* ROWSS = (float*)(ws + WS_ROWSS); float* KS = (float*)(ws + WS_KS); float* F2 = (float*)(ws + WS_F2); float* FG = (float*)(ws + WS_FG); \
    float* ASEG = (float*)(ws + WS_ASEG); float* BSEG = (float*)(ws + WS_BSEG); \
    bf16_t* WUP = (bf16_t*)(ws + WS_WUP); bf16_t* WDN = (bf16_t*)(ws + WS_WDN); bf16_t* WIN = (bf16_t*)(ws + WS_WIN); bf16_t* WOUT = (bf16_t*)(ws + WS_WOUT); \
    bf16_t* XN = (bf16_t*)(ws + WS_XN); bf16_t* HB = (bf16_t*)(ws + WS_H); bf16_t* PROJ = (bf16_t*)(ws + WS_PROJ); bf16_t* YU = (bf16_t*)(ws + WS_YU); \
    bf16_t* HLOC = (bf16_t*)(ws + WS_HLOC); bf16_t* PCUM = (bf16_t*)(ws + WS_PCUM); bf16_t* YN = (bf16_t*)(ws + WS_YN);
#define XB_TMO      128
#define XB_XCNT(j)  (256  + 64 * (j))
#define XB_XSUB(j)  (1280 + 64 * (j))
#define XB_XGEN(j)  (2304 + 64 * (j))
#define XB_TOP      3328
#define XB_TOPGEN   3392
#define XCD_BAR_WORDS 3456
#define XB_SPIN_CAP (1u << 18)

__device__ __forceinline__ unsigned xb_ld(unsigned* p)              { return __hip_atomic_load(p, __ATOMIC_RELAXED, __HIP_MEMORY_SCOPE_AGENT); }
__device__ __forceinline__ unsigned xb_add(unsigned* p, unsigned v) { return __hip_atomic_fetch_add(p, v, __ATOMIC_RELAXED, __HIP_MEMORY_SCOPE_AGENT); }
__device__ __forceinline__ unsigned xb_xcc_id() { return (unsigned)__builtin_amdgcn_s_getreg((3 << 11) | 20) & 0xFu; }
#define XB_SPIN(cond, bar) do { unsigned _sp = 0; while (cond) { __builtin_amdgcn_s_sleep(1); \
    if ((++_sp & 255u) == 0u) { if (xb_ld(&(bar)[XB_TMO])) break; if (_sp > XB_SPIN_CAP) { atomicAdd(&(bar)[XB_TMO], 1u); break; } } } } while (0)

struct XcdBarrier {
    unsigned* bar; unsigned x;
    volatile LAS unsigned* st;
};

__device__ __forceinline__ XcdBarrier xcd_barrier_post(unsigned* bar, volatile LAS unsigned* st) {
    XcdBarrier b; b.bar = bar; b.x = xb_xcc_id(); b.st = st;
    if (threadIdx.x == 0) (void)xb_add(&bar[XB_XCNT(b.x)], 1u);
    return b;
}
__device__ __forceinline__ void xcd_barrier_complete(unsigned* bar, unsigned x, unsigned& nloc, unsigned& nx) {
    const unsigned G = gridDim.x * gridDim.y * gridDim.z;
    unsigned sum, cnt, mine, sp = 0u;
    for (;;) {
        sum = 0u; cnt = 0u; mine = 0u;
#pragma unroll
        for (unsigned j = 0; j < 16; ++j) { const unsigned c = xb_ld(&bar[XB_XCNT(j)]); sum += c; cnt += (c > 0u) ? 1u : 0u; mine = (j == x) ? c : mine; }
        if (sum == G) break;
        __builtin_amdgcn_s_sleep(1);
        if ((++sp & 255u) == 0u) { if (xb_ld(&bar[XB_TMO])) break; if (sp > XB_SPIN_CAP) { atomicAdd(&bar[XB_TMO], 1u); break; } }
    }
    nloc = mine > 0u ? mine : 1u; nx = cnt > 0u ? cnt : 1u;
}

__device__ __forceinline__ void xcd_barrier(const XcdBarrier& b) {
    asm volatile("s_waitcnt vmcnt(0)" ::: "memory");
    __syncthreads();
    if (threadIdx.x == 0) {
        unsigned* bar = b.bar;
        __builtin_amdgcn_s_waitcnt(0);
        unsigned nloc = b.st[0], nx = b.st[1];
        if (nloc == 0u) { xcd_barrier_complete(bar, b.x, nloc, nx); b.st[0] = nloc; b.st[1] = nx; }
        const unsigned old = xb_add(&bar[XB_XSUB(b.x)], 1u);
        const unsigned gen = old / nloc;
        if (old + 1u == (gen + 1u) * nloc) {
            __builtin_amdgcn_fence(__ATOMIC_RELEASE, "agent");
            asm volatile("s_waitcnt vmcnt(0)" ::: "memory");
            const unsigned og = xb_add(&bar[XB_TOP], 1u);
            const unsigned tg = og / nx;
            if (og + 1u == (tg + 1u) * nx) xb_add(&bar[XB_TOPGEN], 1u);
            else XB_SPIN(xb_ld(&bar[XB_TOPGEN]) == tg, bar);
            __builtin_amdgcn_fence(__ATOMIC_ACQUIRE, "agent");
            xb_add(&bar[XB_XGEN(b.x)], 1u);
            asm volatile("s_waitcnt vmcnt(0)" ::: "memory");
        } else {
            XB_SPIN(xb_ld(&bar[XB_XGEN(b.x)]) == gen, bar);
            __builtin_amdgcn_fence(__ATOMIC_ACQUIRE, "agent");
            asm volatile("s_waitcnt vmcnt(0)" ::: "memory");
        }
    }
    __syncthreads();
}

__global__ void __launch_bounds__(512) mk_fwd(Args args) {
    extern __shared__ __attribute__((aligned(16))) unsigned char lds_raw[];
    LAS unsigned char* lds = (LAS unsigned char*)lds_raw;
    cg::grid_group grid = cg::this_grid();
    const int wave = __builtin_amdgcn_readfirstlane(threadIdx.x >> 6);
    const int G = gridDim.x; const int bx = blockIdx.x;
    const int vcu = (G % 8 == 0) ? (bx % 8) * (G / 8) + bx / 8 : bx;
    const int gw = vcu * 8 + wave, NGW = G * 8;
    const int lo = args.ph_lo, hi_ph = args.ph_hi;
    volatile LAS unsigned* MISC = (volatile LAS unsigned*)(lds + 131072 + 320);
    if (threadIdx.x < 16) MISC[threadIdx.x] = 0u;
    __syncthreads();
    XcdBarrier xbar = xcd_barrier_post((unsigned*)args.ws, MISC + 8);
    int ph = 0;
#define PH_ON (ph >= lo && ph < hi_ph)
#ifdef REP_SYNC
#define SYNC_EXTRA grid.sync(); asm volatile("" ::: "memory");
#else
#define SYNC_EXTRA
#endif
#define PH_NEXT do { ++ph; if (ph > lo && ph < hi_ph) { asm volatile("s_waitcnt vmcnt(0) lgkmcnt(0)" ::: "memory"); if (ph == 1) grid.sync(); else xcd_barrier(xbar); asm volatile("" ::: "memory"); SYNC_EXTRA } } while (0)

#ifdef REP_PRO
    int rp_ = 0; pro_again:
#endif
    if (PH_ON) { DEFPTRS
        for (int i = bx * 512 + tid; i < 5 * MTOK; i += G * 512) ROWSS[MTOK + i] = 0.f;
        LAS float* cact = (LAS float*)lds;
        LAS float* red = (LAS float*)(lds + 65536);
        for (int i = tid; i < 16 * 1024; i += 512) { const int b = i >> 10, k = i & 1023; const float v = c_in[i]; cact[k * 16 + b] = v * sigmoidf_(v); }
        __syncthreads();
        for (int task = bx; task < 288; task += G) {
            const int l = task / 144, n0 = (task % 144) * 64;
            float acc[16];
#pragma unroll
            for (int b = 0; b < 16; ++b) acc[b] = 0.f;
            const float* wp = w_ada + (size_t)l * 1024 * 9216 + n0 + lane;
#pragma unroll 1
            for (int k0 = wave * 128; k0 < wave * 128 + 128; k0 += 16) {
                float wv[16];
#pragma unroll
                for (int j = 0; j < 16; ++j) wv[j] = wp[(size_t)(k0 + j) * 9216];
                CFENCE();
#pragma unroll
                for (int j = 0; j < 16; ++j) { const int k = k0 + j; const float w = wv[j];
                    const f32x4 c0 = *(const LAS f32x4*)(cact + k * 16), c1 = *(const LAS f32x4*)(cact + k * 16 + 4), c2 = *(const LAS f32x4*)(cact + k * 16 + 8), c3 = *(const LAS f32x4*)(cact + k * 16 + 12);
#pragma unroll
                    for (int i = 0; i < 4; ++i) { acc[i] += c0[i] * w; acc[4 + i] += c1[i] * w; acc[8 + i] += c2[i] * w; acc[12 + i] += c3[i] * w; }
                    if ((j & 3) == 3) CFENCE(); }
            }
#pragma unroll
            for (int b = 0; b < 16; ++b) red[(wave * 16 + b) * 64 + lane] = acc[b];
            __syncthreads();
            for (int o = tid; o < 1024; o += 512) { const int b = o >> 6, ln = o & 63; float s = 0.f;
#pragma unroll
                for (int w = 0; w < 8; ++w) s += red[(w * 16 + b) * 64 + ln];
                MOD[((size_t)l * 16 + b) * 9216 + n0 + ln] = s + b_ada[l * 9216 + n0 + ln]; }
            __syncthreads();
        }
    }
    PH_NEXT;
    if (PH_ON) { DEFPTRS
        for (int i = bx * 512 + tid; i < 2 * 3 * 16 * 1024; i += G * 512) {
            const int k = i & 1023, b = (i >> 10) & 15, lj = i >> 14, l = lj / 3, j = lj % 3;
            const float* mp = MOD + ((size_t)l * 16 + b) * 9216 + j * 3072;
            GMOD[i] = g_norm[(l * 3 + j) * 1024 + k] * (1.0f + mp[1024 + k]);
            GATE[i] = (j == 1 ? 1.0f : 0.5f) * (1.0f + mp[2048 + k]);
        }
        LAS float* scr = (LAS float*)(lds + wave * 8448);
        constexpr int I_UP = 16 * 176, I_DN = 44 * 32, I_IN = 16 * 88, I_OUT = 16 * 32;
        constexpr int NIT = 4 * I_UP + 4 * I_DN + 2 * I_IN + 2 * I_OUT;
        for (int it = gw; it < NIT; it += NGW) {
            int r = it;
            if (r < 4 * I_UP) { const int mat = r / I_UP; r -= mat * I_UP; const int kb = r / 176, nb = r % 176, n0 = nb * 32;
                const int c0 = ((n0 >> 7) & 1) * DFF + (n0 >> 8) * 128 + (n0 & 127);
                transpose_item(w_up + (size_t)mat * DM * NUP, NUP, NUP, DM, WUP + (size_t)mat * NUP * DM, n0, c0, kb * 64, scr, lane); continue; }
            r -= 4 * I_UP;
            if (r < 4 * I_DN) { const int mat = r / I_DN; r -= mat * I_DN; const int kb = r / 32, nb = r % 32;
                transpose_item(w_dn + (size_t)mat * DFF * DM, DM, DM, DFF, WDN + (size_t)mat * DM * DFF, nb * 32, nb * 32, kb * 64, scr, lane); continue; }
            r -= 4 * I_DN;
            if (r < 2 * I_IN) { const int mat = r / I_IN; r -= mat * I_IN; const int kb = r / 88, nb = r % 88;
                transpose_item(w_in + (size_t)mat * DM * 2564, 2564, 2564, DM, WIN + (size_t)mat * NINP * DM, nb * 32, nb * 32, kb * 64, scr, lane); continue; }
            r -= 2 * I_IN;
            { const int mat = r / I_OUT; r -= mat * I_OUT; const int kb = r / 32, nb = r % 32;
                transpose_item(w_out + (size_t)mat * DM * DM, DM, DM, DM, WOUT + (size_t)mat * DM * DM, nb * 32, nb * 32, kb * 64, scr, lane); }
        }
        for (int m0 = gw; m0 < MTOK; m0 += 2 * NGW) {
            const int m1 = m0 + NGW;
            const f32x4* gp = (const f32x4*)(g_norm) + lane;
            const f32x4* xr0 = (const f32x4*)(x_in + (size_t)m0 * DM) + lane; const f32x4* xr1 = (const f32x4*)(x_in + (size_t)m1 * DM) + lane;
            f32x4 v0[4], v1[4];
#pragma unroll
            for (int j = 0; j < 4; ++j) { v0[j] = xr0[64 * j]; v1[j] = xr1[64 * j]; }
            const f32x4* sp0 = (const f32x4*)(MOD + (size_t)(m0 >> 12) * 9216 + 1024) + lane; const f32x4* sp1 = (const f32x4*)(MOD + (size_t)(m1 >> 12) * 9216 + 1024) + lane;
            float s0 = 0.f, s1 = 0.f; u32x2* o0 = (u32x2*)(XN + (size_t)m0 * DM) + lane; u32x2* o1 = (u32x2*)(XN + (size_t)m1 * DM) + lane;
#pragma unroll
            for (int j = 0; j < 4; ++j) { const f32x4 g = gp[64 * j];
                { const f32x4 v = v0[j]; s0 += (v[0] * v[0] + v[1] * v[1]) + (v[2] * v[2] + v[3] * v[3]); const f32x4 a = v * g * (sp0[64 * j] + 1.0f); u32x2 w; w.x = pk2(a[0], a[1]); w.y = pk2(a[2], a[3]); o0[64 * j] = w; }
                { const f32x4 v = v1[j]; s1 += (v[0] * v[0] + v[1] * v[1]) + (v[2] * v[2] + v[3] * v[3]); const f32x4 a = v * g * (sp1[64 * j] + 1.0f); u32x2 w; w.x = pk2(a[0], a[1]); w.y = pk2(a[2], a[3]); o1[64 * j] = w; } }
            s0 = wave_sum(s0); s1 = wave_sum(s1);
            if (lane == 0) { ROWSS[m0] = s0; ROWSS[m1] = s1; }
        }
    }
    PH_NEXT;
    if (PH_ON) { DEFPTRS
        LAS float* sh = (LAS float*)lds;
        for (int combo = 0; combo < 6; ++combo) {
            const int l = combo / 3, j = combo % 3;
            __syncthreads();
            for (int i = tid; i < 16 * 1024; i += 512) { const int b = i >> 10, k = i & 1023; sh[i] = MOD[((size_t)l * 16 + b) * 9216 + j * 3072 + k]; }
            __syncthreads();
            const bf16_t* Wt = (j == 1) ? WIN + (size_t)l * NINP * DM : WUP + (size_t)(l * 2 + (j == 2 ? 1 : 0)) * NUP * DM;
            const int N = (j == 1) ? NINP : NUP;
            float* dst = SBV + (size_t)combo * 16 * 5632;
            for (int n = gw; n < N; n += NGW) {
                float w[16];
#pragma unroll
                for (int c = 0; c < 4; ++c) { const u32x2 q = *(const u32x2*)(Wt + (size_t)n * DM + c * 256 + lane * 4);
                    w[4 * c] = __uint_as_float(q.x << 16); w[4 * c + 1] = __uint_as_float(q.x & 0xffff0000u); w[4 * c + 2] = __uint_as_float(q.y << 16); w[4 * c + 3] = __uint_as_float(q.y & 0xffff0000u); }
                float sv[16];
#pragma unroll
                for (int b = 0; b < 16; ++b) { float s = 0.f;
#pragma unroll
                    for (int c = 0; c < 4; ++c) { const f32x4 v = *(const LAS f32x4*)(sh + b * 1024 + c * 256 + lane * 4); s += (w[4 * c] * v[0] + w[4 * c + 1] * v[1]) + (w[4 * c + 2] * v[2] + w[4 * c + 3] * v[3]); }
                    sv[b] = s; if ((b & 3) == 3) CFENCE(); }
                float t8[8], t4[4], t2[2];
#pragma unroll
                for (int i = 0; i < 8; ++i) { const float snd = (lane & 32) ? sv[i] : sv[i + 8], kp = (lane & 32) ? sv[i + 8] : sv[i]; t8[i] = kp + __shfl_xor(snd, 32); }
#pragma unroll
                for (int i = 0; i < 4; ++i) { const float snd = (lane & 16) ? t8[i] : t8[i + 4], kp = (lane & 16) ? t8[i + 4] : t8[i]; t4[i] = kp + __shfl_xor(snd, 16); }
#pragma unroll
                for (int i = 0; i < 2; ++i) { const float snd = (lane & 8) ? t4[i] : t4[i + 2], kp = (lane & 8) ? t4[i + 2] : t4[i]; t2[i] = kp + __shfl_xor(snd, 8); }
                float t1; { const float snd = (lane & 4) ? t2[0] : t2[1], kp = (lane & 4) ? t2[1] : t2[0]; t1 = kp + __shfl_xor(snd, 4); }
                t1 += __shfl_xor(t1, 2); t1 += __shfl_xor(t1, 1);
                const int bsel = ((lane >> 5) & 1) * 8 + ((lane >> 4) & 1) * 4 + ((lane >> 3) & 1) * 2 + ((lane >> 2) & 1);
                if ((lane & 3) == 0) dst[(size_t)bsel * 5632 + n] = t1;
            }
        }
        __syncthreads();
    }
    PH_NEXT;

#ifdef REP_PRO
    if (rp_ == 0) { rp_ = 1; ph = 0; goto pro_again; }
#endif
#pragma unroll 1
    for (int f = 0; f < 4; ++f) {
        const int l = f >> 1, s = f & 1;
        if (s == 1) {
            if (PH_ON) { DEFPTRS
                pg8::Gemm g{XN, WIN + (size_t)l * NINP * DM, MTOK, NINP, DM}; pg8::StaticOrder S; S.init(MTOK, NINP, G, bx);
                pg8::EpiIn E{PROJ, FG, ROWSS + (size_t)(l * 3 + 1) * MTOK, SBV + (size_t)(l * 3 + 1) * 16 * 5632};
#ifndef NO_G_IN
                for (int rep_ = 0; rep_ < REP_IN; ++rep_) {
                pg8::gemm_phase<pg8::EpiIn, pg8::StaticOrder, true, true>(lds, g, S, E); }
#endif
            }
            PH_NEXT;
            if (PH_ON) { DEFPTRS
#ifndef NO_PREP
                {
                    const int blk = vcu & 7, n = lane & 31, hi = lane >> 5;
                    LAS unsigned char* wfl = lds;
                    LAS float* xs = (LAS float*)(lds + 16384 + wave * 13568);
                    LAS unsigned char* ub = lds + 16384 + wave * 13568 + 8960;
#pragma unroll
                    for (int q = 0; q < 2; ++q) { const int f = wave * 2 + q, gt = f >> 3, nb = (f >> 2) & 1, d0 = f & 3;
                        const float* wsrc = (gt ? w_ig : w_rg) + ((size_t)(l * 8 + blk) * 64 + 16 * d0 + 8 * hi) * 64 + nb * 32 + n;
                        u32x4 w; w.x = pk2(wsrc[0], wsrc[64]); w.y = pk2(wsrc[128], wsrc[192]); w.z = pk2(wsrc[256], wsrc[320]); w.w = pk2(wsrc[384], wsrc[448]);
                        *(LAS u32x4*)(wfl + f * 1024 + lane * 16) = w; }
                    __syncthreads();
                    float br[2], bi[2], cb[2], cw[2][4], c8[2];
#pragma unroll
                    for (int nb = 0; nb < 2; ++nb) { const int ch = blk * 64 + nb * 32 + n;
                        br[nb] = b_rg[l * 512 + ch]; bi[nb] = b_ig[l * 512 + ch]; cb[nb] = conv_b[l * 512 + ch];
#pragma unroll
                        for (int k = 0; k < 4; ++k) cw[nb][k] = conv_w[(l * 4 + k) * 512 + ch];
                        const float lmv = lam[l * 512 + ch];
                        c8[nb] = -8.0f * LOG2E * (__builtin_fmaxf(-lmv, 0.f) + log1pf(expf(-fabsf(lmv)))); }
                    for (int segi = (vcu >> 3) * 8 + wave; segi < REP_PREP * (MTOK / 32); segi += (G >> 3) * 8) { const int seg = segi & (MTOK / 32 - 1);
                        const int row0 = seg * 32; const bool first = (row0 & (SEQL - 1)) == 0;
                        const bf16_t* xp = PROJ + (size_t)row0 * PPITCH + blk * 64;
                        CFENCE();
#pragma unroll
                        for (int t = 0; t < 35; ++t) { float v = 0.f; if (t >= 3 || !first) v = bf2f((xp + ((long)t - 3) * PPITCH)[lane]); xs[t * 64 + lane] = v; }
                        CFENCE();
#pragma unroll
                        for (int nb = 0; nb < 2; ++nb)
#pragma unroll
                            for (int g = 0; g < 4; ++g) { const LAS float* xb = xs + (8 * g + 4 * hi) * 64 + nb * 32 + n; float xv[7];
#pragma unroll
                                for (int j = 0; j < 7; ++j) xv[j] = xb[j * 64];
#pragma unroll
                                for (int i = 0; i < 4; ++i) { const float uu = cb[nb] + cw[nb][0] * xv[i] + cw[nb][1] * xv[i + 1] + cw[nb][2] * xv[i + 2] + cw[nb][3] * xv[i + 3];
                                    *(LAS unsigned short*)(ub + (8 * g + 4 * hi + i) * 144 + (nb * 32 + n) * 2) = (unsigned short)f2bf(uu); }
                                __builtin_amdgcn_sched_barrier(0); }
                        CFENCE();
                        bf16x8 af[4];
#pragma unroll
                        for (int d0 = 0; d0 < 4; ++d0) af[d0] = *(const LAS bf16x8*)(ub + n * 144 + (16 * d0 + 8 * hi) * 2);
#pragma unroll
                        for (int nb = 0; nb < 2; ++nb) {
                            f32x16 arx, aix;
#pragma unroll
                            for (int r = 0; r < 16; ++r) { arx[r] = br[nb]; aix[r] = bi[nb]; }
#pragma unroll
                            for (int d0 = 0; d0 < 4; ++d0) { const bf16x8 w0 = *(const LAS bf16x8*)(wfl + ((0 * 2 + nb) * 4 + d0) * 1024 + lane * 16), w1 = *(const LAS bf16x8*)(wfl + ((1 * 2 + nb) * 4 + d0) * 1024 + lane * 16);
                                                             arx = __builtin_amdgcn_mfma_f32_32x32x16_bf16(af[d0], w0, arx, 0, 0, 0);
                                                             aix = __builtin_amdgcn_mfma_f32_32x32x16_bf16(af[d0], w1, aix, 0, 0, 0); }
                            CFENCE(); __builtin_amdgcn_sched_barrier(0);
#pragma unroll
                            for (int r = 0; r < 16; ++r) {
                                float uu; { const LAS float* xb = xs + (8 * (r >> 2) + 4 * hi + (r & 3)) * 64 + nb * 32 + n;
                                    uu = cb[nb] + cw[nb][0] * xb[0] + cw[nb][1] * xb[64] + cw[nb][2] * xb[128] + cw[nb][3] * xb[192]; }
                                const float rg = sigmoidf_(arx[r]), ig = sigmoidf_(aix[r]);
                                const float la2 = c8[nb] * rg, a = __builtin_amdgcn_exp2f(la2);
                                const float xx = 2.0f * 0.6931471805599453f * la2;
                                const float om = (xx > -0.25f) ? -xx * (1.0f + xx * 0.5f * (1.0f + xx * (1.0f / 3.0f) * (1.0f + xx * 0.25f * (1.0f + xx * 0.2f)))) : 1.0f - a * a;
                                arx[r] = a; aix[r] = __builtin_sqrtf(om) * ig * uu;
                            }
                            float H = 0.f, P = 1.f;
                            const int ch = blk * 64 + nb * 32 + n;
                            bf16_t* hl = HLOC + (size_t)(row0 + 4 * hi) * 512 + ch; bf16_t* pc = PCUM + (size_t)(row0 + 4 * hi) * 512 + ch;
#pragma unroll
                            for (int g = 0; g < 4; ++g) {
                                const float a0 = arx[4 * g], a1 = arx[4 * g + 1], a2 = arx[4 * g + 2], a3 = arx[4 * g + 3];
                                const float b0 = aix[4 * g], b1 = aix[4 * g + 1], b2 = aix[4 * g + 2], b3 = aix[4 * g + 3];
                                const float Ao = (a0 * a1) * (a2 * a3), Bo = ((b0 * a1 + b1) * a2 + b2) * a3 + b3;
                                const float Ap = __shfl_xor(Ao, 32), Bp = __shfl_xor(Bo, 32);
                                const float A1 = hi ? Ap : Ao, B1 = hi ? Bp : Bo, A2 = hi ? Ao : Ap, B2 = hi ? Bo : Bp;
                                const float Hm = A1 * H + B1, Pm = A1 * P;
                                float h = hi ? Hm : H, p = hi ? Pm : P;
                                H = A2 * Hm + B2; P = A2 * Pm;
                                bf16_t* hg = hl + (size_t)g * 8 * 512; bf16_t* pg = pc + (size_t)g * 8 * 512; asm volatile("" : "+v"(hg), "+v"(pg));
                                h = a0 * h + b0; p *= a0; hg[0 * 512] = (bf16_t)f2bf(h); pg[0 * 512] = (bf16_t)f2bf(p);
                                h = a1 * h + b1; p *= a1; hg[1 * 512] = (bf16_t)f2bf(h); pg[1 * 512] = (bf16_t)f2bf(p);
                                h = a2 * h + b2; p *= a2; hg[2 * 512] = (bf16_t)f2bf(h); pg[2 * 512] = (bf16_t)f2bf(p);
                                h = a3 * h + b3; p *= a3; hg[3 * 512] = (bf16_t)f2bf(h); pg[3 * 512] = (bf16_t)f2bf(p);
                            }
                            if (hi == 0) { ASEG[(size_t)seg * 512 + ch] = P; BSEG[(size_t)seg * 512 + ch] = H; }
                            CFENCE(); __builtin_amdgcn_sched_barrier(0);
                        }
                    }
                }
                for (int row = gw; row < MTOK; row += NGW) {
                    const u32x2 q = *(const u32x2*)(PROJ + (size_t)row * PPITCH + 2048 + lane * 4);
                    const float a0 = __uint_as_float(q.x << 16), a1 = __uint_as_float(q.x & 0xffff0000u), a2 = __uint_as_float(q.y << 16), a3 = __uint_as_float(q.y & 0xffff0000u);
                    float ss = (a0 * a0 + a1 * a1) + (a2 * a2 + a3 * a3);
                    ss += __shfl_xor(ss, 1); ss += __shfl_xor(ss, 2); ss += __shfl_xor(ss, 4); ss += __shfl_xor(ss, 8);
                    const float rk = __builtin_amdgcn_rsqf(ss * (1.0f / 64.0f) + EPSF);
                    u32x2 kn; kn.x = pk2(a0 * rk, a1 * rk); kn.y = pk2(a2 * rk, a3 * rk);
                    *(u32x2*)(PROJ + (size_t)row * PPITCH + 2048 + lane * 4) = kn;
                }
                if (wave == 0) for (int chn = vcu; chn < 64; chn += G) {
                    const int b = chn >> 2, h = chn & 3; const float bf = b_fg[l * 4 + h];
                    const float* fp = FG + ((size_t)b * SEQL + lane * 64) * 4 + h;
                    float tot = 0.f;
#pragma unroll 8
                    for (int i = 0; i < 64; ++i) { const float v = fp[i * 4] + bf; tot += __builtin_fminf(v, 0.f) - log1pf(expf(-fabsf(v))); }
                    float inc = tot;
#pragma unroll
                    for (int o = 1; o < 64; o <<= 1) { const float t_ = __shfl_up(inc, o); if (lane >= o) inc += t_; }
                    float run = inc - tot;
                    float* op = F2 + (size_t)chn * SEQL + lane * 64;
#pragma unroll 8
                    for (int i = 0; i < 64; ++i) { const float v = fp[i * 4] + bf; run += __builtin_fminf(v, 0.f) - log1pf(expf(-fabsf(v))); op[i] = -run * LOG2E; }
                }
#endif
                __syncthreads();
            }
            PH_NEXT;
            if (PH_ON) { DEFPTRS
#ifndef NO_ATTN
                for (int rep_ = 0; rep_ < REP_ATTN; ++rep_)
                for (int vw = vcu; vw < 256; vw += G) {
                    const int bh = vw >> 2, s4 = vw & 3, b = bh >> 2, h = bh & 3;
#pragma unroll 1
                    for (int i = 0; i < 4; ++i) { const int qb = (i == 0) ? s4 : (i == 1) ? 7 - s4 : (i == 2) ? 8 + s4 : 15 - s4;
#ifndef NO_FOX
                        attn_unit<1>(lds, PROJ, YU, KS, F2, g_qk + l * 128, b, h, qb);
#endif
 }
#pragma unroll 1
                    for (int i = 0; i < 4; ++i) { const int qb = (i == 0) ? s4 : (i == 1) ? 7 - s4 : (i == 2) ? 8 + s4 : 15 - s4;
#ifndef NO_SB
                        attn_unit<0>(lds, PROJ, YU, KS, F2, g_qk + l * 128, b, h, qb);
#endif
 }
                }
#endif
            }
            PH_NEXT;
            if (PH_ON) { DEFPTRS
                LAS float* hin = (LAS float*)lds;
                const f32x4 gm0 = *(const f32x4*)(g_mix + l * 1024 + lane * 8), gm1 = *(const f32x4*)(g_mix + l * 1024 + lane * 8 + 4);
                const f32x4 gx0 = *(const f32x4*)(g_mix + l * 1024 + 512 + lane * 8), gx1 = *(const f32x4*)(g_mix + l * 1024 + 512 + lane * 8 + 4);
                for (int tti = vcu; tti < REP_FIN * 256; tti += G) { const int tt = tti & 255;
                    __syncthreads();
                    { const int ch = tid, seg0 = (tt >> 4) * 128, nb = (tt & 15) * 8; float Hc = 0.f;
#pragma unroll 8
                      for (int sg = 0; sg < nb; ++sg) Hc = ASEG[(size_t)(seg0 + sg) * 512 + ch] * Hc + BSEG[(size_t)(seg0 + sg) * 512 + ch];
#pragma unroll
                      for (int s8 = 0; s8 < 8; ++s8) { hin[s8 * 512 + ch] = Hc; Hc = ASEG[(size_t)(seg0 + nb + s8) * 512 + ch] * Hc + BSEG[(size_t)(seg0 + nb + s8) * 512 + ch]; } }
                    __syncthreads();
                    const f32x4 hi0 = *(const LAS f32x4*)(hin + wave * 512 + lane * 8), hi1 = *(const LAS f32x4*)(hin + wave * 512 + lane * 8 + 4);
#pragma unroll 2
                    for (int t = 0; t < 32; ++t) {
                        const size_t row = (size_t)tt * 256 + wave * 32 + t;
                        const u32x4 hq = *(const u32x4*)(HLOC + row * 512 + lane * 8);
                        const u32x4 pq = *(const u32x4*)(PCUM + row * 512 + lane * 8);
                        const u32x4 gq = *(const u32x4*)(PROJ + row * PPITCH + 512 + lane * 8);
                        const u32x4 yq = *(const u32x4*)(YU + row * 512 + lane * 8);
                        float y[8], yu[8]; float ss = 0.f, s2 = 0.f;
#pragma unroll
                        for (int i = 0; i < 8; ++i) {
                            const unsigned pw = pq[i >> 1], gw_ = gq[i >> 1], yw = yq[i >> 1];
                            const float p = (i & 1) ? __uint_as_float(pw & 0xffff0000u) : __uint_as_float(pw << 16);
                            const float gg = (i & 1) ? __uint_as_float(gw_ & 0xffff0000u) : __uint_as_float(gw_ << 16);
                            yu[i] = (i & 1) ? __uint_as_float(yw & 0xffff0000u) : __uint_as_float(yw << 16);
                            const unsigned hw = hq[i >> 1]; const float hlv = (i & 1) ? __uint_as_float(hw & 0xffff0000u) : __uint_as_float(hw << 16);
                            const float hh = hlv + p * (i < 4 ? hi0[i & 3] : hi1[i & 3]);
                            const float inner = 0.7978845608028654f * (gg + 0.044715f * gg * gg * gg);
                            const float ge = gg * __builtin_amdgcn_rcpf(1.0f + __builtin_amdgcn_exp2f(-2.0f * LOG2E * inner));
                            y[i] = hh * ge; ss += y[i] * y[i]; s2 += yu[i] * yu[i];
                        }
                        ss = wave_sum(ss);
                        s2 += __shfl_xor(s2, 1); s2 += __shfl_xor(s2, 2); s2 += __shfl_xor(s2, 4); s2 += __shfl_xor(s2, 8); s2 += __shfl_xor(s2, 16);
                        const float rl = __builtin_amdgcn_rsqf(ss * (1.0f / 512.0f) + EPSF), rx = __builtin_amdgcn_rsqf(s2 * (1.0f / 256.0f) + EPSF);
                        u32x4 o1, o2;
                        o1.x = pk2(y[0] * rl * gm0[0], y[1] * rl * gm0[1]); o1.y = pk2(y[2] * rl * gm0[2], y[3] * rl * gm0[3]);
                        o1.z = pk2(y[4] * rl * gm1[0], y[5] * rl * gm1[1]); o1.w = pk2(y[6] * rl * gm1[2], y[7] * rl * gm1[3]);
                        o2.x = pk2(yu[0] * rx * gx0[0], yu[1] * rx * gx0[1]); o2.y = pk2(yu[2] * rx * gx0[2], yu[3] * rx * gx0[3]);
                        o2.z = pk2(yu[4] * rx * gx1[0], yu[5] * rx * gx1[1]); o2.w = pk2(yu[6] * rx * gx1[2], yu[7] * rx * gx1[3]);
                        *(u32x4*)(YN + row * 1024 + lane * 8) = o1; *(u32x4*)(YN + row * 1024 + 512 + lane * 8) = o2;
                    }
                }
                __syncthreads();
            }
            PH_NEXT;
            if (PH_ON) { DEFPTRS
                pg8::Gemm g{YN, WOUT + (size_t)l * DM * DM, MTOK, DM, DM}; pg8::StaticOrder S; S.init(MTOK, DM, G, bx, 24);
                pg8::EpiRes E{xout, xout, GATE + (size_t)(l * 3 + 1) * 16 * 1024, GMOD + (size_t)(l * 3 + 2) * 16 * 1024, XN, ROWSS + (size_t)(l * 3 + 2) * MTOK, 1};
#ifndef NO_G_OUT
#ifdef REP_OUT
                { E.xout = (float*)HB; E.has_next = 0; pg8::gemm_phase<pg8::EpiRes, pg8::StaticOrder, true, true>(lds, g, S, E); E.xout = xout; E.has_next = 1; }
#endif
                pg8::gemm_phase<pg8::EpiRes, pg8::StaticOrder, true, true>(lds, g, S, E);
#endif
            }
            PH_NEXT;
        }
        const int j = s ? 2 : 0;
        if (PH_ON) { DEFPTRS
            pg8::Gemm g{XN, WUP + (size_t)(l * 2 + s) * NUP * DM, MTOK, NUP, DM}; pg8::StaticOrder S; S.init(MTOK, NUP, G, bx);
            pg8::EpiUp E{HB, ROWSS + (size_t)(l * 3 + j) * MTOK, SBV + (size_t)(l * 3 + j) * 16 * 5632};
#ifndef NO_G_UP
            for (int rep_ = 0; rep_ < REP_UP; ++rep_) {
            pg8::gemm_phase<pg8::EpiUp, pg8::StaticOrder, true, true>(lds, g, S, E);
            }
#endif
        }
        PH_NEXT;
        if (PH_ON) { DEFPTRS
            const int nl = s ? l + 1 : l, nj = s ? 0 : 1; const int has_next = (nl < 2) ? 1 : 0; const int nidx = has_next ? nl * 3 + nj : 0;
            pg8::Gemm g{HB, WDN + (size_t)(l * 2 + s) * DM * DFF, MTOK, DM, DFF}; pg8::StaticOrder S; S.init(MTOK, DM, G, bx, 24);
            pg8::EpiRes E{f == 0 ? x_in : xout, xout, GATE + (size_t)(l * 3 + j) * 16 * 1024, GMOD + (size_t)nidx * 16 * 1024, XN, ROWSS + (size_t)nidx * MTOK, has_next};
#ifndef NO_G_DN
#ifdef REP_DN
            for (int rep_ = 0; rep_ < 2; ++rep_) { E.xout = (rep_ == 0) ? (float*)HLOC : xout; E.has_next = (rep_ == 0) ? 0 : has_next;
            pg8::gemm_phase<pg8::EpiRes, pg8::StaticOrder, true, true>(lds, g, S, E); }
#else
            pg8::gemm_phase<pg8::EpiRes, pg8::StaticOrder, true, true>(lds, g, S, E);
#endif
#endif
        }
        PH_NEXT;
    }
#undef PH_ON
#undef PH_NEXT
}


#ifdef DBG_STOP
__global__ void dbg_dump(const unsigned char* ws, float* out, int mode) {
    const size_t n = (size_t)MTOK * DM; const size_t i0 = (size_t)blockIdx.x * blockDim.x + threadIdx.x, st = (size_t)gridDim.x * blockDim.x;
    const bf16_t* XN = (const bf16_t*)(ws + WS_XN); const bf16_t* HB = (const bf16_t*)(ws + WS_H); const bf16_t* PR = (const bf16_t*)(ws + WS_PROJ);
    const bf16_t* YU = (const bf16_t*)(ws + WS_YU); const float* HL = (const float*)(ws + WS_HLOC); const bf16_t* YN = (const bf16_t*)(ws + WS_YN); const bf16_t* PC = (const bf16_t*)(ws + WS_PCUM);
    for (size_t i = i0; i < n; i += st) {
        float v = 0.f;
        if (mode == 0) v = bf2f(XN[i]);
        else if (mode == 1) v = bf2f(HB[i]) + bf2f(HB[i + n]) + bf2f(HB[i + (size_t)117440512]);
        else if (mode == 2) v = bf2f(PR[i]) + bf2f(PR[i + n]) + bf2f(PR[i + (size_t)100663296]);
        else if (mode == 3) v = (i < n / 2) ? bf2f(YU[i]) : HL[i - n / 2];
        else if (mode == 4) v = bf2f(YN[i]);
        else if (mode == 6) v = (i < n / 2) ? bf2f(PC[i]) : ((const float*)(ws + WS_KS))[(i - n / 2) % (3 * 262144)];
        else if (mode == 7) v = HL[i % (n / 2)] + bf2f(PC[i % (n / 2)]) + ((const float*)(ws + WS_KS))[i % (3 * 262144)] + ((const float*)(ws + WS_ASEG))[i % (2 * 1048576)];
        if (mode == 3) { const bool nan_ = !(v == v), big = (v > 3e38f) || (v < -3e38f); float code = 0.f;
            if (i < n / 2) { const int col = (int)(i & 511); if (col < 256) code = nan_ ? 2000.f : (big ? 1000.f : 0.f); else code = (nan_ || big) ? 4000.f : 0.f; }
            else code = (nan_ || big) ? 8000.f : 0.f;
            v = code; }
        if (!(v == v)) v = 77777.f; if (v > 3e38f) v = 88888.f; if (v < -3e38f) v = 99999.f;
        if (mode != 5) out[i] = v;
    }
}
#endif
#ifndef MK_N_LAUNCHES
#define MK_N_LAUNCHES 1
#endif
constexpr int N_PHASES = 3 + 2 * 9;
extern "C" void kernel_launch(void* const* d_in, const int* in_sizes, int n_in, void* d_out, int out_size, void* d_ws, size_t ws_size, hipStream_t stream) {
    static int grid = 0;
    if (grid == 0) {
        if (n_in != 19 || out_size != MTOK * DM || ws_size < WS_END) { fprintf(stderr, "kernel_launch: unexpected shapes (n_in %d, out %d, ws %zu)\n", n_in, out_size, ws_size); grid = -1; return; }
        int dev = 0, cus = 0, per_cu = 0;
        hipGetDevice(&dev); hipDeviceGetAttribute(&cus, hipDeviceAttributeMultiprocessorCount, dev);
        if (hipFuncSetAttribute((const void*)mk_fwd, hipFuncAttributeMaxDynamicSharedMemorySize, LDS_BYTES) != hipSuccess) { fprintf(stderr, "kernel_launch: hipFuncSetAttribute failed\n"); grid = -1; return; }
        if (hipOccupancyMaxActiveBlocksPerMultiprocessor(&per_cu, (const void*)mk_fwd, 512, LDS_BYTES) != hipSuccess || per_cu < 1) { fprintf(stderr, "kernel_launch: occupancy query says %d\n", per_cu); per_cu = 1; }
        (void)hipGetLastError();
        grid = cus * 1;
    }
    if (grid < 0) return;
    if (hipMemsetAsync(d_ws, 0, 16384, stream) != hipSuccess) { fprintf(stderr, "kernel_launch: memset failed\n"); return; }
    Args a{};
    for (int i = 0; i < 19; ++i) a.in[i] = (const float*)d_in[i];
    a.out = (float*)d_out; a.ws = (unsigned char*)d_ws;
#if MK_N_LAUNCHES == 1
    a.ph_lo = 0; a.ph_hi = N_PHASES;
    void* kargs[] = {&a};
    hipError_t e = hipLaunchCooperativeKernel((const void*)mk_fwd, dim3(grid), dim3(512), kargs, LDS_BYTES, stream);
    if (e != hipSuccess) fprintf(stderr, "kernel_launch: cooperative launch failed: %s (grid %d)\n", hipGetErrorString(e), grid);
#else
#ifdef DBG_STOP
    for (int p = 0; p < DBG_STOP; ++p) { a.ph_lo = p; a.ph_hi = p + 1; hipLaunchKernelGGL(mk_fwd, dim3(grid), dim3(512), LDS_BYTES, stream, a); }
    hipLaunchKernelGGL(dbg_dump, dim3(2048), dim3(256), 0, stream, (const unsigned char*)d_ws, (float*)d_out, DBG_MODE);
#else
    for (int p = 0; p < N_PHASES; ++p) { a.ph_lo = p; a.ph_hi = p + 1; hipLaunchKernelGGL(mk_fwd, dim3(grid), dim3(512), LDS_BYTES, stream, a); }
#endif
#endif
}
```

```cpp
#include <hip/hip_runtime.h>
#include <hip/hip_cooperative_groups.h>
#include <cstdio>
#include <cstdint>
namespace cg = cooperative_groups;
namespace pg8 {
#define PG8_LAS __attribute__((address_space(3)))
typedef unsigned short bf16_t;
typedef short bf16x8 __attribute__((ext_vector_type(8)));
typedef float f32x4 __attribute__((ext_vector_type(4)));
typedef unsigned u32x4 __attribute__((ext_vector_type(4)));
constexpr int BM = 256, BK = 64, HALF = 128, HTB = HALF * BK * 2  , STAGE_BYTES = 8 * HTB, NXCD = 8, WGM = 8;

__host__ __device__ __forceinline__ int lds_byte(int r, int c) { const int st = (r >> 4) * 2 + (c >> 5), rr = r & 15, cc = c & 31, ob = rr * 64 + cc * 2; return st * 1024 + (ob ^ (((ob >> 9) & 1) << 5)); }
__host__ __device__ __forceinline__ void stage_rc(int b, int& R, int& C) { const int st = b / 1024, sb = b % 1024, swz = sb ^ (((sb >> 9) & 1) << 5); R = (st >> 1) * 16 + swz / 64; C = (st & 1) * 32 + (swz % 64) / 2; }
__host__ __device__ __forceinline__ int perm32(int rho) { const int n = rho >> 4, i = rho & 15; return 8 * (i >> 2) + 4 * n + (i & 3); }

struct Unit { int pm, pn; };
struct Gemm { const bf16_t* A; const bf16_t* Bt; int M, N, K; };

struct StaticOrder {
    int nM, nN, nwg, G, c, rev;
    __host__ __device__ void init(int M, int N, int G_, int c_, int rev_ = 0) { nM = M / BM; nN = N / BM; nwg = nM * nN; G = G_; c = c_; rev = rev_; }
    __host__ __device__ bool next(int i, Unit& u) const {
        const long L = (long)i * G + c; if (L >= nwg) return false;
        int wgid = (int)L; { const int q = nwg / NXCD, r = nwg % NXCD, xcd = wgid % NXCD, off = wgid / NXCD; wgid = (xcd < r ? xcd * (q + 1) : r * (q + 1) + (xcd - r) * q) + off; }
        const int nig = WGM * nN, gid = wgid / nig, fm = gid * WGM, gsz = (nM - fm) < WGM ? (nM - fm) : WGM;
        u.pm = (fm + ((wgid % nig) % gsz)) ^ rev; u.pn = (wgid % nig) / gsz; return true;
    }
    __device__ __forceinline__ void a_ready(const Unit&) const {}
    __device__ __forceinline__ void done(const Unit&) const {}
};

typedef float f32x2c_t __attribute__((ext_vector_type(2))); typedef __bf16 bf16x2c_t __attribute__((ext_vector_type(2)));
__device__ __forceinline__ unsigned cvt_pk_bf16(float lo, float hi) { f32x2c_t v = {lo, hi}; bf16x2c_t b = __builtin_convertvector(v, bf16x2c_t); return __builtin_bit_cast(unsigned, b); }
typedef float f32x2 __attribute__((ext_vector_type(2)));
constexpr float RMS_EPS = 1e-6f;
struct EpiUp {
    static constexpr bool PERM = true, AFTER_DRAIN = false;
    bf16_t* H; const float* rowss; const float* sb;
    __device__ __forceinline__ void operator()(const f32x4 (&acc)[2][2][4][2], const Unit& u, int wr, int wc, int fr, int fq) const {
        const int row0 = u.pm * BM + wr * 64 + fr, b = u.pm >> 4, cl = wc * 32 + 8 * fq;
        const float* sbp = sb + (size_t)b * 5632 + u.pn * 256 + cl;
        float rsv[2][4];
#pragma unroll
        for (int ai = 0; ai < 2; ++ai)
#pragma unroll
            for (int m = 0; m < 4; ++m) rsv[ai][m] = rowss[row0 + ai * HALF + m * 16];
        f32x4 sg[2], su[2];
#pragma unroll
        for (int n = 0; n < 2; ++n) { sg[n] = *(const f32x4*)(sbp + 4 * n); su[n] = *(const f32x4*)(sbp + 128 + 4 * n); }
#pragma unroll
        for (int ai = 0; ai < 2; ++ai)
#pragma unroll
            for (int m = 0; m < 4; ++m) {
                const int row = row0 + ai * HALF + m * 16;
                const float rs = __builtin_amdgcn_rsqf(rsv[ai][m] * (1.0f / 1024.0f) + RMS_EPS);
                unsigned wq[4];
#pragma unroll
                for (int n = 0; n < 2; ++n)
#pragma unroll
                    for (int ip = 0; ip < 2; ++ip) {
                        const f32x2 ag = (f32x2){acc[ai][0][m][n][2 * ip], acc[ai][0][m][n][2 * ip + 1]}, au = (f32x2){acc[ai][1][m][n][2 * ip], acc[ai][1][m][n][2 * ip + 1]};
                        const f32x2 g = ag * rs + (f32x2){sg[n][2 * ip], sg[n][2 * ip + 1]}, uu = au * rs + (f32x2){su[n][2 * ip], su[n][2 * ip + 1]};
                        const f32x2 t = g * (-1.4426950408889634f);
                        f32x2 d; d.x = __builtin_amdgcn_exp2f(t.x); d.y = __builtin_amdgcn_exp2f(t.y); d = d + 1.0f;
                        f32x2 r; r.x = __builtin_amdgcn_rcpf(d.x); r.y = __builtin_amdgcn_rcpf(d.y);
                        const f32x2 hv = (g * uu) * r;
                        wq[n * 2 + ip] = cvt_pk_bf16(hv.x, hv.y);
                    }
                u32x4 w; w.x = wq[0]; w.y = wq[1]; w.z = wq[2]; w.w = wq[3];
                *(u32x4*)(H + (size_t)row * 2816 + u.pn * 128 + cl) = w;
            }
    }
};
struct EpiIn {
    static constexpr bool PERM = true, AFTER_DRAIN = false;
    bf16_t* P; float* FG; const float* rowss; const float* sb;
    __device__ __forceinline__ void operator()(const f32x4 (&acc)[2][2][4][2], const Unit& u, int wr, int wc, int fr, int fq) const {
        const int row0 = u.pm * BM + wr * 64 + fr, b = u.pm >> 4, cl = wc * 32 + 8 * fq;
        const float* sbp = sb + (size_t)b * 5632 + u.pn * 256 + cl;
        float rsv[2][4];
#pragma unroll
        for (int ai = 0; ai < 2; ++ai)
#pragma unroll
            for (int m = 0; m < 4; ++m) rsv[ai][m] = rowss[row0 + ai * HALF + m * 16];
        f32x4 sv[2][2];
#pragma unroll
        for (int bj = 0; bj < 2; ++bj)
#pragma unroll
            for (int n = 0; n < 2; ++n) sv[bj][n] = *(const f32x4*)(sbp + bj * HALF + 4 * n);
#pragma unroll
        for (int ai = 0; ai < 2; ++ai)
#pragma unroll
            for (int m = 0; m < 4; ++m) {
                const int row = row0 + ai * HALF + m * 16;
                const float rs = __builtin_amdgcn_rsqf(rsv[ai][m] * (1.0f / 1024.0f) + RMS_EPS);
                if (u.pn < 10) {
#pragma unroll
                    for (int bj = 0; bj < 2; ++bj) {
                        const f32x4 v0 = acc[ai][bj][m][0] * rs + sv[bj][0], v1 = acc[ai][bj][m][1] * rs + sv[bj][1];
                        u32x4 w; w.x = cvt_pk_bf16(v0[0], v0[1]); w.y = cvt_pk_bf16(v0[2], v0[3]); w.z = cvt_pk_bf16(v1[0], v1[1]); w.w = cvt_pk_bf16(v1[2], v1[3]);
                        *(u32x4*)(P + (size_t)row * 2560 + u.pn * 256 + bj * HALF + cl) = w;
                    }
                } else if (wc == 0 && fq == 0) {
                    *(f32x4*)(FG + (size_t)row * 4) = acc[ai][0][m][0] * rs + sv[0][0];
                }
            }
    }
};
struct EpiRes {
    static constexpr bool PERM = false, AFTER_DRAIN = false;
    const float* xin; float* xout; const float* gate; const float* gmn; bf16_t* XN; float* rowssn; int has_next;
    __device__ __forceinline__ void operator()(const f32x4 (&acc)[2][2][4][2], const Unit& u, int wr, int wc, int fr, int fq) const {
        typedef unsigned u32x2v __attribute__((ext_vector_type(2)));
        const int row0 = u.pm * BM + wr * 64 + fr, b = u.pm >> 4, col0 = u.pn * BM + wc * 32 + 4 * fq;
        const float* gp_ = gate + b * 1024 + col0; const float* gm_ = gmn + b * 1024 + col0;
#pragma unroll
        for (int ai = 0; ai < 2; ++ai) {
            f32x4 xi[4][2][2];
#pragma unroll
            for (int m = 0; m < 4; ++m)
#pragma unroll
                for (int bj = 0; bj < 2; ++bj)
#pragma unroll
                    for (int n = 0; n < 2; ++n) xi[m][bj][n] = *(const f32x4*)(xin + (size_t)(row0 + ai * HALF + m * 16) * 1024 + col0 + bj * HALF + n * 16);
            asm volatile("" ::: "memory");
#pragma unroll
            for (int m = 0; m < 4; ++m) {
                const int row = row0 + ai * HALF + m * 16; const size_t off = (size_t)row * 1024 + col0;
                float ss = 0.f;
#pragma unroll
                for (int bj = 0; bj < 2; ++bj)
#pragma unroll
                    for (int n = 0; n < 2; ++n) {
                        const f32x4 xo = xi[m][bj][n] + *(const f32x4*)(gp_ + bj * HALF + n * 16) * acc[ai][bj][m][n];
                        *(f32x4*)(xout + off + bj * HALF + n * 16) = xo;
                        if (has_next) {
                            ss += (xo[0] * xo[0] + xo[1] * xo[1]) + (xo[2] * xo[2] + xo[3] * xo[3]);
                            const f32x4 a = xo * *(const f32x4*)(gm_ + bj * HALF + n * 16); u32x2v w; w.x = cvt_pk_bf16(a[0], a[1]); w.y = cvt_pk_bf16(a[2], a[3]);
                            *(u32x2v*)(XN + off + bj * HALF + n * 16) = w;
                        }
                    }
                if (has_next) { ss += __shfl_xor(ss, 16); ss += __shfl_xor(ss, 32); if (fq == 0) unsafeAtomicAdd(rowssn + row, ss); }
            }
            asm volatile("" ::: "memory");
        }
    }
};

template <class Epi, class Sched, bool ALIGN_EPI = false, bool SP2 = false>
__device__ __forceinline__ void gemm_phase(PG8_LAS unsigned char* lds, const Gemm g, const Sched& S, const Epi& E) {
    int tid_o = threadIdx.x; asm volatile("" : "+v"(tid_o)); const int tid = tid_o, wid = __builtin_amdgcn_readfirstlane(tid >> 6), lane = tid & 63, wr = wid >> 2, wc = wid & 3, fr = lane & 15, fq = lane >> 4;
    const int K = g.K, nt = K / BK;
    unsigned voffA[2], voffB[2];
#pragma unroll
    for (int i = 0; i < 2; ++i) { int R, C; stage_rc(tid * 16 + i * 8192, R, C); const int Rb = Epi::PERM ? ((R & ~31) + perm32(R & 31)) : R;
        voffA[i] = (unsigned)(R * K + C) * 2u; voffB[i] = (unsigned)(Rb * K + C) * 2u; }
    const size_t kstep = (size_t)(BK * 2);
    const size_t hstep = (size_t)HALF * K * 2;
    const size_t tstep = 2 * hstep;
    const unsigned ldsw = (unsigned)wid * 1024u;
    const int aoff = lds_byte(wr * 64 + fr, fq * 8), boff = lds_byte(wc * 32 + fr, fq * 8);
#define PG8_SA(b, h) (((b) * 2 + (h)) * HTB)
#define PG8_SB(b, h) ((4 + (b) * 2 + (h)) * HTB)
#define PG8_STAGE(bufoff, gbase, voff) do { _Pragma("unroll") for (int _i = 0; _i < 2; ++_i) \
        __builtin_amdgcn_global_load_lds((const unsigned*)((const char*)(gbase) + (voff)[_i]), (PG8_LAS unsigned*)(lds + (bufoff) + ldsw + _i * 8192), 16, 0, 0); } while (0)
#define PG8_LDA(dst, b, h) do { _Pragma("unroll") for (int m = 0; m < 4; ++m) _Pragma("unroll") for (int k = 0; k < 2; ++k) dst[m][k] = *(const PG8_LAS bf16x8*)(lds + PG8_SA(b, h) + aoff + m * 2048 + k * 1024); } while (0)
#define PG8_LDB(dst, b, h) do { _Pragma("unroll") for (int n = 0; n < 2; ++n) _Pragma("unroll") for (int k = 0; k < 2; ++k) dst[n][k] = *(const PG8_LAS bf16x8*)(lds + PG8_SB(b, h) + boff + n * 2048 + k * 1024); } while (0)
#define PG8_MMA(ai, bj, At, Bt) do { __builtin_amdgcn_s_setprio(1); _Pragma("unroll") for (int m = 0; m < 4; ++m) _Pragma("unroll") for (int n = 0; n < 2; ++n) _Pragma("unroll") for (int k = 0; k < 2; ++k) \
        acc[ai][bj][m][n] = __builtin_amdgcn_mfma_f32_16x16x32_bf16(Bt[n][k], At[m][k], acc[ai][bj][m][n], 0, 0, 0); __builtin_amdgcn_s_setprio(0); } while (0)
#define PG8_WAIT_V(n) asm volatile("s_waitcnt vmcnt(" #n ")" ::: "memory")
#define PG8_WAIT_L(n) asm volatile("s_waitcnt lgkmcnt(" #n ")" ::: "memory")
#define PG8_BAR __builtin_amdgcn_s_barrier()
#define PG8_SCHED __builtin_amdgcn_sched_barrier(0)
    Unit cur, nxt; int ui = 0;
    if (!S.next(0, cur)) return;
    f32x4 acc[2][2][4][2];
#pragma unroll
    for (int a = 0; a < 2; ++a)
#pragma unroll
        for (int b = 0; b < 2; ++b)
#pragma unroll
            for (int m = 0; m < 4; ++m)
#pragma unroll
                for (int n = 0; n < 2; ++n) acc[a][b][m][n] = (f32x4){0.f, 0.f, 0.f, 0.f};
    bf16x8 At[4][2], B0[2][2], B1[2][2];
    const char* cA = (const char*)g.A + (size_t)cur.pm * tstep; const char* cB = (const char*)g.Bt + (size_t)cur.pn * tstep;
    S.a_ready(cur);
    if constexpr (SP2) {
        PG8_STAGE(PG8_SB(0, 0), cB, voffB); PG8_STAGE(PG8_SB(0, 1), cB + hstep, voffB); PG8_STAGE(PG8_SA(0, 0), cA, voffA); PG8_STAGE(PG8_SA(0, 1), cA + hstep, voffA);
        if (wr == 1) PG8_BAR;
        PG8_WAIT_V(2); PG8_BAR;
        PG8_STAGE(PG8_SB(1, 0), cB + kstep, voffB); PG8_STAGE(PG8_SA(1, 0), cA + kstep, voffA); PG8_STAGE(PG8_SB(1, 1), cB + hstep + kstep, voffB);
        PG8_WAIT_V(6); PG8_BAR;
    } else {
        PG8_STAGE(PG8_SB(0, 0), cB, voffB); PG8_STAGE(PG8_SA(0, 0), cA, voffA); PG8_STAGE(PG8_SB(0, 1), cB + hstep, voffB); PG8_STAGE(PG8_SA(0, 1), cA + hstep, voffA);
        if (wr == 1) PG8_BAR;
        PG8_WAIT_V(4); PG8_BAR;
        PG8_STAGE(PG8_SB(1, 0), cB + kstep, voffB); PG8_STAGE(PG8_SA(1, 0), cA + kstep, voffA); PG8_STAGE(PG8_SB(1, 1), cB + hstep + kstep, voffB);
        PG8_WAIT_V(6); PG8_BAR;
    }
    for (;;) {
        const bool has_next = S.next(ui + 1, nxt);
        const char* nA = has_next ? (const char*)g.A + (size_t)nxt.pm * tstep : cA; const char* nB = has_next ? (const char*)g.Bt + (size_t)nxt.pn * tstep : cB;
        for (int t = 0; t < nt; t += 2) {
            const bool last = (t == nt - 2);
            const char* a1 = cA + (size_t)(t + 1) * kstep;
            const char* a2 = last ? nA : cA + (size_t)(t + 2) * kstep; const char* b2 = last ? nB : cB + (size_t)(t + 2) * kstep;
            const char* a3 = a2 + kstep; const char* b3 = b2 + kstep;
            if (last && has_next) S.a_ready(nxt);
            if constexpr (SP2) {
            PG8_LDB(B0, 0, 0); PG8_LDB(B1, 0, 1); PG8_SCHED; PG8_LDA(At, 0, 0); PG8_STAGE(PG8_SA(1, 1), a1 + hstep, voffA);
            PG8_WAIT_V(8); PG8_WAIT_L(0); PG8_BAR; PG8_MMA(0, 0, At, B0); PG8_MMA(0, 1, At, B1); PG8_BAR; PG8_SCHED;
            PG8_LDA(At, 0, 1); PG8_STAGE(PG8_SB(0, 0), b2, voffB); PG8_STAGE(PG8_SB(0, 1), b2 + hstep, voffB); PG8_STAGE(PG8_SA(0, 0), a2, voffA);
            PG8_WAIT_V(8); PG8_WAIT_L(0); PG8_BAR; PG8_MMA(1, 0, At, B0); PG8_MMA(1, 1, At, B1); PG8_BAR; PG8_SCHED;
            PG8_LDB(B0, 1, 0); PG8_LDB(B1, 1, 1); PG8_SCHED; PG8_LDA(At, 1, 0); PG8_STAGE(PG8_SA(0, 1), a2 + hstep, voffA);
            PG8_WAIT_V(8); PG8_WAIT_L(0); PG8_BAR; PG8_MMA(0, 0, At, B0); PG8_MMA(0, 1, At, B1); PG8_BAR; PG8_SCHED;
            PG8_LDA(At, 1, 1); PG8_STAGE(PG8_SB(1, 0), b3, voffB); PG8_STAGE(PG8_SB(1, 1), b3 + hstep, voffB); PG8_STAGE(PG8_SA(1, 0), a3, voffA);
            PG8_WAIT_V(8); PG8_WAIT_L(0); PG8_BAR; PG8_MMA(1, 0, At, B0); PG8_MMA(1, 1, At, B1); PG8_BAR; PG8_SCHED;
            } else {
            PG8_LDB(B0, 0, 0); PG8_SCHED; PG8_LDA(At, 0, 0); PG8_STAGE(PG8_SA(1, 1), a1 + hstep, voffA);
            PG8_WAIT_L(8); PG8_BAR; PG8_WAIT_L(0); PG8_MMA(0, 0, At, B0); PG8_BAR; PG8_SCHED;
            PG8_LDB(B1, 0, 1); PG8_STAGE(PG8_SB(0, 0), b2, voffB);
            PG8_BAR; PG8_WAIT_L(0); PG8_MMA(0, 1, At, B1); PG8_BAR;
            PG8_LDA(At, 0, 1); PG8_STAGE(PG8_SA(0, 0), a2, voffA);
            PG8_BAR; PG8_WAIT_L(0); PG8_MMA(1, 0, At, B0); PG8_BAR; PG8_SCHED;
            PG8_STAGE(PG8_SB(0, 1), b2 + hstep, voffB);
            PG8_WAIT_V(6); PG8_BAR; PG8_MMA(1, 1, At, B1); PG8_BAR;
            PG8_LDB(B0, 1, 0); PG8_SCHED; PG8_LDA(At, 1, 0); PG8_STAGE(PG8_SA(0, 1), a2 + hstep, voffA);
            PG8_WAIT_L(8); PG8_BAR; PG8_WAIT_L(0); PG8_MMA(0, 0, At, B0); PG8_BAR; PG8_SCHED;
            PG8_LDB(B1, 1, 1); PG8_STAGE(PG8_SB(1, 0), b3, voffB);
            PG8_BAR; PG8_WAIT_L(0); PG8_MMA(0, 1, At, B1); PG8_BAR;
            PG8_LDA(At, 1, 1); PG8_STAGE(PG8_SA(1, 0), a3, voffA);
            PG8_BAR; PG8_WAIT_L(0); PG8_MMA(1, 0, At, B0); PG8_BAR; PG8_SCHED;
            PG8_STAGE(PG8_SB(1, 1), b3 + hstep, voffB);
            PG8_WAIT_V(6); PG8_BAR; PG8_MMA(1, 1, At, B1); PG8_BAR;
            }
        }
        if constexpr (ALIGN_EPI) { if (wr == 0) PG8_BAR; }
        if constexpr (!Epi::AFTER_DRAIN) { E(acc, cur, wr, wc, fr, fq); S.done(cur); }
        if (!has_next) break;
#pragma unroll
        for (int a = 0; a < 2; ++a)
#pragma unroll
            for (int b = 0; b < 2; ++b)
#pragma unroll
                for (int m = 0; m < 4; ++m)
#pragma unroll
                    for (int n = 0; n < 2; ++n) acc[a][b][m][n] = (f32x4){0.f, 0.f, 0.f, 0.f};
        cur = nxt; cA = nA; cB = nB; ++ui;
        if constexpr (ALIGN_EPI) { if (wr == 1) PG8_BAR; }
    }
    PG8_WAIT_V(0);
    if constexpr (!ALIGN_EPI) { if (wr == 0) PG8_BAR; }
    PG8_BAR;
    if constexpr (Epi::AFTER_DRAIN) { E.fused(acc, cur, wr, wc, fr, fq, lds, wid, lane); S.done(cur); }
#undef PG8_SA
#undef PG8_SB
#undef PG8_STAGE
#undef PG8_LDA
#undef PG8_LDB
#undef PG8_MMA
#undef PG8_WAIT_V
#undef PG8_WAIT_L
#undef PG8_BAR
#undef PG8_SCHED
}
}

#define LAS __attribute__((address_space(3)))
typedef unsigned short bf16_t;
typedef short bf16x8 __attribute__((ext_vector_type(8)));
typedef short s16x4 __attribute__((ext_vector_type(4)));
typedef float f32x4 __attribute__((ext_vector_type(4)));
typedef float f32x2 __attribute__((ext_vector_type(2)));
typedef float f32x16 __attribute__((ext_vector_type(16)));
typedef unsigned u32x4 __attribute__((ext_vector_type(4)));
typedef unsigned u32x2 __attribute__((ext_vector_type(2)));

constexpr int MTOK = 65536, DM = 1024, DFF = 2816, NUP = 5632, NINP = 2816, PPITCH = 2560, SEQL = 4096;
constexpr float EPSF = 1e-6f, LOG2E = 1.4426950408889634f;
constexpr size_t MiB = 1u << 20;
constexpr size_t WS_MOD = 1 * MiB, WS_GMOD = 3 * MiB, WS_GATE = 4 * MiB, WS_SB = 5 * MiB, WS_ROWSS = 8 * MiB, WS_KS = 10 * MiB, WS_F2 = 11 * MiB, WS_FG = 12 * MiB,
                 WS_ASEG = 13 * MiB, WS_BSEG = 17 * MiB, WS_WUP = 24 * MiB, WS_WDN = 68 * MiB, WS_WIN = 90 * MiB, WS_WOUT = 101 * MiB, WS_XN = 112 * MiB,
                 WS_H = 240 * MiB, WS_PROJ = 240 * MiB, WS_YU = 592 * MiB, WS_HLOC = 656 * MiB, WS_PCUM = 784 * MiB, WS_YN = 848 * MiB, WS_END = 976 * MiB;
constexpr int LDS_BYTES = 147456;

__device__ __forceinline__ float bf2f(unsigned short v) { return __uint_as_float((unsigned)v << 16); }
__device__ __forceinline__ unsigned f2bf(float f) { unsigned u = __float_as_uint(f); return (u + 0x7fffu + ((u >> 16) & 1u)) >> 16; }
__device__ __forceinline__ unsigned pk2(float lo, float hi) { return pg8::cvt_pk_bf16(lo, hi); }
__device__ __forceinline__ float wave_sum(float v) {
#pragma unroll
    for (int o = 1; o < 64; o <<= 1) v += __shfl_xor(v, o);
    return v;
}
__device__ __forceinline__ float sigmoidf_(float x) { return __builtin_amdgcn_rcpf(1.0f + __builtin_amdgcn_exp2f(-LOG2E * x)); }
#define WAITV(n) asm volatile("s_waitcnt vmcnt(" #n ")" ::: "memory")
#define LBAR() asm volatile("s_waitcnt lgkmcnt(0)\n\ts_barrier" ::: "memory")
#define CFENCE() asm volatile("" ::: "memory")

#ifndef REP_FIN
#define REP_FIN 1
#endif
#ifndef REP_IN
#define REP_IN 1
#endif
#ifndef REP_PREP
#define REP_PREP 1
#endif
#ifndef REP_ATTN
#define REP_ATTN 1
#endif
#ifndef REP_UP
#define REP_UP 1
#endif
struct Args { const float* in[19]; float* out; unsigned char* ws; int ph_lo, ph_hi; };

__device__ __forceinline__ void transpose_item(const float* __restrict__ W, int ldw, int clim, int K, bf16_t* __restrict__ WT, int n0, int c0, int k0, LAS float* scr, int lane) {
    const int col = c0 + (lane & 31);
#pragma unroll 16
    for (int i = 0; i < 32; ++i) { const int kk = 2 * i + (lane >> 5); scr[kk * 33 + (lane & 31)] = (col < clim) ? W[(size_t)(k0 + kk) * ldw + col] : 0.f; }
    asm volatile("s_waitcnt lgkmcnt(0)" ::: "memory");
    const int c = lane & 7;
#pragma unroll
    for (int j = 0; j < 4; ++j) { const int n = (lane >> 3) + 8 * j; const LAS float* s = scr + (8 * c) * 33 + n;
        u32x4 o; o.x = pk2(s[0 * 33], s[1 * 33]); o.y = pk2(s[2 * 33], s[3 * 33]); o.z = pk2(s[4 * 33], s[5 * 33]); o.w = pk2(s[6 * 33], s[7 * 33]);
        *(u32x4*)(WT + (size_t)(n0 + n) * K + k0 + 8 * c) = o; }
    asm volatile("s_waitcnt lgkmcnt(0)" ::: "memory");
}

__device__ __forceinline__ int crow(int r, int hi) { return (r & 3) + 8 * (r >> 2) + 4 * hi; }
__device__ __forceinline__ s16x4 vtr(const LAS unsigned char* p) {
    typedef short v4i16_t __attribute__((ext_vector_type(4)));
    return __builtin_bit_cast(s16x4, __builtin_amdgcn_ds_read_tr16_b64_v4i16((LAS v4i16_t*)p));
}
constexpr int AT_SLOT = 16384, AT_AUX = 3 * AT_SLOT, AT_WSF = AT_AUX + 3 * 512, AT_VOTE = AT_WSF + 8 * 256;
constexpr float C2 = 0.125f * LOG2E;

__device__ __forceinline__ void sb_block(f32x16& X, float& carry, bool band, int kv0  , int qrel, int hi) {
    float lm[16];
#pragma unroll
    for (int r = 0; r < 16; ++r) {
        float z2 = X[r] * C2; z2 = __builtin_fminf(__builtin_fmaxf(z2, -120.f), 120.f);
        const float e = __builtin_amdgcn_exp2f(-z2), sp = __builtin_amdgcn_logf(1.0f + e);
        float l1 = -(sp + z2), lb = -sp;
        if (band) { const int kv = kv0 + (r & 3) + 8 * (r >> 2); const bool valid = kv < qrel; l1 = valid ? l1 : 0.f; lb = valid ? lb : -INFINITY; }
        lm[r] = l1; X[r] = lb;
    }
    float G[4], Gp[4], T[4];
#pragma unroll
    for (int g = 0; g < 4; ++g) { G[g] = (lm[4 * g] + lm[4 * g + 1]) + (lm[4 * g + 2] + lm[4 * g + 3]); Gp[g] = __shfl_xor(G[g], 32); T[g] = G[g] + Gp[g]; }
    float S = carry;
#pragma unroll
    for (int g = 3; g >= 0; --g) {
        const float a3 = S + (hi == 0 ? Gp[g] : 0.f), a2 = a3 + lm[4 * g + 3], a1 = a2 + lm[4 * g + 2], a0 = a1 + lm[4 * g + 1];
        X[4 * g + 3] = __builtin_amdgcn_exp2f(X[4 * g + 3] + a3); X[4 * g + 2] = __builtin_amdgcn_exp2f(X[4 * g + 2] + a2);
        X[4 * g + 1] = __builtin_amdgcn_exp2f(X[4 * g + 1] + a1); X[4 * g] = __builtin_amdgcn_exp2f(X[4 * g] + a0);
        S += T[g];
    }
    carry = S;
}

template <int KIND>
__device__ __forceinline__ void attn_unit(LAS unsigned char* lds, const bf16_t* __restrict__ PROJ, bf16_t* __restrict__ YU, const float* __restrict__ KS,
                                          const float* __restrict__ F2, const float* __restrict__ gqk, int b, int h, int qb) {
    int tid_o = threadIdx.x; asm volatile("" : "+v"(tid_o));
    const int tid = tid_o, lane = tid & 63, r32 = lane & 31, hi = lane >> 5;
    const int wid = __builtin_amdgcn_readfirstlane(tid >> 6);
    const int qcol = (KIND == 0 ? 1024 : 1792) + h * 64, kcol = qcol + 256, vcol = qcol + 512;
    const size_t rowbase = (size_t)b * SEQL; const int q0 = qb * 256, bh = b * 4 + h;
    const int NT = (q0 + 256) / 64;
    const bf16_t* ksrc = PROJ + (rowbase + lane) * PPITCH + kcol + wid * 8;
    const bf16_t* vsrc = PROJ + (rowbase + 16 * (wid & 3) + (lane >> 2)) * PPITCH + vcol + (wid >> 2) * 32 + (lane & 3) * 8;
    const float* axsrc = F2 + (size_t)bh * SEQL + lane;
    u32x4 kreg, vreg; float areg = 0.f;
#define AT_LOAD(it_) do { const int kt_ = NT - 1 - (it_); kreg = *(const u32x4*)(ksrc + (size_t)kt_ * 64 * PPITCH); vreg = *(const u32x4*)(vsrc + (size_t)kt_ * 64 * PPITCH); \
        if (KIND == 1 && wid == 0) areg = axsrc[kt_ * 64]; } while (0)
#define AT_STORE(slot_) do { *(LAS u32x4*)(lds + (slot_) * AT_SLOT + wid * 1024 + lane * 16) = kreg; *(LAS u32x4*)(lds + (slot_) * AT_SLOT + 8192 + wid * 1024 + lane * 16) = vreg; \
        if (KIND == 1 && wid == 0) *(LAS float*)(lds + AT_AUX + (slot_) * 512 + lane * 4) = areg; } while (0)
    const bf16_t* Qw = PROJ + (rowbase + q0 + wid * 32 + r32) * PPITCH + qcol + hi * 8;
    bf16x8 qr[4];
#pragma unroll
    for (int d0 = 0; d0 < 4; ++d0) qr[d0] = *(const bf16x8*)(Qw + d0 * 16);
    AT_LOAD(0);
    float qn2 = 0.f, mref = 0.f;
    if (KIND == 1) {
        float qf[4][8]; float ss = 0.f;
#pragma unroll
        for (int d0 = 0; d0 < 4; ++d0)
#pragma unroll
            for (int i = 0; i < 8; ++i) { qf[d0][i] = bf2f((unsigned short)qr[d0][i]); ss += qf[d0][i] * qf[d0][i]; }
        ss += __shfl_xor(ss, 32);
        const float rs = __builtin_amdgcn_rsqf(ss * (1.0f / 64.0f) + EPSF) * C2;
#pragma unroll
        for (int d0 = 0; d0 < 4; ++d0) {
            const float* gp = gqk + d0 * 16 + hi * 8; float v[8];
#pragma unroll
            for (int i = 0; i < 8; ++i) { v[i] = qf[d0][i] * rs * gp[i] * gp[64 + i]; qn2 += v[i] * v[i]; }
            u32x4 w; w.x = pk2(v[0], v[1]); w.y = pk2(v[2], v[3]); w.z = pk2(v[4], v[5]); w.w = pk2(v[6], v[7]);
            qr[d0] = __builtin_bit_cast(bf16x8, w);
        }
        qn2 += __shfl_xor(qn2, 32);
        mref = F2[(size_t)bh * SEQL + q0 + wid * 32 + r32] + __builtin_fminf(8.08f * __builtin_sqrtf(qn2), 60.0f);
    }
    f32x16 o0, o1;
#pragma unroll
    for (int r = 0; r < 16; ++r) { o0[r] = 0.f; o1[r] = 0.f; }
    float mhat = -1e30f, lsum = 0.f, carry = 0.f;
    LAS float* wsf = (LAS float*)(lds + AT_WSF) + wid * 64;
    LAS unsigned* votes = (LAS unsigned*)(lds + AT_VOTE);
    const int qrel = wid * 32 + r32;
    bool wdone = false;
    AT_STORE(0); LBAR();
    for (int it = 0; it < NT; ++it) {
        const int slot = it & 1;
        if (KIND == 0 && it > 0) {
            const LAS unsigned* vp = votes + ((it - 1) & 1) * 8;
            const unsigned all = vp[0] & vp[1] & vp[2] & vp[3] & vp[4] & vp[5] & vp[6] & vp[7];
            if (all) break;
        }
        if (it + 1 < NT) AT_LOAD(it + 1);
        const int kt = NT - 1 - it, jb = kt - (NT - 4);
        const bool band = jb >= 0;
        const bool active = !(band && 64 * jb > 32 * wid + 31) && !wdone;
        if (active) {
            f32x16 p0, p1;
            __builtin_amdgcn_s_setprio(1);
            { const LAS unsigned char* kb = lds + slot * AT_SLOT + hi * 1024 + r32 * 16;
#pragma unroll
              for (int d0 = 0; d0 < 4; ++d0) {
                  const bf16x8 b0 = *(const LAS bf16x8*)(kb + d0 * 2048), b1 = *(const LAS bf16x8*)(kb + d0 * 2048 + 512);
                  if (d0 == 0) { f32x16 z;
#pragma unroll
                      for (int r = 0; r < 16; ++r) z[r] = (KIND == 1) ? -mref : 0.f;
                      p0 = __builtin_amdgcn_mfma_f32_32x32x16_bf16(b0, qr[0], z, 0, 0, 0); p1 = __builtin_amdgcn_mfma_f32_32x32x16_bf16(b1, qr[0], z, 0, 0, 0); }
                  else { p0 = __builtin_amdgcn_mfma_f32_32x32x16_bf16(b0, qr[d0], p0, 0, 0, 0); p1 = __builtin_amdgcn_mfma_f32_32x32x16_bf16(b1, qr[d0], p1, 0, 0, 0); }
              } }
            __builtin_amdgcn_s_setprio(0);
            if (KIND == 0) {
                sb_block(p1, carry, band, 64 * jb + 32 + 4 * hi, qrel, hi);
                sb_block(p0, carry, band, 64 * jb + 4 * hi, qrel, hi);
            } else {
                const LAS float* ax = (const LAS float*)(lds + AT_AUX + slot * 512);
                f32x2 sacc2 = (f32x2){0.f, 0.f};
#pragma unroll
                for (int g = 0; g < 4; ++g) {
                    const f32x4 f0 = *(const LAS f32x4*)(ax + 8 * g + 4 * hi), f1 = *(const LAS f32x4*)(ax + 32 + 8 * g + 4 * hi);
#pragma unroll
                    for (int i = 0; i < 4; ++i) { p0[4 * g + i] += f0[i]; p1[4 * g + i] += f1[i]; }
                }
                if (band) {
#pragma unroll
                    for (int r = 0; r < 16; ++r) { const int kv = 64 * jb + crow(r, hi); if (kv > qrel) p0[r] = -INFINITY; if (kv + 32 > qrel) p1[r] = -INFINITY; }
                }
#pragma unroll
                for (int r = 0; r < 16; r += 2) {
                    p0[r] = __builtin_amdgcn_exp2f(p0[r]); p0[r + 1] = __builtin_amdgcn_exp2f(p0[r + 1]); p1[r] = __builtin_amdgcn_exp2f(p1[r]); p1[r + 1] = __builtin_amdgcn_exp2f(p1[r + 1]);
                    sacc2 += (f32x2){p0[r], p0[r + 1]}; sacc2 += (f32x2){p1[r], p1[r + 1]};
                }
                lsum += sacc2[0] + sacc2[1];
            }
            u32x4 pw0, pw1, pw2, pw3;
            pw0.x = pk2(p0[0], p0[1]); pw0.y = pk2(p0[2], p0[3]); pw0.z = pk2(p0[4], p0[5]); pw0.w = pk2(p0[6], p0[7]);
            pw1.x = pk2(p0[8], p0[9]); pw1.y = pk2(p0[10], p0[11]); pw1.z = pk2(p0[12], p0[13]); pw1.w = pk2(p0[14], p0[15]);
            pw2.x = pk2(p1[0], p1[1]); pw2.y = pk2(p1[2], p1[3]); pw2.z = pk2(p1[4], p1[5]); pw2.w = pk2(p1[6], p1[7]);
            pw3.x = pk2(p1[8], p1[9]); pw3.y = pk2(p1[10], p1[11]); pw3.z = pk2(p1[12], p1[13]); pw3.w = pk2(p1[14], p1[15]);
            const LAS unsigned char* vb = lds + slot * AT_SLOT + 8192 + ((lane >> 4) & 1) * 32 + (lane & 3) * 8 + (4 * hi + ((lane & 15) >> 2)) * 64;
            s16x4 vlo[8], vhi[8];
#pragma unroll
            for (int i = 0; i < 8; ++i) { vlo[i] = vtr(vb + (i >> 2) * 4096 + (i & 3) * 1024); vhi[i] = vtr(vb + (i >> 2) * 4096 + (i & 3) * 1024 + 512); }
#define VFR(i) (bf16x8){vlo[i][0], vlo[i][1], vlo[i][2], vlo[i][3], vhi[i][0], vhi[i][1], vhi[i][2], vhi[i][3]}
#define PAF(x) __builtin_bit_cast(bf16x8, x)
            __builtin_amdgcn_s_setprio(1);
            o0 = __builtin_amdgcn_mfma_f32_32x32x16_bf16(PAF(pw0), VFR(0), o0, 0, 0, 0); o1 = __builtin_amdgcn_mfma_f32_32x32x16_bf16(PAF(pw0), VFR(4), o1, 0, 0, 0);
            o0 = __builtin_amdgcn_mfma_f32_32x32x16_bf16(PAF(pw1), VFR(1), o0, 0, 0, 0); o1 = __builtin_amdgcn_mfma_f32_32x32x16_bf16(PAF(pw1), VFR(5), o1, 0, 0, 0);
            o0 = __builtin_amdgcn_mfma_f32_32x32x16_bf16(PAF(pw2), VFR(2), o0, 0, 0, 0); o1 = __builtin_amdgcn_mfma_f32_32x32x16_bf16(PAF(pw2), VFR(6), o1, 0, 0, 0);
            o0 = __builtin_amdgcn_mfma_f32_32x32x16_bf16(PAF(pw3), VFR(3), o0, 0, 0, 0); o1 = __builtin_amdgcn_mfma_f32_32x32x16_bf16(PAF(pw3), VFR(7), o1, 0, 0, 0);
            __builtin_amdgcn_s_setprio(0);
#undef VFR
#undef PAF
        }
        if (KIND == 0) { if (active) wdone = __all(carry < -150.0f); if (lane == 0) votes[(it & 1) * 8 + wid] = wdone ? 1u : 0u; }
        if (it + 1 < NT) AT_STORE(slot ^ 1);
        LBAR();
    }
    if (KIND == 1) { lsum += __shfl_xor(lsum, 32); CFENCE(); if (hi == 0) wsf[r32] = lsum; CFENCE(); asm volatile("s_waitcnt lgkmcnt(0)" ::: "memory"); }
    bf16_t* Yw = YU + (rowbase + q0 + wid * 32) * 512 + KIND * 256 + h * 64 + r32;
#pragma unroll
    for (int r = 0; r < 16; ++r) {
        const int orow = crow(r, hi); float sc = 1.0f;
        if (KIND == 1) sc = __builtin_amdgcn_rcpf(wsf[orow]);
        Yw[(size_t)orow * 512] = (bf16_t)f2bf(o0[r] * sc); Yw[(size_t)orow * 512 + 32] = (bf16_t)f2bf(o1[r] * sc);
    }
    LBAR();
#undef AT_LOAD
#undef AT_STORE
}

#define DEFPTRS \
    const __attribute__((address_space(4))) Args* ka_ = (const __attribute__((address_space(4))) Args*)__builtin_amdgcn_kernarg_segment_ptr(); \
    asm volatile("" : "+s"(ka_)); \
    int tid_o_ = threadIdx.x; asm volatile("" : "+v"(tid_o_)); const int tid = tid_o_, lane = tid & 63; (void)lane; \
    unsigned char* ws = ka_->ws; \
    const float* x_in = ka_->in[0]; const float* c_in = ka_->in[1]; const float* w_ada = ka_->in[2]; const float* b_ada = ka_->in[3]; const float* g_norm = ka_->in[4]; \
    const float* w_up = ka_->in[5]; const float* w_dn = ka_->in[6]; const float* w_in = ka_->in[7]; const float* b_fg = ka_->in[8]; const float* conv_w = ka_->in[9]; \
    const float* conv_b = ka_->in[10]; const float* w_rg = ka_->in[11]; const float* b_rg = ka_->in[12]; const float* w_ig = ka_->in[13]; const float* b_ig = ka_->in[14]; \
    const float* lam = ka_->in[15]; const float* g_qk = ka_->in[16]; const float* g_mix = ka_->in[17]; const float* w_out = ka_->in[18]; \
    float* xout = ka_->out; \
    float* MOD = (float*)(ws + WS_MOD); float* GMOD = (float*)(ws + WS_GMOD); float* GATE = (float*)(ws + WS_GATE); float* SBV = (float*)(ws + WS_SB); \
    float* ROWSS = (float*)(ws + WS_ROWSS); float* KS = (float*)(ws + WS_KS); float* F2 = (float*)(ws + WS_F2); float* FG = (float*)(ws + WS_FG); \
    float* ASEG = (float*)(ws + WS_ASEG); float* BSEG = (float*)(ws + WS_BSEG); float* TSEGA = (float*)(ws + 21 * MiB); float* TSEGB = (float*)(ws + 22 * MiB); \
    bf16_t* WUP = (bf16_t*)(ws + WS_WUP); bf16_t* WDN = (bf16_t*)(ws + WS_WDN); bf16_t* WIN = (bf16_t*)(ws + WS_WIN); bf16_t* WOUT = (bf16_t*)(ws + WS_WOUT); \
    bf16_t* XN = (bf16_t*)(ws + WS_XN); bf16_t* HB = (bf16_t*)(ws + WS_H); bf16_t* PROJ = (bf16_t*)(ws + WS_PROJ); bf16_t* YU = (bf16_t*)(ws + WS_YU); \
    bf16_t* HLOC = (bf16_t*)(ws + WS_HLOC); bf16_t* PCUM = (bf16_t*)(ws + WS_PCUM); bf16_t* YN = (bf16_t*)(ws + WS_YN);
#define XB_TMO      128
#define XB_XCNT(j)  (256  + 64 * (j))
#define XB_XSUB(j)  (1280 + 64 * (j))
#define XB_XGEN(j)  (2304 + 64 * (j))
#define XB_TOP      3328
#define XB_TOPGEN   3392
#define XCD_BAR_WORDS 3456
#define XB_SPIN_CAP (1u << 18)

__device__ __forceinline__ unsigned xb_ld(unsigned* p)              { return __hip_atomic_load(p, __ATOMIC_RELAXED, __HIP_MEMORY_SCOPE_AGENT); }
__device__ __forceinline__ unsigned xb_add(unsigned* p, unsigned v) { return __hip_atomic_fetch_add(p, v, __ATOMIC_RELAXED, __HIP_MEMORY_SCOPE_AGENT); }
__device__ __forceinline__ unsigned xb_xcc_id() { return (unsigned)__builtin_amdgcn_s_getreg((3 << 11) | 20) & 0xFu; }
#define XB_SPIN(cond, bar) do { unsigned _sp = 0; while (cond) { __builtin_amdgcn_s_sleep(1); \
    if ((++_sp & 255u) == 0u) { if (xb_ld(&(bar)[XB_TMO])) break; if (_sp > XB_SPIN_CAP) { atomicAdd(&(bar)[XB_TMO], 1u); break; } } } } while (0)

struct XcdBarrier {
    unsigned* bar; unsigned x;
    volatile LAS unsigned* st;
};

__device__ __forceinline__ XcdBarrier xcd_barrier_post(unsigned* bar, volatile LAS unsigned* st) {
    XcdBarrier b; b.bar = bar; b.x = xb_xcc_id(); b.st = st;
    if (threadIdx.x == 0) (void)xb_add(&bar[XB_XCNT(b.x)], 1u);
    return b;
}
__device__ __forceinline__ void xcd_barrier_complete(unsigned* bar, unsigned x, unsigned& nloc, unsigned& nx) {
    const unsigned G = gridDim.x * gridDim.y * gridDim.z;
    unsigned sum, cnt, mine, sp = 0u;
    for (;;) {
        sum = 0u; cnt = 0u; mine = 0u;
#pragma unroll
        for (unsigned j = 0; j < 16; ++j) { const unsigned c = xb_ld(&bar[XB_XCNT(j)]); sum += c; cnt += (c > 0u) ? 1u : 0u; mine = (j == x) ? c : mine; }
        if (sum == G) break;
        __builtin_amdgcn_s_sleep(1);
        if ((++sp & 255u) == 0u) { if (xb_ld(&bar[XB_TMO])) break; if (sp > XB_SPIN_CAP) { atomicAdd(&bar[XB_TMO], 1u); break; } }
    }
    nloc = mine > 0u ? mine : 1u; nx = cnt > 0u ? cnt : 1u;
}

__device__ __forceinline__ void xcd_barrier(const XcdBarrier& b) {
    asm volatile("s_waitcnt vmcnt(0)" ::: "memory");
    __syncthreads();
    if (threadIdx.x == 0) {
        unsigned* bar = b.bar;
        __builtin_amdgcn_s_waitcnt(0);
        unsigned nloc = b.st[0], nx = b.st[1];
        if (nloc == 0u) { xcd_barrier_complete(bar, b.x, nloc, nx); b.st[0] = nloc; b.st[1] = nx; }
        const unsigned old = xb_add(&bar[XB_XSUB(b.x)], 1u);
        const unsigned gen = old / nloc;
        if (old + 1u == (gen + 1u) * nloc) {
            __builtin_amdgcn_fence(__ATOMIC_RELEASE, "agent");
            asm volatile("s_waitcnt vmcnt(0)" ::: "memory");
            const unsigned og = xb_add(&bar[XB_TOP], 1u);
            const unsigned tg = og / nx;
            if (og + 1u == (tg + 1u) * nx) xb_add(&bar[XB_TOPGEN], 1u);
            else XB_SPIN(xb_ld(&bar[XB_TOPGEN]) == tg, bar);
            __builtin_amdgcn_fence(__ATOMIC_ACQUIRE, "agent");
            xb_add(&bar[XB_XGEN(b.x)], 1u);
            asm volatile("s_waitcnt vmcnt(0)" ::: "memory");
        } else {
            XB_SPIN(xb_ld(&bar[XB_XGEN(b.x)]) == gen, bar);
            __builtin_amdgcn_fence(__ATOMIC_ACQUIRE, "agent");
            asm volatile("s_waitcnt vmcnt(0)" ::: "memory");
        }
    }
    __syncthreads();
}

__global__ void __launch_bounds__(512) mk_fwd(Args args) {
    extern __shared__ __attribute__((aligned(16))) unsigned char lds_raw[];
    LAS unsigned char* lds = (LAS unsigned char*)lds_raw;
    cg::grid_group grid = cg::this_grid();
    const int wave = __builtin_amdgcn_readfirstlane(threadIdx.x >> 6);
    const int G = gridDim.x; const int bx = blockIdx.x;
    const int vcu = (G % 8 == 0) ? (bx % 8) * (G / 8) + bx / 8 : bx;
    const int gw = vcu * 8 + wave, NGW = G * 8;
    const int lo = args.ph_lo, hi_ph = args.ph_hi;
    volatile LAS unsigned* MISC = (volatile LAS unsigned*)(lds + 131072 + 320);
    if (threadIdx.x < 16) MISC[threadIdx.x] = 0u;
    __syncthreads();
    XcdBarrier xbar = xcd_barrier_post((unsigned*)args.ws, MISC + 8);
    int ph = 0;
#define PH_ON (ph >= lo && ph < hi_ph)
#ifdef REP_SYNC
#define SYNC_EXTRA grid.sync(); asm volatile("" ::: "memory");
#else
#define SYNC_EXTRA
#endif
#define PH_NEXT do { ++ph; if (ph > lo && ph < hi_ph) { asm volatile("s_waitcnt vmcnt(0) lgkmcnt(0)" ::: "memory"); if (ph == 1) grid.sync(); else xcd_barrier(xbar); asm volatile("" ::: "memory"); SYNC_EXTRA } } while (0)

#ifdef REP_PRO
    int rp_ = 0; pro_again:
#endif
    if (PH_ON) { DEFPTRS
        for (int i = bx * 512 + tid; i < 5 * MTOK; i += G * 512) ROWSS[MTOK + i] = 0.f;
        LAS float* cact = (LAS float*)lds;
        LAS float* red = (LAS float*)(lds + 65536);
        for (int i = tid; i < 16 * 1024; i += 512) { const int b = i >> 10, k = i & 1023; const float v = c_in[i]; cact[k * 16 + b] = v * sigmoidf_(v); }
        __syncthreads();
        for (int task = bx; task < 288; task += G) {
            const int l = task / 144, n0 = (task % 144) * 64;
            float acc[16];
#pragma unroll
            for (int b = 0; b < 16; ++b) acc[b] = 0.f;
            const float* wp = w_ada + (size_t)l * 1024 * 9216 + n0 + lane;
#pragma unroll 1
            for (int k0 = wave * 128; k0 < wave * 128 + 128; k0 += 16) {
                float wv[16];
#pragma unroll
                for (int j = 0; j < 16; ++j) wv[j] = wp[(size_t)(k0 + j) * 9216];
                CFENCE();
#pragma unroll
                for (int j = 0; j < 16; ++j) { const int k = k0 + j; const float w = wv[j];
                    const f32x4 c0 = *(const LAS f32x4*)(cact + k * 16), c1 = *(const LAS f32x4*)(cact + k * 16 + 4), c2 = *(const LAS f32x4*)(cact + k * 16 + 8), c3 = *(const LAS f32x4*)(cact + k * 16 + 12);
#pragma unroll
                    for (int i = 0; i < 4; ++i) { acc[i] += c0[i] * w; acc[4 + i] += c1[i] * w; acc[8 + i] += c2[i] * w; acc[12 + i] += c3[i] * w; }
                    if ((j & 3) == 3) CFENCE(); }
            }
#pragma unroll
            for (int b = 0; b < 16; ++b) red[(wave * 16 + b) * 64 + lane] = acc[b];
            __syncthreads();
            for (int o = tid; o < 1024; o += 512) { const int b = o >> 6, ln = o & 63; float s = 0.f;
#pragma unroll
                for (int w = 0; w < 8; ++w) s += red[(w * 16 + b) * 64 + ln];
                MOD[((size_t)l * 16 + b) * 9216 + n0 + ln] = s + b_ada[l * 9216 + n0 + ln]; }
            __syncthreads();
        }
    }
    PH_NEXT;
    if (PH_ON) { DEFPTRS
        for (int i = bx * 512 + tid; i < 2 * 3 * 16 * 1024; i += G * 512) {
            const int k = i & 1023, b = (i >> 10) & 15, lj = i >> 14, l = lj / 3, j = lj % 3;
            const float* mp = MOD + ((size_t)l * 16 + b) * 9216 + j * 3072;
            GMOD[i] = g_norm[(l * 3 + j) * 1024 + k] * (1.0f + mp[1024 + k]);
            GATE[i] = (j == 1 ? 1.0f : 0.5f) * (1.0f + mp[2048 + k]);
        }
        LAS float* scr = (LAS float*)(lds + wave * 8448);
        constexpr int I_UP = 16 * 176, I_DN = 44 * 32, I_IN = 16 * 88, I_OUT = 16 * 32;
        constexpr int NIT = 4 * I_UP + 4 * I_DN + 2 * I_IN + 2 * I_OUT;
        for (int it = gw; it < NIT; it += NGW) {
            int r = it;
            if (r < 4 * I_UP) { const int mat = r / I_UP; r -= mat * I_UP; const int kb = r / 176, nb = r % 176, n0 = nb * 32;
                const int c0 = ((n0 >> 7) & 1) * DFF + (n0 >> 8) * 128 + (n0 & 127);
                transpose_item(w_up + (size_t)mat * DM * NUP, NUP, NUP, DM, WUP + (size_t)mat * NUP * DM, n0, c0, kb * 64, scr, lane); continue; }
            r -= 4 * I_UP;
            if (r < 4 * I_DN) { const int mat = r / I_DN; r -= mat * I_DN; const int kb = r / 32, nb = r % 32;
                transpose_item(w_dn + (size_t)mat * DFF * DM, DM, DM, DFF, WDN + (size_t)mat * DM * DFF, nb * 32, nb * 32, kb * 64, scr, lane); continue; }
            r -= 4 * I_DN;
            if (r < 2 * I_IN) { const int mat = r / I_IN; r -= mat * I_IN; const int kb = r / 88, nb = r % 88;
                transpose_item(w_in + (size_t)mat * DM * 2564, 2564, 2564, DM, WIN + (size_t)mat * NINP * DM, nb * 32, nb * 32, kb * 64, scr, lane); continue; }
            r -= 2 * I_IN;
            { const int mat = r / I_OUT; r -= mat * I_OUT; const int kb = r / 32, nb = r % 32;
                transpose_item(w_out + (size_t)mat * DM * DM, DM, DM, DM, WOUT + (size_t)mat * DM * DM, nb * 32, nb * 32, kb * 64, scr, lane); }
        }
        for (int m0 = gw; m0 < MTOK; m0 += 2 * NGW) {
            const int m1 = m0 + NGW;
            const f32x4* gp = (const f32x4*)(g_norm) + lane;
            const f32x4* xr0 = (const f32x4*)(x_in + (size_t)m0 * DM) + lane; const f32x4* xr1 = (const f32x4*)(x_in + (size_t)m1 * DM) + lane;
            f32x4 v0[4], v1[4];
#pragma unroll
            for (int j = 0; j < 4; ++j) { v0[j] = xr0[64 * j]; v1[j] = xr1[64 * j]; }
            const f32x4* sp0 = (const f32x4*)(MOD + (size_t)(m0 >> 12) * 9216 + 1024) + lane; const f32x4* sp1 = (const f32x4*)(MOD + (size_t)(m1 >> 12) * 9216 + 1024) + lane;
            float s0 = 0.f, s1 = 0.f; u32x2* o0 = (u32x2*)(XN + (size_t)m0 * DM) + lane; u32x2* o1 = (u32x2*)(XN + (size_t)m1 * DM) + lane;
#pragma unroll
            for (int j = 0; j < 4; ++j) { const f32x4 g = gp[64 * j];
                { const f32x4 v = v0[j]; s0 += (v[0] * v[0] + v[1] * v[1]) + (v[2] * v[2] + v[3] * v[3]); const f32x4 a = v * g * (sp0[64 * j] + 1.0f); u32x2 w; w.x = pk2(a[0], a[1]); w.y = pk2(a[2], a[3]); o0[64 * j] = w; }
                { const f32x4 v = v1[j]; s1 += (v[0] * v[0] + v[1] * v[1]) + (v[2] * v[2] + v[3] * v[3]); const f32x4 a = v * g * (sp1[64 * j] + 1.0f); u32x2 w; w.x = pk2(a[0], a[1]); w.y = pk2(a[2], a[3]); o1[64 * j] = w; } }
            s0 = wave_sum(s0); s1 = wave_sum(s1);
            if (lane == 0) { ROWSS[m0] = s0; ROWSS[m1] = s1; }
        }
    }
    PH_NEXT;
    if (PH_ON) { DEFPTRS
        LAS float* sh = (LAS float*)lds;
        for (int combo = 0; combo < 6; ++combo) {
            const int l = combo / 3, j = combo % 3;
            __syncthreads();
            for (int i = tid; i < 16 * 1024; i += 512) { const int b = i >> 10, k = i & 1023; sh[i] = MOD[((size_t)l * 16 + b) * 9216 + j * 3072 + k]; }
            __syncthreads();
            const bf16_t* Wt = (j == 1) ? WIN + (size_t)l * NINP * DM : WUP + (size_t)(l * 2 + (j == 2 ? 1 : 0)) * NUP * DM;
            const int N = (j == 1) ? NINP : NUP;
            float* dst = SBV + (size_t)combo * 16 * 5632;
            for (int n = gw; n < N; n += NGW) {
                float w[16];
#pragma unroll
                for (int c = 0; c < 4; ++c) { const u32x2 q = *(const u32x2*)(Wt + (size_t)n * DM + c * 256 + lane * 4);
                    w[4 * c] = __uint_as_float(q.x << 16); w[4 * c + 1] = __uint_as_float(q.x & 0xffff0000u); w[4 * c + 2] = __uint_as_float(q.y << 16); w[4 * c + 3] = __uint_as_float(q.y & 0xffff0000u); }
                float sv[16];
#pragma unroll
                for (int b = 0; b < 16; ++b) { float s = 0.f;
#pragma unroll
                    for (int c = 0; c < 4; ++c) { const f32x4 v = *(const LAS f32x4*)(sh + b * 1024 + c * 256 + lane * 4); s += (w[4 * c] * v[0] + w[4 * c + 1] * v[1]) + (w[4 * c + 2] * v[2] + w[4 * c + 3] * v[3]); }
                    sv[b] = s; if ((b & 3) == 3) CFENCE(); }
                float t8[8], t4[4], t2[2];
#pragma unroll
                for (int i = 0; i < 8; ++i) { const float snd = (lane & 32) ? sv[i] : sv[i + 8], kp = (lane & 32) ? sv[i + 8] : sv[i]; t8[i] = kp + __shfl_xor(snd, 32); }
#pragma unroll
                for (int i = 0; i < 4; ++i) { const float snd = (lane & 16) ? t8[i] : t8[i + 4], kp = (lane & 16) ? t8[i + 4] : t8[i]; t4[i] = kp + __shfl_xor(snd, 16); }
#pragma unroll
                for (int i = 0; i < 2; ++i) { const float snd = (lane & 8) ? t4[i] : t4[i + 2], kp = (lane & 8) ? t4[i + 2] : t4[i]; t2[i] = kp + __shfl_xor(snd, 8); }
                float t1; { const float snd = (lane & 4) ? t2[0] : t2[1], kp = (lane & 4) ? t2[1] : t2[0]; t1 = kp + __shfl_xor(snd, 4); }
                t1 += __shfl_xor(t1, 2); t1 += __shfl_xor(t1, 1);
                const int bsel = ((lane >> 5) & 1) * 8 + ((lane >> 4) & 1) * 4 + ((lane >> 3) & 1) * 2 + ((lane >> 2) & 1);
                if ((lane & 3) == 0) dst[(size_t)bsel * 5632 + n] = t1;
            }
        }
        __syncthreads();
    }
    PH_NEXT;

#ifdef REP_PRO
    if (rp_ == 0) { rp_ = 1; ph = 0; goto pro_again; }
#endif
#pragma unroll 1
    for (int f = 0; f < 4; ++f) {
        const int l = f >> 1, s = f & 1;
        if (s == 1) {
            if (PH_ON) { DEFPTRS
                pg8::Gemm g{XN, WIN + (size_t)l * NINP * DM, MTOK, NINP, DM}; pg8::StaticOrder S; S.init(MTOK, NINP, G, bx);
                pg8::EpiIn E{PROJ, FG, ROWSS + (size_t)(l * 3 + 1) * MTOK, SBV + (size_t)(l * 3 + 1) * 16 * 5632};
#ifndef NO_G_IN
                for (int rep_ = 0; rep_ < REP_IN; ++rep_) {
                pg8::gemm_phase<pg8::EpiIn, pg8::StaticOrder, true, true>(lds, g, S, E); }
#endif
            }
            PH_NEXT;
            if (PH_ON) { DEFPTRS
#ifndef NO_PREP
                {
                    const int blk = vcu & 7, n = lane & 31, hi = lane >> 5;
                    LAS unsigned char* wfl = lds;
                    LAS float* xs = (LAS float*)(lds + 16384 + wave * 13568);
                    LAS unsigned char* ub = lds + 16384 + wave * 13568 + 8960;
#pragma unroll
                    for (int q = 0; q < 2; ++q) { const int f = wave * 2 + q, gt = f >> 3, nb = (f >> 2) & 1, d0 = f & 3;
                        const float* wsrc = (gt ? w_ig : w_rg) + ((size_t)(l * 8 + blk) * 64 + 16 * d0 + 8 * hi) * 64 + nb * 32 + n;
                        u32x4 w; w.x = pk2(wsrc[0], wsrc[64]); w.y = pk2(wsrc[128], wsrc[192]); w.z = pk2(wsrc[256], wsrc[320]); w.w = pk2(wsrc[384], wsrc[448]);
                        *(LAS u32x4*)(wfl + f * 1024 + lane * 16) = w; }
                    __syncthreads();
                    float br[2], bi[2], cb[2], cw[2][4], c8[2];
#pragma unroll
                    for (int nb = 0; nb < 2; ++nb) { const int ch = blk * 64 + nb * 32 + n;
                        br[nb] = b_rg[l * 512 + ch]; bi[nb] = b_ig[l * 512 + ch]; cb[nb] = conv_b[l * 512 + ch];
#pragma unroll
                        for (int k = 0; k < 4; ++k) cw[nb][k] = conv_w[(l * 4 + k) * 512 + ch];
                        const float lmv = lam[l * 512 + ch];
                        c8[nb] = -8.0f * LOG2E * (__builtin_fmaxf(-lmv, 0.f) + log1pf(expf(-fabsf(lmv)))); }
                    for (int segi = (vcu >> 3) * 8 + wave; segi < REP_PREP * (MTOK / 32); segi += (G >> 3) * 8) { const int seg = segi & (MTOK / 32 - 1);
                        const int row0 = seg * 32; const bool first = (row0 & (SEQL - 1)) == 0;
                        const bf16_t* xp = PROJ + (size_t)row0 * PPITCH + blk * 64;
                        CFENCE();
#pragma unroll
                        for (int t = 0; t < 35; ++t) { float v = 0.f; if (t >= 3 || !first) v = bf2f((xp + ((long)t - 3) * PPITCH)[lane]); xs[t * 64 + lane] = v; }
                        CFENCE();
#pragma unroll
                        for (int nb = 0; nb < 2; ++nb)
#pragma unroll
                            for (int g = 0; g < 4; ++g) { const LAS float* xb = xs + (8 * g + 4 * hi) * 64 + nb * 32 + n; float xv[7];
#pragma unroll
                                for (int j = 0; j < 7; ++j) xv[j] = xb[j * 64];
#pragma unroll
                                for (int i = 0; i < 4; ++i) { const float uu = cb[nb] + cw[nb][0] * xv[i] + cw[nb][1] * xv[i + 1] + cw[nb][2] * xv[i + 2] + cw[nb][3] * xv[i + 3];
                                    *(LAS unsigned short*)(ub + (8 * g + 4 * hi + i) * 144 + (nb * 32 + n) * 2) = (unsigned short)f2bf(uu); }
                                __builtin_amdgcn_sched_barrier(0); }
                        CFENCE();
                        bf16x8 af[4];
#pragma unroll
                        for (int d0 = 0; d0 < 4; ++d0) af[d0] = *(const LAS bf16x8*)(ub + n * 144 + (16 * d0 + 8 * hi) * 2);
#pragma unroll
                        for (int nb = 0; nb < 2; ++nb) {
                            f32x16 arx, aix;
#pragma unroll
                            for (int r = 0; r < 16; ++r) { arx[r] = br[nb]; aix[r] = bi[nb]; }
#pragma unroll
                            for (int d0 = 0; d0 < 4; ++d0) { const bf16x8 w0 = *(const LAS bf16x8*)(wfl + ((0 * 2 + nb) * 4 + d0) * 1024 + lane * 16), w1 = *(const LAS bf16x8*)(wfl + ((1 * 2 + nb) * 4 + d0) * 1024 + lane * 16);
                                                             arx = __builtin_amdgcn_mfma_f32_32x32x16_bf16(af[d0], w0, arx, 0, 0, 0);
                                                             aix = __builtin_amdgcn_mfma_f32_32x32x16_bf16(af[d0], w1, aix, 0, 0, 0); }
                            CFENCE(); __builtin_amdgcn_sched_barrier(0);
#pragma unroll
                            for (int r = 0; r < 16; ++r) {
                                float uu; { const LAS float* xb = xs + (8 * (r >> 2) + 4 * hi + (r & 3)) * 64 + nb * 32 + n;
                                    uu = cb[nb] + cw[nb][0] * xb[0] + cw[nb][1] * xb[64] + cw[nb][2] * xb[128] + cw[nb][3] * xb[192]; }
                                const float rg = sigmoidf_(arx[r]), ig = sigmoidf_(aix[r]);
                                const float la2 = c8[nb] * rg, a = __builtin_amdgcn_exp2f(la2);
                                const float xx = 2.0f * 0.6931471805599453f * la2;
                                const float om = (xx > -0.25f) ? -xx * (1.0f + xx * 0.5f * (1.0f + xx * (1.0f / 3.0f) * (1.0f + xx * 0.25f * (1.0f + xx * 0.2f)))) : 1.0f - a * a;
                                arx[r] = a; aix[r] = __builtin_sqrtf(om) * ig * uu;
                            }
                            float H = 0.f, P = 1.f;
                            const int ch = blk * 64 + nb * 32 + n;
                            bf16_t* hl = HLOC + (size_t)(row0 + 4 * hi) * 512 + ch; bf16_t* pc = PCUM + (size_t)(row0 + 4 * hi) * 512 + ch;
#pragma unroll
                            for (int g = 0; g < 4; ++g) {
                                const float a0 = arx[4 * g], a1 = arx[4 * g + 1], a2 = arx[4 * g + 2], a3 = arx[4 * g + 3];
                                const float b0 = aix[4 * g], b1 = aix[4 * g + 1], b2 = aix[4 * g + 2], b3 = aix[4 * g + 3];
                                const float Ao = (a0 * a1) * (a2 * a3), Bo = ((b0 * a1 + b1) * a2 + b2) * a3 + b3;
                                const float Ap = __shfl_xor(Ao, 32), Bp = __shfl_xor(Bo, 32);
                                const float A1 = hi ? Ap : Ao, B1 = hi ? Bp : Bo, A2 = hi ? Ao : Ap, B2 = hi ? Bo : Bp;
                                const float Hm = A1 * H + B1, Pm = A1 * P;
                                float h = hi ? Hm : H, p = hi ? Pm : P;
                                H = A2 * Hm + B2; P = A2 * Pm;
                                bf16_t* hg = hl + (size_t)g * 8 * 512; bf16_t* pg = pc + (size_t)g * 8 * 512; asm volatile("" : "+v"(hg), "+v"(pg));
                                h = a0 * h + b0; p *= a0; hg[0 * 512] = (bf16_t)f2bf(h); pg[0 * 512] = (bf16_t)f2bf(p);
                                h = a1 * h + b1; p *= a1; hg[1 * 512] = (bf16_t)f2bf(h); pg[1 * 512] = (bf16_t)f2bf(p);
                                h = a2 * h + b2; p *= a2; hg[2 * 512] = (bf16_t)f2bf(h); pg[2 * 512] = (bf16_t)f2bf(p);
                                h = a3 * h + b3; p *= a3; hg[3 * 512] = (bf16_t)f2bf(h); pg[3 * 512] = (bf16_t)f2bf(p);
                            }
                            if (hi == 0) { ASEG[(size_t)seg * 512 + ch] = P; BSEG[(size_t)seg * 512 + ch] = H; }
                            CFENCE(); __builtin_amdgcn_sched_barrier(0);
                        }
                    }
                }
                for (int row = gw; row < MTOK; row += NGW) {
                    const u32x2 q = *(const u32x2*)(PROJ + (size_t)row * PPITCH + 2048 + lane * 4);
                    const float a0 = __uint_as_float(q.x << 16), a1 = __uint_as_float(q.x & 0xffff0000u), a2 = __uint_as_float(q.y << 16), a3 = __uint_as_float(q.y & 0xffff0000u);
                    float ss = (a0 * a0 + a1 * a1) + (a2 * a2 + a3 * a3);
                    ss += __shfl_xor(ss, 1); ss += __shfl_xor(ss, 2); ss += __shfl_xor(ss, 4); ss += __shfl_xor(ss, 8);
                    const float rk = __builtin_amdgcn_rsqf(ss * (1.0f / 64.0f) + EPSF);
                    u32x2 kn; kn.x = pk2(a0 * rk, a1 * rk); kn.y = pk2(a2 * rk, a3 * rk);
                    *(u32x2*)(PROJ + (size_t)row * PPITCH + 2048 + lane * 4) = kn;
                }
                if (wave == 0) for (int chn = vcu; chn < 64; chn += G) {
                    const int b = chn >> 2, h = chn & 3; const float bf = b_fg[l * 4 + h];
                    const float* fp = FG + ((size_t)b * SEQL + lane * 64) * 4 + h;
                    float tot = 0.f;
#pragma unroll 8
                    for (int i = 0; i < 64; ++i) { const float v = fp[i * 4] + bf; tot += __builtin_fminf(v, 0.f) - log1pf(expf(-fabsf(v))); }
                    float inc = tot;
#pragma unroll
                    for (int o = 1; o < 64; o <<= 1) { const float t_ = __shfl_up(inc, o); if (lane >= o) inc += t_; }
                    float run = inc - tot;
                    float* op = F2 + (size_t)chn * SEQL + lane * 64;
#pragma unroll 8
                    for (int i = 0; i < 64; ++i) { const float v = fp[i * 4] + bf; run += __builtin_fminf(v, 0.f) - log1pf(expf(-fabsf(v))); op[i] = -run * LOG2E; }
                }
#endif
                __syncthreads();
            }
            PH_NEXT;
            if (PH_ON) { DEFPTRS
#ifndef NO_ATTN
                for (int rep_ = 0; rep_ < REP_ATTN; ++rep_)
                for (int tt = vcu; tt < 256; tt += G) { const int ch = tid; float A = 1.f, B = 0.f;
#pragma unroll
                    for (int s8 = 0; s8 < 8; ++s8) { const float as_ = ASEG[(size_t)(tt * 8 + s8) * 512 + ch], bs_ = BSEG[(size_t)(tt * 8 + s8) * 512 + ch]; A = as_ * A; B = as_ * B + bs_; }
                    TSEGA[(size_t)tt * 512 + ch] = A; TSEGB[(size_t)tt * 512 + ch] = B; }
                for (int vw = vcu; vw < 256; vw += G) {
                    const int bh = vw >> 2, s4 = vw & 3, b = bh >> 2, h = bh & 3;
#pragma unroll 1
                    for (int i = 0; i < 4; ++i) { const int qb = (i == 0) ? s4 : (i == 1) ? 7 - s4 : (i == 2) ? 8 + s4 : 15 - s4;
#ifndef NO_FOX
                        attn_unit<1>(lds, PROJ, YU, KS, F2, g_qk + l * 128, b, h, qb);
#endif
 }
#pragma unroll 1
                    for (int i = 0; i < 4; ++i) { const int qb = (i == 0) ? s4 : (i == 1) ? 7 - s4 : (i == 2) ? 8 + s4 : 15 - s4;
#ifndef NO_SB
                        attn_unit<0>(lds, PROJ, YU, KS, F2, g_qk + l * 128, b, h, qb);
#endif
 }
                }
#endif
            }
            PH_NEXT;
            if (PH_ON) { DEFPTRS
                LAS float* hin = (LAS float*)lds;
                const f32x4 gm0 = *(const f32x4*)(g_mix + l * 1024 + lane * 8), gm1 = *(const f32x4*)(g_mix + l * 1024 + lane * 8 + 4);
                const f32x4 gx0 = *(const f32x4*)(g_mix + l * 1024 + 512 + lane * 8), gx1 = *(const f32x4*)(g_mix + l * 1024 + 512 + lane * 8 + 4);
                for (int tti = vcu; tti < REP_FIN * 256; tti += G) { const int tt = tti & 255;
                    __syncthreads();
                    { const int ch = tid, seg0 = (tt >> 4) * 128, nb = (tt & 15) * 8; float Hc = 0.f;
#pragma unroll 5
                      for (int t_ = (tt & ~15); t_ < tt; ++t_) Hc = TSEGA[(size_t)t_ * 512 + ch] * Hc + TSEGB[(size_t)t_ * 512 + ch];
#pragma unroll
                      for (int s8 = 0; s8 < 8; ++s8) { hin[s8 * 512 + ch] = Hc; Hc = ASEG[(size_t)(seg0 + nb + s8) * 512 + ch] * Hc + BSEG[(size_t)(seg0 + nb + s8) * 512 + ch]; } }
                    __syncthreads();
                    const f32x4 hi0 = *(const LAS f32x4*)(hin + wave * 512 + lane * 8), hi1 = *(const LAS f32x4*)(hin + wave * 512 + lane * 8 + 4);
#pragma unroll 2
                    for (int t = 0; t < 32; ++t) {
                        const size_t row = (size_t)tt * 256 + wave * 32 + t;
                        const u32x4 hq = *(const u32x4*)(HLOC + row * 512 + lane * 8);
                        const u32x4 pq = *(const u32x4*)(PCUM + row * 512 + lane * 8);
                        const u32x4 gq = *(const u32x4*)(PROJ + row * PPITCH + 512 + lane * 8);
                        const u32x4 yq = *(const u32x4*)(YU + row * 512 + lane * 8);
                        float y[8], yu[8]; float ss = 0.f, s2 = 0.f;
#pragma unroll
                        for (int i = 0; i < 8; ++i) {
                            const unsigned pw = pq[i >> 1], gw_ = gq[i >> 1], yw = yq[i >> 1];
                            const float p = (i & 1) ? __uint_as_float(pw & 0xffff0000u) : __uint_as_float(pw << 16);
                            const float gg = (i & 1) ? __uint_as_float(gw_ & 0xffff0000u) : __uint_as_float(gw_ << 16);
                            yu[i] = (i & 1) ? __uint_as_float(yw & 0xffff0000u) : __uint_as_float(yw << 16);
                            const unsigned hw = hq[i >> 1]; const float hlv = (i & 1) ? __uint_as_float(hw & 0xffff0000u) : __uint_as_float(hw << 16);
                            const float hh = hlv + p * (i < 4 ? hi0[i & 3] : hi1[i & 3]);
                            const float inner = 0.7978845608028654f * (gg + 0.044715f * gg * gg * gg);
                            const float ge = gg * __builtin_amdgcn_rcpf(1.0f + __builtin_amdgcn_exp2f(-2.0f * LOG2E * inner));
                            y[i] = hh * ge; ss += y[i] * y[i]; s2 += yu[i] * yu[i];
                        }
                        ss = wave_sum(ss);
                        s2 += __shfl_xor(s2, 1); s2 += __shfl_xor(s2, 2); s2 += __shfl_xor(s2, 4); s2 += __shfl_xor(s2, 8); s2 += __shfl_xor(s2, 16);
                        const float rl = __builtin_amdgcn_rsqf(ss * (1.0f / 512.0f) + EPSF), rx = __builtin_amdgcn_rsqf(s2 * (1.0f / 256.0f) + EPSF);
                        u32x4 o1, o2;
                        o1.x = pk2(y[0] * rl * gm0[0], y[1] * rl * gm0[1]); o1.y = pk2(y[2] * rl * gm0[2], y[3] * rl * gm0[3]);
                        o1.z = pk2(y[4] * rl * gm1[0], y[5] * rl * gm1[1]); o1.w = pk2(y[6] * rl * gm1[2], y[7] * rl * gm1[3]);
                        o2.x = pk2(yu[0] * rx * gx0[0], yu[1] * rx * gx0[1]); o2.y = pk2(yu[2] * rx * gx0[2], yu[3] * rx * gx0[3]);
                        o2.z = pk2(yu[4] * rx * gx1[0], yu[5] * rx * gx1[1]); o2.w = pk2(yu[6] * rx * gx1[2], yu[7] * rx * gx1[3]);
                        *(u32x4*)(YN + row * 1024 + lane * 8) = o1; *(u32x4*)(YN + row * 1024 + 512 + lane * 8) = o2;
                    }
                }
                __syncthreads();
            }
            PH_NEXT;
            if (PH_ON) { DEFPTRS
                pg8::Gemm g{YN, WOUT + (size_t)l * DM * DM, MTOK, DM, DM}; pg8::StaticOrder S; S.init(MTOK, DM, G, bx, 24);
                pg8::EpiRes E{xout, xout, GATE + (size_t)(l * 3 + 1) * 16 * 1024, GMOD + (size_t)(l * 3 + 2) * 16 * 1024, XN, ROWSS + (size_t)(l * 3 + 2) * MTOK, 1};
#ifndef NO_G_OUT
#ifdef REP_OUT
                { E.xout = (float*)HB; E.has_next = 0; pg8::gemm_phase<pg8::EpiRes, pg8::StaticOrder, true, true>(lds, g, S, E); E.xout = xout; E.has_next = 1; }
#endif
                pg8::gemm_phase<pg8::EpiRes, pg8::StaticOrder, true, true>(lds, g, S, E);
#endif
            }
            PH_NEXT;
        }
        const int j = s ? 2 : 0;
        if (PH_ON) { DEFPTRS
            pg8::Gemm g{XN, WUP + (size_t)(l * 2 + s) * NUP * DM, MTOK, NUP, DM}; pg8::StaticOrder S; S.init(MTOK, NUP, G, bx);
            pg8::EpiUp E{HB, ROWSS + (size_t)(l * 3 + j) * MTOK, SBV + (size_t)(l * 3 + j) * 16 * 5632};
#ifndef NO_G_UP
            for (int rep_ = 0; rep_ < REP_UP; ++rep_) {
            pg8::gemm_phase<pg8::EpiUp, pg8::StaticOrder, true, true>(lds, g, S, E);
            }
#endif
        }
        PH_NEXT;
        if (PH_ON) { DEFPTRS
            const int nl = s ? l + 1 : l, nj = s ? 0 : 1; const int has_next = (nl < 2) ? 1 : 0; const int nidx = has_next ? nl * 3 + nj : 0;
            pg8::Gemm g{HB, WDN + (size_t)(l * 2 + s) * DM * DFF, MTOK, DM, DFF}; pg8::StaticOrder S; S.init(MTOK, DM, G, bx, 24);
            pg8::EpiRes E{f == 0 ? x_in : xout, xout, GATE + (size_t)(l * 3 + j) * 16 * 1024, GMOD + (size_t)nidx * 16 * 1024, XN, ROWSS + (size_t)nidx * MTOK, has_next};
#ifndef NO_G_DN
#ifdef REP_DN
            for (int rep_ = 0; rep_ < 2; ++rep_) { E.xout = (rep_ == 0) ? (float*)HLOC : xout; E.has_next = (rep_ == 0) ? 0 : has_next;
            pg8::gemm_phase<pg8::EpiRes, pg8::StaticOrder, true, true>(lds, g, S, E); }
#else
            pg8::gemm_phase<pg8::EpiRes, pg8::StaticOrder, true, true>(lds, g, S, E);
#endif
#endif
        }
        PH_NEXT;
    }
#undef PH_ON
#undef PH_NEXT
}


#ifdef DBG_STOP
__global__ void dbg_dump(const unsigned char* ws, float* out, int mode) {
    const size_t n = (size_t)MTOK * DM; const size_t i0 = (size_t)blockIdx.x * blockDim.x + threadIdx.x, st = (size_t)gridDim.x * blockDim.x;
    const bf16_t* XN = (const bf16_t*)(ws + WS_XN); const bf16_t* HB = (const bf16_t*)(ws + WS_H); const bf16_t* PR = (const bf16_t*)(ws + WS_PROJ);
    const bf16_t* YU = (const bf16_t*)(ws + WS_YU); const float* HL = (const float*)(ws + WS_HLOC); const bf16_t* YN = (const bf16_t*)(ws + WS_YN); const bf16_t* PC = (const bf16_t*)(ws + WS_PCUM);
    for (size_t i = i0; i < n; i += st) {
        float v = 0.f;
        if (mode == 0) v = bf2f(XN[i]);
        else if (mode == 1) v = bf2f(HB[i]) + bf2f(HB[i + n]) + bf2f(HB[i + (size_t)117440512]);
        else if (mode == 2) v = bf2f(PR[i]) + bf2f(PR[i + n]) + bf2f(PR[i + (size_t)100663296]);
        else if (mode == 3) v = (i < n / 2) ? bf2f(YU[i]) : HL[i - n / 2];
        else if (mode == 4) v = bf2f(YN[i]);
        else if (mode == 6) v = (i < n / 2) ? bf2f(PC[i]) : ((const float*)(ws + WS_KS))[(i - n / 2) % (3 * 262144)];
        else if (mode == 7) v = HL[i % (n / 2)] + bf2f(PC[i % (n / 2)]) + ((const float*)(ws + WS_KS))[i % (3 * 262144)] + ((const float*)(ws + WS_ASEG))[i % (2 * 1048576)];
        if (mode == 3) { const bool nan_ = !(v == v), big = (v > 3e38f) || (v < -3e38f); float code = 0.f;
            if (i < n / 2) { const int col = (int)(i & 511); if (col < 256) code = nan_ ? 2000.f : (big ? 1000.f : 0.f); else code = (nan_ || big) ? 4000.f : 0.f; }
            else code = (nan_ || big) ? 8000.f : 0.f;
            v = code; }
        if (!(v == v)) v = 77777.f; if (v > 3e38f) v = 88888.f; if (v < -3e38f) v = 99999.f;
        if (mode != 5) out[i] = v;
    }
}
#endif
#ifndef MK_N_LAUNCHES
#define MK_N_LAUNCHES 1
#endif
constexpr int N_PHASES = 3 + 2 * 9;
extern "C" void kernel_launch(void* const* d_in, const int* in_sizes, int n_in, void* d_out, int out_size, void* d_ws, size_t ws_size, hipStream_t stream) {
    static int grid = 0;
    if (grid == 0) {
        if (n_in != 19 || out_size != MTOK * DM || ws_size < WS_END) { fprintf(stderr, "kernel_launch: unexpected shapes (n_in %d, out %d, ws %zu)\n", n_in, out_size, ws_size); grid = -1; return; }
        int dev = 0, cus = 0, per_cu = 0;
        hipGetDevice(&dev); hipDeviceGetAttribute(&cus, hipDeviceAttributeMultiprocessorCount, dev);
        if (hipFuncSetAttribute((const void*)mk_fwd, hipFuncAttributeMaxDynamicSharedMemorySize, LDS_BYTES) != hipSuccess) { fprintf(stderr, "kernel_launch: hipFuncSetAttribute failed\n"); grid = -1; return; }
        if (hipOccupancyMaxActiveBlocksPerMultiprocessor(&per_cu, (const void*)mk_fwd, 512, LDS_BYTES) != hipSuccess || per_cu < 1) { fprintf(stderr, "kernel_launch: occupancy query says %d\n", per_cu); per_cu = 1; }
        (void)hipGetLastError();
        grid = cus * 1;
    }
    if (grid < 0) return;
    if (hipMemsetAsync(d_ws, 0, 16384, stream) != hipSuccess) { fprintf(stderr, "kernel_launch: memset failed\n"); return; }
    Args a{};
    for (int i = 0; i < 19; ++i) a.in[i] = (const float*)d_in[i];
    a.out = (float*)d_out; a.ws = (unsigned char*)d_ws;
#if MK_N_LAUNCHES == 1
    a.ph_lo = 0; a.ph_hi = N_PHASES;
    void* kargs[] = {&a};
    hipError_t e = hipLaunchCooperativeKernel((const void*)mk_fwd, dim3(grid), dim3(512), kargs, LDS_BYTES, stream);
    if (e != hipSuccess) fprintf(stderr, "kernel_launch: cooperative launch failed: %s (grid %d)\n", hipGetErrorString(e), grid);
#else
#ifdef DBG_STOP
    for (int p = 0; p < DBG_STOP; ++p) { a.ph_lo = p; a.ph_hi = p + 1; hipLaunchKernelGGL(mk_fwd, dim3(grid), dim3(512), LDS_BYTES, stream, a); }
    hipLaunchKernelGGL(dbg_dump, dim3(2048), dim3(256), 0, stream, (const unsigned char*)d_ws, (float*)d_out, DBG_MODE);
#else
    for (int p = 0; p < N_PHASES; ++p) { a.ph_lo = p; a.ph_hi = p + 1; hipLaunchKernelGGL(mk_fwd, dim3(grid), dim3(512), LDS_BYTES, stream, a); }
#endif
#endif
}
```

```cpp
#include <hip/hip_runtime.h>
#include <hip/hip_cooperative_groups.h>
#include <cstdio>
#include <cstdint>
namespace cg = cooperative_groups;
namespace pg8 {
#define PG8_LAS __attribute__((address_space(3)))
typedef unsigned short bf16_t;
typedef short bf16x8 __attribute__((ext_vector_type(8)));
typedef float f32x4 __attribute__((ext_vector_type(4)));
typedef unsigned u32x4 __attribute__((ext_vector_type(4)));
constexpr int BM = 256, BK = 64, HALF = 128, HTB = HALF * BK * 2  , STAGE_BYTES = 8 * HTB, NXCD = 8, WGM = 8;

__host__ __device__ __forceinline__ int lds_byte(int r, int c) { const int st = (r >> 4) * 2 + (c >> 5), rr = r & 15, cc = c & 31, ob = rr * 64 + cc * 2; return st * 1024 + (ob ^ (((ob >> 9) & 1) << 5)); }
__host__ __device__ __forceinline__ void stage_rc(int b, int& R, int& C) { const int st = b / 1024, sb = b % 1024, swz = sb ^ (((sb >> 9) & 1) << 5); R = (st >> 1) * 16 + swz / 64; C = (st & 1) * 32 + (swz % 64) / 2; }
__host__ __device__ __forceinline__ int perm32(int rho) { const int n = rho >> 4, i = rho & 15; return 8 * (i >> 2) + 4 * n + (i & 3); }

struct Unit { int pm, pn; };
struct Gemm { const bf16_t* A; const bf16_t* Bt; int M, N, K; };

struct StaticOrder {
    int nM, nN, nwg, G, c, rev;
    __host__ __device__ void init(int M, int N, int G_, int c_, int rev_ = 0) { nM = M / BM; nN = N / BM; nwg = nM * nN; G = G_; c = c_; rev = rev_; }
    __host__ __device__ bool next(int i, Unit& u) const {
        const long L = (long)i * G + c; if (L >= nwg) return false;
        int wgid = (int)L; { const int q = nwg / NXCD, r = nwg % NXCD, xcd = wgid % NXCD, off = wgid / NXCD; wgid = (xcd < r ? xcd * (q + 1) : r * (q + 1) + (xcd - r) * q) + off; }
        const int nig = WGM * nN, gid = wgid / nig, fm = gid * WGM, gsz = (nM - fm) < WGM ? (nM - fm) : WGM;
        u.pm = (fm + ((wgid % nig) % gsz)) ^ rev; u.pn = (wgid % nig) / gsz; return true;
    }
    __device__ __forceinline__ void a_ready(const Unit&) const {}
    __device__ __forceinline__ void done(const Unit&) const {}
};

typedef float f32x2c_t __attribute__((ext_vector_type(2))); typedef __bf16 bf16x2c_t __attribute__((ext_vector_type(2)));
__device__ __forceinline__ unsigned cvt_pk_bf16(float lo, float hi) { f32x2c_t v = {lo, hi}; bf16x2c_t b = __builtin_convertvector(v, bf16x2c_t); return __builtin_bit_cast(unsigned, b); }
typedef float f32x2 __attribute__((ext_vector_type(2)));
constexpr float RMS_EPS = 1e-6f;
struct EpiUp {
    static constexpr bool PERM = true, AFTER_DRAIN = false;
    bf16_t* H; const float* rowss; const float* sb;
    __device__ __forceinline__ void operator()(const f32x4 (&acc)[2][2][4][2], const Unit& u, int wr, int wc, int fr, int fq) const {
        const int row0 = u.pm * BM + wr * 64 + fr, b = u.pm >> 4, cl = wc * 32 + 8 * fq;
        const float* sbp = sb + (size_t)b * 5632 + u.pn * 256 + cl;
        float rsv[2][4];
#pragma unroll
        for (int ai = 0; ai < 2; ++ai)
#pragma unroll
            for (int m = 0; m < 4; ++m) rsv[ai][m] = rowss[row0 + ai * HALF + m * 16];
        f32x4 sg[2], su[2];
#pragma unroll
        for (int n = 0; n < 2; ++n) { sg[n] = *(const f32x4*)(sbp + 4 * n); su[n] = *(const f32x4*)(sbp + 128 + 4 * n); }
#pragma unroll
        for (int ai = 0; ai < 2; ++ai)
#pragma unroll
            for (int m = 0; m < 4; ++m) {
                const int row = row0 + ai * HALF + m * 16;
                const float rs = __builtin_amdgcn_rsqf(rsv[ai][m] * (1.0f / 1024.0f) + RMS_EPS);
                unsigned wq[4];
#pragma unroll
                for (int n = 0; n < 2; ++n)
#pragma unroll
                    for (int ip = 0; ip < 2; ++ip) {
                        const f32x2 ag = (f32x2){acc[ai][0][m][n][2 * ip], acc[ai][0][m][n][2 * ip + 1]}, au = (f32x2){acc[ai][1][m][n][2 * ip], acc[ai][1][m][n][2 * ip + 1]};
                        const f32x2 g = ag * rs + (f32x2){sg[n][2 * ip], sg[n][2 * ip + 1]}, uu = au * rs + (f32x2){su[n][2 * ip], su[n][2 * ip + 1]};
                        const f32x2 t = g * (-1.4426950408889634f);
                        f32x2 d; d.x = __builtin_amdgcn_exp2f(t.x); d.y = __builtin_amdgcn_exp2f(t.y); d = d + 1.0f;
                        f32x2 r; r.x = __builtin_amdgcn_rcpf(d.x); r.y = __builtin_amdgcn_rcpf(d.y);
                        const f32x2 hv = (g * uu) * r;
                        wq[n * 2 + ip] = cvt_pk_bf16(hv.x, hv.y);
                    }
                u32x4 w; w.x = wq[0]; w.y = wq[1]; w.z = wq[2]; w.w = wq[3];
                *(u32x4*)(H + (size_t)row * 2816 + u.pn * 128 + cl) = w;
            }
    }
};
struct EpiIn {
    static constexpr bool PERM = true, AFTER_DRAIN = false;
    bf16_t* P; float* FG; const float* rowss; const float* sb;
    __device__ __forceinline__ void operator()(const f32x4 (&acc)[2][2][4][2], const Unit& u, int wr, int wc, int fr, int fq) const {
        const int row0 = u.pm * BM + wr * 64 + fr, b = u.pm >> 4, cl = wc * 32 + 8 * fq;
        const float* sbp = sb + (size_t)b * 5632 + u.pn * 256 + cl;
        float rsv[2][4];
#pragma unroll
        for (int ai = 0; ai < 2; ++ai)
#pragma unroll
            for (int m = 0; m < 4; ++m) rsv[ai][m] = rowss[row0 + ai * HALF + m * 16];
        f32x4 sv[2][2];
#pragma unroll
        for (int bj = 0; bj < 2; ++bj)
#pragma unroll
            for (int n = 0; n < 2; ++n) sv[bj][n] = *(const f32x4*)(sbp + bj * HALF + 4 * n);
#pragma unroll
        for (int ai = 0; ai < 2; ++ai)
#pragma unroll
            for (int m = 0; m < 4; ++m) {
                const int row = row0 + ai * HALF + m * 16;
                const float rs = __builtin_amdgcn_rsqf(rsv[ai][m] * (1.0f / 1024.0f) + RMS_EPS);
                if (u.pn < 10) {
#pragma unroll
                    for (int bj = 0; bj < 2; ++bj) {
                        const f32x4 v0 = acc[ai][bj][m][0] * rs + sv[bj][0], v1 = acc[ai][bj][m][1] * rs + sv[bj][1];
                        u32x4 w; w.x = cvt_pk_bf16(v0[0], v0[1]); w.y = cvt_pk_bf16(v0[2], v0[3]); w.z = cvt_pk_bf16(v1[0], v1[1]); w.w = cvt_pk_bf16(v1[2], v1[3]);
                        *(u32x4*)(P + (size_t)row * 2560 + u.pn * 256 + bj * HALF + cl) = w;
                    }
                } else if (wc == 0 && fq == 0) {
                    *(f32x4*)(FG + (size_t)row * 4) = acc[ai][0][m][0] * rs + sv[0][0];
                }
            }
    }
};
struct EpiRes {
    static constexpr bool PERM = false, AFTER_DRAIN = false;
    const float* xin; float* xout; const float* gate; const float* gmn; bf16_t* XN; float* rowssn; int has_next;
    __device__ __forceinline__ void operator()(const f32x4 (&acc)[2][2][4][2], const Unit& u, int wr, int wc, int fr, int fq) const {
        typedef unsigned u32x2v __attribute__((ext_vector_type(2)));
        const int row0 = u.pm * BM + wr * 64 + fr, b = u.pm >> 4, col0 = u.pn * BM + wc * 32 + 4 * fq;
        const float* gp_ = gate + b * 1024 + col0; const float* gm_ = gmn + b * 1024 + col0;
#pragma unroll
        for (int ai = 0; ai < 2; ++ai) {
            f32x4 xi[4][2][2];
#pragma unroll
            for (int m = 0; m < 4; ++m)
#pragma unroll
                for (int bj = 0; bj < 2; ++bj)
#pragma unroll
                    for (int n = 0; n < 2; ++n) xi[m][bj][n] = *(const f32x4*)(xin + (size_t)(row0 + ai * HALF + m * 16) * 1024 + col0 + bj * HALF + n * 16);
            asm volatile("" ::: "memory");
#pragma unroll
            for (int m = 0; m < 4; ++m) {
                const int row = row0 + ai * HALF + m * 16; const size_t off = (size_t)row * 1024 + col0;
                float ss = 0.f;
#pragma unroll
                for (int bj = 0; bj < 2; ++bj)
#pragma unroll
                    for (int n = 0; n < 2; ++n) {
                        const f32x4 xo = xi[m][bj][n] + *(const f32x4*)(gp_ + bj * HALF + n * 16) * acc[ai][bj][m][n];
                        *(f32x4*)(xout + off + bj * HALF + n * 16) = xo;
                        if (has_next) {
                            ss += (xo[0] * xo[0] + xo[1] * xo[1]) + (xo[2] * xo[2] + xo[3] * xo[3]);
                            const f32x4 a = xo * *(const f32x4*)(gm_ + bj * HALF + n * 16); u32x2v w; w.x = cvt_pk_bf16(a[0], a[1]); w.y = cvt_pk_bf16(a[2], a[3]);
                            *(u32x2v*)(XN + off + bj * HALF + n * 16) = w;
                        }
                    }
                if (has_next) { ss += __shfl_xor(ss, 16); ss += __shfl_xor(ss, 32); if (fq == 0) unsafeAtomicAdd(rowssn + row, ss); }
            }
            asm volatile("" ::: "memory");
        }
    }
};

template <class Epi, class Sched, bool ALIGN_EPI = false, bool SP2 = false>
__device__ __forceinline__ void gemm_phase(PG8_LAS unsigned char* lds, const Gemm g, const Sched& S, const Epi& E) {
    int tid_o = threadIdx.x; asm volatile("" : "+v"(tid_o)); const int tid = tid_o, wid = __builtin_amdgcn_readfirstlane(tid >> 6), lane = tid & 63, wr = wid >> 2, wc = wid & 3, fr = lane & 15, fq = lane >> 4;
    const int K = g.K, nt = K / BK;
    unsigned voffA[2], voffB[2];
#pragma unroll
    for (int i = 0; i < 2; ++i) { int R, C; stage_rc(tid * 16 + i * 8192, R, C); const int Rb = Epi::PERM ? ((R & ~31) + perm32(R & 31)) : R;
        voffA[i] = (unsigned)(R * K + C) * 2u; voffB[i] = (unsigned)(Rb * K + C) * 2u; }
    const size_t kstep = (size_t)(BK * 2);
    const size_t hstep = (size_t)HALF * K * 2;
    const size_t tstep = 2 * hstep;
    const unsigned ldsw = (unsigned)wid * 1024u;
    const int aoff = lds_byte(wr * 64 + fr, fq * 8), boff = lds_byte(wc * 32 + fr, fq * 8);
#define PG8_SA(b, h) (((b) * 2 + (h)) * HTB)
#define PG8_SB(b, h) ((4 + (b) * 2 + (h)) * HTB)
#define PG8_STAGE(bufoff, gbase, voff) do { _Pragma("unroll") for (int _i = 0; _i < 2; ++_i) \
        __builtin_amdgcn_global_load_lds((const unsigned*)((const char*)(gbase) + (voff)[_i]), (PG8_LAS unsigned*)(lds + (bufoff) + ldsw + _i * 8192), 16, 0, 0); } while (0)
#define PG8_LDA(dst, b, h) do { _Pragma("unroll") for (int m = 0; m < 4; ++m) _Pragma("unroll") for (int k = 0; k < 2; ++k) dst[m][k] = *(const PG8_LAS bf16x8*)(lds + PG8_SA(b, h) + aoff + m * 2048 + k * 1024); } while (0)
#define PG8_LDB(dst, b, h) do { _Pragma("unroll") for (int n = 0; n < 2; ++n) _Pragma("unroll") for (int k = 0; k < 2; ++k) dst[n][k] = *(const PG8_LAS bf16x8*)(lds + PG8_SB(b, h) + boff + n * 2048 + k * 1024); } while (0)
#define PG8_MMA(ai, bj, At, Bt) do { __builtin_amdgcn_s_setprio(1); _Pragma("unroll") for (int m = 0; m < 4; ++m) _Pragma("unroll") for (int n = 0; n < 2; ++n) _Pragma("unroll") for (int k = 0; k < 2; ++k) \
        acc[ai][bj][m][n] = __builtin_amdgcn_mfma_f32_16x16x32_bf16(Bt[n][k], At[m][k], acc[ai][bj][m][n], 0, 0, 0); __builtin_amdgcn_s_setprio(0); } while (0)
#define PG8_WAIT_V(n) asm volatile("s_waitcnt vmcnt(" #n ")" ::: "memory")
#define PG8_WAIT_L(n) asm volatile("s_waitcnt lgkmcnt(" #n ")" ::: "memory")
#define PG8_BAR __builtin_amdgcn_s_barrier()
#define PG8_SCHED __builtin_amdgcn_sched_barrier(0)
    Unit cur, nxt; int ui = 0;
    if (!S.next(0, cur)) return;
    f32x4 acc[2][2][4][2];
#pragma unroll
    for (int a = 0; a < 2; ++a)
#pragma unroll
        for (int b = 0; b < 2; ++b)
#pragma unroll
            for (int m = 0; m < 4; ++m)
#pragma unroll
                for (int n = 0; n < 2; ++n) acc[a][b][m][n] = (f32x4){0.f, 0.f, 0.f, 0.f};
    bf16x8 At[4][2], B0[2][2], B1[2][2];
    const char* cA = (const char*)g.A + (size_t)cur.pm * tstep; const char* cB = (const char*)g.Bt + (size_t)cur.pn * tstep;
    S.a_ready(cur);
    if constexpr (SP2) {
        PG8_STAGE(PG8_SB(0, 0), cB, voffB); PG8_STAGE(PG8_SB(0, 1), cB + hstep, voffB); PG8_STAGE(PG8_SA(0, 0), cA, voffA); PG8_STAGE(PG8_SA(0, 1), cA + hstep, voffA);
        if (wr == 1) PG8_BAR;
        PG8_WAIT_V(2); PG8_BAR;
        PG8_STAGE(PG8_SB(1, 0), cB + kstep, voffB); PG8_STAGE(PG8_SA(1, 0), cA + kstep, voffA); PG8_STAGE(PG8_SB(1, 1), cB + hstep + kstep, voffB);
        PG8_WAIT_V(6); PG8_BAR;
    } else {
        PG8_STAGE(PG8_SB(0, 0), cB, voffB); PG8_STAGE(PG8_SA(0, 0), cA, voffA); PG8_STAGE(PG8_SB(0, 1), cB + hstep, voffB); PG8_STAGE(PG8_SA(0, 1), cA + hstep, voffA);
        if (wr == 1) PG8_BAR;
        PG8_WAIT_V(4); PG8_BAR;
        PG8_STAGE(PG8_SB(1, 0), cB + kstep, voffB); PG8_STAGE(PG8_SA(1, 0), cA + kstep, voffA); PG8_STAGE(PG8_SB(1, 1), cB + hstep + kstep, voffB);
        PG8_WAIT_V(6); PG8_BAR;
    }
    for (;;) {
        const bool has_next = S.next(ui + 1, nxt);
        const char* nA = has_next ? (const char*)g.A + (size_t)nxt.pm * tstep : cA; const char* nB = has_next ? (const char*)g.Bt + (size_t)nxt.pn * tstep : cB;
        for (int t = 0; t < nt; t += 2) {
            const bool last = (t == nt - 2);
            const char* a1 = cA + (size_t)(t + 1) * kstep;
            const char* a2 = last ? nA : cA + (size_t)(t + 2) * kstep; const char* b2 = last ? nB : cB + (size_t)(t + 2) * kstep;
            const char* a3 = a2 + kstep; const char* b3 = b2 + kstep;
            if (last && has_next) S.a_ready(nxt);
            if constexpr (SP2) {
            PG8_LDB(B0, 0, 0); PG8_LDB(B1, 0, 1); PG8_SCHED; PG8_LDA(At, 0, 0); PG8_STAGE(PG8_SA(1, 1), a1 + hstep, voffA);
            PG8_WAIT_V(8); PG8_WAIT_L(0); PG8_BAR; PG8_MMA(0, 0, At, B0); PG8_MMA(0, 1, At, B1); PG8_BAR; PG8_SCHED;
            PG8_LDA(At, 0, 1); PG8_STAGE(PG8_SB(0, 0), b2, voffB); PG8_STAGE(PG8_SB(0, 1), b2 + hstep, voffB); PG8_STAGE(PG8_SA(0, 0), a2, voffA);
            PG8_WAIT_V(8); PG8_WAIT_L(0); PG8_BAR; PG8_MMA(1, 0, At, B0); PG8_MMA(1, 1, At, B1); PG8_BAR; PG8_SCHED;
            PG8_LDB(B0, 1, 0); PG8_LDB(B1, 1, 1); PG8_SCHED; PG8_LDA(At, 1, 0); PG8_STAGE(PG8_SA(0, 1), a2 + hstep, voffA);
            PG8_WAIT_V(8); PG8_WAIT_L(0); PG8_BAR; PG8_MMA(0, 0, At, B0); PG8_MMA(0, 1, At, B1); PG8_BAR; PG8_SCHED;
            PG8_LDA(At, 1, 1); PG8_STAGE(PG8_SB(1, 0), b3, voffB); PG8_STAGE(PG8_SB(1, 1), b3 + hstep, voffB); PG8_STAGE(PG8_SA(1, 0), a3, voffA);
            PG8_WAIT_V(8); PG8_WAIT_L(0); PG8_BAR; PG8_MMA(1, 0, At, B0); PG8_MMA(1, 1, At, B1); PG8_BAR; PG8_SCHED;
            } else {
            PG8_LDB(B0, 0, 0); PG8_SCHED; PG8_LDA(At, 0, 0); PG8_STAGE(PG8_SA(1, 1), a1 + hstep, voffA);
            PG8_WAIT_L(8); PG8_BAR; PG8_WAIT_L(0); PG8_MMA(0, 0, At, B0); PG8_BAR; PG8_SCHED;
            PG8_LDB(B1, 0, 1); PG8_STAGE(PG8_SB(0, 0), b2, voffB);
            PG8_BAR; PG8_WAIT_L(0); PG8_MMA(0, 1, At, B1); PG8_BAR;
            PG8_LDA(At, 0, 1); PG8_STAGE(PG8_SA(0, 0), a2, voffA);
            PG8_BAR; PG8_WAIT_L(0); PG8_MMA(1, 0, At, B0); PG8_BAR; PG8_SCHED;
            PG8_STAGE(PG8_SB(0, 1), b2 + hstep, voffB);
            PG8_WAIT_V(6); PG8_BAR; PG8_MMA(1, 1, At, B1); PG8_BAR;
            PG8_LDB(B0, 1, 0); PG8_SCHED; PG8_LDA(At, 1, 0); PG8_STAGE(PG8_SA(0, 1), a2 + hstep, voffA);
            PG8_WAIT_L(8); PG8_BAR; PG8_WAIT_L(0); PG8_MMA(0, 0, At, B0); PG8_BAR; PG8_SCHED;
            PG8_LDB(B1, 1, 1); PG8_STAGE(PG8_SB(1, 0), b3, voffB);
            PG8_BAR; PG8_WAIT_L(0); PG8_MMA(0, 1, At, B1); PG8_BAR;
            PG8_LDA(At, 1, 1); PG8_STAGE(PG8_SA(1, 0), a3, voffA);
            PG8_BAR; PG8_WAIT_L(0); PG8_MMA(1, 0, At, B0); PG8_BAR; PG8_SCHED;
            PG8_STAGE(PG8_SB(1, 1), b3 + hstep, voffB);
            PG8_WAIT_V(6); PG8_BAR; PG8_MMA(1, 1, At, B1); PG8_BAR;
            }
        }
        if constexpr (ALIGN_EPI) { if (wr == 0) PG8_BAR; }
        if constexpr (!Epi::AFTER_DRAIN) { E(acc, cur, wr, wc, fr, fq); S.done(cur); }
        if (!has_next) break;
#pragma unroll
        for (int a = 0; a < 2; ++a)
#pragma unroll
            for (int b = 0; b < 2; ++b)
#pragma unroll
                for (int m = 0; m < 4; ++m)
#pragma unroll
                    for (int n = 0; n < 2; ++n) acc[a][b][m][n] = (f32x4){0.f, 0.f, 0.f, 0.f};
        cur = nxt; cA = nA; cB = nB; ++ui;
        if constexpr (ALIGN_EPI) { if (wr == 1) PG8_BAR; }
    }
    PG8_WAIT_V(0);
    if constexpr (!ALIGN_EPI) { if (wr == 0) PG8_BAR; }
    PG8_BAR;
    if constexpr (Epi::AFTER_DRAIN) { E.fused(acc, cur, wr, wc, fr, fq, lds, wid, lane); S.done(cur); }
#undef PG8_SA
#undef PG8_SB
#undef PG8_STAGE
#undef PG8_LDA
#undef PG8_LDB
#undef PG8_MMA
#undef PG8_WAIT_V
#undef PG8_WAIT_L
#undef PG8_BAR
#undef PG8_SCHED
}
}

#define LAS __attribute__((address_space(3)))
typedef unsigned short bf16_t;
typedef short bf16x8 __attribute__((ext_vector_type(8)));
typedef short s16x4 __attribute__((ext_vector_type(4)));
typedef float f32x4 __attribute__((ext_vector_type(4)));
typedef float f32x2 __attribute__((ext_vector_type(2)));
typedef float f32x16 __attribute__((ext_vector_type(16)));
typedef unsigned u32x4 __attribute__((ext_vector_type(4)));
typedef unsigned u32x2 __attribute__((ext_vector_type(2)));

constexpr int MTOK = 65536, DM = 1024, DFF = 2816, NUP = 5632, NINP = 2816, PPITCH = 2560, SEQL = 4096;
constexpr float EPSF = 1e-6f, LOG2E = 1.4426950408889634f;
constexpr size_t MiB = 1u << 20;
constexpr size_t WS_MOD = 1 * MiB, WS_GMOD = 3 * MiB, WS_GATE = 4 * MiB, WS_SB = 5 * MiB, WS_ROWSS = 8 * MiB, WS_KS = 10 * MiB, WS_F2 = 11 * MiB, WS_FG = 12 * MiB,
                 WS_ASEG = 13 * MiB, WS_BSEG = 17 * MiB, WS_WUP = 24 * MiB, WS_WDN = 68 * MiB, WS_WIN = 90 * MiB, WS_WOUT = 101 * MiB, WS_XN = 112 * MiB,
                 WS_H = 240 * MiB, WS_PROJ = 240 * MiB, WS_YU = 592 * MiB, WS_HLOC = 656 * MiB, WS_PCUM = 784 * MiB, WS_YN = 848 * MiB, WS_END = 976 * MiB;
constexpr int LDS_BYTES = 147456;

__device__ __forceinline__ float bf2f(unsigned short v) { return __uint_as_float((unsigned)v << 16); }
__device__ __forceinline__ unsigned f2bf(float f) { unsigned u = __float_as_uint(f); return (u + 0x7fffu + ((u >> 16) & 1u)) >> 16; }
__device__ __forceinline__ unsigned pk2(float lo, float hi) { return pg8::cvt_pk_bf16(lo, hi); }
__device__ __forceinline__ float wave_sum(float v) {
#pragma unroll
    for (int o = 1; o < 64; o <<= 1) v += __shfl_xor(v, o);
    return v;
}
__device__ __forceinline__ float sigmoidf_(float x) { return __builtin_amdgcn_rcpf(1.0f + __builtin_amdgcn_exp2f(-LOG2E * x)); }
#define WAITV(n) asm volatile("s_waitcnt vmcnt(" #n ")" ::: "memory")
#define LBAR() asm volatile("s_waitcnt lgkmcnt(0)\n\ts_barrier" ::: "memory")
#define CFENCE() asm volatile("" ::: "memory")

#ifndef REP_FIN
#define REP_FIN 1
#endif
#ifndef REP_IN
#define REP_IN 1
#endif
#ifndef REP_PREP
#define REP_PREP 1
#endif
#ifndef REP_ATTN
#define REP_ATTN 1
#endif
#ifndef REP_UP
#define REP_UP 1
#endif
struct Args { const float* in[19]; float* out; unsigned char* ws; int ph_lo, ph_hi; };

__device__ __forceinline__ void transpose_item(const float* __restrict__ W, int ldw, int clim, int K, bf16_t* __restrict__ WT, int n0, int c0, int k0, LAS float* scr, int lane) {
    const int col = c0 + (lane & 31);
#pragma unroll 16
    for (int i = 0; i < 32; ++i) { const int kk = 2 * i + (lane >> 5); scr[kk * 33 + (lane & 31)] = (col < clim) ? W[(size_t)(k0 + kk) * ldw + col] : 0.f; }
    asm volatile("s_waitcnt lgkmcnt(0)" ::: "memory");
    const int c = lane & 7;
#pragma unroll
    for (int j = 0; j < 4; ++j) { const int n = (lane >> 3) + 8 * j; const LAS float* s = scr + (8 * c) * 33 + n;
        u32x4 o; o.x = pk2(s[0 * 33], s[1 * 33]); o.y = pk2(s[2 * 33], s[3 * 33]); o.z = pk2(s[4 * 33], s[5 * 33]); o.w = pk2(s[6 * 33], s[7 * 33]);
        *(u32x4*)(WT + (size_t)(n0 + n) * K + k0 + 8 * c) = o; }
    asm volatile("s_waitcnt lgkmcnt(0)" ::: "memory");
}

__device__ __forceinline__ int crow(int r, int hi) { return (r & 3) + 8 * (r >> 2) + 4 * hi; }
__device__ __forceinline__ s16x4 vtr(const LAS unsigned char* p) {
    typedef short v4i16_t __attribute__((ext_vector_type(4)));
    return __builtin_bit_cast(s16x4, __builtin_amdgcn_ds_read_tr16_b64_v4i16((LAS v4i16_t*)p));
}
constexpr int AT_SLOT = 16384, AT_AUX = 3 * AT_SLOT, AT_WSF = AT_AUX + 3 * 512, AT_VOTE = AT_WSF + 8 * 256;
constexpr float C2 = 0.125f * LOG2E;

__device__ __forceinline__ void sb_block(f32x16& X, float& carry, bool band, int kv0  , int qrel, int hi) {
    float lm[16];
#pragma unroll
    for (int r = 0; r < 16; ++r) {
        float z2 = X[r] * C2; z2 = __builtin_fminf(__builtin_fmaxf(z2, -120.f), 120.f);
        const float e = __builtin_amdgcn_exp2f(-z2), sp = __builtin_amdgcn_logf(1.0f + e);
        float l1 = -(sp + z2), lb = -sp;
        if (band) { const int kv = kv0 + (r & 3) + 8 * (r >> 2); const bool valid = kv < qrel; l1 = valid ? l1 : 0.f; lb = valid ? lb : -INFINITY; }
        lm[r] = l1; X[r] = lb;
    }
    float G[4], Gp[4], T[4];
#pragma unroll
    for (int g = 0; g < 4; ++g) { G[g] = (lm[4 * g] + lm[4 * g + 1]) + (lm[4 * g + 2] + lm[4 * g + 3]); Gp[g] = __shfl_xor(G[g], 32); T[g] = G[g] + Gp[g]; }
    float S = carry;
#pragma unroll
    for (int g = 3; g >= 0; --g) {
        const float a3 = S + (hi == 0 ? Gp[g] : 0.f), a2 = a3 + lm[4 * g + 3], a1 = a2 + lm[4 * g + 2], a0 = a1 + lm[4 * g + 1];
        X[4 * g + 3] = __builtin_amdgcn_exp2f(X[4 * g + 3] + a3); X[4 * g + 2] = __builtin_amdgcn_exp2f(X[4 * g + 2] + a2);
        X[4 * g + 1] = __builtin_amdgcn_exp2f(X[4 * g + 1] + a1); X[4 * g] = __builtin_amdgcn_exp2f(X[4 * g] + a0);
        S += T[g];
    }
    carry = S;
}

template <int KIND>
__device__ __forceinline__ void attn_unit(LAS unsigned char* lds, const bf16_t* __restrict__ PROJ, bf16_t* __restrict__ YU, const float* __restrict__ KS,
                                          const float* __restrict__ F2, const float* __restrict__ gqk, int b, int h, int qb) {
    int tid_o = threadIdx.x; asm volatile("" : "+v"(tid_o));
    const int tid = tid_o, lane = tid & 63, r32 = lane & 31, hi = lane >> 5;
    const int wid = __builtin_amdgcn_readfirstlane(tid >> 6);
    const int qcol = (KIND == 0 ? 1024 : 1792) + h * 64, kcol = qcol + 256, vcol = qcol + 512;
    const size_t rowbase = (size_t)b * SEQL; const int q0 = qb * 256, bh = b * 4 + h;
    const int NT = (q0 + 256) / 64;
    const bf16_t* ksrc = PROJ + (rowbase + lane) * PPITCH + kcol + wid * 8;
    const bf16_t* vsrc = PROJ + (rowbase + 16 * (wid & 3) + (lane >> 2)) * PPITCH + vcol + (wid >> 2) * 32 + (lane & 3) * 8;
    const float* axsrc = F2 + (size_t)bh * SEQL + lane;
    u32x4 kreg, vreg; float areg = 0.f;
#define AT_LOAD(it_) do { const int kt_ = NT - 1 - (it_); kreg = *(const u32x4*)(ksrc + (size_t)kt_ * 64 * PPITCH); vreg = *(const u32x4*)(vsrc + (size_t)kt_ * 64 * PPITCH); \
        if (KIND == 1 && wid == 0) areg = axsrc[kt_ * 64]; } while (0)
#define AT_STORE(slot_) do { *(LAS u32x4*)(lds + (slot_) * AT_SLOT + wid * 1024 + lane * 16) = kreg; *(LAS u32x4*)(lds + (slot_) * AT_SLOT + 8192 + wid * 1024 + lane * 16) = vreg; \
        if (KIND == 1 && wid == 0) *(LAS float*)(lds + AT_AUX + (slot_) * 512 + lane * 4) = areg; } while (0)
    const bf16_t* Qw = PROJ + (rowbase + q0 + wid * 32 + r32) * PPITCH + qcol + hi * 8;
    bf16x8 qr[4];
#pragma unroll
    for (int d0 = 0; d0 < 4; ++d0) qr[d0] = *(const bf16x8*)(Qw + d0 * 16);
    AT_LOAD(0);
    float qn2 = 0.f, mref = 0.f;
    if (KIND == 1) {
        float qf[4][8]; float ss = 0.f;
#pragma unroll
        for (int d0 = 0; d0 < 4; ++d0)
#pragma unroll
            for (int i = 0; i < 8; ++i) { qf[d0][i] = bf2f((unsigned short)qr[d0][i]); ss += qf[d0][i] * qf[d0][i]; }
        ss += __shfl_xor(ss, 32);
        const float rs = __builtin_amdgcn_rsqf(ss * (1.0f / 64.0f) + EPSF) * C2;
#pragma unroll
        for (int d0 = 0; d0 < 4; ++d0) {
            const float* gp = gqk + d0 * 16 + hi * 8; float v[8];
#pragma unroll
            for (int i = 0; i < 8; ++i) { v[i] = qf[d0][i] * rs * gp[i] * gp[64 + i]; qn2 += v[i] * v[i]; }
            u32x4 w; w.x = pk2(v[0], v[1]); w.y = pk2(v[2], v[3]); w.z = pk2(v[4], v[5]); w.w = pk2(v[6], v[7]);
            qr[d0] = __builtin_bit_cast(bf16x8, w);
        }
        qn2 += __shfl_xor(qn2, 32);
        mref = F2[(size_t)bh * SEQL + q0 + wid * 32 + r32] + __builtin_fminf(8.08f * __builtin_sqrtf(qn2), 60.0f);
    }
    f32x16 o0, o1;
#pragma unroll
    for (int r = 0; r < 16; ++r) { o0[r] = 0.f; o1[r] = 0.f; }
    float mhat = -1e30f, lsum = 0.f, carry = 0.f;
    LAS float* wsf = (LAS float*)(lds + AT_WSF) + wid * 64;
    LAS unsigned* votes = (LAS unsigned*)(lds + AT_VOTE);
    const int qrel = wid * 32 + r32;
    bool wdone = false;
    AT_STORE(0); LBAR();
    for (int it = 0; it < NT; ++it) {
        const int slot = it & 1;
        if (KIND == 0 && it > 0) {
            const LAS unsigned* vp = votes + ((it - 1) & 1) * 8;
            const unsigned all = vp[0] & vp[1] & vp[2] & vp[3] & vp[4] & vp[5] & vp[6] & vp[7];
            if (all) break;
        }
        if (it + 1 < NT) AT_LOAD(it + 1);
        const int kt = NT - 1 - it, jb = kt - (NT - 4);
        const bool band = jb >= 0;
        const bool active = !(band && 64 * jb > 32 * wid + 31) && !wdone;
        if (active) {
            f32x16 p0, p1;
            __builtin_amdgcn_s_setprio(1);
            { const LAS unsigned char* kb = lds + slot * AT_SLOT + hi * 1024 + r32 * 16;
#pragma unroll
              for (int d0 = 0; d0 < 4; ++d0) {
                  const bf16x8 b0 = *(const LAS bf16x8*)(kb + d0 * 2048), b1 = *(const LAS bf16x8*)(kb + d0 * 2048 + 512);
                  if (d0 == 0) { f32x16 z;
#pragma unroll
                      for (int r = 0; r < 16; ++r) z[r] = (KIND == 1) ? -mref : 0.f;
                      p0 = __builtin_amdgcn_mfma_f32_32x32x16_bf16(b0, qr[0], z, 0, 0, 0); p1 = __builtin_amdgcn_mfma_f32_32x32x16_bf16(b1, qr[0], z, 0, 0, 0); }
                  else { p0 = __builtin_amdgcn_mfma_f32_32x32x16_bf16(b0, qr[d0], p0, 0, 0, 0); p1 = __builtin_amdgcn_mfma_f32_32x32x16_bf16(b1, qr[d0], p1, 0, 0, 0); }
              } }
            __builtin_amdgcn_s_setprio(0);
            if (KIND == 0) {
                sb_block(p1, carry, band, 64 * jb + 32 + 4 * hi, qrel, hi);
                sb_block(p0, carry, band, 64 * jb + 4 * hi, qrel, hi);
            } else {
                const LAS float* ax = (const LAS float*)(lds + AT_AUX + slot * 512);
                f32x2 sacc2 = (f32x2){0.f, 0.f};
#pragma unroll
                for (int g = 0; g < 4; ++g) {
                    const f32x4 f0 = *(const LAS f32x4*)(ax + 8 * g + 4 * hi), f1 = *(const LAS f32x4*)(ax + 32 + 8 * g + 4 * hi);
#pragma unroll
                    for (int i = 0; i < 4; ++i) { p0[4 * g + i] += f0[i]; p1[4 * g + i] += f1[i]; }
                }
                if (band) {
#pragma unroll
                    for (int r = 0; r < 16; ++r) { const int kv = 64 * jb + crow(r, hi); if (kv > qrel) p0[r] = -INFINITY; if (kv + 32 > qrel) p1[r] = -INFINITY; }
                }
#pragma unroll
                for (int r = 0; r < 16; r += 2) {
                    p0[r] = __builtin_amdgcn_exp2f(p0[r]); p0[r + 1] = __builtin_amdgcn_exp2f(p0[r + 1]); p1[r] = __builtin_amdgcn_exp2f(p1[r]); p1[r + 1] = __builtin_amdgcn_exp2f(p1[r + 1]);
                    sacc2 += (f32x2){p0[r], p0[r + 1]}; sacc2 += (f32x2){p1[r], p1[r + 1]};
                }
                lsum += sacc2[0] + sacc2[1];
            }
            u32x4 pw0, pw1, pw2, pw3;
            pw0.x = pk2(p0[0], p0[1]); pw0.y = pk2(p0[2], p0[3]); pw0.z = pk2(p0[4], p0[5]); pw0.w = pk2(p0[6], p0[7]);
            pw1.x = pk2(p0[8], p0[9]); pw1.y = pk2(p0[10], p0[11]); pw1.z = pk2(p0[12], p0[13]); pw1.w = pk2(p0[14], p0[15]);
            pw2.x = pk2(p1[0], p1[1]); pw2.y = pk2(p1[2], p1[3]); pw2.z = pk2(p1[4], p1[5]); pw2.w = pk2(p1[6], p1[7]);
            pw3.x = pk2(p1[8], p1[9]); pw3.y = pk2(p1[10], p1[11]); pw3.z = pk2(p1[12], p1[13]); pw3.w = pk2(p1[14], p1[15]);
            const LAS unsigned char* vb = lds + slot * AT_SLOT + 8192 + ((lane >> 4) & 1) * 32 + (lane & 3) * 8 + (4 * hi + ((lane & 15) >> 2)) * 64;
            s16x4 vlo[8], vhi[8];
#pragma unroll
            for (int i = 0; i < 8; ++i) { vlo[i] = vtr(vb + (i >> 2) * 4096 + (i & 3) * 1024); vhi[i] = vtr(vb + (i >> 2) * 4096 + (i & 3) * 1024 + 512); }
#define VFR(i) (bf16x8){vlo[i][0], vlo[i][1], vlo[i][2], vlo[i][3], vhi[i][0], vhi[i][1], vhi[i][2], vhi[i][3]}
#define PAF(x) __builtin_bit_cast(bf16x8, x)
            __builtin_amdgcn_s_setprio(1);
            o0 = __builtin_amdgcn_mfma_f32_32x32x16_bf16(PAF(pw0), VFR(0), o0, 0, 0, 0); o1 = __builtin_amdgcn_mfma_f32_32x32x16_bf16(PAF(pw0), VFR(4), o1, 0, 0, 0);
            o0 = __builtin_amdgcn_mfma_f32_32x32x16_bf16(PAF(pw1), VFR(1), o0, 0, 0, 0); o1 = __builtin_amdgcn_mfma_f32_32x32x16_bf16(PAF(pw1), VFR(5), o1, 0, 0, 0);
            o0 = __builtin_amdgcn_mfma_f32_32x32x16_bf16(PAF(pw2), VFR(2), o0, 0, 0, 0); o1 = __builtin_amdgcn_mfma_f32_32x32x16_bf16(PAF(pw2), VFR(6), o1, 0, 0, 0);
            o0 = __builtin_amdgcn_mfma_f32_32x32x16_bf16(PAF(pw3), VFR(3), o0, 0, 0, 0); o1 = __builtin_amdgcn_mfma_f32_32x32x16_bf16(PAF(pw3), VFR(7), o1, 0, 0, 0);
            __builtin_amdgcn_s_setprio(0);
#undef VFR
#undef PAF
        }
        if (KIND == 0) { if (active) wdone = __all(carry < -150.0f); if (lane == 0) votes[(it & 1) * 8 + wid] = wdone ? 1u : 0u; }
        if (it + 1 < NT) AT_STORE(slot ^ 1);
        LBAR();
    }
    if (KIND == 1) { lsum += __shfl_xor(lsum, 32); CFENCE(); if (hi == 0) wsf[r32] = lsum; CFENCE(); asm volatile("s_waitcnt lgkmcnt(0)" ::: "memory"); }
    bf16_t* Yw = YU + (rowbase + q0 + wid * 32) * 512 + KIND * 256 + h * 64 + r32;
#pragma unroll
    for (int r = 0; r < 16; ++r) {
        const int orow = crow(r, hi); float sc = 1.0f;
        if (KIND == 1) sc = __builtin_amdgcn_rcpf(wsf[orow]);
        Yw[(size_t)orow * 512] = (bf16_t)f2bf(o0[r] * sc); Yw[(size_t)orow * 512 + 32] = (bf16_t)f2bf(o1[r] * sc);
    }
    LBAR();
#undef AT_LOAD
#undef AT_STORE
}

#define DEFPTRS \
    const __attribute__((address_space(4))) Args* ka_ = (const __attribute__((address_space(4))) Args*)__builtin_amdgcn_kernarg_segment_ptr(); \
    asm volatile("" : "+s"(ka_)); \
    int tid_o_ = threadIdx.x; asm volatile("" : "+v"(tid_o_)); const int tid = tid_o_, lane = tid & 63; (void)lane; \
    unsigned char* ws = ka_->ws; \
    const float* x_in = ka_->in[0]; const float* c_in = ka_->in[1]; const float* w_ada = ka_->in[2]; const float* b_ada = ka_->in[3]; const float* g_norm = ka_->in[4]; \
    const float* w_up = ka_->in[5]; const float* w_dn = ka_->in[6]; const float* w_in = ka_->in[7]; const float* b_fg = ka_->in[8]; const float* conv_w = ka_->in[9]; \
    const float* conv_b = ka_->in[10]; const float* w_rg = ka_->in[11]; const float* b_rg = ka_->in[12]; const float* w_ig = ka_->in[13]; const float* b_ig = ka_->in[14]; \
    const float* lam = ka_->in[15]; const float* g_qk = ka_->in[16]; const float* g_mix = ka_->in[17]; const float* w_out = ka_->in[18]; \
    float* xout = ka_->out; \
    float* MOD = (float*)(ws + WS_MOD); float* GMOD = (float*)(ws + WS_GMOD); float* GATE = (float*)(ws + WS_GATE); float* SBV = (float*)(ws + WS_SB); \
    float* ROWSS = (float*)(ws + WS_ROWSS); float* KS = (float*)(ws + WS_KS); float* F2 = (float*)(ws + WS_F2); float* FG = (float*)(ws + WS_FG); \
    float* ASEG = (float*)(ws + WS_ASEG); float* BSEG = (float*)(ws + WS_BSEG); float* TSEGA = (float*)(ws + 21 * MiB); float* TSEGB = (float*)(ws + 22 * MiB); \
    bf16_t* WUP = (bf16_t*)(ws + WS_WUP); bf16_t* WDN = (bf16_t*)(ws + WS_WDN); bf16_t* WIN = (bf16_t*)(ws + WS_WIN); bf16_t* WOUT = (bf16_t*)(ws + WS_WOUT); \
    bf16_t* XN = (bf16_t*)(ws + WS_XN); bf16_t* HB = (bf16_t*)(ws + WS_H); bf16_t* PROJ = (bf16_t*)(ws + WS_PROJ); bf16_t* YU = (bf16_t*)(ws + WS_YU); \
    bf16_t* HLOC = (bf16_t*)(ws + WS_HLOC); bf16_t* PCUM = (bf16_t*)(ws + WS_PCUM); bf16_t* YN = (bf16_t*)(ws + WS_YN);
#define XB_TMO      128
#define XB_XCNT(j)  (256  + 64 * (j))
#define XB_XSUB(j)  (1280 + 64 * (j))
#define XB_XGEN(j)  (2304 + 64 * (j))
#define XB_TOP      3328
#define XB_TOPGEN   3392
#define XCD_BAR_WORDS 3456
#define XB_SPIN_CAP (1u << 18)

__device__ __forceinline__ unsigned xb_ld(unsigned* p)              { return __hip_atomic_load(p, __ATOMIC_RELAXED, __HIP_MEMORY_SCOPE_AGENT); }
__device__ __forceinline__ unsigned xb_add(unsigned* p, unsigned v) { return __hip_atomic_fetch_add(p, v, __ATOMIC_RELAXED, __HIP_MEMORY_SCOPE_AGENT); }
__device__ __forceinline__ unsigned xb_xcc_id() { return (unsigned)__builtin_amdgcn_s_getreg((3 << 11) | 20) & 0xFu; }
#define XB_SPIN(cond, bar) do { unsigned _sp = 0; while (cond) { __builtin_amdgcn_s_sleep(1); \
    if ((++_sp & 255u) == 0u) { if (xb_ld(&(bar)[XB_TMO])) break; if (_sp > XB_SPIN_CAP) { atomicAdd(&(bar)[XB_TMO], 1u); break; } } } } while (0)

struct XcdBarrier {
    unsigned* bar; unsigned x;
    volatile LAS unsigned* st;
};

__device__ __forceinline__ XcdBarrier xcd_barrier_post(unsigned* bar, volatile LAS unsigned* st) {
    XcdBarrier b; b.bar = bar; b.x = xb_xcc_id(); b.st = st;
    if (threadIdx.x == 0) (void)xb_add(&bar[XB_XCNT(b.x)], 1u);
    return b;
}
__device__ __forceinline__ void xcd_barrier_complete(unsigned* bar, unsigned x, unsigned& nloc, unsigned& nx) {
    const unsigned G = gridDim.x * gridDim.y * gridDim.z;
    unsigned sum, cnt, mine, sp = 0u;
    for (;;) {
        sum = 0u; cnt = 0u; mine = 0u;
#pragma unroll
        for (unsigned j = 0; j < 16; ++j) { const unsigned c = xb_ld(&bar[XB_XCNT(j)]); sum += c; cnt += (c > 0u) ? 1u : 0u; mine = (j == x) ? c : mine; }
        if (sum == G) break;
        __builtin_amdgcn_s_sleep(1);
        if ((++sp & 255u) == 0u) { if (xb_ld(&bar[XB_TMO])) break; if (sp > XB_SPIN_CAP) { atomicAdd(&bar[XB_TMO], 1u); break; } }
    }
    nloc = mine > 0u ? mine : 1u; nx = cnt > 0u ? cnt : 1u;
}

__device__ __forceinline__ void xcd_barrier(const XcdBarrier& b) {
    asm volatile("s_waitcnt vmcnt(0)" ::: "memory");
    __syncthreads();
    if (threadIdx.x == 0) {
        unsigned* bar = b.bar;
        __builtin_amdgcn_s_waitcnt(0);
        unsigned nloc = b.st[0], nx = b.st[1];
        if (nloc == 0u) { xcd_barrier_complete(bar, b.x, nloc, nx); b.st[0] = nloc; b.st[1] = nx; }
        const unsigned old = xb_add(&bar[XB_XSUB(b.x)], 1u);
        const unsigned gen = old / nloc;
        if (old + 1u == (gen + 1u) * nloc) {
            __builtin_amdgcn_fence(__ATOMIC_RELEASE, "agent");
            asm volatile("s_waitcnt vmcnt(0)" ::: "memory");
            const unsigned og = xb_add(&bar[XB_TOP], 1u);
            const unsigned tg = og / nx;
            if (og + 1u == (tg + 1u) * nx) xb_add(&bar[XB_TOPGEN], 1u);
            else XB_SPIN(xb_ld(&bar[XB_TOPGEN]) == tg, bar);
            __builtin_amdgcn_fence(__ATOMIC_ACQUIRE, "agent");
            xb_add(&bar[XB_XGEN(b.x)], 1u);
            asm volatile("s_waitcnt vmcnt(0)" ::: "memory");
        } else {
            XB_SPIN(xb_ld(&bar[XB_XGEN(b.x)]) == gen, bar);
            __builtin_amdgcn_fence(__ATOMIC_ACQUIRE, "agent");
            asm volatile("s_waitcnt vmcnt(0)" ::: "memory");
        }
    }
    __syncthreads();
}

__global__ void __launch_bounds__(512) mk_fwd(Args args) {
    extern __shared__ __attribute__((aligned(16))) unsigned char lds_raw[];
    LAS unsigned char* lds = (LAS unsigned char*)lds_raw;
    cg::grid_group grid = cg::this_grid();
    const int wave = __builtin_amdgcn_readfirstlane(threadIdx.x >> 6);
    const int G = gridDim.x; const int bx = blockIdx.x;
    const int vcu = (G % 8 == 0) ? (bx % 8) * (G / 8) + bx / 8 : bx;
    const int gw = vcu * 8 + wave, NGW = G * 8;
    const int lo = args.ph_lo, hi_ph = args.ph_hi;
    volatile LAS unsigned* MISC = (volatile LAS unsigned*)(lds + 131072 + 320);
    if (threadIdx.x < 16) MISC[threadIdx.x] = 0u;
    __syncthreads();
    XcdBarrier xbar = xcd_barrier_post((unsigned*)args.ws, MISC + 8);
    int ph = 0;
#define PH_ON (ph >= lo && ph < hi_ph)
#ifdef REP_SYNC
#define SYNC_EXTRA grid.sync(); asm volatile("" ::: "memory");
#else
#define SYNC_EXTRA
#endif
#define PH_NEXT do { ++ph; if (ph > lo && ph < hi_ph) { asm volatile("s_waitcnt vmcnt(0) lgkmcnt(0)" ::: "memory"); if (ph == 1) grid.sync(); else xcd_barrier(xbar); asm volatile("" ::: "memory"); SYNC_EXTRA } } while (0)

#ifdef REP_PRO
    int rp_ = 0; pro_again:
#endif
    if (PH_ON) { DEFPTRS
        for (int i = bx * 512 + tid; i < 5 * MTOK; i += G * 512) ROWSS[MTOK + i] = 0.f;
        LAS float* cact = (LAS float*)lds;
        LAS float* red = (LAS float*)(lds + 65536);
        for (int i = tid; i < 16 * 1024; i += 512) { const int b = i >> 10, k = i & 1023; const float v = c_in[i]; cact[k * 16 + b] = v * sigmoidf_(v); }
        __syncthreads();
        for (int task = bx; task < 288; task += G) {
            const int l = task / 144, n0 = (task % 144) * 64;
            float acc[16];
#pragma unroll
            for (int b = 0; b < 16; ++b) acc[b] = 0.f;
            const float* wp = w_ada + (size_t)l * 1024 * 9216 + n0 + lane;
#pragma unroll 1
            for (int k0 = wave * 128; k0 < wave * 128 + 128; k0 += 16) {
                float wv[16];
#pragma unroll
                for (int j = 0; j < 16; ++j) wv[j] = wp[(size_t)(k0 + j) * 9216];
                CFENCE();
#pragma unroll
                for (int j = 0; j < 16; ++j) { const int k = k0 + j; const float w = wv[j];
                    const f32x4 c0 = *(const LAS f32x4*)(cact + k * 16), c1 = *(const LAS f32x4*)(cact + k * 16 + 4), c2 = *(const LAS f32x4*)(cact + k * 16 + 8), c3 = *(const LAS f32x4*)(cact + k * 16 + 12);
#pragma unroll
                    for (int i = 0; i < 4; ++i) { acc[i] += c0[i] * w; acc[4 + i] += c1[i] * w; acc[8 + i] += c2[i] * w; acc[12 + i] += c3[i] * w; }
                    if ((j & 3) == 3) CFENCE(); }
            }
#pragma unroll
            for (int b = 0; b < 16; ++b) red[(wave * 16 + b) * 64 + lane] = acc[b];
            __syncthreads();
            for (int o = tid; o < 1024; o += 512) { const int b = o >> 6, ln = o & 63; float s = 0.f;
#pragma unroll
                for (int w = 0; w < 8; ++w) s += red[(w * 16 + b) * 64 + ln];
                MOD[((size_t)l * 16 + b) * 9216 + n0 + ln] = s + b_ada[l * 9216 + n0 + ln]; }
            __syncthreads();
        }
    }
    PH_NEXT;
    if (PH_ON) { DEFPTRS
        for (int i = bx * 512 + tid; i < 2 * 3 * 16 * 1024; i += G * 512) {
            const int k = i & 1023, b = (i >> 10) & 15, lj = i >> 14, l = lj / 3, j = lj % 3;
            const float* mp = MOD + ((size_t)l * 16 + b) * 9216 + j * 3072;
            GMOD[i] = g_norm[(l * 3 + j) * 1024 + k] * (1.0f + mp[1024 + k]);
            GATE[i] = (j == 1 ? 1.0f : 0.5f) * (1.0f + mp[2048 + k]);
        }
        LAS float* scr = (LAS float*)(lds + wave * 8448);
        constexpr int I_UP = 16 * 176, I_DN = 44 * 32, I_IN = 16 * 88, I_OUT = 16 * 32;
        constexpr int NIT = 4 * I_UP + 4 * I_DN + 2 * I_IN + 2 * I_OUT;
        for (int it = gw; it < NIT; it += NGW) {
            int r = it;
            if (r < 4 * I_UP) { const int mat = r / I_UP; r -= mat * I_UP; const int kb = r / 176, nb = r % 176, n0 = nb * 32;
                const int c0 = ((n0 >> 7) & 1) * DFF + (n0 >> 8) * 128 + (n0 & 127);
                transpose_item(w_up + (size_t)mat * DM * NUP, NUP, NUP, DM, WUP + (size_t)mat * NUP * DM, n0, c0, kb * 64, scr, lane); continue; }
            r -= 4 * I_UP;
            if (r < 4 * I_DN) { const int mat = r / I_DN; r -= mat * I_DN; const int kb = r / 32, nb = r % 32;
                transpose_item(w_dn + (size_t)mat * DFF * DM, DM, DM, DFF, WDN + (size_t)mat * DM * DFF, nb * 32, nb * 32, kb * 64, scr, lane); continue; }
            r -= 4 * I_DN;
            if (r < 2 * I_IN) { const int mat = r / I_IN; r -= mat * I_IN; const int kb = r / 88, nb = r % 88;
                transpose_item(w_in + (size_t)mat * DM * 2564, 2564, 2564, DM, WIN + (size_t)mat * NINP * DM, nb * 32, nb * 32, kb * 64, scr, lane); continue; }
            r -= 2 * I_IN;
            { const int mat = r / I_OUT; r -= mat * I_OUT; const int kb = r / 32, nb = r % 32;
                transpose_item(w_out + (size_t)mat * DM * DM, DM, DM, DM, WOUT + (size_t)mat * DM * DM, nb * 32, nb * 32, kb * 64, scr, lane); }
        }
        for (int m0 = gw; m0 < MTOK; m0 += 2 * NGW) {
            const int m1 = m0 + NGW;
            const f32x4* gp = (const f32x4*)(g_norm) + lane;
            const f32x4* xr0 = (const f32x4*)(x_in + (size_t)m0 * DM) + lane; const f32x4* xr1 = (const f32x4*)(x_in + (size_t)m1 * DM) + lane;
            f32x4 v0[4], v1[4];
#pragma unroll
            for (int j = 0; j < 4; ++j) { v0[j] = xr0[64 * j]; v1[j] = xr1[64 * j]; }
            const f32x4* sp0 = (const f32x4*)(MOD + (size_t)(m0 >> 12) * 9216 + 1024) + lane; const f32x4* sp1 = (const f32x4*)(MOD + (size_t)(m1 >> 12) * 9216 + 1024) + lane;
            float s0 = 0.f, s1 = 0.f; u32x2* o0 = (u32x2*)(XN + (size_t)m0 * DM) + lane; u32x2* o1 = (u32x2*)(XN + (size_t)m1 * DM) + lane;
#pragma unroll
            for (int j = 0; j < 4; ++j) { const f32x4 g = gp[64 * j];
                { const f32x4 v = v0[j]; s0 += (v[0] * v[0] + v[1] * v[1]) + (v[2] * v[2] + v[3] * v[3]); const f32x4 a = v * g * (sp0[64 * j] + 1.0f); u32x2 w; w.x = pk2(a[0], a[1]); w.y = pk2(a[2], a[3]); o0[64 * j] = w; }
                { const f32x4 v = v1[j]; s1 += (v[0] * v[0] + v[1] * v[1]) + (v[2] * v[2] + v[3] * v[3]); const f32x4 a = v * g * (sp1[64 * j] + 1.0f); u32x2 w; w.x = pk2(a[0], a[1]); w.y = pk2(a[2], a[3]); o1[64 * j] = w; } }
            s0 = wave_sum(s0); s1 = wave_sum(s1);
            if (lane == 0) { ROWSS[m0] = s0; ROWSS[m1] = s1; }
        }
    }
    PH_NEXT;
    if (PH_ON) { DEFPTRS
        LAS float* sh = (LAS float*)lds;
        for (int combo = 0; combo < 6; ++combo) {
            const int l = combo / 3, j = combo % 3;
            __syncthreads();
            for (int i = tid; i < 16 * 1024; i += 512) { const int b = i >> 10, k = i & 1023; sh[i] = MOD[((size_t)l * 16 + b) * 9216 + j * 3072 + k]; }
            __syncthreads();
            const bf16_t* Wt = (j == 1) ? WIN + (size_t)l * NINP * DM : WUP + (size_t)(l * 2 + (j == 2 ? 1 : 0)) * NUP * DM;
            const int N = (j == 1) ? NINP : NUP;
            float* dst = SBV + (size_t)combo * 16 * 5632;
            for (int n = gw; n < N; n += NGW) {
                float w[16];
#pragma unroll
                for (int c = 0; c < 4; ++c) { const u32x2 q = *(const u32x2*)(Wt + (size_t)n * DM + c * 256 + lane * 4);
                    w[4 * c] = __uint_as_float(q.x << 16); w[4 * c + 1] = __uint_as_float(q.x & 0xffff0000u); w[4 * c + 2] = __uint_as_float(q.y << 16); w[4 * c + 3] = __uint_as_float(q.y & 0xffff0000u); }
                float sv[16];
#pragma unroll
                for (int b = 0; b < 16; ++b) { float s = 0.f;
#pragma unroll
                    for (int c = 0; c < 4; ++c) { const f32x4 v = *(const LAS f32x4*)(sh + b * 1024 + c * 256 + lane * 4); s += (w[4 * c] * v[0] + w[4 * c + 1] * v[1]) + (w[4 * c + 2] * v[2] + w[4 * c + 3] * v[3]); }
                    sv[b] = s; if ((b & 3) == 3) CFENCE(); }
                float t8[8], t4[4], t2[2];
#pragma unroll
                for (int i = 0; i < 8; ++i) { const float snd = (lane & 32) ? sv[i] : sv[i + 8], kp = (lane & 32) ? sv[i + 8] : sv[i]; t8[i] = kp + __shfl_xor(snd, 32); }
#pragma unroll
                for (int i = 0; i < 4; ++i) { const float snd = (lane & 16) ? t8[i] : t8[i + 4], kp = (lane & 16) ? t8[i + 4] : t8[i]; t4[i] = kp + __shfl_xor(snd, 16); }
#pragma unroll
                for (int i = 0; i < 2; ++i) { const float snd = (lane & 8) ? t4[i] : t4[i + 2], kp = (lane & 8) ? t4[i + 2] : t4[i]; t2[i] = kp + __shfl_xor(snd, 8); }
                float t1; { const float snd = (lane & 4) ? t2[0] : t2[1], kp = (lane & 4) ? t2[1] : t2[0]; t1 = kp + __shfl_xor(snd, 4); }
                t1 += __shfl_xor(t1, 2); t1 += __shfl_xor(t1, 1);
                const int bsel = ((lane >> 5) & 1) * 8 + ((lane >> 4) & 1) * 4 + ((lane >> 3) & 1) * 2 + ((lane >> 2) & 1);
                if ((lane & 3) == 0) dst[(size_t)bsel * 5632 + n] = t1;
            }
        }
        __syncthreads();
    }
    PH_NEXT;

#ifdef REP_PRO
    if (rp_ == 0) { rp_ = 1; ph = 0; goto pro_again; }
#endif
#pragma unroll 1
    for (int f = 0; f < 4; ++f) {
        const int l = f >> 1, s = f & 1;
        if (s == 1) {
            if (PH_ON) { DEFPTRS
                pg8::Gemm g{XN, WIN + (size_t)l * NINP * DM, MTOK, NINP, DM}; pg8::StaticOrder S; S.init(MTOK, NINP, G, bx);
                pg8::EpiIn E{PROJ, FG, ROWSS + (size_t)(l * 3 + 1) * MTOK, SBV + (size_t)(l * 3 + 1) * 16 * 5632};
#ifndef NO_G_IN
                for (int rep_ = 0; rep_ < REP_IN; ++rep_) {
                pg8::gemm_phase<pg8::EpiIn, pg8::StaticOrder, true, true>(lds, g, S, E); }
#endif
            }
            PH_NEXT;
            if (PH_ON) { DEFPTRS
#ifndef NO_PREP
                {
                    const int blk = vcu & 7, n = lane & 31, hi = lane >> 5;
                    LAS unsigned char* wfl = lds;
                    LAS float* xs = (LAS float*)(lds + 16384 + wave * 13568);
                    LAS unsigned char* ub = lds + 16384 + wave * 13568 + 8960;
#pragma unroll
                    for (int q = 0; q < 2; ++q) { const int f = wave * 2 + q, gt = f >> 3, nb = (f >> 2) & 1, d0 = f & 3;
                        const float* wsrc = (gt ? w_ig : w_rg) + ((size_t)(l * 8 + blk) * 64 + 16 * d0 + 8 * hi) * 64 + nb * 32 + n;
                        u32x4 w; w.x = pk2(wsrc[0], wsrc[64]); w.y = pk2(wsrc[128], wsrc[192]); w.z = pk2(wsrc[256], wsrc[320]); w.w = pk2(wsrc[384], wsrc[448]);
                        *(LAS u32x4*)(wfl + f * 1024 + lane * 16) = w; }
                    __syncthreads();
                    float br[2], bi[2], cb[2], cw[2][4], c8[2];
#pragma unroll
                    for (int nb = 0; nb < 2; ++nb) { const int ch = blk * 64 + nb * 32 + n;
                        br[nb] = b_rg[l * 512 + ch]; bi[nb] = b_ig[l * 512 + ch]; cb[nb] = conv_b[l * 512 + ch];
#pragma unroll
                        for (int k = 0; k < 4; ++k) cw[nb][k] = conv_w[(l * 4 + k) * 512 + ch];
                        const float lmv = lam[l * 512 + ch];
                        c8[nb] = -8.0f * LOG2E * (__builtin_fmaxf(-lmv, 0.f) + log1pf(expf(-fabsf(lmv)))); }
                    for (int segi = (vcu >> 3) * 8 + wave; segi < REP_PREP * (MTOK / 32); segi += (G >> 3) * 8) { const int seg = segi & (MTOK / 32 - 1);
                        const int row0 = seg * 32; const bool first = (row0 & (SEQL - 1)) == 0;
                        const bf16_t* xp = PROJ + (size_t)row0 * PPITCH + blk * 64;
                        CFENCE();
#pragma unroll
                        for (int t = 0; t < 35; ++t) { float v = 0.f; if (t >= 3 || !first) v = bf2f((xp + ((long)t - 3) * PPITCH)[lane]); xs[t * 64 + lane] = v; }
                        CFENCE();
#pragma unroll
                        for (int nb = 0; nb < 2; ++nb)
#pragma unroll
                            for (int g = 0; g < 4; ++g) { const LAS float* xb = xs + (8 * g + 4 * hi) * 64 + nb * 32 + n; float xv[7];
#pragma unroll
                                for (int j = 0; j < 7; ++j) xv[j] = xb[j * 64];
#pragma unroll
                                for (int i = 0; i < 4; ++i) { const float uu = cb[nb] + cw[nb][0] * xv[i] + cw[nb][1] * xv[i + 1] + cw[nb][2] * xv[i + 2] + cw[nb][3] * xv[i + 3];
                                    *(LAS unsigned short*)(ub + (8 * g + 4 * hi + i) * 144 + (nb * 32 + n) * 2) = (unsigned short)f2bf(uu); }
                                __builtin_amdgcn_sched_barrier(0); }
                        CFENCE();
                        bf16x8 af[4];
#pragma unroll
                        for (int d0 = 0; d0 < 4; ++d0) af[d0] = *(const LAS bf16x8*)(ub + n * 144 + (16 * d0 + 8 * hi) * 2);
#pragma unroll
                        for (int nb = 0; nb < 2; ++nb) {
                            f32x16 arx, aix;
#pragma unroll
                            for (int r = 0; r < 16; ++r) { arx[r] = br[nb]; aix[r] = bi[nb]; }
#pragma unroll
                            for (int d0 = 0; d0 < 4; ++d0) { const bf16x8 w0 = *(const LAS bf16x8*)(wfl + ((0 * 2 + nb) * 4 + d0) * 1024 + lane * 16), w1 = *(const LAS bf16x8*)(wfl + ((1 * 2 + nb) * 4 + d0) * 1024 + lane * 16);
                                                             arx = __builtin_amdgcn_mfma_f32_32x32x16_bf16(af[d0], w0, arx, 0, 0, 0);
                                                             aix = __builtin_amdgcn_mfma_f32_32x32x16_bf16(af[d0], w1, aix, 0, 0, 0); }
                            CFENCE(); __builtin_amdgcn_sched_barrier(0);
#pragma unroll
                            for (int r = 0; r < 16; ++r) {
                                float uu; { const LAS float* xb = xs + (8 * (r >> 2) + 4 * hi + (r & 3)) * 64 + nb * 32 + n;
                                    uu = cb[nb] + cw[nb][0] * xb[0] + cw[nb][1] * xb[64] + cw[nb][2] * xb[128] + cw[nb][3] * xb[192]; }
                                const float rg = sigmoidf_(arx[r]), ig = sigmoidf_(aix[r]);
                                const float la2 = c8[nb] * rg, a = __builtin_amdgcn_exp2f(la2);
                                const float xx = 2.0f * 0.6931471805599453f * la2;
                                const float om = (xx > -0.25f) ? -xx * (1.0f + xx * 0.5f * (1.0f + xx * (1.0f / 3.0f) * (1.0f + xx * 0.25f * (1.0f + xx * 0.2f)))) : 1.0f - a * a;
                                arx[r] = a; aix[r] = __builtin_sqrtf(om) * ig * uu;
                            }
                            float H = 0.f, P = 1.f;
                            const int ch = blk * 64 + nb * 32 + n;
                            bf16_t* hl = HLOC + (size_t)(row0 + 4 * hi) * 512 + ch; bf16_t* pc = PCUM + (size_t)(row0 + 4 * hi) * 512 + ch;
#pragma unroll
                            for (int g = 0; g < 4; ++g) {
                                const float a0 = arx[4 * g], a1 = arx[4 * g + 1], a2 = arx[4 * g + 2], a3 = arx[4 * g + 3];
                                const float b0 = aix[4 * g], b1 = aix[4 * g + 1], b2 = aix[4 * g + 2], b3 = aix[4 * g + 3];
                                const float Ao = (a0 * a1) * (a2 * a3), Bo = ((b0 * a1 + b1) * a2 + b2) * a3 + b3;
                                const float Ap = __shfl_xor(Ao, 32), Bp = __shfl_xor(Bo, 32);
                                const float A1 = hi ? Ap : Ao, B1 = hi ? Bp : Bo, A2 = hi ? Ao : Ap, B2 = hi ? Bo : Bp;
                                const float Hm = A1 * H + B1, Pm = A1 * P;
                                float h = hi ? Hm : H, p = hi ? Pm : P;
                                H = A2 * Hm + B2; P = A2 * Pm;
                                bf16_t* hg = hl + (size_t)g * 8 * 512; bf16_t* pg = pc + (size_t)g * 8 * 512; asm volatile("" : "+v"(hg), "+v"(pg));
                                h = a0 * h + b0; p *= a0; hg[0 * 512] = (bf16_t)f2bf(h); pg[0 * 512] = (bf16_t)f2bf(p);
                                h = a1 * h + b1; p *= a1; hg[1 * 512] = (bf16_t)f2bf(h); pg[1 * 512] = (bf16_t)f2bf(p);
                                h = a2 * h + b2; p *= a2; hg[2 * 512] = (bf16_t)f2bf(h); pg[2 * 512] = (bf16_t)f2bf(p);
                                h = a3 * h + b3; p *= a3; hg[3 * 512] = (bf16_t)f2bf(h); pg[3 * 512] = (bf16_t)f2bf(p);
                            }
                            if (hi == 0) { ASEG[(size_t)seg * 512 + ch] = P; BSEG[(size_t)seg * 512 + ch] = H; }
                            CFENCE(); __builtin_amdgcn_sched_barrier(0);
                        }
                    }
                }
                for (int row = gw; row < MTOK; row += NGW) {
                    const u32x2 q = *(const u32x2*)(PROJ + (size_t)row * PPITCH + 2048 + lane * 4);
                    const float a0 = __uint_as_float(q.x << 16), a1 = __uint_as_float(q.x & 0xffff0000u), a2 = __uint_as_float(q.y << 16), a3 = __uint_as_float(q.y & 0xffff0000u);
                    float ss = (a0 * a0 + a1 * a1) + (a2 * a2 + a3 * a3);
                    ss += __shfl_xor(ss, 1); ss += __shfl_xor(ss, 2); ss += __shfl_xor(ss, 4); ss += __shfl_xor(ss, 8);
                    const float rk = __builtin_amdgcn_rsqf(ss * (1.0f / 64.0f) + EPSF);
                    u32x2 kn; kn.x = pk2(a0 * rk, a1 * rk); kn.y = pk2(a2 * rk, a3 * rk);
                    *(u32x2*)(PROJ + (size_t)row * PPITCH + 2048 + lane * 4) = kn;
                }
                for (int chn = vcu; chn < 64; chn += G) {
                    const int b = chn >> 2, h = chn & 3; const float bf = b_fg[l * 4 + h];
                    const int t0 = wave * 512 + lane * 8;
                    const float* fp = FG + ((size_t)b * SEQL + t0) * 4 + h;
                    float lf[8], tot = 0.f;
#pragma unroll
                    for (int i = 0; i < 8; ++i) { const float v = fp[i * 4] + bf; lf[i] = __builtin_fminf(v, 0.f) - log1pf(expf(-fabsf(v))); tot += lf[i]; }
                    float inc = tot;
#pragma unroll
                    for (int o = 1; o < 64; o <<= 1) { const float t_ = __shfl_up(inc, o); if (lane >= o) inc += t_; }
                    LAS float* wt = (LAS float*)(lds + 16384 + 8 * 13568);
                    __syncthreads();
                    if (lane == 63) wt[wave] = inc;
                    __syncthreads();
                    float run = inc - tot;
                    for (int w = 0; w < wave; ++w) run += wt[w];
                    f32x4 o0, o1;
                    run += lf[0]; o0[0] = -run * LOG2E; run += lf[1]; o0[1] = -run * LOG2E; run += lf[2]; o0[2] = -run * LOG2E; run += lf[3]; o0[3] = -run * LOG2E;
                    run += lf[4]; o1[0] = -run * LOG2E; run += lf[5]; o1[1] = -run * LOG2E; run += lf[6]; o1[2] = -run * LOG2E; run += lf[7]; o1[3] = -run * LOG2E;
                    float* op = F2 + (size_t)chn * SEQL + t0;
                    *(f32x4*)op = o0; *(f32x4*)(op + 4) = o1;
                }
#endif
                __syncthreads();
            }
            PH_NEXT;
            if (PH_ON) { DEFPTRS
#ifndef NO_ATTN
                for (int rep_ = 0; rep_ < REP_ATTN; ++rep_)
                for (int tt = vcu; tt < 256; tt += G) { const int ch = tid; float A = 1.f, B = 0.f;
#pragma unroll
                    for (int s8 = 0; s8 < 8; ++s8) { const float as_ = ASEG[(size_t)(tt * 8 + s8) * 512 + ch], bs_ = BSEG[(size_t)(tt * 8 + s8) * 512 + ch]; A = as_ * A; B = as_ * B + bs_; }
                    TSEGA[(size_t)tt * 512 + ch] = A; TSEGB[(size_t)tt * 512 + ch] = B; }
                for (int vw = vcu; vw < 256; vw += G) {
                    const int bh = vw >> 2, s4 = vw & 3, b = bh >> 2, h = bh & 3;
#pragma unroll 1
                    for (int i = 0; i < 4; ++i) { const int qb = (i == 0) ? s4 : (i == 1) ? 7 - s4 : (i == 2) ? 8 + s4 : 15 - s4;
#ifndef NO_FOX
                        attn_unit<1>(lds, PROJ, YU, KS, F2, g_qk + l * 128, b, h, qb);
#endif
 }
#pragma unroll 1
                    for (int i = 0; i < 4; ++i) { const int qb = (i == 0) ? s4 : (i == 1) ? 7 - s4 : (i == 2) ? 8 + s4 : 15 - s4;
#ifndef NO_SB
                        attn_unit<0>(lds, PROJ, YU, KS, F2, g_qk + l * 128, b, h, qb);
#endif
 }
                }
#endif
            }
            PH_NEXT;
            if (PH_ON) { DEFPTRS
                LAS float* hin = (LAS float*)lds;
                const f32x4 gm0 = *(const f32x4*)(g_mix + l * 1024 + lane * 8), gm1 = *(const f32x4*)(g_mix + l * 1024 + lane * 8 + 4);
                const f32x4 gx0 = *(const f32x4*)(g_mix + l * 1024 + 512 + lane * 8), gx1 = *(const f32x4*)(g_mix + l * 1024 + 512 + lane * 8 + 4);
                for (int tti = vcu; tti < REP_FIN * 256; tti += G) { const int tt = tti & 255;
                    __syncthreads();
                    { const int ch = tid, seg0 = (tt >> 4) * 128, nb = (tt & 15) * 8; float Hc = 0.f;
#pragma unroll 5
                      for (int t_ = (tt & ~15); t_ < tt; ++t_) Hc = TSEGA[(size_t)t_ * 512 + ch] * Hc + TSEGB[(size_t)t_ * 512 + ch];
#pragma unroll
                      for (int s8 = 0; s8 < 8; ++s8) { hin[s8 * 512 + ch] = Hc; Hc = ASEG[(size_t)(seg0 + nb + s8) * 512 + ch] * Hc + BSEG[(size_t)(seg0 + nb + s8) * 512 + ch]; } }
                    __syncthreads();
                    const f32x4 hi0 = *(const LAS f32x4*)(hin + wave * 512 + lane * 8), hi1 = *(const LAS f32x4*)(hin + wave * 512 + lane * 8 + 4);
#pragma unroll 2
                    for (int t = 0; t < 32; ++t) {
                        const size_t row = (size_t)tt * 256 + wave * 32 + t;
                        const u32x4 hq = *(const u32x4*)(HLOC + row * 512 + lane * 8);
                        const u32x4 pq = *(const u32x4*)(PCUM + row * 512 + lane * 8);
                        const u32x4 gq = *(const u32x4*)(PROJ + row * PPITCH + 512 + lane * 8);
                        const u32x4 yq = *(const u32x4*)(YU + row * 512 + lane * 8);
                        float y[8], yu[8]; float ss = 0.f, s2 = 0.f;
#pragma unroll
                        for (int i = 0; i < 8; ++i) {
                            const unsigned pw = pq[i >> 1], gw_ = gq[i >> 1], yw = yq[i >> 1];
                            const float p = (i & 1) ? __uint_as_float(pw & 0xffff0000u) : __uint_as_float(pw << 16);
                            const float gg = (i & 1) ? __uint_as_float(gw_ & 0xffff0000u) : __uint_as_float(gw_ << 16);
                            yu[i] = (i & 1) ? __uint_as_float(yw & 0xffff0000u) : __uint_as_float(yw << 16);
                            const unsigned hw = hq[i >> 1]; const float hlv = (i & 1) ? __uint_as_float(hw & 0xffff0000u) : __uint_as_float(hw << 16);
                            const float hh = hlv + p * (i < 4 ? hi0[i & 3] : hi1[i & 3]);
                            const float inner = 0.7978845608028654f * (gg + 0.044715f * gg * gg * gg);
                            const float ge = gg * __builtin_amdgcn_rcpf(1.0f + __builtin_amdgcn_exp2f(-2.0f * LOG2E * inner));
                            y[i] = hh * ge; ss += y[i] * y[i]; s2 += yu[i] * yu[i];
                        }
                        ss = wave_sum(ss);
                        s2 += __shfl_xor(s2, 1); s2 += __shfl_xor(s2, 2); s2 += __shfl_xor(s2, 4); s2 += __shfl_xor(s2, 8); s2 += __shfl_xor(s2, 16);
                        const float rl = __builtin_amdgcn_rsqf(ss * (1.0f / 512.0f) + EPSF), rx = __builtin_amdgcn_rsqf(s2 * (1.0f / 256.0f) + EPSF);
                        u32x4 o1, o2;
                        o1.x = pk2(y[0] * rl * gm0[0], y[1] * rl * gm0[1]); o1.y = pk2(y[2] * rl * gm0[2], y[3] * rl * gm0[3]);
                        o1.z = pk2(y[4] * rl * gm1[0], y[5] * rl * gm1[1]); o1.w = pk2(y[6] * rl * gm1[2], y[7] * rl * gm1[3]);
                        o2.x = pk2(yu[0] * rx * gx0[0], yu[1] * rx * gx0[1]); o2.y = pk2(yu[2] * rx * gx0[2], yu[3] * rx * gx0[3]);
                        o2.z = pk2(yu[4] * rx * gx1[0], yu[5] * rx * gx1[1]); o2.w = pk2(yu[6] * rx * gx1[2], yu[7] * rx * gx1[3]);
                        *(u32x4*)(YN + row * 1024 + lane * 8) = o1; *(u32x4*)(YN + row * 1024 + 512 + lane * 8) = o2;
                    }
                }
                __syncthreads();
            }
            PH_NEXT;
            if (PH_ON) { DEFPTRS
                pg8::Gemm g{YN, WOUT + (size_t)l * DM * DM, MTOK, DM, DM}; pg8::StaticOrder S; S.init(MTOK, DM, G, bx, 24);
                pg8::EpiRes E{xout, xout, GATE + (size_t)(l * 3 + 1) * 16 * 1024, GMOD + (size_t)(l * 3 + 2) * 16 * 1024, XN, ROWSS + (size_t)(l * 3 + 2) * MTOK, 1};
#ifndef NO_G_OUT
#ifdef REP_OUT
                { E.xout = (float*)HB; E.has_next = 0; pg8::gemm_phase<pg8::EpiRes, pg8::StaticOrder, true, true>(lds, g, S, E); E.xout = xout; E.has_next = 1; }
#endif
                pg8::gemm_phase<pg8::EpiRes, pg8::StaticOrder, true, true>(lds, g, S, E);
#endif
            }
            PH_NEXT;
        }
        const int j = s ? 2 : 0;
        if (PH_ON) { DEFPTRS
            pg8::Gemm g{XN, WUP + (size_t)(l * 2 + s) * NUP * DM, MTOK, NUP, DM}; pg8::StaticOrder S; S.init(MTOK, NUP, G, bx);
            pg8::EpiUp E{HB, ROWSS + (size_t)(l * 3 + j) * MTOK, SBV + (size_t)(l * 3 + j) * 16 * 5632};
#ifndef NO_G_UP
            for (int rep_ = 0; rep_ < REP_UP; ++rep_) {
            pg8::gemm_phase<pg8::EpiUp, pg8::StaticOrder, true, true>(lds, g, S, E);
            }
#endif
        }
        PH_NEXT;
        if (PH_ON) { DEFPTRS
            const int nl = s ? l + 1 : l, nj = s ? 0 : 1; const int has_next = (nl < 2) ? 1 : 0; const int nidx = has_next ? nl * 3 + nj : 0;
            pg8::Gemm g{HB, WDN + (size_t)(l * 2 + s) * DM * DFF, MTOK, DM, DFF}; pg8::StaticOrder S; S.init(MTOK, DM, G, bx, 24);
            pg8::EpiRes E{f == 0 ? x_in : xout, xout, GATE + (size_t)(l * 3 + j) * 16 * 1024, GMOD + (size_t)nidx * 16 * 1024, XN, ROWSS + (size_t)nidx * MTOK, has_next};
#ifndef NO_G_DN
#ifdef REP_DN
            for (int rep_ = 0; rep_ < 2; ++rep_) { E.xout = (rep_ == 0) ? (float*)HLOC : xout; E.has_next = (rep_ == 0) ? 0 : has_next;
            pg8::gemm_phase<pg8::EpiRes, pg8::StaticOrder, true, true>(lds, g, S, E); }
#else
            pg8::gemm_phase<pg8::EpiRes, pg8::StaticOrder, true, true>(lds, g, S, E);
#endif
#endif
        }
        PH_NEXT;
    }
#undef PH_ON
#undef PH_NEXT
}


#ifdef DBG_STOP
__global__ void dbg_dump(const unsigned char* ws, float* out, int mode) {
    const size_t n = (size_t)MTOK * DM; const size_t i0 = (size_t)blockIdx.x * blockDim.x + threadIdx.x, st = (size_t)gridDim.x * blockDim.x;
    const bf16_t* XN = (const bf16_t*)(ws + WS_XN); const bf16_t* HB = (const bf16_t*)(ws + WS_H); const bf16_t* PR = (const bf16_t*)(ws + WS_PROJ);
    const bf16_t* YU = (const bf16_t*)(ws + WS_YU); const float* HL = (const float*)(ws + WS_HLOC); const bf16_t* YN = (const bf16_t*)(ws + WS_YN); const bf16_t* PC = (const bf16_t*)(ws + WS_PCUM);
    for (size_t i = i0; i < n; i += st) {
        float v = 0.f;
        if (mode == 0) v = bf2f(XN[i]);
        else if (mode == 1) v = bf2f(HB[i]) + bf2f(HB[i + n]) + bf2f(HB[i + (size_t)117440512]);
        else if (mode == 2) v = bf2f(PR[i]) + bf2f(PR[i + n]) + bf2f(PR[i + (size_t)100663296]);
        else if (mode == 3) v = (i < n / 2) ? bf2f(YU[i]) : HL[i - n / 2];
        else if (mode == 4) v = bf2f(YN[i]);
        else if (mode == 6) v = (i < n / 2) ? bf2f(PC[i]) : ((const float*)(ws + WS_KS))[(i - n / 2) % (3 * 262144)];
        else if (mode == 7) v = HL[i % (n / 2)] + bf2f(PC[i % (n / 2)]) + ((const float*)(ws + WS_KS))[i % (3 * 262144)] + ((const float*)(ws + WS_ASEG))[i % (2 * 1048576)];
        if (mode == 3) { const bool nan_ = !(v == v), big = (v > 3e38f) || (v < -3e38f); float code = 0.f;
            if (i < n / 2) { const int col = (int)(i & 511); if (col < 256) code = nan_ ? 2000.f : (big ? 1000.f : 0.f); else code = (nan_ || big) ? 4000.f : 0.f; }
            else code = (nan_ || big) ? 8000.f : 0.f;
            v = code; }
        if (!(v == v)) v = 77777.f; if (v > 3e38f) v = 88888.f; if (v < -3e38f) v = 99999.f;
        if (mode != 5) out[i] = v;
    }
}
#endif
#ifndef MK_N_LAUNCHES
#define MK_N_LAUNCHES 1
#endif
constexpr int N_PHASES = 3 + 2 * 9;
extern "C" void kernel_launch(void* const* d_in, const int* in_sizes, int n_in, void* d_out, int out_size, void* d_ws, size_t ws_size, hipStream_t stream) {
    static int grid = 0;
    if (grid == 0) {
        if (n_in != 19 || out_size != MTOK * DM || ws_size < WS_END) { fprintf(stderr, "kernel_launch: unexpected shapes (n_in %d, out %d, ws %zu)\n", n_in, out_size, ws_size); grid = -1; return; }
        int dev = 0, cus = 0, per_cu = 0;
        hipGetDevice(&dev); hipDeviceGetAttribute(&cus, hipDeviceAttributeMultiprocessorCount, dev);
        if (hipFuncSetAttribute((const void*)mk_fwd, hipFuncAttributeMaxDynamicSharedMemorySize, LDS_BYTES) != hipSuccess) { fprintf(stderr, "kernel_launch: hipFuncSetAttribute failed\n"); grid = -1; return; }
        if (hipOccupancyMaxActiveBlocksPerMultiprocessor(&per_cu, (const void*)mk_fwd, 512, LDS_BYTES) != hipSuccess || per_cu < 1) { fprintf(stderr, "kernel_launch: occupancy query says %d\n", per_cu); per_cu = 1; }
        (void)hipGetLastError();
        grid = cus * 1;
    }
    if (grid < 0) return;
    if (hipMemsetAsync(d_ws, 0, 16384, stream) != hipSuccess) { fprintf(stderr, "kernel_launch: memset failed\n"); return; }
    Args a{};
    for (int i = 0; i < 19; ++i) a.in[i] = (const float*)d_in[i];
    a.out = (float*)d_out; a.ws = (unsigned char*)d_ws;
#if MK_N_LAUNCHES == 1
    a.ph_lo = 0; a.ph_hi = N_PHASES;
    void* kargs[] = {&a};
    hipError_t e = hipLaunchCooperativeKernel((const void*)mk_fwd, dim3(grid), dim3(512), kargs, LDS_BYTES, stream);
    if (e != hipSuccess) fprintf(stderr, "kernel_launch: cooperative launch failed: %s (grid %d)\n", hipGetErrorString(e), grid);
#else
#ifdef DBG_STOP
    for (int p = 0; p < DBG_STOP; ++p) { a.ph_lo = p; a.ph_hi = p + 1; hipLaunchKernelGGL(mk_fwd, dim3(grid), dim3(512), LDS_BYTES, stream, a); }
    hipLaunchKernelGGL(dbg_dump, dim3(2048), dim3(256), 0, stream, (const unsigned char*)d_ws, (float*)d_out, DBG_MODE);
#else
    for (int p = 0; p < N_PHASES; ++p) { a.ph_lo = p; a.ph_hi = p + 1; hipLaunchKernelGGL(mk_fwd, dim3(grid), dim3(512), LDS_BYTES, stream, a); }
#endif
#endif
}
```

```cpp
#include <hip/hip_runtime.h>
#include <hip/hip_cooperative_groups.h>
#include <cstdio>
#include <cstdint>
namespace cg = cooperative_groups;
namespace pg8 {
#define PG8_LAS __attribute__((address_space(3)))
typedef unsigned short bf16_t;
typedef short bf16x8 __attribute__((ext_vector_type(8)));
typedef float f32x4 __attribute__((ext_vector_type(4)));
typedef unsigned u32x4 __attribute__((ext_vector_type(4)));
constexpr int BM = 256, BK = 64, HALF = 128, HTB = HALF * BK * 2  , STAGE_BYTES = 8 * HTB, NXCD = 8, WGM = 8;

__host__ __device__ __forceinline__ int lds_byte(int r, int c) { const int st = (r >> 4) * 2 + (c >> 5), rr = r & 15, cc = c & 31, ob = rr * 64 + cc * 2; return st * 1024 + (ob ^ (((ob >> 9) & 1) << 5)); }
__host__ __device__ __forceinline__ void stage_rc(int b, int& R, int& C) { const int st = b / 1024, sb = b % 1024, swz = sb ^ (((sb >> 9) & 1) << 5); R = (st >> 1) * 16 + swz / 64; C = (st & 1) * 32 + (swz % 64) / 2; }
__host__ __device__ __forceinline__ int perm32(int rho) { const int n = rho >> 4, i = rho & 15; return 8 * (i >> 2) + 4 * n + (i & 3); }

struct Unit { int pm, pn; };
struct Gemm { const bf16_t* A; const bf16_t* Bt; int M, N, K; };

struct StaticOrder {
    int nM, nN, nwg, G, c, rev;
    __host__ __device__ void init(int M, int N, int G_, int c_, int rev_ = 0) { nM = M / BM; nN = N / BM; nwg = nM * nN; G = G_; c = c_; rev = rev_; }
    __host__ __device__ bool next(int i, Unit& u) const {
        const long L = (long)i * G + c; if (L >= nwg) return false;
        int wgid = (int)L; { const int q = nwg / NXCD, r = nwg % NXCD, xcd = wgid % NXCD, off = wgid / NXCD; wgid = (xcd < r ? xcd * (q + 1) : r * (q + 1) + (xcd - r) * q) + off; }
        const int nig = WGM * nN, gid = wgid / nig, fm = gid * WGM, gsz = (nM - fm) < WGM ? (nM - fm) : WGM;
        u.pm = (fm + ((wgid % nig) % gsz)) ^ rev; u.pn = (wgid % nig) / gsz; return true;
    }
    __device__ __forceinline__ void a_ready(const Unit&) const {}
    __device__ __forceinline__ void done(const Unit&) const {}
};

typedef float f32x2c_t __attribute__((ext_vector_type(2))); typedef __bf16 bf16x2c_t __attribute__((ext_vector_type(2)));
__device__ __forceinline__ unsigned cvt_pk_bf16(float lo, float hi) { f32x2c_t v = {lo, hi}; bf16x2c_t b = __builtin_convertvector(v, bf16x2c_t); return __builtin_bit_cast(unsigned, b); }
typedef float f32x2 __attribute__((ext_vector_type(2)));
constexpr float RMS_EPS = 1e-6f;
struct EpiUp {
    static constexpr bool PERM = true, AFTER_DRAIN = false;
    bf16_t* H; const float* rowss; const float* sb;
    PG8_LAS unsigned char* xl;
    __device__ __forceinline__ void prefetch(const Unit& u, int wid, int lane) const {
        if (wid < 4) __builtin_amdgcn_global_load_lds((const unsigned*)(rowss + u.pm * BM + wid * 64 + lane), (PG8_LAS unsigned*)(xl + wid * 256), 4, 0, 0);
        else if (wid == 4) __builtin_amdgcn_global_load_lds((const unsigned*)(sb + (size_t)(u.pm >> 4) * 5632 + u.pn * 256 + lane * 4), (PG8_LAS unsigned*)(xl + 1024), 16, 0, 0);
    }
    __device__ __forceinline__ void operator()(const f32x4 (&acc)[2][2][4][2], const Unit& u, int wr, int wc, int fr, int fq) const {
        const int row0 = u.pm * BM + wr * 64 + fr, b = u.pm >> 4, cl = wc * 32 + 8 * fq;
        const PG8_LAS float* xr = (const PG8_LAS float*)xl + wr * 64 + fr; const PG8_LAS float* xs_ = (const PG8_LAS float*)(xl + 1024) + cl; (void)b;
        float rsv[2][4];
#pragma unroll
        for (int ai = 0; ai < 2; ++ai)
#pragma unroll
            for (int m = 0; m < 4; ++m) rsv[ai][m] = xr[ai * HALF + m * 16];
        f32x4 sg[2], su[2];
#pragma unroll
        for (int n = 0; n < 2; ++n) { sg[n] = *(const PG8_LAS f32x4*)(xs_ + 4 * n); su[n] = *(const PG8_LAS f32x4*)(xs_ + 128 + 4 * n); }
#pragma unroll
        for (int ai = 0; ai < 2; ++ai)
#pragma unroll
            for (int m = 0; m < 4; ++m) {
                const int row = row0 + ai * HALF + m * 16;
                const float rs = __builtin_amdgcn_rsqf(rsv[ai][m] * (1.0f / 1024.0f) + RMS_EPS);
                unsigned wq[4];
#pragma unroll
                for (int n = 0; n < 2; ++n)
#pragma unroll
                    for (int ip = 0; ip < 2; ++ip) {
                        const f32x2 ag = (f32x2){acc[ai][0][m][n][2 * ip], acc[ai][0][m][n][2 * ip + 1]}, au = (f32x2){acc[ai][1][m][n][2 * ip], acc[ai][1][m][n][2 * ip + 1]};
                        const f32x2 g = ag * rs + (f32x2){sg[n][2 * ip], sg[n][2 * ip + 1]}, uu = au * rs + (f32x2){su[n][2 * ip], su[n][2 * ip + 1]};
                        const f32x2 t = g * (-1.4426950408889634f);
                        f32x2 d; d.x = __builtin_amdgcn_exp2f(t.x); d.y = __builtin_amdgcn_exp2f(t.y); d = d + 1.0f;
                        f32x2 r; r.x = __builtin_amdgcn_rcpf(d.x); r.y = __builtin_amdgcn_rcpf(d.y);
                        const f32x2 hv = (g * uu) * r;
                        wq[n * 2 + ip] = cvt_pk_bf16(hv.x, hv.y);
                    }
                u32x4 w; w.x = wq[0]; w.y = wq[1]; w.z = wq[2]; w.w = wq[3];
                *(u32x4*)(H + (size_t)row * 2816 + u.pn * 128 + cl) = w;
            }
    }
};
struct EpiIn {
    static constexpr bool PERM = true, AFTER_DRAIN = false;
    bf16_t* P; float* FG; const float* rowss; const float* sb;
    PG8_LAS unsigned char* xl;
    __device__ __forceinline__ void prefetch(const Unit& u, int wid, int lane) const {
        if (wid < 4) __builtin_amdgcn_global_load_lds((const unsigned*)(rowss + u.pm * BM + wid * 64 + lane), (PG8_LAS unsigned*)(xl + wid * 256), 4, 0, 0);
        else if (wid == 4) __builtin_amdgcn_global_load_lds((const unsigned*)(sb + (size_t)(u.pm >> 4) * 5632 + u.pn * 256 + lane * 4), (PG8_LAS unsigned*)(xl + 1024), 16, 0, 0);
    }
    __device__ __forceinline__ void operator()(const f32x4 (&acc)[2][2][4][2], const Unit& u, int wr, int wc, int fr, int fq) const {
        const int row0 = u.pm * BM + wr * 64 + fr, b = u.pm >> 4, cl = wc * 32 + 8 * fq;
        const PG8_LAS float* xr = (const PG8_LAS float*)xl + wr * 64 + fr; const PG8_LAS float* xs_ = (const PG8_LAS float*)(xl + 1024) + cl; (void)b;
        float rsv[2][4];
#pragma unroll
        for (int ai = 0; ai < 2; ++ai)
#pragma unroll
            for (int m = 0; m < 4; ++m) rsv[ai][m] = xr[ai * HALF + m * 16];
        f32x4 sv[2][2];
#pragma unroll
        for (int bj = 0; bj < 2; ++bj)
#pragma unroll
            for (int n = 0; n < 2; ++n) sv[bj][n] = *(const PG8_LAS f32x4*)(xs_ + bj * HALF + 4 * n);
#pragma unroll
        for (int ai = 0; ai < 2; ++ai)
#pragma unroll
            for (int m = 0; m < 4; ++m) {
                const int row = row0 + ai * HALF + m * 16;
                const float rs = __builtin_amdgcn_rsqf(rsv[ai][m] * (1.0f / 1024.0f) + RMS_EPS);
                if (u.pn < 10) {
#pragma unroll
                    for (int bj = 0; bj < 2; ++bj) {
                        const f32x4 v0 = acc[ai][bj][m][0] * rs + sv[bj][0], v1 = acc[ai][bj][m][1] * rs + sv[bj][1];
                        u32x4 w; w.x = cvt_pk_bf16(v0[0], v0[1]); w.y = cvt_pk_bf16(v0[2], v0[3]); w.z = cvt_pk_bf16(v1[0], v1[1]); w.w = cvt_pk_bf16(v1[2], v1[3]);
                        *(u32x4*)(P + (size_t)row * 2560 + u.pn * 256 + bj * HALF + cl) = w;
                    }
                } else if (wc == 0 && fq == 0) {
                    *(f32x4*)(FG + (size_t)row * 4) = acc[ai][0][m][0] * rs + sv[0][0];
                }
            }
    }
};
struct EpiRes {
    static constexpr bool PERM = false, AFTER_DRAIN = false;
    const float* xin; float* xout; const float* gate; const float* gmn; bf16_t* XN; float* rowssn; int has_next;
    __device__ __forceinline__ void prefetch(const Unit&, int, int) const {}
    __device__ __forceinline__ void operator()(const f32x4 (&acc)[2][2][4][2], const Unit& u, int wr, int wc, int fr, int fq) const {
        typedef unsigned u32x2v __attribute__((ext_vector_type(2)));
        const int row0 = u.pm * BM + wr * 64 + fr, b = u.pm >> 4, col0 = u.pn * BM + wc * 32 + 4 * fq;
        const float* gp_ = gate + b * 1024 + col0; const float* gm_ = gmn + b * 1024 + col0;
#pragma unroll
        for (int ai = 0; ai < 2; ++ai) {
            f32x4 xi[4][2][2];
#pragma unroll
            for (int m = 0; m < 4; ++m)
#pragma unroll
                for (int bj = 0; bj < 2; ++bj)
#pragma unroll
                    for (int n = 0; n < 2; ++n) xi[m][bj][n] = *(const f32x4*)(xin + (size_t)(row0 + ai * HALF + m * 16) * 1024 + col0 + bj * HALF + n * 16);
            asm volatile("" ::: "memory");
#pragma unroll
            for (int m = 0; m < 4; ++m) {
                const int row = row0 + ai * HALF + m * 16; const size_t off = (size_t)row * 1024 + col0;
                float ss = 0.f;
#pragma unroll
                for (int bj = 0; bj < 2; ++bj)
#pragma unroll
                    for (int n = 0; n < 2; ++n) {
                        const f32x4 xo = xi[m][bj][n] + *(const f32x4*)(gp_ + bj * HALF + n * 16) * acc[ai][bj][m][n];
                        *(f32x4*)(xout + off + bj * HALF + n * 16) = xo;
                        if (has_next) {
                            ss += (xo[0] * xo[0] + xo[1] * xo[1]) + (xo[2] * xo[2] + xo[3] * xo[3]);
                            const f32x4 a = xo * *(const f32x4*)(gm_ + bj * HALF + n * 16); u32x2v w; w.x = cvt_pk_bf16(a[0], a[1]); w.y = cvt_pk_bf16(a[2], a[3]);
                            *(u32x2v*)(XN + off + bj * HALF + n * 16) = w;
                        }
                    }
                if (has_next) { ss += __shfl_xor(ss, 16); ss += __shfl_xor(ss, 32); if (fq == 0) unsafeAtomicAdd(rowssn + row, ss); }
            }
            asm volatile("" ::: "memory");
        }
    }
};

template <class Epi, class Sched, bool ALIGN_EPI = false, bool SP2 = false>
__device__ __forceinline__ void gemm_phase(PG8_LAS unsigned char* lds, const Gemm g, const Sched& S, const Epi& E) {
    int tid_o = threadIdx.x; asm volatile("" : "+v"(tid_o)); const int tid = tid_o, wid = __builtin_amdgcn_readfirstlane(tid >> 6), lane = tid & 63, wr = wid >> 2, wc = wid & 3, fr = lane & 15, fq = lane >> 4;
    const int K = g.K, nt = K / BK;
    unsigned voffA[2], voffB[2];
#pragma unroll
    for (int i = 0; i < 2; ++i) { int R, C; stage_rc(tid * 16 + i * 8192, R, C); const int Rb = Epi::PERM ? ((R & ~31) + perm32(R & 31)) : R;
        voffA[i] = (unsigned)(R * K + C) * 2u; voffB[i] = (unsigned)(Rb * K + C) * 2u; }
    const size_t kstep = (size_t)(BK * 2);
    const size_t hstep = (size_t)HALF * K * 2;
    const size_t tstep = 2 * hstep;
    const unsigned ldsw = (unsigned)wid * 1024u;
    const int aoff = lds_byte(wr * 64 + fr, fq * 8), boff = lds_byte(wc * 32 + fr, fq * 8);
#define PG8_SA(b, h) (((b) * 2 + (h)) * HTB)
#define PG8_SB(b, h) ((4 + (b) * 2 + (h)) * HTB)
#define PG8_STAGE(bufoff, gbase, voff) do { _Pragma("unroll") for (int _i = 0; _i < 2; ++_i) \
        __builtin_amdgcn_global_load_lds((const unsigned*)((const char*)(gbase) + (voff)[_i]), (PG8_LAS unsigned*)(lds + (bufoff) + ldsw + _i * 8192), 16, 0, 0); } while (0)
#define PG8_LDA(dst, b, h) do { _Pragma("unroll") for (int m = 0; m < 4; ++m) _Pragma("unroll") for (int k = 0; k < 2; ++k) dst[m][k] = *(const PG8_LAS bf16x8*)(lds + PG8_SA(b, h) + aoff + m * 2048 + k * 1024); } while (0)
#define PG8_LDB(dst, b, h) do { _Pragma("unroll") for (int n = 0; n < 2; ++n) _Pragma("unroll") for (int k = 0; k < 2; ++k) dst[n][k] = *(const PG8_LAS bf16x8*)(lds + PG8_SB(b, h) + boff + n * 2048 + k * 1024); } while (0)
#define PG8_MMA(ai, bj, At, Bt) do { __builtin_amdgcn_s_setprio(1); _Pragma("unroll") for (int m = 0; m < 4; ++m) _Pragma("unroll") for (int n = 0; n < 2; ++n) _Pragma("unroll") for (int k = 0; k < 2; ++k) \
        acc[ai][bj][m][n] = __builtin_amdgcn_mfma_f32_16x16x32_bf16(Bt[n][k], At[m][k], acc[ai][bj][m][n], 0, 0, 0); __builtin_amdgcn_s_setprio(0); } while (0)
#define PG8_WAIT_V(n) asm volatile("s_waitcnt vmcnt(" #n ")" ::: "memory")
#define PG8_WAIT_L(n) asm volatile("s_waitcnt lgkmcnt(" #n ")" ::: "memory")
#define PG8_BAR __builtin_amdgcn_s_barrier()
#define PG8_SCHED __builtin_amdgcn_sched_barrier(0)
    Unit cur, nxt; int ui = 0;
    if (!S.next(0, cur)) return;
    f32x4 acc[2][2][4][2];
#pragma unroll
    for (int a = 0; a < 2; ++a)
#pragma unroll
        for (int b = 0; b < 2; ++b)
#pragma unroll
            for (int m = 0; m < 4; ++m)
#pragma unroll
                for (int n = 0; n < 2; ++n) acc[a][b][m][n] = (f32x4){0.f, 0.f, 0.f, 0.f};
    bf16x8 At[4][2], B0[2][2], B1[2][2];
    const char* cA = (const char*)g.A + (size_t)cur.pm * tstep; const char* cB = (const char*)g.Bt + (size_t)cur.pn * tstep;
    S.a_ready(cur);
    if constexpr (SP2) {
        PG8_STAGE(PG8_SB(0, 0), cB, voffB); PG8_STAGE(PG8_SB(0, 1), cB + hstep, voffB); PG8_STAGE(PG8_SA(0, 0), cA, voffA); PG8_STAGE(PG8_SA(0, 1), cA + hstep, voffA);
        if (wr == 1) PG8_BAR;
        PG8_WAIT_V(2); PG8_BAR;
        PG8_STAGE(PG8_SB(1, 0), cB + kstep, voffB); PG8_STAGE(PG8_SA(1, 0), cA + kstep, voffA); PG8_STAGE(PG8_SB(1, 1), cB + hstep + kstep, voffB);
        PG8_WAIT_V(6); PG8_BAR;
    } else {
        PG8_STAGE(PG8_SB(0, 0), cB, voffB); PG8_STAGE(PG8_SA(0, 0), cA, voffA); PG8_STAGE(PG8_SB(0, 1), cB + hstep, voffB); PG8_STAGE(PG8_SA(0, 1), cA + hstep, voffA);
        if (wr == 1) PG8_BAR;
        PG8_WAIT_V(4); PG8_BAR;
        PG8_STAGE(PG8_SB(1, 0), cB + kstep, voffB); PG8_STAGE(PG8_SA(1, 0), cA + kstep, voffA); PG8_STAGE(PG8_SB(1, 1), cB + hstep + kstep, voffB);
        PG8_WAIT_V(6); PG8_BAR;
    }
    for (;;) {
        const bool has_next = S.next(ui + 1, nxt);
        const char* nA = has_next ? (const char*)g.A + (size_t)nxt.pm * tstep : cA; const char* nB = has_next ? (const char*)g.Bt + (size_t)nxt.pn * tstep : cB;
        for (int t = 0; t < nt; t += 2) {
            const bool last = (t == nt - 2);
            const char* a1 = cA + (size_t)(t + 1) * kstep;
            const char* a2 = last ? nA : cA + (size_t)(t + 2) * kstep; const char* b2 = last ? nB : cB + (size_t)(t + 2) * kstep;
            const char* a3 = a2 + kstep; const char* b3 = b2 + kstep;
            if (last) E.prefetch(cur, wid, lane);
            if (last && has_next) S.a_ready(nxt);
            if constexpr (SP2) {
            PG8_LDB(B0, 0, 0); PG8_LDB(B1, 0, 1); PG8_SCHED; PG8_LDA(At, 0, 0); PG8_STAGE(PG8_SA(1, 1), a1 + hstep, voffA);
            PG8_WAIT_V(8); PG8_WAIT_L(0); PG8_BAR; PG8_MMA(0, 0, At, B0); PG8_MMA(0, 1, At, B1); PG8_BAR; PG8_SCHED;
            PG8_LDA(At, 0, 1); PG8_STAGE(PG8_SB(0, 0), b2, voffB); PG8_STAGE(PG8_SB(0, 1), b2 + hstep, voffB); PG8_STAGE(PG8_SA(0, 0), a2, voffA);
            PG8_WAIT_V(8); PG8_WAIT_L(0); PG8_BAR; PG8_MMA(1, 0, At, B0); PG8_MMA(1, 1, At, B1); PG8_BAR; PG8_SCHED;
            PG8_LDB(B0, 1, 0); PG8_LDB(B1, 1, 1); PG8_SCHED; PG8_LDA(At, 1, 0); PG8_STAGE(PG8_SA(0, 1), a2 + hstep, voffA);
            PG8_WAIT_V(8); PG8_WAIT_L(0); PG8_BAR; PG8_MMA(0, 0, At, B0); PG8_MMA(0, 1, At, B1); PG8_BAR; PG8_SCHED;
            PG8_LDA(At, 1, 1); PG8_STAGE(PG8_SB(1, 0), b3, voffB); PG8_STAGE(PG8_SB(1, 1), b3 + hstep, voffB); PG8_STAGE(PG8_SA(1, 0), a3, voffA);
            PG8_WAIT_V(8); PG8_WAIT_L(0); PG8_BAR; PG8_MMA(1, 0, At, B0); PG8_MMA(1, 1, At, B1); PG8_BAR; PG8_SCHED;
            } else {
            PG8_LDB(B0, 0, 0); PG8_SCHED; PG8_LDA(At, 0, 0); PG8_STAGE(PG8_SA(1, 1), a1 + hstep, voffA);
            PG8_WAIT_L(8); PG8_BAR; PG8_WAIT_L(0); PG8_MMA(0, 0, At, B0); PG8_BAR; PG8_SCHED;
            PG8_LDB(B1, 0, 1); PG8_STAGE(PG8_SB(0, 0), b2, voffB);
            PG8_BAR; PG8_WAIT_L(0); PG8_MMA(0, 1, At, B1); PG8_BAR;
            PG8_LDA(At, 0, 1); PG8_STAGE(PG8_SA(0, 0), a2, voffA);
            PG8_BAR; PG8_WAIT_L(0); PG8_MMA(1, 0, At, B0); PG8_BAR; PG8_SCHED;
            PG8_STAGE(PG8_SB(0, 1), b2 + hstep, voffB);
            PG8_WAIT_V(6); PG8_BAR; PG8_MMA(1, 1, At, B1); PG8_BAR;
            PG8_LDB(B0, 1, 0); PG8_SCHED; PG8_LDA(At, 1, 0); PG8_STAGE(PG8_SA(0, 1), a2 + hstep, voffA);
            PG8_WAIT_L(8); PG8_BAR; PG8_WAIT_L(0); PG8_MMA(0, 0, At, B0); PG8_BAR; PG8_SCHED;
            PG8_LDB(B1, 1, 1); PG8_STAGE(PG8_SB(1, 0), b3, voffB);
            PG8_BAR; PG8_WAIT_L(0); PG8_MMA(0, 1, At, B1); PG8_BAR;
            PG8_LDA(At, 1, 1); PG8_STAGE(PG8_SA(1, 0), a3, voffA);
            PG8_BAR; PG8_WAIT_L(0); PG8_MMA(1, 0, At, B0); PG8_BAR; PG8_SCHED;
            PG8_STAGE(PG8_SB(1, 1), b3 + hstep, voffB);
            PG8_WAIT_V(6); PG8_BAR; PG8_MMA(1, 1, At, B1); PG8_BAR;
            }
        }
        if constexpr (ALIGN_EPI) { if (wr == 0) PG8_BAR; }
        if constexpr (!Epi::AFTER_DRAIN) { E(acc, cur, wr, wc, fr, fq); S.done(cur); }
        if (!has_next) break;
#pragma unroll
        for (int a = 0; a < 2; ++a)
#pragma unroll
            for (int b = 0; b < 2; ++b)
#pragma unroll
                for (int m = 0; m < 4; ++m)
#pragma unroll
                    for (int n = 0; n < 2; ++n) acc[a][b][m][n] = (f32x4){0.f, 0.f, 0.f, 0.f};
        cur = nxt; cA = nA; cB = nB; ++ui;
        if constexpr (ALIGN_EPI) { if (wr == 1) PG8_BAR; }
    }
    PG8_WAIT_V(0);
    if constexpr (!ALIGN_EPI) { if (wr == 0) PG8_BAR; }
    PG8_BAR;
    if constexpr (Epi::AFTER_DRAIN) { E.fused(acc, cur, wr, wc, fr, fq, lds, wid, lane); S.done(cur); }
#undef PG8_SA
#undef PG8_SB
#undef PG8_STAGE
#undef PG8_LDA
#undef PG8_LDB
#undef PG8_MMA
#undef PG8_WAIT_V
#undef PG8_WAIT_L
#undef PG8_BAR
#undef PG8_SCHED
}
}

#define LAS __attribute__((address_space(3)))
typedef unsigned short bf16_t;
typedef short bf16x8 __attribute__((ext_vector_type(8)));
typedef short s16x4 __attribute__((ext_vector_type(4)));
typedef float f32x4 __attribute__((ext_vector_type(4)));
typedef float f32x2 __attribute__((ext_vector_type(2)));
typedef float f32x16 __attribute__((ext_vector_type(16)));
typedef unsigned u32x4 __attribute__((ext_vector_type(4)));
typedef unsigned u32x2 __attribute__((ext_vector_type(2)));

constexpr int MTOK = 65536, DM = 1024, DFF = 2816, NUP = 5632, NINP = 2816, PPITCH = 2560, SEQL = 4096;
constexpr float EPSF = 1e-6f, LOG2E = 1.4426950408889634f;
constexpr size_t MiB = 1u << 20;
constexpr size_t WS_MOD = 1 * MiB, WS_GMOD = 3 * MiB, WS_GATE = 4 * MiB, WS_SB = 5 * MiB, WS_ROWSS = 8 * MiB, WS_KS = 10 * MiB, WS_F2 = 11 * MiB, WS_FG = 12 * MiB,
                 WS_ASEG = 13 * MiB, WS_BSEG = 17 * MiB, WS_WUP = 24 * MiB, WS_WDN = 68 * MiB, WS_WIN = 90 * MiB, WS_WOUT = 101 * MiB, WS_XN = 112 * MiB,
                 WS_H = 240 * MiB, WS_PROJ = 240 * MiB, WS_YU = 592 * MiB, WS_HLOC = 656 * MiB, WS_PCUM = 784 * MiB, WS_YN = 848 * MiB, WS_END = 976 * MiB;
constexpr int LDS_BYTES = 147456;

__device__ __forceinline__ float bf2f(unsigned short v) { return __uint_as_float((unsigned)v << 16); }
__device__ __forceinline__ unsigned f2bf(float f) { unsigned u = __float_as_uint(f); return (u + 0x7fffu + ((u >> 16) & 1u)) >> 16; }
__device__ __forceinline__ unsigned pk2(float lo, float hi) { return pg8::cvt_pk_bf16(lo, hi); }
__device__ __forceinline__ float wave_sum(float v) {
#pragma unroll
    for (int o = 1; o < 64; o <<= 1) v += __shfl_xor(v, o);
    return v;
}
__device__ __forceinline__ float sigmoidf_(float x) { return __builtin_amdgcn_rcpf(1.0f + __builtin_amdgcn_exp2f(-LOG2E * x)); }
#define WAITV(n) asm volatile("s_waitcnt vmcnt(" #n ")" ::: "memory")
#define LBAR() asm volatile("s_waitcnt lgkmcnt(0)\n\ts_barrier" ::: "memory")
#define CFENCE() asm volatile("" ::: "memory")

#ifndef REP_FIN
#define REP_FIN 1
#endif
#ifndef REP_IN
#define REP_IN 1
#endif
#ifndef REP_PREP
#define REP_PREP 1
#endif
#ifndef REP_ATTN
#define REP_ATTN 1
#endif
#ifndef REP_UP
#define REP_UP 1
#endif
struct Args { const float* in[19]; float* out; unsigned char* ws; int ph_lo, ph_hi; };

__device__ __forceinline__ void transpose_item(const float* __restrict__ W, int ldw, int clim, int K, bf16_t* __restrict__ WT, int n0, int c0, int k0, LAS float* scr, int lane) {
    const int col = c0 + (lane & 31);
#pragma unroll 16
    for (int i = 0; i < 32; ++i) { const int kk = 2 * i + (lane >> 5); scr[kk * 33 + (lane & 31)] = (col < clim) ? W[(size_t)(k0 + kk) * ldw + col] : 0.f; }
    asm volatile("s_waitcnt lgkmcnt(0)" ::: "memory");
    const int c = lane & 7;
#pragma unroll
    for (int j = 0; j < 4; ++j) { const int n = (lane >> 3) + 8 * j; const LAS float* s = scr + (8 * c) * 33 + n;
        u32x4 o; o.x = pk2(s[0 * 33], s[1 * 33]); o.y = pk2(s[2 * 33], s[3 * 33]); o.z = pk2(s[4 * 33], s[5 * 33]); o.w = pk2(s[6 * 33], s[7 * 33]);
        *(u32x4*)(WT + (size_t)(n0 + n) * K + k0 + 8 * c) = o; }
    asm volatile("s_waitcnt lgkmcnt(0)" ::: "memory");
}

__device__ __forceinline__ int crow(int r, int hi) { return (r & 3) + 8 * (r >> 2) + 4 * hi; }
__device__ __forceinline__ s16x4 vtr(const LAS unsigned char* p) {
    typedef short v4i16_t __attribute__((ext_vector_type(4)));
    return __builtin_bit_cast(s16x4, __builtin_amdgcn_ds_read_tr16_b64_v4i16((LAS v4i16_t*)p));
}
constexpr int AT_SLOT = 16384, AT_AUX = 3 * AT_SLOT, AT_WSF = AT_AUX + 3 * 512, AT_VOTE = AT_WSF + 8 * 256;
constexpr float C2 = 0.125f * LOG2E;

__device__ __forceinline__ void sb_block(f32x16& X, float& carry, bool band, int kv0  , int qrel, int hi) {
    float lm[16];
#pragma unroll
    for (int r = 0; r < 16; ++r) {
        float z2 = X[r] * C2; z2 = __builtin_fminf(__builtin_fmaxf(z2, -120.f), 120.f);
        const float e = __builtin_amdgcn_exp2f(-z2), sp = __builtin_amdgcn_logf(1.0f + e);
        float l1 = -(sp + z2), lb = -sp;
        if (band) { const int kv = kv0 + (r & 3) + 8 * (r >> 2); const bool valid = kv < qrel; l1 = valid ? l1 : 0.f; lb = valid ? lb : -INFINITY; }
        lm[r] = l1; X[r] = lb;
    }
    float G[4], Gp[4], T[4];
#pragma unroll
    for (int g = 0; g < 4; ++g) { G[g] = (lm[4 * g] + lm[4 * g + 1]) + (lm[4 * g + 2] + lm[4 * g + 3]); Gp[g] = __shfl_xor(G[g], 32); T[g] = G[g] + Gp[g]; }
    float S = carry;
#pragma unroll
    for (int g = 3; g >= 0; --g) {
        const float a3 = S + (hi == 0 ? Gp[g] : 0.f), a2 = a3 + lm[4 * g + 3], a1 = a2 + lm[4 * g + 2], a0 = a1 + lm[4 * g + 1];
        X[4 * g + 3] = __builtin_amdgcn_exp2f(X[4 * g + 3] + a3); X[4 * g + 2] = __builtin_amdgcn_exp2f(X[4 * g + 2] + a2);
        X[4 * g + 1] = __builtin_amdgcn_exp2f(X[4 * g + 1] + a1); X[4 * g] = __builtin_amdgcn_exp2f(X[4 * g] + a0);
        S += T[g];
    }
    carry = S;
}

template <int KIND>
__device__ __forceinline__ void attn_unit(LAS unsigned char* lds, const bf16_t* __restrict__ PROJ, bf16_t* __restrict__ YU, const float* __restrict__ KS,
                                          const float* __restrict__ F2, const float* __restrict__ gqk, int b, int h, int qb) {
    int tid_o = threadIdx.x; asm volatile("" : "+v"(tid_o));
    const int tid = tid_o, lane = tid & 63, r32 = lane & 31, hi = lane >> 5;
    const int wid = __builtin_amdgcn_readfirstlane(tid >> 6);
    const int qcol = (KIND == 0 ? 1024 : 1792) + h * 64, kcol = qcol + 256, vcol = qcol + 512;
    const size_t rowbase = (size_t)b * SEQL; const int q0 = qb * 256, bh = b * 4 + h;
    const int NT = (q0 + 256) / 64;
    const bf16_t* ksrc = PROJ + (rowbase + lane) * PPITCH + kcol + wid * 8;
    const bf16_t* vsrc = PROJ + (rowbase + 16 * (wid & 3) + (lane >> 2)) * PPITCH + vcol + (wid >> 2) * 32 + (lane & 3) * 8;
    const float* axsrc = F2 + (size_t)bh * SEQL + lane;
    u32x4 kreg, vreg; float areg = 0.f;
#define AT_LOAD(it_) do { const int kt_ = NT - 1 - (it_); kreg = *(const u32x4*)(ksrc + (size_t)kt_ * 64 * PPITCH); vreg = *(const u32x4*)(vsrc + (size_t)kt_ * 64 * PPITCH); \
        if (KIND == 1 && wid == 0) areg = axsrc[kt_ * 64]; } while (0)
#define AT_STORE(slot_) do { *(LAS u32x4*)(lds + (slot_) * AT_SLOT + wid * 1024 + lane * 16) = kreg; *(LAS u32x4*)(lds + (slot_) * AT_SLOT + 8192 + wid * 1024 + lane * 16) = vreg; \
        if (KIND == 1 && wid == 0) *(LAS float*)(lds + AT_AUX + (slot_) * 512 + lane * 4) = areg; } while (0)
    const bf16_t* Qw = PROJ + (rowbase + q0 + wid * 32 + r32) * PPITCH + qcol + hi * 8;
    bf16x8 qr[4];
#pragma unroll
    for (int d0 = 0; d0 < 4; ++d0) qr[d0] = *(const bf16x8*)(Qw + d0 * 16);
    AT_LOAD(0);
    float qn2 = 0.f, mref = 0.f;
    if (KIND == 1) {
        float qf[4][8]; float ss = 0.f;
#pragma unroll
        for (int d0 = 0; d0 < 4; ++d0)
#pragma unroll
            for (int i = 0; i < 8; ++i) { qf[d0][i] = bf2f((unsigned short)qr[d0][i]); ss += qf[d0][i] * qf[d0][i]; }
        ss += __shfl_xor(ss, 32);
        const float rs = __builtin_amdgcn_rsqf(ss * (1.0f / 64.0f) + EPSF) * C2;
#pragma unroll
        for (int d0 = 0; d0 < 4; ++d0) {
            const float* gp = gqk + d0 * 16 + hi * 8; float v[8];
#pragma unroll
            for (int i = 0; i < 8; ++i) { v[i] = qf[d0][i] * rs * gp[i] * gp[64 + i]; qn2 += v[i] * v[i]; }
            u32x4 w; w.x = pk2(v[0], v[1]); w.y = pk2(v[2], v[3]); w.z = pk2(v[4], v[5]); w.w = pk2(v[6], v[7]);
            qr[d0] = __builtin_bit_cast(bf16x8, w);
        }
        qn2 += __shfl_xor(qn2, 32);
        mref = F2[(size_t)bh * SEQL + q0 + wid * 32 + r32] + __builtin_fminf(8.08f * __builtin_sqrtf(qn2), 60.0f);
    }
    f32x16 o0, o1;
#pragma unroll
    for (int r = 0; r < 16; ++r) { o0[r] = 0.f; o1[r] = 0.f; }
    float mhat = -1e30f, lsum = 0.f, carry = 0.f;
    LAS float* wsf = (LAS float*)(lds + AT_WSF) + wid * 64;
    LAS unsigned* votes = (LAS unsigned*)(lds + AT_VOTE);
    const int qrel = wid * 32 + r32;
    bool wdone = false;
    AT_STORE(0); LBAR();
    for (int it = 0; it < NT; ++it) {
        const int slot = it & 1;
        if (KIND == 0 && it > 0) {
            const LAS unsigned* vp = votes + ((it - 1) & 1) * 8;
            const unsigned all = vp[0] & vp[1] & vp[2] & vp[3] & vp[4] & vp[5] & vp[6] & vp[7];
            if (all) break;
        }
        if (it + 1 < NT) AT_LOAD(it + 1);
        const int kt = NT - 1 - it, jb = kt - (NT - 4);
        const bool band = jb >= 0;
        const bool active = !(band && 64 * jb > 32 * wid + 31) && !wdone;
        if (active) {
            f32x16 p0, p1;
            __builtin_amdgcn_s_setprio(1);
            { const LAS unsigned char* kb = lds + slot * AT_SLOT + hi * 1024 + r32 * 16;
#pragma unroll
              for (int d0 = 0; d0 < 4; ++d0) {
                  const bf16x8 b0 = *(const LAS bf16x8*)(kb + d0 * 2048), b1 = *(const LAS bf16x8*)(kb + d0 * 2048 + 512);
                  if (d0 == 0) { f32x16 z;
#pragma unroll
                      for (int r = 0; r < 16; ++r) z[r] = (KIND == 1) ? -mref : 0.f;
                      p0 = __builtin_amdgcn_mfma_f32_32x32x16_bf16(b0, qr[0], z, 0, 0, 0); p1 = __builtin_amdgcn_mfma_f32_32x32x16_bf16(b1, qr[0], z, 0, 0, 0); }
                  else { p0 = __builtin_amdgcn_mfma_f32_32x32x16_bf16(b0, qr[d0], p0, 0, 0, 0); p1 = __builtin_amdgcn_mfma_f32_32x32x16_bf16(b1, qr[d0], p1, 0, 0, 0); }
              } }
            __builtin_amdgcn_s_setprio(0);
            if (KIND == 0) {
                sb_block(p1, carry, band, 64 * jb + 32 + 4 * hi, qrel, hi);
                sb_block(p0, carry, band, 64 * jb + 4 * hi, qrel, hi);
            } else {
                const LAS float* ax = (const LAS float*)(lds + AT_AUX + slot * 512);
                f32x2 sacc2 = (f32x2){0.f, 0.f};
#pragma unroll
                for (int g = 0; g < 4; ++g) {
                    const f32x4 f0 = *(const LAS f32x4*)(ax + 8 * g + 4 * hi), f1 = *(const LAS f32x4*)(ax + 32 + 8 * g + 4 * hi);
#pragma unroll
                    for (int i = 0; i < 4; ++i) { p0[4 * g + i] += f0[i]; p1[4 * g + i] += f1[i]; }
                }
                if (band) {
#pragma unroll
                    for (int r = 0; r < 16; ++r) { const int kv = 64 * jb + crow(r, hi); if (kv > qrel) p0[r] = -INFINITY; if (kv + 32 > qrel) p1[r] = -INFINITY; }
                }
#pragma unroll
                for (int r = 0; r < 16; r += 2) {
                    p0[r] = __builtin_amdgcn_exp2f(p0[r]); p0[r + 1] = __builtin_amdgcn_exp2f(p0[r + 1]); p1[r] = __builtin_amdgcn_exp2f(p1[r]); p1[r + 1] = __builtin_amdgcn_exp2f(p1[r + 1]);
                    sacc2 += (f32x2){p0[r], p0[r + 1]}; sacc2 += (f32x2){p1[r], p1[r + 1]};
                }
                lsum += sacc2[0] + sacc2[1];
            }
            u32x4 pw0, pw1, pw2, pw3;
            pw0.x = pk2(p0[0], p0[1]); pw0.y = pk2(p0[2], p0[3]); pw0.z = pk2(p0[4], p0[5]); pw0.w = pk2(p0[6], p0[7]);
            pw1.x = pk2(p0[8], p0[9]); pw1.y = pk2(p0[10], p0[11]); pw1.z = pk2(p0[12], p0[13]); pw1.w = pk2(p0[14], p0[15]);
            pw2.x = pk2(p1[0], p1[1]); pw2.y = pk2(p1[2], p1[3]); pw2.z = pk2(p1[4], p1[5]); pw2.w = pk2(p1[6], p1[7]);
            pw3.x = pk2(p1[8], p1[9]); pw3.y = pk2(p1[10], p1[11]); pw3.z = pk2(p1[12], p1[13]); pw3.w = pk2(p1[14], p1[15]);
            const LAS unsigned char* vb = lds + slot * AT_SLOT + 8192 + ((lane >> 4) & 1) * 32 + (lane & 3) * 8 + (4 * hi + ((lane & 15) >> 2)) * 64;
            s16x4 vlo[8], vhi[8];
#pragma unroll
            for (int i = 0; i < 8; ++i) { vlo[i] = vtr(vb + (i >> 2) * 4096 + (i & 3) * 1024); vhi[i] = vtr(vb + (i >> 2) * 4096 + (i & 3) * 1024 + 512); }
#define VFR(i) (bf16x8){vlo[i][0], vlo[i][1], vlo[i][2], vlo[i][3], vhi[i][0], vhi[i][1], vhi[i][2], vhi[i][3]}
#define PAF(x) __builtin_bit_cast(bf16x8, x)
            __builtin_amdgcn_s_setprio(1);
            o0 = __builtin_amdgcn_mfma_f32_32x32x16_bf16(PAF(pw0), VFR(0), o0, 0, 0, 0); o1 = __builtin_amdgcn_mfma_f32_32x32x16_bf16(PAF(pw0), VFR(4), o1, 0, 0, 0);
            o0 = __builtin_amdgcn_mfma_f32_32x32x16_bf16(PAF(pw1), VFR(1), o0, 0, 0, 0); o1 = __builtin_amdgcn_mfma_f32_32x32x16_bf16(PAF(pw1), VFR(5), o1, 0, 0, 0);
            o0 = __builtin_amdgcn_mfma_f32_32x32x16_bf16(PAF(pw2), VFR(2), o0, 0, 0, 0); o1 = __builtin_amdgcn_mfma_f32_32x32x16_bf16(PAF(pw2), VFR(6), o1, 0, 0, 0);
            o0 = __builtin_amdgcn_mfma_f32_32x32x16_bf16(PAF(pw3), VFR(3), o0, 0, 0, 0); o1 = __builtin_amdgcn_mfma_f32_32x32x16_bf16(PAF(pw3), VFR(7), o1, 0, 0, 0);
            __builtin_amdgcn_s_setprio(0);
#undef VFR
#undef PAF
        }
        if (KIND == 0) { if (active) wdone = __all(carry < -150.0f); if (lane == 0) votes[(it & 1) * 8 + wid] = wdone ? 1u : 0u; }
        if (it + 1 < NT) AT_STORE(slot ^ 1);
        LBAR();
    }
    if (KIND == 1) { lsum += __shfl_xor(lsum, 32); CFENCE(); if (hi == 0) wsf[r32] = lsum; CFENCE(); asm volatile("s_waitcnt lgkmcnt(0)" ::: "memory"); }
    bf16_t* Yw = YU + (rowbase + q0 + wid * 32) * 512 + KIND * 256 + h * 64 + r32;
#pragma unroll
    for (int r = 0; r < 16; ++r) {
        const int orow = crow(r, hi); float sc = 1.0f;
        if (KIND == 1) sc = __builtin_amdgcn_rcpf(wsf[orow]);
        Yw[(size_t)orow * 512] = (bf16_t)f2bf(o0[r] * sc); Yw[(size_t)orow * 512 + 32] = (bf16_t)f2bf(o1[r] * sc);
    }
    LBAR();
#undef AT_LOAD
#undef AT_STORE
}

#define DEFPTRS \
    const __attribute__((address_space(4))) Args* ka_ = (const __attribute__((address_space(4))) Args*)__builtin_amdgcn_kernarg_segment_ptr(); \
    asm volatile("" : "+s"(ka_)); \
    int tid_o_ = threadIdx.x; asm volatile("" : "+v"(tid_o_)); const int tid = tid_o_, lane = tid & 63; (void)lane; \
    unsigned char* ws = ka_->ws; \
    const float* x_in = ka_->in[0]; const float* c_in = ka_->in[1]; const float* w_ada = ka_->in[2]; const float* b_ada = ka_->in[3]; const float* g_norm = ka_->in[4]; \
    const float* w_up = ka_->in[5]; const float* w_dn = ka_->in[6]; const float* w_in = ka_->in[7]; const float* b_fg = ka_->in[8]; const float* conv_w = ka_->in[9]; \
    const float* conv_b = ka_->in[10]; const float* w_rg = ka_->in[11]; const float* b_rg = ka_->in[12]; const float* w_ig = ka_->in[13]; const float* b_ig = ka_->in[14]; \
    const float* lam = ka_->in[15]; const float* g_qk = ka_->in[16]; const float* g_mix = ka_->in[17]; const float* w_out = ka_->in[18]; \
    float* xout = ka_->out; \
    float* MOD = (float*)(ws + WS_MOD); float* GMOD = (float*)(ws + WS_GMOD); float* GATE = (float*)(ws + WS_GATE); float* SBV = (float*)(ws + WS_SB); \
    float* ROWSS = (float*)(ws + WS_ROWSS); float* KS = (float*)(ws + WS_KS); float* F2 = (float*)(ws + WS_F2); float* FG = (float*)(ws + WS_FG); \
    float* ASEG = (float*)(ws + WS_ASEG); float* BSEG = (float*)(ws + WS_BSEG); float* TSEGA = (float*)(ws + 21 * MiB); float* TSEGB = (float*)(ws + 22 * MiB); \
    bf16_t* WUP = (bf16_t*)(ws + WS_WUP); bf16_t* WDN = (bf16_t*)(ws + WS_WDN); bf16_t* WIN = (bf16_t*)(ws + WS_WIN); bf16_t* WOUT = (bf16_t*)(ws + WS_WOUT); \
    bf16_t* XN = (bf16_t*)(ws + WS_XN); bf16_t* HB = (bf16_t*)(ws + WS_H); bf16_t* PROJ = (bf16_t*)(ws + WS_PROJ); bf16_t* YU = (bf16_t*)(ws + WS_YU); \
    bf16_t* HLOC = (bf16_t*)(ws + WS_HLOC); bf16_t* PCUM = (bf16_t*)(ws + WS_PCUM); bf16_t* YN = (bf16_t*)(ws + WS_YN);
#define XB_TMO      128
#define XB_XCNT(j)  (256  + 64 * (j))
#define XB_XSUB(j)  (1280 + 64 * (j))
#define XB_XGEN(j)  (2304 + 64 * (j))
#define XB_TOP      3328
#define XB_TOPGEN   3392
#define XCD_BAR_WORDS 3456
#define XB_SPIN_CAP (1u << 18)

__device__ __forceinline__ unsigned xb_ld(unsigned* p)              { return __hip_atomic_load(p, __ATOMIC_RELAXED, __HIP_MEMORY_SCOPE_AGENT); }
__device__ __forceinline__ unsigned xb_add(unsigned* p, unsigned v) { return __hip_atomic_fetch_add(p, v, __ATOMIC_RELAXED, __HIP_MEMORY_SCOPE_AGENT); }
__device__ __forceinline__ unsigned xb_xcc_id() { return (unsigned)__builtin_amdgcn_s_getreg((3 << 11) | 20) & 0xFu; }
#define XB_SPIN(cond, bar) do { unsigned _sp = 0; while (cond) { __builtin_amdgcn_s_sleep(1); \
    if ((++_sp & 255u) == 0u) { if (xb_ld(&(bar)[XB_TMO])) break; if (_sp > XB_SPIN_CAP) { atomicAdd(&(bar)[XB_TMO], 1u); break; } } } } while (0)

struct XcdBarrier {
    unsigned* bar; unsigned x;
    volatile LAS unsigned* st;
};

__device__ __forceinline__ XcdBarrier xcd_barrier_post(unsigned* bar, volatile LAS unsigned* st) {
    XcdBarrier b; b.bar = bar; b.x = xb_xcc_id(); b.st = st;
    if (threadIdx.x == 0) (void)xb_add(&bar[XB_XCNT(b.x)], 1u);
    return b;
}
__device__ __forceinline__ void xcd_barrier_complete(unsigned* bar, unsigned x, unsigned& nloc, unsigned& nx) {
    const unsigned G = gridDim.x * gridDim.y * gridDim.z;
    unsigned sum, cnt, mine, sp = 0u;
    for (;;) {
        sum = 0u; cnt = 0u; mine = 0u;
#pragma unroll
        for (unsigned j = 0; j < 16; ++j) { const unsigned c = xb_ld(&bar[XB_XCNT(j)]); sum += c; cnt += (c > 0u) ? 1u : 0u; mine = (j == x) ? c : mine; }
        if (sum == G) break;
        __builtin_amdgcn_s_sleep(1);
        if ((++sp & 255u) == 0u) { if (xb_ld(&bar[XB_TMO])) break; if (sp > XB_SPIN_CAP) { atomicAdd(&bar[XB_TMO], 1u); break; } }
    }
    nloc = mine > 0u ? mine : 1u; nx = cnt > 0u ? cnt : 1u;
}

__device__ __forceinline__ void xcd_barrier(const XcdBarrier& b) {
    asm volatile("s_waitcnt vmcnt(0)" ::: "memory");
    __syncthreads();
    if (threadIdx.x == 0) {
        unsigned* bar = b.bar;
        __builtin_amdgcn_s_waitcnt(0);
        unsigned nloc = b.st[0], nx = b.st[1];
        if (nloc == 0u) { xcd_barrier_complete(bar, b.x, nloc, nx); b.st[0] = nloc; b.st[1] = nx; }
        const unsigned old = xb_add(&bar[XB_XSUB(b.x)], 1u);
        const unsigned gen = old / nloc;
        if (old + 1u == (gen + 1u) * nloc) {
            __builtin_amdgcn_fence(__ATOMIC_RELEASE, "agent");
            asm volatile("s_waitcnt vmcnt(0)" ::: "memory");
            const unsigned og = xb_add(&bar[XB_TOP], 1u);
            const unsigned tg = og / nx;
            if (og + 1u == (tg + 1u) * nx) xb_add(&bar[XB_TOPGEN], 1u);
            else XB_SPIN(xb_ld(&bar[XB_TOPGEN]) == tg, bar);
            __builtin_amdgcn_fence(__ATOMIC_ACQUIRE, "agent");
            xb_add(&bar[XB_XGEN(b.x)], 1u);
            asm volatile("s_waitcnt vmcnt(0)" ::: "memory");
        } else {
            XB_SPIN(xb_ld(&bar[XB_XGEN(b.x)]) == gen, bar);
            __builtin_amdgcn_fence(__ATOMIC_ACQUIRE, "agent");
            asm volatile("s_waitcnt vmcnt(0)" ::: "memory");
        }
    }
    __syncthreads();
}

__global__ void __launch_bounds__(512) mk_fwd(Args args) {
    extern __shared__ __attribute__((aligned(16))) unsigned char lds_raw[];
    LAS unsigned char* lds = (LAS unsigned char*)lds_raw;
    cg::grid_group grid = cg::this_grid();
    const int wave = __builtin_amdgcn_readfirstlane(threadIdx.x >> 6);
    const int G = gridDim.x; const int bx = blockIdx.x;
    const int vcu = (G % 8 == 0) ? (bx % 8) * (G / 8) + bx / 8 : bx;
    const int gw = vcu * 8 + wave, NGW = G * 8;
    const int lo = args.ph_lo, hi_ph = args.ph_hi;
    volatile LAS unsigned* MISC = (volatile LAS unsigned*)(lds + 131072 + 320);
    if (threadIdx.x < 16) MISC[threadIdx.x] = 0u;
    __syncthreads();
    XcdBarrier xbar = xcd_barrier_post((unsigned*)args.ws, MISC + 8);
    int ph = 0;
#define PH_ON (ph >= lo && ph < hi_ph)
#ifdef REP_SYNC
#define SYNC_EXTRA grid.sync(); asm volatile("" ::: "memory");
#else
#define SYNC_EXTRA
#endif
#define PH_NEXT do { ++ph; if (ph > lo && ph < hi_ph) { asm volatile("s_waitcnt vmcnt(0) lgkmcnt(0)" ::: "memory"); if (ph == 1) grid.sync(); else xcd_barrier(xbar); asm volatile("" ::: "memory"); SYNC_EXTRA } } while (0)

#ifdef REP_PRO
    int rp_ = 0; pro_again:
#endif
    if (PH_ON) { DEFPTRS
        for (int i = bx * 512 + tid; i < 5 * MTOK; i += G * 512) ROWSS[MTOK + i] = 0.f;
        LAS float* cact = (LAS float*)lds;
        LAS float* red = (LAS float*)(lds + 65536);
        for (int i = tid; i < 16 * 1024; i += 512) { const int b = i >> 10, k = i & 1023; const float v = c_in[i]; cact[k * 16 + b] = v * sigmoidf_(v); }
        __syncthreads();
        for (int task = bx; task < 288; task += G) {
            const int l = task / 144, n0 = (task % 144) * 64;
            float acc[16];
#pragma unroll
            for (int b = 0; b < 16; ++b) acc[b] = 0.f;
            const float* wp = w_ada + (size_t)l * 1024 * 9216 + n0 + lane;
#pragma unroll 1
            for (int k0 = wave * 128; k0 < wave * 128 + 128; k0 += 16) {
                float wv[16];
#pragma unroll
                for (int j = 0; j < 16; ++j) wv[j] = wp[(size_t)(k0 + j) * 9216];
                CFENCE();
#pragma unroll
                for (int j = 0; j < 16; ++j) { const int k = k0 + j; const float w = wv[j];
                    const f32x4 c0 = *(const LAS f32x4*)(cact + k * 16), c1 = *(const LAS f32x4*)(cact + k * 16 + 4), c2 = *(const LAS f32x4*)(cact + k * 16 + 8), c3 = *(const LAS f32x4*)(cact + k * 16 + 12);
#pragma unroll
                    for (int i = 0; i < 4; ++i) { acc[i] += c0[i] * w; acc[4 + i] += c1[i] * w; acc[8 + i] += c2[i] * w; acc[12 + i] += c3[i] * w; }
                    if ((j & 3) == 3) CFENCE(); }
            }
#pragma unroll
            for (int b = 0; b < 16; ++b) red[(wave * 16 + b) * 64 + lane] = acc[b];
            __syncthreads();
            for (int o = tid; o < 1024; o += 512) { const int b = o >> 6, ln = o & 63; float s = 0.f;
#pragma unroll
                for (int w = 0; w < 8; ++w) s += red[(w * 16 + b) * 64 + ln];
                MOD[((size_t)l * 16 + b) * 9216 + n0 + ln] = s + b_ada[l * 9216 + n0 + ln]; }
            __syncthreads();
        }
    }
    PH_NEXT;
    if (PH_ON) { DEFPTRS
        for (int i = bx * 512 + tid; i < 2 * 3 * 16 * 1024; i += G * 512) {
            const int k = i & 1023, b = (i >> 10) & 15, lj = i >> 14, l = lj / 3, j = lj % 3;
            const float* mp = MOD + ((size_t)l * 16 + b) * 9216 + j * 3072;
            GMOD[i] = g_norm[(l * 3 + j) * 1024 + k] * (1.0f + mp[1024 + k]);
            GATE[i] = (j == 1 ? 1.0f : 0.5f) * (1.0f + mp[2048 + k]);
        }
        LAS float* scr = (LAS float*)(lds + wave * 8448);
        constexpr int I_UP = 16 * 176, I_DN = 44 * 32, I_IN = 16 * 88, I_OUT = 16 * 32;
        constexpr int NIT = 4 * I_UP + 4 * I_DN + 2 * I_IN + 2 * I_OUT;
        for (int it = gw; it < NIT; it += NGW) {
            int r = it;
            if (r < 4 * I_UP) { const int mat = r / I_UP; r -= mat * I_UP; const int kb = r / 176, nb = r % 176, n0 = nb * 32;
                const int c0 = ((n0 >> 7) & 1) * DFF + (n0 >> 8) * 128 + (n0 & 127);
                transpose_item(w_up + (size_t)mat * DM * NUP, NUP, NUP, DM, WUP + (size_t)mat * NUP * DM, n0, c0, kb * 64, scr, lane); continue; }
            r -= 4 * I_UP;
            if (r < 4 * I_DN) { const int mat = r / I_DN; r -= mat * I_DN; const int kb = r / 32, nb = r % 32;
                transpose_item(w_dn + (size_t)mat * DFF * DM, DM, DM, DFF, WDN + (size_t)mat * DM * DFF, nb * 32, nb * 32, kb * 64, scr, lane); continue; }
            r -= 4 * I_DN;
            if (r < 2 * I_IN) { const int mat = r / I_IN; r -= mat * I_IN; const int kb = r / 88, nb = r % 88;
                transpose_item(w_in + (size_t)mat * DM * 2564, 2564, 2564, DM, WIN + (size_t)mat * NINP * DM, nb * 32, nb * 32, kb * 64, scr, lane); continue; }
            r -= 2 * I_IN;
            { const int mat = r / I_OUT; r -= mat * I_OUT; const int kb = r / 32, nb = r % 32;
                transpose_item(w_out + (size_t)mat * DM * DM, DM, DM, DM, WOUT + (size_t)mat * DM * DM, nb * 32, nb * 32, kb * 64, scr, lane); }
        }
        for (int m0 = gw; m0 < MTOK; m0 += 2 * NGW) {
            const int m1 = m0 + NGW;
            const f32x4* gp = (const f32x4*)(g_norm) + lane;
            const f32x4* xr0 = (const f32x4*)(x_in + (size_t)m0 * DM) + lane; const f32x4* xr1 = (const f32x4*)(x_in + (size_t)m1 * DM) + lane;
            f32x4 v0[4], v1[4];
#pragma unroll
            for (int j = 0; j < 4; ++j) { v0[j] = xr0[64 * j]; v1[j] = xr1[64 * j]; }
            const f32x4* sp0 = (const f32x4*)(MOD + (size_t)(m0 >> 12) * 9216 + 1024) + lane; const f32x4* sp1 = (const f32x4*)(MOD + (size_t)(m1 >> 12) * 9216 + 1024) + lane;
            float s0 = 0.f, s1 = 0.f; u32x2* o0 = (u32x2*)(XN + (size_t)m0 * DM) + lane; u32x2* o1 = (u32x2*)(XN + (size_t)m1 * DM) + lane;
#pragma unroll
            for (int j = 0; j < 4; ++j) { const f32x4 g = gp[64 * j];
                { const f32x4 v = v0[j]; s0 += (v[0] * v[0] + v[1] * v[1]) + (v[2] * v[2] + v[3] * v[3]); const f32x4 a = v * g * (sp0[64 * j] + 1.0f); u32x2 w; w.x = pk2(a[0], a[1]); w.y = pk2(a[2], a[3]); o0[64 * j] = w; }
                { const f32x4 v = v1[j]; s1 += (v[0] * v[0] + v[1] * v[1]) + (v[2] * v[2] + v[3] * v[3]); const f32x4 a = v * g * (sp1[64 * j] + 1.0f); u32x2 w; w.x = pk2(a[0], a[1]); w.y = pk2(a[2], a[3]); o1[64 * j] = w; } }
            s0 = wave_sum(s0); s1 = wave_sum(s1);
            if (lane == 0) { ROWSS[m0] = s0; ROWSS[m1] = s1; }
        }
    }
    PH_NEXT;
    if (PH_ON) { DEFPTRS
        LAS float* sh = (LAS float*)lds;
        for (int combo = 0; combo < 6; ++combo) {
            const int l = combo / 3, j = combo % 3;
            __syncthreads();
            for (int i = tid; i < 16 * 1024; i += 512) { const int b = i >> 10, k = i & 1023; sh[i] = MOD[((size_t)l * 16 + b) * 9216 + j * 3072 + k]; }
            __syncthreads();
            const bf16_t* Wt = (j == 1) ? WIN + (size_t)l * NINP * DM : WUP + (size_t)(l * 2 + (j == 2 ? 1 : 0)) * NUP * DM;
            const int N = (j == 1) ? NINP : NUP;
            float* dst = SBV + (size_t)combo * 16 * 5632;
            for (int n = gw; n < N; n += NGW) {
                float w[16];
#pragma unroll
                for (int c = 0; c < 4; ++c) { const u32x2 q = *(const u32x2*)(Wt + (size_t)n * DM + c * 256 + lane * 4);
                    w[4 * c] = __uint_as_float(q.x << 16); w[4 * c + 1] = __uint_as_float(q.x & 0xffff0000u); w[4 * c + 2] = __uint_as_float(q.y << 16); w[4 * c + 3] = __uint_as_float(q.y & 0xffff0000u); }
                float sv[16];
#pragma unroll
                for (int b = 0; b < 16; ++b) { float s = 0.f;
#pragma unroll
                    for (int c = 0; c < 4; ++c) { const f32x4 v = *(const LAS f32x4*)(sh + b * 1024 + c * 256 + lane * 4); s += (w[4 * c] * v[0] + w[4 * c + 1] * v[1]) + (w[4 * c + 2] * v[2] + w[4 * c + 3] * v[3]); }
                    sv[b] = s; if ((b & 3) == 3) CFENCE(); }
                float t8[8], t4[4], t2[2];
#pragma unroll
                for (int i = 0; i < 8; ++i) { const float snd = (lane & 32) ? sv[i] : sv[i + 8], kp = (lane & 32) ? sv[i + 8] : sv[i]; t8[i] = kp + __shfl_xor(snd, 32); }
#pragma unroll
                for (int i = 0; i < 4; ++i) { const float snd = (lane & 16) ? t8[i] : t8[i + 4], kp = (lane & 16) ? t8[i + 4] : t8[i]; t4[i] = kp + __shfl_xor(snd, 16); }
#pragma unroll
                for (int i = 0; i < 2; ++i) { const float snd = (lane & 8) ? t4[i] : t4[i + 2], kp = (lane & 8) ? t4[i + 2] : t4[i]; t2[i] = kp + __shfl_xor(snd, 8); }
                float t1; { const float snd = (lane & 4) ? t2[0] : t2[1], kp = (lane & 4) ? t2[1] : t2[0]; t1 = kp + __shfl_xor(snd, 4); }
                t1 += __shfl_xor(t1, 2); t1 += __shfl_xor(t1, 1);
                const int bsel = ((lane >> 5) & 1) * 8 + ((lane >> 4) & 1) * 4 + ((lane >> 3) & 1) * 2 + ((lane >> 2) & 1);
                if ((lane & 3) == 0) dst[(size_t)bsel * 5632 + n] = t1;
            }
        }
        __syncthreads();
    }
    PH_NEXT;

#ifdef REP_PRO
    if (rp_ == 0) { rp_ = 1; ph = 0; goto pro_again; }
#endif
#pragma unroll 1
    for (int f = 0; f < 4; ++f) {
        const int l = f >> 1, s = f & 1;
        if (s == 1) {
            if (PH_ON) { DEFPTRS
                pg8::Gemm g{XN, WIN + (size_t)l * NINP * DM, MTOK, NINP, DM}; pg8::StaticOrder S; S.init(MTOK, NINP, G, bx);
                pg8::EpiIn E{PROJ, FG, ROWSS + (size_t)(l * 3 + 1) * MTOK, SBV + (size_t)(l * 3 + 1) * 16 * 5632, lds + 131072 + 2048};
#ifndef NO_G_IN
                for (int rep_ = 0; rep_ < REP_IN; ++rep_) {
                pg8::gemm_phase<pg8::EpiIn, pg8::StaticOrder, true, true>(lds, g, S, E); }
#endif
            }
            PH_NEXT;
            if (PH_ON) { DEFPTRS
#ifndef NO_PREP
                {
                    const int blk = vcu & 7, n = lane & 31, hi = lane >> 5;
                    LAS unsigned char* wfl = lds;
                    LAS float* xs = (LAS float*)(lds + 16384 + wave * 13568);
                    LAS unsigned char* ub = lds + 16384 + wave * 13568 + 8960;
#pragma unroll
                    for (int q = 0; q < 2; ++q) { const int f = wave * 2 + q, gt = f >> 3, nb = (f >> 2) & 1, d0 = f & 3;
                        const float* wsrc = (gt ? w_ig : w_rg) + ((size_t)(l * 8 + blk) * 64 + 16 * d0 + 8 * hi) * 64 + nb * 32 + n;
                        u32x4 w; w.x = pk2(wsrc[0], wsrc[64]); w.y = pk2(wsrc[128], wsrc[192]); w.z = pk2(wsrc[256], wsrc[320]); w.w = pk2(wsrc[384], wsrc[448]);
                        *(LAS u32x4*)(wfl + f * 1024 + lane * 16) = w; }
                    __syncthreads();
                    float br[2], bi[2], cb[2], cw[2][4], c8[2];
#pragma unroll
                    for (int nb = 0; nb < 2; ++nb) { const int ch = blk * 64 + nb * 32 + n;
                        br[nb] = b_rg[l * 512 + ch]; bi[nb] = b_ig[l * 512 + ch]; cb[nb] = conv_b[l * 512 + ch];
#pragma unroll
                        for (int k = 0; k < 4; ++k) cw[nb][k] = conv_w[(l * 4 + k) * 512 + ch];
                        const float lmv = lam[l * 512 + ch];
                        c8[nb] = -8.0f * LOG2E * (__builtin_fmaxf(-lmv, 0.f) + log1pf(expf(-fabsf(lmv)))); }
                    for (int segi = (vcu >> 3) * 8 + wave; segi < REP_PREP * (MTOK / 32); segi += (G >> 3) * 8) { const int seg = segi & (MTOK / 32 - 1);
                        const int row0 = seg * 32; const bool first = (row0 & (SEQL - 1)) == 0;
                        const bf16_t* xp = PROJ + (size_t)row0 * PPITCH + blk * 64;
                        CFENCE();
#pragma unroll
                        for (int t = 0; t < 35; ++t) { float v = 0.f; if (t >= 3 || !first) v = bf2f((xp + ((long)t - 3) * PPITCH)[lane]); xs[t * 64 + lane] = v; }
                        CFENCE();
#pragma unroll
                        for (int nb = 0; nb < 2; ++nb)
#pragma unroll
                            for (int g = 0; g < 4; ++g) { const LAS float* xb = xs + (8 * g + 4 * hi) * 64 + nb * 32 + n; float xv[7];
#pragma unroll
                                for (int j = 0; j < 7; ++j) xv[j] = xb[j * 64];
#pragma unroll
                                for (int i = 0; i < 4; ++i) { const float uu = cb[nb] + cw[nb][0] * xv[i] + cw[nb][1] * xv[i + 1] + cw[nb][2] * xv[i + 2] + cw[nb][3] * xv[i + 3];
                                    *(LAS unsigned short*)(ub + (8 * g + 4 * hi + i) * 144 + (nb * 32 + n) * 2) = (unsigned short)f2bf(uu); }
                                __builtin_amdgcn_sched_barrier(0); }
                        CFENCE();
                        bf16x8 af[4];
#pragma unroll
                        for (int d0 = 0; d0 < 4; ++d0) af[d0] = *(const LAS bf16x8*)(ub + n * 144 + (16 * d0 + 8 * hi) * 2);
#pragma unroll
                        for (int nb = 0; nb < 2; ++nb) {
                            f32x16 arx, aix;
#pragma unroll
                            for (int r = 0; r < 16; ++r) { arx[r] = br[nb]; aix[r] = bi[nb]; }
#pragma unroll
                            for (int d0 = 0; d0 < 4; ++d0) { const bf16x8 w0 = *(const LAS bf16x8*)(wfl + ((0 * 2 + nb) * 4 + d0) * 1024 + lane * 16), w1 = *(const LAS bf16x8*)(wfl + ((1 * 2 + nb) * 4 + d0) * 1024 + lane * 16);
                                                             arx = __builtin_amdgcn_mfma_f32_32x32x16_bf16(af[d0], w0, arx, 0, 0, 0);
                                                             aix = __builtin_amdgcn_mfma_f32_32x32x16_bf16(af[d0], w1, aix, 0, 0, 0); }
                            CFENCE(); __builtin_amdgcn_sched_barrier(0);
#pragma unroll
                            for (int r = 0; r < 16; ++r) {
                                float uu; { const LAS float* xb = xs + (8 * (r >> 2) + 4 * hi + (r & 3)) * 64 + nb * 32 + n;
                                    uu = cb[nb] + cw[nb][0] * xb[0] + cw[nb][1] * xb[64] + cw[nb][2] * xb[128] + cw[nb][3] * xb[192]; }
                                const float rg = sigmoidf_(arx[r]), ig = sigmoidf_(aix[r]);
                                const float la2 = c8[nb] * rg, a = __builtin_amdgcn_exp2f(la2);
                                const float xx = 2.0f * 0.6931471805599453f * la2;
                                const float om = (xx > -0.25f) ? -xx * (1.0f + xx * 0.5f * (1.0f + xx * (1.0f / 3.0f) * (1.0f + xx * 0.25f * (1.0f + xx * 0.2f)))) : 1.0f - a * a;
                                arx[r] = a; aix[r] = __builtin_sqrtf(om) * ig * uu;
                            }
                            float H = 0.f, P = 1.f;
                            const int ch = blk * 64 + nb * 32 + n;
                            bf16_t* hl = HLOC + (size_t)(row0 + 4 * hi) * 512 + ch; bf16_t* pc = PCUM + (size_t)(row0 + 4 * hi) * 512 + ch;
#pragma unroll
                            for (int g = 0; g < 4; ++g) {
                                const float a0 = arx[4 * g], a1 = arx[4 * g + 1], a2 = arx[4 * g + 2], a3 = arx[4 * g + 3];
                                const float b0 = aix[4 * g], b1 = aix[4 * g + 1], b2 = aix[4 * g + 2], b3 = aix[4 * g + 3];
                                const float Ao = (a0 * a1) * (a2 * a3), Bo = ((b0 * a1 + b1) * a2 + b2) * a3 + b3;
                                const float Ap = __shfl_xor(Ao, 32), Bp = __shfl_xor(Bo, 32);
                                const float A1 = hi ? Ap : Ao, B1 = hi ? Bp : Bo, A2 = hi ? Ao : Ap, B2 = hi ? Bo : Bp;
                                const float Hm = A1 * H + B1, Pm = A1 * P;
                                float h = hi ? Hm : H, p = hi ? Pm : P;
                                H = A2 * Hm + B2; P = A2 * Pm;
                                bf16_t* hg = hl + (size_t)g * 8 * 512; bf16_t* pg = pc + (size_t)g * 8 * 512; asm volatile("" : "+v"(hg), "+v"(pg));
                                h = a0 * h + b0; p *= a0; hg[0 * 512] = (bf16_t)f2bf(h); pg[0 * 512] = (bf16_t)f2bf(p);
                                h = a1 * h + b1; p *= a1; hg[1 * 512] = (bf16_t)f2bf(h); pg[1 * 512] = (bf16_t)f2bf(p);
                                h = a2 * h + b2; p *= a2; hg[2 * 512] = (bf16_t)f2bf(h); pg[2 * 512] = (bf16_t)f2bf(p);
                                h = a3 * h + b3; p *= a3; hg[3 * 512] = (bf16_t)f2bf(h); pg[3 * 512] = (bf16_t)f2bf(p);
                            }
                            if (hi == 0) { ASEG[(size_t)seg * 512 + ch] = P; BSEG[(size_t)seg * 512 + ch] = H; }
                            CFENCE(); __builtin_amdgcn_sched_barrier(0);
                        }
                    }
                }
                for (int row = gw; row < MTOK; row += NGW) {
                    const u32x2 q = *(const u32x2*)(PROJ + (size_t)row * PPITCH + 2048 + lane * 4);
                    const float a0 = __uint_as_float(q.x << 16), a1 = __uint_as_float(q.x & 0xffff0000u), a2 = __uint_as_float(q.y << 16), a3 = __uint_as_float(q.y & 0xffff0000u);
                    float ss = (a0 * a0 + a1 * a1) + (a2 * a2 + a3 * a3);
                    ss += __shfl_xor(ss, 1); ss += __shfl_xor(ss, 2); ss += __shfl_xor(ss, 4); ss += __shfl_xor(ss, 8);
                    const float rk = __builtin_amdgcn_rsqf(ss * (1.0f / 64.0f) + EPSF);
                    u32x2 kn; kn.x = pk2(a0 * rk, a1 * rk); kn.y = pk2(a2 * rk, a3 * rk);
                    *(u32x2*)(PROJ + (size_t)row * PPITCH + 2048 + lane * 4) = kn;
                }
                for (int chn = vcu; chn < 64; chn += G) {
                    const int b = chn >> 2, h = chn & 3; const float bf = b_fg[l * 4 + h];
                    const int t0 = wave * 512 + lane * 8;
                    const float* fp = FG + ((size_t)b * SEQL + t0) * 4 + h;
                    float lf[8], tot = 0.f;
#pragma unroll
                    for (int i = 0; i < 8; ++i) { const float v = fp[i * 4] + bf; lf[i] = __builtin_fminf(v, 0.f) - log1pf(expf(-fabsf(v))); tot += lf[i]; }
                    float inc = tot;
#pragma unroll
                    for (int o = 1; o < 64; o <<= 1) { const float t_ = __shfl_up(inc, o); if (lane >= o) inc += t_; }
                    LAS float* wt = (LAS float*)(lds + 16384 + 8 * 13568);
                    __syncthreads();
                    if (lane == 63) wt[wave] = inc;
                    __syncthreads();
                    float run = inc - tot;
                    for (int w = 0; w < wave; ++w) run += wt[w];
                    f32x4 o0, o1;
                    run += lf[0]; o0[0] = -run * LOG2E; run += lf[1]; o0[1] = -run * LOG2E; run += lf[2]; o0[2] = -run * LOG2E; run += lf[3]; o0[3] = -run * LOG2E;
                    run += lf[4]; o1[0] = -run * LOG2E; run += lf[5]; o1[1] = -run * LOG2E; run += lf[6]; o1[2] = -run * LOG2E; run += lf[7]; o1[3] = -run * LOG2E;
                    float* op = F2 + (size_t)chn * SEQL + t0;
                    *(f32x4*)op = o0; *(f32x4*)(op + 4) = o1;
                }
#endif
                __syncthreads();
            }
            PH_NEXT;
            if (PH_ON) { DEFPTRS
#ifndef NO_ATTN
                for (int rep_ = 0; rep_ < REP_ATTN; ++rep_)
                for (int tt = vcu; tt < 256; tt += G) { const int ch = tid; float A = 1.f, B = 0.f;
#pragma unroll
                    for (int s8 = 0; s8 < 8; ++s8) { const float as_ = ASEG[(size_t)(tt * 8 + s8) * 512 + ch], bs_ = BSEG[(size_t)(tt * 8 + s8) * 512 + ch]; A = as_ * A; B = as_ * B + bs_; }
                    TSEGA[(size_t)tt * 512 + ch] = A; TSEGB[(size_t)tt * 512 + ch] = B; }
                for (int vw = vcu; vw < 256; vw += G) {
                    const int bh = vw >> 2, s4 = vw & 3, b = bh >> 2, h = bh & 3;
#pragma unroll 1
                    for (int i = 0; i < 4; ++i) { const int qb = (i == 0) ? s4 : (i == 1) ? 7 - s4 : (i == 2) ? 8 + s4 : 15 - s4;
#ifndef NO_FOX
                        attn_unit<1>(lds, PROJ, YU, KS, F2, g_qk + l * 128, b, h, qb);
#endif
 }
#pragma unroll 1
                    for (int i = 0; i < 4; ++i) { const int qb = (i == 0) ? s4 : (i == 1) ? 7 - s4 : (i == 2) ? 8 + s4 : 15 - s4;
#ifndef NO_SB
                        attn_unit<0>(lds, PROJ, YU, KS, F2, g_qk + l * 128, b, h, qb);
#endif
 }
                }
#endif
            }
            PH_NEXT;
            if (PH_ON) { DEFPTRS
                LAS float* hin = (LAS float*)lds;
                const f32x4 gm0 = *(const f32x4*)(g_mix + l * 1024 + lane * 8), gm1 = *(const f32x4*)(g_mix + l * 1024 + lane * 8 + 4);
                const f32x4 gx0 = *(const f32x4*)(g_mix + l * 1024 + 512 + lane * 8), gx1 = *(const f32x4*)(g_mix + l * 1024 + 512 + lane * 8 + 4);
                for (int tti = vcu; tti < REP_FIN * 256; tti += G) { const int tt = tti & 255;
                    __syncthreads();
                    { const int ch = tid, seg0 = (tt >> 4) * 128, nb = (tt & 15) * 8; float Hc = 0.f;
#pragma unroll 5
                      for (int t_ = (tt & ~15); t_ < tt; ++t_) Hc = TSEGA[(size_t)t_ * 512 + ch] * Hc + TSEGB[(size_t)t_ * 512 + ch];
#pragma unroll
                      for (int s8 = 0; s8 < 8; ++s8) { hin[s8 * 512 + ch] = Hc; Hc = ASEG[(size_t)(seg0 + nb + s8) * 512 + ch] * Hc + BSEG[(size_t)(seg0 + nb + s8) * 512 + ch]; } }
                    __syncthreads();
                    const f32x4 hi0 = *(const LAS f32x4*)(hin + wave * 512 + lane * 8), hi1 = *(const LAS f32x4*)(hin + wave * 512 + lane * 8 + 4);
#pragma unroll 2
                    for (int t = 0; t < 32; ++t) {
                        const size_t row = (size_t)tt * 256 + wave * 32 + t;
                        const u32x4 hq = *(const u32x4*)(HLOC + row * 512 + lane * 8);
                        const u32x4 pq = *(const u32x4*)(PCUM + row * 512 + lane * 8);
                        const u32x4 gq = *(const u32x4*)(PROJ + row * PPITCH + 512 + lane * 8);
                        const u32x4 yq = *(const u32x4*)(YU + row * 512 + lane * 8);
                        float y[8], yu[8]; float ss = 0.f, s2 = 0.f;
#pragma unroll
                        for (int i = 0; i < 8; ++i) {
                            const unsigned pw = pq[i >> 1], gw_ = gq[i >> 1], yw = yq[i >> 1];
                            const float p = (i & 1) ? __uint_as_float(pw & 0xffff0000u) : __uint_as_float(pw << 16);
                            const float gg = (i & 1) ? __uint_as_float(gw_ & 0xffff0000u) : __uint_as_float(gw_ << 16);
                            yu[i] = (i & 1) ? __uint_as_float(yw & 0xffff0000u) : __uint_as_float(yw << 16);
                            const unsigned hw = hq[i >> 1]; const float hlv = (i & 1) ? __uint_as_float(hw & 0xffff0000u) : __uint_as_float(hw << 16);
                            const float hh = hlv + p * (i < 4 ? hi0[i & 3] : hi1[i & 3]);
                            const float inner = 0.7978845608028654f * (gg + 0.044715f * gg * gg * gg);
                            const float ge = gg * __builtin_amdgcn_rcpf(1.0f + __builtin_amdgcn_exp2f(-2.0f * LOG2E * inner));
                            y[i] = hh * ge; ss += y[i] * y[i]; s2 += yu[i] * yu[i];
                        }
                        ss = wave_sum(ss);
                        s2 += __shfl_xor(s2, 1); s2 += __shfl_xor(s2, 2); s2 += __shfl_xor(s2, 4); s2 += __shfl_xor(s2, 8); s2 += __shfl_xor(s2, 16);
                        const float rl = __builtin_amdgcn_rsqf(ss * (1.0f / 512.0f) + EPSF), rx = __builtin_amdgcn_rsqf(s2 * (1.0f / 256.0f) + EPSF);
                        u32x4 o1, o2;
                        o1.x = pk2(y[0] * rl * gm0[0], y[1] * rl * gm0[1]); o1.y = pk2(y[2] * rl * gm0[2], y[3] * rl * gm0[3]);
                        o1.z = pk2(y[4] * rl * gm1[0], y[5] * rl * gm1[1]); o1.w = pk2(y[6] * rl * gm1[2], y[7] * rl * gm1[3]);
                        o2.x = pk2(yu[0] * rx * gx0[0], yu[1] * rx * gx0[1]); o2.y = pk2(yu[2] * rx * gx0[2], yu[3] * rx * gx0[3]);
                        o2.z = pk2(yu[4] * rx * gx1[0], yu[5] * rx * gx1[1]); o2.w = pk2(yu[6] * rx * gx1[2], yu[7] * rx * gx1[3]);
                        *(u32x4*)(YN + row * 1024 + lane * 8) = o1; *(u32x4*)(YN + row * 1024 + 512 + lane * 8) = o2;
                    }
                }
                __syncthreads();
            }
            PH_NEXT;
            if (PH_ON) { DEFPTRS
                pg8::Gemm g{YN, WOUT + (size_t)l * DM * DM, MTOK, DM, DM}; pg8::StaticOrder S; S.init(MTOK, DM, G, bx, 24);
                pg8::EpiRes E{xout, xout, GATE + (size_t)(l * 3 + 1) * 16 * 1024, GMOD + (size_t)(l * 3 + 2) * 16 * 1024, XN, ROWSS + (size_t)(l * 3 + 2) * MTOK, 1};
#ifndef NO_G_OUT
#ifdef REP_OUT
                { E.xout = (float*)HB; E.has_next = 0; pg8::gemm_phase<pg8::EpiRes, pg8::StaticOrder, true, true>(lds, g, S, E); E.xout = xout; E.has_next = 1; }
#endif
                pg8::gemm_phase<pg8::EpiRes, pg8::StaticOrder, true, true>(lds, g, S, E);
#endif
            }
            PH_NEXT;
        }
        const int j = s ? 2 : 0;
        if (PH_ON) { DEFPTRS
            pg8::Gemm g{XN, WUP + (size_t)(l * 2 + s) * NUP * DM, MTOK, NUP, DM}; pg8::StaticOrder S; S.init(MTOK, NUP, G, bx);
            pg8::EpiUp E{HB, ROWSS + (size_t)(l * 3 + j) * MTOK, SBV + (size_t)(l * 3 + j) * 16 * 5632, lds + 131072 + 2048};
#ifndef NO_G_UP
            for (int rep_ = 0; rep_ < REP_UP; ++rep_) {
            pg8::gemm_phase<pg8::EpiUp, pg8::StaticOrder, true, true>(lds, g, S, E);
            }
#endif
        }
        PH_NEXT;
        if (PH_ON) { DEFPTRS
            const int nl = s ? l + 1 : l, nj = s ? 0 : 1; const int has_next = (nl < 2) ? 1 : 0; const int nidx = has_next ? nl * 3 + nj : 0;
            pg8::Gemm g{HB, WDN + (size_t)(l * 2 + s) * DM * DFF, MTOK, DM, DFF}; pg8::StaticOrder S; S.init(MTOK, DM, G, bx, 24);
            pg8::EpiRes E{f == 0 ? x_in : xout, xout, GATE + (size_t)(l * 3 + j) * 16 * 1024, GMOD + (size_t)nidx * 16 * 1024, XN, ROWSS + (size_t)nidx * MTOK, has_next};
#ifndef NO_G_DN
#ifdef REP_DN
            for (int rep_ = 0; rep_ < 2; ++rep_) { E.xout = (rep_ == 0) ? (float*)HLOC : xout; E.has_next = (rep_ == 0) ? 0 : has_next;
            pg8::gemm_phase<pg8::EpiRes, pg8::StaticOrder, true, true>(lds, g, S, E); }
#else
            pg8::gemm_phase<pg8::EpiRes, pg8::StaticOrder, true, true>(lds, g, S, E);
#endif
#endif
        }
        PH_NEXT;
    }
#undef PH_ON
#undef PH_NEXT
}


#ifdef DBG_STOP
__global__ void dbg_dump(const unsigned char* ws, float* out, int mode) {
    const size_t n = (size_t)MTOK * DM; const size_t i0 = (size_t)blockIdx.x * blockDim.x + threadIdx.x, st = (size_t)gridDim.x * blockDim.x;
    const bf16_t* XN = (const bf16_t*)(ws + WS_XN); const bf16_t* HB = (const bf16_t*)(ws + WS_H); const bf16_t* PR = (const bf16_t*)(ws + WS_PROJ);
    const bf16_t* YU = (const bf16_t*)(ws + WS_YU); const float* HL = (const float*)(ws + WS_HLOC); const bf16_t* YN = (const bf16_t*)(ws + WS_YN); const bf16_t* PC = (const bf16_t*)(ws + WS_PCUM);
    for (size_t i = i0; i < n; i += st) {
        float v = 0.f;
        if (mode == 0) v = bf2f(XN[i]);
        else if (mode == 1) v = bf2f(HB[i]) + bf2f(HB[i + n]) + bf2f(HB[i + (size_t)117440512]);
        else if (mode == 2) v = bf2f(PR[i]) + bf2f(PR[i + n]) + bf2f(PR[i + (size_t)100663296]);
        else if (mode == 3) v = (i < n / 2) ? bf2f(YU[i]) : HL[i - n / 2];
        else if (mode == 4) v = bf2f(YN[i]);
        else if (mode == 6) v = (i < n / 2) ? bf2f(PC[i]) : ((const float*)(ws + WS_KS))[(i - n / 2) % (3 * 262144)];
        else if (mode == 7) v = HL[i % (n / 2)] + bf2f(PC[i % (n / 2)]) + ((const float*)(ws + WS_KS))[i % (3 * 262144)] + ((const float*)(ws + WS_ASEG))[i % (2 * 1048576)];
        if (mode == 3) { const bool nan_ = !(v == v), big = (v > 3e38f) || (v < -3e38f); float code = 0.f;
            if (i < n / 2) { const int col = (int)(i & 511); if (col < 256) code = nan_ ? 2000.f : (big ? 1000.f : 0.f); else code = (nan_ || big) ? 4000.f : 0.f; }
            else code = (nan_ || big) ? 8000.f : 0.f;
            v = code; }
        if (!(v == v)) v = 77777.f; if (v > 3e38f) v = 88888.f; if (v < -3e38f) v = 99999.f;
        if (mode != 5) out[i] = v;
    }
}
#endif
#ifndef MK_N_LAUNCHES
#define MK_N_LAUNCHES 1
#endif
constexpr int N_PHASES = 3 + 2 * 9;
extern "C" void kernel_launch(void* const* d_in, const int* in_sizes, int n_in, void* d_out, int out_size, void* d_ws, size_t ws_size, hipStream_t stream) {
    static int grid = 0;
    if (grid == 0) {
        if (n_in != 19 || out_size != MTOK * DM || ws_size < WS_END) { fprintf(stderr, "kernel_launch: unexpected shapes (n_in %d, out %d, ws %zu)\n", n_in, out_size, ws_size); grid = -1; return; }
        int dev = 0, cus = 0, per_cu = 0;
        hipGetDevice(&dev); hipDeviceGetAttribute(&cus, hipDeviceAttributeMultiprocessorCount, dev);
        if (hipFuncSetAttribute((const void*)mk_fwd, hipFuncAttributeMaxDynamicSharedMemorySize, LDS_BYTES) != hipSuccess) { fprintf(stderr, "kernel_launch: hipFuncSetAttribute failed\n"); grid = -1; return; }
        if (hipOccupancyMaxActiveBlocksPerMultiprocessor(&per_cu, (const void*)mk_fwd, 512, LDS_BYTES) != hipSuccess || per_cu < 1) { fprintf(stderr, "kernel_launch: occupancy query says %d\n", per_cu); per_cu = 1; }
        (void)hipGetLastError();
        grid = cus * 1;
    }
    if (grid < 0) return;
    if (hipMemsetAsync(d_ws, 0, 16384, stream) != hipSuccess) { fprintf(stderr, "kernel_launch: memset failed\n"); return; }
    Args a{};
    for (int i = 0; i < 19; ++i) a.in[i] = (const float*)d_in[i];
    a.out = (float*)d_out; a.ws = (unsigned char*)d_ws;
#if MK_N_LAUNCHES == 1
    a.ph_lo = 0; a.ph_hi = N_PHASES;
    void* kargs[] = {&a};
    hipError_t e = hipLaunchCooperativeKernel((const void*)mk_fwd, dim3(grid), dim3(512), kargs, LDS_BYTES, stream);
    if (e != hipSuccess) fprintf(stderr, "kernel_launch: cooperative launch failed: %s (grid %d)\n", hipGetErrorString(e), grid);
#else
#ifdef DBG_STOP
    for (int p = 0; p < DBG_STOP; ++p) { a.ph_lo = p; a.ph_hi = p + 1; hipLaunchKernelGGL(mk_fwd, dim3(grid), dim3(512), LDS_BYTES, stream, a); }
    hipLaunchKernelGGL(dbg_dump, dim3(2048), dim3(256), 0, stream, (const unsigned char*)d_ws, (float*)d_out, DBG_MODE);
#else
    for (int p = 0; p < N_PHASES; ++p) { a.ph_lo = p; a.ph_hi = p + 1; hipLaunchKernelGGL(mk_fwd, dim3(grid), dim3(512), LDS_BYTES, stream, a); }
#endif
#endif
}
```

```cpp
#include <hip/hip_runtime.h>
#include <hip/hip_cooperative_groups.h>
#include <cstdio>
#include <cstdint>
namespace cg = cooperative_groups;
namespace pg8 {
#define PG8_LAS __attribute__((address_space(3)))
typedef unsigned short bf16_t;
typedef short bf16x8 __attribute__((ext_vector_type(8)));
typedef float f32x4 __attribute__((ext_vector_type(4)));
typedef unsigned u32x4 __attribute__((ext_vector_type(4)));
constexpr int BM = 256, BK = 64, HALF = 128, HTB = HALF * BK * 2  , STAGE_BYTES = 8 * HTB, NXCD = 8, WGM = 8;

__host__ __device__ __forceinline__ int lds_byte(int r, int c) { const int st = (r >> 4) * 2 + (c >> 5), rr = r & 15, cc = c & 31, ob = rr * 64 + cc * 2; return st * 1024 + (ob ^ (((ob >> 9) & 1) << 5)); }
__host__ __device__ __forceinline__ void stage_rc(int b, int& R, int& C) { const int st = b / 1024, sb = b % 1024, swz = sb ^ (((sb >> 9) & 1) << 5); R = (st >> 1) * 16 + swz / 64; C = (st & 1) * 32 + (swz % 64) / 2; }
__host__ __device__ __forceinline__ int perm32(int rho) { const int n = rho >> 4, i = rho & 15; return 8 * (i >> 2) + 4 * n + (i & 3); }

struct Unit { int pm, pn; };
struct Gemm { const bf16_t* A; const bf16_t* Bt; int M, N, K; };

struct StaticOrder {
    int nM, nN, nwg, G, c, rev;
    __host__ __device__ void init(int M, int N, int G_, int c_, int rev_ = 0) { nM = M / BM; nN = N / BM; nwg = nM * nN; G = G_; c = c_; rev = rev_; }
    __host__ __device__ bool next(int i, Unit& u) const {
        const long L = (long)i * G + c; if (L >= nwg) return false;
        int wgid = (int)L; { const int q = nwg / NXCD, r = nwg % NXCD, xcd = wgid % NXCD, off = wgid / NXCD; wgid = (xcd < r ? xcd * (q + 1) : r * (q + 1) + (xcd - r) * q) + off; }
        const int nig = WGM * nN, gid = wgid / nig, fm = gid * WGM, gsz = (nM - fm) < WGM ? (nM - fm) : WGM;
        u.pm = (fm + ((wgid % nig) % gsz)) ^ rev; u.pn = (wgid % nig) / gsz; return true;
    }
    __device__ __forceinline__ void a_ready(const Unit&) const {}
    __device__ __forceinline__ void done(const Unit&) const {}
};

typedef float f32x2c_t __attribute__((ext_vector_type(2))); typedef __bf16 bf16x2c_t __attribute__((ext_vector_type(2)));
__device__ __forceinline__ unsigned cvt_pk_bf16(float lo, float hi) { f32x2c_t v = {lo, hi}; bf16x2c_t b = __builtin_convertvector(v, bf16x2c_t); return __builtin_bit_cast(unsigned, b); }
typedef float f32x2 __attribute__((ext_vector_type(2)));
constexpr float RMS_EPS = 1e-6f;
struct EpiUp {
    static constexpr bool PERM = true, AFTER_DRAIN = false;
    bf16_t* H; const float* rowss; const float* sb;
    PG8_LAS unsigned char* xl;
    __device__ __forceinline__ void prefetch(const Unit& u, int wid, int lane) const {
        if (wid < 4) __builtin_amdgcn_global_load_lds((const unsigned*)(rowss + u.pm * BM + wid * 64 + lane), (PG8_LAS unsigned*)(xl + wid * 256), 4, 0, 0);
        else if (wid == 4) __builtin_amdgcn_global_load_lds((const unsigned*)(sb + (size_t)(u.pm >> 4) * 5632 + u.pn * 256 + lane * 4), (PG8_LAS unsigned*)(xl + 1024), 16, 0, 0);
    }
    __device__ __forceinline__ void operator()(const f32x4 (&acc)[2][2][4][2], const Unit& u, int wr, int wc, int fr, int fq) const {
        const int row0 = u.pm * BM + wr * 64 + fr, b = u.pm >> 4, cl = wc * 32 + 8 * fq;
        const PG8_LAS float* xr = (const PG8_LAS float*)xl + wr * 64 + fr; const PG8_LAS float* xs_ = (const PG8_LAS float*)(xl + 1024) + cl; (void)b;
        float rsv[2][4];
#pragma unroll
        for (int ai = 0; ai < 2; ++ai)
#pragma unroll
            for (int m = 0; m < 4; ++m) rsv[ai][m] = xr[ai * HALF + m * 16];
        f32x4 sg[2], su[2];
#pragma unroll
        for (int n = 0; n < 2; ++n) { sg[n] = *(const PG8_LAS f32x4*)(xs_ + 4 * n); su[n] = *(const PG8_LAS f32x4*)(xs_ + 128 + 4 * n); }
#pragma unroll
        for (int ai = 0; ai < 2; ++ai)
#pragma unroll
            for (int m = 0; m < 4; ++m) {
                const int row = row0 + ai * HALF + m * 16;
                const float rs = __builtin_amdgcn_rsqf(rsv[ai][m] * (1.0f / 1024.0f) + RMS_EPS);
                unsigned wq[4];
#pragma unroll
                for (int n = 0; n < 2; ++n)
#pragma unroll
                    for (int ip = 0; ip < 2; ++ip) {
                        const f32x2 ag = (f32x2){acc[ai][0][m][n][2 * ip], acc[ai][0][m][n][2 * ip + 1]}, au = (f32x2){acc[ai][1][m][n][2 * ip], acc[ai][1][m][n][2 * ip + 1]};
                        const f32x2 g = ag * rs + (f32x2){sg[n][2 * ip], sg[n][2 * ip + 1]}, uu = au * rs + (f32x2){su[n][2 * ip], su[n][2 * ip + 1]};
                        const f32x2 t = g * (-1.4426950408889634f);
                        f32x2 d; d.x = __builtin_amdgcn_exp2f(t.x); d.y = __builtin_amdgcn_exp2f(t.y); d = d + 1.0f;
                        f32x2 r; r.x = __builtin_amdgcn_rcpf(d.x); r.y = __builtin_amdgcn_rcpf(d.y);
                        const f32x2 hv = (g * uu) * r;
                        wq[n * 2 + ip] = cvt_pk_bf16(hv.x, hv.y);
                    }
                u32x4 w; w.x = wq[0]; w.y = wq[1]; w.z = wq[2]; w.w = wq[3];
                *(u32x4*)(H + (size_t)row * 2816 + u.pn * 128 + cl) = w;
            }
    }
};
struct EpiIn {
    static constexpr bool PERM = true, AFTER_DRAIN = false;
    bf16_t* P; float* FG; const float* rowss; const float* sb;
    PG8_LAS unsigned char* xl;
    __device__ __forceinline__ void prefetch(const Unit& u, int wid, int lane) const {
        if (wid < 4) __builtin_amdgcn_global_load_lds((const unsigned*)(rowss + u.pm * BM + wid * 64 + lane), (PG8_LAS unsigned*)(xl + wid * 256), 4, 0, 0);
        else if (wid == 4) __builtin_amdgcn_global_load_lds((const unsigned*)(sb + (size_t)(u.pm >> 4) * 5632 + u.pn * 256 + lane * 4), (PG8_LAS unsigned*)(xl + 1024), 16, 0, 0);
    }
    __device__ __forceinline__ void operator()(const f32x4 (&acc)[2][2][4][2], const Unit& u, int wr, int wc, int fr, int fq) const {
        const int row0 = u.pm * BM + wr * 64 + fr, b = u.pm >> 4, cl = wc * 32 + 8 * fq;
        const PG8_LAS float* xr = (const PG8_LAS float*)xl + wr * 64 + fr; const PG8_LAS float* xs_ = (const PG8_LAS float*)(xl + 1024) + cl; (void)b;
        float rsv[2][4];
#pragma unroll
        for (int ai = 0; ai < 2; ++ai)
#pragma unroll
            for (int m = 0; m < 4; ++m) rsv[ai][m] = xr[ai * HALF + m * 16];
        f32x4 sv[2][2];
#pragma unroll
        for (int bj = 0; bj < 2; ++bj)
#pragma unroll
            for (int n = 0; n < 2; ++n) sv[bj][n] = *(const PG8_LAS f32x4*)(xs_ + bj * HALF + 4 * n);
#pragma unroll
        for (int ai = 0; ai < 2; ++ai)
#pragma unroll
            for (int m = 0; m < 4; ++m) {
                const int row = row0 + ai * HALF + m * 16;
                const float rs = __builtin_amdgcn_rsqf(rsv[ai][m] * (1.0f / 1024.0f) + RMS_EPS);
                if (u.pn < 10) {
#pragma unroll
                    for (int bj = 0; bj < 2; ++bj) {
                        const f32x4 v0 = acc[ai][bj][m][0] * rs + sv[bj][0], v1 = acc[ai][bj][m][1] * rs + sv[bj][1];
                        u32x4 w; w.x = cvt_pk_bf16(v0[0], v0[1]); w.y = cvt_pk_bf16(v0[2], v0[3]); w.z = cvt_pk_bf16(v1[0], v1[1]); w.w = cvt_pk_bf16(v1[2], v1[3]);
                        *(u32x4*)(P + (size_t)row * 2560 + u.pn * 256 + bj * HALF + cl) = w;
                    }
                } else if (wc == 0 && fq == 0) {
                    *(f32x4*)(FG + (size_t)row * 4) = acc[ai][0][m][0] * rs + sv[0][0];
                }
            }
    }
};
struct EpiRes {
    static constexpr bool PERM = false, AFTER_DRAIN = false;
    const float* xin; float* xout; const float* gate; const float* gmn; bf16_t* XN; float* rowssn; int has_next;
    __device__ __forceinline__ void prefetch(const Unit&, int, int) const {}
    __device__ __forceinline__ void operator()(const f32x4 (&acc)[2][2][4][2], const Unit& u, int wr, int wc, int fr, int fq) const {
        typedef unsigned u32x2v __attribute__((ext_vector_type(2)));
        const int row0 = u.pm * BM + wr * 64 + fr, b = u.pm >> 4, col0 = u.pn * BM + wc * 32 + 4 * fq;
        const float* gp_ = gate + b * 1024 + col0; const float* gm_ = gmn + b * 1024 + col0;
#pragma unroll
        for (int ai = 0; ai < 2; ++ai) {
            f32x4 xi[4][2][2];
#pragma unroll
            for (int m = 0; m < 4; ++m)
#pragma unroll
                for (int bj = 0; bj < 2; ++bj)
#pragma unroll
                    for (int n = 0; n < 2; ++n) xi[m][bj][n] = *(const f32x4*)(xin + (size_t)(row0 + ai * HALF + m * 16) * 1024 + col0 + bj * HALF + n * 16);
            asm volatile("" ::: "memory");
#pragma unroll
            for (int m = 0; m < 4; ++m) {
                const int row = row0 + ai * HALF + m * 16; const size_t off = (size_t)row * 1024 + col0;
                float ss = 0.f;
#pragma unroll
                for (int bj = 0; bj < 2; ++bj)
#pragma unroll
                    for (int n = 0; n < 2; ++n) {
                        const f32x4 xo = xi[m][bj][n] + *(const f32x4*)(gp_ + bj * HALF + n * 16) * acc[ai][bj][m][n];
                        *(f32x4*)(xout + off + bj * HALF + n * 16) = xo;
                        if (has_next) {
                            ss += (xo[0] * xo[0] + xo[1] * xo[1]) + (xo[2] * xo[2] + xo[3] * xo[3]);
                            const f32x4 a = xo * *(const f32x4*)(gm_ + bj * HALF + n * 16); u32x2v w; w.x = cvt_pk_bf16(a[0], a[1]); w.y = cvt_pk_bf16(a[2], a[3]);
                            *(u32x2v*)(XN + off + bj * HALF + n * 16) = w;
                        }
                    }
                if (has_next) { ss += __shfl_xor(ss, 16); ss += __shfl_xor(ss, 32); if (fq == 0) unsafeAtomicAdd(rowssn + row, ss); }
            }
            asm volatile("" ::: "memory");
        }
    }
};

template <class Epi, class Sched, bool ALIGN_EPI = false, bool SP2 = false>
__device__ __forceinline__ void gemm_phase(PG8_LAS unsigned char* lds, const Gemm g, const Sched& S, const Epi& E) {
    int tid_o = threadIdx.x; asm volatile("" : "+v"(tid_o)); const int tid = tid_o, wid = __builtin_amdgcn_readfirstlane(tid >> 6), lane = tid & 63, wr = wid >> 2, wc = wid & 3, fr = lane & 15, fq = lane >> 4;
    const int K = g.K, nt = K / BK;
    unsigned voffA[2], voffB[2];
#pragma unroll
    for (int i = 0; i < 2; ++i) { int R, C; stage_rc(tid * 16 + i * 8192, R, C); const int Rb = Epi::PERM ? ((R & ~31) + perm32(R & 31)) : R;
        voffA[i] = (unsigned)(R * K + C) * 2u; voffB[i] = (unsigned)(Rb * K + C) * 2u; }
    const size_t kstep = (size_t)(BK * 2);
    const size_t hstep = (size_t)HALF * K * 2;
    const size_t tstep = 2 * hstep;
    const unsigned ldsw = (unsigned)wid * 1024u;
    const int aoff = lds_byte(wr * 64 + fr, fq * 8), boff = lds_byte(wc * 32 + fr, fq * 8);
#define PG8_SA(b, h) (((b) * 2 + (h)) * HTB)
#define PG8_SB(b, h) ((4 + (b) * 2 + (h)) * HTB)
#define PG8_STAGE(bufoff, gbase, voff) do { _Pragma("unroll") for (int _i = 0; _i < 2; ++_i) \
        __builtin_amdgcn_global_load_lds((const unsigned*)((const char*)(gbase) + (voff)[_i]), (PG8_LAS unsigned*)(lds + (bufoff) + ldsw + _i * 8192), 16, 0, 0); } while (0)
#define PG8_LDA(dst, b, h) do { _Pragma("unroll") for (int m = 0; m < 4; ++m) _Pragma("unroll") for (int k = 0; k < 2; ++k) dst[m][k] = *(const PG8_LAS bf16x8*)(lds + PG8_SA(b, h) + aoff + m * 2048 + k * 1024); } while (0)
#define PG8_LDB(dst, b, h) do { _Pragma("unroll") for (int n = 0; n < 2; ++n) _Pragma("unroll") for (int k = 0; k < 2; ++k) dst[n][k] = *(const PG8_LAS bf16x8*)(lds + PG8_SB(b, h) + boff + n * 2048 + k * 1024); } while (0)
#define PG8_MMA(ai, bj, At, Bt) do { __builtin_amdgcn_s_setprio(1); _Pragma("unroll") for (int m = 0; m < 4; ++m) _Pragma("unroll") for (int n = 0; n < 2; ++n) _Pragma("unroll") for (int k = 0; k < 2; ++k) \
        acc[ai][bj][m][n] = __builtin_amdgcn_mfma_f32_16x16x32_bf16(Bt[n][k], At[m][k], acc[ai][bj][m][n], 0, 0, 0); __builtin_amdgcn_s_setprio(0); } while (0)
#define PG8_WAIT_V(n) asm volatile("s_waitcnt vmcnt(" #n ")" ::: "memory")
#define PG8_WAIT_L(n) asm volatile("s_waitcnt lgkmcnt(" #n ")" ::: "memory")
#define PG8_BAR __builtin_amdgcn_s_barrier()
#define PG8_SCHED __builtin_amdgcn_sched_barrier(0)
    Unit cur, nxt; int ui = 0;
    if (!S.next(0, cur)) return;
    f32x4 acc[2][2][4][2];
#pragma unroll
    for (int a = 0; a < 2; ++a)
#pragma unroll
        for (int b = 0; b < 2; ++b)
#pragma unroll
            for (int m = 0; m < 4; ++m)
#pragma unroll
                for (int n = 0; n < 2; ++n) acc[a][b][m][n] = (f32x4){0.f, 0.f, 0.f, 0.f};
    bf16x8 At[4][2], B0[2][2], B1[2][2];
    const char* cA = (const char*)g.A + (size_t)cur.pm * tstep; const char* cB = (const char*)g.Bt + (size_t)cur.pn * tstep;
    S.a_ready(cur);
    if constexpr (SP2) {
        PG8_STAGE(PG8_SB(0, 0), cB, voffB); PG8_STAGE(PG8_SB(0, 1), cB + hstep, voffB); PG8_STAGE(PG8_SA(0, 0), cA, voffA); PG8_STAGE(PG8_SA(0, 1), cA + hstep, voffA);
        if (wr == 1) PG8_BAR;
        PG8_WAIT_V(2); PG8_BAR;
        PG8_STAGE(PG8_SB(1, 0), cB + kstep, voffB); PG8_STAGE(PG8_SA(1, 0), cA + kstep, voffA); PG8_STAGE(PG8_SB(1, 1), cB + hstep + kstep, voffB);
        PG8_WAIT_V(6); PG8_BAR;
    } else {
        PG8_STAGE(PG8_SB(0, 0), cB, voffB); PG8_STAGE(PG8_SA(0, 0), cA, voffA); PG8_STAGE(PG8_SB(0, 1), cB + hstep, voffB); PG8_STAGE(PG8_SA(0, 1), cA + hstep, voffA);
        if (wr == 1) PG8_BAR;
        PG8_WAIT_V(4); PG8_BAR;
        PG8_STAGE(PG8_SB(1, 0), cB + kstep, voffB); PG8_STAGE(PG8_SA(1, 0), cA + kstep, voffA); PG8_STAGE(PG8_SB(1, 1), cB + hstep + kstep, voffB);
        PG8_WAIT_V(6); PG8_BAR;
    }
    for (;;) {
        const bool has_next = S.next(ui + 1, nxt);
        const char* nA = has_next ? (const char*)g.A + (size_t)nxt.pm * tstep : cA; const char* nB = has_next ? (const char*)g.Bt + (size_t)nxt.pn * tstep : cB;
        for (int t = 0; t < nt; t += 2) {
            const bool last = (t == nt - 2);
            const char* a1 = cA + (size_t)(t + 1) * kstep;
            const char* a2 = last ? nA : cA + (size_t)(t + 2) * kstep; const char* b2 = last ? nB : cB + (size_t)(t + 2) * kstep;
            const char* a3 = a2 + kstep; const char* b3 = b2 + kstep;
            if (last) E.prefetch(cur, wid, lane);
            if (last && has_next) S.a_ready(nxt);
            if constexpr (SP2) {
            PG8_LDB(B0, 0, 0); PG8_LDB(B1, 0, 1); PG8_SCHED; PG8_LDA(At, 0, 0); PG8_STAGE(PG8_SA(1, 1), a1 + hstep, voffA);
            PG8_WAIT_V(8); PG8_WAIT_L(0); PG8_BAR; PG8_MMA(0, 0, At, B0); PG8_MMA(0, 1, At, B1); PG8_BAR; PG8_SCHED;
            PG8_LDA(At, 0, 1); PG8_STAGE(PG8_SB(0, 0), b2, voffB); PG8_STAGE(PG8_SB(0, 1), b2 + hstep, voffB); PG8_STAGE(PG8_SA(0, 0), a2, voffA);
            PG8_WAIT_V(8); PG8_WAIT_L(0); PG8_BAR; PG8_MMA(1, 0, At, B0); PG8_MMA(1, 1, At, B1); PG8_BAR; PG8_SCHED;
            PG8_LDB(B0, 1, 0); PG8_LDB(B1, 1, 1); PG8_SCHED; PG8_LDA(At, 1, 0); PG8_STAGE(PG8_SA(0, 1), a2 + hstep, voffA);
            PG8_WAIT_V(8); PG8_WAIT_L(0); PG8_BAR; PG8_MMA(0, 0, At, B0); PG8_MMA(0, 1, At, B1); PG8_BAR; PG8_SCHED;
            PG8_LDA(At, 1, 1); PG8_STAGE(PG8_SB(1, 0), b3, voffB); PG8_STAGE(PG8_SB(1, 1), b3 + hstep, voffB); PG8_STAGE(PG8_SA(1, 0), a3, voffA);
            PG8_WAIT_V(8); PG8_WAIT_L(0); PG8_BAR; PG8_MMA(1, 0, At, B0); PG8_MMA(1, 1, At, B1); PG8_BAR; PG8_SCHED;
            } else {
            PG8_LDB(B0, 0, 0); PG8_SCHED; PG8_LDA(At, 0, 0); PG8_STAGE(PG8_SA(1, 1), a1 + hstep, voffA);
            PG8_WAIT_L(8); PG8_BAR; PG8_WAIT_L(0); PG8_MMA(0, 0, At, B0); PG8_BAR; PG8_SCHED;
            PG8_LDB(B1, 0, 1); PG8_STAGE(PG8_SB(0, 0), b2, voffB);
            PG8_BAR; PG8_WAIT_L(0); PG8_MMA(0, 1, At, B1); PG8_BAR;
            PG8_LDA(At, 0, 1); PG8_STAGE(PG8_SA(0, 0), a2, voffA);
            PG8_BAR; PG8_WAIT_L(0); PG8_MMA(1, 0, At, B0); PG8_BAR; PG8_SCHED;
            PG8_STAGE(PG8_SB(0, 1), b2 + hstep, voffB);
            PG8_WAIT_V(6); PG8_BAR; PG8_MMA(1, 1, At, B1); PG8_BAR;
            PG8_LDB(B0, 1, 0); PG8_SCHED; PG8_LDA(At, 1, 0); PG8_STAGE(PG8_SA(0, 1), a2 + hstep, voffA);
            PG8_WAIT_L(8); PG8_BAR; PG8_WAIT_L(0); PG8_MMA(0, 0, At, B0); PG8_BAR; PG8_SCHED;
            PG8_LDB(B1, 1, 1); PG8_STAGE(PG8_SB(1, 0), b3, voffB);
            PG8_BAR; PG8_WAIT_L(0); PG8_MMA(0, 1, At, B1); PG8_BAR;
            PG8_LDA(At, 1, 1); PG8_STAGE(PG8_SA(1, 0), a3, voffA);
            PG8_BAR; PG8_WAIT_L(0); PG8_MMA(1, 0, At, B0); PG8_BAR; PG8_SCHED;
            PG8_STAGE(PG8_SB(1, 1), b3 + hstep, voffB);
            PG8_WAIT_V(6); PG8_BAR; PG8_MMA(1, 1, At, B1); PG8_BAR;
            }
        }
        if constexpr (ALIGN_EPI) { if (wr == 0) PG8_BAR; }
        if constexpr (!Epi::AFTER_DRAIN) { E(acc, cur, wr, wc, fr, fq); S.done(cur); }
        if (!has_next) break;
#pragma unroll
        for (int a = 0; a < 2; ++a)
#pragma unroll
            for (int b = 0; b < 2; ++b)
#pragma unroll
                for (int m = 0; m < 4; ++m)
#pragma unroll
                    for (int n = 0; n < 2; ++n) acc[a][b][m][n] = (f32x4){0.f, 0.f, 0.f, 0.f};
        cur = nxt; cA = nA; cB = nB; ++ui;
        if constexpr (ALIGN_EPI) { if (wr == 1) PG8_BAR; }
    }
    PG8_WAIT_V(0);
    if constexpr (!ALIGN_EPI) { if (wr == 0) PG8_BAR; }
    PG8_BAR;
    if constexpr (Epi::AFTER_DRAIN) { E.fused(acc, cur, wr, wc, fr, fq, lds, wid, lane); S.done(cur); }
#undef PG8_SA
#undef PG8_SB
#undef PG8_STAGE
#undef PG8_LDA
#undef PG8_LDB
#undef PG8_MMA
#undef PG8_WAIT_V
#undef PG8_WAIT_L
#undef PG8_BAR
#undef PG8_SCHED
}
}

#define LAS __attribute__((address_space(3)))
typedef unsigned short bf16_t;
typedef short bf16x8 __attribute__((ext_vector_type(8)));
typedef short s16x4 __attribute__((ext_vector_type(4)));
typedef float f32x4 __attribute__((ext_vector_type(4)));
typedef float f32x2 __attribute__((ext_vector_type(2)));
typedef float f32x16 __attribute__((ext_vector_type(16)));
typedef unsigned u32x4 __attribute__((ext_vector_type(4)));
typedef unsigned u32x2 __attribute__((ext_vector_type(2)));

constexpr int MTOK = 65536, DM = 1024, DFF = 2816, NUP = 5632, NINP = 2816, PPITCH = 2560, SEQL = 4096;
constexpr float EPSF = 1e-6f, LOG2E = 1.4426950408889634f;
constexpr size_t MiB = 1u << 20;
constexpr size_t WS_MOD = 1 * MiB, WS_GMOD = 3 * MiB, WS_GATE = 4 * MiB, WS_SB = 5 * MiB, WS_ROWSS = 8 * MiB, WS_KS = 10 * MiB, WS_F2 = 11 * MiB, WS_FG = 12 * MiB,
                 WS_ASEG = 13 * MiB, WS_BSEG = 17 * MiB, WS_WUP = 24 * MiB, WS_WDN = 68 * MiB, WS_WIN = 90 * MiB, WS_WOUT = 101 * MiB, WS_XN = 112 * MiB,
                 WS_H = 240 * MiB, WS_PROJ = 240 * MiB, WS_YU = 592 * MiB, WS_HLOC = 656 * MiB, WS_PCUM = 784 * MiB, WS_YN = 848 * MiB, WS_END = 976 * MiB;
constexpr int LDS_BYTES = 147456;

__device__ __forceinline__ float bf2f(unsigned short v) { return __uint_as_float((unsigned)v << 16); }
__device__ __forceinline__ unsigned f2bf(float f) { unsigned u = __float_as_uint(f); return (u + 0x7fffu + ((u >> 16) & 1u)) >> 16; }
__device__ __forceinline__ unsigned pk2(float lo, float hi) { return pg8::cvt_pk_bf16(lo, hi); }
__device__ __forceinline__ float wave_sum(float v) {
#pragma unroll
    for (int o = 1; o < 64; o <<= 1) v += __shfl_xor(v, o);
    return v;
}
__device__ __forceinline__ float sigmoidf_(float x) { return __builtin_amdgcn_rcpf(1.0f + __builtin_amdgcn_exp2f(-LOG2E * x)); }
#define WAITV(n) asm volatile("s_waitcnt vmcnt(" #n ")" ::: "memory")
#define LBAR() asm volatile("s_waitcnt lgkmcnt(0)\n\ts_barrier" ::: "memory")
#define CFENCE() asm volatile("" ::: "memory")

#ifndef REP_FIN
#define REP_FIN 1
#endif
#ifndef REP_IN
#define REP_IN 1
#endif
#ifndef REP_PREP
#define REP_PREP 1
#endif
#ifndef REP_ATTN
#define REP_ATTN 1
#endif
#ifndef REP_UP
#define REP_UP 1
#endif
struct Args { const float* in[19]; float* out; unsigned char* ws; int ph_lo, ph_hi; };

__device__ __forceinline__ void transpose_item(const float* __restrict__ W, int ldw, int clim, int K, bf16_t* __restrict__ WT, int n0, int c0, int k0, LAS float* scr, int lane) {
    const int col = c0 + (lane & 31);
#pragma unroll 16
    for (int i = 0; i < 32; ++i) { const int kk = 2 * i + (lane >> 5); scr[kk * 33 + (lane & 31)] = (col < clim) ? W[(size_t)(k0 + kk) * ldw + col] : 0.f; }
    asm volatile("s_waitcnt lgkmcnt(0)" ::: "memory");
    const int c = lane & 7;
#pragma unroll
    for (int j = 0; j < 4; ++j) { const int n = (lane >> 3) + 8 * j; const LAS float* s = scr + (8 * c) * 33 + n;
        u32x4 o; o.x = pk2(s[0 * 33], s[1 * 33]); o.y = pk2(s[2 * 33], s[3 * 33]); o.z = pk2(s[4 * 33], s[5 * 33]); o.w = pk2(s[6 * 33], s[7 * 33]);
        *(u32x4*)(WT + (size_t)(n0 + n) * K + k0 + 8 * c) = o; }
    asm volatile("s_waitcnt lgkmcnt(0)" ::: "memory");
}

__device__ __forceinline__ int crow(int r, int hi) { return (r & 3) + 8 * (r >> 2) + 4 * hi; }
__device__ __forceinline__ s16x4 vtr(const LAS unsigned char* p) {
    typedef short v4i16_t __attribute__((ext_vector_type(4)));
    return __builtin_bit_cast(s16x4, __builtin_amdgcn_ds_read_tr16_b64_v4i16((LAS v4i16_t*)p));
}
constexpr int AT_SLOT = 16384, AT_AUX = 3 * AT_SLOT, AT_WSF = AT_AUX + 3 * 512, AT_VOTE = AT_WSF + 8 * 256;
constexpr float C2 = 0.125f * LOG2E;

__device__ __forceinline__ void sb_block(f32x16& X, float& carry, bool band, int kv0  , int qrel, int hi) {
    float lm[16];
#pragma unroll
    for (int r = 0; r < 16; ++r) {
        float z2 = X[r] * C2; z2 = __builtin_fminf(__builtin_fmaxf(z2, -120.f), 120.f);
        const float e = __builtin_amdgcn_exp2f(-z2), sp = __builtin_amdgcn_logf(1.0f + e);
        float l1 = -(sp + z2), lb = -sp;
        if (band) { const int kv = kv0 + (r & 3) + 8 * (r >> 2); const bool valid = kv < qrel; l1 = valid ? l1 : 0.f; lb = valid ? lb : -INFINITY; }
        lm[r] = l1; X[r] = lb;
    }
    float G[4], Gp[4], T[4];
#pragma unroll
    for (int g = 0; g < 4; ++g) { G[g] = (lm[4 * g] + lm[4 * g + 1]) + (lm[4 * g + 2] + lm[4 * g + 3]); Gp[g] = __shfl_xor(G[g], 32); T[g] = G[g] + Gp[g]; }
    float S = carry;
#pragma unroll
    for (int g = 3; g >= 0; --g) {
        const float a3 = S + (hi == 0 ? Gp[g] : 0.f), a2 = a3 + lm[4 * g + 3], a1 = a2 + lm[4 * g + 2], a0 = a1 + lm[4 * g + 1];
        X[4 * g + 3] = __builtin_amdgcn_exp2f(X[4 * g + 3] + a3); X[4 * g + 2] = __builtin_amdgcn_exp2f(X[4 * g + 2] + a2);
        X[4 * g + 1] = __builtin_amdgcn_exp2f(X[4 * g + 1] + a1); X[4 * g] = __builtin_amdgcn_exp2f(X[4 * g] + a0);
        S += T[g];
    }
    carry = S;
}

template <int KIND>
__device__ __forceinline__ void attn_unit(LAS unsigned char* lds, const bf16_t* __restrict__ PROJ, bf16_t* __restrict__ YU, const float* __restrict__ KS,
                                          const float* __restrict__ F2, const float* __restrict__ gqk, int b, int h, int qb) {
    int tid_o = threadIdx.x; asm volatile("" : "+v"(tid_o));
    const int tid = tid_o, lane = tid & 63, r32 = lane & 31, hi = lane >> 5;
    const int wid = __builtin_amdgcn_readfirstlane(tid >> 6);
    const int qcol = (KIND == 0 ? 1024 : 1792) + h * 64, kcol = qcol + 256, vcol = qcol + 512;
    const size_t rowbase = (size_t)b * SEQL; const int q0 = qb * 256, bh = b * 4 + h;
    const int NT = (q0 + 256) / 64;
    const bf16_t* ksrc = PROJ + (rowbase + lane) * PPITCH + kcol + wid * 8;
    const bf16_t* vsrc = PROJ + (rowbase + 16 * (wid & 3) + (lane >> 2)) * PPITCH + vcol + (wid >> 2) * 32 + (lane & 3) * 8;
    const float* axsrc = F2 + (size_t)bh * SEQL + lane;
    u32x4 kreg, vreg; float areg = 0.f;
#define AT_LOAD(it_) do { const int kt_ = NT - 1 - (it_); kreg = *(const u32x4*)(ksrc + (size_t)kt_ * 64 * PPITCH); vreg = *(const u32x4*)(vsrc + (size_t)kt_ * 64 * PPITCH); \
        if (KIND == 1 && wid == 0) areg = axsrc[kt_ * 64]; } while (0)
#define AT_STORE(slot_) do { *(LAS u32x4*)(lds + (slot_) * AT_SLOT + wid * 1024 + lane * 16) = kreg; *(LAS u32x4*)(lds + (slot_) * AT_SLOT + 8192 + wid * 1024 + lane * 16) = vreg; \
        if (KIND == 1 && wid == 0) *(LAS float*)(lds + AT_AUX + (slot_) * 512 + lane * 4) = areg; } while (0)
    const bf16_t* Qw = PROJ + (rowbase + q0 + wid * 32 + r32) * PPITCH + qcol + hi * 8;
    bf16x8 qr[4];
#pragma unroll
    for (int d0 = 0; d0 < 4; ++d0) qr[d0] = *(const bf16x8*)(Qw + d0 * 16);
    AT_LOAD(0);
    float qn2 = 0.f, mref = 0.f;
    if (KIND == 1) {
        float qf[4][8]; float ss = 0.f;
#pragma unroll
        for (int d0 = 0; d0 < 4; ++d0)
#pragma unroll
            for (int i = 0; i < 8; ++i) { qf[d0][i] = bf2f((unsigned short)qr[d0][i]); ss += qf[d0][i] * qf[d0][i]; }
        ss += __shfl_xor(ss, 32);
        const float rs = __builtin_amdgcn_rsqf(ss * (1.0f / 64.0f) + EPSF) * C2;
#pragma unroll
        for (int d0 = 0; d0 < 4; ++d0) {
            const float* gp = gqk + d0 * 16 + hi * 8; float v[8];
#pragma unroll
            for (int i = 0; i < 8; ++i) { v[i] = qf[d0][i] * rs * gp[i] * gp[64 + i]; qn2 += v[i] * v[i]; }
            u32x4 w; w.x = pk2(v[0], v[1]); w.y = pk2(v[2], v[3]); w.z = pk2(v[4], v[5]); w.w = pk2(v[6], v[7]);
            qr[d0] = __builtin_bit_cast(bf16x8, w);
        }
        qn2 += __shfl_xor(qn2, 32);
        mref = F2[(size_t)bh * SEQL + q0 + wid * 32 + r32] + __builtin_fminf(8.08f * __builtin_sqrtf(qn2), 60.0f);
    }
    f32x16 o0, o1;
#pragma unroll
    for (int r = 0; r < 16; ++r) { o0[r] = 0.f; o1[r] = 0.f; }
    float mhat = -1e30f, lsum = 0.f, carry = 0.f;
    LAS float* wsf = (LAS float*)(lds + AT_WSF) + wid * 64;
    LAS unsigned* votes = (LAS unsigned*)(lds + AT_VOTE);
    const int qrel = wid * 32 + r32;
    bool wdone = false;
    AT_STORE(0); LBAR();
    for (int it = 0; it < NT; ++it) {
        const int slot = it & 1;
        if (KIND == 0 && it > 0) {
            const LAS unsigned* vp = votes + ((it - 1) & 1) * 8;
            const unsigned all = vp[0] & vp[1] & vp[2] & vp[3] & vp[4] & vp[5] & vp[6] & vp[7];
            if (all) break;
        }
        if (it + 1 < NT) AT_LOAD(it + 1);
        const int kt = NT - 1 - it, jb = kt - (NT - 4);
        const bool band = jb >= 0;
        const bool active = !(band && 64 * jb > 32 * wid + 31) && !wdone;
        if (active) {
            f32x16 p0, p1;
            __builtin_amdgcn_s_setprio(1);
            { const LAS unsigned char* kb = lds + slot * AT_SLOT + hi * 1024 + r32 * 16;
#pragma unroll
              for (int d0 = 0; d0 < 4; ++d0) {
                  const bf16x8 b0 = *(const LAS bf16x8*)(kb + d0 * 2048), b1 = *(const LAS bf16x8*)(kb + d0 * 2048 + 512);
                  if (d0 == 0) { f32x16 z;
#pragma unroll
                      for (int r = 0; r < 16; ++r) z[r] = (KIND == 1) ? -mref : 0.f;
                      p0 = __builtin_amdgcn_mfma_f32_32x32x16_bf16(b0, qr[0], z, 0, 0, 0); p1 = __builtin_amdgcn_mfma_f32_32x32x16_bf16(b1, qr[0], z, 0, 0, 0); }
                  else { p0 = __builtin_amdgcn_mfma_f32_32x32x16_bf16(b0, qr[d0], p0, 0, 0, 0); p1 = __builtin_amdgcn_mfma_f32_32x32x16_bf16(b1, qr[d0], p1, 0, 0, 0); }
              } }
            __builtin_amdgcn_s_setprio(0);
            if (KIND == 0) {
                sb_block(p1, carry, band, 64 * jb + 32 + 4 * hi, qrel, hi);
                sb_block(p0, carry, band, 64 * jb + 4 * hi, qrel, hi);
            } else {
                const LAS float* ax = (const LAS float*)(lds + AT_AUX + slot * 512);
                f32x2 sacc2 = (f32x2){0.f, 0.f};
#pragma unroll
                for (int g = 0; g < 4; ++g) {
                    const f32x4 f0 = *(const LAS f32x4*)(ax + 8 * g + 4 * hi), f1 = *(const LAS f32x4*)(ax + 32 + 8 * g + 4 * hi);
#pragma unroll
                    for (int i = 0; i < 4; ++i) { p0[4 * g + i] += f0[i]; p1[4 * g + i] += f1[i]; }
                }
                if (band) {
#pragma unroll
                    for (int r = 0; r < 16; ++r) { const int kv = 64 * jb + crow(r, hi); if (kv > qrel) p0[r] = -INFINITY; if (kv + 32 > qrel) p1[r] = -INFINITY; }
                }
#pragma unroll
                for (int r = 0; r < 16; r += 2) {
                    p0[r] = __builtin_amdgcn_exp2f(p0[r]); p0[r + 1] = __builtin_amdgcn_exp2f(p0[r + 1]); p1[r] = __builtin_amdgcn_exp2f(p1[r]); p1[r + 1] = __builtin_amdgcn_exp2f(p1[r + 1]);
                    sacc2 += (f32x2){p0[r], p0[r + 1]}; sacc2 += (f32x2){p1[r], p1[r + 1]};
                }
                lsum += sacc2[0] + sacc2[1];
            }
            u32x4 pw0, pw1, pw2, pw3;
            pw0.x = pk2(p0[0], p0[1]); pw0.y = pk2(p0[2], p0[3]); pw0.z = pk2(p0[4], p0[5]); pw0.w = pk2(p0[6], p0[7]);
            pw1.x = pk2(p0[8], p0[9]); pw1.y = pk2(p0[10], p0[11]); pw1.z = pk2(p0[12], p0[13]); pw1.w = pk2(p0[14], p0[15]);
            pw2.x = pk2(p1[0], p1[1]); pw2.y = pk2(p1[2], p1[3]); pw2.z = pk2(p1[4], p1[5]); pw2.w = pk2(p1[6], p1[7]);
            pw3.x = pk2(p1[8], p1[9]); pw3.y = pk2(p1[10], p1[11]); pw3.z = pk2(p1[12], p1[13]); pw3.w = pk2(p1[14], p1[15]);
            const LAS unsigned char* vb = lds + slot * AT_SLOT + 8192 + ((lane >> 4) & 1) * 32 + (lane & 3) * 8 + (4 * hi + ((lane & 15) >> 2)) * 64;
            s16x4 vlo[8], vhi[8];
#pragma unroll
            for (int i = 0; i < 8; ++i) { vlo[i] = vtr(vb + (i >> 2) * 4096 + (i & 3) * 1024); vhi[i] = vtr(vb + (i >> 2) * 4096 + (i & 3) * 1024 + 512); }
#define VFR(i) (bf16x8){vlo[i][0], vlo[i][1], vlo[i][2], vlo[i][3], vhi[i][0], vhi[i][1], vhi[i][2], vhi[i][3]}
#define PAF(x) __builtin_bit_cast(bf16x8, x)
            __builtin_amdgcn_s_setprio(1);
            o0 = __builtin_amdgcn_mfma_f32_32x32x16_bf16(PAF(pw0), VFR(0), o0, 0, 0, 0); o1 = __builtin_amdgcn_mfma_f32_32x32x16_bf16(PAF(pw0), VFR(4), o1, 0, 0, 0);
            o0 = __builtin_amdgcn_mfma_f32_32x32x16_bf16(PAF(pw1), VFR(1), o0, 0, 0, 0); o1 = __builtin_amdgcn_mfma_f32_32x32x16_bf16(PAF(pw1), VFR(5), o1, 0, 0, 0);
            o0 = __builtin_amdgcn_mfma_f32_32x32x16_bf16(PAF(pw2), VFR(2), o0, 0, 0, 0); o1 = __builtin_amdgcn_mfma_f32_32x32x16_bf16(PAF(pw2), VFR(6), o1, 0, 0, 0);
            o0 = __builtin_amdgcn_mfma_f32_32x32x16_bf16(PAF(pw3), VFR(3), o0, 0, 0, 0); o1 = __builtin_amdgcn_mfma_f32_32x32x16_bf16(PAF(pw3), VFR(7), o1, 0, 0, 0);
            __builtin_amdgcn_s_setprio(0);
#undef VFR
#undef PAF
        }
        if (KIND == 0) { if (active) wdone = __all(carry < -150.0f); if (lane == 0) votes[(it & 1) * 8 + wid] = wdone ? 1u : 0u; }
        if (it + 1 < NT) AT_STORE(slot ^ 1);
        LBAR();
    }
    if (KIND == 1) { lsum += __shfl_xor(lsum, 32); CFENCE(); if (hi == 0) wsf[r32] = lsum; CFENCE(); asm volatile("s_waitcnt lgkmcnt(0)" ::: "memory"); }
    bf16_t* Yw = YU + (rowbase + q0 + wid * 32) * 512 + KIND * 256 + h * 64 + r32;
#pragma unroll
    for (int r = 0; r < 16; ++r) {
        const int orow = crow(r, hi); float sc = 1.0f;
        if (KIND == 1) sc = __builtin_amdgcn_rcpf(wsf[orow]);
        Yw[(size_t)orow * 512] = (bf16_t)f2bf(o0[r] * sc); Yw[(size_t)orow * 512 + 32] = (bf16_t)f2bf(o1[r] * sc);
    }
    LBAR();
#undef AT_LOAD
#undef AT_STORE
}

#define DEFPTRS \
    const __attribute__((address_space(4))) Args* ka_ = (const __attribute__((address_space(4))) Args*)__builtin_amdgcn_kernarg_segment_ptr(); \
    asm volatile("" : "+s"(ka_)); \
    int tid_o_ = threadIdx.x; asm volatile("" : "+v"(tid_o_)); const int tid = tid_o_, lane = tid & 63; (void)lane; \
    unsigned char* ws = ka_->ws; \
    const float* x_in = ka_->in[0]; const float* c_in = ka_->in[1]; const float* w_ada = ka_->in[2]; const float* b_ada = ka_->in[3]; const float* g_norm = ka_->in[4]; \
    const float* w_up = ka_->in[5]; const float* w_dn = ka_->in[6]; const float* w_in = ka_->in[7]; const float* b_fg = ka_->in[8]; const float* conv_w = ka_->in[9]; \
    const float* conv_b = ka_->in[10]; const float* w_rg = ka_->in[11]; const float* b_rg = ka_->in[12]; const float* w_ig = ka_->in[13]; const float* b_ig = ka_->in[14]; \
    const float* lam = ka_->in[15]; const float* g_qk = ka_->in[16]; const float* g_mix = ka_->in[17]; const float* w_out = ka_->in[18]; \
    float* xout = ka_->out; \
    float* MOD = (float*)(ws + WS_MOD); float* GMOD = (float*)(ws + WS_GMOD); float* GATE = (float*)(ws + WS_GATE); float* SBV = (float*)(ws + WS_SB); \
    float* ROWSS = (float*)(ws + WS_ROWSS); float* KS = (float*)(ws + WS_KS); float* F2 = (float*)(ws + WS_F2); float* FG = (float*)(ws + WS_FG); \
    float* ASEG = (float*)(ws + WS_ASEG); float* BSEG = (float*)(ws + WS_BSEG); float* TSEGA = (float*)(ws + 21 * MiB); float* TSEGB = (float*)(ws + 22 * MiB); \
    bf16_t* WUP = (bf16_t*)(ws + WS_WUP); bf16_t* WDN = (bf16_t*)(ws + WS_WDN); bf16_t* WIN = (bf16_t*)(ws + WS_WIN); bf16_t* WOUT = (bf16_t*)(ws + WS_WOUT); \
    bf16_t* XN = (bf16_t*)(ws + WS_XN); bf16_t* HB = (bf16_t*)(ws + WS_H); bf16_t* PROJ = (bf16_t*)(ws + WS_PROJ); bf16_t* YU = (bf16_t*)(ws + WS_YU); \
    bf16_t* HLOC = (bf16_t*)(ws + WS_HLOC); bf16_t* PCUM = (bf16_t*)(ws + WS_PCUM); bf16_t* YN = (bf16_t*)(ws + WS_YN);
#define XB_TMO      128
#define XB_XCNT(j)  (256  + 64 * (j))
#define XB_XSUB(j)  (1280 + 64 * (j))
#define XB_XGEN(j)  (2304 + 64 * (j))
#define XB_TOP      3328
#define XB_TOPGEN   3392
#define XCD_BAR_WORDS 3456
#define XB_SPIN_CAP (1u << 18)

__device__ __forceinline__ unsigned xb_ld(unsigned* p)              { return __hip_atomic_load(p, __ATOMIC_RELAXED, __HIP_MEMORY_SCOPE_AGENT); }
__device__ __forceinline__ unsigned xb_add(unsigned* p, unsigned v) { return __hip_atomic_fetch_add(p, v, __ATOMIC_RELAXED, __HIP_MEMORY_SCOPE_AGENT); }
__device__ __forceinline__ unsigned xb_xcc_id() { return (unsigned)__builtin_amdgcn_s_getreg((3 << 11) | 20) & 0xFu; }
#define XB_SPIN(cond, bar) do { unsigned _sp = 0; while (cond) { __builtin_amdgcn_s_sleep(1); \
    if ((++_sp & 255u) == 0u) { if (xb_ld(&(bar)[XB_TMO])) break; if (_sp > XB_SPIN_CAP) { atomicAdd(&(bar)[XB_TMO], 1u); break; } } } } while (0)

struct XcdBarrier {
    unsigned* bar; unsigned x;
    volatile LAS unsigned* st;
};

__device__ __forceinline__ XcdBarrier xcd_barrier_post(unsigned* bar, volatile LAS unsigned* st) {
    XcdBarrier b; b.bar = bar; b.x = xb_xcc_id(); b.st = st;
    if (threadIdx.x == 0) (void)xb_add(&bar[XB_XCNT(b.x)], 1u);
    return b;
}
__device__ __forceinline__ void xcd_barrier_complete(unsigned* bar, unsigned x, unsigned& nloc, unsigned& nx) {
    const unsigned G = gridDim.x * gridDim.y * gridDim.z;
    unsigned sum, cnt, mine, sp = 0u;
    for (;;) {
        sum = 0u; cnt = 0u; mine = 0u;
#pragma unroll
        for (unsigned j = 0; j < 16; ++j) { const unsigned c = xb_ld(&bar[XB_XCNT(j)]); sum += c; cnt += (c > 0u) ? 1u : 0u; mine = (j == x) ? c : mine; }
        if (sum == G) break;
        __builtin_amdgcn_s_sleep(1);
        if ((++sp & 255u) == 0u) { if (xb_ld(&bar[XB_TMO])) break; if (sp > XB_SPIN_CAP) { atomicAdd(&bar[XB_TMO], 1u); break; } }
    }
    nloc = mine > 0u ? mine : 1u; nx = cnt > 0u ? cnt : 1u;
}

__device__ __forceinline__ void xcd_barrier(const XcdBarrier& b) {
    asm volatile("s_waitcnt vmcnt(0)" ::: "memory");
    __syncthreads();
    if (threadIdx.x == 0) {
        unsigned* bar = b.bar;
        __builtin_amdgcn_s_waitcnt(0);
        unsigned nloc = b.st[0], nx = b.st[1];
        if (nloc == 0u) { xcd_barrier_complete(bar, b.x, nloc, nx); b.st[0] = nloc; b.st[1] = nx; }
        const unsigned old = xb_add(&bar[XB_XSUB(b.x)], 1u);
        const unsigned gen = old / nloc;
        if (old + 1u == (gen + 1u) * nloc) {
            __builtin_amdgcn_fence(__ATOMIC_RELEASE, "agent");
            asm volatile("s_waitcnt vmcnt(0)" ::: "memory");
            const unsigned og = xb_add(&bar[XB_TOP], 1u);
            const unsigned tg = og / nx;
            if (og + 1u == (tg + 1u) * nx) xb_add(&bar[XB_TOPGEN], 1u);
            else XB_SPIN(xb_ld(&bar[XB_TOPGEN]) == tg, bar);
            __builtin_amdgcn_fence(__ATOMIC_ACQUIRE, "agent");
            xb_add(&bar[XB_XGEN(b.x)], 1u);
            asm volatile("s_waitcnt vmcnt(0)" ::: "memory");
        } else {
            XB_SPIN(xb_ld(&bar[XB_XGEN(b.x)]) == gen, bar);
            __builtin_amdgcn_fence(__ATOMIC_ACQUIRE, "agent");
            asm volatile("s_waitcnt vmcnt(0)" ::: "memory");
        }
    }
    __syncthreads();
}

__global__ void __launch_bounds__(512) mk_fwd(Args args) {
    extern __shared__ __attribute__((aligned(16))) unsigned char lds_raw[];
    LAS unsigned char* lds = (LAS unsigned char*)lds_raw;
    cg::grid_group grid = cg::this_grid();
    const int wave = __builtin_amdgcn_readfirstlane(threadIdx.x >> 6);
    const int G = gridDim.x; const int bx = blockIdx.x;
    const int vcu = (G % 8 == 0) ? (bx % 8) * (G / 8) + bx / 8 : bx;
    const int gw = vcu * 8 + wave, NGW = G * 8;
    const int lo = args.ph_lo, hi_ph = args.ph_hi;
    volatile LAS unsigned* MISC = (volatile LAS unsigned*)(lds + 131072 + 320);
    if (threadIdx.x < 16) MISC[threadIdx.x] = 0u;
    __syncthreads();
    XcdBarrier xbar = xcd_barrier_post((unsigned*)args.ws, MISC + 8);
    int ph = 0;
#define PH_ON (ph >= lo && ph < hi_ph)
#ifdef REP_SYNC
#define SYNC_EXTRA grid.sync(); asm volatile("" ::: "memory");
#else
#define SYNC_EXTRA
#endif
#define PH_NEXT do { ++ph; if (ph > lo && ph < hi_ph) { asm volatile("s_waitcnt vmcnt(0) lgkmcnt(0)" ::: "memory"); if (ph == 1) grid.sync(); else xcd_barrier(xbar); asm volatile("" ::: "memory"); SYNC_EXTRA } } while (0)

#ifdef REP_PRO
    int rp_ = 0; pro_again:
#endif
    if (PH_ON) { DEFPTRS
        for (int i = bx * 512 + tid; i < 5 * MTOK; i += G * 512) ROWSS[MTOK + i] = 0.f;
        LAS float* cact = (LAS float*)lds;
        LAS float* red = (LAS float*)(lds + 65536);
        for (int i = tid; i < 16 * 1024; i += 512) { const int b = i >> 10, k = i & 1023; const float v = c_in[i]; cact[k * 16 + b] = v * sigmoidf_(v); }
        __syncthreads();
        for (int task = bx; task < 288; task += G) {
            const int l = task / 144, n0 = (task % 144) * 64;
            float acc[16];
#pragma unroll
            for (int b = 0; b < 16; ++b) acc[b] = 0.f;
            const float* wp = w_ada + (size_t)l * 1024 * 9216 + n0 + lane;
#pragma unroll 1
            for (int k0 = wave * 128; k0 < wave * 128 + 128; k0 += 16) {
                float wv[16];
#pragma unroll
                for (int j = 0; j < 16; ++j) wv[j] = wp[(size_t)(k0 + j) * 9216];
                CFENCE();
#pragma unroll
                for (int j = 0; j < 16; ++j) { const int k = k0 + j; const float w = wv[j];
                    const f32x4 c0 = *(const LAS f32x4*)(cact + k * 16), c1 = *(const LAS f32x4*)(cact + k * 16 + 4), c2 = *(const LAS f32x4*)(cact + k * 16 + 8), c3 = *(const LAS f32x4*)(cact + k * 16 + 12);
#pragma unroll
                    for (int i = 0; i < 4; ++i) { acc[i] += c0[i] * w; acc[4 + i] += c1[i] * w; acc[8 + i] += c2[i] * w; acc[12 + i] += c3[i] * w; }
                    if ((j & 3) == 3) CFENCE(); }
            }
#pragma unroll
            for (int b = 0; b < 16; ++b) red[(wave * 16 + b) * 64 + lane] = acc[b];
            __syncthreads();
            for (int o = tid; o < 1024; o += 512) { const int b = o >> 6, ln = o & 63; float s = 0.f;
#pragma unroll
                for (int w = 0; w < 8; ++w) s += red[(w * 16 + b) * 64 + ln];
                MOD[((size_t)l * 16 + b) * 9216 + n0 + ln] = s + b_ada[l * 9216 + n0 + ln]; }
            __syncthreads();
        }
    }
    PH_NEXT;
    if (PH_ON) { DEFPTRS
        for (int i = bx * 512 + tid; i < 2 * 3 * 16 * 1024; i += G * 512) {
            const int k = i & 1023, b = (i >> 10) & 15, lj = i >> 14, l = lj / 3, j = lj % 3;
            const float* mp = MOD + ((size_t)l * 16 + b) * 9216 + j * 3072;
            GMOD[i] = g_norm[(l * 3 + j) * 1024 + k] * (1.0f + mp[1024 + k]);
            GATE[i] = (j == 1 ? 1.0f : 0.5f) * (1.0f + mp[2048 + k]);
        }
        LAS float* scr = (LAS float*)(lds + wave * 8448);
        constexpr int I_UP = 16 * 176, I_DN = 44 * 32, I_IN = 16 * 88, I_OUT = 16 * 32;
        constexpr int NIT = 4 * I_UP + 4 * I_DN + 2 * I_IN + 2 * I_OUT;
        for (int it = gw; it < NIT; it += NGW) {
            int r = it;
            if (r < 4 * I_UP) { const int mat = r / I_UP; r -= mat * I_UP; const int kb = r / 176, nb = r % 176, n0 = nb * 32;
                const int c0 = ((n0 >> 7) & 1) * DFF + (n0 >> 8) * 128 + (n0 & 127);
                transpose_item(w_up + (size_t)mat * DM * NUP, NUP, NUP, DM, WUP + (size_t)mat * NUP * DM, n0, c0, kb * 64, scr, lane); continue; }
            r -= 4 * I_UP;
            if (r < 4 * I_DN) { const int mat = r / I_DN; r -= mat * I_DN; const int kb = r / 32, nb = r % 32;
                transpose_item(w_dn + (size_t)mat * DFF * DM, DM, DM, DFF, WDN + (size_t)mat * DM * DFF, nb * 32, nb * 32, kb * 64, scr, lane); continue; }
            r -= 4 * I_DN;
            if (r < 2 * I_IN) { const int mat = r / I_IN; r -= mat * I_IN; const int kb = r / 88, nb = r % 88;
                transpose_item(w_in + (size_t)mat * DM * 2564, 2564, 2564, DM, WIN + (size_t)mat * NINP * DM, nb * 32, nb * 32, kb * 64, scr, lane); continue; }
            r -= 2 * I_IN;
            { const int mat = r / I_OUT; r -= mat * I_OUT; const int kb = r / 32, nb = r % 32;
                transpose_item(w_out + (size_t)mat * DM * DM, DM, DM, DM, WOUT + (size_t)mat * DM * DM, nb * 32, nb * 32, kb * 64, scr, lane); }
        }
        for (int m0 = gw; m0 < MTOK; m0 += 2 * NGW) {
            const int m1 = m0 + NGW;
            const f32x4* gp = (const f32x4*)(g_norm) + lane;
            const f32x4* xr0 = (const f32x4*)(x_in + (size_t)m0 * DM) + lane; const f32x4* xr1 = (const f32x4*)(x_in + (size_t)m1 * DM) + lane;
            f32x4 v0[4], v1[4];
#pragma unroll
            for (int j = 0; j < 4; ++j) { v0[j] = xr0[64 * j]; v1[j] = xr1[64 * j]; }
            const f32x4* sp0 = (const f32x4*)(MOD + (size_t)(m0 >> 12) * 9216 + 1024) + lane; const f32x4* sp1 = (const f32x4*)(MOD + (size_t)(m1 >> 12) * 9216 + 1024) + lane;
            float s0 = 0.f, s1 = 0.f; u32x2* o0 = (u32x2*)(XN + (size_t)m0 * DM) + lane; u32x2* o1 = (u32x2*)(XN + (size_t)m1 * DM) + lane;
#pragma unroll
            for (int j = 0; j < 4; ++j) { const f32x4 g = gp[64 * j];
                { const f32x4 v = v0[j]; s0 += (v[0] * v[0] + v[1] * v[1]) + (v[2] * v[2] + v[3] * v[3]); const f32x4 a = v * g * (sp0[64 * j] + 1.0f); u32x2 w; w.x = pk2(a[0], a[1]); w.y = pk2(a[2], a[3]); o0[64 * j] = w; }
                { const f32x4 v = v1[j]; s1 += (v[0] * v[0] + v[1] * v[1]) + (v[2] * v[2] + v[3] * v[3]); const f32x4 a = v * g * (sp1[64 * j] + 1.0f); u32x2 w; w.x = pk2(a[0], a[1]); w.y = pk2(a[2], a[3]); o1[64 * j] = w; } }
            s0 = wave_sum(s0); s1 = wave_sum(s1);
            if (lane == 0) { ROWSS[m0] = s0; ROWSS[m1] = s1; }
        }
    }
    PH_NEXT;
    if (PH_ON) { DEFPTRS
        LAS float* sh = (LAS float*)lds;
        for (int combo = 0; combo < 6; ++combo) {
            const int l = combo / 3, j = combo % 3;
            __syncthreads();
            for (int i = tid; i < 16 * 1024; i += 512) { const int b = i >> 10, k = i & 1023; sh[i] = MOD[((size_t)l * 16 + b) * 9216 + j * 3072 + k]; }
            __syncthreads();
            const bf16_t* Wt = (j == 1) ? WIN + (size_t)l * NINP * DM : WUP + (size_t)(l * 2 + (j == 2 ? 1 : 0)) * NUP * DM;
            const int N = (j == 1) ? NINP : NUP;
            float* dst = SBV + (size_t)combo * 16 * 5632;
            for (int n = gw; n < N; n += NGW) {
                float w[16];
#pragma unroll
                for (int c = 0; c < 4; ++c) { const u32x2 q = *(const u32x2*)(Wt + (size_t)n * DM + c * 256 + lane * 4);
                    w[4 * c] = __uint_as_float(q.x << 16); w[4 * c + 1] = __uint_as_float(q.x & 0xffff0000u); w[4 * c + 2] = __uint_as_float(q.y << 16); w[4 * c + 3] = __uint_as_float(q.y & 0xffff0000u); }
                float sv[16];
#pragma unroll
                for (int b = 0; b < 16; ++b) { float s = 0.f;
#pragma unroll
                    for (int c = 0; c < 4; ++c) { const f32x4 v = *(const LAS f32x4*)(sh + b * 1024 + c * 256 + lane * 4); s += (w[4 * c] * v[0] + w[4 * c + 1] * v[1]) + (w[4 * c + 2] * v[2] + w[4 * c + 3] * v[3]); }
                    sv[b] = s; if ((b & 3) == 3) CFENCE(); }
                float t8[8], t4[4], t2[2];
#pragma unroll
                for (int i = 0; i < 8; ++i) { const float snd = (lane & 32) ? sv[i] : sv[i + 8], kp = (lane & 32) ? sv[i + 8] : sv[i]; t8[i] = kp + __shfl_xor(snd, 32); }
#pragma unroll
                for (int i = 0; i < 4; ++i) { const float snd = (lane & 16) ? t8[i] : t8[i + 4], kp = (lane & 16) ? t8[i + 4] : t8[i]; t4[i] = kp + __shfl_xor(snd, 16); }
#pragma unroll
                for (int i = 0; i < 2; ++i) { const float snd = (lane & 8) ? t4[i] : t4[i + 2], kp = (lane & 8) ? t4[i + 2] : t4[i]; t2[i] = kp + __shfl_xor(snd, 8); }
                float t1; { const float snd = (lane & 4) ? t2[0] : t2[1], kp = (lane & 4) ? t2[1] : t2[0]; t1 = kp + __shfl_xor(snd, 4); }
                t1 += __shfl_xor(t1, 2); t1 += __shfl_xor(t1, 1);
                const int bsel = ((lane >> 5) & 1) * 8 + ((lane >> 4) & 1) * 4 + ((lane >> 3) & 1) * 2 + ((lane >> 2) & 1);
                if ((lane & 3) == 0) dst[(size_t)bsel * 5632 + n] = t1;
            }
        }
        __syncthreads();
    }
    PH_NEXT;

#ifdef REP_PRO
    if (rp_ == 0) { rp_ = 1; ph = 0; goto pro_again; }
#endif
#pragma unroll 1
    for (int f = 0; f < 4; ++f) {
        const int l = f >> 1, s = f & 1;
        if (s == 1) {
            if (PH_ON) { DEFPTRS
                pg8::Gemm g{XN, WIN + (size_t)l * NINP * DM, MTOK, NINP, DM}; pg8::StaticOrder S; S.init(MTOK, NINP, G, bx);
                pg8::EpiIn E{PROJ, FG, ROWSS + (size_t)(l * 3 + 1) * MTOK, SBV + (size_t)(l * 3 + 1) * 16 * 5632, lds + 131072 + 2048};
#ifndef NO_G_IN
                for (int rep_ = 0; rep_ < REP_IN; ++rep_) {
                pg8::gemm_phase<pg8::EpiIn, pg8::StaticOrder, true, true>(lds, g, S, E); }
#endif
            }
            PH_NEXT;
            if (PH_ON) { DEFPTRS
#ifndef NO_PREP
                {
                    const int blk = vcu & 7, n = lane & 31, hi = lane >> 5;
                    LAS unsigned char* wfl = lds;
                    LAS float* xs = (LAS float*)(lds + 16384 + wave * 13568);
                    LAS unsigned char* ub = lds + 16384 + wave * 13568 + 8960;
#pragma unroll
                    for (int q = 0; q < 2; ++q) { const int f = wave * 2 + q, gt = f >> 3, nb = (f >> 2) & 1, d0 = f & 3;
                        const float* wsrc = (gt ? w_ig : w_rg) + ((size_t)(l * 8 + blk) * 64 + 16 * d0 + 8 * hi) * 64 + nb * 32 + n;
                        u32x4 w; w.x = pk2(wsrc[0], wsrc[64]); w.y = pk2(wsrc[128], wsrc[192]); w.z = pk2(wsrc[256], wsrc[320]); w.w = pk2(wsrc[384], wsrc[448]);
                        *(LAS u32x4*)(wfl + f * 1024 + lane * 16) = w; }
                    __syncthreads();
                    float br[2], bi[2], cb[2], cw[2][4], c8[2];
#pragma unroll
                    for (int nb = 0; nb < 2; ++nb) { const int ch = blk * 64 + nb * 32 + n;
                        br[nb] = b_rg[l * 512 + ch]; bi[nb] = b_ig[l * 512 + ch]; cb[nb] = conv_b[l * 512 + ch];
#pragma unroll
                        for (int k = 0; k < 4; ++k) cw[nb][k] = conv_w[(l * 4 + k) * 512 + ch];
                        const float lmv = lam[l * 512 + ch];
                        c8[nb] = -8.0f * LOG2E * (__builtin_fmaxf(-lmv, 0.f) + log1pf(expf(-fabsf(lmv)))); }
                    for (int segi = (vcu >> 3) * 8 + wave; segi < REP_PREP * (MTOK / 32); segi += (G >> 3) * 8) { const int seg = segi & (MTOK / 32 - 1);
                        const int row0 = seg * 32; const bool first = (row0 & (SEQL - 1)) == 0;
                        const bf16_t* xp = PROJ + (size_t)row0 * PPITCH + blk * 64;
                        CFENCE();
#pragma unroll
                        for (int t = 0; t < 35; ++t) { float v = 0.f; if (t >= 3 || !first) v = bf2f((xp + ((long)t - 3) * PPITCH)[lane]); xs[t * 64 + lane] = v; }
                        CFENCE();
#pragma unroll
                        for (int nb = 0; nb < 2; ++nb)
#pragma unroll
                            for (int g = 0; g < 4; ++g) { const LAS float* xb = xs + (8 * g + 4 * hi) * 64 + nb * 32 + n; float xv[7];
#pragma unroll
                                for (int j = 0; j < 7; ++j) xv[j] = xb[j * 64];
#pragma unroll
                                for (int i = 0; i < 4; ++i) { const float uu = cb[nb] + cw[nb][0] * xv[i] + cw[nb][1] * xv[i + 1] + cw[nb][2] * xv[i + 2] + cw[nb][3] * xv[i + 3];
                                    *(LAS unsigned short*)(ub + (8 * g + 4 * hi + i) * 144 + (nb * 32 + n) * 2) = (unsigned short)f2bf(uu); }
                                __builtin_amdgcn_sched_barrier(0); }
                        CFENCE();
                        bf16x8 af[4];
#pragma unroll
                        for (int d0 = 0; d0 < 4; ++d0) af[d0] = *(const LAS bf16x8*)(ub + n * 144 + (16 * d0 + 8 * hi) * 2);
#pragma unroll
                        for (int nb = 0; nb < 2; ++nb) {
                            f32x16 arx, aix;
#pragma unroll
                            for (int r = 0; r < 16; ++r) { arx[r] = br[nb]; aix[r] = bi[nb]; }
#pragma unroll
                            for (int d0 = 0; d0 < 4; ++d0) { const bf16x8 w0 = *(const LAS bf16x8*)(wfl + ((0 * 2 + nb) * 4 + d0) * 1024 + lane * 16), w1 = *(const LAS bf16x8*)(wfl + ((1 * 2 + nb) * 4 + d0) * 1024 + lane * 16);
                                                             arx = __builtin_amdgcn_mfma_f32_32x32x16_bf16(af[d0], w0, arx, 0, 0, 0);
                                                             aix = __builtin_amdgcn_mfma_f32_32x32x16_bf16(af[d0], w1, aix, 0, 0, 0); }
                            CFENCE(); __builtin_amdgcn_sched_barrier(0);
#pragma unroll
                            for (int r = 0; r < 16; ++r) {
                                float uu; { const LAS float* xb = xs + (8 * (r >> 2) + 4 * hi + (r & 3)) * 64 + nb * 32 + n;
                                    uu = cb[nb] + cw[nb][0] * xb[0] + cw[nb][1] * xb[64] + cw[nb][2] * xb[128] + cw[nb][3] * xb[192]; }
                                const float rg = sigmoidf_(arx[r]), ig = sigmoidf_(aix[r]);
                                const float la2 = c8[nb] * rg, a = __builtin_amdgcn_exp2f(la2);
                                const float xx = 2.0f * 0.6931471805599453f * la2;
                                const float om = (xx > -0.25f) ? -xx * (1.0f + xx * 0.5f * (1.0f + xx * (1.0f / 3.0f) * (1.0f + xx * 0.25f * (1.0f + xx * 0.2f)))) : 1.0f - a * a;
                                arx[r] = a; aix[r] = __builtin_sqrtf(om) * ig * uu;
                            }
                            float H = 0.f, P = 1.f;
                            const int ch = blk * 64 + nb * 32 + n;
                            bf16_t* hl = HLOC + (size_t)(row0 + 4 * hi) * 512 + ch; bf16_t* pc = PCUM + (size_t)(row0 + 4 * hi) * 512 + ch;
#pragma unroll
                            for (int g = 0; g < 4; ++g) {
                                const float a0 = arx[4 * g], a1 = arx[4 * g + 1], a2 = arx[4 * g + 2], a3 = arx[4 * g + 3];
                                const float b0 = aix[4 * g], b1 = aix[4 * g + 1], b2 = aix[4 * g + 2], b3 = aix[4 * g + 3];
                                const float Ao = (a0 * a1) * (a2 * a3), Bo = ((b0 * a1 + b1) * a2 + b2) * a3 + b3;
                                const float Ap = __shfl_xor(Ao, 32), Bp = __shfl_xor(Bo, 32);
                                const float A1 = hi ? Ap : Ao, B1 = hi ? Bp : Bo, A2 = hi ? Ao : Ap, B2 = hi ? Bo : Bp;
                                const float Hm = A1 * H + B1, Pm = A1 * P;
                                float h = hi ? Hm : H, p = hi ? Pm : P;
                                H = A2 * Hm + B2; P = A2 * Pm;
                                bf16_t* hg = hl + (size_t)g * 8 * 512; bf16_t* pg = pc + (size_t)g * 8 * 512; asm volatile("" : "+v"(hg), "+v"(pg));
                                h = a0 * h + b0; p *= a0; hg[0 * 512] = (bf16_t)f2bf(h); pg[0 * 512] = (bf16_t)f2bf(p);
                                h = a1 * h + b1; p *= a1; hg[1 * 512] = (bf16_t)f2bf(h); pg[1 * 512] = (bf16_t)f2bf(p);
                                h = a2 * h + b2; p *= a2; hg[2 * 512] = (bf16_t)f2bf(h); pg[2 * 512] = (bf16_t)f2bf(p);
                                h = a3 * h + b3; p *= a3; hg[3 * 512] = (bf16_t)f2bf(h); pg[3 * 512] = (bf16_t)f2bf(p);
                            }
                            if (hi == 0) { ASEG[(size_t)seg * 512 + ch] = P; BSEG[(size_t)seg * 512 + ch] = H; }
                            CFENCE(); __builtin_amdgcn_sched_barrier(0);
                        }
                    }
                }
                for (int row = gw; row < MTOK; row += NGW) {
                    const u32x2 q = *(const u32x2*)(PROJ + (size_t)row * PPITCH + 2048 + lane * 4);
                    const float a0 = __uint_as_float(q.x << 16), a1 = __uint_as_float(q.x & 0xffff0000u), a2 = __uint_as_float(q.y << 16), a3 = __uint_as_float(q.y & 0xffff0000u);
                    float ss = (a0 * a0 + a1 * a1) + (a2 * a2 + a3 * a3);
                    ss += __shfl_xor(ss, 1); ss += __shfl_xor(ss, 2); ss += __shfl_xor(ss, 4); ss += __shfl_xor(ss, 8);
                    const float rk = __builtin_amdgcn_rsqf(ss * (1.0f / 64.0f) + EPSF);
                    u32x2 kn; kn.x = pk2(a0 * rk, a1 * rk); kn.y = pk2(a2 * rk, a3 * rk);
                    *(u32x2*)(PROJ + (size_t)row * PPITCH + 2048 + lane * 4) = kn;
                }
                for (int chn = vcu; chn < 64; chn += G) {
                    const int b = chn >> 2, h = chn & 3; const float bf = b_fg[l * 4 + h];
                    const int t0 = wave * 512 + lane * 8;
                    const float* fp = FG + ((size_t)b * SEQL + t0) * 4 + h;
                    float lf[8], tot = 0.f;
#pragma unroll
                    for (int i = 0; i < 8; ++i) { const float v = fp[i * 4] + bf; lf[i] = __builtin_fminf(v, 0.f) - log1pf(expf(-fabsf(v))); tot += lf[i]; }
                    float inc = tot;
#pragma unroll
                    for (int o = 1; o < 64; o <<= 1) { const float t_ = __shfl_up(inc, o); if (lane >= o) inc += t_; }
                    LAS float* wt = (LAS float*)(lds + 16384 + 8 * 13568);
                    __syncthreads();
                    if (lane == 63) wt[wave] = inc;
                    __syncthreads();
                    float run = inc - tot;
                    for (int w = 0; w < wave; ++w) run += wt[w];
                    f32x4 o0, o1;
                    run += lf[0]; o0[0] = -run * LOG2E; run += lf[1]; o0[1] = -run * LOG2E; run += lf[2]; o0[2] = -run * LOG2E; run += lf[3]; o0[3] = -run * LOG2E;
                    run += lf[4]; o1[0] = -run * LOG2E; run += lf[5]; o1[1] = -run * LOG2E; run += lf[6]; o1[2] = -run * LOG2E; run += lf[7]; o1[3] = -run * LOG2E;
                    float* op = F2 + (size_t)chn * SEQL + t0;
                    *(f32x4*)op = o0; *(f32x4*)(op + 4) = o1;
                }
#endif
                __syncthreads();
            }
            PH_NEXT;
            if (PH_ON) { DEFPTRS
#ifndef NO_ATTN
                for (int rep_ = 0; rep_ < REP_ATTN; ++rep_)
                for (int tt = vcu; tt < 256; tt += G) { const int ch = tid; float A = 1.f, B = 0.f;
#pragma unroll
                    for (int s8 = 0; s8 < 8; ++s8) { const float as_ = ASEG[(size_t)(tt * 8 + s8) * 512 + ch], bs_ = BSEG[(size_t)(tt * 8 + s8) * 512 + ch]; A = as_ * A; B = as_ * B + bs_; }
                    TSEGA[(size_t)tt * 512 + ch] = A; TSEGB[(size_t)tt * 512 + ch] = B; }
                for (int vw = vcu; vw < 256; vw += G) {
                    const int bh = vw >> 2, s4 = vw & 3, b = bh >> 2, h = bh & 3;
#pragma unroll 1
                    for (int i = 0; i < 4; ++i) { const int qb = (i == 0) ? s4 : (i == 1) ? 7 - s4 : (i == 2) ? 8 + s4 : 15 - s4;
#ifndef NO_FOX
                        attn_unit<1>(lds, PROJ, YU, KS, F2, g_qk + l * 128, b, h, qb);
#endif
 }
#pragma unroll 1
                    for (int i = 0; i < 4; ++i) { const int qb = (i == 0) ? s4 : (i == 1) ? 7 - s4 : (i == 2) ? 8 + s4 : 15 - s4;
#ifndef NO_SB
                        attn_unit<0>(lds, PROJ, YU, KS, F2, g_qk + l * 128, b, h, qb);
#endif
 }
                }
#endif
            }
            PH_NEXT;
            if (PH_ON) { DEFPTRS
                LAS float* hin = (LAS float*)lds;
                const f32x4 gm0 = *(const f32x4*)(g_mix + l * 1024 + lane * 8), gm1 = *(const f32x4*)(g_mix + l * 1024 + lane * 8 + 4);
                const f32x4 gx0 = *(const f32x4*)(g_mix + l * 1024 + 512 + lane * 8), gx1 = *(const f32x4*)(g_mix + l * 1024 + 512 + lane * 8 + 4);
                for (int tti = vcu; tti < REP_FIN * 256; tti += G) { const int tt = tti & 255;
                    __syncthreads();
                    { const int ch = tid, seg0 = (tt >> 4) * 128, nb = (tt & 15) * 8; float Hc = 0.f;
#pragma unroll 5
                      for (int t_ = (tt & ~15); t_ < tt; ++t_) Hc = TSEGA[(size_t)t_ * 512 + ch] * Hc + TSEGB[(size_t)t_ * 512 + ch];
#pragma unroll
                      for (int s8 = 0; s8 < 8; ++s8) { hin[s8 * 512 + ch] = Hc; Hc = ASEG[(size_t)(seg0 + nb + s8) * 512 + ch] * Hc + BSEG[(size_t)(seg0 + nb + s8) * 512 + ch]; } }
                    __syncthreads();
                    const f32x4 hi0 = *(const LAS f32x4*)(hin + wave * 512 + lane * 8), hi1 = *(const LAS f32x4*)(hin + wave * 512 + lane * 8 + 4);
#pragma unroll 2
                    for (int t = 0; t < 32; ++t) {
                        const size_t row = (size_t)tt * 256 + wave * 32 + t;
                        const u32x4 hq = *(const u32x4*)(HLOC + row * 512 + lane * 8);
                        const u32x4 pq = *(const u32x4*)(PCUM + row * 512 + lane * 8);
                        const u32x4 gq = *(const u32x4*)(PROJ + row * PPITCH + 512 + lane * 8);
                        const u32x4 yq = *(const u32x4*)(YU + row * 512 + lane * 8);
                        float y[8], yu[8]; float ss = 0.f, s2 = 0.f;
#pragma unroll
                        for (int i = 0; i < 8; ++i) {
                            const unsigned pw = pq[i >> 1], gw_ = gq[i >> 1], yw = yq[i >> 1];
                            const float p = (i & 1) ? __uint_as_float(pw & 0xffff0000u) : __uint_as_float(pw << 16);
                            const float gg = (i & 1) ? __uint_as_float(gw_ & 0xffff0000u) : __uint_as_float(gw_ << 16);
                            yu[i] = (i & 1) ? __uint_as_float(yw & 0xffff0000u) : __uint_as_float(yw << 16);
                            const unsigned hw = hq[i >> 1]; const float hlv = (i & 1) ? __uint_as_float(hw & 0xffff0000u) : __uint_as_float(hw << 16);
                            const float hh = hlv + p * (i < 4 ? hi0[i & 3] : hi1[i & 3]);
                            const float inner = 0.7978845608028654f * (gg + 0.044715f * gg * gg * gg);
                            const float ge = gg * __builtin_amdgcn_rcpf(1.0f + __builtin_amdgcn_exp2f(-2.0f * LOG2E * inner));
                            y[i] = hh * ge; ss += y[i] * y[i]; s2 += yu[i] * yu[i];
                        }
                        ss = wave_sum(ss);
                        s2 += __shfl_xor(s2, 1); s2 += __shfl_xor(s2, 2); s2 += __shfl_xor(s2, 4); s2 += __shfl_xor(s2, 8); s2 += __shfl_xor(s2, 16);
                        const float rl = __builtin_amdgcn_rsqf(ss * (1.0f / 512.0f) + EPSF), rx = __builtin_amdgcn_rsqf(s2 * (1.0f / 256.0f) + EPSF);
                        u32x4 o1, o2;
                        o1.x = pk2(y[0] * rl * gm0[0], y[1] * rl * gm0[1]); o1.y = pk2(y[2] * rl * gm0[2], y[3] * rl * gm0[3]);
                        o1.z = pk2(y[4] * rl * gm1[0], y[5] * rl * gm1[1]); o1.w = pk2(y[6] * rl * gm1[2], y[7] * rl * gm1[3]);
                        o2.x = pk2(yu[0] * rx * gx0[0], yu[1] * rx * gx0[1]); o2.y = pk2(yu[2] * rx * gx0[2], yu[3] * rx * gx0[3]);
                        o2.z = pk2(yu[4] * rx * gx1[0], yu[5] * rx * gx1[1]); o2.w = pk2(yu[6] * rx * gx1[2], yu[7] * rx * gx1[3]);
                        *(u32x4*)(YN + row * 1024 + lane * 8) = o1; *(u32x4*)(YN + row * 1024 + 512 + lane * 8) = o2;
                    }
                }
                __syncthreads();
            }
            PH_NEXT;
            if (PH_ON) { DEFPTRS
                pg8::Gemm g{YN, WOUT + (size_t)l * DM * DM, MTOK, DM, DM}; pg8::StaticOrder S; S.init(MTOK, DM, G, bx, 24);
                pg8::EpiRes E{xout, xout, GATE + (size_t)(l * 3 + 1) * 16 * 1024, GMOD + (size_t)(l * 3 + 2) * 16 * 1024, XN, ROWSS + (size_t)(l * 3 + 2) * MTOK, 1};
#ifndef NO_G_OUT
#ifdef REP_OUT
                { E.xout = (float*)HB; E.has_next = 0; pg8::gemm_phase<pg8::EpiRes, pg8::StaticOrder, false, true>(lds, g, S, E); E.xout = xout; E.has_next = 1; }
#endif
                pg8::gemm_phase<pg8::EpiRes, pg8::StaticOrder, false, true>(lds, g, S, E);
#endif
            }
            PH_NEXT;
        }
        const int j = s ? 2 : 0;
        if (PH_ON) { DEFPTRS
            pg8::Gemm g{XN, WUP + (size_t)(l * 2 + s) * NUP * DM, MTOK, NUP, DM}; pg8::StaticOrder S; S.init(MTOK, NUP, G, bx);
            pg8::EpiUp E{HB, ROWSS + (size_t)(l * 3 + j) * MTOK, SBV + (size_t)(l * 3 + j) * 16 * 5632, lds + 131072 + 2048};
#ifndef NO_G_UP
            for (int rep_ = 0; rep_ < REP_UP; ++rep_) {
            pg8::gemm_phase<pg8::EpiUp, pg8::StaticOrder, true, true>(lds, g, S, E);
            }
#endif
        }
        PH_NEXT;
        if (PH_ON) { DEFPTRS
            const int nl = s ? l + 1 : l, nj = s ? 0 : 1; const int has_next = (nl < 2) ? 1 : 0; const int nidx = has_next ? nl * 3 + nj : 0;
            pg8::Gemm g{HB, WDN + (size_t)(l * 2 + s) * DM * DFF, MTOK, DM, DFF}; pg8::StaticOrder S; S.init(MTOK, DM, G, bx, 24);
            pg8::EpiRes E{f == 0 ? x_in : xout, xout, GATE + (size_t)(l * 3 + j) * 16 * 1024, GMOD + (size_t)nidx * 16 * 1024, XN, ROWSS + (size_t)nidx * MTOK, has_next};
#ifndef NO_G_DN
#ifdef REP_DN
            for (int rep_ = 0; rep_ < 2; ++rep_) { E.xout = (rep_ == 0) ? (float*)HLOC : xout; E.has_next = (rep_ == 0) ? 0 : has_next;
            pg8::gemm_phase<pg8::EpiRes, pg8::StaticOrder, false, true>(lds, g, S, E); }
#else
            pg8::gemm_phase<pg8::EpiRes, pg8::StaticOrder, false, true>(lds, g, S, E);
#endif
#endif
        }
        PH_NEXT;
    }
#undef PH_ON
#undef PH_NEXT
}


#ifdef DBG_STOP
__global__ void dbg_dump(const unsigned char* ws, float* out, int mode) {
    const size_t n = (size_t)MTOK * DM; const size_t i0 = (size_t)blockIdx.x * blockDim.x + threadIdx.x, st = (size_t)gridDim.x * blockDim.x;
    const bf16_t* XN = (const bf16_t*)(ws + WS_XN); const bf16_t* HB = (const bf16_t*)(ws + WS_H); const bf16_t* PR = (const bf16_t*)(ws + WS_PROJ);
    const bf16_t* YU = (const bf16_t*)(ws + WS_YU); const float* HL = (const float*)(ws + WS_HLOC); const bf16_t* YN = (const bf16_t*)(ws + WS_YN); const bf16_t* PC = (const bf16_t*)(ws + WS_PCUM);
    for (size_t i = i0; i < n; i += st) {
        float v = 0.f;
        if (mode == 0) v = bf2f(XN[i]);
        else if (mode == 1) v = bf2f(HB[i]) + bf2f(HB[i + n]) + bf2f(HB[i + (size_t)117440512]);
        else if (mode == 2) v = bf2f(PR[i]) + bf2f(PR[i + n]) + bf2f(PR[i + (size_t)100663296]);
        else if (mode == 3) v = (i < n / 2) ? bf2f(YU[i]) : HL[i - n / 2];
        else if (mode == 4) v = bf2f(YN[i]);
        else if (mode == 6) v = (i < n / 2) ? bf2f(PC[i]) : ((const float*)(ws + WS_KS))[(i - n / 2) % (3 * 262144)];
        else if (mode == 7) v = HL[i % (n / 2)] + bf2f(PC[i % (n / 2)]) + ((const float*)(ws + WS_KS))[i % (3 * 262144)] + ((const float*)(ws + WS_ASEG))[i % (2 * 1048576)];
        if (mode == 3) { const bool nan_ = !(v == v), big = (v > 3e38f) || (v < -3e38f); float code = 0.f;
            if (i < n / 2) { const int col = (int)(i & 511); if (col < 256) code = nan_ ? 2000.f : (big ? 1000.f : 0.f); else code = (nan_ || big) ? 4000.f : 0.f; }
            else code = (nan_ || big) ? 8000.f : 0.f;
            v = code; }
        if (!(v == v)) v = 77777.f; if (v > 3e38f) v = 88888.f; if (v < -3e38f) v = 99999.f;
        if (mode != 5) out[i] = v;
    }
}
#endif
#ifndef MK_N_LAUNCHES
#define MK_N_LAUNCHES 1
#endif
constexpr int N_PHASES = 3 + 2 * 9;
extern "C" void kernel_launch(void* const* d_in, const int* in_sizes, int n_in, void* d_out, int out_size, void* d_ws, size_t ws_size, hipStream_t stream) {
    static int grid = 0;
    if (grid == 0) {
        if (n_in != 19 || out_size != MTOK * DM || ws_size < WS_END) { fprintf(stderr, "kernel_launch: unexpected shapes (n_in %d, out %d, ws %zu)\n", n_in, out_size, ws_size); grid = -1; return; }
        int dev = 0, cus = 0, per_cu = 0;
        hipGetDevice(&dev); hipDeviceGetAttribute(&cus, hipDeviceAttributeMultiprocessorCount, dev);
        if (hipFuncSetAttribute((const void*)mk_fwd, hipFuncAttributeMaxDynamicSharedMemorySize, LDS_BYTES) != hipSuccess) { fprintf(stderr, "kernel_launch: hipFuncSetAttribute failed\n"); grid = -1; return; }
        if (hipOccupancyMaxActiveBlocksPerMultiprocessor(&per_cu, (const void*)mk_fwd, 512, LDS_BYTES) != hipSuccess || per_cu < 1) { fprintf(stderr, "kernel_launch: occupancy query says %d\n", per_cu); per_cu = 1; }
        (void)hipGetLastError();
        grid = cus * 1;
    }
    if (grid < 0) return;
    if (hipMemsetAsync(d_ws, 0, 16384, stream) != hipSuccess) { fprintf(stderr, "kernel_launch: memset failed\n"); return; }
    Args a{};
    for (int i = 0; i < 19; ++i) a.in[i] = (const float*)d_in[i];
    a.out = (float*)d_out; a.ws = (unsigned char*)d_ws;
#if MK_N_LAUNCHES == 1
    a.ph_lo = 0; a.ph_hi = N_PHASES;
    void* kargs[] = {&a};
    hipError_t e = hipLaunchCooperativeKernel((const void*)mk_fwd, dim3(grid), dim3(512), kargs, LDS_BYTES, stream);
    if (e != hipSuccess) fprintf(stderr, "kernel_launch: cooperative launch failed: %s (grid %d)\n", hipGetErrorString(e), grid);
#else
#ifdef DBG_STOP
    for (int p = 0; p < DBG_STOP; ++p) { a.ph_lo = p; a.ph_hi = p + 1; hipLaunchKernelGGL(mk_fwd, dim3(grid), dim3(512), LDS_BYTES, stream, a); }
    hipLaunchKernelGGL(dbg_dump, dim3(2048), dim3(256), 0, stream, (const unsigned char*)d_ws, (float*)d_out, DBG_MODE);
#else
    for (int p = 0; p < N_PHASES; ++p) { a.ph_lo = p; a.ph_hi = p + 1; hipLaunchKernelGGL(mk_fwd, dim3(grid), dim3(512), LDS_BYTES, stream, a); }
#endif
#endif
}
```

```cpp
#include <hip/hip_runtime.h>
#include <hip/hip_cooperative_groups.h>
#include <cstdio>
#include <cstdint>
namespace cg = cooperative_groups;
namespace pg8 {
#define PG8_LAS __attribute__((address_space(3)))
typedef unsigned short bf16_t;
typedef short bf16x8 __attribute__((ext_vector_type(8)));
typedef float f32x4 __attribute__((ext_vector_type(4)));
typedef unsigned u32x4 __attribute__((ext_vector_type(4)));
constexpr int BM = 256, BK = 64, HALF = 128, HTB = HALF * BK * 2  , STAGE_BYTES = 8 * HTB, NXCD = 8, WGM = 8;

__host__ __device__ __forceinline__ int lds_byte(int r, int c) { const int st = (r >> 4) * 2 + (c >> 5), rr = r & 15, cc = c & 31, ob = rr * 64 + cc * 2; return st * 1024 + (ob ^ (((ob >> 9) & 1) << 5)); }
__host__ __device__ __forceinline__ void stage_rc(int b, int& R, int& C) { const int st = b / 1024, sb = b % 1024, swz = sb ^ (((sb >> 9) & 1) << 5); R = (st >> 1) * 16 + swz / 64; C = (st & 1) * 32 + (swz % 64) / 2; }
__host__ __device__ __forceinline__ int perm32(int rho) { const int n = rho >> 4, i = rho & 15; return 8 * (i >> 2) + 4 * n + (i & 3); }

struct Unit { int pm, pn; };
struct Gemm { const bf16_t* A; const bf16_t* Bt; int M, N, K; };

struct StaticOrder {
    int nM, nN, nwg, G, c, rev;
    __host__ __device__ void init(int M, int N, int G_, int c_, int rev_ = 0) { nM = M / BM; nN = N / BM; nwg = nM * nN; G = G_; c = c_; rev = rev_; }
    __host__ __device__ bool next(int i, Unit& u) const {
        const long L = (long)i * G + c; if (L >= nwg) return false;
        int wgid = (int)L; { const int q = nwg / NXCD, r = nwg % NXCD, xcd = wgid % NXCD, off = wgid / NXCD; wgid = (xcd < r ? xcd * (q + 1) : r * (q + 1) + (xcd - r) * q) + off; }
        const int nig = WGM * nN, gid = wgid / nig, fm = gid * WGM, gsz = (nM - fm) < WGM ? (nM - fm) : WGM;
        u.pm = (fm + ((wgid % nig) % gsz)) ^ rev; u.pn = (wgid % nig) / gsz; return true;
    }
    __device__ __forceinline__ void a_ready(const Unit&) const {}
    __device__ __forceinline__ void done(const Unit&) const {}
};

typedef float f32x2c_t __attribute__((ext_vector_type(2))); typedef __bf16 bf16x2c_t __attribute__((ext_vector_type(2)));
__device__ __forceinline__ unsigned cvt_pk_bf16(float lo, float hi) { f32x2c_t v = {lo, hi}; bf16x2c_t b = __builtin_convertvector(v, bf16x2c_t); return __builtin_bit_cast(unsigned, b); }
typedef float f32x2 __attribute__((ext_vector_type(2)));
constexpr float RMS_EPS = 1e-6f;
struct EpiUp {
    static constexpr bool PERM = true, AFTER_DRAIN = false;
    bf16_t* H; const float* rowss; const float* sb;
    PG8_LAS unsigned char* xl;
    __device__ __forceinline__ void prefetch(const Unit& u, int wid, int lane) const {
        if (wid < 4) __builtin_amdgcn_global_load_lds((const unsigned*)(rowss + u.pm * BM + wid * 64 + lane), (PG8_LAS unsigned*)(xl + wid * 256), 4, 0, 0);
        else if (wid == 4) __builtin_amdgcn_global_load_lds((const unsigned*)(sb + (size_t)(u.pm >> 4) * 5632 + u.pn * 256 + lane * 4), (PG8_LAS unsigned*)(xl + 1024), 16, 0, 0);
    }
    __device__ __forceinline__ void operator()(const f32x4 (&acc)[2][2][4][2], const Unit& u, int wr, int wc, int fr, int fq) const {
        const int row0 = u.pm * BM + wr * 64 + fr, b = u.pm >> 4, cl = wc * 32 + 8 * fq;
        const PG8_LAS float* xr = (const PG8_LAS float*)xl + wr * 64 + fr; const PG8_LAS float* xs_ = (const PG8_LAS float*)(xl + 1024) + cl; (void)b;
        float rsv[2][4];
#pragma unroll
        for (int ai = 0; ai < 2; ++ai)
#pragma unroll
            for (int m = 0; m < 4; ++m) rsv[ai][m] = xr[ai * HALF + m * 16];
        f32x4 sg[2], su[2];
#pragma unroll
        for (int n = 0; n < 2; ++n) { sg[n] = *(const PG8_LAS f32x4*)(xs_ + 4 * n); su[n] = *(const PG8_LAS f32x4*)(xs_ + 128 + 4 * n); }
#pragma unroll
        for (int ai = 0; ai < 2; ++ai)
#pragma unroll
            for (int m = 0; m < 4; ++m) {
                const int row = row0 + ai * HALF + m * 16;
                const float rs = __builtin_amdgcn_rsqf(rsv[ai][m] * (1.0f / 1024.0f) + RMS_EPS);
                unsigned wq[4];
#pragma unroll
                for (int n = 0; n < 2; ++n)
#pragma unroll
                    for (int ip = 0; ip < 2; ++ip) {
                        const f32x2 ag = (f32x2){acc[ai][0][m][n][2 * ip], acc[ai][0][m][n][2 * ip + 1]}, au = (f32x2){acc[ai][1][m][n][2 * ip], acc[ai][1][m][n][2 * ip + 1]};
                        const f32x2 g = ag * rs + (f32x2){sg[n][2 * ip], sg[n][2 * ip + 1]}, uu = au * rs + (f32x2){su[n][2 * ip], su[n][2 * ip + 1]};
                        const f32x2 t = g * (-1.4426950408889634f);
                        f32x2 d; d.x = __builtin_amdgcn_exp2f(t.x); d.y = __builtin_amdgcn_exp2f(t.y); d = d + 1.0f;
                        f32x2 r; r.x = __builtin_amdgcn_rcpf(d.x); r.y = __builtin_amdgcn_rcpf(d.y);
                        const f32x2 hv = (g * uu) * r;
                        wq[n * 2 + ip] = cvt_pk_bf16(hv.x, hv.y);
                    }
                u32x4 w; w.x = wq[0]; w.y = wq[1]; w.z = wq[2]; w.w = wq[3];
                *(u32x4*)(H + (size_t)row * 2816 + u.pn * 128 + cl) = w;
            }
    }
};
struct EpiIn {
    static constexpr bool PERM = true, AFTER_DRAIN = false;
    bf16_t* P; float* FG; const float* rowss; const float* sb;
    PG8_LAS unsigned char* xl;
    __device__ __forceinline__ void prefetch(const Unit& u, int wid, int lane) const {
        if (wid < 4) __builtin_amdgcn_global_load_lds((const unsigned*)(rowss + u.pm * BM + wid * 64 + lane), (PG8_LAS unsigned*)(xl + wid * 256), 4, 0, 0);
        else if (wid == 4) __builtin_amdgcn_global_load_lds((const unsigned*)(sb + (size_t)(u.pm >> 4) * 5632 + u.pn * 256 + lane * 4), (PG8_LAS unsigned*)(xl + 1024), 16, 0, 0);
    }
    __device__ __forceinline__ void operator()(const f32x4 (&acc)[2][2][4][2], const Unit& u, int wr, int wc, int fr, int fq) const {
        const int row0 = u.pm * BM + wr * 64 + fr, b = u.pm >> 4, cl = wc * 32 + 8 * fq;
        const PG8_LAS float* xr = (const PG8_LAS float*)xl + wr * 64 + fr; const PG8_LAS float* xs_ = (const PG8_LAS float*)(xl + 1024) + cl; (void)b;
        float rsv[2][4];
#pragma unroll
        for (int ai = 0; ai < 2; ++ai)
#pragma unroll
            for (int m = 0; m < 4; ++m) rsv[ai][m] = xr[ai * HALF + m * 16];
        f32x4 sv[2][2];
#pragma unroll
        for (int bj = 0; bj < 2; ++bj)
#pragma unroll
            for (int n = 0; n < 2; ++n) sv[bj][n] = *(const PG8_LAS f32x4*)(xs_ + bj * HALF + 4 * n);
#pragma unroll
        for (int ai = 0; ai < 2; ++ai)
#pragma unroll
            for (int m = 0; m < 4; ++m) {
                const int row = row0 + ai * HALF + m * 16;
                const float rs = __builtin_amdgcn_rsqf(rsv[ai][m] * (1.0f / 1024.0f) + RMS_EPS);
                if (u.pn < 10) {
#pragma unroll
                    for (int bj = 0; bj < 2; ++bj) {
                        const f32x4 v0 = acc[ai][bj][m][0] * rs + sv[bj][0], v1 = acc[ai][bj][m][1] * rs + sv[bj][1];
                        u32x4 w; w.x = cvt_pk_bf16(v0[0], v0[1]); w.y = cvt_pk_bf16(v0[2], v0[3]); w.z = cvt_pk_bf16(v1[0], v1[1]); w.w = cvt_pk_bf16(v1[2], v1[3]);
                        *(u32x4*)(P + (size_t)row * 2560 + u.pn * 256 + bj * HALF + cl) = w;
                    }
                } else if (wc == 0 && fq == 0) {
                    *(f32x4*)(FG + (size_t)row * 4) = acc[ai][0][m][0] * rs + sv[0][0];
                }
            }
    }
};
struct EpiRes {
    static constexpr bool PERM = false, AFTER_DRAIN = false;
    const float* xin; float* xout; const float* gate; const float* gmn; bf16_t* XN; float* rowssn; int has_next;
    PG8_LAS unsigned char* xl;
    __device__ __forceinline__ void prefetch(const Unit& u, int wid, int lane) const {
        if (wid == 0) __builtin_amdgcn_global_load_lds((const unsigned*)(gate + (u.pm >> 4) * 1024 + u.pn * BM + lane * 4), (PG8_LAS unsigned*)(xl), 16, 0, 0);
        else if (wid == 1) __builtin_amdgcn_global_load_lds((const unsigned*)(gmn + (u.pm >> 4) * 1024 + u.pn * BM + lane * 4), (PG8_LAS unsigned*)(xl + 1024), 16, 0, 0);
    }
    __device__ __forceinline__ void operator()(const f32x4 (&acc)[2][2][4][2], const Unit& u, int wr, int wc, int fr, int fq) const {
        typedef unsigned u32x2v __attribute__((ext_vector_type(2)));
        const int row0 = u.pm * BM + wr * 64 + fr, b = u.pm >> 4, col0 = u.pn * BM + wc * 32 + 4 * fq;
        const PG8_LAS float* gp_ = (const PG8_LAS float*)xl + wc * 32 + 4 * fq; const PG8_LAS float* gm_ = (const PG8_LAS float*)(xl + 1024) + wc * 32 + 4 * fq; (void)b;
#pragma unroll
        for (int ai = 0; ai < 2; ++ai) {
            f32x4 xi[4][2][2];
#pragma unroll
            for (int m = 0; m < 4; ++m)
#pragma unroll
                for (int bj = 0; bj < 2; ++bj)
#pragma unroll
                    for (int n = 0; n < 2; ++n) xi[m][bj][n] = *(const f32x4*)(xin + (size_t)(row0 + ai * HALF + m * 16) * 1024 + col0 + bj * HALF + n * 16);
            asm volatile("" ::: "memory");
#pragma unroll
            for (int m = 0; m < 4; ++m) {
                const int row = row0 + ai * HALF + m * 16; const size_t off = (size_t)row * 1024 + col0;
                float ss = 0.f;
#pragma unroll
                for (int bj = 0; bj < 2; ++bj)
#pragma unroll
                    for (int n = 0; n < 2; ++n) {
                        const f32x4 xo = xi[m][bj][n] + *(const PG8_LAS f32x4*)(gp_ + bj * HALF + n * 16) * acc[ai][bj][m][n];
                        *(f32x4*)(xout + off + bj * HALF + n * 16) = xo;
                        if (has_next) {
                            ss += (xo[0] * xo[0] + xo[1] * xo[1]) + (xo[2] * xo[2] + xo[3] * xo[3]);
                            const f32x4 a = xo * *(const PG8_LAS f32x4*)(gm_ + bj * HALF + n * 16); u32x2v w; w.x = cvt_pk_bf16(a[0], a[1]); w.y = cvt_pk_bf16(a[2], a[3]);
                            *(u32x2v*)(XN + off + bj * HALF + n * 16) = w;
                        }
                    }
                if (has_next) { ss += __shfl_xor(ss, 16); ss += __shfl_xor(ss, 32); if (fq == 0) unsafeAtomicAdd(rowssn + row, ss); }
            }
            asm volatile("" ::: "memory");
        }
    }
};

template <class Epi, class Sched, bool ALIGN_EPI = false, bool SP2 = false>
__device__ __forceinline__ void gemm_phase(PG8_LAS unsigned char* lds, const Gemm g, const Sched& S, const Epi& E) {
    int tid_o = threadIdx.x; asm volatile("" : "+v"(tid_o)); const int tid = tid_o, wid = __builtin_amdgcn_readfirstlane(tid >> 6), lane = tid & 63, wr = wid >> 2, wc = wid & 3, fr = lane & 15, fq = lane >> 4;
    const int K = g.K, nt = K / BK;
    unsigned voffA[2], voffB[2];
#pragma unroll
    for (int i = 0; i < 2; ++i) { int R, C; stage_rc(tid * 16 + i * 8192, R, C); const int Rb = Epi::PERM ? ((R & ~31) + perm32(R & 31)) : R;
        voffA[i] = (unsigned)(R * K + C) * 2u; voffB[i] = (unsigned)(Rb * K + C) * 2u; }
    const size_t kstep = (size_t)(BK * 2);
    const size_t hstep = (size_t)HALF * K * 2;
    const size_t tstep = 2 * hstep;
    const unsigned ldsw = (unsigned)wid * 1024u;
    const int aoff = lds_byte(wr * 64 + fr, fq * 8), boff = lds_byte(wc * 32 + fr, fq * 8);
#define PG8_SA(b, h) (((b) * 2 + (h)) * HTB)
#define PG8_SB(b, h) ((4 + (b) * 2 + (h)) * HTB)
#define PG8_STAGE(bufoff, gbase, voff) do { _Pragma("unroll") for (int _i = 0; _i < 2; ++_i) \
        __builtin_amdgcn_global_load_lds((const unsigned*)((const char*)(gbase) + (voff)[_i]), (PG8_LAS unsigned*)(lds + (bufoff) + ldsw + _i * 8192), 16, 0, 0); } while (0)
#define PG8_LDA(dst, b, h) do { _Pragma("unroll") for (int m = 0; m < 4; ++m) _Pragma("unroll") for (int k = 0; k < 2; ++k) dst[m][k] = *(const PG8_LAS bf16x8*)(lds + PG8_SA(b, h) + aoff + m * 2048 + k * 1024); } while (0)
#define PG8_LDB(dst, b, h) do { _Pragma("unroll") for (int n = 0; n < 2; ++n) _Pragma("unroll") for (int k = 0; k < 2; ++k) dst[n][k] = *(const PG8_LAS bf16x8*)(lds + PG8_SB(b, h) + boff + n * 2048 + k * 1024); } while (0)
#define PG8_MMA(ai, bj, At, Bt) do { __builtin_amdgcn_s_setprio(1); _Pragma("unroll") for (int m = 0; m < 4; ++m) _Pragma("unroll") for (int n = 0; n < 2; ++n) _Pragma("unroll") for (int k = 0; k < 2; ++k) \
        acc[ai][bj][m][n] = __builtin_amdgcn_mfma_f32_16x16x32_bf16(Bt[n][k], At[m][k], acc[ai][bj][m][n], 0, 0, 0); __builtin_amdgcn_s_setprio(0); } while (0)
#define PG8_WAIT_V(n) asm volatile("s_waitcnt vmcnt(" #n ")" ::: "memory")
#define PG8_WAIT_L(n) asm volatile("s_waitcnt lgkmcnt(" #n ")" ::: "memory")
#define PG8_BAR __builtin_amdgcn_s_barrier()
#define PG8_SCHED __builtin_amdgcn_sched_barrier(0)
    Unit cur, nxt; int ui = 0;
    if (!S.next(0, cur)) return;
    f32x4 acc[2][2][4][2];
#pragma unroll
    for (int a = 0; a < 2; ++a)
#pragma unroll
        for (int b = 0; b < 2; ++b)
#pragma unroll
            for (int m = 0; m < 4; ++m)
#pragma unroll
                for (int n = 0; n < 2; ++n) acc[a][b][m][n] = (f32x4){0.f, 0.f, 0.f, 0.f};
    bf16x8 At[4][2], B0[2][2], B1[2][2];
    const char* cA = (const char*)g.A + (size_t)cur.pm * tstep; const char* cB = (const char*)g.Bt + (size_t)cur.pn * tstep;
    S.a_ready(cur);
    if constexpr (SP2) {
        PG8_STAGE(PG8_SB(0, 0), cB, voffB); PG8_STAGE(PG8_SB(0, 1), cB + hstep, voffB); PG8_STAGE(PG8_SA(0, 0), cA, voffA); PG8_STAGE(PG8_SA(0, 1), cA + hstep, voffA);
        if (wr == 1) PG8_BAR;
        PG8_WAIT_V(2); PG8_BAR;
        PG8_STAGE(PG8_SB(1, 0), cB + kstep, voffB); PG8_STAGE(PG8_SA(1, 0), cA + kstep, voffA); PG8_STAGE(PG8_SB(1, 1), cB + hstep + kstep, voffB);
        PG8_WAIT_V(6); PG8_BAR;
    } else {
        PG8_STAGE(PG8_SB(0, 0), cB, voffB); PG8_STAGE(PG8_SA(0, 0), cA, voffA); PG8_STAGE(PG8_SB(0, 1), cB + hstep, voffB); PG8_STAGE(PG8_SA(0, 1), cA + hstep, voffA);
        if (wr == 1) PG8_BAR;
        PG8_WAIT_V(4); PG8_BAR;
        PG8_STAGE(PG8_SB(1, 0), cB + kstep, voffB); PG8_STAGE(PG8_SA(1, 0), cA + kstep, voffA); PG8_STAGE(PG8_SB(1, 1), cB + hstep + kstep, voffB);
        PG8_WAIT_V(6); PG8_BAR;
    }
    for (;;) {
        const bool has_next = S.next(ui + 1, nxt);
        const char* nA = has_next ? (const char*)g.A + (size_t)nxt.pm * tstep : cA; const char* nB = has_next ? (const char*)g.Bt + (size_t)nxt.pn * tstep : cB;
        for (int t = 0; t < nt; t += 2) {
            const bool last = (t == nt - 2);
            const char* a1 = cA + (size_t)(t + 1) * kstep;
            const char* a2 = last ? nA : cA + (size_t)(t + 2) * kstep; const char* b2 = last ? nB : cB + (size_t)(t + 2) * kstep;
            const char* a3 = a2 + kstep; const char* b3 = b2 + kstep;
            if (last) E.prefetch(cur, wid, lane);
            if (last && has_next) S.a_ready(nxt);
            if constexpr (SP2) {
            PG8_LDB(B0, 0, 0); PG8_LDB(B1, 0, 1); PG8_SCHED; PG8_LDA(At, 0, 0); PG8_STAGE(PG8_SA(1, 1), a1 + hstep, voffA);
            PG8_WAIT_V(8); PG8_WAIT_L(0); PG8_BAR; PG8_MMA(0, 0, At, B0); PG8_MMA(0, 1, At, B1); PG8_BAR; PG8_SCHED;
            PG8_LDA(At, 0, 1); PG8_STAGE(PG8_SB(0, 0), b2, voffB); PG8_STAGE(PG8_SB(0, 1), b2 + hstep, voffB); PG8_STAGE(PG8_SA(0, 0), a2, voffA);
            PG8_WAIT_V(8); PG8_WAIT_L(0); PG8_BAR; PG8_MMA(1, 0, At, B0); PG8_MMA(1, 1, At, B1); PG8_BAR; PG8_SCHED;
            PG8_LDB(B0, 1, 0); PG8_LDB(B1, 1, 1); PG8_SCHED; PG8_LDA(At, 1, 0); PG8_STAGE(PG8_SA(0, 1), a2 + hstep, voffA);
            PG8_WAIT_V(8); PG8_WAIT_L(0); PG8_BAR; PG8_MMA(0, 0, At, B0); PG8_MMA(0, 1, At, B1); PG8_BAR; PG8_SCHED;
            PG8_LDA(At, 1, 1); PG8_STAGE(PG8_SB(1, 0), b3, voffB); PG8_STAGE(PG8_SB(1, 1), b3 + hstep, voffB); PG8_STAGE(PG8_SA(1, 0), a3, voffA);
            PG8_WAIT_V(8); PG8_WAIT_L(0); PG8_BAR; PG8_MMA(1, 0, At, B0); PG8_MMA(1, 1, At, B1); PG8_BAR; PG8_SCHED;
            } else {
            PG8_LDB(B0, 0, 0); PG8_SCHED; PG8_LDA(At, 0, 0); PG8_STAGE(PG8_SA(1, 1), a1 + hstep, voffA);
            PG8_WAIT_L(8); PG8_BAR; PG8_WAIT_L(0); PG8_MMA(0, 0, At, B0); PG8_BAR; PG8_SCHED;
            PG8_LDB(B1, 0, 1); PG8_STAGE(PG8_SB(0, 0), b2, voffB);
            PG8_BAR; PG8_WAIT_L(0); PG8_MMA(0, 1, At, B1); PG8_BAR;
            PG8_LDA(At, 0, 1); PG8_STAGE(PG8_SA(0, 0), a2, voffA);
            PG8_BAR; PG8_WAIT_L(0); PG8_MMA(1, 0, At, B0); PG8_BAR; PG8_SCHED;
            PG8_STAGE(PG8_SB(0, 1), b2 + hstep, voffB);
            PG8_WAIT_V(6); PG8_BAR; PG8_MMA(1, 1, At, B1); PG8_BAR;
            PG8_LDB(B0, 1, 0); PG8_SCHED; PG8_LDA(At, 1, 0); PG8_STAGE(PG8_SA(0, 1), a2 + hstep, voffA);
            PG8_WAIT_L(8); PG8_BAR; PG8_WAIT_L(0); PG8_MMA(0, 0, At, B0); PG8_BAR; PG8_SCHED;
            PG8_LDB(B1, 1, 1); PG8_STAGE(PG8_SB(1, 0), b3, voffB);
            PG8_BAR; PG8_WAIT_L(0); PG8_MMA(0, 1, At, B1); PG8_BAR;
            PG8_LDA(At, 1, 1); PG8_STAGE(PG8_SA(1, 0), a3, voffA);
            PG8_BAR; PG8_WAIT_L(0); PG8_MMA(1, 0, At, B0); PG8_BAR; PG8_SCHED;
            PG8_STAGE(PG8_SB(1, 1), b3 + hstep, voffB);
            PG8_WAIT_V(6); PG8_BAR; PG8_MMA(1, 1, At, B1); PG8_BAR;
            }
        }
        if constexpr (ALIGN_EPI) { if (wr == 0) PG8_BAR; }
        if constexpr (!Epi::AFTER_DRAIN) { E(acc, cur, wr, wc, fr, fq); S.done(cur); }
        if (!has_next) break;
#pragma unroll
        for (int a = 0; a < 2; ++a)
#pragma unroll
            for (int b = 0; b < 2; ++b)
#pragma unroll
                for (int m = 0; m < 4; ++m)
#pragma unroll
                    for (int n = 0; n < 2; ++n) acc[a][b][m][n] = (f32x4){0.f, 0.f, 0.f, 0.f};
        cur = nxt; cA = nA; cB = nB; ++ui;
        if constexpr (ALIGN_EPI) { if (wr == 1) PG8_BAR; }
    }
    PG8_WAIT_V(0);
    if constexpr (!ALIGN_EPI) { if (wr == 0) PG8_BAR; }
    PG8_BAR;
    if constexpr (Epi::AFTER_DRAIN) { E.fused(acc, cur, wr, wc, fr, fq, lds, wid, lane); S.done(cur); }
#undef PG8_SA
#undef PG8_SB
#undef PG8_STAGE
#undef PG8_LDA
#undef PG8_LDB
#undef PG8_MMA
#undef PG8_WAIT_V
#undef PG8_WAIT_L
#undef PG8_BAR
#undef PG8_SCHED
}
}

#define LAS __attribute__((address_space(3)))
typedef unsigned short bf16_t;
typedef short bf16x8 __attribute__((ext_vector_type(8)));
typedef short s16x4 __attribute__((ext_vector_type(4)));
typedef float f32x4 __attribute__((ext_vector_type(4)));
typedef float f32x2 __attribute__((ext_vector_type(2)));
typedef float f32x16 __attribute__((ext_vector_type(16)));
typedef unsigned u32x4 __attribute__((ext_vector_type(4)));
typedef unsigned u32x2 __attribute__((ext_vector_type(2)));

constexpr int MTOK = 65536, DM = 1024, DFF = 2816, NUP = 5632, NINP = 2816, PPITCH = 2560, SEQL = 4096;
constexpr float EPSF = 1e-6f, LOG2E = 1.4426950408889634f;
constexpr size_t MiB = 1u << 20;
constexpr size_t WS_MOD = 1 * MiB, WS_GMOD = 3 * MiB, WS_GATE = 4 * MiB, WS_SB = 5 * MiB, WS_ROWSS = 8 * MiB, WS_KS = 10 * MiB, WS_F2 = 11 * MiB, WS_FG = 12 * MiB,
                 WS_ASEG = 13 * MiB, WS_BSEG = 17 * MiB, WS_WUP = 24 * MiB, WS_WDN = 68 * MiB, WS_WIN = 90 * MiB, WS_WOUT = 101 * MiB, WS_XN = 112 * MiB,
                 WS_H = 240 * MiB, WS_PROJ = 240 * MiB, WS_YU = 592 * MiB, WS_HLOC = 656 * MiB, WS_PCUM = 784 * MiB, WS_YN = 848 * MiB, WS_END = 976 * MiB;
constexpr int LDS_BYTES = 147456;

__device__ __forceinline__ float bf2f(unsigned short v) { return __uint_as_float((unsigned)v << 16); }
__device__ __forceinline__ unsigned f2bf(float f) { unsigned u = __float_as_uint(f); return (u + 0x7fffu + ((u >> 16) & 1u)) >> 16; }
__device__ __forceinline__ unsigned pk2(float lo, float hi) { return pg8::cvt_pk_bf16(lo, hi); }
__device__ __forceinline__ float wave_sum(float v) {
#pragma unroll
    for (int o = 1; o < 64; o <<= 1) v += __shfl_xor(v, o);
    return v;
}
__device__ __forceinline__ float sigmoidf_(float x) { return __builtin_amdgcn_rcpf(1.0f + __builtin_amdgcn_exp2f(-LOG2E * x)); }
#define WAITV(n) asm volatile("s_waitcnt vmcnt(" #n ")" ::: "memory")
#define LBAR() asm volatile("s_waitcnt lgkmcnt(0)\n\ts_barrier" ::: "memory")
#define CFENCE() asm volatile("" ::: "memory")

#ifndef REP_FIN
#define REP_FIN 1
#endif
#ifndef REP_IN
#define REP_IN 1
#endif
#ifndef REP_PREP
#define REP_PREP 1
#endif
#ifndef REP_ATTN
#define REP_ATTN 1
#endif
#ifndef REP_UP
#define REP_UP 1
#endif
struct Args { const float* in[19]; float* out; unsigned char* ws; int ph_lo, ph_hi; };

__device__ __forceinline__ void transpose_item(const float* __restrict__ W, int ldw, int clim, int K, bf16_t* __restrict__ WT, int n0, int c0, int k0, LAS float* scr, int lane) {
    const int col = c0 + (lane & 31);
#pragma unroll 16
    for (int i = 0; i < 32; ++i) { const int kk = 2 * i + (lane >> 5); scr[kk * 33 + (lane & 31)] = (col < clim) ? W[(size_t)(k0 + kk) * ldw + col] : 0.f; }
    asm volatile("s_waitcnt lgkmcnt(0)" ::: "memory");
    const int c = lane & 7;
#pragma unroll
    for (int j = 0; j < 4; ++j) { const int n = (lane >> 3) + 8 * j; const LAS float* s = scr + (8 * c) * 33 + n;
        u32x4 o; o.x = pk2(s[0 * 33], s[1 * 33]); o.y = pk2(s[2 * 33], s[3 * 33]); o.z = pk2(s[4 * 33], s[5 * 33]); o.w = pk2(s[6 * 33], s[7 * 33]);
        *(u32x4*)(WT + (size_t)(n0 + n) * K + k0 + 8 * c) = o; }
    asm volatile("s_waitcnt lgkmcnt(0)" ::: "memory");
}

__device__ __forceinline__ int crow(int r, int hi) { return (r & 3) + 8 * (r >> 2) + 4 * hi; }
__device__ __forceinline__ s16x4 vtr(const LAS unsigned char* p) {
    typedef short v4i16_t __attribute__((ext_vector_type(4)));
    return __builtin_bit_cast(s16x4, __builtin_amdgcn_ds_read_tr16_b64_v4i16((LAS v4i16_t*)p));
}
constexpr int AT_SLOT = 16384, AT_AUX = 3 * AT_SLOT, AT_WSF = AT_AUX + 3 * 512, AT_VOTE = AT_WSF + 8 * 256;
constexpr float C2 = 0.125f * LOG2E;

__device__ __forceinline__ void sb_block(f32x16& X, float& carry, bool band, int kv0  , int qrel, int hi) {
    float lm[16];
#pragma unroll
    for (int r = 0; r < 16; ++r) {
        float z2 = X[r] * C2; z2 = __builtin_fminf(__builtin_fmaxf(z2, -120.f), 120.f);
        const float e = __builtin_amdgcn_exp2f(-z2), sp = __builtin_amdgcn_logf(1.0f + e);
        float l1 = -(sp + z2), lb = -sp;
        if (band) { const int kv = kv0 + (r & 3) + 8 * (r >> 2); const bool valid = kv < qrel; l1 = valid ? l1 : 0.f; lb = valid ? lb : -INFINITY; }
        lm[r] = l1; X[r] = lb;
    }
    float G[4], Gp[4], T[4];
#pragma unroll
    for (int g = 0; g < 4; ++g) { G[g] = (lm[4 * g] + lm[4 * g + 1]) + (lm[4 * g + 2] + lm[4 * g + 3]); Gp[g] = __shfl_xor(G[g], 32); T[g] = G[g] + Gp[g]; }
    float S = carry;
#pragma unroll
    for (int g = 3; g >= 0; --g) {
        const float a3 = S + (hi == 0 ? Gp[g] : 0.f), a2 = a3 + lm[4 * g + 3], a1 = a2 + lm[4 * g + 2], a0 = a1 + lm[4 * g + 1];
        X[4 * g + 3] = __builtin_amdgcn_exp2f(X[4 * g + 3] + a3); X[4 * g + 2] = __builtin_amdgcn_exp2f(X[4 * g + 2] + a2);
        X[4 * g + 1] = __builtin_amdgcn_exp2f(X[4 * g + 1] + a1); X[4 * g] = __builtin_amdgcn_exp2f(X[4 * g] + a0);
        S += T[g];
    }
    carry = S;
}

template <int KIND>
__device__ __forceinline__ void attn_unit(LAS unsigned char* lds, const bf16_t* __restrict__ PROJ, bf16_t* __restrict__ YU, const float* __restrict__ KS,
                                          const float* __restrict__ F2, const float* __restrict__ gqk, int b, int h, int qb) {
    int tid_o = threadIdx.x; asm volatile("" : "+v"(tid_o));
    const int tid = tid_o, lane = tid & 63, r32 = lane & 31, hi = lane >> 5;
    const int wid = __builtin_amdgcn_readfirstlane(tid >> 6);
    const int qcol = (KIND == 0 ? 1024 : 1792) + h * 64, kcol = qcol + 256, vcol = qcol + 512;
    const size_t rowbase = (size_t)b * SEQL; const int q0 = qb * 256, bh = b * 4 + h;
    const int NT = (q0 + 256) / 64;
    const bf16_t* ksrc = PROJ + (rowbase + lane) * PPITCH + kcol + wid * 8;
    const bf16_t* vsrc = PROJ + (rowbase + 16 * (wid & 3) + (lane >> 2)) * PPITCH + vcol + (wid >> 2) * 32 + (lane & 3) * 8;
    const float* axsrc = F2 + (size_t)bh * SEQL + lane;
    u32x4 kreg, vreg; float areg = 0.f;
#define AT_LOAD(it_) do { const int kt_ = NT - 1 - (it_); kreg = *(const u32x4*)(ksrc + (size_t)kt_ * 64 * PPITCH); vreg = *(const u32x4*)(vsrc + (size_t)kt_ * 64 * PPITCH); \
        if (KIND == 1 && wid == 0) areg = axsrc[kt_ * 64]; } while (0)
#define AT_STORE(slot_) do { *(LAS u32x4*)(lds + (slot_) * AT_SLOT + wid * 1024 + lane * 16) = kreg; *(LAS u32x4*)(lds + (slot_) * AT_SLOT + 8192 + wid * 1024 + lane * 16) = vreg; \
        if (KIND == 1 && wid == 0) *(LAS float*)(lds + AT_AUX + (slot_) * 512 + lane * 4) = areg; } while (0)
    const bf16_t* Qw = PROJ + (rowbase + q0 + wid * 32 + r32) * PPITCH + qcol + hi * 8;
    bf16x8 qr[4];
#pragma unroll
    for (int d0 = 0; d0 < 4; ++d0) qr[d0] = *(const bf16x8*)(Qw + d0 * 16);
    AT_LOAD(0);
    float qn2 = 0.f, mref = 0.f;
    if (KIND == 1) {
        float qf[4][8]; float ss = 0.f;
#pragma unroll
        for (int d0 = 0; d0 < 4; ++d0)
#pragma unroll
            for (int i = 0; i < 8; ++i) { qf[d0][i] = bf2f((unsigned short)qr[d0][i]); ss += qf[d0][i] * qf[d0][i]; }
        ss += __shfl_xor(ss, 32);
        const float rs = __builtin_amdgcn_rsqf(ss * (1.0f / 64.0f) + EPSF) * C2;
#pragma unroll
        for (int d0 = 0; d0 < 4; ++d0) {
            const float* gp = gqk + d0 * 16 + hi * 8; float v[8];
#pragma unroll
            for (int i = 0; i < 8; ++i) { v[i] = qf[d0][i] * rs * gp[i] * gp[64 + i]; qn2 += v[i] * v[i]; }
            u32x4 w; w.x = pk2(v[0], v[1]); w.y = pk2(v[2], v[3]); w.z = pk2(v[4], v[5]); w.w = pk2(v[6], v[7]);
            qr[d0] = __builtin_bit_cast(bf16x8, w);
        }
        qn2 += __shfl_xor(qn2, 32);
        mref = F2[(size_t)bh * SEQL + q0 + wid * 32 + r32] + __builtin_fminf(8.08f * __builtin_sqrtf(qn2), 60.0f);
    }
    f32x16 o0, o1;
#pragma unroll
    for (int r = 0; r < 16; ++r) { o0[r] = 0.f; o1[r] = 0.f; }
    float mhat = -1e30f, lsum = 0.f, carry = 0.f;
    LAS float* wsf = (LAS float*)(lds + AT_WSF) + wid * 64;
    LAS unsigned* votes = (LAS unsigned*)(lds + AT_VOTE);
    const int qrel = wid * 32 + r32;
    bool wdone = false;
    AT_STORE(0); LBAR();
    for (int it = 0; it < NT; ++it) {
        const int slot = it & 1;
        if (KIND == 0 && it > 0) {
            const LAS unsigned* vp = votes + ((it - 1) & 1) * 8;
            const unsigned all = vp[0] & vp[1] & vp[2] & vp[3] & vp[4] & vp[5] & vp[6] & vp[7];
            if (all) break;
        }
        if (it + 1 < NT) AT_LOAD(it + 1);
        const int kt = NT - 1 - it, jb = kt - (NT - 4);
        const bool band = jb >= 0;
        const bool active = !(band && 64 * jb > 32 * wid + 31) && !wdone;
        if (active) {
            f32x16 p0, p1;
            __builtin_amdgcn_s_setprio(1);
            { const LAS unsigned char* kb = lds + slot * AT_SLOT + hi * 1024 + r32 * 16;
#pragma unroll
              for (int d0 = 0; d0 < 4; ++d0) {
                  const bf16x8 b0 = *(const LAS bf16x8*)(kb + d0 * 2048), b1 = *(const LAS bf16x8*)(kb + d0 * 2048 + 512);
                  if (d0 == 0) { f32x16 z;
#pragma unroll
                      for (int r = 0; r < 16; ++r) z[r] = (KIND == 1) ? -mref : 0.f;
                      p0 = __builtin_amdgcn_mfma_f32_32x32x16_bf16(b0, qr[0], z, 0, 0, 0); p1 = __builtin_amdgcn_mfma_f32_32x32x16_bf16(b1, qr[0], z, 0, 0, 0); }
                  else { p0 = __builtin_amdgcn_mfma_f32_32x32x16_bf16(b0, qr[d0], p0, 0, 0, 0); p1 = __builtin_amdgcn_mfma_f32_32x32x16_bf16(b1, qr[d0], p1, 0, 0, 0); }
              } }
            __builtin_amdgcn_s_setprio(0);
            if (KIND == 0) {
                sb_block(p1, carry, band, 64 * jb + 32 + 4 * hi, qrel, hi);
                sb_block(p0, carry, band, 64 * jb + 4 * hi, qrel, hi);
            } else {
                const LAS float* ax = (const LAS float*)(lds + AT_AUX + slot * 512);
                f32x2 sacc2 = (f32x2){0.f, 0.f};
#pragma unroll
                for (int g = 0; g < 4; ++g) {
                    const f32x4 f0 = *(const LAS f32x4*)(ax + 8 * g + 4 * hi), f1 = *(const LAS f32x4*)(ax + 32 + 8 * g + 4 * hi);
#pragma unroll
                    for (int i = 0; i < 4; ++i) { p0[4 * g + i] += f0[i]; p1[4 * g + i] += f1[i]; }
                }
                if (band) {
#pragma unroll
                    for (int r = 0; r < 16; ++r) { const int kv = 64 * jb + crow(r, hi); if (kv > qrel) p0[r] = -INFINITY; if (kv + 32 > qrel) p1[r] = -INFINITY; }
                }
#pragma unroll
                for (int r = 0; r < 16; r += 2) {
                    p0[r] = __builtin_amdgcn_exp2f(p0[r]); p0[r + 1] = __builtin_amdgcn_exp2f(p0[r + 1]); p1[r] = __builtin_amdgcn_exp2f(p1[r]); p1[r + 1] = __builtin_amdgcn_exp2f(p1[r + 1]);
                    sacc2 += (f32x2){p0[r], p0[r + 1]}; sacc2 += (f32x2){p1[r], p1[r + 1]};
                }
                lsum += sacc2[0] + sacc2[1];
            }
            u32x4 pw0, pw1, pw2, pw3;
            pw0.x = pk2(p0[0], p0[1]); pw0.y = pk2(p0[2], p0[3]); pw0.z = pk2(p0[4], p0[5]); pw0.w = pk2(p0[6], p0[7]);
            pw1.x = pk2(p0[8], p0[9]); pw1.y = pk2(p0[10], p0[11]); pw1.z = pk2(p0[12], p0[13]); pw1.w = pk2(p0[14], p0[15]);
            pw2.x = pk2(p1[0], p1[1]); pw2.y = pk2(p1[2], p1[3]); pw2.z = pk2(p1[4], p1[5]); pw2.w = pk2(p1[6], p1[7]);
            pw3.x = pk2(p1[8], p1[9]); pw3.y = pk2(p1[10], p1[11]); pw3.z = pk2(p1[12], p1[13]); pw3.w = pk2(p1[14], p1[15]);
            const LAS unsigned char* vb = lds + slot * AT_SLOT + 8192 + ((lane >> 4) & 1) * 32 + (lane & 3) * 8 + (4 * hi + ((lane & 15) >> 2)) * 64;
            s16x4 vlo[8], vhi[8];
#pragma unroll
            for (int i = 0; i < 8; ++i) { vlo[i] = vtr(vb + (i >> 2) * 4096 + (i & 3) * 1024); vhi[i] = vtr(vb + (i >> 2) * 4096 + (i & 3) * 1024 + 512); }
#define VFR(i) (bf16x8){vlo[i][0], vlo[i][1], vlo[i][2], vlo[i][3], vhi[i][0], vhi[i][1], vhi[i][2], vhi[i][3]}
#define PAF(x) __builtin_bit_cast(bf16x8, x)
            __builtin_amdgcn_s_setprio(1);
            o0 = __builtin_amdgcn_mfma_f32_32x32x16_bf16(PAF(pw0), VFR(0), o0, 0, 0, 0); o1 = __builtin_amdgcn_mfma_f32_32x32x16_bf16(PAF(pw0), VFR(4), o1, 0, 0, 0);
            o0 = __builtin_amdgcn_mfma_f32_32x32x16_bf16(PAF(pw1), VFR(1), o0, 0, 0, 0); o1 = __builtin_amdgcn_mfma_f32_32x32x16_bf16(PAF(pw1), VFR(5), o1, 0, 0, 0);
            o0 = __builtin_amdgcn_mfma_f32_32x32x16_bf16(PAF(pw2), VFR(2), o0, 0, 0, 0); o1 = __builtin_amdgcn_mfma_f32_32x32x16_bf16(PAF(pw2), VFR(6), o1, 0, 0, 0);
            o0 = __builtin_amdgcn_mfma_f32_32x32x16_bf16(PAF(pw3), VFR(3), o0, 0, 0, 0); o1 = __builtin_amdgcn_mfma_f32_32x32x16_bf16(PAF(pw3), VFR(7), o1, 0, 0, 0);
            __builtin_amdgcn_s_setprio(0);
#undef VFR
#undef PAF
        }
        if (KIND == 0) { if (active) wdone = __all(carry < -150.0f); if (lane == 0) votes[(it & 1) * 8 + wid] = wdone ? 1u : 0u; }
        if (it + 1 < NT) AT_STORE(slot ^ 1);
        LBAR();
    }
    if (KIND == 1) { lsum += __shfl_xor(lsum, 32); CFENCE(); if (hi == 0) wsf[r32] = lsum; CFENCE(); asm volatile("s_waitcnt lgkmcnt(0)" ::: "memory"); }
    bf16_t* Yw = YU + (rowbase + q0 + wid * 32) * 512 + KIND * 256 + h * 64 + r32;
#pragma unroll
    for (int r = 0; r < 16; ++r) {
        const int orow = crow(r, hi); float sc = 1.0f;
        if (KIND == 1) sc = __builtin_amdgcn_rcpf(wsf[orow]);
        Yw[(size_t)orow * 512] = (bf16_t)f2bf(o0[r] * sc); Yw[(size_t)orow * 512 + 32] = (bf16_t)f2bf(o1[r] * sc);
    }
    LBAR();
#undef AT_LOAD
#undef AT_STORE
}

#define DEFPTRS \
    const __attribute__((address_space(4))) Args* ka_ = (const __attribute__((address_space(4))) Args*)__builtin_amdgcn_kernarg_segment_ptr(); \
    asm volatile("" : "+s"(ka_)); \
    int tid_o_ = threadIdx.x; asm volatile("" : "+v"(tid_o_)); const int tid = tid_o_, lane = tid & 63; (void)lane; \
    unsigned char* ws = ka_->ws; \
    const float* x_in = ka_->in[0]; const float* c_in = ka_->in[1]; const float* w_ada = ka_->in[2]; const float* b_ada = ka_->in[3]; const float* g_norm = ka_->in[4]; \
    const float* w_up = ka_->in[5]; const float* w_dn = ka_->in[6]; const float* w_in = ka_->in[7]; const float* b_fg = ka_->in[8]; const float* conv_w = ka_->in[9]; \
    const float* conv_b = ka_->in[10]; const float* w_rg = ka_->in[11]; const float* b_rg = ka_->in[12]; const float* w_ig = ka_->in[13]; const float* b_ig = ka_->in[14]; \
    const float* lam = ka_->in[15]; const float* g_qk = ka_->in[16]; const float* g_mix = ka_->in[17]; const float* w_out = ka_->in[18]; \
    float* xout = ka_->out; \
    float* MOD = (float*)(ws + WS_MOD); float* GMOD = (float*)(ws + WS_GMOD); float* GATE = (float*)(ws + WS_GATE); float* SBV = (float*)(ws + WS_SB); \
    float* ROWSS = (float*)(ws + WS_ROWSS); float* KS = (float*)(ws + WS_KS); float* F2 = (float*)(ws + WS_F2); float* FG = (float*)(ws + WS_FG); \
    float* ASEG = (float*)(ws + WS_ASEG); float* BSEG = (float*)(ws + WS_BSEG); float* TSEGA = (float*)(ws + 21 * MiB); float* TSEGB = (float*)(ws + 22 * MiB); \
    bf16_t* WUP = (bf16_t*)(ws + WS_WUP); bf16_t* WDN = (bf16_t*)(ws + WS_WDN); bf16_t* WIN = (bf16_t*)(ws + WS_WIN); bf16_t* WOUT = (bf16_t*)(ws + WS_WOUT); \
    bf16_t* XN = (bf16_t*)(ws + WS_XN); bf16_t* HB = (bf16_t*)(ws + WS_H); bf16_t* PROJ = (bf16_t*)(ws + WS_PROJ); bf16_t* YU = (bf16_t*)(ws + WS_YU); \
    bf16_t* HLOC = (bf16_t*)(ws + WS_HLOC); bf16_t* PCUM = (bf16_t*)(ws + WS_PCUM); bf16_t* YN = (bf16_t*)(ws + WS_YN);
#define XB_TMO      128
#define XB_XCNT(j)  (256  + 64 * (j))
#define XB_XSUB(j)  (1280 + 64 * (j))
#define XB_XGEN(j)  (2304 + 64 * (j))
#define XB_TOP      3328
#define XB_TOPGEN   3392
#define XCD_BAR_WORDS 3456
#define XB_SPIN_CAP (1u << 18)

__device__ __forceinline__ unsigned xb_ld(unsigned* p)              { return __hip_atomic_load(p, __ATOMIC_RELAXED, __HIP_MEMORY_SCOPE_AGENT); }
__device__ __forceinline__ unsigned xb_add(unsigned* p, unsigned v) { return __hip_atomic_fetch_add(p, v, __ATOMIC_RELAXED, __HIP_MEMORY_SCOPE_AGENT); }
__device__ __forceinline__ unsigned xb_xcc_id() { return (unsigned)__builtin_amdgcn_s_getreg((3 << 11) | 20) & 0xFu; }
#define XB_SPIN(cond, bar) do { unsigned _sp = 0; while (cond) { __builtin_amdgcn_s_sleep(1); \
    if ((++_sp & 255u) == 0u) { if (xb_ld(&(bar)[XB_TMO])) break; if (_sp > XB_SPIN_CAP) { atomicAdd(&(bar)[XB_TMO], 1u); break; } } } } while (0)

struct XcdBarrier {
    unsigned* bar; unsigned x;
    volatile LAS unsigned* st;
};

__device__ __forceinline__ XcdBarrier xcd_barrier_post(unsigned* bar, volatile LAS unsigned* st) {
    XcdBarrier b; b.bar = bar; b.x = xb_xcc_id(); b.st = st;
    if (threadIdx.x == 0) (void)xb_add(&bar[XB_XCNT(b.x)], 1u);
    return b;
}
__device__ __forceinline__ void xcd_barrier_complete(unsigned* bar, unsigned x, unsigned& nloc, unsigned& nx) {
    const unsigned G = gridDim.x * gridDim.y * gridDim.z;
    unsigned sum, cnt, mine, sp = 0u;
    for (;;) {
        sum = 0u; cnt = 0u; mine = 0u;
#pragma unroll
        for (unsigned j = 0; j < 16; ++j) { const unsigned c = xb_ld(&bar[XB_XCNT(j)]); sum += c; cnt += (c > 0u) ? 1u : 0u; mine = (j == x) ? c : mine; }
        if (sum == G) break;
        __builtin_amdgcn_s_sleep(1);
        if ((++sp & 255u) == 0u) { if (xb_ld(&bar[XB_TMO])) break; if (sp > XB_SPIN_CAP) { atomicAdd(&bar[XB_TMO], 1u); break; } }
    }
    nloc = mine > 0u ? mine : 1u; nx = cnt > 0u ? cnt : 1u;
}

__device__ __forceinline__ void xcd_barrier(const XcdBarrier& b) {
    asm volatile("s_waitcnt vmcnt(0)" ::: "memory");
    __syncthreads();
    if (threadIdx.x == 0) {
        unsigned* bar = b.bar;
        __builtin_amdgcn_s_waitcnt(0);
        unsigned nloc = b.st[0], nx = b.st[1];
        if (nloc == 0u) { xcd_barrier_complete(bar, b.x, nloc, nx); b.st[0] = nloc; b.st[1] = nx; }
        const unsigned old = xb_add(&bar[XB_XSUB(b.x)], 1u);
        const unsigned gen = old / nloc;
        if (old + 1u == (gen + 1u) * nloc) {
            __builtin_amdgcn_fence(__ATOMIC_RELEASE, "agent");
            asm volatile("s_waitcnt vmcnt(0)" ::: "memory");
            const unsigned og = xb_add(&bar[XB_TOP], 1u);
            const unsigned tg = og / nx;
            if (og + 1u == (tg + 1u) * nx) xb_add(&bar[XB_TOPGEN], 1u);
            else XB_SPIN(xb_ld(&bar[XB_TOPGEN]) == tg, bar);
            __builtin_amdgcn_fence(__ATOMIC_ACQUIRE, "agent");
            xb_add(&bar[XB_XGEN(b.x)], 1u);
            asm volatile("s_waitcnt vmcnt(0)" ::: "memory");
        } else {
            XB_SPIN(xb_ld(&bar[XB_XGEN(b.x)]) == gen, bar);
            __builtin_amdgcn_fence(__ATOMIC_ACQUIRE, "agent");
            asm volatile("s_waitcnt vmcnt(0)" ::: "memory");
        }
    }
    __syncthreads();
}

__global__ void __launch_bounds__(512) mk_fwd(Args args) {
    extern __shared__ __attribute__((aligned(16))) unsigned char lds_raw[];
    LAS unsigned char* lds = (LAS unsigned char*)lds_raw;
    cg::grid_group grid = cg::this_grid();
    const int wave = __builtin_amdgcn_readfirstlane(threadIdx.x >> 6);
    const int G = gridDim.x; const int bx = blockIdx.x;
    const int vcu = (G % 8 == 0) ? (bx % 8) * (G / 8) + bx / 8 : bx;
    const int gw = vcu * 8 + wave, NGW = G * 8;
    const int lo = args.ph_lo, hi_ph = args.ph_hi;
    volatile LAS unsigned* MISC = (volatile LAS unsigned*)(lds + 131072 + 320);
    if (threadIdx.x < 16) MISC[threadIdx.x] = 0u;
    __syncthreads();
    XcdBarrier xbar = xcd_barrier_post((unsigned*)args.ws, MISC + 8);
    int ph = 0;
#define PH_ON (ph >= lo && ph < hi_ph)
#ifdef REP_SYNC
#define SYNC_EXTRA grid.sync(); asm volatile("" ::: "memory");
#else
#define SYNC_EXTRA
#endif
#define PH_NEXT do { ++ph; if (ph > lo && ph < hi_ph) { asm volatile("s_waitcnt vmcnt(0) lgkmcnt(0)" ::: "memory"); if (ph == 1) grid.sync(); else xcd_barrier(xbar); asm volatile("" ::: "memory"); SYNC_EXTRA } } while (0)

#ifdef REP_PRO
    int rp_ = 0; pro_again:
#endif
    if (PH_ON) { DEFPTRS
        for (int i = bx * 512 + tid; i < 5 * MTOK; i += G * 512) ROWSS[MTOK + i] = 0.f;
        LAS float* cact = (LAS float*)lds;
        LAS float* red = (LAS float*)(lds + 65536);
        for (int i = tid; i < 16 * 1024; i += 512) { const int b = i >> 10, k = i & 1023; const float v = c_in[i]; cact[k * 16 + b] = v * sigmoidf_(v); }
        __syncthreads();
        for (int task = bx; task < 288; task += G) {
            const int l = task / 144, n0 = (task % 144) * 64;
            float acc[16];
#pragma unroll
            for (int b = 0; b < 16; ++b) acc[b] = 0.f;
            const float* wp = w_ada + (size_t)l * 1024 * 9216 + n0 + lane;
#pragma unroll 1
            for (int k0 = wave * 128; k0 < wave * 128 + 128; k0 += 16) {
                float wv[16];
#pragma unroll
                for (int j = 0; j < 16; ++j) wv[j] = wp[(size_t)(k0 + j) * 9216];
                CFENCE();
#pragma unroll
                for (int j = 0; j < 16; ++j) { const int k = k0 + j; const float w = wv[j];
                    const f32x4 c0 = *(const LAS f32x4*)(cact + k * 16), c1 = *(const LAS f32x4*)(cact + k * 16 + 4), c2 = *(const LAS f32x4*)(cact + k * 16 + 8), c3 = *(const LAS f32x4*)(cact + k * 16 + 12);
#pragma unroll
                    for (int i = 0; i < 4; ++i) { acc[i] += c0[i] * w; acc[4 + i] += c1[i] * w; acc[8 + i] += c2[i] * w; acc[12 + i] += c3[i] * w; }
                    if ((j & 3) == 3) CFENCE(); }
            }
#pragma unroll
            for (int b = 0; b < 16; ++b) red[(wave * 16 + b) * 64 + lane] = acc[b];
            __syncthreads();
            for (int o = tid; o < 1024; o += 512) { const int b = o >> 6, ln = o & 63; float s = 0.f;
#pragma unroll
                for (int w = 0; w < 8; ++w) s += red[(w * 16 + b) * 64 + ln];
                MOD[((size_t)l * 16 + b) * 9216 + n0 + ln] = s + b_ada[l * 9216 + n0 + ln]; }
            __syncthreads();
        }
    }
    PH_NEXT;
    if (PH_ON) { DEFPTRS
        for (int i = bx * 512 + tid; i < 2 * 3 * 16 * 1024; i += G * 512) {
            const int k = i & 1023, b = (i >> 10) & 15, lj = i >> 14, l = lj / 3, j = lj % 3;
            const float* mp = MOD + ((size_t)l * 16 + b) * 9216 + j * 3072;
            GMOD[i] = g_norm[(l * 3 + j) * 1024 + k] * (1.0f + mp[1024 + k]);
            GATE[i] = (j == 1 ? 1.0f : 0.5f) * (1.0f + mp[2048 + k]);
        }
        LAS float* scr = (LAS float*)(lds + wave * 8448);
        constexpr int I_UP = 16 * 176, I_DN = 44 * 32, I_IN = 16 * 88, I_OUT = 16 * 32;
        constexpr int NIT = 4 * I_UP + 4 * I_DN + 2 * I_IN + 2 * I_OUT;
        for (int it = gw; it < NIT; it += NGW) {
            int r = it;
            if (r < 4 * I_UP) { const int mat = r / I_UP; r -= mat * I_UP; const int kb = r / 176, nb = r % 176, n0 = nb * 32;
                const int c0 = ((n0 >> 7) & 1) * DFF + (n0 >> 8) * 128 + (n0 & 127);
                transpose_item(w_up + (size_t)mat * DM * NUP, NUP, NUP, DM, WUP + (size_t)mat * NUP * DM, n0, c0, kb * 64, scr, lane); continue; }
            r -= 4 * I_UP;
            if (r < 4 * I_DN) { const int mat = r / I_DN; r -= mat * I_DN; const int kb = r / 32, nb = r % 32;
                transpose_item(w_dn + (size_t)mat * DFF * DM, DM, DM, DFF, WDN + (size_t)mat * DM * DFF, nb * 32, nb * 32, kb * 64, scr, lane); continue; }
            r -= 4 * I_DN;
            if (r < 2 * I_IN) { const int mat = r / I_IN; r -= mat * I_IN; const int kb = r / 88, nb = r % 88;
                transpose_item(w_in + (size_t)mat * DM * 2564, 2564, 2564, DM, WIN + (size_t)mat * NINP * DM, nb * 32, nb * 32, kb * 64, scr, lane); continue; }
            r -= 2 * I_IN;
            { const int mat = r / I_OUT; r -= mat * I_OUT; const int kb = r / 32, nb = r % 32;
                transpose_item(w_out + (size_t)mat * DM * DM, DM, DM, DM, WOUT + (size_t)mat * DM * DM, nb * 32, nb * 32, kb * 64, scr, lane); }
        }
        for (int m0 = gw; m0 < MTOK; m0 += 2 * NGW) {
            const int m1 = m0 + NGW;
            const f32x4* gp = (const f32x4*)(g_norm) + lane;
            const f32x4* xr0 = (const f32x4*)(x_in + (size_t)m0 * DM) + lane; const f32x4* xr1 = (const f32x4*)(x_in + (size_t)m1 * DM) + lane;
            f32x4 v0[4], v1[4];
#pragma unroll
            for (int j = 0; j < 4; ++j) { v0[j] = xr0[64 * j]; v1[j] = xr1[64 * j]; }
            const f32x4* sp0 = (const f32x4*)(MOD + (size_t)(m0 >> 12) * 9216 + 1024) + lane; const f32x4* sp1 = (const f32x4*)(MOD + (size_t)(m1 >> 12) * 9216 + 1024) + lane;
            float s0 = 0.f, s1 = 0.f; u32x2* o0 = (u32x2*)(XN + (size_t)m0 * DM) + lane; u32x2* o1 = (u32x2*)(XN + (size_t)m1 * DM) + lane;
#pragma unroll
            for (int j = 0; j < 4; ++j) { const f32x4 g = gp[64 * j];
                { const f32x4 v = v0[j]; s0 += (v[0] * v[0] + v[1] * v[1]) + (v[2] * v[2] + v[3] * v[3]); const f32x4 a = v * g * (sp0[64 * j] + 1.0f); u32x2 w; w.x = pk2(a[0], a[1]); w.y = pk2(a[2], a[3]); o0[64 * j] = w; }
                { const f32x4 v = v1[j]; s1 += (v[0] * v[0] + v[1] * v[1]) + (v[2] * v[2] + v[3] * v[3]); const f32x4 a = v * g * (sp1[64 * j] + 1.0f); u32x2 w; w.x = pk2(a[0], a[1]); w.y = pk2(a[2], a[3]); o1[64 * j] = w; } }
            s0 = wave_sum(s0); s1 = wave_sum(s1);
            if (lane == 0) { ROWSS[m0] = s0; ROWSS[m1] = s1; }
        }
    }
    PH_NEXT;
    if (PH_ON) { DEFPTRS
        LAS float* sh = (LAS float*)lds;
        for (int combo = 0; combo < 6; ++combo) {
            const int l = combo / 3, j = combo % 3;
            __syncthreads();
            for (int i = tid; i < 16 * 1024; i += 512) { const int b = i >> 10, k = i & 1023; sh[i] = MOD[((size_t)l * 16 + b) * 9216 + j * 3072 + k]; }
            __syncthreads();
            const bf16_t* Wt = (j == 1) ? WIN + (size_t)l * NINP * DM : WUP + (size_t)(l * 2 + (j == 2 ? 1 : 0)) * NUP * DM;
            const int N = (j == 1) ? NINP : NUP;
            float* dst = SBV + (size_t)combo * 16 * 5632;
            for (int n = gw; n < N; n += NGW) {
                float w[16];
#pragma unroll
                for (int c = 0; c < 4; ++c) { const u32x2 q = *(const u32x2*)(Wt + (size_t)n * DM + c * 256 + lane * 4);
                    w[4 * c] = __uint_as_float(q.x << 16); w[4 * c + 1] = __uint_as_float(q.x & 0xffff0000u); w[4 * c + 2] = __uint_as_float(q.y << 16); w[4 * c + 3] = __uint_as_float(q.y & 0xffff0000u); }
                float sv[16];
#pragma unroll
                for (int b = 0; b < 16; ++b) { float s = 0.f;
#pragma unroll
                    for (int c = 0; c < 4; ++c) { const f32x4 v = *(const LAS f32x4*)(sh + b * 1024 + c * 256 + lane * 4); s += (w[4 * c] * v[0] + w[4 * c + 1] * v[1]) + (w[4 * c + 2] * v[2] + w[4 * c + 3] * v[3]); }
                    sv[b] = s; if ((b & 3) == 3) CFENCE(); }
                float t8[8], t4[4], t2[2];
#pragma unroll
                for (int i = 0; i < 8; ++i) { const float snd = (lane & 32) ? sv[i] : sv[i + 8], kp = (lane & 32) ? sv[i + 8] : sv[i]; t8[i] = kp + __shfl_xor(snd, 32); }
#pragma unroll
                for (int i = 0; i < 4; ++i) { const float snd = (lane & 16) ? t8[i] : t8[i + 4], kp = (lane & 16) ? t8[i + 4] : t8[i]; t4[i] = kp + __shfl_xor(snd, 16); }
#pragma unroll
                for (int i = 0; i < 2; ++i) { const float snd = (lane & 8) ? t4[i] : t4[i + 2], kp = (lane & 8) ? t4[i + 2] : t4[i]; t2[i] = kp + __shfl_xor(snd, 8); }
                float t1; { const float snd = (lane & 4) ? t2[0] : t2[1], kp = (lane & 4) ? t2[1] : t2[0]; t1 = kp + __shfl_xor(snd, 4); }
                t1 += __shfl_xor(t1, 2); t1 += __shfl_xor(t1, 1);
                const int bsel = ((lane >> 5) & 1) * 8 + ((lane >> 4) & 1) * 4 + ((lane >> 3) & 1) * 2 + ((lane >> 2) & 1);
                if ((lane & 3) == 0) dst[(size_t)bsel * 5632 + n] = t1;
            }
        }
        __syncthreads();
    }
    PH_NEXT;

#ifdef REP_PRO
    if (rp_ == 0) { rp_ = 1; ph = 0; goto pro_again; }
#endif
#pragma unroll 1
    for (int f = 0; f < 4; ++f) {
        const int l = f >> 1, s = f & 1;
        if (s == 1) {
            if (PH_ON) { DEFPTRS
                pg8::Gemm g{XN, WIN + (size_t)l * NINP * DM, MTOK, NINP, DM}; pg8::StaticOrder S; S.init(MTOK, NINP, G, bx);
                pg8::EpiIn E{PROJ, FG, ROWSS + (size_t)(l * 3 + 1) * MTOK, SBV + (size_t)(l * 3 + 1) * 16 * 5632, lds + 131072 + 2048};
#ifndef NO_G_IN
                for (int rep_ = 0; rep_ < REP_IN; ++rep_) {
                pg8::gemm_phase<pg8::EpiIn, pg8::StaticOrder, true, true>(lds, g, S, E); }
#endif
            }
            PH_NEXT;
            if (PH_ON) { DEFPTRS
#ifndef NO_PREP
                {
                    const int blk = vcu & 7, n = lane & 31, hi = lane >> 5;
                    LAS unsigned char* wfl = lds;
                    LAS float* xs = (LAS float*)(lds + 16384 + wave * 13568);
                    LAS unsigned char* ub = lds + 16384 + wave * 13568 + 8960;
#pragma unroll
                    for (int q = 0; q < 2; ++q) { const int f = wave * 2 + q, gt = f >> 3, nb = (f >> 2) & 1, d0 = f & 3;
                        const float* wsrc = (gt ? w_ig : w_rg) + ((size_t)(l * 8 + blk) * 64 + 16 * d0 + 8 * hi) * 64 + nb * 32 + n;
                        u32x4 w; w.x = pk2(wsrc[0], wsrc[64]); w.y = pk2(wsrc[128], wsrc[192]); w.z = pk2(wsrc[256], wsrc[320]); w.w = pk2(wsrc[384], wsrc[448]);
                        *(LAS u32x4*)(wfl + f * 1024 + lane * 16) = w; }
                    __syncthreads();
                    float br[2], bi[2], cb[2], cw[2][4], c8[2];
#pragma unroll
                    for (int nb = 0; nb < 2; ++nb) { const int ch = blk * 64 + nb * 32 + n;
                        br[nb] = b_rg[l * 512 + ch]; bi[nb] = b_ig[l * 512 + ch]; cb[nb] = conv_b[l * 512 + ch];
#pragma unroll
                        for (int k = 0; k < 4; ++k) cw[nb][k] = conv_w[(l * 4 + k) * 512 + ch];
                        const float lmv = lam[l * 512 + ch];
                        c8[nb] = -8.0f * LOG2E * (__builtin_fmaxf(-lmv, 0.f) + log1pf(expf(-fabsf(lmv)))); }
                    for (int segi = (vcu >> 3) * 8 + wave; segi < REP_PREP * (MTOK / 32); segi += (G >> 3) * 8) { const int seg = segi & (MTOK / 32 - 1);
                        const int row0 = seg * 32; const bool first = (row0 & (SEQL - 1)) == 0;
                        const bf16_t* xp = PROJ + (size_t)row0 * PPITCH + blk * 64;
                        CFENCE();
#pragma unroll
                        for (int t = 0; t < 35; ++t) { float v = 0.f; if (t >= 3 || !first) v = bf2f((xp + ((long)t - 3) * PPITCH)[lane]); xs[t * 64 + lane] = v; }
                        CFENCE();
#pragma unroll
                        for (int nb = 0; nb < 2; ++nb)
#pragma unroll
                            for (int g = 0; g < 4; ++g) { const LAS float* xb = xs + (8 * g + 4 * hi) * 64 + nb * 32 + n; float xv[7];
#pragma unroll
                                for (int j = 0; j < 7; ++j) xv[j] = xb[j * 64];
#pragma unroll
                                for (int i = 0; i < 4; ++i) { const float uu = cb[nb] + cw[nb][0] * xv[i] + cw[nb][1] * xv[i + 1] + cw[nb][2] * xv[i + 2] + cw[nb][3] * xv[i + 3];
                                    *(LAS unsigned short*)(ub + (8 * g + 4 * hi + i) * 144 + (nb * 32 + n) * 2) = (unsigned short)f2bf(uu); }
                                __builtin_amdgcn_sched_barrier(0); }
                        CFENCE();
                        bf16x8 af[4];
#pragma unroll
                        for (int d0 = 0; d0 < 4; ++d0) af[d0] = *(const LAS bf16x8*)(ub + n * 144 + (16 * d0 + 8 * hi) * 2);
#pragma unroll
                        for (int nb = 0; nb < 2; ++nb) {
                            f32x16 arx, aix;
#pragma unroll
                            for (int r = 0; r < 16; ++r) { arx[r] = br[nb]; aix[r] = bi[nb]; }
#pragma unroll
                            for (int d0 = 0; d0 < 4; ++d0) { const bf16x8 w0 = *(const LAS bf16x8*)(wfl + ((0 * 2 + nb) * 4 + d0) * 1024 + lane * 16), w1 = *(const LAS bf16x8*)(wfl + ((1 * 2 + nb) * 4 + d0) * 1024 + lane * 16);
                                                             arx = __builtin_amdgcn_mfma_f32_32x32x16_bf16(af[d0], w0, arx, 0, 0, 0);
                                                             aix = __builtin_amdgcn_mfma_f32_32x32x16_bf16(af[d0], w1, aix, 0, 0, 0); }
                            CFENCE(); __builtin_amdgcn_sched_barrier(0);
#pragma unroll
                            for (int r = 0; r < 16; ++r) {
                                float uu; { const LAS float* xb = xs + (8 * (r >> 2) + 4 * hi + (r & 3)) * 64 + nb * 32 + n;
                                    uu = cb[nb] + cw[nb][0] * xb[0] + cw[nb][1] * xb[64] + cw[nb][2] * xb[128] + cw[nb][3] * xb[192]; }
                                const float rg = sigmoidf_(arx[r]), ig = sigmoidf_(aix[r]);
                                const float la2 = c8[nb] * rg, a = __builtin_amdgcn_exp2f(la2);
                                const float xx = 2.0f * 0.6931471805599453f * la2;
                                const float om = (xx > -0.25f) ? -xx * (1.0f + xx * 0.5f * (1.0f + xx * (1.0f / 3.0f) * (1.0f + xx * 0.25f * (1.0f + xx * 0.2f)))) : 1.0f - a * a;
                                arx[r] = a; aix[r] = __builtin_sqrtf(om) * ig * uu;
                            }
                            float H = 0.f, P = 1.f;
                            const int ch = blk * 64 + nb * 32 + n;
                            bf16_t* hl = HLOC + (size_t)(row0 + 4 * hi) * 512 + ch; bf16_t* pc = PCUM + (size_t)(row0 + 4 * hi) * 512 + ch;
#pragma unroll
                            for (int g = 0; g < 4; ++g) {
                                const float a0 = arx[4 * g], a1 = arx[4 * g + 1], a2 = arx[4 * g + 2], a3 = arx[4 * g + 3];
                                const float b0 = aix[4 * g], b1 = aix[4 * g + 1], b2 = aix[4 * g + 2], b3 = aix[4 * g + 3];
                                const float Ao = (a0 * a1) * (a2 * a3), Bo = ((b0 * a1 + b1) * a2 + b2) * a3 + b3;
                                const float Ap = __shfl_xor(Ao, 32), Bp = __shfl_xor(Bo, 32);
                                const float A1 = hi ? Ap : Ao, B1 = hi ? Bp : Bo, A2 = hi ? Ao : Ap, B2 = hi ? Bo : Bp;
                                const float Hm = A1 * H + B1, Pm = A1 * P;
                                float h = hi ? Hm : H, p = hi ? Pm : P;
                                H = A2 * Hm + B2; P = A2 * Pm;
                                bf16_t* hg = hl + (size_t)g * 8 * 512; bf16_t* pg = pc + (size_t)g * 8 * 512; asm volatile("" : "+v"(hg), "+v"(pg));
                                h = a0 * h + b0; p *= a0; hg[0 * 512] = (bf16_t)f2bf(h); pg[0 * 512] = (bf16_t)f2bf(p);
                                h = a1 * h + b1; p *= a1; hg[1 * 512] = (bf16_t)f2bf(h); pg[1 * 512] = (bf16_t)f2bf(p);
                                h = a2 * h + b2; p *= a2; hg[2 * 512] = (bf16_t)f2bf(h); pg[2 * 512] = (bf16_t)f2bf(p);
                                h = a3 * h + b3; p *= a3; hg[3 * 512] = (bf16_t)f2bf(h); pg[3 * 512] = (bf16_t)f2bf(p);
                            }
                            if (hi == 0) { ASEG[(size_t)seg * 512 + ch] = P; BSEG[(size_t)seg * 512 + ch] = H; }
                            CFENCE(); __builtin_amdgcn_sched_barrier(0);
                        }
                    }
                }
                for (int row = gw; row < MTOK; row += NGW) {
                    const u32x2 q = *(const u32x2*)(PROJ + (size_t)row * PPITCH + 2048 + lane * 4);
                    const float a0 = __uint_as_float(q.x << 16), a1 = __uint_as_float(q.x & 0xffff0000u), a2 = __uint_as_float(q.y << 16), a3 = __uint_as_float(q.y & 0xffff0000u);
                    float ss = (a0 * a0 + a1 * a1) + (a2 * a2 + a3 * a3);
                    ss += __shfl_xor(ss, 1); ss += __shfl_xor(ss, 2); ss += __shfl_xor(ss, 4); ss += __shfl_xor(ss, 8);
                    const float rk = __builtin_amdgcn_rsqf(ss * (1.0f / 64.0f) + EPSF);
                    u32x2 kn; kn.x = pk2(a0 * rk, a1 * rk); kn.y = pk2(a2 * rk, a3 * rk);
                    *(u32x2*)(PROJ + (size_t)row * PPITCH + 2048 + lane * 4) = kn;
                }
                for (int chn = vcu; chn < 64; chn += G) {
                    const int b = chn >> 2, h = chn & 3; const float bf = b_fg[l * 4 + h];
                    const int t0 = wave * 512 + lane * 8;
                    const float* fp = FG + ((size_t)b * SEQL + t0) * 4 + h;
                    float lf[8], tot = 0.f;
#pragma unroll
                    for (int i = 0; i < 8; ++i) { const float v = fp[i * 4] + bf; lf[i] = __builtin_fminf(v, 0.f) - log1pf(expf(-fabsf(v))); tot += lf[i]; }
                    float inc = tot;
#pragma unroll
                    for (int o = 1; o < 64; o <<= 1) { const float t_ = __shfl_up(inc, o); if (lane >= o) inc += t_; }
                    LAS float* wt = (LAS float*)(lds + 16384 + 8 * 13568);
                    __syncthreads();
                    if (lane == 63) wt[wave] = inc;
                    __syncthreads();
                    float run = inc - tot;
                    for (int w = 0; w < wave; ++w) run += wt[w];
                    f32x4 o0, o1;
                    run += lf[0]; o0[0] = -run * LOG2E; run += lf[1]; o0[1] = -run * LOG2E; run += lf[2]; o0[2] = -run * LOG2E; run += lf[3]; o0[3] = -run * LOG2E;
                    run += lf[4]; o1[0] = -run * LOG2E; run += lf[5]; o1[1] = -run * LOG2E; run += lf[6]; o1[2] = -run * LOG2E; run += lf[7]; o1[3] = -run * LOG2E;
                    float* op = F2 + (size_t)chn * SEQL + t0;
                    *(f32x4*)op = o0; *(f32x4*)(op + 4) = o1;
                }
#endif
                __syncthreads();
            }
            PH_NEXT;
            if (PH_ON) { DEFPTRS
#ifndef NO_ATTN
                for (int rep_ = 0; rep_ < REP_ATTN; ++rep_)
                for (int tt = vcu; tt < 256; tt += G) { const int ch = tid; float A = 1.f, B = 0.f;
#pragma unroll
                    for (int s8 = 0; s8 < 8; ++s8) { const float as_ = ASEG[(size_t)(tt * 8 + s8) * 512 + ch], bs_ = BSEG[(size_t)(tt * 8 + s8) * 512 + ch]; A = as_ * A; B = as_ * B + bs_; }
                    TSEGA[(size_t)tt * 512 + ch] = A; TSEGB[(size_t)tt * 512 + ch] = B; }
                for (int vw = vcu; vw < 256; vw += G) {
                    const int bh = vw >> 2, s4 = vw & 3, b = bh >> 2, h = bh & 3;
#pragma unroll 1
                    for (int i = 0; i < 4; ++i) { const int qb = (i == 0) ? s4 : (i == 1) ? 7 - s4 : (i == 2) ? 8 + s4 : 15 - s4;
#ifndef NO_FOX
                        attn_unit<1>(lds, PROJ, YU, KS, F2, g_qk + l * 128, b, h, qb);
#endif
 }
#pragma unroll 1
                    for (int i = 0; i < 4; ++i) { const int qb = (i == 0) ? s4 : (i == 1) ? 7 - s4 : (i == 2) ? 8 + s4 : 15 - s4;
#ifndef NO_SB
                        attn_unit<0>(lds, PROJ, YU, KS, F2, g_qk + l * 128, b, h, qb);
#endif
 }
                }
#endif
            }
            PH_NEXT;
            if (PH_ON) { DEFPTRS
                LAS float* hin = (LAS float*)lds;
                const f32x4 gm0 = *(const f32x4*)(g_mix + l * 1024 + lane * 8), gm1 = *(const f32x4*)(g_mix + l * 1024 + lane * 8 + 4);
                const f32x4 gx0 = *(const f32x4*)(g_mix + l * 1024 + 512 + lane * 8), gx1 = *(const f32x4*)(g_mix + l * 1024 + 512 + lane * 8 + 4);
                for (int tti = vcu; tti < REP_FIN * 256; tti += G) { const int tt = tti & 255;
                    __syncthreads();
                    { const int ch = tid, seg0 = (tt >> 4) * 128, nb = (tt & 15) * 8; float Hc = 0.f;
#pragma unroll 5
                      for (int t_ = (tt & ~15); t_ < tt; ++t_) Hc = TSEGA[(size_t)t_ * 512 + ch] * Hc + TSEGB[(size_t)t_ * 512 + ch];
#pragma unroll
                      for (int s8 = 0; s8 < 8; ++s8) { hin[s8 * 512 + ch] = Hc; Hc = ASEG[(size_t)(seg0 + nb + s8) * 512 + ch] * Hc + BSEG[(size_t)(seg0 + nb + s8) * 512 + ch]; } }
                    __syncthreads();
                    const f32x4 hi0 = *(const LAS f32x4*)(hin + wave * 512 + lane * 8), hi1 = *(const LAS f32x4*)(hin + wave * 512 + lane * 8 + 4);
#pragma unroll 2
                    for (int t = 0; t < 32; ++t) {
                        const size_t row = (size_t)tt * 256 + wave * 32 + t;
                        const u32x4 hq = *(const u32x4*)(HLOC + row * 512 + lane * 8);
                        const u32x4 pq = *(const u32x4*)(PCUM + row * 512 + lane * 8);
                        const u32x4 gq = *(const u32x4*)(PROJ + row * PPITCH + 512 + lane * 8);
                        const u32x4 yq = *(const u32x4*)(YU + row * 512 + lane * 8);
                        float y[8], yu[8]; float ss = 0.f, s2 = 0.f;
#pragma unroll
                        for (int i = 0; i < 8; ++i) {
                            const unsigned pw = pq[i >> 1], gw_ = gq[i >> 1], yw = yq[i >> 1];
                            const float p = (i & 1) ? __uint_as_float(pw & 0xffff0000u) : __uint_as_float(pw << 16);
                            const float gg = (i & 1) ? __uint_as_float(gw_ & 0xffff0000u) : __uint_as_float(gw_ << 16);
                            yu[i] = (i & 1) ? __uint_as_float(yw & 0xffff0000u) : __uint_as_float(yw << 16);
                            const unsigned hw = hq[i >> 1]; const float hlv = (i & 1) ? __uint_as_float(hw & 0xffff0000u) : __uint_as_float(hw << 16);
                            const float hh = hlv + p * (i < 4 ? hi0[i & 3] : hi1[i & 3]);
                            const float inner = 0.7978845608028654f * (gg + 0.044715f * gg * gg * gg);
                            const float ge = gg * __builtin_amdgcn_rcpf(1.0f + __builtin_amdgcn_exp2f(-2.0f * LOG2E * inner));
                            y[i] = hh * ge; ss += y[i] * y[i]; s2 += yu[i] * yu[i];
                        }
                        ss = wave_sum(ss);
                        s2 += __shfl_xor(s2, 1); s2 += __shfl_xor(s2, 2); s2 += __shfl_xor(s2, 4); s2 += __shfl_xor(s2, 8); s2 += __shfl_xor(s2, 16);
                        const float rl = __builtin_amdgcn_rsqf(ss * (1.0f / 512.0f) + EPSF), rx = __builtin_amdgcn_rsqf(s2 * (1.0f / 256.0f) + EPSF);
                        u32x4 o1, o2;
                        o1.x = pk2(y[0] * rl * gm0[0], y[1] * rl * gm0[1]); o1.y = pk2(y[2] * rl * gm0[2], y[3] * rl * gm0[3]);
                        o1.z = pk2(y[4] * rl * gm1[0], y[5] * rl * gm1[1]); o1.w = pk2(y[6] * rl * gm1[2], y[7] * rl * gm1[3]);
                        o2.x = pk2(yu[0] * rx * gx0[0], yu[1] * rx * gx0[1]); o2.y = pk2(yu[2] * rx * gx0[2], yu[3] * rx * gx0[3]);
                        o2.z = pk2(yu[4] * rx * gx1[0], yu[5] * rx * gx1[1]); o2.w = pk2(yu[6] * rx * gx1[2], yu[7] * rx * gx1[3]);
                        *(u32x4*)(YN + row * 1024 + lane * 8) = o1; *(u32x4*)(YN + row * 1024 + 512 + lane * 8) = o2;
                    }
                }
                __syncthreads();
            }
            PH_NEXT;
            if (PH_ON) { DEFPTRS
                pg8::Gemm g{YN, WOUT + (size_t)l * DM * DM, MTOK, DM, DM}; pg8::StaticOrder S; S.init(MTOK, DM, G, bx, 24);
                pg8::EpiRes E{xout, xout, GATE + (size_t)(l * 3 + 1) * 16 * 1024, GMOD + (size_t)(l * 3 + 2) * 16 * 1024, XN, ROWSS + (size_t)(l * 3 + 2) * MTOK, 1, lds + 131072 + 2048};
#ifndef NO_G_OUT
#ifdef REP_OUT
                { E.xout = (float*)HB; E.has_next = 0; pg8::gemm_phase<pg8::EpiRes, pg8::StaticOrder, false, true>(lds, g, S, E); E.xout = xout; E.has_next = 1; }
#endif
                pg8::gemm_phase<pg8::EpiRes, pg8::StaticOrder, false, true>(lds, g, S, E);
#endif
            }
            PH_NEXT;
        }
        const int j = s ? 2 : 0;
        if (PH_ON) { DEFPTRS
            pg8::Gemm g{XN, WUP + (size_t)(l * 2 + s) * NUP * DM, MTOK, NUP, DM}; pg8::StaticOrder S; S.init(MTOK, NUP, G, bx);
            pg8::EpiUp E{HB, ROWSS + (size_t)(l * 3 + j) * MTOK, SBV + (size_t)(l * 3 + j) * 16 * 5632, lds + 131072 + 2048};
#ifndef NO_G_UP
            for (int rep_ = 0; rep_ < REP_UP; ++rep_) {
            pg8::gemm_phase<pg8::EpiUp, pg8::StaticOrder, true, true>(lds, g, S, E);
            }
#endif
        }
        PH_NEXT;
        if (PH_ON) { DEFPTRS
            const int nl = s ? l + 1 : l, nj = s ? 0 : 1; const int has_next = (nl < 2) ? 1 : 0; const int nidx = has_next ? nl * 3 + nj : 0;
            pg8::Gemm g{HB, WDN + (size_t)(l * 2 + s) * DM * DFF, MTOK, DM, DFF}; pg8::StaticOrder S; S.init(MTOK, DM, G, bx, 24);
            pg8::EpiRes E{f == 0 ? x_in : xout, xout, GATE + (size_t)(l * 3 + j) * 16 * 1024, GMOD + (size_t)nidx * 16 * 1024, XN, ROWSS + (size_t)nidx * MTOK, has_next, lds + 131072 + 2048};
#ifndef NO_G_DN
#ifdef REP_DN
            for (int rep_ = 0; rep_ < 2; ++rep_) { E.xout = (rep_ == 0) ? (float*)HLOC : xout; E.has_next = (rep_ == 0) ? 0 : has_next;
            pg8::gemm_phase<pg8::EpiRes, pg8::StaticOrder, false, true>(lds, g, S, E); }
#else
            pg8::gemm_phase<pg8::EpiRes, pg8::StaticOrder, false, true>(lds, g, S, E);
#endif
#endif
        }
        PH_NEXT;
    }
#undef PH_ON
#undef PH_NEXT
}


#ifdef DBG_STOP
__global__ void dbg_dump(const unsigned char* ws, float* out, int mode) {
    const size_t n = (size_t)MTOK * DM; const size_t i0 = (size_t)blockIdx.x * blockDim.x + threadIdx.x, st = (size_t)gridDim.x * blockDim.x;
    const bf16_t* XN = (const bf16_t*)(ws + WS_XN); const bf16_t* HB = (const bf16_t*)(ws + WS_H); const bf16_t* PR = (const bf16_t*)(ws + WS_PROJ);
    const bf16_t* YU = (const bf16_t*)(ws + WS_YU); const float* HL = (const float*)(ws + WS_HLOC); const bf16_t* YN = (const bf16_t*)(ws + WS_YN); const bf16_t* PC = (const bf16_t*)(ws + WS_PCUM);
    for (size_t i = i0; i < n; i += st) {
        float v = 0.f;
        if (mode == 0) v = bf2f(XN[i]);
        else if (mode == 1) v = bf2f(HB[i]) + bf2f(HB[i + n]) + bf2f(HB[i + (size_t)117440512]);
        else if (mode == 2) v = bf2f(PR[i]) + bf2f(PR[i + n]) + bf2f(PR[i + (size_t)100663296]);
        else if (mode == 3) v = (i < n / 2) ? bf2f(YU[i]) : HL[i - n / 2];
        else if (mode == 4) v = bf2f(YN[i]);
        else if (mode == 6) v = (i < n / 2) ? bf2f(PC[i]) : ((const float*)(ws + WS_KS))[(i - n / 2) % (3 * 262144)];
        else if (mode == 7) v = HL[i % (n / 2)] + bf2f(PC[i % (n / 2)]) + ((const float*)(ws + WS_KS))[i % (3 * 262144)] + ((const float*)(ws + WS_ASEG))[i % (2 * 1048576)];
        if (mode == 3) { const bool nan_ = !(v == v), big = (v > 3e38f) || (v < -3e38f); float code = 0.f;
            if (i < n / 2) { const int col = (int)(i & 511); if (col < 256) code = nan_ ? 2000.f : (big ? 1000.f : 0.f); else code = (nan_ || big) ? 4000.f : 0.f; }
            else code = (nan_ || big) ? 8000.f : 0.f;
            v = code; }
        if (!(v == v)) v = 77777.f; if (v > 3e38f) v = 88888.f; if (v < -3e38f) v = 99999.f;
        if (mode != 5) out[i] = v;
    }
}
#endif
#ifndef MK_N_LAUNCHES
#define MK_N_LAUNCHES 1
#endif
constexpr int N_PHASES = 3 + 2 * 9;
extern "C" void kernel_launch(void* const* d_in, const int* in_sizes, int n_in, void* d_out, int out_size, void* d_ws, size_t ws_size, hipStream_t stream) {
    static int grid = 0;
    if (grid == 0) {
        if (n_in != 19 || out_size != MTOK * DM || ws_size < WS_END) { fprintf(stderr, "kernel_launch: unexpected shapes (n_in %d, out %d, ws %zu)\n", n_in, out_size, ws_size); grid = -1; return; }
        int dev = 0, cus = 0, per_cu = 0;
        hipGetDevice(&dev); hipDeviceGetAttribute(&cus, hipDeviceAttributeMultiprocessorCount, dev);
        if (hipFuncSetAttribute((const void*)mk_fwd, hipFuncAttributeMaxDynamicSharedMemorySize, LDS_BYTES) != hipSuccess) { fprintf(stderr, "kernel_launch: hipFuncSetAttribute failed\n"); grid = -1; return; }
        if (hipOccupancyMaxActiveBlocksPerMultiprocessor(&per_cu, (const void*)mk_fwd, 512, LDS_BYTES) != hipSuccess || per_cu < 1) { fprintf(stderr, "kernel_launch: occupancy query says %d\n", per_cu); per_cu = 1; }
        (void)hipGetLastError();
        grid = cus * 1;
    }
    if (grid < 0) return;
    if (hipMemsetAsync(d_ws, 0, 16384, stream) != hipSuccess) { fprintf(stderr, "kernel_launch: memset failed\n"); return; }
    Args a{};
    for (int i = 0; i < 19; ++i) a.in[i] = (const float*)d_in[i];
    a.out = (float*)d_out; a.ws = (unsigned char*)d_ws;
#if MK_N_LAUNCHES == 1
    a.ph_lo = 0; a.ph_hi = N_PHASES;
    void* kargs[] = {&a};
    hipError_t e = hipLaunchCooperativeKernel((const void*)mk_fwd, dim3(grid), dim3(512), kargs, LDS_BYTES, stream);
    if (e != hipSuccess) fprintf(stderr, "kernel_launch: cooperative launch failed: %s (grid %d)\n", hipGetErrorString(e), grid);
#else
#ifdef DBG_STOP
    for (int p = 0; p < DBG_STOP; ++p) { a.ph_lo = p; a.ph_hi = p + 1; hipLaunchKernelGGL(mk_fwd, dim3(grid), dim3(512), LDS_BYTES, stream, a); }
    hipLaunchKernelGGL(dbg_dump, dim3(2048), dim3(256), 0, stream, (const unsigned char*)d_ws, (float*)d_out, DBG_MODE);
#else
    for (int p = 0; p < N_PHASES; ++p) { a.ph_lo = p; a.ph_hi = p + 1; hipLaunchKernelGGL(mk_fwd, dim3(grid), dim3(512), LDS_BYTES, stream, a); }
#endif
#endif
}
```

```cpp
#include <hip/hip_runtime.h>
#include <hip/hip_cooperative_groups.h>
#include <cstdio>
#include <cstdint>
namespace cg = cooperative_groups;
namespace pg8 {
#define PG8_LAS __attribute__((address_space(3)))
typedef unsigned short bf16_t;
typedef short bf16x8 __attribute__((ext_vector_type(8)));
typedef float f32x4 __attribute__((ext_vector_type(4)));
typedef unsigned u32x4 __attribute__((ext_vector_type(4)));
constexpr int BM = 256, BK = 64, HALF = 128, HTB = HALF * BK * 2  , STAGE_BYTES = 8 * HTB, NXCD = 8, WGM = 8;

__host__ __device__ __forceinline__ int lds_byte(int r, int c) { const int st = (r >> 4) * 2 + (c >> 5), rr = r & 15, cc = c & 31, ob = rr * 64 + cc * 2; return st * 1024 + (ob ^ (((ob >> 9) & 1) << 5)); }
__host__ __device__ __forceinline__ void stage_rc(int b, int& R, int& C) { const int st = b / 1024, sb = b % 1024, swz = sb ^ (((sb >> 9) & 1) << 5); R = (st >> 1) * 16 + swz / 64; C = (st & 1) * 32 + (swz % 64) / 2; }
__host__ __device__ __forceinline__ int perm32(int rho) { const int n = rho >> 4, i = rho & 15; return 8 * (i >> 2) + 4 * n + (i & 3); }

struct Unit { int pm, pn; };
struct Gemm { const bf16_t* A; const bf16_t* Bt; int M, N, K; };

struct StaticOrder {
    int nM, nN, nwg, G, c, rev;
    __host__ __device__ void init(int M, int N, int G_, int c_, int rev_ = 0) { nM = M / BM; nN = N / BM; nwg = nM * nN; G = G_; c = c_; rev = rev_; }
    __host__ __device__ bool next(int i, Unit& u) const {
        const long L = (long)i * G + c; if (L >= nwg) return false;
        int wgid = (int)L; { const int q = nwg / NXCD, r = nwg % NXCD, xcd = wgid % NXCD, off = wgid / NXCD; wgid = (xcd < r ? xcd * (q + 1) : r * (q + 1) + (xcd - r) * q) + off; }
        const int nig = WGM * nN, gid = wgid / nig, fm = gid * WGM, gsz = (nM - fm) < WGM ? (nM - fm) : WGM;
        u.pm = (fm + ((wgid % nig) % gsz)) ^ rev; u.pn = (wgid % nig) / gsz; return true;
    }
    __device__ __forceinline__ void a_ready(const Unit&) const {}
    __device__ __forceinline__ void done(const Unit&) const {}
};

typedef float f32x2c_t __attribute__((ext_vector_type(2))); typedef __bf16 bf16x2c_t __attribute__((ext_vector_type(2)));
__device__ __forceinline__ unsigned cvt_pk_bf16(float lo, float hi) { f32x2c_t v = {lo, hi}; bf16x2c_t b = __builtin_convertvector(v, bf16x2c_t); return __builtin_bit_cast(unsigned, b); }
typedef float f32x2 __attribute__((ext_vector_type(2)));
constexpr float RMS_EPS = 1e-6f;
struct EpiUp {
    static constexpr bool PERM = true, AFTER_DRAIN = false;
    bf16_t* H; const float* rowss; const float* sb;
    PG8_LAS unsigned char* xl;
    __device__ __forceinline__ void prefetch(const Unit& u, int wid, int lane) const {
        if (wid < 4) __builtin_amdgcn_global_load_lds((const unsigned*)(rowss + u.pm * BM + wid * 64 + lane), (PG8_LAS unsigned*)(xl + wid * 256), 4, 0, 0);
        else if (wid == 4) __builtin_amdgcn_global_load_lds((const unsigned*)(sb + (size_t)(u.pm >> 4) * 5632 + u.pn * 256 + lane * 4), (PG8_LAS unsigned*)(xl + 1024), 16, 0, 0);
    }
    __device__ __forceinline__ void operator()(const f32x4 (&acc)[2][2][4][2], const Unit& u, int wr, int wc, int fr, int fq) const {
        const int row0 = u.pm * BM + wr * 64 + fr, b = u.pm >> 4, cl = wc * 32 + 8 * fq;
        const PG8_LAS float* xr = (const PG8_LAS float*)xl + wr * 64 + fr; const PG8_LAS float* xs_ = (const PG8_LAS float*)(xl + 1024) + cl; (void)b;
        float rsv[2][4];
#pragma unroll
        for (int ai = 0; ai < 2; ++ai)
#pragma unroll
            for (int m = 0; m < 4; ++m) rsv[ai][m] = xr[ai * HALF + m * 16];
        f32x4 sg[2], su[2];
#pragma unroll
        for (int n = 0; n < 2; ++n) { sg[n] = *(const PG8_LAS f32x4*)(xs_ + 4 * n); su[n] = *(const PG8_LAS f32x4*)(xs_ + 128 + 4 * n); }
#pragma unroll
        for (int ai = 0; ai < 2; ++ai)
#pragma unroll
            for (int m = 0; m < 4; ++m) {
                const int row = row0 + ai * HALF + m * 16;
                const float rs = __builtin_amdgcn_rsqf(rsv[ai][m] * (1.0f / 1024.0f) + RMS_EPS);
                unsigned wq[4];
#pragma unroll
                for (int n = 0; n < 2; ++n)
#pragma unroll
                    for (int ip = 0; ip < 2; ++ip) {
                        const f32x2 ag = (f32x2){acc[ai][0][m][n][2 * ip], acc[ai][0][m][n][2 * ip + 1]}, au = (f32x2){acc[ai][1][m][n][2 * ip], acc[ai][1][m][n][2 * ip + 1]};
                        const f32x2 g = ag * rs + (f32x2){sg[n][2 * ip], sg[n][2 * ip + 1]}, uu = au * rs + (f32x2){su[n][2 * ip], su[n][2 * ip + 1]};
                        const f32x2 t = g * (-1.4426950408889634f);
                        f32x2 d; d.x = __builtin_amdgcn_exp2f(t.x); d.y = __builtin_amdgcn_exp2f(t.y); d = d + 1.0f;
                        f32x2 r; r.x = __builtin_amdgcn_rcpf(d.x); r.y = __builtin_amdgcn_rcpf(d.y);
                        const f32x2 hv = (g * uu) * r;
                        wq[n * 2 + ip] = cvt_pk_bf16(hv.x, hv.y);
                    }
                u32x4 w; w.x = wq[0]; w.y = wq[1]; w.z = wq[2]; w.w = wq[3];
                *(u32x4*)(H + (size_t)row * 2816 + u.pn * 128 + cl) = w;
            }
    }
};
struct EpiIn {
    static constexpr bool PERM = true, AFTER_DRAIN = false;
    bf16_t* P; float* FG; const float* rowss; const float* sb;
    PG8_LAS unsigned char* xl;
    __device__ __forceinline__ void prefetch(const Unit& u, int wid, int lane) const {
        if (wid < 4) __builtin_amdgcn_global_load_lds((const unsigned*)(rowss + u.pm * BM + wid * 64 + lane), (PG8_LAS unsigned*)(xl + wid * 256), 4, 0, 0);
        else if (wid == 4) __builtin_amdgcn_global_load_lds((const unsigned*)(sb + (size_t)(u.pm >> 4) * 5632 + u.pn * 256 + lane * 4), (PG8_LAS unsigned*)(xl + 1024), 16, 0, 0);
    }
    __device__ __forceinline__ void operator()(const f32x4 (&acc)[2][2][4][2], const Unit& u, int wr, int wc, int fr, int fq) const {
        const int row0 = u.pm * BM + wr * 64 + fr, b = u.pm >> 4, cl = wc * 32 + 8 * fq;
        const PG8_LAS float* xr = (const PG8_LAS float*)xl + wr * 64 + fr; const PG8_LAS float* xs_ = (const PG8_LAS float*)(xl + 1024) + cl; (void)b;
        float rsv[2][4];
#pragma unroll
        for (int ai = 0; ai < 2; ++ai)
#pragma unroll
            for (int m = 0; m < 4; ++m) rsv[ai][m] = xr[ai * HALF + m * 16];
        f32x4 sv[2][2];
#pragma unroll
        for (int bj = 0; bj < 2; ++bj)
#pragma unroll
            for (int n = 0; n < 2; ++n) sv[bj][n] = *(const PG8_LAS f32x4*)(xs_ + bj * HALF + 4 * n);
#pragma unroll
        for (int ai = 0; ai < 2; ++ai)
#pragma unroll
            for (int m = 0; m < 4; ++m) {
                const int row = row0 + ai * HALF + m * 16;
                const float rs = __builtin_amdgcn_rsqf(rsv[ai][m] * (1.0f / 1024.0f) + RMS_EPS);
                if (u.pn < 10) {
#pragma unroll
                    for (int bj = 0; bj < 2; ++bj) {
                        const f32x4 v0 = acc[ai][bj][m][0] * rs + sv[bj][0], v1 = acc[ai][bj][m][1] * rs + sv[bj][1];
                        u32x4 w; w.x = cvt_pk_bf16(v0[0], v0[1]); w.y = cvt_pk_bf16(v0[2], v0[3]); w.z = cvt_pk_bf16(v1[0], v1[1]); w.w = cvt_pk_bf16(v1[2], v1[3]);
                        *(u32x4*)(P + (size_t)row * 2560 + u.pn * 256 + bj * HALF + cl) = w;
                    }
                } else if (wc == 0 && fq == 0) {
                    *(f32x4*)(FG + (size_t)row * 4) = acc[ai][0][m][0] * rs + sv[0][0];
                }
            }
    }
};
struct EpiRes {
    static constexpr bool PERM = false, AFTER_DRAIN = false;
    const float* xin; float* xout; const float* gate; const float* gmn; bf16_t* XN; float* rowssn; int has_next;
    PG8_LAS unsigned char* xl;
    __device__ __forceinline__ void prefetch(const Unit& u, int wid, int lane) const {
        if (wid == 0) __builtin_amdgcn_global_load_lds((const unsigned*)(gate + (u.pm >> 4) * 1024 + u.pn * BM + lane * 4), (PG8_LAS unsigned*)(xl), 16, 0, 0);
        else if (wid == 1) __builtin_amdgcn_global_load_lds((const unsigned*)(gmn + (u.pm >> 4) * 1024 + u.pn * BM + lane * 4), (PG8_LAS unsigned*)(xl + 1024), 16, 0, 0);
    }
    __device__ __forceinline__ void operator()(const f32x4 (&acc)[2][2][4][2], const Unit& u, int wr, int wc, int fr, int fq) const {
        typedef unsigned u32x2v __attribute__((ext_vector_type(2)));
        const int row0 = u.pm * BM + wr * 64 + fr, b = u.pm >> 4, col0 = u.pn * BM + wc * 32 + 4 * fq;
        const PG8_LAS float* gp_ = (const PG8_LAS float*)xl + wc * 32 + 4 * fq; const PG8_LAS float* gm_ = (const PG8_LAS float*)(xl + 1024) + wc * 32 + 4 * fq; (void)b;
#pragma unroll
        for (int ai = 0; ai < 2; ++ai) {
            f32x4 xi[4][2][2];
#pragma unroll
            for (int m = 0; m < 4; ++m)
#pragma unroll
                for (int bj = 0; bj < 2; ++bj)
#pragma unroll
                    for (int n = 0; n < 2; ++n) xi[m][bj][n] = *(const f32x4*)(xin + (size_t)(row0 + ai * HALF + m * 16) * 1024 + col0 + bj * HALF + n * 16);
            asm volatile("" ::: "memory");
#pragma unroll
            for (int m = 0; m < 4; ++m) {
                const int row = row0 + ai * HALF + m * 16; const size_t off = (size_t)row * 1024 + col0;
                float ss = 0.f;
#pragma unroll
                for (int bj = 0; bj < 2; ++bj)
#pragma unroll
                    for (int n = 0; n < 2; ++n) {
                        const f32x4 xo = xi[m][bj][n] + *(const PG8_LAS f32x4*)(gp_ + bj * HALF + n * 16) * acc[ai][bj][m][n];
                        *(f32x4*)(xout + off + bj * HALF + n * 16) = xo;
                        if (has_next) {
                            ss += (xo[0] * xo[0] + xo[1] * xo[1]) + (xo[2] * xo[2] + xo[3] * xo[3]);
                            const f32x4 a = xo * *(const PG8_LAS f32x4*)(gm_ + bj * HALF + n * 16); u32x2v w; w.x = cvt_pk_bf16(a[0], a[1]); w.y = cvt_pk_bf16(a[2], a[3]);
                            *(u32x2v*)(XN + off + bj * HALF + n * 16) = w;
                        }
                    }
                if (has_next) { ss += __shfl_xor(ss, 16); ss += __shfl_xor(ss, 32); if (fq == 0) unsafeAtomicAdd(rowssn + row, ss); }
            }
            asm volatile("" ::: "memory");
        }
    }
};

template <class Epi, class Sched, bool ALIGN_EPI = false, bool SP2 = false>
__device__ __forceinline__ void gemm_phase(PG8_LAS unsigned char* lds, const Gemm g, const Sched& S, const Epi& E) {
    int tid_o = threadIdx.x; asm volatile("" : "+v"(tid_o)); const int tid = tid_o, wid = __builtin_amdgcn_readfirstlane(tid >> 6), lane = tid & 63, wr = wid >> 2, wc = wid & 3, fr = lane & 15, fq = lane >> 4;
    const int K = g.K, nt = K / BK;
    unsigned voffA[2], voffB[2];
#pragma unroll
    for (int i = 0; i < 2; ++i) { int R, C; stage_rc(tid * 16 + i * 8192, R, C); const int Rb = Epi::PERM ? ((R & ~31) + perm32(R & 31)) : R;
        voffA[i] = (unsigned)(R * K + C) * 2u; voffB[i] = (unsigned)(Rb * K + C) * 2u; }
    const size_t kstep = (size_t)(BK * 2);
    const size_t hstep = (size_t)HALF * K * 2;
    const size_t tstep = 2 * hstep;
    const unsigned ldsw = (unsigned)wid * 1024u;
    const int aoff = lds_byte(wr * 64 + fr, fq * 8), boff = lds_byte(wc * 32 + fr, fq * 8);
#define PG8_SA(b, h) (((b) * 2 + (h)) * HTB)
#define PG8_SB(b, h) ((4 + (b) * 2 + (h)) * HTB)
#define PG8_STAGE(bufoff, gbase, voff) do { _Pragma("unroll") for (int _i = 0; _i < 2; ++_i) \
        __builtin_amdgcn_global_load_lds((const unsigned*)((const char*)(gbase) + (voff)[_i]), (PG8_LAS unsigned*)(lds + (bufoff) + ldsw + _i * 8192), 16, 0, 0); } while (0)
#define PG8_LDA(dst, b, h) do { _Pragma("unroll") for (int m = 0; m < 4; ++m) _Pragma("unroll") for (int k = 0; k < 2; ++k) dst[m][k] = *(const PG8_LAS bf16x8*)(lds + PG8_SA(b, h) + aoff + m * 2048 + k * 1024); } while (0)
#define PG8_LDB(dst, b, h) do { _Pragma("unroll") for (int n = 0; n < 2; ++n) _Pragma("unroll") for (int k = 0; k < 2; ++k) dst[n][k] = *(const PG8_LAS bf16x8*)(lds + PG8_SB(b, h) + boff + n * 2048 + k * 1024); } while (0)
#define PG8_MMA(ai, bj, At, Bt) do { __builtin_amdgcn_s_setprio(1); _Pragma("unroll") for (int m = 0; m < 4; ++m) _Pragma("unroll") for (int n = 0; n < 2; ++n) _Pragma("unroll") for (int k = 0; k < 2; ++k) \
        acc[ai][bj][m][n] = __builtin_amdgcn_mfma_f32_16x16x32_bf16(Bt[n][k], At[m][k], acc[ai][bj][m][n], 0, 0, 0); __builtin_amdgcn_s_setprio(0); } while (0)
#define PG8_WAIT_V(n) asm volatile("s_waitcnt vmcnt(" #n ")" ::: "memory")
#define PG8_WAIT_L(n) asm volatile("s_waitcnt lgkmcnt(" #n ")" ::: "memory")
#define PG8_BAR __builtin_amdgcn_s_barrier()
#define PG8_SCHED __builtin_amdgcn_sched_barrier(0)
    Unit cur, nxt; int ui = 0;
    if (!S.next(0, cur)) return;
    f32x4 acc[2][2][4][2];
#pragma unroll
    for (int a = 0; a < 2; ++a)
#pragma unroll
        for (int b = 0; b < 2; ++b)
#pragma unroll
            for (int m = 0; m < 4; ++m)
#pragma unroll
                for (int n = 0; n < 2; ++n) acc[a][b][m][n] = (f32x4){0.f, 0.f, 0.f, 0.f};
    bf16x8 At[4][2], B0[2][2], B1[2][2];
    const char* cA = (const char*)g.A + (size_t)cur.pm * tstep; const char* cB = (const char*)g.Bt + (size_t)cur.pn * tstep;
    S.a_ready(cur);
    if constexpr (SP2) {
        PG8_STAGE(PG8_SB(0, 0), cB, voffB); PG8_STAGE(PG8_SB(0, 1), cB + hstep, voffB); PG8_STAGE(PG8_SA(0, 0), cA, voffA); PG8_STAGE(PG8_SA(0, 1), cA + hstep, voffA);
        if (wr == 1) PG8_BAR;
        PG8_WAIT_V(2); PG8_BAR;
        PG8_STAGE(PG8_SB(1, 0), cB + kstep, voffB); PG8_STAGE(PG8_SA(1, 0), cA + kstep, voffA); PG8_STAGE(PG8_SB(1, 1), cB + hstep + kstep, voffB);
        PG8_WAIT_V(6); PG8_BAR;
    } else {
        PG8_STAGE(PG8_SB(0, 0), cB, voffB); PG8_STAGE(PG8_SA(0, 0), cA, voffA); PG8_STAGE(PG8_SB(0, 1), cB + hstep, voffB); PG8_STAGE(PG8_SA(0, 1), cA + hstep, voffA);
        if (wr == 1) PG8_BAR;
        PG8_WAIT_V(4); PG8_BAR;
        PG8_STAGE(PG8_SB(1, 0), cB + kstep, voffB); PG8_STAGE(PG8_SA(1, 0), cA + kstep, voffA); PG8_STAGE(PG8_SB(1, 1), cB + hstep + kstep, voffB);
        PG8_WAIT_V(6); PG8_BAR;
    }
    for (;;) {
        const bool has_next = S.next(ui + 1, nxt);
        const char* nA = has_next ? (const char*)g.A + (size_t)nxt.pm * tstep : cA; const char* nB = has_next ? (const char*)g.Bt + (size_t)nxt.pn * tstep : cB;
        for (int t = 0; t < nt; t += 2) {
            const bool last = (t == nt - 2);
            const char* a1 = cA + (size_t)(t + 1) * kstep;
            const char* a2 = last ? nA : cA + (size_t)(t + 2) * kstep; const char* b2 = last ? nB : cB + (size_t)(t + 2) * kstep;
            const char* a3 = a2 + kstep; const char* b3 = b2 + kstep;
            if (last) E.prefetch(cur, wid, lane);
            if (last && has_next) S.a_ready(nxt);
            if constexpr (SP2) {
            PG8_LDB(B0, 0, 0); PG8_LDB(B1, 0, 1); PG8_SCHED; PG8_LDA(At, 0, 0); PG8_STAGE(PG8_SA(1, 1), a1 + hstep, voffA);
            PG8_WAIT_V(8); PG8_WAIT_L(0); PG8_BAR; PG8_MMA(0, 0, At, B0); PG8_MMA(0, 1, At, B1); PG8_BAR; PG8_SCHED;
            PG8_LDA(At, 0, 1); PG8_STAGE(PG8_SB(0, 0), b2, voffB); PG8_STAGE(PG8_SB(0, 1), b2 + hstep, voffB); PG8_STAGE(PG8_SA(0, 0), a2, voffA);
            PG8_WAIT_V(8); PG8_WAIT_L(0); PG8_BAR; PG8_MMA(1, 0, At, B0); PG8_MMA(1, 1, At, B1); PG8_BAR; PG8_SCHED;
            PG8_LDB(B0, 1, 0); PG8_LDB(B1, 1, 1); PG8_SCHED; PG8_LDA(At, 1, 0); PG8_STAGE(PG8_SA(0, 1), a2 + hstep, voffA);
            PG8_WAIT_V(8); PG8_WAIT_L(0); PG8_BAR; PG8_MMA(0, 0, At, B0); PG8_MMA(0, 1, At, B1); PG8_BAR; PG8_SCHED;
            PG8_LDA(At, 1, 1); PG8_STAGE(PG8_SB(1, 0), b3, voffB); PG8_STAGE(PG8_SB(1, 1), b3 + hstep, voffB); PG8_STAGE(PG8_SA(1, 0), a3, voffA);
            PG8_WAIT_V(8); PG8_WAIT_L(0); PG8_BAR; PG8_MMA(1, 0, At, B0); PG8_MMA(1, 1, At, B1); PG8_BAR; PG8_SCHED;
            } else {
            PG8_LDB(B0, 0, 0); PG8_SCHED; PG8_LDA(At, 0, 0); PG8_STAGE(PG8_SA(1, 1), a1 + hstep, voffA);
            PG8_WAIT_L(8); PG8_BAR; PG8_WAIT_L(0); PG8_MMA(0, 0, At, B0); PG8_BAR; PG8_SCHED;
            PG8_LDB(B1, 0, 1); PG8_STAGE(PG8_SB(0, 0), b2, voffB);
            PG8_BAR; PG8_WAIT_L(0); PG8_MMA(0, 1, At, B1); PG8_BAR;
            PG8_LDA(At, 0, 1); PG8_STAGE(PG8_SA(0, 0), a2, voffA);
            PG8_BAR; PG8_WAIT_L(0); PG8_MMA(1, 0, At, B0); PG8_BAR; PG8_SCHED;
            PG8_STAGE(PG8_SB(0, 1), b2 + hstep, voffB);
            PG8_WAIT_V(6); PG8_BAR; PG8_MMA(1, 1, At, B1); PG8_BAR;
            PG8_LDB(B0, 1, 0); PG8_SCHED; PG8_LDA(At, 1, 0); PG8_STAGE(PG8_SA(0, 1), a2 + hstep, voffA);
            PG8_WAIT_L(8); PG8_BAR; PG8_WAIT_L(0); PG8_MMA(0, 0, At, B0); PG8_BAR; PG8_SCHED;
            PG8_LDB(B1, 1, 1); PG8_STAGE(PG8_SB(1, 0), b3, voffB);
            PG8_BAR; PG8_WAIT_L(0); PG8_MMA(0, 1, At, B1); PG8_BAR;
            PG8_LDA(At, 1, 1); PG8_STAGE(PG8_SA(1, 0), a3, voffA);
            PG8_BAR; PG8_WAIT_L(0); PG8_MMA(1, 0, At, B0); PG8_BAR; PG8_SCHED;
            PG8_STAGE(PG8_SB(1, 1), b3 + hstep, voffB);
            PG8_WAIT_V(6); PG8_BAR; PG8_MMA(1, 1, At, B1); PG8_BAR;
            }
        }
        if constexpr (ALIGN_EPI) { if (wr == 0) PG8_BAR; }
        if constexpr (!Epi::AFTER_DRAIN) { E(acc, cur, wr, wc, fr, fq); S.done(cur); }
        if (!has_next) break;
#pragma unroll
        for (int a = 0; a < 2; ++a)
#pragma unroll
            for (int b = 0; b < 2; ++b)
#pragma unroll
                for (int m = 0; m < 4; ++m)
#pragma unroll
                    for (int n = 0; n < 2; ++n) acc[a][b][m][n] = (f32x4){0.f, 0.f, 0.f, 0.f};
        cur = nxt; cA = nA; cB = nB; ++ui;
        if constexpr (ALIGN_EPI) { if (wr == 1) PG8_BAR; }
    }
    PG8_WAIT_V(0);
    if constexpr (!ALIGN_EPI) { if (wr == 0) PG8_BAR; }
    PG8_BAR;
    if constexpr (Epi::AFTER_DRAIN) { E.fused(acc, cur, wr, wc, fr, fq, lds, wid, lane); S.done(cur); }
#undef PG8_SA
#undef PG8_SB
#undef PG8_STAGE
#undef PG8_LDA
#undef PG8_LDB
#undef PG8_MMA
#undef PG8_WAIT_V
#undef PG8_WAIT_L
#undef PG8_BAR
#undef PG8_SCHED
}
}

#define LAS __attribute__((address_space(3)))
typedef unsigned short bf16_t;
typedef short bf16x8 __attribute__((ext_vector_type(8)));
typedef short s16x4 __attribute__((ext_vector_type(4)));
typedef float f32x4 __attribute__((ext_vector_type(4)));
typedef float f32x2 __attribute__((ext_vector_type(2)));
typedef float f32x16 __attribute__((ext_vector_type(16)));
typedef unsigned u32x4 __attribute__((ext_vector_type(4)));
typedef unsigned u32x2 __attribute__((ext_vector_type(2)));

constexpr int MTOK = 65536, DM = 1024, DFF = 2816, NUP = 5632, NINP = 2816, PPITCH = 2560, SEQL = 4096;
constexpr float EPSF = 1e-6f, LOG2E = 1.4426950408889634f;
constexpr size_t MiB = 1u << 20;
constexpr size_t WS_MOD = 1 * MiB, WS_GMOD = 3 * MiB, WS_GATE = 4 * MiB, WS_SB = 5 * MiB, WS_ROWSS = 8 * MiB, WS_KS = 10 * MiB, WS_F2 = 11 * MiB, WS_FG = 12 * MiB,
                 WS_ASEG = 13 * MiB, WS_BSEG = 17 * MiB, WS_WUP = 24 * MiB, WS_WDN = 68 * MiB, WS_WIN = 90 * MiB, WS_WOUT = 101 * MiB, WS_XN = 112 * MiB,
                 WS_H = 240 * MiB, WS_PROJ = 240 * MiB, WS_YU = 592 * MiB, WS_HLOC = 656 * MiB, WS_PCUM = 784 * MiB, WS_YN = 848 * MiB, WS_END = 976 * MiB;
constexpr int LDS_BYTES = 147456;

__device__ __forceinline__ float bf2f(unsigned short v) { return __uint_as_float((unsigned)v << 16); }
__device__ __forceinline__ unsigned f2bf(float f) { unsigned u = __float_as_uint(f); return (u + 0x7fffu + ((u >> 16) & 1u)) >> 16; }
__device__ __forceinline__ unsigned pk2(float lo, float hi) { return pg8::cvt_pk_bf16(lo, hi); }
__device__ __forceinline__ float wave_sum(float v) {
#pragma unroll
    for (int o = 1; o < 64; o <<= 1) v += __shfl_xor(v, o);
    return v;
}
__device__ __forceinline__ float sigmoidf_(float x) { return __builtin_amdgcn_rcpf(1.0f + __builtin_amdgcn_exp2f(-LOG2E * x)); }
#define WAITV(n) asm volatile("s_waitcnt vmcnt(" #n ")" ::: "memory")
#define LBAR() asm volatile("s_waitcnt lgkmcnt(0)\n\ts_barrier" ::: "memory")
#define CFENCE() asm volatile("" ::: "memory")

#ifndef REP_FIN
#define REP_FIN 1
#endif
#ifndef REP_IN
#define REP_IN 1
#endif
#ifndef REP_PREP
#define REP_PREP 1
#endif
#ifndef REP_ATTN
#define REP_ATTN 1
#endif
#ifndef REP_UP
#define REP_UP 1
#endif
struct Args { const float* in[19]; float* out; unsigned char* ws; int ph_lo, ph_hi; };

__device__ __forceinline__ void transpose_item(const float* __restrict__ W, int ldw, int clim, int K, bf16_t* __restrict__ WT, int n0, int c0, int k0, LAS float* scr, int lane) {
    const int col = c0 + (lane & 31);
#pragma unroll 16
    for (int i = 0; i < 32; ++i) { const int kk = 2 * i + (lane >> 5); scr[kk * 33 + (lane & 31)] = (col < clim) ? W[(size_t)(k0 + kk) * ldw + col] : 0.f; }
    asm volatile("s_waitcnt lgkmcnt(0)" ::: "memory");
    const int c = lane & 7;
#pragma unroll
    for (int j = 0; j < 4; ++j) { const int n = (lane >> 3) + 8 * j; const LAS float* s = scr + (8 * c) * 33 + n;
        u32x4 o; o.x = pk2(s[0 * 33], s[1 * 33]); o.y = pk2(s[2 * 33], s[3 * 33]); o.z = pk2(s[4 * 33], s[5 * 33]); o.w = pk2(s[6 * 33], s[7 * 33]);
        *(u32x4*)(WT + (size_t)(n0 + n) * K + k0 + 8 * c) = o; }
    asm volatile("s_waitcnt lgkmcnt(0)" ::: "memory");
}

__device__ __forceinline__ int crow(int r, int hi) { return (r & 3) + 8 * (r >> 2) + 4 * hi; }
__device__ __forceinline__ s16x4 vtr(const LAS unsigned char* p) {
    typedef short v4i16_t __attribute__((ext_vector_type(4)));
    return __builtin_bit_cast(s16x4, __builtin_amdgcn_ds_read_tr16_b64_v4i16((LAS v4i16_t*)p));
}
constexpr int AT_SLOT = 16384, AT_AUX = 3 * AT_SLOT, AT_WSF = AT_AUX + 3 * 512, AT_VOTE = AT_WSF + 8 * 256;
constexpr float C2 = 0.125f * LOG2E;

__device__ __forceinline__ void sb_block(f32x16& X, float& carry, bool band, int kv0  , int qrel, int hi) {
    float lm[16];
#pragma unroll
    for (int r = 0; r < 16; ++r) {
        float z2 = X[r] * C2; z2 = __builtin_fminf(__builtin_fmaxf(z2, -120.f), 120.f);
        const float e = __builtin_amdgcn_exp2f(-z2), sp = __builtin_amdgcn_logf(1.0f + e);
        float l1 = -(sp + z2), lb = -sp;
        if (band) { const int kv = kv0 + (r & 3) + 8 * (r >> 2); const bool valid = kv < qrel; l1 = valid ? l1 : 0.f; lb = valid ? lb : -INFINITY; }
        lm[r] = l1; X[r] = lb;
    }
    float G[4], Gp[4], T[4];
#pragma unroll
    for (int g = 0; g < 4; ++g) { G[g] = (lm[4 * g] + lm[4 * g + 1]) + (lm[4 * g + 2] + lm[4 * g + 3]); Gp[g] = __shfl_xor(G[g], 32); T[g] = G[g] + Gp[g]; }
    float S = carry;
#pragma unroll
    for (int g = 3; g >= 0; --g) {
        const float a3 = S + (hi == 0 ? Gp[g] : 0.f), a2 = a3 + lm[4 * g + 3], a1 = a2 + lm[4 * g + 2], a0 = a1 + lm[4 * g + 1];
        X[4 * g + 3] = __builtin_amdgcn_exp2f(X[4 * g + 3] + a3); X[4 * g + 2] = __builtin_amdgcn_exp2f(X[4 * g + 2] + a2);
        X[4 * g + 1] = __builtin_amdgcn_exp2f(X[4 * g + 1] + a1); X[4 * g] = __builtin_amdgcn_exp2f(X[4 * g] + a0);
        S += T[g];
    }
    carry = S;
}

template <int KIND>
__device__ __forceinline__ void attn_unit(LAS unsigned char* lds, const bf16_t* __restrict__ PROJ, bf16_t* __restrict__ YU, const float* __restrict__ KS,
                                          const float* __restrict__ F2, const float* __restrict__ gqk, int b, int h, int qb) {
    int tid_o = threadIdx.x; asm volatile("" : "+v"(tid_o));
    const int tid = tid_o, lane = tid & 63, r32 = lane & 31, hi = lane >> 5;
    const int wid = __builtin_amdgcn_readfirstlane(tid >> 6);
    const int qcol = (KIND == 0 ? 1024 : 1792) + h * 64, kcol = qcol + 256, vcol = qcol + 512;
    const size_t rowbase = (size_t)b * SEQL; const int q0 = qb * 256, bh = b * 4 + h;
    const int NT = (q0 + 256) / 64;
    const bf16_t* ksrc = PROJ + (rowbase + lane) * PPITCH + kcol + wid * 8;
    const bf16_t* vsrc = PROJ + (rowbase + 16 * (wid & 3) + (lane >> 2)) * PPITCH + vcol + (wid >> 2) * 32 + (lane & 3) * 8;
    const float* axsrc = F2 + (size_t)bh * SEQL + lane;
    u32x4 kreg, vreg; float areg = 0.f;
#define AT_LOAD(it_) do { const int kt_ = NT - 1 - (it_); kreg = *(const u32x4*)(ksrc + (size_t)kt_ * 64 * PPITCH); vreg = *(const u32x4*)(vsrc + (size_t)kt_ * 64 * PPITCH); \
        if (KIND == 1 && wid == 0) areg = axsrc[kt_ * 64]; } while (0)
#define AT_STORE(slot_) do { *(LAS u32x4*)(lds + (slot_) * AT_SLOT + wid * 1024 + lane * 16) = kreg; *(LAS u32x4*)(lds + (slot_) * AT_SLOT + 8192 + wid * 1024 + lane * 16) = vreg; \
        if (KIND == 1 && wid == 0) *(LAS float*)(lds + AT_AUX + (slot_) * 512 + lane * 4) = areg; } while (0)
    const bf16_t* Qw = PROJ + (rowbase + q0 + wid * 32 + r32) * PPITCH + qcol + hi * 8;
    bf16x8 qr[4];
#pragma unroll
    for (int d0 = 0; d0 < 4; ++d0) qr[d0] = *(const bf16x8*)(Qw + d0 * 16);
    AT_LOAD(0);
    float qn2 = 0.f, mref = 0.f;
    if (KIND == 1) {
        float qf[4][8]; float ss = 0.f;
#pragma unroll
        for (int d0 = 0; d0 < 4; ++d0)
#pragma unroll
            for (int i = 0; i < 8; ++i) { qf[d0][i] = bf2f((unsigned short)qr[d0][i]); ss += qf[d0][i] * qf[d0][i]; }
        ss += __shfl_xor(ss, 32);
        const float rs = __builtin_amdgcn_rsqf(ss * (1.0f / 64.0f) + EPSF) * C2;
#pragma unroll
        for (int d0 = 0; d0 < 4; ++d0) {
            const float* gp = gqk + d0 * 16 + hi * 8; float v[8];
#pragma unroll
            for (int i = 0; i < 8; ++i) { v[i] = qf[d0][i] * rs * gp[i] * gp[64 + i]; qn2 += v[i] * v[i]; }
            u32x4 w; w.x = pk2(v[0], v[1]); w.y = pk2(v[2], v[3]); w.z = pk2(v[4], v[5]); w.w = pk2(v[6], v[7]);
            qr[d0] = __builtin_bit_cast(bf16x8, w);
        }
        qn2 += __shfl_xor(qn2, 32);
        mref = F2[(size_t)bh * SEQL + q0 + wid * 32 + r32] + __builtin_fminf(8.08f * __builtin_sqrtf(qn2), 60.0f);
    }
    f32x16 o0, o1;
#pragma unroll
    for (int r = 0; r < 16; ++r) { o0[r] = 0.f; o1[r] = 0.f; }
    float mhat = -1e30f, lsum = 0.f, carry = 0.f;
    LAS float* wsf = (LAS float*)(lds + AT_WSF) + wid * 64;
    LAS unsigned* votes = (LAS unsigned*)(lds + AT_VOTE);
    const int qrel = wid * 32 + r32;
    bool wdone = false;
    AT_STORE(0); LBAR();
    for (int it = 0; it < NT; ++it) {
        const int slot = it & 1;
        if (KIND == 0 && it > 0) {
            const LAS unsigned* vp = votes + ((it - 1) & 1) * 8;
            const unsigned all = vp[0] & vp[1] & vp[2] & vp[3] & vp[4] & vp[5] & vp[6] & vp[7];
            if (all) break;
        }
        if (it + 1 < NT) AT_LOAD(it + 1);
        const int kt = NT - 1 - it, jb = kt - (NT - 4);
        const bool band = jb >= 0;
        const bool active = !(band && 64 * jb > 32 * wid + 31) && !wdone;
        if (active) {
            f32x16 p0, p1;
            __builtin_amdgcn_s_setprio(1);
            { const LAS unsigned char* kb = lds + slot * AT_SLOT + hi * 1024 + r32 * 16;
#pragma unroll
              for (int d0 = 0; d0 < 4; ++d0) {
                  const bf16x8 b0 = *(const LAS bf16x8*)(kb + d0 * 2048), b1 = *(const LAS bf16x8*)(kb + d0 * 2048 + 512);
                  if (d0 == 0) { f32x16 z;
#pragma unroll
                      for (int r = 0; r < 16; ++r) z[r] = (KIND == 1) ? -mref : 0.f;
                      p0 = __builtin_amdgcn_mfma_f32_32x32x16_bf16(b0, qr[0], z, 0, 0, 0); p1 = __builtin_amdgcn_mfma_f32_32x32x16_bf16(b1, qr[0], z, 0, 0, 0); }
                  else { p0 = __builtin_amdgcn_mfma_f32_32x32x16_bf16(b0, qr[d0], p0, 0, 0, 0); p1 = __builtin_amdgcn_mfma_f32_32x32x16_bf16(b1, qr[d0], p1, 0, 0, 0); }
              } }
            __builtin_amdgcn_s_setprio(0);
            if (KIND == 0) {
                sb_block(p1, carry, band, 64 * jb + 32 + 4 * hi, qrel, hi);
                sb_block(p0, carry, band, 64 * jb + 4 * hi, qrel, hi);
            } else {
                const LAS float* ax = (const LAS float*)(lds + AT_AUX + slot * 512);
                f32x2 sacc2 = (f32x2){0.f, 0.f};
#pragma unroll
                for (int g = 0; g < 4; ++g) {
                    const f32x4 f0 = *(const LAS f32x4*)(ax + 8 * g + 4 * hi), f1 = *(const LAS f32x4*)(ax + 32 + 8 * g + 4 * hi);
#pragma unroll
                    for (int i = 0; i < 4; ++i) { p0[4 * g + i] += f0[i]; p1[4 * g + i] += f1[i]; }
                }
                if (band) {
#pragma unroll
                    for (int r = 0; r < 16; ++r) { const int kv = 64 * jb + crow(r, hi); if (kv > qrel) p0[r] = -INFINITY; if (kv + 32 > qrel) p1[r] = -INFINITY; }
                }
#pragma unroll
                for (int r = 0; r < 16; r += 2) {
                    p0[r] = __builtin_amdgcn_exp2f(p0[r]); p0[r + 1] = __builtin_amdgcn_exp2f(p0[r + 1]); p1[r] = __builtin_amdgcn_exp2f(p1[r]); p1[r + 1] = __builtin_amdgcn_exp2f(p1[r + 1]);
                    sacc2 += (f32x2){p0[r], p0[r + 1]}; sacc2 += (f32x2){p1[r], p1[r + 1]};
                }
                lsum += sacc2[0] + sacc2[1];
            }
            u32x4 pw0, pw1, pw2, pw3;
            pw0.x = pk2(p0[0], p0[1]); pw0.y = pk2(p0[2], p0[3]); pw0.z = pk2(p0[4], p0[5]); pw0.w = pk2(p0[6], p0[7]);
            pw1.x = pk2(p0[8], p0[9]); pw1.y = pk2(p0[10], p0[11]); pw1.z = pk2(p0[12], p0[13]); pw1.w = pk2(p0[14], p0[15]);
            pw2.x = pk2(p1[0], p1[1]); pw2.y = pk2(p1[2], p1[3]); pw2.z = pk2(p1[4], p1[5]); pw2.w = pk2(p1[6], p1[7]);
            pw3.x = pk2(p1[8], p1[9]); pw3.y = pk2(p1[10], p1[11]); pw3.z = pk2(p1[12], p1[13]); pw3.w = pk2(p1[14], p1[15]);
            const LAS unsigned char* vb = lds + slot * AT_SLOT + 8192 + ((lane >> 4) & 1) * 32 + (lane & 3) * 8 + (4 * hi + ((lane & 15) >> 2)) * 64;
            s16x4 vlo[8], vhi[8];
#pragma unroll
            for (int i = 0; i < 8; ++i) { vlo[i] = vtr(vb + (i >> 2) * 4096 + (i & 3) * 1024); vhi[i] = vtr(vb + (i >> 2) * 4096 + (i & 3) * 1024 + 512); }
#define VFR(i) (bf16x8){vlo[i][0], vlo[i][1], vlo[i][2], vlo[i][3], vhi[i][0], vhi[i][1], vhi[i][2], vhi[i][3]}
#define PAF(x) __builtin_bit_cast(bf16x8, x)
            __builtin_amdgcn_s_setprio(1);
            o0 = __builtin_amdgcn_mfma_f32_32x32x16_bf16(PAF(pw0), VFR(0), o0, 0, 0, 0); o1 = __builtin_amdgcn_mfma_f32_32x32x16_bf16(PAF(pw0), VFR(4), o1, 0, 0, 0);
            o0 = __builtin_amdgcn_mfma_f32_32x32x16_bf16(PAF(pw1), VFR(1), o0, 0, 0, 0); o1 = __builtin_amdgcn_mfma_f32_32x32x16_bf16(PAF(pw1), VFR(5), o1, 0, 0, 0);
            o0 = __builtin_amdgcn_mfma_f32_32x32x16_bf16(PAF(pw2), VFR(2), o0, 0, 0, 0); o1 = __builtin_amdgcn_mfma_f32_32x32x16_bf16(PAF(pw2), VFR(6), o1, 0, 0, 0);
            o0 = __builtin_amdgcn_mfma_f32_32x32x16_bf16(PAF(pw3), VFR(3), o0, 0, 0, 0); o1 = __builtin_amdgcn_mfma_f32_32x32x16_bf16(PAF(pw3), VFR(7), o1, 0, 0, 0);
            __builtin_amdgcn_s_setprio(0);
#undef VFR
#undef PAF
        }
        if (KIND == 0) { if (active) wdone = __all(carry < -150.0f); if (lane == 0) votes[(it & 1) * 8 + wid] = wdone ? 1u : 0u; }
        if (it + 1 < NT) AT_STORE(slot ^ 1);
        LBAR();
    }
    if (KIND == 1) { lsum += __shfl_xor(lsum, 32); CFENCE(); if (hi == 0) wsf[r32] = lsum; CFENCE(); asm volatile("s_waitcnt lgkmcnt(0)" ::: "memory"); }
    bf16_t* Yw = YU + (rowbase + q0 + wid * 32) * 512 + KIND * 256 + h * 64 + r32;
#pragma unroll
    for (int r = 0; r < 16; ++r) {
        const int orow = crow(r, hi); float sc = 1.0f;
        if (KIND == 1) sc = __builtin_amdgcn_rcpf(wsf[orow]);
        Yw[(size_t)orow * 512] = (bf16_t)f2bf(o0[r] * sc); Yw[(size_t)orow * 512 + 32] = (bf16_t)f2bf(o1[r] * sc);
    }
    LBAR();
#undef AT_LOAD
#undef AT_STORE
}

#define DEFPTRS \
    const __attribute__((address_space(4))) Args* ka_ = (const __attribute__((address_space(4))) Args*)__builtin_amdgcn_kernarg_segment_ptr(); \
    asm volatile("" : "+s"(ka_)); \
    int tid_o_ = threadIdx.x; asm volatile("" : "+v"(tid_o_)); const int tid = tid_o_, lane = tid & 63; (void)lane; \
    unsigned char* ws = ka_->ws; \
    const float* x_in = ka_->in[0]; const float* c_in = ka_->in[1]; const float* w_ada = ka_->in[2]; const float* b_ada = ka_->in[3]; const float* g_norm = ka_->in[4]; \
    const float* w_up = ka_->in[5]; const float* w_dn = ka_->in[6]; const float* w_in = ka_->in[7]; const float* b_fg = ka_->in[8]; const float* conv_w = ka_->in[9]; \
    const float* conv_b = ka_->in[10]; const float* w_rg = ka_->in[11]; const float* b_rg = ka_->in[12]; const float* w_ig = ka_->in[13]; const float* b_ig = ka_->in[14]; \
    const float* lam = ka_->in[15]; const float* g_qk = ka_->in[16]; const float* g_mix = ka_->in[17]; const float* w_out = ka_->in[18]; \
    float* xout = ka_->out; \
    float* MOD = (float*)(ws + WS_MOD); float* GMOD = (float*)(ws + WS_GMOD); float* GATE = (float*)(ws + WS_GATE); float* SBV = (float*)(ws + WS_SB); \
    float* ROWSS = (float*)(ws + WS_ROWSS); float* KS = (float*)(ws + WS_KS); float* F2 = (float*)(ws + WS_F2); float* FG = (float*)(ws + WS_FG); \
    float* ASEG = (float*)(ws + WS_ASEG); float* BSEG = (float*)(ws + WS_BSEG); float* TSEGA = (float*)(ws + 21 * MiB); float* TSEGB = (float*)(ws + 22 * MiB); \
    bf16_t* WUP = (bf16_t*)(ws + WS_WUP); bf16_t* WDN = (bf16_t*)(ws + WS_WDN); bf16_t* WIN = (bf16_t*)(ws + WS_WIN); bf16_t* WOUT = (bf16_t*)(ws + WS_WOUT); \
    bf16_t* XN = (bf16_t*)(ws + WS_XN); bf16_t* HB = (bf16_t*)(ws + WS_H); bf16_t* PROJ = (bf16_t*)(ws + WS_PROJ); bf16_t* YU = (bf16_t*)(ws + WS_YU); \
    bf16_t* HLOC = (bf16_t*)(ws + WS_HLOC); bf16_t* PCUM = (bf16_t*)(ws + WS_PCUM); bf16_t* YN = (bf16_t*)(ws + WS_YN);
#define XB_TMO      128
#define XB_XCNT(j)  (256  + 64 * (j))
#define XB_XSUB(j)  (1280 + 64 * (j))
#define XB_XGEN(j)  (2304 + 64 * (j))
#define XB_TOP      3328
#define XB_TOPGEN   3392
#define XCD_BAR_WORDS 3456
#define XB_SPIN_CAP (1u << 18)

__device__ __forceinline__ unsigned xb_ld(unsigned* p)              { return __hip_atomic_load(p, __ATOMIC_RELAXED, __HIP_MEMORY_SCOPE_AGENT); }
__device__ __forceinline__ unsigned xb_add(unsigned* p, unsigned v) { return __hip_atomic_fetch_add(p, v, __ATOMIC_RELAXED, __HIP_MEMORY_SCOPE_AGENT); }
__device__ __forceinline__ unsigned xb_xcc_id() { return (unsigned)__builtin_amdgcn_s_getreg((3 << 11) | 20) & 0xFu; }
#define XB_SPIN(cond, bar) do { unsigned _sp = 0; while (cond) { __builtin_amdgcn_s_sleep(1); \
    if ((++_sp & 255u) == 0u) { if (xb_ld(&(bar)[XB_TMO])) break; if (_sp > XB_SPIN_CAP) { atomicAdd(&(bar)[XB_TMO], 1u); break; } } } } while (0)

struct XcdBarrier {
    unsigned* bar; unsigned x;
    volatile LAS unsigned* st;
};

__device__ __forceinline__ XcdBarrier xcd_barrier_post(unsigned* bar, volatile LAS unsigned* st) {
    XcdBarrier b; b.bar = bar; b.x = xb_xcc_id(); b.st = st;
    if (threadIdx.x == 0) (void)xb_add(&bar[XB_XCNT(b.x)], 1u);
    return b;
}
__device__ __forceinline__ void xcd_barrier_complete(unsigned* bar, unsigned x, unsigned& nloc, unsigned& nx) {
    const unsigned G = gridDim.x * gridDim.y * gridDim.z;
    unsigned sum, cnt, mine, sp = 0u;
    for (;;) {
        sum = 0u; cnt = 0u; mine = 0u;
#pragma unroll
        for (unsigned j = 0; j < 16; ++j) { const unsigned c = xb_ld(&bar[XB_XCNT(j)]); sum += c; cnt += (c > 0u) ? 1u : 0u; mine = (j == x) ? c : mine; }
        if (sum == G) break;
        __builtin_amdgcn_s_sleep(1);
        if ((++sp & 255u) == 0u) { if (xb_ld(&bar[XB_TMO])) break; if (sp > XB_SPIN_CAP) { atomicAdd(&bar[XB_TMO], 1u); break; } }
    }
    nloc = mine > 0u ? mine : 1u; nx = cnt > 0u ? cnt : 1u;
}

__device__ __forceinline__ void xcd_barrier(const XcdBarrier& b) {
    asm volatile("s_waitcnt vmcnt(0)" ::: "memory");
    __syncthreads();
    if (threadIdx.x == 0) {
        unsigned* bar = b.bar;
        __builtin_amdgcn_s_waitcnt(0);
        unsigned nloc = b.st[0], nx = b.st[1];
        if (nloc == 0u) { xcd_barrier_complete(bar, b.x, nloc, nx); b.st[0] = nloc; b.st[1] = nx; }
        const unsigned old = xb_add(&bar[XB_XSUB(b.x)], 1u);
        const unsigned gen = old / nloc;
        if (old + 1u == (gen + 1u) * nloc) {
            __builtin_amdgcn_fence(__ATOMIC_RELEASE, "agent");
            asm volatile("s_waitcnt vmcnt(0)" ::: "memory");
            const unsigned og = xb_add(&bar[XB_TOP], 1u);
            const unsigned tg = og / nx;
            if (og + 1u == (tg + 1u) * nx) xb_add(&bar[XB_TOPGEN], 1u);
            else XB_SPIN(xb_ld(&bar[XB_TOPGEN]) == tg, bar);
            __builtin_amdgcn_fence(__ATOMIC_ACQUIRE, "agent");
            xb_add(&bar[XB_XGEN(b.x)], 1u);
            asm volatile("s_waitcnt vmcnt(0)" ::: "memory");
        } else {
            XB_SPIN(xb_ld(&bar[XB_XGEN(b.x)]) == gen, bar);
            __builtin_amdgcn_fence(__ATOMIC_ACQUIRE, "agent");
            asm volatile("s_waitcnt vmcnt(0)" ::: "memory");
        }
    }
    __syncthreads();
}

__global__ void __launch_bounds__(512) mk_fwd(Args args) {
    extern __shared__ __attribute__((aligned(16))) unsigned char lds_raw[];
    LAS unsigned char* lds = (LAS unsigned char*)lds_raw;
    cg::grid_group grid = cg::this_grid();
    const int wave = __builtin_amdgcn_readfirstlane(threadIdx.x >> 6);
    const int G = gridDim.x; const int bx = blockIdx.x;
    const int vcu = (G % 8 == 0) ? (bx % 8) * (G / 8) + bx / 8 : bx;
    const int gw = vcu * 8 + wave, NGW = G * 8;
    const int lo = args.ph_lo, hi_ph = args.ph_hi;
    volatile LAS unsigned* MISC = (volatile LAS unsigned*)(lds + 131072 + 320);
    if (threadIdx.x < 16) MISC[threadIdx.x] = 0u;
    __syncthreads();
    XcdBarrier xbar = xcd_barrier_post((unsigned*)args.ws, MISC + 8);
    int ph = 0;
#define PH_ON (ph >= lo && ph < hi_ph)
#ifdef REP_SYNC
#define SYNC_EXTRA grid.sync(); asm volatile("" ::: "memory");
#else
#define SYNC_EXTRA
#endif
#define PH_NEXT do { ++ph; if (ph > lo && ph < hi_ph) { asm volatile("s_waitcnt vmcnt(0) lgkmcnt(0)" ::: "memory"); if (ph == 1) grid.sync(); else xcd_barrier(xbar); asm volatile("" ::: "memory"); SYNC_EXTRA } } while (0)

#ifdef REP_PRO
    int rp_ = 0; pro_again:
#endif
    if (PH_ON) { DEFPTRS
        for (int i = bx * 512 + tid; i < 5 * MTOK; i += G * 512) ROWSS[MTOK + i] = 0.f;
        LAS float* cact = (LAS float*)lds;
        LAS float* red = (LAS float*)(lds + 65536);
        for (int i = tid; i < 16 * 1024; i += 512) { const int b = i >> 10, k = i & 1023; const float v = c_in[i]; cact[k * 16 + b] = v * sigmoidf_(v); }
        __syncthreads();
        for (int task = bx; task < 288; task += G) {
            const int l = task / 144, n0 = (task % 144) * 64;
            float acc[16];
#pragma unroll
            for (int b = 0; b < 16; ++b) acc[b] = 0.f;
            const float* wp = w_ada + (size_t)l * 1024 * 9216 + n0 + lane;
#pragma unroll 1
            for (int k0 = wave * 128; k0 < wave * 128 + 128; k0 += 16) {
                float wv[16];
#pragma unroll
                for (int j = 0; j < 16; ++j) wv[j] = wp[(size_t)(k0 + j) * 9216];
                CFENCE();
#pragma unroll
                for (int j = 0; j < 16; ++j) { const int k = k0 + j; const float w = wv[j];
                    const f32x4 c0 = *(const LAS f32x4*)(cact + k * 16), c1 = *(const LAS f32x4*)(cact + k * 16 + 4), c2 = *(const LAS f32x4*)(cact + k * 16 + 8), c3 = *(const LAS f32x4*)(cact + k * 16 + 12);
#pragma unroll
                    for (int i = 0; i < 4; ++i) { acc[i] += c0[i] * w; acc[4 + i] += c1[i] * w; acc[8 + i] += c2[i] * w; acc[12 + i] += c3[i] * w; }
                    if ((j & 3) == 3) CFENCE(); }
            }
#pragma unroll
            for (int b = 0; b < 16; ++b) red[(wave * 16 + b) * 64 + lane] = acc[b];
            __syncthreads();
            for (int o = tid; o < 1024; o += 512) { const int b = o >> 6, ln = o & 63; float s = 0.f;
#pragma unroll
                for (int w = 0; w < 8; ++w) s += red[(w * 16 + b) * 64 + ln];
                MOD[((size_t)l * 16 + b) * 9216 + n0 + ln] = s + b_ada[l * 9216 + n0 + ln]; }
            __syncthreads();
        }
    }
    PH_NEXT;
    if (PH_ON) { DEFPTRS
        for (int i = bx * 512 + tid; i < 2 * 3 * 16 * 1024; i += G * 512) {
            const int k = i & 1023, b = (i >> 10) & 15, lj = i >> 14, l = lj / 3, j = lj % 3;
            const float* mp = MOD + ((size_t)l * 16 + b) * 9216 + j * 3072;
            GMOD[i] = g_norm[(l * 3 + j) * 1024 + k] * (1.0f + mp[1024 + k]);
            GATE[i] = (j == 1 ? 1.0f : 0.5f) * (1.0f + mp[2048 + k]);
        }
        LAS float* scr = (LAS float*)(lds + wave * 8448);
        constexpr int I_UP = 16 * 176, I_DN = 44 * 32, I_IN = 16 * 88, I_OUT = 16 * 32;
        constexpr int NIT = 4 * I_UP + 4 * I_DN + 2 * I_IN + 2 * I_OUT;
        for (int it = gw; it < NIT; it += NGW) {
            int r = it;
            if (r < 4 * I_UP) { const int mat = r / I_UP; r -= mat * I_UP; const int kb = r / 176, nb = r % 176, n0 = nb * 32;
                const int c0 = ((n0 >> 7) & 1) * DFF + (n0 >> 8) * 128 + (n0 & 127);
                transpose_item(w_up + (size_t)mat * DM * NUP, NUP, NUP, DM, WUP + (size_t)mat * NUP * DM, n0, c0, kb * 64, scr, lane); continue; }
            r -= 4 * I_UP;
            if (r < 4 * I_DN) { const int mat = r / I_DN; r -= mat * I_DN; const int kb = r / 32, nb = r % 32;
                transpose_item(w_dn + (size_t)mat * DFF * DM, DM, DM, DFF, WDN + (size_t)mat * DM * DFF, nb * 32, nb * 32, kb * 64, scr, lane); continue; }
            r -= 4 * I_DN;
            if (r < 2 * I_IN) { const int mat = r / I_IN; r -= mat * I_IN; const int kb = r / 88, nb = r % 88;
                transpose_item(w_in + (size_t)mat * DM * 2564, 2564, 2564, DM, WIN + (size_t)mat * NINP * DM, nb * 32, nb * 32, kb * 64, scr, lane); continue; }
            r -= 2 * I_IN;
            { const int mat = r / I_OUT; r -= mat * I_OUT; const int kb = r / 32, nb = r % 32;
                transpose_item(w_out + (size_t)mat * DM * DM, DM, DM, DM, WOUT + (size_t)mat * DM * DM, nb * 32, nb * 32, kb * 64, scr, lane); }
        }
        for (int m0 = gw; m0 < MTOK; m0 += 2 * NGW) {
            const int m1 = m0 + NGW;
            const f32x4* gp = (const f32x4*)(g_norm) + lane;
            const f32x4* xr0 = (const f32x4*)(x_in + (size_t)m0 * DM) + lane; const f32x4* xr1 = (const f32x4*)(x_in + (size_t)m1 * DM) + lane;
            f32x4 v0[4], v1[4];
#pragma unroll
            for (int j = 0; j < 4; ++j) { v0[j] = xr0[64 * j]; v1[j] = xr1[64 * j]; }
            const f32x4* sp0 = (const f32x4*)(MOD + (size_t)(m0 >> 12) * 9216 + 1024) + lane; const f32x4* sp1 = (const f32x4*)(MOD + (size_t)(m1 >> 12) * 9216 + 1024) + lane;
            float s0 = 0.f, s1 = 0.f; u32x2* o0 = (u32x2*)(XN + (size_t)m0 * DM) + lane; u32x2* o1 = (u32x2*)(XN + (size_t)m1 * DM) + lane;
#pragma unroll
            for (int j = 0; j < 4; ++j) { const f32x4 g = gp[64 * j];
                { const f32x4 v = v0[j]; s0 += (v[0] * v[0] + v[1] * v[1]) + (v[2] * v[2] + v[3] * v[3]); const f32x4 a = v * g * (sp0[64 * j] + 1.0f); u32x2 w; w.x = pk2(a[0], a[1]); w.y = pk2(a[2], a[3]); o0[64 * j] = w; }
                { const f32x4 v = v1[j]; s1 += (v[0] * v[0] + v[1] * v[1]) + (v[2] * v[2] + v[3] * v[3]); const f32x4 a = v * g * (sp1[64 * j] + 1.0f); u32x2 w; w.x = pk2(a[0], a[1]); w.y = pk2(a[2], a[3]); o1[64 * j] = w; } }
            s0 = wave_sum(s0); s1 = wave_sum(s1);
            if (lane == 0) { ROWSS[m0] = s0; ROWSS[m1] = s1; }
        }
    }
    PH_NEXT;
    if (PH_ON) { DEFPTRS
        LAS float* sh = (LAS float*)lds;
        for (int combo = 0; combo < 6; ++combo) {
            const int l = combo / 3, j = combo % 3;
            __syncthreads();
            for (int i = tid; i < 16 * 1024; i += 512) { const int b = i >> 10, k = i & 1023; sh[i] = MOD[((size_t)l * 16 + b) * 9216 + j * 3072 + k]; }
            __syncthreads();
            const bf16_t* Wt = (j == 1) ? WIN + (size_t)l * NINP * DM : WUP + (size_t)(l * 2 + (j == 2 ? 1 : 0)) * NUP * DM;
            const int N = (j == 1) ? NINP : NUP;
            float* dst = SBV + (size_t)combo * 16 * 5632;
            for (int n = gw; n < N; n += NGW) {
                float w[16];
#pragma unroll
                for (int c = 0; c < 4; ++c) { const u32x2 q = *(const u32x2*)(Wt + (size_t)n * DM + c * 256 + lane * 4);
                    w[4 * c] = __uint_as_float(q.x << 16); w[4 * c + 1] = __uint_as_float(q.x & 0xffff0000u); w[4 * c + 2] = __uint_as_float(q.y << 16); w[4 * c + 3] = __uint_as_float(q.y & 0xffff0000u); }
                float sv[16];
#pragma unroll
                for (int b = 0; b < 16; ++b) { float s = 0.f;
#pragma unroll
                    for (int c = 0; c < 4; ++c) { const f32x4 v = *(const LAS f32x4*)(sh + b * 1024 + c * 256 + lane * 4); s += (w[4 * c] * v[0] + w[4 * c + 1] * v[1]) + (w[4 * c + 2] * v[2] + w[4 * c + 3] * v[3]); }
                    sv[b] = s; if ((b & 3) == 3) CFENCE(); }
                float t8[8], t4[4], t2[2];
#pragma unroll
                for (int i = 0; i < 8; ++i) { const float snd = (lane & 32) ? sv[i] : sv[i + 8], kp = (lane & 32) ? sv[i + 8] : sv[i]; t8[i] = kp + __shfl_xor(snd, 32); }
#pragma unroll
                for (int i = 0; i < 4; ++i) { const float snd = (lane & 16) ? t8[i] : t8[i + 4], kp = (lane & 16) ? t8[i + 4] : t8[i]; t4[i] = kp + __shfl_xor(snd, 16); }
#pragma unroll
                for (int i = 0; i < 2; ++i) { const float snd = (lane & 8) ? t4[i] : t4[i + 2], kp = (lane & 8) ? t4[i + 2] : t4[i]; t2[i] = kp + __shfl_xor(snd, 8); }
                float t1; { const float snd = (lane & 4) ? t2[0] : t2[1], kp = (lane & 4) ? t2[1] : t2[0]; t1 = kp + __shfl_xor(snd, 4); }
                t1 += __shfl_xor(t1, 2); t1 += __shfl_xor(t1, 1);
                const int bsel = ((lane >> 5) & 1) * 8 + ((lane >> 4) & 1) * 4 + ((lane >> 3) & 1) * 2 + ((lane >> 2) & 1);
                if ((lane & 3) == 0) dst[(size_t)bsel * 5632 + n] = t1;
            }
        }
        __syncthreads();
    }
    PH_NEXT;

#ifdef REP_PRO
    if (rp_ == 0) { rp_ = 1; ph = 0; goto pro_again; }
#endif
#pragma unroll 1
    for (int f = 0; f < 4; ++f) {
        const int l = f >> 1, s = f & 1;
        if (s == 1) {
            if (PH_ON) { DEFPTRS
                pg8::Gemm g{XN, WIN + (size_t)l * NINP * DM, MTOK, NINP, DM}; pg8::StaticOrder S; S.init(MTOK, NINP, G, bx);
                pg8::EpiIn E{PROJ, FG, ROWSS + (size_t)(l * 3 + 1) * MTOK, SBV + (size_t)(l * 3 + 1) * 16 * 5632, lds + 131072 + 2048};
#ifndef NO_G_IN
                for (int rep_ = 0; rep_ < REP_IN; ++rep_) {
                pg8::gemm_phase<pg8::EpiIn, pg8::StaticOrder, true, true>(lds, g, S, E); }
#endif
            }
            PH_NEXT;
            if (PH_ON) { DEFPTRS
#ifndef NO_PREP
                {
                    const int blk = vcu & 7, n = lane & 31, hi = lane >> 5;
                    LAS unsigned char* wfl = lds;
                    LAS float* xs = (LAS float*)(lds + 16384 + wave * 13568);
                    LAS unsigned char* ub = lds + 16384 + wave * 13568 + 8960;
#pragma unroll
                    for (int q = 0; q < 2; ++q) { const int f = wave * 2 + q, gt = f >> 3, nb = (f >> 2) & 1, d0 = f & 3;
                        const float* wsrc = (gt ? w_ig : w_rg) + ((size_t)(l * 8 + blk) * 64 + 16 * d0 + 8 * hi) * 64 + nb * 32 + n;
                        u32x4 w; w.x = pk2(wsrc[0], wsrc[64]); w.y = pk2(wsrc[128], wsrc[192]); w.z = pk2(wsrc[256], wsrc[320]); w.w = pk2(wsrc[384], wsrc[448]);
                        *(LAS u32x4*)(wfl + f * 1024 + lane * 16) = w; }
                    __syncthreads();
                    float br[2], bi[2], cb[2], cw[2][4], c8[2];
#pragma unroll
                    for (int nb = 0; nb < 2; ++nb) { const int ch = blk * 64 + nb * 32 + n;
                        br[nb] = b_rg[l * 512 + ch]; bi[nb] = b_ig[l * 512 + ch]; cb[nb] = conv_b[l * 512 + ch];
#pragma unroll
                        for (int k = 0; k < 4; ++k) cw[nb][k] = conv_w[(l * 4 + k) * 512 + ch];
                        const float lmv = lam[l * 512 + ch];
                        c8[nb] = -8.0f * LOG2E * (__builtin_fmaxf(-lmv, 0.f) + log1pf(expf(-fabsf(lmv)))); }
                    for (int segi = (vcu >> 3) * 8 + wave; segi < REP_PREP * (MTOK / 32); segi += (G >> 3) * 8) { const int seg = segi & (MTOK / 32 - 1);
                        const int row0 = seg * 32; const bool first = (row0 & (SEQL - 1)) == 0;
                        const bf16_t* xp = PROJ + (size_t)row0 * PPITCH + blk * 64;
                        CFENCE();
#pragma unroll
                        for (int t = 0; t < 35; ++t) { float v = 0.f; if (t >= 3 || !first) v = bf2f((xp + ((long)t - 3) * PPITCH)[lane]); xs[t * 64 + lane] = v; }
                        CFENCE();
#pragma unroll
                        for (int nb = 0; nb < 2; ++nb)
#pragma unroll
                            for (int g = 0; g < 4; ++g) { const LAS float* xb = xs + (8 * g + 4 * hi) * 64 + nb * 32 + n; float xv[7];
#pragma unroll
                                for (int j = 0; j < 7; ++j) xv[j] = xb[j * 64];
#pragma unroll
                                for (int i = 0; i < 4; ++i) { const float uu = cb[nb] + cw[nb][0] * xv[i] + cw[nb][1] * xv[i + 1] + cw[nb][2] * xv[i + 2] + cw[nb][3] * xv[i + 3];
                                    *(LAS unsigned short*)(ub + (8 * g + 4 * hi + i) * 144 + (nb * 32 + n) * 2) = (unsigned short)f2bf(uu); }
                                __builtin_amdgcn_sched_barrier(0); }
                        CFENCE();
                        bf16x8 af[4];
#pragma unroll
                        for (int d0 = 0; d0 < 4; ++d0) af[d0] = *(const LAS bf16x8*)(ub + n * 144 + (16 * d0 + 8 * hi) * 2);
#pragma unroll
                        for (int nb = 0; nb < 2; ++nb) {
                            f32x16 arx, aix;
#pragma unroll
                            for (int r = 0; r < 16; ++r) { arx[r] = br[nb]; aix[r] = bi[nb]; }
#pragma unroll
                            for (int d0 = 0; d0 < 4; ++d0) { const bf16x8 w0 = *(const LAS bf16x8*)(wfl + ((0 * 2 + nb) * 4 + d0) * 1024 + lane * 16), w1 = *(const LAS bf16x8*)(wfl + ((1 * 2 + nb) * 4 + d0) * 1024 + lane * 16);
                                                             arx = __builtin_amdgcn_mfma_f32_32x32x16_bf16(af[d0], w0, arx, 0, 0, 0);
                                                             aix = __builtin_amdgcn_mfma_f32_32x32x16_bf16(af[d0], w1, aix, 0, 0, 0); }
                            CFENCE(); __builtin_amdgcn_sched_barrier(0);
#pragma unroll
                            for (int r = 0; r < 16; ++r) {
                                float uu; { const LAS float* xb = xs + (8 * (r >> 2) + 4 * hi + (r & 3)) * 64 + nb * 32 + n;
                                    uu = cb[nb] + cw[nb][0] * xb[0] + cw[nb][1] * xb[64] + cw[nb][2] * xb[128] + cw[nb][3] * xb[192]; }
                                const float rg = sigmoidf_(arx[r]), ig = sigmoidf_(aix[r]);
                                const float la2 = c8[nb] * rg, a = __builtin_amdgcn_exp2f(la2);
                                const float xx = 2.0f * 0.6931471805599453f * la2;
                                const float om = (xx > -0.25f) ? -xx * (1.0f + xx * 0.5f * (1.0f + xx * (1.0f / 3.0f) * (1.0f + xx * 0.25f * (1.0f + xx * 0.2f)))) : 1.0f - a * a;
                                arx[r] = a; aix[r] = __builtin_sqrtf(om) * ig * uu;
                            }
                            float H = 0.f, P = 1.f;
                            const int ch = blk * 64 + nb * 32 + n;
                            bf16_t* hl = HLOC + (size_t)(row0 + 4 * hi) * 512 + ch; bf16_t* pc = PCUM + (size_t)(row0 + 4 * hi) * 512 + ch;
#pragma unroll
                            for (int g = 0; g < 4; ++g) {
                                const float a0 = arx[4 * g], a1 = arx[4 * g + 1], a2 = arx[4 * g + 2], a3 = arx[4 * g + 3];
                                const float b0 = aix[4 * g], b1 = aix[4 * g + 1], b2 = aix[4 * g + 2], b3 = aix[4 * g + 3];
                                const float Ao = (a0 * a1) * (a2 * a3), Bo = ((b0 * a1 + b1) * a2 + b2) * a3 + b3;
                                const float Ap = __shfl_xor(Ao, 32), Bp = __shfl_xor(Bo, 32);
                                const float A1 = hi ? Ap : Ao, B1 = hi ? Bp : Bo, A2 = hi ? Ao : Ap, B2 = hi ? Bo : Bp;
                                const float Hm = A1 * H + B1, Pm = A1 * P;
                                float h = hi ? Hm : H, p = hi ? Pm : P;
                                H = A2 * Hm + B2; P = A2 * Pm;
                                bf16_t* hg = hl + (size_t)g * 8 * 512; bf16_t* pg = pc + (size_t)g * 8 * 512; asm volatile("" : "+v"(hg), "+v"(pg));
                                h = a0 * h + b0; p *= a0; hg[0 * 512] = (bf16_t)f2bf(h); pg[0 * 512] = (bf16_t)f2bf(p);
                                h = a1 * h + b1; p *= a1; hg[1 * 512] = (bf16_t)f2bf(h); pg[1 * 512] = (bf16_t)f2bf(p);
                                h = a2 * h + b2; p *= a2; hg[2 * 512] = (bf16_t)f2bf(h); pg[2 * 512] = (bf16_t)f2bf(p);
                                h = a3 * h + b3; p *= a3; hg[3 * 512] = (bf16_t)f2bf(h); pg[3 * 512] = (bf16_t)f2bf(p);
                            }
                            if (hi == 0) { ASEG[(size_t)seg * 512 + ch] = P; BSEG[(size_t)seg * 512 + ch] = H; }
                            CFENCE(); __builtin_amdgcn_sched_barrier(0);
                        }
                    }
                }
                for (int row = gw; row < MTOK; row += NGW) {
                    const u32x2 q = *(const u32x2*)(PROJ + (size_t)row * PPITCH + 2048 + lane * 4);
                    const float a0 = __uint_as_float(q.x << 16), a1 = __uint_as_float(q.x & 0xffff0000u), a2 = __uint_as_float(q.y << 16), a3 = __uint_as_float(q.y & 0xffff0000u);
                    float ss = (a0 * a0 + a1 * a1) + (a2 * a2 + a3 * a3);
                    ss += __shfl_xor(ss, 1); ss += __shfl_xor(ss, 2); ss += __shfl_xor(ss, 4); ss += __shfl_xor(ss, 8);
                    const float rk = __builtin_amdgcn_rsqf(ss * (1.0f / 64.0f) + EPSF);
                    u32x2 kn; kn.x = pk2(a0 * rk, a1 * rk); kn.y = pk2(a2 * rk, a3 * rk);
                    *(u32x2*)(PROJ + (size_t)row * PPITCH + 2048 + lane * 4) = kn;
                }
                for (int chn = vcu; chn < 64; chn += G) {
                    const int b = chn >> 2, h = chn & 3; const float bf = b_fg[l * 4 + h];
                    const int t0 = wave * 512 + lane * 8;
                    const float* fp = FG + ((size_t)b * SEQL + t0) * 4 + h;
                    float lf[8], tot = 0.f;
#pragma unroll
                    for (int i = 0; i < 8; ++i) { const float v = fp[i * 4] + bf; lf[i] = __builtin_fminf(v, 0.f) - log1pf(expf(-fabsf(v))); tot += lf[i]; }
                    float inc = tot;
#pragma unroll
                    for (int o = 1; o < 64; o <<= 1) { const float t_ = __shfl_up(inc, o); if (lane >= o) inc += t_; }
                    LAS float* wt = (LAS float*)(lds + 16384 + 8 * 13568);
                    __syncthreads();
                    if (lane == 63) wt[wave] = inc;
                    __syncthreads();
                    float run = inc - tot;
                    for (int w = 0; w < wave; ++w) run += wt[w];
                    f32x4 o0, o1;
                    run += lf[0]; o0[0] = -run * LOG2E; run += lf[1]; o0[1] = -run * LOG2E; run += lf[2]; o0[2] = -run * LOG2E; run += lf[3]; o0[3] = -run * LOG2E;
                    run += lf[4]; o1[0] = -run * LOG2E; run += lf[5]; o1[1] = -run * LOG2E; run += lf[6]; o1[2] = -run * LOG2E; run += lf[7]; o1[3] = -run * LOG2E;
                    float* op = F2 + (size_t)chn * SEQL + t0;
                    *(f32x4*)op = o0; *(f32x4*)(op + 4) = o1;
                }
#endif
                __syncthreads();
            }
            PH_NEXT;
            if (PH_ON) { DEFPTRS
#ifndef NO_ATTN
                for (int rep_ = 0; rep_ < REP_ATTN; ++rep_)
                for (int tt = vcu; tt < 256; tt += G) { const int ch = tid; float A = 1.f, B = 0.f;
#pragma unroll
                    for (int s8 = 0; s8 < 8; ++s8) { const float as_ = ASEG[(size_t)(tt * 8 + s8) * 512 + ch], bs_ = BSEG[(size_t)(tt * 8 + s8) * 512 + ch]; A = as_ * A; B = as_ * B + bs_; }
                    TSEGA[(size_t)tt * 512 + ch] = A; TSEGB[(size_t)tt * 512 + ch] = B; }
                for (int vw = vcu; vw < 256; vw += G) {
                    const int bh = vw >> 2, s4 = vw & 3, b = bh >> 2, h = bh & 3;
#pragma unroll 1
                    for (int i = 0; i < 4; ++i) { const int qb = (i == 0) ? s4 : (i == 1) ? 7 - s4 : (i == 2) ? 8 + s4 : 15 - s4;
#ifndef NO_FOX
                        attn_unit<1>(lds, PROJ, YU, KS, F2, g_qk + l * 128, b, h, qb);
#endif
 }
#pragma unroll 1
                    for (int i = 0; i < 4; ++i) { const int qb = (i == 0) ? s4 : (i == 1) ? 7 - s4 : (i == 2) ? 8 + s4 : 15 - s4;
#ifndef NO_SB
                        attn_unit<0>(lds, PROJ, YU, KS, F2, g_qk + l * 128, b, h, qb);
#endif
 }
                }
#endif
            }
            PH_NEXT;
            if (PH_ON) { DEFPTRS
                LAS float* hin = (LAS float*)lds;
                const f32x4 gm0 = *(const f32x4*)(g_mix + l * 1024 + lane * 8), gm1 = *(const f32x4*)(g_mix + l * 1024 + lane * 8 + 4);
                const f32x4 gx0 = *(const f32x4*)(g_mix + l * 1024 + 512 + lane * 8), gx1 = *(const f32x4*)(g_mix + l * 1024 + 512 + lane * 8 + 4);
                for (int tti = vcu; tti < REP_FIN * 256; tti += G) { const int tt = tti & 255;
                    __syncthreads();
                    { const int ch = tid, seg0 = (tt >> 4) * 128, nb = (tt & 15) * 8; float Hc = 0.f;
#pragma unroll 5
                      for (int t_ = (tt & ~15); t_ < tt; ++t_) Hc = TSEGA[(size_t)t_ * 512 + ch] * Hc + TSEGB[(size_t)t_ * 512 + ch];
#pragma unroll
                      for (int s8 = 0; s8 < 8; ++s8) { hin[s8 * 512 + ch] = Hc; Hc = ASEG[(size_t)(seg0 + nb + s8) * 512 + ch] * Hc + BSEG[(size_t)(seg0 + nb + s8) * 512 + ch]; } }
                    __syncthreads();
                    const f32x4 hi0 = *(const LAS f32x4*)(hin + wave * 512 + lane * 8), hi1 = *(const LAS f32x4*)(hin + wave * 512 + lane * 8 + 4);
#pragma unroll 1
                    for (int t4 = 0; t4 < 32; t4 += 4) {
                      u32x4 hq4[4], pq4[4], gq4[4], yq4[4];
#pragma unroll
                      for (int rr = 0; rr < 4; ++rr) { const size_t row = (size_t)tt * 256 + wave * 32 + t4 + rr;
                          hq4[rr] = *(const u32x4*)(HLOC + row * 512 + lane * 8); pq4[rr] = *(const u32x4*)(PCUM + row * 512 + lane * 8);
                          gq4[rr] = *(const u32x4*)(PROJ + row * PPITCH + 512 + lane * 8); yq4[rr] = *(const u32x4*)(YU + row * 512 + lane * 8); }
                      CFENCE();
#pragma unroll
                      for (int rr = 0; rr < 4; ++rr) {
                        const size_t row = (size_t)tt * 256 + wave * 32 + t4 + rr;
                        const u32x4 hq = hq4[rr], pq = pq4[rr], gq = gq4[rr], yq = yq4[rr];
                        float y[8], yu[8]; float ss = 0.f, s2 = 0.f;
#pragma unroll
                        for (int i = 0; i < 8; ++i) {
                            const unsigned pw = pq[i >> 1], gw_ = gq[i >> 1], yw = yq[i >> 1];
                            const float p = (i & 1) ? __uint_as_float(pw & 0xffff0000u) : __uint_as_float(pw << 16);
                            const float gg = (i & 1) ? __uint_as_float(gw_ & 0xffff0000u) : __uint_as_float(gw_ << 16);
                            yu[i] = (i & 1) ? __uint_as_float(yw & 0xffff0000u) : __uint_as_float(yw << 16);
                            const unsigned hw = hq[i >> 1]; const float hlv = (i & 1) ? __uint_as_float(hw & 0xffff0000u) : __uint_as_float(hw << 16);
                            const float hh = hlv + p * (i < 4 ? hi0[i & 3] : hi1[i & 3]);
                            const float inner = 0.7978845608028654f * (gg + 0.044715f * gg * gg * gg);
                            const float ge = gg * __builtin_amdgcn_rcpf(1.0f + __builtin_amdgcn_exp2f(-2.0f * LOG2E * inner));
                            y[i] = hh * ge; ss += y[i] * y[i]; s2 += yu[i] * yu[i];
                        }
                        ss = wave_sum(ss);
                        s2 += __shfl_xor(s2, 1); s2 += __shfl_xor(s2, 2); s2 += __shfl_xor(s2, 4); s2 += __shfl_xor(s2, 8); s2 += __shfl_xor(s2, 16);
                        const float rl = __builtin_amdgcn_rsqf(ss * (1.0f / 512.0f) + EPSF), rx = __builtin_amdgcn_rsqf(s2 * (1.0f / 256.0f) + EPSF);
                        u32x4 o1, o2;
                        o1.x = pk2(y[0] * rl * gm0[0], y[1] * rl * gm0[1]); o1.y = pk2(y[2] * rl * gm0[2], y[3] * rl * gm0[3]);
                        o1.z = pk2(y[4] * rl * gm1[0], y[5] * rl * gm1[1]); o1.w = pk2(y[6] * rl * gm1[2], y[7] * rl * gm1[3]);
                        o2.x = pk2(yu[0] * rx * gx0[0], yu[1] * rx * gx0[1]); o2.y = pk2(yu[2] * rx * gx0[2], yu[3] * rx * gx0[3]);
                        o2.z = pk2(yu[4] * rx * gx1[0], yu[5] * rx * gx1[1]); o2.w = pk2(yu[6] * rx * gx1[2], yu[7] * rx * gx1[3]);
                        *(u32x4*)(YN + row * 1024 + lane * 8) = o1; *(u32x4*)(YN + row * 1024 + 512 + lane * 8) = o2;
                      }
                    }
                }
                __syncthreads();
            }
            PH_NEXT;
            if (PH_ON) { DEFPTRS
                pg8::Gemm g{YN, WOUT + (size_t)l * DM * DM, MTOK, DM, DM}; pg8::StaticOrder S; S.init(MTOK, DM, G, bx, 24);
                pg8::EpiRes E{xout, xout, GATE + (size_t)(l * 3 + 1) * 16 * 1024, GMOD + (size_t)(l * 3 + 2) * 16 * 1024, XN, ROWSS + (size_t)(l * 3 + 2) * MTOK, 1, lds + 131072 + 2048};
#ifndef NO_G_OUT
#ifdef REP_OUT
                { E.xout = (float*)HB; E.has_next = 0; pg8::gemm_phase<pg8::EpiRes, pg8::StaticOrder, false, true>(lds, g, S, E); E.xout = xout; E.has_next = 1; }
#endif
                pg8::gemm_phase<pg8::EpiRes, pg8::StaticOrder, false, true>(lds, g, S, E);
#endif
            }
            PH_NEXT;
        }
        const int j = s ? 2 : 0;
        if (PH_ON) { DEFPTRS
            pg8::Gemm g{XN, WUP + (size_t)(l * 2 + s) * NUP * DM, MTOK, NUP, DM}; pg8::StaticOrder S; S.init(MTOK, NUP, G, bx);
            pg8::EpiUp E{HB, ROWSS + (size_t)(l * 3 + j) * MTOK, SBV + (size_t)(l * 3 + j) * 16 * 5632, lds + 131072 + 2048};
#ifndef NO_G_UP
            for (int rep_ = 0; rep_ < REP_UP; ++rep_) {
            pg8::gemm_phase<pg8::EpiUp, pg8::StaticOrder, true, true>(lds, g, S, E);
            }
#endif
        }
        PH_NEXT;
        if (PH_ON) { DEFPTRS
            const int nl = s ? l + 1 : l, nj = s ? 0 : 1; const int has_next = (nl < 2) ? 1 : 0; const int nidx = has_next ? nl * 3 + nj : 0;
            pg8::Gemm g{HB, WDN + (size_t)(l * 2 + s) * DM * DFF, MTOK, DM, DFF}; pg8::StaticOrder S; S.init(MTOK, DM, G, bx, 24);
            pg8::EpiRes E{f == 0 ? x_in : xout, xout, GATE + (size_t)(l * 3 + j) * 16 * 1024, GMOD + (size_t)nidx * 16 * 1024, XN, ROWSS + (size_t)nidx * MTOK, has_next, lds + 131072 + 2048};
#ifndef NO_G_DN
#ifdef REP_DN
            for (int rep_ = 0; rep_ < 2; ++rep_) { E.xout = (rep_ == 0) ? (float*)HLOC : xout; E.has_next = (rep_ == 0) ? 0 : has_next;
            pg8::gemm_phase<pg8::EpiRes, pg8::StaticOrder, false, true>(lds, g, S, E); }
#else
            pg8::gemm_phase<pg8::EpiRes, pg8::StaticOrder, false, true>(lds, g, S, E);
#endif
#endif
        }
        PH_NEXT;
    }
#undef PH_ON
#undef PH_NEXT
}


#ifdef DBG_STOP
__global__ void dbg_dump(const unsigned char* ws, float* out, int mode) {
    const size_t n = (size_t)MTOK * DM; const size_t i0 = (size_t)blockIdx.x * blockDim.x + threadIdx.x, st = (size_t)gridDim.x * blockDim.x;
    const bf16_t* XN = (const bf16_t*)(ws + WS_XN); const bf16_t* HB = (const bf16_t*)(ws + WS_H); const bf16_t* PR = (const bf16_t*)(ws + WS_PROJ);
    const bf16_t* YU = (const bf16_t*)(ws + WS_YU); const float* HL = (const float*)(ws + WS_HLOC); const bf16_t* YN = (const bf16_t*)(ws + WS_YN); const bf16_t* PC = (const bf16_t*)(ws + WS_PCUM);
    for (size_t i = i0; i < n; i += st) {
        float v = 0.f;
        if (mode == 0) v = bf2f(XN[i]);
        else if (mode == 1) v = bf2f(HB[i]) + bf2f(HB[i + n]) + bf2f(HB[i + (size_t)117440512]);
        else if (mode == 2) v = bf2f(PR[i]) + bf2f(PR[i + n]) + bf2f(PR[i + (size_t)100663296]);
        else if (mode == 3) v = (i < n / 2) ? bf2f(YU[i]) : HL[i - n / 2];
        else if (mode == 4) v = bf2f(YN[i]);
        else if (mode == 6) v = (i < n / 2) ? bf2f(PC[i]) : ((const float*)(ws + WS_KS))[(i - n / 2) % (3 * 262144)];
        else if (mode == 7) v = HL[i % (n / 2)] + bf2f(PC[i % (n / 2)]) + ((const float*)(ws + WS_KS))[i % (3 * 262144)] + ((const float*)(ws + WS_ASEG))[i % (2 * 1048576)];
        if (mode == 3) { const bool nan_ = !(v == v), big = (v > 3e38f) || (v < -3e38f); float code = 0.f;
            if (i < n / 2) { const int col = (int)(i & 511); if (col < 256) code = nan_ ? 2000.f : (big ? 1000.f : 0.f); else code = (nan_ || big) ? 4000.f : 0.f; }
            else code = (nan_ || big) ? 8000.f : 0.f;
            v = code; }
        if (!(v == v)) v = 77777.f; if (v > 3e38f) v = 88888.f; if (v < -3e38f) v = 99999.f;
        if (mode != 5) out[i] = v;
    }
}
#endif
#ifndef MK_N_LAUNCHES
#define MK_N_LAUNCHES 1
#endif
constexpr int N_PHASES = 3 + 2 * 9;
extern "C" void kernel_launch(void* const* d_in, const int* in_sizes, int n_in, void* d_out, int out_size, void* d_ws, size_t ws_size, hipStream_t stream) {
    static int grid = 0;
    if (grid == 0) {
        if (n_in != 19 || out_size != MTOK * DM || ws_size < WS_END) { fprintf(stderr, "kernel_launch: unexpected shapes (n_in %d, out %d, ws %zu)\n", n_in, out_size, ws_size); grid = -1; return; }
        int dev = 0, cus = 0, per_cu = 0;
        hipGetDevice(&dev); hipDeviceGetAttribute(&cus, hipDeviceAttributeMultiprocessorCount, dev);
        if (hipFuncSetAttribute((const void*)mk_fwd, hipFuncAttributeMaxDynamicSharedMemorySize, LDS_BYTES) != hipSuccess) { fprintf(stderr, "kernel_launch: hipFuncSetAttribute failed\n"); grid = -1; return; }
        if (hipOccupancyMaxActiveBlocksPerMultiprocessor(&per_cu, (const void*)mk_fwd, 512, LDS_BYTES) != hipSuccess || per_cu < 1) { fprintf(stderr, "kernel_launch: occupancy query says %d\n", per_cu); per_cu = 1; }
        (void)hipGetLastError();
        grid = cus * 1;
    }
    if (grid < 0) return;
    if (hipMemsetAsync(d_ws, 0, 16384, stream) != hipSuccess) { fprintf(stderr, "kernel_launch: memset failed\n"); return; }
    Args a{};
    for (int i = 0; i < 19; ++i) a.in[i] = (const float*)d_in[i];
    a.out = (float*)d_out; a.ws = (unsigned char*)d_ws;
#if MK_N_LAUNCHES == 1
    a.ph_lo = 0; a.ph_hi = N_PHASES;
    void* kargs[] = {&a};
    hipError_t e = hipLaunchCooperativeKernel((const void*)mk_fwd, dim3(grid), dim3(512), kargs, LDS_BYTES, stream);
    if (e != hipSuccess) fprintf(stderr, "kernel_launch: cooperative launch failed: %s (grid %d)\n", hipGetErrorString(e), grid);
#else
#ifdef DBG_STOP
    for (int p = 0; p < DBG_STOP; ++p) { a.ph_lo = p; a.ph_hi = p + 1; hipLaunchKernelGGL(mk_fwd, dim3(grid), dim3(512), LDS_BYTES, stream, a); }
    hipLaunchKernelGGL(dbg_dump, dim3(2048), dim3(256), 0, stream, (const unsigned char*)d_ws, (float*)d_out, DBG_MODE);
#else
    for (int p = 0; p < N_PHASES; ++p) { a.ph_lo = p; a.ph_hi = p + 1; hipLaunchKernelGGL(mk_fwd, dim3(grid), dim3(512), LDS_BYTES, stream, a); }
#endif
#endif
}
```
